# Optimizing an MI355X kernel written in HIP

```python
import math
import jax, jax.numpy as jnp
from jax import lax
import numpy as np

D_MODEL = 1024
BATCH = 4
SEQ = 8192
DEPTH = 1

N_MEM = 256
EPS = 1e-6
ATTN_HEADS = 8
ATTN_KV_HEADS = 2
ATTN_HEAD_DIM = 64
WINDOW = 128
ATTN_BLOCK = 128
REL_BUCKETS = 32
REL_MAX_DIST = 128
DN_HEADS = 8
DN_KEY_DIM = 64
DN_VALUE_DIM = 64
DN_CONV = 5
DN_CHUNK = 64
MEM_HEADS = 4
MEM_HEAD_DIM = 128
D_FF = 2816
FFN_CONV = 3
N_BRANCH = 3

ATTN_Q = ATTN_HEADS * ATTN_HEAD_DIM
ATTN_KV = ATTN_KV_HEADS * ATTN_HEAD_DIM
DN_QK = DN_HEADS * DN_KEY_DIM
DN_V = DN_HEADS * DN_VALUE_DIM
MEM_Q = MEM_HEADS * MEM_HEAD_DIM
IN_SPLITS = (ATTN_Q, ATTN_KV, ATTN_KV, DN_QK, DN_QK, DN_V, DN_V, 2 * DN_HEADS, 2 * DN_HEADS, MEM_Q, N_BRANCH * D_MODEL)
D_IN = sum(IN_SPLITS)

kernel_name = "hybrid_gated_swa_deltanet_memory_encoder"


def _split(t, sizes):
    idx = np.cumsum(sizes)[:-1].tolist()
    return jnp.split(t, idx, axis=-1)


def rmsnorm(x, g):
    x32 = x.astype(jnp.float32)
    y = x32 * lax.rsqrt(jnp.mean(x32 * x32, axis=-1, keepdims=True) + EPS)
    return (y * g.astype(jnp.float32)).astype(x.dtype)


def l2norm(x):
    x32 = x.astype(jnp.float32)
    return (x32 * lax.rsqrt(jnp.sum(x32 * x32, axis=-1, keepdims=True) + EPS)).astype(x.dtype)


def dwconv_centred(x, w):
    K = w.shape[0]
    p = K // 2
    S = x.shape[1]
    xp = jnp.pad(x, ((0, 0), (p, p), (0, 0)))
    y = xp[:, 0:S] * w[0]
    for j in range(1, K):
        y = y + xp[:, j:j + S] * w[j]
    return y


def _t5_buckets(rel):
    nb = REL_BUCKETS // 2
    max_exact = nb // 2
    ret = (rel > 0).astype(np.int32) * nb
    n = np.abs(rel)
    large = max_exact + (np.log(np.maximum(n, 1) / max_exact) / np.log(REL_MAX_DIST / max_exact) * (nb - max_exact)).astype(np.int32)
    large = np.minimum(large, nb - 1)
    return (ret + np.where(n < max_exact, n, large)).astype(np.int32)


def windowed_gqa(q, k, v, sink, rel_table):
    B, S, H, dh = q.shape
    Hkv = k.shape[2]
    G = H // Hkv
    T = ATTN_BLOCK
    nb = S // T
    t_idx = np.arange(T)[:, None]
    j_idx = np.arange(3 * T)[None, :]
    rel = j_idx - T - t_idx
    kpos = np.arange(nb)[:, None, None] * T - T + j_idx[None]
    valid = (np.abs(rel) <= WINDOW)[None] & (kpos >= 0) & (kpos < S)
    bias = jnp.transpose(rel_table[jnp.asarray(_t5_buckets(rel))], (2, 0, 1)).astype(jnp.float32)
    bias = bias.reshape(Hkv, G, T, 3 * T)

    qb = q.reshape(B, nb, T, Hkv, G, dh)

    def band(a):
        ap = jnp.pad(a, ((0, 0), (T, T), (0, 0), (0, 0))).reshape(B, nb + 2, T, Hkv, dh)
        return jnp.concatenate([ap[:, :-2], ap[:, 1:-1], ap[:, 2:]], axis=2)

    kb, vb = band(k), band(v)
    s = jnp.einsum('bnqkgd,bnjkd->bnkgqj', qb, kb).astype(jnp.float32) * (dh ** -0.5) + bias
    s = jnp.where(jnp.asarray(valid)[None, :, None, None], s, -jnp.inf)
    sk = sink.astype(jnp.float32).reshape(1, 1, Hkv, G, 1, 1)
    m = jnp.maximum(s.max(axis=-1, keepdims=True), sk)
    p = jnp.exp(s - m)
    p = p / (p.sum(axis=-1, keepdims=True) + jnp.exp(sk - m))
    o = jnp.einsum('bnkgqj,bnjkd->bnqkgd', p.astype(v.dtype), vb)
    return o.reshape(B, S, H * dh)


def gated_delta_rule(q, k, v, g, beta):
    B, S, H, dk = q.shape
    dv = v.shape[-1]
    C = DN_CHUNK
    n = S // C
    f32 = jnp.float32

    def ch(t):
        return t.astype(f32).reshape(B, n, C, H, -1).transpose(0, 3, 1, 2, 4)

    q, k, v = ch(q), ch(k), ch(v)
    g = g.astype(f32).reshape(B, n, C, H).transpose(0, 3, 1, 2)
    beta = beta.astype(f32).reshape(B, n, C, H).transpose(0, 3, 1, 2)
    gc = jnp.cumsum(g, axis=-1)
    lower = jnp.asarray(np.tril(np.ones((C, C), bool)))
    strict = jnp.asarray(np.tril(np.ones((C, C), bool), -1))
    decay = jnp.exp(jnp.where(lower, gc[..., :, None] - gc[..., None, :], -jnp.inf))
    kb = k * beta[..., None]
    L = jnp.where(strict, jnp.einsum('bhncd,bhnmd->bhncm', kb, k) * decay, 0.0)
    A = L + jnp.eye(C, dtype=f32)
    rhs = jnp.concatenate([v * beta[..., None], kb * jnp.exp(gc)[..., None]], axis=-1)
    sol = lax.linalg.triangular_solve(A, rhs, left_side=True, lower=True, unit_diagonal=True)
    u, w = sol[..., :dv], sol[..., dv:]
    qk = jnp.einsum('bhncd,bhnmd->bhncm', q, k) * decay
    g_last = gc[..., -1]
    q_in = q * jnp.exp(gc)[..., None]
    k_up = k * jnp.exp(g_last[..., None] - gc)[..., None]

    def step(state, inp):
        qi, ki, ui, wi, qki, gl = inp
        v_new = ui - jnp.einsum('bhcd,bhde->bhce', wi, state)
        o = jnp.einsum('bhcd,bhde->bhce', qi, state) + jnp.einsum('bhcm,bhme->bhce', qki, v_new)
        state = state * jnp.exp(gl)[..., None, None] + jnp.einsum('bhcd,bhce->bhde', ki, v_new)
        return state, o

    xs = (jnp.moveaxis(q_in, 2, 0), jnp.moveaxis(k_up, 2, 0), jnp.moveaxis(u, 2, 0),
          jnp.moveaxis(w, 2, 0), jnp.moveaxis(qk, 2, 0), jnp.moveaxis(g_last, 2, 0))
    state0 = jnp.zeros((B, H, dk, dv), f32)
    _, o = lax.scan(step, state0, xs)
    return o.transpose(1, 0, 3, 2, 4).reshape(B, S, H, dv)


def deltanet_branch(dq, dk, dv, dz, db, da, conv_w, a_log, dt_bias, out_g):
    B, S, _ = dq.shape
    f32 = jnp.float32
    qkv = jax.nn.silu(dwconv_centred(jnp.concatenate([dq, dk, dv], axis=-1), conv_w))
    q, k, v = _split(qkv, (DN_QK, DN_QK, DN_V))
    q = l2norm(q.reshape(B, S, DN_HEADS, DN_KEY_DIM)) * (DN_KEY_DIM ** -0.5)
    k = l2norm(k.reshape(B, S, DN_HEADS, DN_KEY_DIM))
    v = v.reshape(B, S, DN_HEADS, DN_VALUE_DIM)
    beta = jax.nn.sigmoid(db.astype(f32)).reshape(B, S, 2, DN_HEADS)
    g = -jnp.exp(a_log.astype(f32)) * jax.nn.softplus(da.astype(f32).reshape(B, S, 2, DN_HEADS) + dt_bias.astype(f32))
    o_fwd = gated_delta_rule(q, k, v, g[:, :, 0], beta[:, :, 0])
    o_bwd = jnp.flip(gated_delta_rule(jnp.flip(q, 1), jnp.flip(k, 1), jnp.flip(v, 1),
                                      jnp.flip(g[:, :, 1], 1), jnp.flip(beta[:, :, 1], 1)), 1)
    z = dz.reshape(B, S, DN_HEADS, DN_VALUE_DIM).astype(f32)
    o = rmsnorm(o_fwd + o_bwd, out_g) * jax.nn.silu(z)
    return o.reshape(B, S, DN_V).astype(dq.dtype)


def memory_cross_attention(mq, mem_n, w_kv, q_g, k_g):
    B, S, _ = mq.shape
    M = mem_n.shape[1]
    k, v = jnp.split(mem_n @ w_kv, 2, axis=-1)
    q = rmsnorm(mq.reshape(B, S, MEM_HEADS, MEM_HEAD_DIM), q_g)
    k = rmsnorm(k.reshape(B, M, MEM_HEADS, MEM_HEAD_DIM), k_g)
    v = v.reshape(B, M, MEM_HEADS, MEM_HEAD_DIM)
    s = jnp.einsum('bshd,bmhd->bhsm', q, k).astype(jnp.float32) * (MEM_HEAD_DIM ** -0.5)
    p = jax.nn.softmax(s, axis=-1).astype(v.dtype)
    return jnp.einsum('bhsm,bmhd->bshd', p, v).reshape(B, S, MEM_Q)


def setup_inputs(seed: int = 0) -> dict:
    key = jax.random.key(seed)
    ks = jax.random.split(key, 26)
    f32 = jnp.float32
    L = DEPTH

    def nrm(k, shape, scale):
        return jax.random.normal(k, shape, f32) * scale

    def gain(k, shape):
        return 1.0 + 0.05 * jax.random.normal(k, shape, f32)

    dt = jnp.exp(jax.random.uniform(ks[9], (L, 2, DN_HEADS), f32, math.log(1e-3), math.log(1e-1)))
    return {
        "x": nrm(ks[0], (BATCH, SEQ, D_MODEL), 1.0),
        "mem": nrm(ks[1], (BATCH, N_MEM, D_MODEL), 1.0),
        "rel_bias_table": nrm(ks[2], (REL_BUCKETS, ATTN_HEADS), 0.5),
        "norm_mix_g": gain(ks[3], (L, D_MODEL)),
        "w_in": nrm(ks[4], (L, D_MODEL, D_IN), D_MODEL ** -0.5),
        "attn_q_norm_g": gain(ks[5], (L, ATTN_HEAD_DIM)),
        "attn_k_norm_g": gain(ks[6], (L, ATTN_HEAD_DIM)),
        "attn_sink": nrm(ks[7], (L, ATTN_HEADS), 1.0),
        "dn_conv_w": nrm(ks[8], (L, DN_CONV, 2 * DN_QK + DN_V), DN_CONV ** -0.5),
        "dn_a_log": jnp.log(jax.random.uniform(ks[10], (L, 2, DN_HEADS), f32, 1.0, 16.0)),
        "dn_dt_bias": dt + jnp.log(-jnp.expm1(-dt)),
        "dn_out_norm_g": gain(ks[11], (L, DN_VALUE_DIM)),
        "mem_norm_g": gain(ks[12], (L, D_MODEL)),
        "mem_w_kv": nrm(ks[13], (L, D_MODEL, 2 * MEM_Q), D_MODEL ** -0.5),
        "mem_q_norm_g": gain(ks[14], (L, MEM_HEAD_DIM)),
        "mem_k_norm_g": gain(ks[15], (L, MEM_HEAD_DIM)),
        "w_br_attn": nrm(ks[16], (L, ATTN_Q, D_MODEL), ATTN_Q ** -0.5),
        "w_br_dn": nrm(ks[17], (L, DN_V, D_MODEL), DN_V ** -0.5),
        "w_br_mem": nrm(ks[18], (L, MEM_Q, D_MODEL), MEM_Q ** -0.5),
        "w_out": nrm(ks[19], (L, D_MODEL, D_MODEL), D_MODEL ** -0.5),
        "norm_ffn_g": gain(ks[20], (L, D_MODEL)),
        "ffn_w_up": nrm(ks[21], (L, D_MODEL, 2 * D_FF), D_MODEL ** -0.5),
        "ffn_conv_w": nrm(ks[22], (L, FFN_CONV, 2 * D_FF), FFN_CONV ** -0.5),
        "ffn_conv_b": nrm(ks[23], (L, 2 * D_FF), 0.01),
        "ffn_w_down": nrm(ks[24], (L, D_FF, D_MODEL), D_FF ** -0.5),
    }


def reference(x, mem, rel_bias_table, norm_mix_g, w_in, attn_q_norm_g, attn_k_norm_g, attn_sink,
              dn_conv_w, dn_a_log, dn_dt_bias, dn_out_norm_g, mem_norm_g, mem_w_kv, mem_q_norm_g,
              mem_k_norm_g, w_br_attn, w_br_dn, w_br_mem, w_out, norm_ffn_g, ffn_w_up, ffn_conv_w,
              ffn_conv_b, ffn_w_down):
    B, S, _ = x.shape
    for l in range(DEPTH):
        h = rmsnorm(x, norm_mix_g[l])
        aq, ak, av, dq, dk, dv, dz, db, da, mq, gates = _split(h @ w_in[l], IN_SPLITS)
        y_attn = windowed_gqa(
            rmsnorm(aq.reshape(B, S, ATTN_HEADS, ATTN_HEAD_DIM), attn_q_norm_g[l]),
            rmsnorm(ak.reshape(B, S, ATTN_KV_HEADS, ATTN_HEAD_DIM), attn_k_norm_g[l]),
            av.reshape(B, S, ATTN_KV_HEADS, ATTN_HEAD_DIM),
            attn_sink[l], rel_bias_table)
        y_dn = deltanet_branch(dq, dk, dv, dz, db, da, dn_conv_w[l], dn_a_log[l], dn_dt_bias[l], dn_out_norm_g[l])
        y_mem = memory_cross_attention(mq, rmsnorm(mem, mem_norm_g[l]), mem_w_kv[l], mem_q_norm_g[l], mem_k_norm_g[l])
        g_attn, g_dn, g_mem = jnp.split(jax.nn.sigmoid(gates), N_BRANCH, axis=-1)
        merged = (g_attn * (y_attn @ w_br_attn[l]) + g_dn * (y_dn @ w_br_dn[l])
                  + g_mem * (y_mem @ w_br_mem[l]))
        x = x + merged @ w_out[l]
        h = rmsnorm(x, norm_ffn_g[l])
        u = dwconv_centred(h @ ffn_w_up[l], ffn_conv_w[l]) + ffn_conv_b[l]
        u_gate, u_val = jnp.split(u, 2, axis=-1)
        x = x + (jax.nn.silu(u_gate) * u_val) @ ffn_w_down[l]
    return x
```

```cpp
#include <hip/hip_runtime.h>
#include <cstdio>
#include <cstdint>
#include <cmath>
namespace pg8 {
#define PG8_LAS __attribute__((address_space(3)))
typedef unsigned short bf16_t;
typedef short bf16x8 __attribute__((ext_vector_type(8)));
typedef float f32x4 __attribute__((ext_vector_type(4)));
typedef unsigned u32x4 __attribute__((ext_vector_type(4)));
constexpr int BM = 256, BK = 64, HALF = 128, HTB = HALF * BK * 2  , STAGE_BYTES = 8 * HTB, NXCD = 8, WGM = 8;

__host__ __device__ __forceinline__ int lds_byte(int r, int c) { const int st = (r >> 4) * 2 + (c >> 5), rr = r & 15, cc = c & 31, ob = rr * 64 + cc * 2; return st * 1024 + (ob ^ (((ob >> 9) & 1) << 5)); }
__host__ __device__ __forceinline__ void stage_rc(int b, int& R, int& C) { const int st = b / 1024, sb = b % 1024, swz = sb ^ (((sb >> 9) & 1) << 5); R = (st >> 1) * 16 + swz / 64; C = (st & 1) * 32 + (swz % 64) / 2; }
__host__ __device__ __forceinline__ int perm32(int rho) { const int n = rho >> 4, i = rho & 15; return 8 * (i >> 2) + 4 * n + (i & 3); }

struct Unit { int pm, pn; };
struct Gemm { const bf16_t* A; const bf16_t* Bt; int M, N, K, lda, ldb; };

struct StaticOrder {
    int nM, nN, nwg, G, c;
    __host__ __device__ void init(int M, int N, int G_, int c_) { nM = M / BM; nN = N / BM; nwg = nM * nN; G = G_; c = c_; }
    __host__ __device__ bool next(int i, Unit& u) const {
        const long L = (long)i * G + c; if (L >= nwg) return false;
        int wgid = (int)L; { const int q = nwg / NXCD, r = nwg % NXCD, xcd = wgid % NXCD, off = wgid / NXCD; wgid = (xcd < r ? xcd * (q + 1) : r * (q + 1) + (xcd - r) * q) + off; }
        const int nig = WGM * nN, gid = wgid / nig, fm = gid * WGM, gsz = (nM - fm) < WGM ? (nM - fm) : WGM;
        u.pm = fm + ((wgid % nig) % gsz); u.pn = (wgid % nig) / gsz; return true;
    }
    __device__ __forceinline__ void a_ready(const Unit&) const {}
    __device__ __forceinline__ void done(const Unit&) const {}
};

template <class Epi, class Sched, bool ALIGN_EPI = false, bool SP2 = false>
__device__ __forceinline__ void gemm_phase(PG8_LAS unsigned char* lds, const Gemm g, const Sched& S, const Epi& E) {
    const int tid = threadIdx.x, wid = __builtin_amdgcn_readfirstlane(tid >> 6), lane = tid & 63, wr = wid >> 2, wc = wid & 3, fr = lane & 15, fq = lane >> 4;
    const int K = g.K, nt = K / BK;
    unsigned voffA[2], voffB[2];
#pragma unroll
    for (int i = 0; i < 2; ++i) { int R, C; stage_rc(tid * 16 + i * 8192, R, C); const int Rb = Epi::PERM ? ((R & ~31) + perm32(R & 31)) : R;
        voffA[i] = (unsigned)(R * g.lda + C) * 2u; voffB[i] = (unsigned)(Rb * g.ldb + C) * 2u; }
    const size_t kstep = (size_t)(BK * 2);
    const size_t hstepA = (size_t)HALF * g.lda * 2, hstepB = (size_t)HALF * g.ldb * 2;
    const size_t tstepA = 2 * hstepA, tstepB = 2 * hstepB;
    const unsigned ldsw = (unsigned)wid * 1024u;
    const int aoff = lds_byte(wr * 64 + fr, fq * 8), boff = lds_byte(wc * 32 + fr, fq * 8);
#define PG8_SA(b, h) (((b) * 2 + (h)) * HTB)
#define PG8_SB(b, h) ((4 + (b) * 2 + (h)) * HTB)
#define PG8_STAGE(bufoff, gbase, voff) do { _Pragma("unroll") for (int _i = 0; _i < 2; ++_i) \
        __builtin_amdgcn_global_load_lds((const unsigned*)((const char*)(gbase) + (voff)[_i]), (PG8_LAS unsigned*)(lds + (bufoff) + ldsw + _i * 8192), 16, 0, 0); } while (0)
#define PG8_LDA(dst, b, h) do { _Pragma("unroll") for (int m = 0; m < 4; ++m) _Pragma("unroll") for (int k = 0; k < 2; ++k) dst[m][k] = *(const PG8_LAS bf16x8*)(lds + PG8_SA(b, h) + aoff + m * 2048 + k * 1024); } while (0)
#define PG8_LDB(dst, b, h) do { _Pragma("unroll") for (int n = 0; n < 2; ++n) _Pragma("unroll") for (int k = 0; k < 2; ++k) dst[n][k] = *(const PG8_LAS bf16x8*)(lds + PG8_SB(b, h) + boff + n * 2048 + k * 1024); } while (0)
#define PG8_MMA(ai, bj, At, Bt) do { __builtin_amdgcn_s_setprio(1); _Pragma("unroll") for (int m = 0; m < 4; ++m) _Pragma("unroll") for (int n = 0; n < 2; ++n) _Pragma("unroll") for (int k = 0; k < 2; ++k) \
        acc[ai][bj][m][n] = __builtin_amdgcn_mfma_f32_16x16x32_bf16(Bt[n][k], At[m][k], acc[ai][bj][m][n], 0, 0, 0); __builtin_amdgcn_s_setprio(0); } while (0)
#define PG8_WAIT_V(n) asm volatile("s_waitcnt vmcnt(" #n ")" ::: "memory")
#define PG8_WAIT_L(n) asm volatile("s_waitcnt lgkmcnt(" #n ")" ::: "memory")
#define PG8_BAR __builtin_amdgcn_s_barrier()
#define PG8_SCHED __builtin_amdgcn_sched_barrier(0)
    Unit cur, nxt; int ui = 0;
    if (!S.next(0, cur)) return;
    f32x4 acc[2][2][4][2];
#pragma unroll
    for (int a = 0; a < 2; ++a)
#pragma unroll
        for (int b = 0; b < 2; ++b)
#pragma unroll
            for (int m = 0; m < 4; ++m)
#pragma unroll
                for (int n = 0; n < 2; ++n) acc[a][b][m][n] = (f32x4){0.f, 0.f, 0.f, 0.f};
    bf16x8 At[4][2], B0[2][2], B1[2][2];
    const char* cA = (const char*)g.A + (size_t)cur.pm * tstepA; const char* cB = (const char*)g.Bt + (size_t)cur.pn * tstepB;
    S.a_ready(cur);
    if constexpr (SP2) {
        PG8_STAGE(PG8_SB(0, 0), cB, voffB); PG8_STAGE(PG8_SB(0, 1), cB + hstepB, voffB); PG8_STAGE(PG8_SA(0, 0), cA, voffA); PG8_STAGE(PG8_SA(0, 1), cA + hstepA, voffA);
        if (wr == 1) PG8_BAR;
        PG8_WAIT_V(2); PG8_BAR;
        PG8_STAGE(PG8_SB(1, 0), cB + kstep, voffB); PG8_STAGE(PG8_SA(1, 0), cA + kstep, voffA); PG8_STAGE(PG8_SB(1, 1), cB + hstepB + kstep, voffB);
        PG8_WAIT_V(6); PG8_BAR;
    } else {
        PG8_STAGE(PG8_SB(0, 0), cB, voffB); PG8_STAGE(PG8_SA(0, 0), cA, voffA); PG8_STAGE(PG8_SB(0, 1), cB + hstepB, voffB); PG8_STAGE(PG8_SA(0, 1), cA + hstepA, voffA);
        if (wr == 1) PG8_BAR;
        PG8_WAIT_V(4); PG8_BAR;
        PG8_STAGE(PG8_SB(1, 0), cB + kstep, voffB); PG8_STAGE(PG8_SA(1, 0), cA + kstep, voffA); PG8_STAGE(PG8_SB(1, 1), cB + hstepB + kstep, voffB);
        PG8_WAIT_V(6); PG8_BAR;
    }
    for (;;) {
        const bool has_next = S.next(ui + 1, nxt);
        const char* nA = has_next ? (const char*)g.A + (size_t)nxt.pm * tstepA : cA; const char* nB = has_next ? (const char*)g.Bt + (size_t)nxt.pn * tstepB : cB;
        for (int t = 0; t < nt; t += 2) {
            const bool last = (t == nt - 2);
            const char* a1 = cA + (size_t)(t + 1) * kstep;
            const char* a2 = last ? nA : cA + (size_t)(t + 2) * kstep; const char* b2 = last ? nB : cB + (size_t)(t + 2) * kstep;
            const char* a3 = a2 + kstep; const char* b3 = b2 + kstep;
            if (last && has_next) S.a_ready(nxt);
            if constexpr (SP2) {
            PG8_LDB(B0, 0, 0); PG8_LDB(B1, 0, 1); PG8_SCHED; PG8_LDA(At, 0, 0); PG8_STAGE(PG8_SA(1, 1), a1 + hstepA, voffA);
            PG8_WAIT_V(8); PG8_WAIT_L(0); PG8_BAR; PG8_MMA(0, 0, At, B0); PG8_MMA(0, 1, At, B1); PG8_BAR; PG8_SCHED;
            PG8_LDA(At, 0, 1); PG8_STAGE(PG8_SB(0, 0), b2, voffB); PG8_STAGE(PG8_SB(0, 1), b2 + hstepB, voffB); PG8_STAGE(PG8_SA(0, 0), a2, voffA);
            PG8_WAIT_V(8); PG8_WAIT_L(0); PG8_BAR; PG8_MMA(1, 0, At, B0); PG8_MMA(1, 1, At, B1); PG8_BAR; PG8_SCHED;
            PG8_LDB(B0, 1, 0); PG8_LDB(B1, 1, 1); PG8_SCHED; PG8_LDA(At, 1, 0); PG8_STAGE(PG8_SA(0, 1), a2 + hstepA, voffA);
            PG8_WAIT_V(8); PG8_WAIT_L(0); PG8_BAR; PG8_MMA(0, 0, At, B0); PG8_MMA(0, 1, At, B1); PG8_BAR; PG8_SCHED;
            PG8_LDA(At, 1, 1); PG8_STAGE(PG8_SB(1, 0), b3, voffB); PG8_STAGE(PG8_SB(1, 1), b3 + hstepB, voffB); PG8_STAGE(PG8_SA(1, 0), a3, voffA);
            PG8_WAIT_V(8); PG8_WAIT_L(0); PG8_BAR; PG8_MMA(1, 0, At, B0); PG8_MMA(1, 1, At, B1); PG8_BAR; PG8_SCHED;
            } else {
            PG8_LDB(B0, 0, 0); PG8_SCHED; PG8_LDA(At, 0, 0); PG8_STAGE(PG8_SA(1, 1), a1 + hstepA, voffA);
            PG8_WAIT_L(8); PG8_BAR; PG8_WAIT_L(0); PG8_MMA(0, 0, At, B0); PG8_BAR; PG8_SCHED;
            PG8_LDB(B1, 0, 1); PG8_STAGE(PG8_SB(0, 0), b2, voffB);
            PG8_BAR; PG8_WAIT_L(0); PG8_MMA(0, 1, At, B1); PG8_BAR;
            PG8_LDA(At, 0, 1); PG8_STAGE(PG8_SA(0, 0), a2, voffA);
            PG8_BAR; PG8_WAIT_L(0); PG8_MMA(1, 0, At, B0); PG8_BAR; PG8_SCHED;
            PG8_STAGE(PG8_SB(0, 1), b2 + hstepB, voffB);
            PG8_WAIT_V(6); PG8_BAR; PG8_MMA(1, 1, At, B1); PG8_BAR;
            PG8_LDB(B0, 1, 0); PG8_SCHED; PG8_LDA(At, 1, 0); PG8_STAGE(PG8_SA(0, 1), a2 + hstepA, voffA);
            PG8_WAIT_L(8); PG8_BAR; PG8_WAIT_L(0); PG8_MMA(0, 0, At, B0); PG8_BAR; PG8_SCHED;
            PG8_LDB(B1, 1, 1); PG8_STAGE(PG8_SB(1, 0), b3, voffB);
            PG8_BAR; PG8_WAIT_L(0); PG8_MMA(0, 1, At, B1); PG8_BAR;
            PG8_LDA(At, 1, 1); PG8_STAGE(PG8_SA(1, 0), a3, voffA);
            PG8_BAR; PG8_WAIT_L(0); PG8_MMA(1, 0, At, B0); PG8_BAR; PG8_SCHED;
            PG8_STAGE(PG8_SB(1, 1), b3 + hstepB, voffB);
            PG8_WAIT_V(6); PG8_BAR; PG8_MMA(1, 1, At, B1); PG8_BAR;
            }
        }
        if constexpr (ALIGN_EPI) { if (wr == 0) PG8_BAR; }
        if constexpr (!Epi::AFTER_DRAIN) { E(acc, cur, wr, wc, fr, fq); S.done(cur); }
        if (!has_next) break;
#pragma unroll
        for (int a = 0; a < 2; ++a)
#pragma unroll
            for (int b = 0; b < 2; ++b)
#pragma unroll
                for (int m = 0; m < 4; ++m)
#pragma unroll
                    for (int n = 0; n < 2; ++n) acc[a][b][m][n] = (f32x4){0.f, 0.f, 0.f, 0.f};
        cur = nxt; cA = nA; cB = nB; ++ui;
        if constexpr (ALIGN_EPI) { if (wr == 1) PG8_BAR; }
    }
    PG8_WAIT_V(0);
    if constexpr (!ALIGN_EPI) { if (wr == 0) PG8_BAR; }
    PG8_BAR;
    if constexpr (Epi::AFTER_DRAIN) { E.fused(acc, cur, wr, wc, fr, fq, lds, wid, lane); S.done(cur); }
#undef PG8_SA
#undef PG8_SB
#undef PG8_STAGE
#undef PG8_LDA
#undef PG8_LDB
#undef PG8_MMA
#undef PG8_WAIT_V
#undef PG8_WAIT_L
#undef PG8_BAR
#undef PG8_SCHED
}
}

#define LAS __attribute__((address_space(3)))
#define GAS __attribute__((address_space(1)))
typedef unsigned short bf16;
typedef short bf16x8 __attribute__((ext_vector_type(8)));
typedef short s16x4 __attribute__((ext_vector_type(4)));
typedef float f32x4 __attribute__((ext_vector_type(4)));
typedef float f32x16 __attribute__((ext_vector_type(16)));
typedef unsigned u32x4 __attribute__((ext_vector_type(4)));
typedef unsigned u32x2 __attribute__((ext_vector_type(2)));
typedef float f32x2_t __attribute__((ext_vector_type(2)));
typedef __bf16 bf16x2_t __attribute__((ext_vector_type(2)));

constexpr int BATCH = 4, SEQ = 8192, DM = 1024, M = BATCH * SEQ;
constexpr int NMEM = 256;
constexpr int PLD = 6400;
constexpr int C_AQ = 0, C_AK = 512, C_AV = 640, C_DQ = 768, C_DK = 1280, C_DV = 1792, C_DZ = 2304, C_MQ = 2816, C_GATE = 3328;
constexpr int C_MG = 768, C_X1B = 1792, C_ACT = 2816;
constexpr int NIN = 6656;
constexpr int DFF = 2816, NUP = 5632;
constexpr float EPS = 1e-6f;
constexpr float LOG2E = 1.4426950408889634f;

__device__ __forceinline__ float bf_lo(unsigned w) { return __uint_as_float(w << 16); }
__device__ __forceinline__ float bf_hi(unsigned w) { return __uint_as_float(w & 0xffff0000u); }
__device__ __forceinline__ unsigned pk2(float lo, float hi) { f32x2_t v = {lo, hi}; bf16x2_t b = __builtin_convertvector(v, bf16x2_t); return __builtin_bit_cast(unsigned, b); }
__device__ __forceinline__ float fexp2(float x) { return __builtin_amdgcn_exp2f(x); }
__device__ __forceinline__ float frcp(float x) { return __builtin_amdgcn_rcpf(x); }
__device__ __forceinline__ float sigmoidf_(float x) { return frcp(1.0f + fexp2(-x * LOG2E)); }
__device__ __forceinline__ float siluf_(float x) { return x * sigmoidf_(x); }
__device__ __forceinline__ void unpack8(const u32x4 w, float (&v)[8]) {
    v[0] = bf_lo(w.x); v[1] = bf_hi(w.x); v[2] = bf_lo(w.y); v[3] = bf_hi(w.y); v[4] = bf_lo(w.z); v[5] = bf_hi(w.z); v[6] = bf_lo(w.w); v[7] = bf_hi(w.w); }
__device__ __forceinline__ u32x4 pack8(const float (&v)[8]) { u32x4 w; w.x = pk2(v[0], v[1]); w.y = pk2(v[2], v[3]); w.z = pk2(v[4], v[5]); w.w = pk2(v[6], v[7]); return w; }

using pg8::Unit;
constexpr int HALF = pg8::HALF, BM = pg8::BM;

struct EpiInProj {
    static constexpr bool PERM = true, AFTER_DRAIN = false;
    bf16* P; float* BA;
    __device__ __forceinline__ void operator()(const f32x4 (&acc)[2][2][4][2], const Unit& u, int wr, int wc, int fr, int fq) const {
        const int row0 = u.pm * BM + wr * 64 + fr;
        if (u.pn < 25) {
            const int col0 = u.pn * BM + wc * 32 + 8 * fq;
#pragma unroll
            for (int ai = 0; ai < 2; ++ai)
#pragma unroll
                for (int m = 0; m < 4; ++m) { bf16* rowp = P + (size_t)(row0 + ai * HALF + m * 16) * PLD + col0;
#pragma unroll
                    for (int bj = 0; bj < 2; ++bj) { const f32x4 v0 = acc[ai][bj][m][0], v1 = acc[ai][bj][m][1];
                        u32x4 w; w.x = pk2(v0[0], v0[1]); w.y = pk2(v0[2], v0[3]); w.z = pk2(v1[0], v1[1]); w.w = pk2(v1[2], v1[3]);
                        *(u32x4*)(rowp + bj * HALF) = w; } }
        } else if (wc == 0) {
#pragma unroll
            for (int ai = 0; ai < 2; ++ai)
#pragma unroll
                for (int m = 0; m < 4; ++m) { float* rp = BA + (size_t)(row0 + ai * HALF + m * 16) * 32 + 8 * fq;
                    *(f32x4*)rp = acc[ai][0][m][0]; *(f32x4*)(rp + 4) = acc[ai][0][m][1]; }
        }
    }
};
struct EpiBf16 {
    static constexpr bool PERM = true, AFTER_DRAIN = false;
    bf16* O; int ldc;
    __device__ __forceinline__ void operator()(const f32x4 (&acc)[2][2][4][2], const Unit& u, int wr, int wc, int fr, int fq) const {
        const int row0 = u.pm * BM + wr * 64 + fr, col0 = u.pn * BM + wc * 32 + 8 * fq;
#pragma unroll
        for (int ai = 0; ai < 2; ++ai)
#pragma unroll
            for (int m = 0; m < 4; ++m) { bf16* rowp = O + (size_t)(row0 + ai * HALF + m * 16) * ldc + col0;
#pragma unroll
                for (int bj = 0; bj < 2; ++bj) { const f32x4 v0 = acc[ai][bj][m][0], v1 = acc[ai][bj][m][1];
                    u32x4 w; w.x = pk2(v0[0], v0[1]); w.y = pk2(v0[2], v0[3]); w.z = pk2(v1[0], v1[1]); w.w = pk2(v1[2], v1[3]);
                    *(u32x4*)(rowp + bj * HALF) = w; } }
    }
};
template <int PASS> struct EpiBranch {
    static constexpr bool PERM = true, AFTER_DRAIN = false;
    bf16* P;
    __device__ __forceinline__ void operator()(const f32x4 (&acc)[2][2][4][2], const Unit& u, int wr, int wc, int fr, int fq) const {
        const int row0 = u.pm * BM + wr * 64 + fr, col0 = u.pn * BM + wc * 32 + 8 * fq;
#pragma unroll
        for (int ai = 0; ai < 2; ++ai)
#pragma unroll
            for (int m = 0; m < 4; ++m) { bf16* rowp = P + (size_t)(row0 + ai * HALF + m * 16) * PLD;
#pragma unroll
                for (int bj = 0; bj < 2; ++bj) {
                    const int c = col0 + bj * HALF;
                    const u32x4 gw = *(const u32x4*)(rowp + C_GATE + 1024 * PASS + c);
                    float g[8]; unpack8(gw, g);
                    float pv[8];
                    if (PASS > 0) { const u32x4 mw = *(const u32x4*)(rowp + C_MG + c); unpack8(mw, pv); }
                    else {
#pragma unroll
                        for (int i = 0; i < 8; ++i) pv[i] = 0.f; }
                    const f32x4 v0 = acc[ai][bj][m][0], v1 = acc[ai][bj][m][1];
                    float o[8];
#pragma unroll
                    for (int i = 0; i < 4; ++i) { o[i] = pv[i] + sigmoidf_(g[i]) * v0[i]; o[4 + i] = pv[4 + i] + sigmoidf_(g[4 + i]) * v1[i]; }
                    *(u32x4*)(rowp + C_MG + c) = pack8(o); } }
    }
};
struct EpiWout {
    static constexpr bool PERM = true, AFTER_DRAIN = false;
    const float* x; float* out; bf16* P; float* SSQ;
    __device__ __forceinline__ void operator()(const f32x4 (&acc)[2][2][4][2], const Unit& u, int wr, int wc, int fr, int fq) const {
        const int row0 = u.pm * BM + wr * 64 + fr, col0 = u.pn * BM + wc * 32 + 8 * fq;
#pragma unroll
        for (int ai = 0; ai < 2; ++ai)
#pragma unroll
            for (int m = 0; m < 4; ++m) { const int row = row0 + ai * HALF + m * 16; float ss = 0.f;
#pragma unroll
                for (int bj = 0; bj < 2; ++bj) { const int c = col0 + bj * HALF; const size_t off = (size_t)row * DM + c;
                    const f32x4 a0 = *(const f32x4*)(x + off), a1 = *(const f32x4*)(x + off + 4);
                    const f32x4 r0 = a0 + acc[ai][bj][m][0], r1 = a1 + acc[ai][bj][m][1];
                    *(f32x4*)(out + off) = r0; *(f32x4*)(out + off + 4) = r1;
                    ss += (r0[0] * r0[0] + r0[1] * r0[1]) + (r0[2] * r0[2] + r0[3] * r0[3]) + (r1[0] * r1[0] + r1[1] * r1[1]) + (r1[2] * r1[2] + r1[3] * r1[3]);
                    u32x4 w; w.x = pk2(r0[0], r0[1]); w.y = pk2(r0[2], r0[3]); w.z = pk2(r1[0], r1[1]); w.w = pk2(r1[2], r1[3]);
                    *(u32x4*)(P + (size_t)row * PLD + C_X1B + c) = w; }
                ss += __shfl_xor(ss, 16); ss += __shfl_xor(ss, 32);
                if (fq == 0) SSQ[(size_t)row * 16 + u.pn * 4 + wc] = ss; }
    }
};
struct EpiUp {
    static constexpr bool PERM = true, AFTER_DRAIN = false;
    const float* SSQ; const float* cw; const float* cb; bf16* P; float* UE;
    __device__ __forceinline__ void operator()(const f32x4 (&acc)[2][2][4][2], const Unit& u, int wr, int wc, int fr, int fq) const {
        const int lane = fq * 16 + fr;
        const int row0 = u.pm * BM + wr * 64 + fr;
        float rs[2][4];
#pragma unroll
        for (int ai = 0; ai < 2; ++ai)
#pragma unroll
            for (int m = 0; m < 4; ++m) { const float* sp = SSQ + (size_t)(row0 + ai * HALF + m * 16) * 16;
                const f32x4 a = *(const f32x4*)sp, b = *(const f32x4*)(sp + 4), c = *(const f32x4*)(sp + 8), d = *(const f32x4*)(sp + 12);
                const float s = ((a[0] + a[1]) + (a[2] + a[3])) + ((b[0] + b[1]) + (b[2] + b[3])) + ((c[0] + c[1]) + (c[2] + c[3])) + ((d[0] + d[1]) + (d[2] + d[3]));
                rs[ai][m] = __builtin_amdgcn_rsqf(s * (1.0f / DM) + EPS); asm volatile("" : "+v"(rs[ai][m]) :: "memory"); }
        const int src_prev = (fr == 0) ? lane + 15 : lane - 1, src_next = (fr == 15) ? lane - 15 : lane + 1;
#pragma unroll
        for (int n = 0; n < 2; ++n) {
            const int a0 = u.pn * 128 + wc * 32 + 8 * fq + 4 * n;
            const f32x4 wg0 = *(const f32x4*)(cw + a0), wg1 = *(const f32x4*)(cw + NUP + a0), wg2 = *(const f32x4*)(cw + 2 * NUP + a0), bg = *(const f32x4*)(cb + a0);
            const f32x4 wv0 = *(const f32x4*)(cw + DFF + a0), wv1 = *(const f32x4*)(cw + NUP + DFF + a0), wv2 = *(const f32x4*)(cw + 2 * NUP + DFF + a0), bv = *(const f32x4*)(cb + DFF + a0);
#pragma unroll
            for (int ai = 0; ai < 2; ++ai) {
                f32x4 ug[4], uv[4];
#pragma unroll
                for (int m = 0; m < 4; ++m) { ug[m] = acc[ai][0][m][n] * rs[ai][m]; uv[m] = acc[ai][1][m][n] * rs[ai][m]; }
                const int g64 = u.pm * 4 + ai * 2 + wr;
#pragma unroll
                for (int m = 0; m < 4; ++m) {
                    f32x4 pg, ng, pvv, nv;
#pragma unroll
                    for (int i = 0; i < 4; ++i) {
                        const float tpg = (fr == 15) ? ug[(m + 3) & 3][i] : ug[m][i];
                        const float tng = (fr == 0) ? ug[(m + 1) & 3][i] : ug[m][i];
                        const float tpv = (fr == 15) ? uv[(m + 3) & 3][i] : uv[m][i];
                        const float tnv = (fr == 0) ? uv[(m + 1) & 3][i] : uv[m][i];
                        pg[i] = __shfl(tpg, src_prev); ng[i] = __shfl(tng, src_next); pvv[i] = __shfl(tpv, src_prev); nv[i] = __shfl(tnv, src_next); }
                    const f32x4 gate = wg0 * pg + wg1 * ug[m] + wg2 * ng + bg;
                    const f32x4 val = wv0 * pvv + wv1 * uv[m] + wv2 * nv + bv;
                    const int row = row0 + ai * HALF + m * 16;
                    const bool edge = (m == 0 && fr == 0) || (m == 3 && fr == 15);
                    if (!edge) { u32x2 w; w.x = pk2(siluf_(gate[0]) * val[0], siluf_(gate[1]) * val[1]); w.y = pk2(siluf_(gate[2]) * val[2], siluf_(gate[3]) * val[3]);
                        *(u32x2*)(P + (size_t)row * PLD + C_ACT + a0) = w; }
                    if ((m == 0 && fr < 2) || (m == 3 && fr >= 14)) { const int slot = (m == 0) ? fr : fr - 12;
                        float* ue = UE + ((size_t)g64 * 4 + slot) * NUP;
                        *(f32x4*)(ue + a0) = ug[m]; *(f32x4*)(ue + DFF + a0) = uv[m]; }
                }
                asm volatile("" ::: "memory");
            }
        }
    }
};
struct EpiDown {
    static constexpr bool PERM = true, AFTER_DRAIN = false;
    float* out;
    __device__ __forceinline__ void operator()(const f32x4 (&acc)[2][2][4][2], const Unit& u, int wr, int wc, int fr, int fq) const {
        const int row0 = u.pm * BM + wr * 64 + fr, col0 = u.pn * BM + wc * 32 + 8 * fq;
#pragma unroll
        for (int ai = 0; ai < 2; ++ai)
#pragma unroll
            for (int m = 0; m < 4; ++m) {
#pragma unroll
                for (int bj = 0; bj < 2; ++bj) { const size_t off = (size_t)(row0 + ai * HALF + m * 16) * DM + col0 + bj * HALF;
                    const f32x4 a0 = *(const f32x4*)(out + off), a1 = *(const f32x4*)(out + off + 4);
                    *(f32x4*)(out + off) = a0 + acc[ai][bj][m][0]; *(f32x4*)(out + off + 4) = a1 + acc[ai][bj][m][1]; } }
    }
};

template <int DH, int RSK, int RSV, bool BIAS>
__device__ __forceinline__ void attn_tile(const LAS unsigned char* Kl, const LAS unsigned char* Vl, int jk, const bf16x8 (&qf)[DH / 16], const float* biasrow,
                                          float& m, float& l, f32x16 (&o)[DH / 32], int lane) {
    const int r32 = lane & 31, hi = lane >> 5;
    f32x16 s0, s1;
    if (BIAS) {
#pragma unroll
        for (int g4 = 0; g4 < 4; ++g4) { const f32x4 c0 = *(const f32x4*)(biasrow + 8 * g4 + 4 * hi), c1 = *(const f32x4*)(biasrow + 32 + 8 * g4 + 4 * hi);
#pragma unroll
            for (int i = 0; i < 4; ++i) { s0[4 * g4 + i] = c0[i]; s1[4 * g4 + i] = c1[i]; } }
    } else {
#pragma unroll
        for (int r = 0; r < 16; ++r) { s0[r] = 0.f; s1[r] = 0.f; }
    }
    const LAS unsigned char* kp = Kl + (size_t)(jk + r32) * RSK + 16 * hi;
#pragma unroll
    for (int ks = 0; ks < DH / 16; ++ks) {
        const bf16x8 k0 = *(const LAS bf16x8*)(kp + 32 * ks), k1 = *(const LAS bf16x8*)(kp + 32 * RSK + 32 * ks);
        s0 = __builtin_amdgcn_mfma_f32_32x32x16_bf16(k0, qf[ks], s0, 0, 0, 0);
        s1 = __builtin_amdgcn_mfma_f32_32x32x16_bf16(k1, qf[ks], s1, 0, 0, 0);
    }
    float mx = fmaxf(s0[0], s1[0]);
#pragma unroll
    for (int r = 1; r < 16; ++r) mx = fmaxf(mx, fmaxf(s0[r], s1[r]));
    mx = fmaxf(mx, __shfl_xor(mx, 32));
    const float mn = fmaxf(m, mx), f = fexp2(m - mn);
    m = mn; l *= f;
#pragma unroll
    for (int db = 0; db < DH / 32; ++db)
#pragma unroll
        for (int r = 0; r < 16; ++r) o[db][r] *= f;
    float ps = 0.f;
#pragma unroll
    for (int r = 0; r < 16; ++r) { s0[r] = fexp2(s0[r] - mn); s1[r] = fexp2(s1[r] - mn); ps += s0[r] + s1[r]; }
    l += ps;
    bf16x8 pf[4];
    { u32x4 w;
      w.x = pk2(s0[0], s0[1]); w.y = pk2(s0[2], s0[3]); w.z = pk2(s0[4], s0[5]); w.w = pk2(s0[6], s0[7]); pf[0] = __builtin_bit_cast(bf16x8, w);
      w.x = pk2(s0[8], s0[9]); w.y = pk2(s0[10], s0[11]); w.z = pk2(s0[12], s0[13]); w.w = pk2(s0[14], s0[15]); pf[1] = __builtin_bit_cast(bf16x8, w);
      w.x = pk2(s1[0], s1[1]); w.y = pk2(s1[2], s1[3]); w.z = pk2(s1[4], s1[5]); w.w = pk2(s1[6], s1[7]); pf[2] = __builtin_bit_cast(bf16x8, w);
      w.x = pk2(s1[8], s1[9]); w.y = pk2(s1[10], s1[11]); w.z = pk2(s1[12], s1[13]); w.w = pk2(s1[14], s1[15]); pf[3] = __builtin_bit_cast(bf16x8, w); }
    const int g = lane >> 4, q4 = (lane & 15) >> 2, p = lane & 3;
    const LAS unsigned char* vp = Vl + (size_t)(jk + 4 * hi + q4) * RSV + (16 * (g & 1) + 4 * p) * 2;
#pragma unroll
    for (int db = 0; db < DH / 32; ++db)
#pragma unroll
        for (int kk = 0; kk < 4; ++kk) {
            const s16x4 lo = __builtin_bit_cast(s16x4, __builtin_amdgcn_ds_read_tr16_b64_v4i16((LAS s16x4*)(vp + (size_t)(16 * kk) * RSV + 64 * db)));
            const s16x4 h4 = __builtin_bit_cast(s16x4, __builtin_amdgcn_ds_read_tr16_b64_v4i16((LAS s16x4*)(vp + (size_t)(16 * kk + 8) * RSV + 64 * db)));
            const bf16x8 vf = (bf16x8){lo[0], lo[1], lo[2], lo[3], h4[0], h4[1], h4[2], h4[3]};
            o[db] = __builtin_amdgcn_mfma_f32_32x32x16_bf16(vf, pf[kk], o[db], 0, 0, 0);
        }
}
template <int DH>
__device__ __forceinline__ void load_q(const bf16* qrow, const float* gq, float scale, bf16x8 (&qf)[DH / 16], int lane) {
    const int hi = lane >> 5;
    u32x4 w[DH / 16]; float ss = 0.f;
#pragma unroll
    for (int ks = 0; ks < DH / 16; ++ks) { w[ks] = *(const u32x4*)(qrow + 16 * ks + 8 * hi); float v[8]; unpack8(w[ks], v);
#pragma unroll
        for (int j = 0; j < 8; ++j) ss += v[j] * v[j]; }
    ss += __shfl_xor(ss, 32);
    const float rstd = __builtin_amdgcn_rsqf(ss * (1.0f / DH) + EPS) * scale;
#pragma unroll
    for (int ks = 0; ks < DH / 16; ++ks) { float v[8]; unpack8(w[ks], v);
        const f32x4 g0 = *(const f32x4*)(gq + 16 * ks + 8 * hi), g1 = *(const f32x4*)(gq + 16 * ks + 8 * hi + 4);
#pragma unroll
        for (int j = 0; j < 4; ++j) { v[j] *= rstd * g0[j]; v[4 + j] *= rstd * g1[j]; }
        qf[ks] = __builtin_bit_cast(bf16x8, pack8(v)); }
}
template <int DH>
__device__ __forceinline__ void store_o(bf16* yrow, const f32x16 (&o)[DH / 32], float l, int lane) {
    const int hi = lane >> 5;
    const float inv = frcp(l + __shfl_xor(l, 32));
#pragma unroll
    for (int db = 0; db < DH / 32; ++db)
#pragma unroll
        for (int g4 = 0; g4 < 4; ++g4) { u32x2 w; w.x = pk2(o[db][4 * g4] * inv, o[db][4 * g4 + 1] * inv); w.y = pk2(o[db][4 * g4 + 2] * inv, o[db][4 * g4 + 3] * inv);
            *(u32x2*)(yrow + 32 * db + 8 * g4 + 4 * hi) = w; }
}
template <int DH, int RSK, int RSV>
__device__ __forceinline__ void stage_kv(LAS unsigned char* Kl, LAS unsigned char* Vl, int ldsrow0, const bf16* src, size_t pitch, int kcol, int vcol, int nrows, const float* gk, int tid) {
    constexpr int CPR = DH / 8;
    for (int c = tid; c < nrows * CPR; c += 512) {
        const int row = c / CPR, ch = c % CPR;
        const bf16* rp = src + (size_t)row * pitch;
        const u32x4 kw = *(const u32x4*)(rp + kcol + ch * 8), vw = *(const u32x4*)(rp + vcol + ch * 8);
        float v[8]; unpack8(kw, v); float ss = 0.f;
#pragma unroll
        for (int j = 0; j < 8; ++j) ss += v[j] * v[j];
#pragma unroll
        for (int o = 1; o < CPR; o <<= 1) ss += __shfl_xor(ss, o);
        const float rstd = __builtin_amdgcn_rsqf(ss * (1.0f / DH) + EPS);
        const f32x4 g0 = *(const f32x4*)(gk + ch * 8), g1 = *(const f32x4*)(gk + ch * 8 + 4);
#pragma unroll
        for (int j = 0; j < 4; ++j) { v[j] *= rstd * g0[j]; v[4 + j] *= rstd * g1[j]; }
        *(LAS u32x4*)(Kl + (size_t)(ldsrow0 + row) * RSK + ch * 16) = pack8(v);
        *(LAS u32x4*)(Vl + (size_t)(ldsrow0 + row) * RSV + ch * 16) = vw;
    }
}

constexpr int NWAVES = 8;
constexpr size_t MiB = 1u << 20;
constexpr size_t WS_CTL = 0, CTL_ZERO_BYTES = 1 * MiB;
constexpr size_t WS_WIN = 2 * MiB;
constexpr size_t WS_WBR = 15 * MiB;
constexpr size_t WS_WOUT = 18 * MiB;
constexpr size_t WS_WUP = 20 * MiB;
constexpr size_t WS_WDN = 31 * MiB;
constexpr size_t WS_WKV = 37 * MiB;
constexpr size_t WS_MEMN = 39 * MiB;
constexpr size_t WS_KV = 41 * MiB;
constexpr size_t WS_BT = 43 * MiB;
constexpr size_t WS_BA = 45 * MiB;
constexpr size_t WS_SSQ = 49 * MiB;
constexpr size_t WS_P = 52 * MiB;
constexpr size_t WS_UE = 452 * MiB;
constexpr size_t WS_END = 512 * MiB;
static_assert(WS_P + (size_t)M * PLD * 2 == WS_UE && WS_UE + (size_t)512 * 4 * NUP * 4 <= WS_END, "d_ws map");

constexpr int CW_TMO = 0, CW_CODE = 1;
constexpr int CW_BAR = 4096;
constexpr int RING_OFF = 0, RING_BYTES = 131072;
constexpr int LDSCTL_OFF = RING_BYTES, MISC_OFF = LDSCTL_OFF + 320;
constexpr int LDS_BYTES = 147456;

typedef GAS unsigned gu32;
#define RLX_AGENT __ATOMIC_RELAXED, __HIP_MEMORY_SCOPE_AGENT
#define LDS_WAIT() asm volatile("s_waitcnt lgkmcnt(0)" ::: "memory")
#define VM_WAIT() asm volatile("s_waitcnt vmcnt(0)" ::: "memory")

#define XB_TMO      128
#define XB_XCNT(j)  (256  + 64 * (j))
#define XB_XSUB(j)  (1280 + 64 * (j))
#define XB_XGEN(j)  (2304 + 64 * (j))
#define XB_TOP      3328
#define XB_TOPGEN   3392
#define XCD_BAR_WORDS 3456
#define XB_SPIN_CAP (1u << 22)

__device__ __forceinline__ unsigned xb_ld(unsigned* p)              { return __hip_atomic_load(p, __ATOMIC_RELAXED, __HIP_MEMORY_SCOPE_AGENT); }
__device__ __forceinline__ unsigned xb_add(unsigned* p, unsigned v) { return __hip_atomic_fetch_add(p, v, __ATOMIC_RELAXED, __HIP_MEMORY_SCOPE_AGENT); }
__device__ __forceinline__ unsigned xb_xcc_id() { return (unsigned)__builtin_amdgcn_s_getreg((3 << 11) | 20) & 0xFu; }
#define XB_SPIN(cond, bar) do { unsigned _sp = 0; while (cond) { __builtin_amdgcn_s_sleep(1); \
    if ((++_sp & 255u) == 0u) { if (xb_ld(&(bar)[XB_TMO])) break; if (_sp > XB_SPIN_CAP) { atomicAdd(&(bar)[XB_TMO], 1u); break; } } } } while (0)

struct XcdBarrier { unsigned* bar; unsigned x; volatile LAS unsigned* st; };

__device__ __forceinline__ XcdBarrier xcd_barrier_post(unsigned* bar, volatile LAS unsigned* st) {
    XcdBarrier b; b.bar = bar; b.x = xb_xcc_id(); b.st = st;
    if (threadIdx.x == 0) (void)xb_add(&bar[XB_XCNT(b.x)], 1u);
    return b;
}
__device__ __forceinline__ void xcd_barrier_complete(unsigned* bar, unsigned x, unsigned& nloc, unsigned& nx) {
    const unsigned G = gridDim.x * gridDim.y * gridDim.z;
    unsigned sum, cnt, mine, sp = 0u;
    for (;;) {
        sum = 0u; cnt = 0u; mine = 0u;
#pragma unroll
        for (unsigned j = 0; j < 16; ++j) { const unsigned c = xb_ld(&bar[XB_XCNT(j)]); sum += c; cnt += (c > 0u) ? 1u : 0u; mine = (j == x) ? c : mine; }
        if (sum == G) break;
        __builtin_amdgcn_s_sleep(1);
        if ((++sp & 255u) == 0u) { if (xb_ld(&bar[XB_TMO])) break; if (sp > XB_SPIN_CAP) { atomicAdd(&bar[XB_TMO], 1u); break; } }
    }
    nloc = mine > 0u ? mine : 1u; nx = cnt > 0u ? cnt : 1u;
}
__device__ __forceinline__ void xcd_barrier(const XcdBarrier& b) {
    asm volatile("s_waitcnt vmcnt(0)" ::: "memory");
    __syncthreads();
    if (threadIdx.x == 0) {
        unsigned* bar = b.bar;
        __builtin_amdgcn_s_waitcnt(0);
        unsigned nloc = b.st[0], nx = b.st[1];
        if (nloc == 0u) { xcd_barrier_complete(bar, b.x, nloc, nx); b.st[0] = nloc; b.st[1] = nx; }
        const unsigned old = xb_add(&bar[XB_XSUB(b.x)], 1u);
        const unsigned gen = old / nloc;
        if (old + 1u == (gen + 1u) * nloc) {
            __builtin_amdgcn_fence(__ATOMIC_RELEASE, "agent");
            asm volatile("s_waitcnt vmcnt(0)" ::: "memory");
            const unsigned og = xb_add(&bar[XB_TOP], 1u);
            const unsigned tg = og / nx;
            if (og + 1u == (tg + 1u) * nx) xb_add(&bar[XB_TOPGEN], 1u);
            else XB_SPIN(xb_ld(&bar[XB_TOPGEN]) == tg, bar);
            __builtin_amdgcn_fence(__ATOMIC_ACQUIRE, "agent");
            xb_add(&bar[XB_XGEN(b.x)], 1u);
            asm volatile("s_waitcnt vmcnt(0)" ::: "memory");
        } else {
            XB_SPIN(xb_ld(&bar[XB_XGEN(b.x)]) == gen, bar);
            __builtin_amdgcn_fence(__ATOMIC_ACQUIRE, "agent");
            asm volatile("s_waitcnt vmcnt(0)" ::: "memory");
        }
    }
    __syncthreads();
}

struct Frame {
    LAS unsigned char* lds;
    volatile LAS unsigned* MISC;
    gu32* ctl;
    int tid, lane, wave, vcu, G;
};

__device__ __forceinline__ float wave_sum(float v) {
#pragma unroll
    for (int o = 1; o < 64; o <<= 1) v += __shfl_xor(v, o);
    return v;
}
__device__ __forceinline__ int t5_bucket(int rel) {
    const int n = rel < 0 ? -rel : rel;
    const int mag = n < 8 ? n : n < 12 ? 8 : n < 16 ? 9 : n < 23 ? 10 : n < 32 ? 11 : n < 46 ? 12 : n < 64 ? 13 : n < 91 ? 14 : 15;
    return (rel > 0 ? 16 : 0) + mag;
}

__device__ __forceinline__ void transpose_item(const float* W, int K, int N, int k0, int n0, bf16* WT, int drow0, const float* gk, LAS float* scr, int lane) {
#pragma unroll 8
    for (int i = 0; i < 32; ++i) { const int kk = 2 * i + (lane >> 5); float v = W[(size_t)(k0 + kk) * N + n0 + (lane & 31)]; if (gk) v *= gk[k0 + kk]; scr[kk * 33 + (lane & 31)] = v; }
    LDS_WAIT(); asm volatile("" ::: "memory");
    const int c = lane & 7;
#pragma unroll
    for (int j = 0; j < 4; ++j) { const int n = (lane >> 3) + 8 * j; const LAS float* s = scr + (8 * c) * 33 + n;
        u32x4 o; o.x = pk2(s[0 * 33], s[1 * 33]); o.y = pk2(s[2 * 33], s[3 * 33]); o.z = pk2(s[4 * 33], s[5 * 33]); o.w = pk2(s[6 * 33], s[7 * 33]);
        *(GAS u32x4*)(WT + (size_t)(drow0 + n) * K + k0 + 8 * c) = o; }
    LDS_WAIT(); asm volatile("" ::: "memory");
}
__device__ __forceinline__ void rms_row_to_bf16(const float* xrow, const float* g, bf16* orow, int lane) {
    const GAS f32x4* xr = (const GAS f32x4*)xrow + lane;
    const GAS f32x4* gr = (const GAS f32x4*)g + lane;
    f32x4 v[4]; float s = 0.f;
#pragma unroll
    for (int j = 0; j < 4; ++j) { v[j] = xr[64 * j]; s += (v[j].x * v[j].x + v[j].y * v[j].y) + (v[j].z * v[j].z + v[j].w * v[j].w); }
    const float rstd = __builtin_amdgcn_rsqf(wave_sum(s) * (1.f / DM) + EPS);
    GAS unsigned long long* o8 = (GAS unsigned long long*)orow + lane;
#pragma unroll
    for (int j = 0; j < 4; ++j) { const f32x4 gg = gr[64 * j];
        o8[64 * j] = (unsigned long long)pk2(v[j].x * rstd * gg.x, v[j].y * rstd * gg.y) | ((unsigned long long)pk2(v[j].z * rstd * gg.z, v[j].w * rstd * gg.w) << 32); }
}

struct Args { const float* in[25]; float* out; unsigned char* ws; int ph_lo, ph_hi; };

__device__ __forceinline__ void p0_prologue(Frame& F, const Args& a) {
    unsigned char* ws = a.ws;
    LAS float* scr = (LAS float*)(F.lds + RING_OFF + F.wave * 16384);
    const int gw = F.vcu * NWAVES + F.wave, NGW = F.G * NWAVES;
    constexpr int I_IN = 16 * 201, I_BR = 8 * 32, I_OUT = 16 * 32, I_UP = 16 * 176, I_DN = 44 * 32, I_KV = 16 * 32;
    constexpr int NITEMS = I_IN + 3 * I_BR + I_OUT + I_UP + I_DN + I_KV;
    for (int it = gw; it < NITEMS; it += NGW) {
        int r = it;
        if (r < I_IN) { const int kb = r / 201, nb = r % 201, n0 = nb * 32;
            const int d0 = n0 < 2816 ? n0 : (n0 < 2848 ? 6400 + (n0 - 2816) : n0 - 32);
            transpose_item(a.in[4], 1024, 6432, kb * 64, n0, (bf16*)(ws + WS_WIN), d0, nullptr, scr, F.lane); continue; }
        r -= I_IN;
        if (r < 3 * I_BR) { const int br = r / I_BR, q = r % I_BR, kb = q / 32, nb = q % 32;
            transpose_item(a.in[16 + br], 512, 1024, kb * 64, nb * 32, (bf16*)(ws + WS_WBR) + (size_t)br * 1024 * 512, nb * 32, nullptr, scr, F.lane); continue; }
        r -= 3 * I_BR;
        if (r < I_OUT) { const int kb = r / 32, nb = r % 32;
            transpose_item(a.in[19], 1024, 1024, kb * 64, nb * 32, (bf16*)(ws + WS_WOUT), nb * 32, nullptr, scr, F.lane); continue; }
        r -= I_OUT;
        if (r < I_UP) { const int kb = r / 176, nb = r % 176, n0 = nb * 32;
            const int isv = n0 >= DFF, nn = isv ? n0 - DFF : n0, d0 = (nn >> 7) * 256 + isv * 128 + (nn & 127);
            transpose_item(a.in[21], 1024, NUP, kb * 64, n0, (bf16*)(ws + WS_WUP), d0, a.in[20], scr, F.lane); continue; }
        r -= I_UP;
        if (r < I_DN) { const int kb = r / 32, nb = r % 32;
            transpose_item(a.in[24], DFF, 1024, kb * 64, nb * 32, (bf16*)(ws + WS_WDN), nb * 32, nullptr, scr, F.lane); continue; }
        r -= I_DN;
        { const int kb = r / 32, nb = r % 32;
            transpose_item(a.in[13], 1024, 1024, kb * 64, nb * 32, (bf16*)(ws + WS_WKV), nb * 32, nullptr, scr, F.lane); }
    }
    { u32x4* z = (u32x4*)((bf16*)(ws + WS_WIN) + (size_t)6432 * 1024); const int n16 = 224 * 1024 * 2 / 16;
      for (int i = blockIdx.x * 512 + F.tid; i < n16; i += F.G * 512) z[i] = (u32x4){0u, 0u, 0u, 0u}; }
    bf16* H = (bf16*)a.out;
    for (int m = gw; m < M; m += NGW) rms_row_to_bf16(a.in[0] + (size_t)m * DM, a.in[3], H + (size_t)m * DM, F.lane);
    for (int m = gw; m < BATCH * NMEM; m += NGW) rms_row_to_bf16(a.in[1] + (size_t)m * DM, a.in[12], (bf16*)(ws + WS_MEMN) + (size_t)m * DM, F.lane);
    { float* BT = (float*)(ws + WS_BT); const float* tab = a.in[2];
      for (int i = blockIdx.x * 512 + F.tid; i < 8 * 128 * 384; i += F.G * 512) { const int j = i % 384, t = (i / 384) % 128, h = i / (384 * 128);
          const int rel = j - 128 - t; const bool ok = rel >= -128 && rel <= 128;
          BT[i] = ok ? tab[t5_bucket(rel) * 8 + h] * LOG2E : -INFINITY; } }
}

__device__ __forceinline__ void attnA_unit(Frame& F, const Args& a, int b, int n, int kvh) {
    constexpr int RSK = 144, RSV = 128;
    LAS unsigned char* Kl = F.lds; LAS unsigned char* Vl = F.lds + 384 * RSK;
    bf16* P = (bf16*)(a.ws + WS_P);
    const float* BT = (const float*)(a.ws + WS_BT);
    for (int blk = 0; blk < 3; ++blk) { const int pos0 = n * 128 - 128 + blk * 128; if (pos0 < 0 || pos0 >= SEQ) continue;
        stage_kv<64, RSK, RSV>(Kl, Vl, blk * 128, P + (size_t)(b * SEQ + pos0) * PLD, PLD, C_AK + kvh * 64, C_AV + kvh * 64, 128, a.in[6], F.tid); }
    LDS_WAIT(); __syncthreads();
    const int h = kvh * 4 + (F.wave >> 1), r32 = F.lane & 31, hi = F.lane >> 5;
    const float sink = a.in[7][h] * LOG2E;
#pragma unroll 1
    for (int qb = 0; qb < 2; ++qb) {
        const int t0 = (F.wave & 1) * 64 + qb * 32, t = t0 + r32;
        bf16* qrow = P + (size_t)(b * SEQ + n * 128 + t) * PLD + C_AQ + h * 64;
        bf16x8 qf[4]; load_q<64>(qrow, a.in[5], 0.125f * LOG2E, qf, F.lane);
        float m = sink, l = hi == 0 ? 1.f : 0.f; f32x16 o[2];
#pragma unroll
        for (int r = 0; r < 16; ++r) { o[0][r] = 0.f; o[1][r] = 0.f; }
#pragma unroll 1
        for (int kt = 0; kt < 6; ++kt) { const int j0 = 64 * kt, pos0 = n * 128 - 128 + (kt >> 1) * 128;
            if (pos0 < 0 || pos0 >= SEQ) continue;
            if (j0 + 63 < t0 || j0 > t0 + 31 + 256) continue;
            attn_tile<64, RSK, RSV, true>(Kl, Vl, j0, qf, BT + ((size_t)h * 128 + t) * 384 + j0, m, l, o, F.lane); }
        store_o<64>(qrow, o, l, F.lane);
    }
    LDS_WAIT(); __syncthreads();
}
__device__ __forceinline__ void xattn_unit(Frame& F, const Args& a, int b, int tb, int h) {
    constexpr int RSK = 272, RSV = 320;
    LAS unsigned char* Kl = F.lds; LAS unsigned char* Vl = F.lds + 128 * RSK;
    bf16* P = (bf16*)(a.ws + WS_P);
    const bf16* KV = (const bf16*)(a.ws + WS_KV);
    const int r32 = F.lane & 31;
    bf16* qrow = P + (size_t)(b * SEQ + tb * 256 + F.wave * 32 + r32) * PLD + C_MQ + h * 128;
    bf16x8 qf[8]; load_q<128>(qrow, a.in[14], 0.08838834764831845f * LOG2E, qf, F.lane);
    float m = -1e30f, l = 0.f; f32x16 o[4];
#pragma unroll
    for (int db = 0; db < 4; ++db)
#pragma unroll
        for (int r = 0; r < 16; ++r) o[db][r] = 0.f;
#pragma unroll 1
    for (int half = 0; half < 2; ++half) {
        stage_kv<128, RSK, RSV>(Kl, Vl, 0, KV + (size_t)(b * NMEM + half * 128) * 1024, 1024, h * 128, 512 + h * 128, 128, a.in[15], F.tid);
        LDS_WAIT(); __syncthreads();
#pragma unroll 1
        for (int kt = 0; kt < 2; ++kt) attn_tile<128, RSK, RSV, false>(Kl, Vl, 64 * kt, qf, nullptr, m, l, o, F.lane);
        LDS_WAIT(); __syncthreads();
    }
    store_o<128>(qrow, o, l, F.lane);
}

__device__ __forceinline__ void dn_unit_v1(Frame& F, const Args& a, int b, int h, int dir) {
    LAS float* raw = (LAS float*)(F.lds);
    LAS float* qs = (LAS float*)(F.lds + 52224);
    LAS float* ks = (LAS float*)(F.lds + 68608);
    LAS float* vs = (LAS float*)(F.lds + 84992);
    LAS float* ob = (LAS float*)(F.lds + 101376);
    LAS float* red1 = (LAS float*)(F.lds + 117760);
    LAS float* red2 = (LAS float*)(F.lds + 119808);
    LAS float* bg = (LAS float*)(F.lds + 121856);
    const bf16* P = (const bf16*)(a.ws + WS_P);
    const float* BA = (const float*)(a.ws + WS_BA);
    const float* cw = a.in[8];
    float* OD = a.out + (size_t)dir * ((size_t)M * 512);
    const float Ah = expf(a.in[9][dir * 8 + h]), dtb = a.in[10][dir * 8 + h];
    float S[8];
#pragma unroll
    for (int e = 0; e < 8; ++e) S[e] = 0.f;
    const int w = F.wave, lane = F.lane, tid = F.tid;
#pragma unroll 1
    for (int cc = 0; cc < 128; ++cc) {
        const int c = dir == 0 ? cc : 127 - cc, t0 = c * 64;
        for (int e = tid; e < 68 * 24; e += 512) { const int row = e / 24, c8 = e % 24, which = c8 >> 3, t = t0 - 2 + row;
            float v[8];
            if (t >= 0 && t < SEQ) { const int col = (which == 0 ? C_DQ : which == 1 ? C_DK : C_DV) + h * 64 + (c8 & 7) * 8;
                unpack8(*(const u32x4*)(P + (size_t)(b * SEQ + t) * PLD + col), v); }
            else {
#pragma unroll
                for (int j = 0; j < 8; ++j) v[j] = 0.f; }
#pragma unroll
            for (int j = 0; j < 8; ++j) raw[row * 192 + c8 * 8 + j] = v[j]; }
        LDS_WAIT(); __syncthreads();
        for (int e = tid; e < 64 * 192; e += 512) { const int row = e / 192, ch = e % 192, which = ch >> 6, d = ch & 63;
            const int cg = which * 512 + h * 64 + d; float acc = 0.f;
#pragma unroll
            for (int j = 0; j < 5; ++j) acc += raw[(row + j) * 192 + ch] * cw[j * 1536 + cg];
            const float y = siluf_(acc);
            (which == 0 ? qs : which == 1 ? ks : vs)[row * 64 + d] = y; }
        if (tid < 64) { const size_t tok = (size_t)b * SEQ + t0 + tid;
            const float beta = sigmoidf_(BA[tok * 32 + dir * 8 + h]);
            const float xa = BA[tok * 32 + 16 + dir * 8 + h] + dtb;
            const float sp = fmaxf(xa, 0.f) + log1pf(expf(-fabsf(xa)));
            bg[tid * 2] = beta; bg[tid * 2 + 1] = expf(-Ah * sp); }
        LDS_WAIT(); __syncthreads();
        for (int rv = w * 16; rv < w * 16 + 16; ++rv) { LAS float* mat = rv < 64 ? qs : ks; const int row = rv & 63;
            const float xv = mat[row * 64 + lane]; const float ss = wave_sum(xv * xv);
            mat[row * 64 + lane] = xv * __builtin_amdgcn_rsqf(ss + EPS) * (rv < 64 ? 0.125f : 1.0f); }
        LDS_WAIT(); __syncthreads();
#pragma unroll 1
        for (int ii = 0; ii < 64; ++ii) {
            const int i = dir == 0 ? ii : 63 - ii;
            const float beta = bg[i * 2], eg = bg[i * 2 + 1];
            float kk[8], part = 0.f;
#pragma unroll
            for (int e = 0; e < 8; ++e) { kk[e] = ks[i * 64 + 8 * w + e]; part += kk[e] * S[e]; }
            red1[w * 64 + lane] = part;
            LDS_WAIT(); __syncthreads();
            float kS = 0.f;
#pragma unroll
            for (int ww = 0; ww < 8; ++ww) kS += red1[ww * 64 + lane];
            const float vp = beta * (vs[i * 64 + lane] - eg * kS);
            float part2 = 0.f;
#pragma unroll
            for (int e = 0; e < 8; ++e) { S[e] = eg * S[e] + kk[e] * vp; part2 += qs[i * 64 + 8 * w + e] * S[e]; }
            red2[w * 64 + lane] = part2;
            LDS_WAIT(); __syncthreads();
            if (w == (ii & 7)) { float os = 0.f;
#pragma unroll
                for (int ww = 0; ww < 8; ++ww) os += red2[ww * 64 + lane];
                ob[i * 64 + lane] = os; }
        }
        LDS_WAIT(); __syncthreads();
        { const int e = tid * 8, row = e >> 6, d0 = e & 63; float* op = OD + ((size_t)b * SEQ + t0 + row) * 512 + h * 64 + d0;
          f32x4 x0, x1;
#pragma unroll
          for (int j = 0; j < 4; ++j) { x0[j] = ob[row * 64 + d0 + j]; x1[j] = ob[row * 64 + d0 + 4 + j]; }
          *(f32x4*)op = x0; *(f32x4*)(op + 4) = x1; }
        LDS_WAIT(); __syncthreads();
    }
}
__device__ __forceinline__ void dn_combine(Frame& F, const Args& a) {
    bf16* P = (bf16*)(a.ws + WS_P);
    const float* OF = a.out; const float* OB = a.out + (size_t)M * 512; const float* og = a.in[11];
    const int gw = F.vcu * NWAVES + F.wave, NGW = F.G * NWAVES, c0 = F.lane * 8;
    for (int row = gw; row < M; row += NGW) {
        const f32x4 f0 = *(const f32x4*)(OF + (size_t)row * 512 + c0), f1 = *(const f32x4*)(OF + (size_t)row * 512 + c0 + 4);
        const f32x4 b0 = *(const f32x4*)(OB + (size_t)row * 512 + c0), b1 = *(const f32x4*)(OB + (size_t)row * 512 + c0 + 4);
        float s[8];
#pragma unroll
        for (int j = 0; j < 4; ++j) { s[j] = f0[j] + b0[j]; s[4 + j] = f1[j] + b1[j]; }
        float ss = 0.f;
#pragma unroll
        for (int j = 0; j < 8; ++j) ss += s[j] * s[j];
        ss += __shfl_xor(ss, 1); ss += __shfl_xor(ss, 2); ss += __shfl_xor(ss, 4);
        const float rstd = __builtin_amdgcn_rsqf(ss * (1.0f / 64) + EPS);
        bf16* zp = P + (size_t)row * PLD + C_DZ + c0; float z[8]; unpack8(*(const u32x4*)zp, z);
        const f32x4 g0 = *(const f32x4*)(og + (c0 & 63)), g1 = *(const f32x4*)(og + (c0 & 63) + 4);
        float y[8];
#pragma unroll
        for (int j = 0; j < 4; ++j) { y[j] = s[j] * rstd * g0[j] * siluf_(z[j]); y[4 + j] = s[4 + j] * rstd * g1[j] * siluf_(z[4 + j]); }
        *(u32x4*)zp = pack8(y);
    }
}
__device__ __forceinline__ void ffn_fixup_panel(Frame& F, const Args& a, int pm) {
    bf16* P = (bf16*)(a.ws + WS_P); const float* UE = (const float*)(a.ws + WS_UE);
    const float* cw = a.in[22]; const float* cb = a.in[23];
    for (int e = F.tid; e < 8 * DFF; e += 512) { const int k = e / DFF, ch = e % DFF, g = pm * 4 + (k >> 1), last = k & 1;
        const int row = g * 64 + (last ? 63 : 0);
        const float* pu; const float* cu; const float* nu; bool hp = true, hn = true;
        if (!last) { hp = (row % SEQ) != 0; pu = UE + ((size_t)(g > 0 ? g - 1 : 0) * 4 + 3) * NUP; cu = UE + ((size_t)g * 4 + 0) * NUP; nu = UE + ((size_t)g * 4 + 1) * NUP; }
        else { hn = (row % SEQ) != SEQ - 1; pu = UE + ((size_t)g * 4 + 2) * NUP; cu = UE + ((size_t)g * 4 + 3) * NUP; nu = UE + ((size_t)(g < 511 ? g + 1 : 511) * 4 + 0) * NUP; }
        const float pg = hp ? pu[ch] : 0.f, pv = hp ? pu[DFF + ch] : 0.f, ng = hn ? nu[ch] : 0.f, nv = hn ? nu[DFF + ch] : 0.f;
        const float gate = cw[ch] * pg + cw[NUP + ch] * cu[ch] + cw[2 * NUP + ch] * ng + cb[ch];
        const float val = cw[DFF + ch] * pv + cw[NUP + DFF + ch] * cu[DFF + ch] + cw[2 * NUP + DFF + ch] * nv + cb[DFF + ch];
        P[(size_t)row * PLD + C_ACT + ch] = (bf16)(pk2(siluf_(gate) * val, 0.f) & 0xffffu); }
}

__global__ void __launch_bounds__(NWAVES * 64, 2) fwd_kernel(Args args) {
    extern __shared__ __attribute__((aligned(16))) unsigned char lds[];
    Frame F;
    F.lds = (LAS unsigned char*)lds;
    F.MISC = (volatile LAS unsigned*)(F.lds + MISC_OFF);
    F.tid = threadIdx.x; F.lane = F.tid & 63; F.wave = __builtin_amdgcn_readfirstlane(F.tid >> 6);
    F.G = gridDim.x; { const int bx = blockIdx.x; F.vcu = (F.G % 8 == 0) ? (bx % 8) * (F.G / 8) + bx / 8 : bx; }
    unsigned char* ws = args.ws;
    F.ctl = (gu32*)(ws + WS_CTL);
    for (int u = F.tid; u < (LDS_BYTES - LDSCTL_OFF) / 4; u += NWAVES * 64) ((LAS unsigned*)(F.lds + LDSCTL_OFF))[u] = 0u;
    __syncthreads();
    const int lo = args.ph_lo, hi = args.ph_hi;
    const bool single = (hi - lo) > 1;
    XcdBarrier bar; bar.bar = (unsigned*)(F.ctl + CW_BAR); bar.x = 0; bar.st = nullptr;
    if (single) bar = xcd_barrier_post((unsigned*)(F.ctl + CW_BAR), F.MISC + 8);
#ifndef PH_MASK
#define PH_MASK 0xFF
#endif
#define IN(k) (((PH_MASK >> (k)) & 1) && lo <= (k) && (k) < hi)
#define SEAM(k) do { if (IN(k) && IN((k) + 1)) xcd_barrier(bar); } while (0)
    bf16* P = (bf16*)(ws + WS_P);
    const int bid = (int)blockIdx.x;

    if (IN(0)) { p0_prologue(F, args); }
    SEAM(0);
    if (IN(1)) {
        { pg8::Gemm g{(const bf16*)args.out, (const bf16*)(ws + WS_WIN), M, NIN, 1024, 1024, 1024}; pg8::StaticOrder S; S.init(M, NIN, F.G, bid);
          EpiInProj E{P, (float*)(ws + WS_BA)};
          pg8::gemm_phase<EpiInProj, pg8::StaticOrder, true, true>(F.lds + RING_OFF, g, S, E); }
        { pg8::Gemm g{(const bf16*)(ws + WS_MEMN), (const bf16*)(ws + WS_WKV), BATCH * NMEM, 1024, 1024, 1024, 1024}; pg8::StaticOrder S; S.init(BATCH * NMEM, 1024, F.G, bid);
          EpiBf16 E{(bf16*)(ws + WS_KV), 1024};
          pg8::gemm_phase<EpiBf16, pg8::StaticOrder, true, true>(F.lds + RING_OFF, g, S, E); }
    }
    SEAM(1);
    if (IN(2)) {
        const int ndn = F.G >= 128 ? 64 : 0;
        if (bid < ndn) { dn_unit_v1(F, args, bid >> 4, (bid >> 1) & 7, bid & 1); }
        else {
            if (ndn == 0) for (int u = bid; u < 64; u += F.G) dn_unit_v1(F, args, u >> 4, (u >> 1) & 7, u & 1);
            const int nb = F.G - ndn, me = bid - ndn;
            for (int u = me; u < 1024; u += nb) {
                if (u < 512) attnA_unit(F, args, u >> 7, (u >> 1) & 63, u & 1);
                else { const int v = u - 512; xattn_unit(F, args, v >> 7, (v >> 2) & 31, v & 3); }
            }
        }
    }
    SEAM(2);
    if (IN(3)) { dn_combine(F, args); }
    SEAM(3);
    if (IN(4)) {
        { pg8::Gemm g{P + C_AQ, (const bf16*)(ws + WS_WBR), M, 1024, 512, PLD, 512}; pg8::StaticOrder S; S.init(M, 1024, F.G, bid);
          EpiBranch<0> E{P}; pg8::gemm_phase<EpiBranch<0>, pg8::StaticOrder, true, true>(F.lds + RING_OFF, g, S, E); }
        VM_WAIT(); __syncthreads();
        { pg8::Gemm g{P + C_DZ, (const bf16*)(ws + WS_WBR) + (size_t)1024 * 512, M, 1024, 512, PLD, 512}; pg8::StaticOrder S; S.init(M, 1024, F.G, bid);
          EpiBranch<1> E{P}; pg8::gemm_phase<EpiBranch<1>, pg8::StaticOrder, true, true>(F.lds + RING_OFF, g, S, E); }
        VM_WAIT(); __syncthreads();
        { pg8::Gemm g{P + C_MQ, (const bf16*)(ws + WS_WBR) + (size_t)2 * 1024 * 512, M, 1024, 512, PLD, 512}; pg8::StaticOrder S; S.init(M, 1024, F.G, bid);
          EpiBranch<2> E{P}; pg8::gemm_phase<EpiBranch<2>, pg8::StaticOrder, true, true>(F.lds + RING_OFF, g, S, E); }
    }
    SEAM(4);
    if (IN(5)) {
        pg8::Gemm g{P + C_MG, (const bf16*)(ws + WS_WOUT), M, 1024, 1024, PLD, 1024}; pg8::StaticOrder S; S.init(M, 1024, F.G, bid);
        EpiWout E{args.in[0], args.out, P, (float*)(ws + WS_SSQ)};
        pg8::gemm_phase<EpiWout, pg8::StaticOrder, true, true>(F.lds + RING_OFF, g, S, E);
    }
    SEAM(5);
    if (IN(6)) {
        pg8::Gemm g{P + C_X1B, (const bf16*)(ws + WS_WUP), M, NUP, 1024, PLD, 1024}; pg8::StaticOrder S; S.init(M, NUP, F.G, bid);
        EpiUp E{(const float*)(ws + WS_SSQ), args.in[22], args.in[23], P, (float*)(ws + WS_UE)};
        pg8::gemm_phase<EpiUp, pg8::StaticOrder, true, true>(F.lds + RING_OFF, g, S, E);
    }
    SEAM(6);
    if (IN(7)) {
        pg8::Gemm g{P + C_ACT, (const bf16*)(ws + WS_WDN), M, 1024, DFF, PLD, DFF}; pg8::StaticOrder S; S.init(M, 1024, F.G, bid);
        { Unit u; int prev = -1; for (int i = 0; S.next(i, u); ++i) { if (u.pm != prev) ffn_fixup_panel(F, args, u.pm); prev = u.pm; } }
        VM_WAIT(); __syncthreads();
        EpiDown E{args.out};
        pg8::gemm_phase<EpiDown, pg8::StaticOrder, true, true>(F.lds + RING_OFF, g, S, E);
    }
#undef IN
#undef SEAM
}

constexpr int N_PHASES = 8;
#ifndef MK_PER_PHASE
#define MK_PER_PHASE 0
#endif
extern "C" void kernel_launch(void* const* d_in, const int* in_sizes, int n_in, void* d_out, int out_size, void* d_ws, size_t ws_size, hipStream_t stream) {
    static int grid = 0;
    if (grid == 0) {
        if (n_in != 25 || in_sizes[0] != M * DM || out_size != M * DM || ws_size < WS_END) {
            fprintf(stderr, "kernel_launch: unexpected shapes (n_in %d, in0 %d, out %d, ws %zu); nothing launched\n", n_in, n_in > 0 ? in_sizes[0] : -1, out_size, ws_size); grid = -1; return; }
        int dev = 0, cus = 0, per_cu = 0;
        if (hipGetDevice(&dev) != hipSuccess || hipDeviceGetAttribute(&cus, hipDeviceAttributeMultiprocessorCount, dev) != hipSuccess) { grid = -1; return; }
        if (hipFuncSetAttribute((const void*)fwd_kernel, hipFuncAttributeMaxDynamicSharedMemorySize, LDS_BYTES) != hipSuccess) { fprintf(stderr, "kernel_launch: hipFuncSetAttribute failed\n"); grid = -1; return; }
        if (hipOccupancyMaxActiveBlocksPerMultiprocessor(&per_cu, (const void*)fwd_kernel, NWAVES * 64, LDS_BYTES) != hipSuccess || per_cu < 1) { fprintf(stderr, "kernel_launch: occupancy query reports %d\n", per_cu); }
        (void)hipGetLastError();
        grid = cus;
    }
    if (grid < 0) return;
    if (hipMemsetAsync((char*)d_ws + WS_CTL, 0, CTL_ZERO_BYTES, stream) != hipSuccess) return;
    Args a{};
    for (int i = 0; i < 25; ++i) a.in[i] = (const float*)d_in[i];
    a.out = (float*)d_out; a.ws = (unsigned char*)d_ws;
    if (MK_PER_PHASE) {
        for (int p = 0; p < N_PHASES; ++p) { a.ph_lo = p; a.ph_hi = p + 1; hipLaunchKernelGGL(fwd_kernel, dim3(grid), dim3(NWAVES * 64), LDS_BYTES, stream, a); }
    } else {
        a.ph_lo = 0; a.ph_hi = N_PHASES; hipLaunchKernelGGL(fwd_kernel, dim3(grid), dim3(NWAVES * 64), LDS_BYTES, stream, a);
    }
}
```

```cpp
#include <hip/hip_runtime.h>
#include <cstdio>
#include <cstdint>
#include <cmath>
namespace pg8 {
#define PG8_LAS __attribute__((address_space(3)))
typedef unsigned short bf16_t;
typedef short bf16x8 __attribute__((ext_vector_type(8)));
typedef float f32x4 __attribute__((ext_vector_type(4)));
typedef unsigned u32x4 __attribute__((ext_vector_type(4)));
constexpr int BM = 256, BK = 64, HALF = 128, HTB = HALF * BK * 2  , STAGE_BYTES = 8 * HTB, NXCD = 8, WGM = 8;

__host__ __device__ __forceinline__ int lds_byte(int r, int c) { const int st = (r >> 4) * 2 + (c >> 5), rr = r & 15, cc = c & 31, ob = rr * 64 + cc * 2; return st * 1024 + (ob ^ (((ob >> 9) & 1) << 5)); }
__host__ __device__ __forceinline__ void stage_rc(int b, int& R, int& C) { const int st = b / 1024, sb = b % 1024, swz = sb ^ (((sb >> 9) & 1) << 5); R = (st >> 1) * 16 + swz / 64; C = (st & 1) * 32 + (swz % 64) / 2; }
__host__ __device__ __forceinline__ int perm32(int rho) { const int n = rho >> 4, i = rho & 15; return 8 * (i >> 2) + 4 * n + (i & 3); }

struct Unit { int pm, pn; };
struct Gemm { const bf16_t* A; const bf16_t* Bt; int M, N, K, lda, ldb; };

struct StaticOrder {
    int nM, nN, nwg, G, c;
    __host__ __device__ void init(int M, int N, int G_, int c_) { nM = M / BM; nN = N / BM; nwg = nM * nN; G = G_; c = c_; }
    __host__ __device__ bool next(int i, Unit& u) const {
        const long L = (long)i * G + c; if (L >= nwg) return false;
        int wgid = (int)L; { const int q = nwg / NXCD, r = nwg % NXCD, xcd = wgid % NXCD, off = wgid / NXCD; wgid = (xcd < r ? xcd * (q + 1) : r * (q + 1) + (xcd - r) * q) + off; }
        const int nig = WGM * nN, gid = wgid / nig, fm = gid * WGM, gsz = (nM - fm) < WGM ? (nM - fm) : WGM;
        u.pm = fm + ((wgid % nig) % gsz); u.pn = (wgid % nig) / gsz; return true;
    }
    __device__ __forceinline__ void a_ready(const Unit&) const {}
    __device__ __forceinline__ void done(const Unit&) const {}
};

template <class Epi, class Sched, bool ALIGN_EPI = false, bool SP2 = false>
__device__ __forceinline__ void gemm_phase(PG8_LAS unsigned char* lds, const Gemm g, const Sched& S, const Epi& E) {
    const int tid = threadIdx.x, wid = __builtin_amdgcn_readfirstlane(tid >> 6), lane = tid & 63, wr = wid >> 2, wc = wid & 3, fr = lane & 15, fq = lane >> 4;
    const int K = g.K, nt = K / BK;
    unsigned voffA[2], voffB[2];
#pragma unroll
    for (int i = 0; i < 2; ++i) { int R, C; stage_rc(tid * 16 + i * 8192, R, C); const int Rb = Epi::PERM ? ((R & ~31) + perm32(R & 31)) : R;
        voffA[i] = (unsigned)(R * g.lda + C) * 2u; voffB[i] = (unsigned)(Rb * g.ldb + C) * 2u; }
    const size_t kstep = (size_t)(BK * 2);
    const size_t hstepA = (size_t)HALF * g.lda * 2, hstepB = (size_t)HALF * g.ldb * 2;
    const size_t tstepA = 2 * hstepA, tstepB = 2 * hstepB;
    const unsigned ldsw = (unsigned)wid * 1024u;
    const int aoff = lds_byte(wr * 64 + fr, fq * 8), boff = lds_byte(wc * 32 + fr, fq * 8);
#define PG8_SA(b, h) (((b) * 2 + (h)) * HTB)
#define PG8_SB(b, h) ((4 + (b) * 2 + (h)) * HTB)
#define PG8_STAGE(bufoff, gbase, voff) do { _Pragma("unroll") for (int _i = 0; _i < 2; ++_i) \
        __builtin_amdgcn_global_load_lds((const unsigned*)((const char*)(gbase) + (voff)[_i]), (PG8_LAS unsigned*)(lds + (bufoff) + ldsw + _i * 8192), 16, 0, 0); } while (0)
#define PG8_LDA(dst, b, h) do { _Pragma("unroll") for (int m = 0; m < 4; ++m) _Pragma("unroll") for (int k = 0; k < 2; ++k) dst[m][k] = *(const PG8_LAS bf16x8*)(lds + PG8_SA(b, h) + aoff + m * 2048 + k * 1024); } while (0)
#define PG8_LDB(dst, b, h) do { _Pragma("unroll") for (int n = 0; n < 2; ++n) _Pragma("unroll") for (int k = 0; k < 2; ++k) dst[n][k] = *(const PG8_LAS bf16x8*)(lds + PG8_SB(b, h) + boff + n * 2048 + k * 1024); } while (0)
#define PG8_MMA(ai, bj, At, Bt) do { __builtin_amdgcn_s_setprio(1); _Pragma("unroll") for (int m = 0; m < 4; ++m) _Pragma("unroll") for (int n = 0; n < 2; ++n) _Pragma("unroll") for (int k = 0; k < 2; ++k) \
        acc[ai][bj][m][n] = __builtin_amdgcn_mfma_f32_16x16x32_bf16(Bt[n][k], At[m][k], acc[ai][bj][m][n], 0, 0, 0); __builtin_amdgcn_s_setprio(0); } while (0)
#define PG8_WAIT_V(n) asm volatile("s_waitcnt vmcnt(" #n ")" ::: "memory")
#define PG8_WAIT_L(n) asm volatile("s_waitcnt lgkmcnt(" #n ")" ::: "memory")
#define PG8_BAR __builtin_amdgcn_s_barrier()
#define PG8_SCHED __builtin_amdgcn_sched_barrier(0)
    Unit cur, nxt; int ui = 0;
    if (!S.next(0, cur)) return;
    f32x4 acc[2][2][4][2];
#pragma unroll
    for (int a = 0; a < 2; ++a)
#pragma unroll
        for (int b = 0; b < 2; ++b)
#pragma unroll
            for (int m = 0; m < 4; ++m)
#pragma unroll
                for (int n = 0; n < 2; ++n) acc[a][b][m][n] = (f32x4){0.f, 0.f, 0.f, 0.f};
    bf16x8 At[4][2], B0[2][2], B1[2][2];
    const char* cA = (const char*)g.A + (size_t)cur.pm * tstepA; const char* cB = (const char*)g.Bt + (size_t)cur.pn * tstepB;
    S.a_ready(cur);
    if constexpr (SP2) {
        PG8_STAGE(PG8_SB(0, 0), cB, voffB); PG8_STAGE(PG8_SB(0, 1), cB + hstepB, voffB); PG8_STAGE(PG8_SA(0, 0), cA, voffA); PG8_STAGE(PG8_SA(0, 1), cA + hstepA, voffA);
        if (wr == 1) PG8_BAR;
        PG8_WAIT_V(2); PG8_BAR;
        PG8_STAGE(PG8_SB(1, 0), cB + kstep, voffB); PG8_STAGE(PG8_SA(1, 0), cA + kstep, voffA); PG8_STAGE(PG8_SB(1, 1), cB + hstepB + kstep, voffB);
        PG8_WAIT_V(6); PG8_BAR;
    } else {
        PG8_STAGE(PG8_SB(0, 0), cB, voffB); PG8_STAGE(PG8_SA(0, 0), cA, voffA); PG8_STAGE(PG8_SB(0, 1), cB + hstepB, voffB); PG8_STAGE(PG8_SA(0, 1), cA + hstepA, voffA);
        if (wr == 1) PG8_BAR;
        PG8_WAIT_V(4); PG8_BAR;
        PG8_STAGE(PG8_SB(1, 0), cB + kstep, voffB); PG8_STAGE(PG8_SA(1, 0), cA + kstep, voffA); PG8_STAGE(PG8_SB(1, 1), cB + hstepB + kstep, voffB);
        PG8_WAIT_V(6); PG8_BAR;
    }
    for (;;) {
        const bool has_next = S.next(ui + 1, nxt);
        const char* nA = has_next ? (const char*)g.A + (size_t)nxt.pm * tstepA : cA; const char* nB = has_next ? (const char*)g.Bt + (size_t)nxt.pn * tstepB : cB;
        for (int t = 0; t < nt; t += 2) {
            const bool last = (t == nt - 2);
            const char* a1 = cA + (size_t)(t + 1) * kstep;
            const char* a2 = last ? nA : cA + (size_t)(t + 2) * kstep; const char* b2 = last ? nB : cB + (size_t)(t + 2) * kstep;
            const char* a3 = a2 + kstep; const char* b3 = b2 + kstep;
            if (last && has_next) S.a_ready(nxt);
            if constexpr (SP2) {
            PG8_LDB(B0, 0, 0); PG8_LDB(B1, 0, 1); PG8_SCHED; PG8_LDA(At, 0, 0); PG8_STAGE(PG8_SA(1, 1), a1 + hstepA, voffA);
            PG8_WAIT_V(8); PG8_WAIT_L(0); PG8_BAR; PG8_MMA(0, 0, At, B0); PG8_MMA(0, 1, At, B1); PG8_BAR; PG8_SCHED;
            PG8_LDA(At, 0, 1); PG8_STAGE(PG8_SB(0, 0), b2, voffB); PG8_STAGE(PG8_SB(0, 1), b2 + hstepB, voffB); PG8_STAGE(PG8_SA(0, 0), a2, voffA);
            PG8_WAIT_V(8); PG8_WAIT_L(0); PG8_BAR; PG8_MMA(1, 0, At, B0); PG8_MMA(1, 1, At, B1); PG8_BAR; PG8_SCHED;
            PG8_LDB(B0, 1, 0); PG8_LDB(B1, 1, 1); PG8_SCHED; PG8_LDA(At, 1, 0); PG8_STAGE(PG8_SA(0, 1), a2 + hstepA, voffA);
            PG8_WAIT_V(8); PG8_WAIT_L(0); PG8_BAR; PG8_MMA(0, 0, At, B0); PG8_MMA(0, 1, At, B1); PG8_BAR; PG8_SCHED;
            PG8_LDA(At, 1, 1); PG8_STAGE(PG8_SB(1, 0), b3, voffB); PG8_STAGE(PG8_SB(1, 1), b3 + hstepB, voffB); PG8_STAGE(PG8_SA(1, 0), a3, voffA);
            PG8_WAIT_V(8); PG8_WAIT_L(0); PG8_BAR; PG8_MMA(1, 0, At, B0); PG8_MMA(1, 1, At, B1); PG8_BAR; PG8_SCHED;
            } else {
            PG8_LDB(B0, 0, 0); PG8_SCHED; PG8_LDA(At, 0, 0); PG8_STAGE(PG8_SA(1, 1), a1 + hstepA, voffA);
            PG8_WAIT_L(8); PG8_BAR; PG8_WAIT_L(0); PG8_MMA(0, 0, At, B0); PG8_BAR; PG8_SCHED;
            PG8_LDB(B1, 0, 1); PG8_STAGE(PG8_SB(0, 0), b2, voffB);
            PG8_BAR; PG8_WAIT_L(0); PG8_MMA(0, 1, At, B1); PG8_BAR;
            PG8_LDA(At, 0, 1); PG8_STAGE(PG8_SA(0, 0), a2, voffA);
            PG8_BAR; PG8_WAIT_L(0); PG8_MMA(1, 0, At, B0); PG8_BAR; PG8_SCHED;
            PG8_STAGE(PG8_SB(0, 1), b2 + hstepB, voffB);
            PG8_WAIT_V(6); PG8_BAR; PG8_MMA(1, 1, At, B1); PG8_BAR;
            PG8_LDB(B0, 1, 0); PG8_SCHED; PG8_LDA(At, 1, 0); PG8_STAGE(PG8_SA(0, 1), a2 + hstepA, voffA);
            PG8_WAIT_L(8); PG8_BAR; PG8_WAIT_L(0); PG8_MMA(0, 0, At, B0); PG8_BAR; PG8_SCHED;
            PG8_LDB(B1, 1, 1); PG8_STAGE(PG8_SB(1, 0), b3, voffB);
            PG8_BAR; PG8_WAIT_L(0); PG8_MMA(0, 1, At, B1); PG8_BAR;
            PG8_LDA(At, 1, 1); PG8_STAGE(PG8_SA(1, 0), a3, voffA);
            PG8_BAR; PG8_WAIT_L(0); PG8_MMA(1, 0, At, B0); PG8_BAR; PG8_SCHED;
            PG8_STAGE(PG8_SB(1, 1), b3 + hstepB, voffB);
            PG8_WAIT_V(6); PG8_BAR; PG8_MMA(1, 1, At, B1); PG8_BAR;
            }
        }
        if constexpr (ALIGN_EPI) { if (wr == 0) PG8_BAR; }
        if constexpr (!Epi::AFTER_DRAIN) { E(acc, cur, wr, wc, fr, fq); S.done(cur); }
        if (!has_next) break;
#pragma unroll
        for (int a = 0; a < 2; ++a)
#pragma unroll
            for (int b = 0; b < 2; ++b)
#pragma unroll
                for (int m = 0; m < 4; ++m)
#pragma unroll
                    for (int n = 0; n < 2; ++n) acc[a][b][m][n] = (f32x4){0.f, 0.f, 0.f, 0.f};
        cur = nxt; cA = nA; cB = nB; ++ui;
        if constexpr (ALIGN_EPI) { if (wr == 1) PG8_BAR; }
    }
    PG8_WAIT_V(0);
    if constexpr (!ALIGN_EPI) { if (wr == 0) PG8_BAR; }
    PG8_BAR;
    if constexpr (Epi::AFTER_DRAIN) { E.fused(acc, cur, wr, wc, fr, fq, lds, wid, lane); S.done(cur); }
#undef PG8_SA
#undef PG8_SB
#undef PG8_STAGE
#undef PG8_LDA
#undef PG8_LDB
#undef PG8_MMA
#undef PG8_WAIT_V
#undef PG8_WAIT_L
#undef PG8_BAR
#undef PG8_SCHED
}
}

#define LAS __attribute__((address_space(3)))
#define GAS __attribute__((address_space(1)))
typedef unsigned short bf16;
typedef short bf16x8 __attribute__((ext_vector_type(8)));
typedef short s16x4 __attribute__((ext_vector_type(4)));
typedef float f32x4 __attribute__((ext_vector_type(4)));
typedef float f32x16 __attribute__((ext_vector_type(16)));
typedef unsigned u32x4 __attribute__((ext_vector_type(4)));
typedef unsigned u32x2 __attribute__((ext_vector_type(2)));
typedef float f32x2_t __attribute__((ext_vector_type(2)));
typedef __bf16 bf16x2_t __attribute__((ext_vector_type(2)));

constexpr int BATCH = 4, SEQ = 8192, DM = 1024, M = BATCH * SEQ;
constexpr int NMEM = 256;
constexpr int PLD = 6400;
constexpr int C_AQ = 0, C_AK = 512, C_AV = 640, C_DQ = 768, C_DK = 1280, C_DV = 1792, C_DZ = 2304, C_MQ = 2816, C_GATE = 3328;
constexpr int C_MG = 768, C_X1B = 1792, C_ACT = 2816;
constexpr int NIN = 6656;
constexpr int DFF = 2816, NUP = 5632;
constexpr float EPS = 1e-6f;
constexpr float LOG2E = 1.4426950408889634f;

__device__ __forceinline__ float bf_lo(unsigned w) { return __uint_as_float(w << 16); }
__device__ __forceinline__ float bf_hi(unsigned w) { return __uint_as_float(w & 0xffff0000u); }
__device__ __forceinline__ unsigned pk2(float lo, float hi) { f32x2_t v = {lo, hi}; bf16x2_t b = __builtin_convertvector(v, bf16x2_t); return __builtin_bit_cast(unsigned, b); }
__device__ __forceinline__ float fexp2(float x) { return __builtin_amdgcn_exp2f(x); }
__device__ __forceinline__ float frcp(float x) { return __builtin_amdgcn_rcpf(x); }
__device__ __forceinline__ float sigmoidf_(float x) { return frcp(1.0f + fexp2(-x * LOG2E)); }
__device__ __forceinline__ float siluf_(float x) { return x * sigmoidf_(x); }
__device__ __forceinline__ void unpack8(const u32x4 w, float (&v)[8]) {
    v[0] = bf_lo(w.x); v[1] = bf_hi(w.x); v[2] = bf_lo(w.y); v[3] = bf_hi(w.y); v[4] = bf_lo(w.z); v[5] = bf_hi(w.z); v[6] = bf_lo(w.w); v[7] = bf_hi(w.w); }
__device__ __forceinline__ u32x4 pack8(const float (&v)[8]) { u32x4 w; w.x = pk2(v[0], v[1]); w.y = pk2(v[2], v[3]); w.z = pk2(v[4], v[5]); w.w = pk2(v[6], v[7]); return w; }

using pg8::Unit;
constexpr int HALF = pg8::HALF, BM = pg8::BM;

struct EpiInProj {
    static constexpr bool PERM = true, AFTER_DRAIN = false;
    bf16* P; float* BA;
    __device__ __forceinline__ void operator()(const f32x4 (&acc)[2][2][4][2], const Unit& u, int wr, int wc, int fr, int fq) const {
        const int row0 = u.pm * BM + wr * 64 + fr;
        if (u.pn < 13) {
            const int col0 = u.pn * BM + wc * 32 + 8 * fq;
#pragma unroll
            for (int ai = 0; ai < 2; ++ai)
#pragma unroll
                for (int m = 0; m < 4; ++m) { bf16* rowp = P + (size_t)(row0 + ai * HALF + m * 16) * PLD + col0;
#pragma unroll
                    for (int bj = 0; bj < 2; ++bj) { const f32x4 v0 = acc[ai][bj][m][0], v1 = acc[ai][bj][m][1];
                        u32x4 w; w.x = pk2(v0[0], v0[1]); w.y = pk2(v0[2], v0[3]); w.z = pk2(v1[0], v1[1]); w.w = pk2(v1[2], v1[3]);
                        *(u32x4*)(rowp + bj * HALF) = w; } }
        } else if (wc == 0) {
#pragma unroll
            for (int ai = 0; ai < 2; ++ai)
#pragma unroll
                for (int m = 0; m < 4; ++m) { float* rp = BA + (size_t)(row0 + ai * HALF + m * 16) * 32 + 8 * fq;
                    *(f32x4*)rp = acc[ai][0][m][0]; *(f32x4*)(rp + 4) = acc[ai][0][m][1]; }
        }
    }
};
struct EpiBf16 {
    static constexpr bool PERM = true, AFTER_DRAIN = false;
    bf16* O; int ldc;
    __device__ __forceinline__ void operator()(const f32x4 (&acc)[2][2][4][2], const Unit& u, int wr, int wc, int fr, int fq) const {
        const int row0 = u.pm * BM + wr * 64 + fr, col0 = u.pn * BM + wc * 32 + 8 * fq;
#pragma unroll
        for (int ai = 0; ai < 2; ++ai)
#pragma unroll
            for (int m = 0; m < 4; ++m) { bf16* rowp = O + (size_t)(row0 + ai * HALF + m * 16) * ldc + col0;
#pragma unroll
                for (int bj = 0; bj < 2; ++bj) { const f32x4 v0 = acc[ai][bj][m][0], v1 = acc[ai][bj][m][1];
                    u32x4 w; w.x = pk2(v0[0], v0[1]); w.y = pk2(v0[2], v0[3]); w.z = pk2(v1[0], v1[1]); w.w = pk2(v1[2], v1[3]);
                    *(u32x4*)(rowp + bj * HALF) = w; } }
    }
};
template <int PASS> struct EpiBranch {
    static constexpr bool PERM = true, AFTER_DRAIN = false;
    bf16* P;
    __device__ __forceinline__ void operator()(const f32x4 (&acc)[2][2][4][2], const Unit& u, int wr, int wc, int fr, int fq) const {
        const int row0 = u.pm * BM + wr * 64 + fr, col0 = u.pn * BM + wc * 32 + 8 * fq;
#pragma unroll
        for (int ai = 0; ai < 2; ++ai)
#pragma unroll
            for (int m = 0; m < 4; ++m) { bf16* rowp = P + (size_t)(row0 + ai * HALF + m * 16) * PLD;
#pragma unroll
                for (int bj = 0; bj < 2; ++bj) {
                    const int c = col0 + bj * HALF;
                    const u32x4 gw = *(const u32x4*)(rowp + C_GATE + 1024 * PASS + c);
                    float g[8]; unpack8(gw, g);
                    float pv[8];
                    if (PASS > 0) { const u32x4 mw = *(const u32x4*)(rowp + C_MG + c); unpack8(mw, pv); }
                    else {
#pragma unroll
                        for (int i = 0; i < 8; ++i) pv[i] = 0.f; }
                    const f32x4 v0 = acc[ai][bj][m][0], v1 = acc[ai][bj][m][1];
                    float o[8];
#pragma unroll
                    for (int i = 0; i < 4; ++i) { o[i] = pv[i] + sigmoidf_(g[i]) * v0[i]; o[4 + i] = pv[4 + i] + sigmoidf_(g[4 + i]) * v1[i]; }
                    *(u32x4*)(rowp + C_MG + c) = pack8(o); } }
    }
};
struct EpiWout {
    static constexpr bool PERM = true, AFTER_DRAIN = false;
    const float* x; float* out; bf16* P; float* SSQ;
    __device__ __forceinline__ void operator()(const f32x4 (&acc)[2][2][4][2], const Unit& u, int wr, int wc, int fr, int fq) const {
        const int row0 = u.pm * BM + wr * 64 + fr, col0 = u.pn * BM + wc * 32 + 8 * fq;
#pragma unroll
        for (int ai = 0; ai < 2; ++ai)
#pragma unroll
            for (int m = 0; m < 4; ++m) { const int row = row0 + ai * HALF + m * 16; float ss = 0.f;
#pragma unroll
                for (int bj = 0; bj < 2; ++bj) { const int c = col0 + bj * HALF; const size_t off = (size_t)row * DM + c;
                    const f32x4 a0 = *(const f32x4*)(x + off), a1 = *(const f32x4*)(x + off + 4);
                    const f32x4 r0 = a0 + acc[ai][bj][m][0], r1 = a1 + acc[ai][bj][m][1];
                    *(f32x4*)(out + off) = r0; *(f32x4*)(out + off + 4) = r1;
                    ss += (r0[0] * r0[0] + r0[1] * r0[1]) + (r0[2] * r0[2] + r0[3] * r0[3]) + (r1[0] * r1[0] + r1[1] * r1[1]) + (r1[2] * r1[2] + r1[3] * r1[3]);
                    u32x4 w; w.x = pk2(r0[0], r0[1]); w.y = pk2(r0[2], r0[3]); w.z = pk2(r1[0], r1[1]); w.w = pk2(r1[2], r1[3]);
                    *(u32x4*)(P + (size_t)row * PLD + C_X1B + c) = w; }
                ss += __shfl_xor(ss, 16); ss += __shfl_xor(ss, 32);
                if (fq == 0) SSQ[(size_t)row * 16 + u.pn * 4 + wc] = ss; }
    }
};
struct EpiUp {
    static constexpr bool PERM = true, AFTER_DRAIN = false;
    const float* SSQ; const float* cw; const float* cb; bf16* P; float* UE;
    __device__ __forceinline__ void operator()(const f32x4 (&acc)[2][2][4][2], const Unit& u, int wr, int wc, int fr, int fq) const {
        const int lane = fq * 16 + fr;
        const int row0 = u.pm * BM + wr * 64 + fr;
        float rs[2][4];
#pragma unroll
        for (int ai = 0; ai < 2; ++ai)
#pragma unroll
            for (int m = 0; m < 4; ++m) { const float* sp = SSQ + (size_t)(row0 + ai * HALF + m * 16) * 16;
                const f32x4 a = *(const f32x4*)sp, b = *(const f32x4*)(sp + 4), c = *(const f32x4*)(sp + 8), d = *(const f32x4*)(sp + 12);
                const float s = ((a[0] + a[1]) + (a[2] + a[3])) + ((b[0] + b[1]) + (b[2] + b[3])) + ((c[0] + c[1]) + (c[2] + c[3])) + ((d[0] + d[1]) + (d[2] + d[3]));
                rs[ai][m] = __builtin_amdgcn_rsqf(s * (1.0f / DM) + EPS); asm volatile("" : "+v"(rs[ai][m]) :: "memory"); }
        const int src_prev = (fr == 0) ? lane + 15 : lane - 1, src_next = (fr == 15) ? lane - 15 : lane + 1;
#pragma unroll
        for (int n = 0; n < 2; ++n) {
            const int a0 = u.pn * 128 + wc * 32 + 8 * fq + 4 * n;
            const f32x4 wg0 = *(const f32x4*)(cw + a0), wg1 = *(const f32x4*)(cw + NUP + a0), wg2 = *(const f32x4*)(cw + 2 * NUP + a0), bg = *(const f32x4*)(cb + a0);
            const f32x4 wv0 = *(const f32x4*)(cw + DFF + a0), wv1 = *(const f32x4*)(cw + NUP + DFF + a0), wv2 = *(const f32x4*)(cw + 2 * NUP + DFF + a0), bv = *(const f32x4*)(cb + DFF + a0);
#pragma unroll
            for (int ai = 0; ai < 2; ++ai) {
                f32x4 ug[4], uv[4];
#pragma unroll
                for (int m = 0; m < 4; ++m) { ug[m] = acc[ai][0][m][n] * rs[ai][m]; uv[m] = acc[ai][1][m][n] * rs[ai][m]; }
                const int g64 = u.pm * 4 + ai * 2 + wr;
#pragma unroll
                for (int m = 0; m < 4; ++m) {
                    f32x4 pg, ng, pvv, nv;
#pragma unroll
                    for (int i = 0; i < 4; ++i) {
                        const float tpg = (fr == 15) ? ug[(m + 3) & 3][i] : ug[m][i];
                        const float tng = (fr == 0) ? ug[(m + 1) & 3][i] : ug[m][i];
                        const float tpv = (fr == 15) ? uv[(m + 3) & 3][i] : uv[m][i];
                        const float tnv = (fr == 0) ? uv[(m + 1) & 3][i] : uv[m][i];
                        pg[i] = __shfl(tpg, src_prev); ng[i] = __shfl(tng, src_next); pvv[i] = __shfl(tpv, src_prev); nv[i] = __shfl(tnv, src_next); }
                    const f32x4 gate = wg0 * pg + wg1 * ug[m] + wg2 * ng + bg;
                    const f32x4 val = wv0 * pvv + wv1 * uv[m] + wv2 * nv + bv;
                    const int row = row0 + ai * HALF + m * 16;
                    const bool edge = (m == 0 && fr == 0) || (m == 3 && fr == 15);
                    if (!edge) { u32x2 w; w.x = pk2(siluf_(gate[0]) * val[0], siluf_(gate[1]) * val[1]); w.y = pk2(siluf_(gate[2]) * val[2], siluf_(gate[3]) * val[3]);
                        *(u32x2*)(P + (size_t)row * PLD + C_ACT + a0) = w; }
                    if ((m == 0 && fr < 2) || (m == 3 && fr >= 14)) { const int slot = (m == 0) ? fr : fr - 12;
                        float* ue = UE + ((size_t)g64 * 4 + slot) * NUP;
                        *(f32x4*)(ue + a0) = ug[m]; *(f32x4*)(ue + DFF + a0) = uv[m]; }
                }
                asm volatile("" ::: "memory");
            }
        }
    }
};
struct EpiDown {
    static constexpr bool PERM = true, AFTER_DRAIN = false;
    float* out;
    __device__ __forceinline__ void operator()(const f32x4 (&acc)[2][2][4][2], const Unit& u, int wr, int wc, int fr, int fq) const {
        const int row0 = u.pm * BM + wr * 64 + fr, col0 = u.pn * BM + wc * 32 + 8 * fq;
#pragma unroll
        for (int ai = 0; ai < 2; ++ai)
#pragma unroll
            for (int m = 0; m < 4; ++m) {
#pragma unroll
                for (int bj = 0; bj < 2; ++bj) { const size_t off = (size_t)(row0 + ai * HALF + m * 16) * DM + col0 + bj * HALF;
                    const f32x4 a0 = *(const f32x4*)(out + off), a1 = *(const f32x4*)(out + off + 4);
                    *(f32x4*)(out + off) = a0 + acc[ai][bj][m][0]; *(f32x4*)(out + off + 4) = a1 + acc[ai][bj][m][1]; } }
    }
};

template <int DH, int RSK, int RSV, bool BIAS>
__device__ __forceinline__ void attn_tile(const LAS unsigned char* Kl, const LAS unsigned char* Vl, int jk, const bf16x8 (&qf)[DH / 16], const float* biasrow,
                                          float& m, float& l, f32x16 (&o)[DH / 32], int lane) {
    const int r32 = lane & 31, hi = lane >> 5;
    f32x16 s0, s1;
    if (BIAS) {
#pragma unroll
        for (int g4 = 0; g4 < 4; ++g4) { const f32x4 c0 = *(const f32x4*)(biasrow + 8 * g4 + 4 * hi), c1 = *(const f32x4*)(biasrow + 32 + 8 * g4 + 4 * hi);
#pragma unroll
            for (int i = 0; i < 4; ++i) { s0[4 * g4 + i] = c0[i]; s1[4 * g4 + i] = c1[i]; } }
    } else {
#pragma unroll
        for (int r = 0; r < 16; ++r) { s0[r] = 0.f; s1[r] = 0.f; }
    }
    const LAS unsigned char* kp = Kl + (size_t)(jk + r32) * RSK + 16 * hi;
#pragma unroll
    for (int ks = 0; ks < DH / 16; ++ks) {
        const bf16x8 k0 = *(const LAS bf16x8*)(kp + 32 * ks), k1 = *(const LAS bf16x8*)(kp + 32 * RSK + 32 * ks);
        s0 = __builtin_amdgcn_mfma_f32_32x32x16_bf16(k0, qf[ks], s0, 0, 0, 0);
        s1 = __builtin_amdgcn_mfma_f32_32x32x16_bf16(k1, qf[ks], s1, 0, 0, 0);
    }
    float mx = fmaxf(s0[0], s1[0]);
#pragma unroll
    for (int r = 1; r < 16; ++r) mx = fmaxf(mx, fmaxf(s0[r], s1[r]));
    mx = fmaxf(mx, __shfl_xor(mx, 32));
    const float mn = fmaxf(m, mx), f = fexp2(m - mn);
    m = mn; l *= f;
#pragma unroll
    for (int db = 0; db < DH / 32; ++db)
#pragma unroll
        for (int r = 0; r < 16; ++r) o[db][r] *= f;
    float ps = 0.f;
#pragma unroll
    for (int r = 0; r < 16; ++r) { s0[r] = fexp2(s0[r] - mn); s1[r] = fexp2(s1[r] - mn); ps += s0[r] + s1[r]; }
    l += ps;
    bf16x8 pf[4];
    { u32x4 w;
      w.x = pk2(s0[0], s0[1]); w.y = pk2(s0[2], s0[3]); w.z = pk2(s0[4], s0[5]); w.w = pk2(s0[6], s0[7]); pf[0] = __builtin_bit_cast(bf16x8, w);
      w.x = pk2(s0[8], s0[9]); w.y = pk2(s0[10], s0[11]); w.z = pk2(s0[12], s0[13]); w.w = pk2(s0[14], s0[15]); pf[1] = __builtin_bit_cast(bf16x8, w);
      w.x = pk2(s1[0], s1[1]); w.y = pk2(s1[2], s1[3]); w.z = pk2(s1[4], s1[5]); w.w = pk2(s1[6], s1[7]); pf[2] = __builtin_bit_cast(bf16x8, w);
      w.x = pk2(s1[8], s1[9]); w.y = pk2(s1[10], s1[11]); w.z = pk2(s1[12], s1[13]); w.w = pk2(s1[14], s1[15]); pf[3] = __builtin_bit_cast(bf16x8, w); }
    const int g = lane >> 4, q4 = (lane & 15) >> 2, p = lane & 3;
    const LAS unsigned char* vp = Vl + (size_t)(jk + 4 * hi + q4) * RSV + (16 * (g & 1) + 4 * p) * 2;
#pragma unroll
    for (int db = 0; db < DH / 32; ++db)
#pragma unroll
        for (int kk = 0; kk < 4; ++kk) {
            const s16x4 lo = __builtin_bit_cast(s16x4, __builtin_amdgcn_ds_read_tr16_b64_v4i16((LAS s16x4*)(vp + (size_t)(16 * kk) * RSV + 64 * db)));
            const s16x4 h4 = __builtin_bit_cast(s16x4, __builtin_amdgcn_ds_read_tr16_b64_v4i16((LAS s16x4*)(vp + (size_t)(16 * kk + 8) * RSV + 64 * db)));
            const bf16x8 vf = (bf16x8){lo[0], lo[1], lo[2], lo[3], h4[0], h4[1], h4[2], h4[3]};
            o[db] = __builtin_amdgcn_mfma_f32_32x32x16_bf16(vf, pf[kk], o[db], 0, 0, 0);
        }
}
template <int DH>
__device__ __forceinline__ void load_q(const bf16* qrow, const float* gq, float scale, bf16x8 (&qf)[DH / 16], int lane) {
    const int hi = lane >> 5;
    u32x4 w[DH / 16]; float ss = 0.f;
#pragma unroll
    for (int ks = 0; ks < DH / 16; ++ks) { w[ks] = *(const u32x4*)(qrow + 16 * ks + 8 * hi); float v[8]; unpack8(w[ks], v);
#pragma unroll
        for (int j = 0; j < 8; ++j) ss += v[j] * v[j]; }
    ss += __shfl_xor(ss, 32);
    const float rstd = __builtin_amdgcn_rsqf(ss * (1.0f / DH) + EPS) * scale;
#pragma unroll
    for (int ks = 0; ks < DH / 16; ++ks) { float v[8]; unpack8(w[ks], v);
        const f32x4 g0 = *(const f32x4*)(gq + 16 * ks + 8 * hi), g1 = *(const f32x4*)(gq + 16 * ks + 8 * hi + 4);
#pragma unroll
        for (int j = 0; j < 4; ++j) { v[j] *= rstd * g0[j]; v[4 + j] *= rstd * g1[j]; }
        qf[ks] = __builtin_bit_cast(bf16x8, pack8(v)); }
}
template <int DH>
__device__ __forceinline__ void store_o(bf16* yrow, const f32x16 (&o)[DH / 32], float l, int lane) {
    const int hi = lane >> 5;
    const float inv = frcp(l + __shfl_xor(l, 32));
#pragma unroll
    for (int db = 0; db < DH / 32; ++db)
#pragma unroll
        for (int g4 = 0; g4 < 4; ++g4) { u32x2 w; w.x = pk2(o[db][4 * g4] * inv, o[db][4 * g4 + 1] * inv); w.y = pk2(o[db][4 * g4 + 2] * inv, o[db][4 * g4 + 3] * inv);
            *(u32x2*)(yrow + 32 * db + 8 * g4 + 4 * hi) = w; }
}
template <int DH, int RSK, int RSV>
__device__ __forceinline__ void stage_kv(LAS unsigned char* Kl, LAS unsigned char* Vl, int ldsrow0, const bf16* src, size_t pitch, int kcol, int vcol, int nrows, const float* gk, int tid) {
    constexpr int CPR = DH / 8;
    for (int c = tid; c < nrows * CPR; c += 512) {
        const int row = c / CPR, ch = c % CPR;
        const bf16* rp = src + (size_t)row * pitch;
        const u32x4 kw = *(const u32x4*)(rp + kcol + ch * 8), vw = *(const u32x4*)(rp + vcol + ch * 8);
        float v[8]; unpack8(kw, v); float ss = 0.f;
#pragma unroll
        for (int j = 0; j < 8; ++j) ss += v[j] * v[j];
#pragma unroll
        for (int o = 1; o < CPR; o <<= 1) ss += __shfl_xor(ss, o);
        const float rstd = __builtin_amdgcn_rsqf(ss * (1.0f / DH) + EPS);
        const f32x4 g0 = *(const f32x4*)(gk + ch * 8), g1 = *(const f32x4*)(gk + ch * 8 + 4);
#pragma unroll
        for (int j = 0; j < 4; ++j) { v[j] *= rstd * g0[j]; v[4 + j] *= rstd * g1[j]; }
        *(LAS u32x4*)(Kl + (size_t)(ldsrow0 + row) * RSK + ch * 16) = pack8(v);
        *(LAS u32x4*)(Vl + (size_t)(ldsrow0 + row) * RSV + ch * 16) = vw;
    }
}

constexpr int NWAVES = 8;
constexpr size_t MiB = 1u << 20;
constexpr size_t WS_CTL = 0, CTL_ZERO_BYTES = 1 * MiB;
constexpr size_t WS_WIN = 2 * MiB;
constexpr size_t WS_WBR = 15 * MiB;
constexpr size_t WS_WOUT = 18 * MiB;
constexpr size_t WS_WUP = 20 * MiB;
constexpr size_t WS_WDN = 31 * MiB;
constexpr size_t WS_WKV = 37 * MiB;
constexpr size_t WS_MEMN = 39 * MiB;
constexpr size_t WS_KV = 41 * MiB;
constexpr size_t WS_BT = 43 * MiB;
constexpr size_t WS_BA = 45 * MiB;
constexpr size_t WS_SSQ = 49 * MiB;
constexpr size_t WS_P = 52 * MiB;
constexpr size_t WS_UE = 452 * MiB;
constexpr size_t WS_END = 512 * MiB;
static_assert(WS_P + (size_t)M * PLD * 2 == WS_UE && WS_UE + (size_t)512 * 4 * NUP * 4 <= WS_END, "d_ws map");

constexpr int CW_TMO = 0, CW_CODE = 1;
constexpr int CW_BAR = 4096;
constexpr int RING_OFF = 0, RING_BYTES = 131072;
constexpr int LDSCTL_OFF = RING_BYTES, MISC_OFF = LDSCTL_OFF + 320;
constexpr int LDS_BYTES = 147456;

typedef GAS unsigned gu32;
#define RLX_AGENT __ATOMIC_RELAXED, __HIP_MEMORY_SCOPE_AGENT
#define LDS_WAIT() asm volatile("s_waitcnt lgkmcnt(0)" ::: "memory")
#define VM_WAIT() asm volatile("s_waitcnt vmcnt(0)" ::: "memory")

#define XB_TMO      128
#define XB_XCNT(j)  (256  + 64 * (j))
#define XB_XSUB(j)  (1280 + 64 * (j))
#define XB_XGEN(j)  (2304 + 64 * (j))
#define XB_TOP      3328
#define XB_TOPGEN   3392
#define XCD_BAR_WORDS 3456
#define XB_SPIN_CAP (1u << 22)

__device__ __forceinline__ unsigned xb_ld(unsigned* p)              { return __hip_atomic_load(p, __ATOMIC_RELAXED, __HIP_MEMORY_SCOPE_AGENT); }
__device__ __forceinline__ unsigned xb_add(unsigned* p, unsigned v) { return __hip_atomic_fetch_add(p, v, __ATOMIC_RELAXED, __HIP_MEMORY_SCOPE_AGENT); }
__device__ __forceinline__ unsigned xb_xcc_id() { return (unsigned)__builtin_amdgcn_s_getreg((3 << 11) | 20) & 0xFu; }
#define XB_SPIN(cond, bar) do { unsigned _sp = 0; while (cond) { __builtin_amdgcn_s_sleep(1); \
    if ((++_sp & 255u) == 0u) { if (xb_ld(&(bar)[XB_TMO])) break; if (_sp > XB_SPIN_CAP) { atomicAdd(&(bar)[XB_TMO], 1u); break; } } } } while (0)

struct XcdBarrier { unsigned* bar; unsigned x; volatile LAS unsigned* st; };

__device__ __forceinline__ XcdBarrier xcd_barrier_post(unsigned* bar, volatile LAS unsigned* st) {
    XcdBarrier b; b.bar = bar; b.x = xb_xcc_id(); b.st = st;
    if (threadIdx.x == 0) (void)xb_add(&bar[XB_XCNT(b.x)], 1u);
    return b;
}
__device__ __forceinline__ void xcd_barrier_complete(unsigned* bar, unsigned x, unsigned& nloc, unsigned& nx) {
    const unsigned G = gridDim.x * gridDim.y * gridDim.z;
    unsigned sum, cnt, mine, sp = 0u;
    for (;;) {
        sum = 0u; cnt = 0u; mine = 0u;
#pragma unroll
        for (unsigned j = 0; j < 16; ++j) { const unsigned c = xb_ld(&bar[XB_XCNT(j)]); sum += c; cnt += (c > 0u) ? 1u : 0u; mine = (j == x) ? c : mine; }
        if (sum == G) break;
        __builtin_amdgcn_s_sleep(1);
        if ((++sp & 255u) == 0u) { if (xb_ld(&bar[XB_TMO])) break; if (sp > XB_SPIN_CAP) { atomicAdd(&bar[XB_TMO], 1u); break; } }
    }
    nloc = mine > 0u ? mine : 1u; nx = cnt > 0u ? cnt : 1u;
}
__device__ __forceinline__ void xcd_barrier(const XcdBarrier& b) {
    asm volatile("s_waitcnt vmcnt(0)" ::: "memory");
    __syncthreads();
    if (threadIdx.x == 0) {
        unsigned* bar = b.bar;
        __builtin_amdgcn_s_waitcnt(0);
        unsigned nloc = b.st[0], nx = b.st[1];
        if (nloc == 0u) { xcd_barrier_complete(bar, b.x, nloc, nx); b.st[0] = nloc; b.st[1] = nx; }
        const unsigned old = xb_add(&bar[XB_XSUB(b.x)], 1u);
        const unsigned gen = old / nloc;
        if (old + 1u == (gen + 1u) * nloc) {
            __builtin_amdgcn_fence(__ATOMIC_RELEASE, "agent");
            asm volatile("s_waitcnt vmcnt(0)" ::: "memory");
            const unsigned og = xb_add(&bar[XB_TOP], 1u);
            const unsigned tg = og / nx;
            if (og + 1u == (tg + 1u) * nx) xb_add(&bar[XB_TOPGEN], 1u);
            else XB_SPIN(xb_ld(&bar[XB_TOPGEN]) == tg, bar);
            __builtin_amdgcn_fence(__ATOMIC_ACQUIRE, "agent");
            xb_add(&bar[XB_XGEN(b.x)], 1u);
            asm volatile("s_waitcnt vmcnt(0)" ::: "memory");
        } else {
            XB_SPIN(xb_ld(&bar[XB_XGEN(b.x)]) == gen, bar);
            __builtin_amdgcn_fence(__ATOMIC_ACQUIRE, "agent");
            asm volatile("s_waitcnt vmcnt(0)" ::: "memory");
        }
    }
    __syncthreads();
}

struct Frame {
    LAS unsigned char* lds;
    volatile LAS unsigned* MISC;
    gu32* ctl;
    int tid, lane, wave, vcu, G;
};

__device__ __forceinline__ float wave_sum(float v) {
#pragma unroll
    for (int o = 1; o < 64; o <<= 1) v += __shfl_xor(v, o);
    return v;
}
__device__ __forceinline__ int t5_bucket(int rel) {
    const int n = rel < 0 ? -rel : rel;
    const int mag = n < 8 ? n : n < 12 ? 8 : n < 16 ? 9 : n < 23 ? 10 : n < 32 ? 11 : n < 46 ? 12 : n < 64 ? 13 : n < 91 ? 14 : 15;
    return (rel > 0 ? 16 : 0) + mag;
}

__device__ __forceinline__ void transpose_item(const float* W, int K, int N, int k0, int n0, bf16* WT, int drow0, const float* gk, LAS float* scr, int lane) {
#pragma unroll 8
    for (int i = 0; i < 32; ++i) { const int kk = 2 * i + (lane >> 5); float v = W[(size_t)(k0 + kk) * N + n0 + (lane & 31)]; if (gk) v *= gk[k0 + kk]; scr[kk * 33 + (lane & 31)] = v; }
    LDS_WAIT(); asm volatile("" ::: "memory");
    const int c = lane & 7;
#pragma unroll
    for (int j = 0; j < 4; ++j) { const int n = (lane >> 3) + 8 * j; const LAS float* s = scr + (8 * c) * 33 + n;
        u32x4 o; o.x = pk2(s[0 * 33], s[1 * 33]); o.y = pk2(s[2 * 33], s[3 * 33]); o.z = pk2(s[4 * 33], s[5 * 33]); o.w = pk2(s[6 * 33], s[7 * 33]);
        *(GAS u32x4*)(WT + (size_t)(drow0 + n) * K + k0 + 8 * c) = o; }
    LDS_WAIT(); asm volatile("" ::: "memory");
}
__device__ __forceinline__ void rms_row_to_bf16(const float* xrow, const float* g, bf16* orow, int lane) {
    const GAS f32x4* xr = (const GAS f32x4*)xrow + lane;
    const GAS f32x4* gr = (const GAS f32x4*)g + lane;
    f32x4 v[4]; float s = 0.f;
#pragma unroll
    for (int j = 0; j < 4; ++j) { v[j] = xr[64 * j]; s += (v[j].x * v[j].x + v[j].y * v[j].y) + (v[j].z * v[j].z + v[j].w * v[j].w); }
    const float rstd = __builtin_amdgcn_rsqf(wave_sum(s) * (1.f / DM) + EPS);
    GAS unsigned long long* o8 = (GAS unsigned long long*)orow + lane;
#pragma unroll
    for (int j = 0; j < 4; ++j) { const f32x4 gg = gr[64 * j];
        o8[64 * j] = (unsigned long long)pk2(v[j].x * rstd * gg.x, v[j].y * rstd * gg.y) | ((unsigned long long)pk2(v[j].z * rstd * gg.z, v[j].w * rstd * gg.w) << 32); }
}

struct Args { const float* in[25]; float* out; unsigned char* ws; int ph_lo, ph_hi; };

__device__ __forceinline__ void p0_prologue(Frame& F, const Args& a) {
    unsigned char* ws = a.ws;
    LAS float* scr = (LAS float*)(F.lds + RING_OFF + F.wave * 16384);
    const int gw = F.vcu * NWAVES + F.wave, NGW = F.G * NWAVES;
    constexpr int I_IN = 16 * 201, I_BR = 8 * 32, I_OUT = 16 * 32, I_UP = 16 * 176, I_DN = 44 * 32, I_KV = 16 * 32;
    constexpr int NITEMS = I_IN + 3 * I_BR + I_OUT + I_UP + I_DN + I_KV;
    for (int it = gw; it < NITEMS; it += NGW) {
        int r = it;
        if (r < I_IN) { const int kb = r / 201, nb = r % 201, n0 = nb * 32;
            const int d0 = n0 < 2816 ? n0 : (n0 < 2848 ? 3328 + (n0 - 2816) : (n0 < 3360 ? n0 - 32 : 3584 + (n0 - 3360)));
            transpose_item(a.in[4], 1024, 6432, kb * 64, n0, (bf16*)(ws + WS_WIN), d0, nullptr, scr, F.lane); continue; }
        r -= I_IN;
        if (r < 3 * I_BR) { const int br = r / I_BR, q = r % I_BR, kb = q / 32, nb = q % 32;
            transpose_item(a.in[16 + br], 512, 1024, kb * 64, nb * 32, (bf16*)(ws + WS_WBR) + (size_t)br * 1024 * 512, nb * 32, nullptr, scr, F.lane); continue; }
        r -= 3 * I_BR;
        if (r < I_OUT) { const int kb = r / 32, nb = r % 32;
            transpose_item(a.in[19], 1024, 1024, kb * 64, nb * 32, (bf16*)(ws + WS_WOUT), nb * 32, nullptr, scr, F.lane); continue; }
        r -= I_OUT;
        if (r < I_UP) { const int kb = r / 176, nb = r % 176, n0 = nb * 32;
            const int isv = n0 >= DFF, nn = isv ? n0 - DFF : n0, d0 = (nn >> 7) * 256 + isv * 128 + (nn & 127);
            transpose_item(a.in[21], 1024, NUP, kb * 64, n0, (bf16*)(ws + WS_WUP), d0, a.in[20], scr, F.lane); continue; }
        r -= I_UP;
        if (r < I_DN) { const int kb = r / 32, nb = r % 32;
            transpose_item(a.in[24], DFF, 1024, kb * 64, nb * 32, (bf16*)(ws + WS_WDN), nb * 32, nullptr, scr, F.lane); continue; }
        r -= I_DN;
        { const int kb = r / 32, nb = r % 32;
            transpose_item(a.in[13], 1024, 1024, kb * 64, nb * 32, (bf16*)(ws + WS_WKV), nb * 32, nullptr, scr, F.lane); }
    }
    { u32x4* z = (u32x4*)((bf16*)(ws + WS_WIN) + (size_t)3360 * 1024); const int n16 = 224 * 1024 * 2 / 16;
      for (int i = blockIdx.x * 512 + F.tid; i < n16; i += F.G * 512) z[i] = (u32x4){0u, 0u, 0u, 0u}; }
    bf16* H = (bf16*)a.out;
    for (int m = gw; m < M; m += NGW) rms_row_to_bf16(a.in[0] + (size_t)m * DM, a.in[3], H + (size_t)m * DM, F.lane);
    for (int m = gw; m < BATCH * NMEM; m += NGW) rms_row_to_bf16(a.in[1] + (size_t)m * DM, a.in[12], (bf16*)(ws + WS_MEMN) + (size_t)m * DM, F.lane);
    { float* BT = (float*)(ws + WS_BT); const float* tab = a.in[2];
      for (int i = blockIdx.x * 512 + F.tid; i < 8 * 128 * 384; i += F.G * 512) { const int j = i % 384, t = (i / 384) % 128, h = i / (384 * 128);
          const int rel = j - 128 - t; const bool ok = rel >= -128 && rel <= 128;
          BT[i] = ok ? tab[t5_bucket(rel) * 8 + h] * LOG2E : -INFINITY; } }
}

__device__ __forceinline__ void attnA_unit(Frame& F, const Args& a, int b, int n, int kvh) {
    constexpr int RSK = 144, RSV = 128;
    LAS unsigned char* Kl = F.lds; LAS unsigned char* Vl = F.lds + 384 * RSK;
    bf16* P = (bf16*)(a.ws + WS_P);
    const float* BT = (const float*)(a.ws + WS_BT);
    for (int blk = 0; blk < 3; ++blk) { const int pos0 = n * 128 - 128 + blk * 128; if (pos0 < 0 || pos0 >= SEQ) continue;
        stage_kv<64, RSK, RSV>(Kl, Vl, blk * 128, P + (size_t)(b * SEQ + pos0) * PLD, PLD, C_AK + kvh * 64, C_AV + kvh * 64, 128, a.in[6], F.tid); }
    LDS_WAIT(); __syncthreads();
    const int h = kvh * 4 + (F.wave >> 1), r32 = F.lane & 31, hi = F.lane >> 5;
    const float sink = a.in[7][h] * LOG2E;
#pragma unroll 1
    for (int qb = 0; qb < 2; ++qb) {
        const int t0 = (F.wave & 1) * 64 + qb * 32, t = t0 + r32;
        bf16* qrow = P + (size_t)(b * SEQ + n * 128 + t) * PLD + C_AQ + h * 64;
        bf16x8 qf[4]; load_q<64>(qrow, a.in[5], 0.125f * LOG2E, qf, F.lane);
        float m = sink, l = hi == 0 ? 1.f : 0.f; f32x16 o[2];
#pragma unroll
        for (int r = 0; r < 16; ++r) { o[0][r] = 0.f; o[1][r] = 0.f; }
#pragma unroll 1
        for (int kt = 0; kt < 6; ++kt) { const int j0 = 64 * kt, pos0 = n * 128 - 128 + (kt >> 1) * 128;
            if (pos0 < 0 || pos0 >= SEQ) continue;
            if (j0 + 63 < t0 || j0 > t0 + 31 + 256) continue;
            attn_tile<64, RSK, RSV, true>(Kl, Vl, j0, qf, BT + ((size_t)h * 128 + t) * 384 + j0, m, l, o, F.lane); }
        store_o<64>(qrow, o, l, F.lane);
    }
    LDS_WAIT(); __syncthreads();
}
__device__ __forceinline__ void xattn_unit(Frame& F, const Args& a, int b, int tb, int h) {
    constexpr int RSK = 272, RSV = 320;
    LAS unsigned char* Kl = F.lds; LAS unsigned char* Vl = F.lds + 128 * RSK;
    bf16* P = (bf16*)(a.ws + WS_P);
    const bf16* KV = (const bf16*)(a.ws + WS_KV);
    const int r32 = F.lane & 31;
    bf16* qrow = P + (size_t)(b * SEQ + tb * 256 + F.wave * 32 + r32) * PLD + C_MQ + h * 128;
    bf16x8 qf[8]; load_q<128>(qrow, a.in[14], 0.08838834764831845f * LOG2E, qf, F.lane);
    float m = -1e30f, l = 0.f; f32x16 o[4];
#pragma unroll
    for (int db = 0; db < 4; ++db)
#pragma unroll
        for (int r = 0; r < 16; ++r) o[db][r] = 0.f;
#pragma unroll 1
    for (int half = 0; half < 2; ++half) {
        stage_kv<128, RSK, RSV>(Kl, Vl, 0, KV + (size_t)(b * NMEM + half * 128) * 1024, 1024, h * 128, 512 + h * 128, 128, a.in[15], F.tid);
        LDS_WAIT(); __syncthreads();
#pragma unroll 1
        for (int kt = 0; kt < 2; ++kt) attn_tile<128, RSK, RSV, false>(Kl, Vl, 64 * kt, qf, nullptr, m, l, o, F.lane);
        LDS_WAIT(); __syncthreads();
    }
    store_o<128>(qrow, o, l, F.lane);
}


constexpr int SQ = C_GATE, SK = C_GATE + 512, SWF = C_GATE + 1024, SUF = C_GATE + 1536, SWB = C_GATE + 2048, SUB = C_GATE + 2560;
constexpr int C_OF = C_DQ, C_OB = C_DK;
__device__ __forceinline__ void dn_solve(const LAS float* L, float (&x)[64]) {
#pragma unroll
    for (int p = 1; p < 64; ++p) {
        float a0 = x[p], a1 = 0.f, a2 = 0.f, a3 = 0.f;
#pragma unroll
        for (int j = 0; j < (p + 3) / 4; ++j) { const f32x4 l = *(const LAS f32x4*)(L + p * 64 + 4 * j);
            a0 -= l[0] * x[4 * j]; a1 -= l[1] * x[4 * j + 1]; a2 -= l[2] * x[4 * j + 2]; a3 -= l[3] * x[4 * j + 3]; }
        x[p] = (a0 + a1) + (a2 + a3);
    }
}
__device__ __forceinline__ void dn_prep_unit(Frame& F, const Args& a, int b, int h, int c) {
    LAS float* raw = (LAS float*)(F.lds);
    LAS float* KK = (LAS float*)(F.lds);
    LAS float* QKm = (LAS float*)(F.lds + 16384);
    LAS float* Lm = (LAS float*)(F.lds + 32768);
    LAS float* qs = (LAS float*)(F.lds + 65536);
    LAS float* ks = (LAS float*)(F.lds + 81920);
    LAS float* vs = (LAS float*)(F.lds + 98304);
    LAS float* gt = (LAS float*)(F.lds + 114688);
    LAS float* btk = gt + 128;
    LAS float* gcl = gt + 256;
    LAS float* btp = gt + 384;
    bf16* P = (bf16*)(a.ws + WS_P);
    const float* BA = (const float*)(a.ws + WS_BA);
    float* GC = (float*)(a.ws + WS_SSQ);
    bf16* QKB = (bf16*)a.out + (size_t)M * 1024;
    const float* cw = a.in[8];
    const int w = F.wave, lane = F.lane, tid = F.tid, t0 = c * 64;
    const size_t tok0 = (size_t)b * SEQ + t0;
    for (int e = tid; e < 68 * 24; e += 512) { const int row = e / 24, c8 = e % 24, which = c8 >> 3, t = t0 - 2 + row;
        float v[8];
        if (t >= 0 && t < SEQ) { const int col = (which == 0 ? C_DQ : which == 1 ? C_DK : C_DV) + h * 64 + (c8 & 7) * 8;
            unpack8(*(const u32x4*)(P + ((size_t)b * SEQ + t) * PLD + col), v); }
        else {
#pragma unroll
            for (int j = 0; j < 8; ++j) v[j] = 0.f; }
#pragma unroll
        for (int j = 0; j < 8; ++j) raw[row * 192 + c8 * 8 + j] = v[j]; }
    if (tid < 128) { const int d = tid >> 6, i = tid & 63; const size_t tok = tok0 + i;
        const float Ah = expf(a.in[9][d * 8 + h]), dtb = a.in[10][d * 8 + h];
        const float xa = BA[tok * 32 + 16 + d * 8 + h] + dtb;
        gt[d * 64 + i] = -Ah * (fmaxf(xa, 0.f) + log1pf(expf(-fabsf(xa))));
        btk[d * 64 + i] = sigmoidf_(BA[tok * 32 + d * 8 + h]); }
    LDS_WAIT(); __syncthreads();
    for (int e = tid; e < 64 * 192; e += 512) { const int row = e / 192, ch = e % 192, which = ch >> 6, d = ch & 63;
        const int cg = which * 512 + h * 64 + d; float acc = 0.f;
#pragma unroll
        for (int j = 0; j < 5; ++j) acc += raw[(row + j) * 192 + ch] * cw[j * 1536 + cg];
        (which == 0 ? qs : which == 1 ? ks : vs)[row * 64 + d] = siluf_(acc); }
    if (w < 2) { const int i = w ? 63 - lane : lane; float gv = gt[w * 64 + i];
#pragma unroll
        for (int o = 1; o < 64; o <<= 1) { const float t = __shfl_up(gv, o); if (lane >= o) gv += t; }
        gcl[w * 64 + lane] = gv; btp[w * 64 + lane] = btk[w * 64 + i];
        GC[(tok0 + lane) * 16 + w * 8 + h] = gv; }
    LDS_WAIT(); __syncthreads();
    for (int rv = w * 16; rv < w * 16 + 16; ++rv) { LAS float* mat = rv < 64 ? qs : ks; const int row = rv & 63;
        const float xv = mat[row * 64 + lane]; const float ss = wave_sum(xv * xv);
        mat[row * 64 + lane] = xv * __builtin_amdgcn_rsqf(ss + EPS) * (rv < 64 ? 0.125f : 1.0f); }
    LDS_WAIT(); __syncthreads();
    { const int row = tid >> 3, c8 = (tid & 7) * 8; float v[8];
#pragma unroll
      for (int j = 0; j < 8; ++j) v[j] = qs[row * 64 + c8 + j];
      *(u32x4*)(P + (tok0 + row) * PLD + SQ + h * 64 + c8) = pack8(v);
#pragma unroll
      for (int j = 0; j < 8; ++j) v[j] = ks[row * 64 + c8 + j];
      *(u32x4*)(P + (tok0 + row) * PLD + SK + h * 64 + c8) = pack8(v); }
    { const int wq = w & 3, tm = wq >> 1, tn = wq & 1, r32 = lane & 31, hi = lane >> 5;
      const LAS float* X = (w < 4) ? ks : qs; LAS float* D = (w < 4) ? KK : QKm;
      f32x16 acc;
#pragma unroll
      for (int r = 0; r < 16; ++r) acc[r] = 0.f;
#pragma unroll
      for (int kst = 0; kst < 4; ++kst) { float va[8], vb[8];
          const LAS float* ap = X + (32 * tm + r32) * 64 + 16 * kst + 8 * hi; const LAS float* bp = ks + (32 * tn + r32) * 64 + 16 * kst + 8 * hi;
#pragma unroll
          for (int j = 0; j < 8; ++j) { va[j] = ap[j]; vb[j] = bp[j]; }
          acc = __builtin_amdgcn_mfma_f32_32x32x16_bf16(__builtin_bit_cast(bf16x8, pack8(va)), __builtin_bit_cast(bf16x8, pack8(vb)), acc, 0, 0, 0); }
#pragma unroll
      for (int r = 0; r < 16; ++r) D[(32 * tm + (r & 3) + 8 * (r >> 2) + 4 * hi) * 64 + 32 * tn + r32] = acc[r]; }
    LDS_WAIT(); __syncthreads();
    for (int e = tid; e < 2 * 4096; e += 512) { const int d = e >> 12, p = (e >> 6) & 63, pp = e & 63, ip = d ? 63 - p : p, ipp = d ? 63 - pp : pp;
        const float dec = (pp <= p) ? __expf(gcl[d * 64 + p] - gcl[d * 64 + pp]) : 0.f;
        Lm[d * 4096 + p * 64 + pp] = (pp < p) ? btp[d * 64 + p] * KK[ip * 64 + ipp] * dec : 0.f;
        QKB[(size_t)d * M * 512 + (tok0 + p) * 512 + h * 64 + pp] = (bf16)(pk2(QKm[ip * 64 + ipp] * dec, 0.f) & 0xffffu); }
    LDS_WAIT(); __syncthreads();
    if (w < 4) { const int d = w >> 1, part = w & 1; float x[64];
#pragma unroll
        for (int p = 0; p < 64; ++p) { const int ip = d ? 63 - p : p;
            x[p] = part == 0 ? btp[d * 64 + p] * vs[ip * 64 + lane] : btp[d * 64 + p] * __expf(gcl[d * 64 + p]) * ks[ip * 64 + lane]; }
        dn_solve(Lm + d * 4096, x);
        if (part == 0) { bf16* up = P + (tok0 + lane) * PLD + (d ? SUB : SUF) + h * 64;
#pragma unroll
            for (int j = 0; j < 8; ++j) { float v[8];
#pragma unroll
                for (int i = 0; i < 8; ++i) v[i] = x[8 * j + i];
                *(u32x4*)(up + 8 * j) = pack8(v); } }
        else { bf16* wp = P + tok0 * PLD + (d ? SWB : SWF) + h * 64 + lane;
#pragma unroll
            for (int p = 0; p < 64; ++p) wp[(size_t)p * PLD] = (bf16)(pk2(-x[p], 0.f) & 0xffffu); }
    }
    LDS_WAIT(); __syncthreads();
}

constexpr int DNB_W = 0, DNB_Q = 9216, DNB_QK = 18432, DNB_UT = 27648, DNB_K = 36864, DNB_EG = 47104, DNB_SZ = 48128;
struct DnSet { u32x4 v[10]; float gcv, glast; };
__device__ __forceinline__ void dn_issue(DnSet& s, const Args& a, int b, int h, int dir, int n, int ht) {
    const bf16* P = (const bf16*)(a.ws + WS_P); const bf16* QKB = (const bf16*)a.out + (size_t)M * 1024 + (size_t)dir * M * 512;
    const float* GC = (const float*)(a.ws + WS_SSQ);
    const int c = dir ? 127 - n : n; const size_t tok0 = (size_t)b * SEQ + c * 64;
#pragma unroll
    for (int i = 0; i < 2; ++i) { const int idx = ht + 256 * i, row = idx >> 3, ch = idx & 7, frow = dir ? 63 - row : row;
        s.v[0 + i] = *(const u32x4*)(P + (tok0 + row) * PLD + (dir ? SWB : SWF) + h * 64 + ch * 8);
        s.v[2 + i] = *(const u32x4*)(P + (tok0 + frow) * PLD + SQ + h * 64 + ch * 8);
        s.v[4 + i] = *(const u32x4*)(QKB + (tok0 + row) * 512 + h * 64 + ch * 8);
        s.v[6 + i] = *(const u32x4*)(P + (tok0 + row) * PLD + (dir ? SUB : SUF) + h * 64 + ch * 8);
        s.v[8 + i] = *(const u32x4*)(P + (tok0 + frow) * PLD + SK + h * 64 + ch * 8); }
    s.gcv = GC[(tok0 + (ht & 63)) * 16 + dir * 8 + h]; s.glast = GC[(tok0 + 63) * 16 + dir * 8 + h];
}
__device__ __forceinline__ void dn_consume(const DnSet& s, LAS unsigned char* buf, int ht) {
#pragma unroll
    for (int i = 0; i < 2; ++i) { const int idx = ht + 256 * i, row = idx >> 3, ch = idx & 7;
        *(LAS u32x4*)(buf + DNB_W + row * 144 + ch * 16) = s.v[0 + i];
        *(LAS u32x4*)(buf + DNB_Q + row * 144 + ch * 16) = s.v[2 + i];
        *(LAS u32x4*)(buf + DNB_QK + row * 144 + ch * 16) = s.v[4 + i];
        *(LAS u32x4*)(buf + DNB_UT + row * 144 + ch * 16) = s.v[6 + i];
        *(LAS u32x4*)(buf + DNB_K + row * 160 + ch * 16) = s.v[8 + i]; }
    if (ht < 64) { LAS float* EG = (LAS float*)(buf + DNB_EG); EG[ht] = __expf(s.gcv); EG[64 + ht] = __expf(s.glast - s.gcv); if (ht == 0) EG[128] = __expf(s.glast); }
}
__device__ __forceinline__ bf16x8 pack_f4f4(const f32x4 a, const f32x4 b) { u32x4 w; w.x = pk2(a[0], a[1]); w.y = pk2(a[2], a[3]); w.z = pk2(b[0], b[1]); w.w = pk2(b[2], b[3]); return __builtin_bit_cast(bf16x8, w); }
__device__ __forceinline__ bf16x8 lds_frag2(const LAS unsigned char* p) { const u32x2 a0 = *(const LAS u32x2*)p, a1 = *(const LAS u32x2*)(p + 32); u32x4 w; w.x = a0.x; w.y = a0.y; w.z = a1.x; w.w = a1.y; return __builtin_bit_cast(bf16x8, w); }
__device__ __forceinline__ void dn_scan_step(const LAS unsigned char* buf, f32x4 (&Sacc)[4], int ws, int lane, bf16* Oout, int dir) {
    const int c = lane & 15, g = lane >> 4;
    const LAS float* EG = (const LAS float*)(buf + DNB_EG);
    bf16x8 Sb[2];
#pragma unroll
    for (int ks = 0; ks < 2; ++ks) Sb[ks] = pack_f4f4(Sacc[2 * ks], Sacc[2 * ks + 1]);
    f32x4 Vn[4], Oa[4];
#pragma unroll
    for (int mt = 0; mt < 4; ++mt) {
        const u32x2 uw = *(const LAS u32x2*)(buf + DNB_UT + (16 * ws + c) * 144 + (16 * mt + 4 * g) * 2);
        Vn[mt] = (f32x4){bf_lo(uw.x), bf_hi(uw.x), bf_lo(uw.y), bf_hi(uw.y)};
        Oa[mt] = (f32x4){0.f, 0.f, 0.f, 0.f};
#pragma unroll
        for (int ks = 0; ks < 2; ++ks) {
            const bf16x8 wf = lds_frag2(buf + DNB_W + (16 * mt + c) * 144 + (32 * ks + 4 * g) * 2);
            const bf16x8 qf = lds_frag2(buf + DNB_Q + (16 * mt + c) * 144 + (32 * ks + 4 * g) * 2);
            Vn[mt] = __builtin_amdgcn_mfma_f32_16x16x32_bf16(wf, Sb[ks], Vn[mt], 0, 0, 0);
            Oa[mt] = __builtin_amdgcn_mfma_f32_16x16x32_bf16(qf, Sb[ks], Oa[mt], 0, 0, 0); }
    }
#pragma unroll
    for (int mt = 0; mt < 4; ++mt) Oa[mt] *= *(const LAS f32x4*)(EG + 16 * mt + 4 * g);
    bf16x8 Vb[2], Vsb[2];
#pragma unroll
    for (int ks = 0; ks < 2; ++ks) { const f32x4 e0 = *(const LAS f32x4*)(EG + 64 + 32 * ks + 4 * g), e1 = *(const LAS f32x4*)(EG + 64 + 32 * ks + 16 + 4 * g);
        Vb[ks] = pack_f4f4(Vn[2 * ks], Vn[2 * ks + 1]); Vsb[ks] = pack_f4f4(Vn[2 * ks] * e0, Vn[2 * ks + 1] * e1); }
#pragma unroll
    for (int mt = 0; mt < 4; ++mt)
#pragma unroll
        for (int ks = 0; ks < 2; ++ks) { if (ks == 1 && mt < 2) continue;
            const bf16x8 af = lds_frag2(buf + DNB_QK + (16 * mt + c) * 144 + (32 * ks + 4 * g) * 2);
            Oa[mt] = __builtin_amdgcn_mfma_f32_16x16x32_bf16(af, Vb[ks], Oa[mt], 0, 0, 0); }
    const float gm = EG[128];
    const int q4 = (lane & 15) >> 2, pp = lane & 3;
#pragma unroll
    for (int mt = 0; mt < 4; ++mt) { Sacc[mt] *= gm;
#pragma unroll
        for (int ks = 0; ks < 2; ++ks) { const LAS unsigned char* kp = buf + DNB_K + (32 * ks + 4 * g + q4) * 160 + (16 * mt + 4 * pp) * 2;
            const s16x4 lo = __builtin_bit_cast(s16x4, __builtin_amdgcn_ds_read_tr16_b64_v4i16((LAS s16x4*)kp));
            const s16x4 h4 = __builtin_bit_cast(s16x4, __builtin_amdgcn_ds_read_tr16_b64_v4i16((LAS s16x4*)(kp + 16 * 160)));
            const bf16x8 kf = (bf16x8){lo[0], lo[1], lo[2], lo[3], h4[0], h4[1], h4[2], h4[3]};
            Sacc[mt] = __builtin_amdgcn_mfma_f32_16x16x32_bf16(kf, Vsb[ks], Sacc[mt], 0, 0, 0); } }
#pragma unroll
    for (int mt = 0; mt < 4; ++mt)
#pragma unroll
        for (int r = 0; r < 4; ++r) { const int p = 16 * mt + 4 * g + r, i = dir ? 63 - p : p;
            Oout[(size_t)i * PLD + c] = (bf16)(pk2(Oa[mt][r], 0.f) & 0xffffu); }
}
__device__ __forceinline__ void dn_scan_unit(Frame& F, const Args& a, int b, int h, int dir) {
    bf16* P = (bf16*)(a.ws + WS_P);
    const int w = F.wave, lane = F.lane, ht = F.tid - 256;
    f32x4 Sacc[4];
#pragma unroll
    for (int mt = 0; mt < 4; ++mt) Sacc[mt] = (f32x4){0.f, 0.f, 0.f, 0.f};
    DnSet sA, sB;
    if (w >= 4) { dn_issue(sA, a, b, h, dir, 0, ht); dn_issue(sB, a, b, h, dir, 1, ht);
        dn_consume(sA, F.lds, ht); dn_issue(sA, a, b, h, dir, 2, ht); }
    LDS_WAIT(); __syncthreads();
#pragma unroll 1
    for (int s = 0; s < 128; s += 2) {
        if (w < 4) { const int cc = dir ? 127 - s : s;
            dn_scan_step(F.lds, Sacc, w, lane, P + ((size_t)b * SEQ + cc * 64) * PLD + (dir ? C_OB : C_OF) + h * 64 + 16 * w, dir); }
        else { dn_consume(sB, F.lds + DNB_SZ, ht); if (s + 3 < 128) dn_issue(sB, a, b, h, dir, s + 3, ht); }
        LDS_WAIT(); __syncthreads();
        if (w < 4) { const int cc = dir ? 127 - (s + 1) : s + 1;
            dn_scan_step(F.lds + DNB_SZ, Sacc, w, lane, P + ((size_t)b * SEQ + cc * 64) * PLD + (dir ? C_OB : C_OF) + h * 64 + 16 * w, dir); }
        else { if (s + 2 < 128) { dn_consume(sA, F.lds, ht); if (s + 4 < 128) dn_issue(sA, a, b, h, dir, s + 4, ht); } }
        LDS_WAIT(); __syncthreads();
    }
}

__device__ __forceinline__ void dn_combine(Frame& F, const Args& a) {
    bf16* P = (bf16*)(a.ws + WS_P);
    const float* og = a.in[11];
    const int gw = F.vcu * NWAVES + F.wave, NGW = F.G * NWAVES, c0 = F.lane * 8;
    for (int row = gw; row < M; row += NGW) {
        bf16* rp = P + (size_t)row * PLD;
        float of[8], ob[8]; unpack8(*(const u32x4*)(rp + C_OF + c0), of); unpack8(*(const u32x4*)(rp + C_OB + c0), ob);
        float s[8], ss = 0.f;
#pragma unroll
        for (int j = 0; j < 8; ++j) { s[j] = of[j] + ob[j]; ss += s[j] * s[j]; }
        ss += __shfl_xor(ss, 1); ss += __shfl_xor(ss, 2); ss += __shfl_xor(ss, 4);
        const float rstd = __builtin_amdgcn_rsqf(ss * (1.0f / 64) + EPS);
        bf16* zp = rp + C_DZ + c0; float z[8]; unpack8(*(const u32x4*)zp, z);
        const f32x4 g0 = *(const f32x4*)(og + (c0 & 63)), g1 = *(const f32x4*)(og + (c0 & 63) + 4);
        float y[8];
#pragma unroll
        for (int j = 0; j < 4; ++j) { y[j] = s[j] * rstd * g0[j] * siluf_(z[j]); y[4 + j] = s[4 + j] * rstd * g1[j] * siluf_(z[4 + j]); }
        *(u32x4*)zp = pack8(y);
    }
}
__device__ __forceinline__ void ffn_fixup_panel(Frame& F, const Args& a, int pm) {
    bf16* P = (bf16*)(a.ws + WS_P); const float* UE = (const float*)(a.ws + WS_UE);
    const float* cw = a.in[22]; const float* cb = a.in[23];
    for (int e = F.tid; e < 8 * DFF; e += 512) { const int k = e / DFF, ch = e % DFF, g = pm * 4 + (k >> 1), last = k & 1;
        const int row = g * 64 + (last ? 63 : 0);
        const float* pu; const float* cu; const float* nu; bool hp = true, hn = true;
        if (!last) { hp = (row % SEQ) != 0; pu = UE + ((size_t)(g > 0 ? g - 1 : 0) * 4 + 3) * NUP; cu = UE + ((size_t)g * 4 + 0) * NUP; nu = UE + ((size_t)g * 4 + 1) * NUP; }
        else { hn = (row % SEQ) != SEQ - 1; pu = UE + ((size_t)g * 4 + 2) * NUP; cu = UE + ((size_t)g * 4 + 3) * NUP; nu = UE + ((size_t)(g < 511 ? g + 1 : 511) * 4 + 0) * NUP; }
        const float pg = hp ? pu[ch] : 0.f, pv = hp ? pu[DFF + ch] : 0.f, ng = hn ? nu[ch] : 0.f, nv = hn ? nu[DFF + ch] : 0.f;
        const float gate = cw[ch] * pg + cw[NUP + ch] * cu[ch] + cw[2 * NUP + ch] * ng + cb[ch];
        const float val = cw[DFF + ch] * pv + cw[NUP + DFF + ch] * cu[DFF + ch] + cw[2 * NUP + DFF + ch] * nv + cb[DFF + ch];
        P[(size_t)row * PLD + C_ACT + ch] = (bf16)(pk2(siluf_(gate) * val, 0.f) & 0xffffu); }
}

__global__ void __launch_bounds__(NWAVES * 64, 2) fwd_kernel(Args args) {
    extern __shared__ __attribute__((aligned(16))) unsigned char lds[];
    Frame F;
    F.lds = (LAS unsigned char*)lds;
    F.MISC = (volatile LAS unsigned*)(F.lds + MISC_OFF);
    F.tid = threadIdx.x; F.lane = F.tid & 63; F.wave = __builtin_amdgcn_readfirstlane(F.tid >> 6);
    F.G = gridDim.x; { const int bx = blockIdx.x; F.vcu = (F.G % 8 == 0) ? (bx % 8) * (F.G / 8) + bx / 8 : bx; }
    unsigned char* ws = args.ws;
    F.ctl = (gu32*)(ws + WS_CTL);
    for (int u = F.tid; u < (LDS_BYTES - LDSCTL_OFF) / 4; u += NWAVES * 64) ((LAS unsigned*)(F.lds + LDSCTL_OFF))[u] = 0u;
    __syncthreads();
    const int lo = args.ph_lo, hi = args.ph_hi;
    const bool single = (hi - lo) > 1;
    XcdBarrier bar; bar.bar = (unsigned*)(F.ctl + CW_BAR); bar.x = 0; bar.st = nullptr;
    if (single) bar = xcd_barrier_post((unsigned*)(F.ctl + CW_BAR), F.MISC + 8);
#ifndef PH_MASK
#define PH_MASK 0x1FF
#endif
#define IN(k) (((PH_MASK >> (k)) & 1) && lo <= (k) && (k) < hi)
#define SEAM(k) do { if (IN(k) && IN((k) + 1)) xcd_barrier(bar); } while (0)
    bf16* P = (bf16*)(ws + WS_P);
    const int bid = (int)blockIdx.x;

    if (IN(0)) { p0_prologue(F, args); }
    SEAM(0);
    if (IN(1)) {
        { pg8::Gemm g{(const bf16*)args.out, (const bf16*)(ws + WS_WIN), M, 3584, 1024, 1024, 1024}; pg8::StaticOrder S; S.init(M, 3584, F.G, bid);
          EpiInProj E{P, (float*)(ws + WS_BA)};
          pg8::gemm_phase<EpiInProj, pg8::StaticOrder, true, true>(F.lds + RING_OFF, g, S, E); }
        { pg8::Gemm g{(const bf16*)(ws + WS_MEMN), (const bf16*)(ws + WS_WKV), BATCH * NMEM, 1024, 1024, 1024, 1024}; pg8::StaticOrder S; S.init(BATCH * NMEM, 1024, F.G, bid);
          EpiBf16 E{(bf16*)(ws + WS_KV), 1024};
          pg8::gemm_phase<EpiBf16, pg8::StaticOrder, true, true>(F.lds + RING_OFF, g, S, E); }
    }
    SEAM(1);
    if (IN(2)) {
        for (int u = bid; u < 4096; u += F.G) dn_prep_unit(F, args, u >> 10, (u >> 7) & 7, u & 127);
    }
    SEAM(2);
    if (IN(3)) {
        const int ndn = F.G >= 128 ? 64 : 0;
        if (bid < ndn) { dn_scan_unit(F, args, bid >> 4, (bid >> 1) & 7, bid & 1); }
        else {
            if (ndn == 0) for (int u = bid; u < 64; u += F.G) dn_scan_unit(F, args, u >> 4, (u >> 1) & 7, u & 1);
            const int nb = F.G - ndn, me = bid - ndn;
            for (int u = me; u < 1024; u += nb) {
                if (u < 512) attnA_unit(F, args, u >> 7, (u >> 1) & 63, u & 1);
                else { const int v = u - 512; xattn_unit(F, args, v >> 7, (v >> 2) & 31, v & 3); }
            }
        }
    }
    SEAM(3);
    if (IN(4)) {
        dn_combine(F, args);
        pg8::Gemm g{(const bf16*)args.out, (const bf16*)(ws + WS_WIN) + (size_t)3584 * 1024, M, 3072, 1024, 1024, 1024}; pg8::StaticOrder S; S.init(M, 3072, F.G, bid);
        EpiBf16 E{P + C_GATE, PLD};
        pg8::gemm_phase<EpiBf16, pg8::StaticOrder, true, true>(F.lds + RING_OFF, g, S, E);
    }
    SEAM(4);
    if (IN(5)) {
        { pg8::Gemm g{P + C_AQ, (const bf16*)(ws + WS_WBR), M, 1024, 512, PLD, 512}; pg8::StaticOrder S; S.init(M, 1024, F.G, bid);
          EpiBranch<0> E{P}; pg8::gemm_phase<EpiBranch<0>, pg8::StaticOrder, true, true>(F.lds + RING_OFF, g, S, E); }
        VM_WAIT(); __syncthreads();
        { pg8::Gemm g{P + C_DZ, (const bf16*)(ws + WS_WBR) + (size_t)1024 * 512, M, 1024, 512, PLD, 512}; pg8::StaticOrder S; S.init(M, 1024, F.G, bid);
          EpiBranch<1> E{P}; pg8::gemm_phase<EpiBranch<1>, pg8::StaticOrder, true, true>(F.lds + RING_OFF, g, S, E); }
        VM_WAIT(); __syncthreads();
        { pg8::Gemm g{P + C_MQ, (const bf16*)(ws + WS_WBR) + (size_t)2 * 1024 * 512, M, 1024, 512, PLD, 512}; pg8::StaticOrder S; S.init(M, 1024, F.G, bid);
          EpiBranch<2> E{P}; pg8::gemm_phase<EpiBranch<2>, pg8::StaticOrder, true, true>(F.lds + RING_OFF, g, S, E); }
    }
    SEAM(5);
    if (IN(6)) {
        pg8::Gemm g{P + C_MG, (const bf16*)(ws + WS_WOUT), M, 1024, 1024, PLD, 1024}; pg8::StaticOrder S; S.init(M, 1024, F.G, bid);
        EpiWout E{args.in[0], args.out, P, (float*)(ws + WS_SSQ)};
        pg8::gemm_phase<EpiWout, pg8::StaticOrder, true, true>(F.lds + RING_OFF, g, S, E);
    }
    SEAM(6);
    if (IN(7)) {
        pg8::Gemm g{P + C_X1B, (const bf16*)(ws + WS_WUP), M, NUP, 1024, PLD, 1024}; pg8::StaticOrder S; S.init(M, NUP, F.G, bid);
        EpiUp E{(const float*)(ws + WS_SSQ), args.in[22], args.in[23], P, (float*)(ws + WS_UE)};
        pg8::gemm_phase<EpiUp, pg8::StaticOrder, true, true>(F.lds + RING_OFF, g, S, E);
    }
    SEAM(7);
    if (IN(8)) {
        pg8::Gemm g{P + C_ACT, (const bf16*)(ws + WS_WDN), M, 1024, DFF, PLD, DFF}; pg8::StaticOrder S; S.init(M, 1024, F.G, bid);
        { Unit u; int prev = -1; for (int i = 0; S.next(i, u); ++i) { if (u.pm != prev) ffn_fixup_panel(F, args, u.pm); prev = u.pm; } }
        VM_WAIT(); __syncthreads();
        EpiDown E{args.out};
        pg8::gemm_phase<EpiDown, pg8::StaticOrder, true, true>(F.lds + RING_OFF, g, S, E);
    }
#undef IN
#undef SEAM
}

constexpr int N_PHASES = 9;
#ifndef MK_PER_PHASE
#define MK_PER_PHASE 0
#endif
extern "C" void kernel_launch(void* const* d_in, const int* in_sizes, int n_in, void* d_out, int out_size, void* d_ws, size_t ws_size, hipStream_t stream) {
    static int grid = 0;
    if (grid == 0) {
        if (n_in != 25 || in_sizes[0] != M * DM || out_size != M * DM || ws_size < WS_END) {
            fprintf(stderr, "kernel_launch: unexpected shapes (n_in %d, in0 %d, out %d, ws %zu); nothing launched\n", n_in, n_in > 0 ? in_sizes[0] : -1, out_size, ws_size); grid = -1; return; }
        int dev = 0, cus = 0, per_cu = 0;
        if (hipGetDevice(&dev) != hipSuccess || hipDeviceGetAttribute(&cus, hipDeviceAttributeMultiprocessorCount, dev) != hipSuccess) { grid = -1; return; }
        if (hipFuncSetAttribute((const void*)fwd_kernel, hipFuncAttributeMaxDynamicSharedMemorySize, LDS_BYTES) != hipSuccess) { fprintf(stderr, "kernel_launch: hipFuncSetAttribute failed\n"); grid = -1; return; }
        if (hipOccupancyMaxActiveBlocksPerMultiprocessor(&per_cu, (const void*)fwd_kernel, NWAVES * 64, LDS_BYTES) != hipSuccess || per_cu < 1) { fprintf(stderr, "kernel_launch: occupancy query reports %d\n", per_cu); }
        (void)hipGetLastError();
        grid = cus;
    }
    if (grid < 0) return;
    if (hipMemsetAsync((char*)d_ws + WS_CTL, 0, CTL_ZERO_BYTES, stream) != hipSuccess) return;
    Args a{};
    for (int i = 0; i < 25; ++i) a.in[i] = (const float*)d_in[i];
    a.out = (float*)d_out; a.ws = (unsigned char*)d_ws;
    if (MK_PER_PHASE) {
        for (int p = 0; p < N_PHASES; ++p) { a.ph_lo = p; a.ph_hi = p + 1; hipLaunchKernelGGL(fwd_kernel, dim3(grid), dim3(NWAVES * 64), LDS_BYTES, stream, a); }
    } else {
        a.ph_lo = 0; a.ph_hi = N_PHASES; hipLaunchKernelGGL(fwd_kernel, dim3(grid), dim3(NWAVES * 64), LDS_BYTES, stream, a);
    }
}
```

```cpp
#include <hip/hip_runtime.h>
#include <cstdio>
#include <cstdint>
#include <cmath>
namespace pg8 {
#define PG8_LAS __attribute__((address_space(3)))
typedef unsigned short bf16_t;
typedef short bf16x8 __attribute__((ext_vector_type(8)));
typedef float f32x4 __attribute__((ext_vector_type(4)));
typedef unsigned u32x4 __attribute__((ext_vector_type(4)));
constexpr int BM = 256, BK = 64, HALF = 128, HTB = HALF * BK * 2  , STAGE_BYTES = 8 * HTB, NXCD = 8, WGM = 8;

__host__ __device__ __forceinline__ int lds_byte(int r, int c) { const int st = (r >> 4) * 2 + (c >> 5), rr = r & 15, cc = c & 31, ob = rr * 64 + cc * 2; return st * 1024 + (ob ^ (((ob >> 9) & 1) << 5)); }
__host__ __device__ __forceinline__ void stage_rc(int b, int& R, int& C) { const int st = b / 1024, sb = b % 1024, swz = sb ^ (((sb >> 9) & 1) << 5); R = (st >> 1) * 16 + swz / 64; C = (st & 1) * 32 + (swz % 64) / 2; }
__host__ __device__ __forceinline__ int perm32(int rho) { const int n = rho >> 4, i = rho & 15; return 8 * (i >> 2) + 4 * n + (i & 3); }

struct Unit { int pm, pn; };
struct Gemm { const bf16_t* A; const bf16_t* Bt; int M, N, K, lda, ldb; };

struct StaticOrder {
    int nM, nN, nwg, G, c;
    __host__ __device__ void init(int M, int N, int G_, int c_) { nM = M / BM; nN = N / BM; nwg = nM * nN; G = G_; c = c_; }
    __host__ __device__ bool next(int i, Unit& u) const {
        const long L = (long)i * G + c; if (L >= nwg) return false;
        int wgid = (int)L; { const int q = nwg / NXCD, r = nwg % NXCD, xcd = wgid % NXCD, off = wgid / NXCD; wgid = (xcd < r ? xcd * (q + 1) : r * (q + 1) + (xcd - r) * q) + off; }
        const int nig = WGM * nN, gid = wgid / nig, fm = gid * WGM, gsz = (nM - fm) < WGM ? (nM - fm) : WGM;
        u.pm = fm + ((wgid % nig) % gsz); u.pn = (wgid % nig) / gsz; return true;
    }
    __device__ __forceinline__ void a_ready(const Unit&) const {}
    __device__ __forceinline__ void done(const Unit&) const {}
};

template <class Epi, class Sched, bool ALIGN_EPI = false, bool SP2 = false>
__device__ __forceinline__ void gemm_phase(PG8_LAS unsigned char* lds, const Gemm g, const Sched& S, const Epi& E) {
    const int tid = threadIdx.x, wid = __builtin_amdgcn_readfirstlane(tid >> 6), lane = tid & 63, wr = wid >> 2, wc = wid & 3, fr = lane & 15, fq = lane >> 4;
    const int K = g.K, nt = K / BK;
    unsigned voffA[2], voffB[2];
#pragma unroll
    for (int i = 0; i < 2; ++i) { int R, C; stage_rc(tid * 16 + i * 8192, R, C); const int Rb = Epi::PERM ? ((R & ~31) + perm32(R & 31)) : R;
        voffA[i] = (unsigned)(R * g.lda + C) * 2u; voffB[i] = (unsigned)(Rb * g.ldb + C) * 2u; }
    const size_t kstep = (size_t)(BK * 2);
    const size_t hstepA = (size_t)HALF * g.lda * 2, hstepB = (size_t)HALF * g.ldb * 2;
    const size_t tstepA = 2 * hstepA, tstepB = 2 * hstepB;
    const unsigned ldsw = (unsigned)wid * 1024u;
    const int aoff = lds_byte(wr * 64 + fr, fq * 8), boff = lds_byte(wc * 32 + fr, fq * 8);
#define PG8_SA(b, h) (((b) * 2 + (h)) * HTB)
#define PG8_SB(b, h) ((4 + (b) * 2 + (h)) * HTB)
#define PG8_STAGE(bufoff, gbase, voff) do { _Pragma("unroll") for (int _i = 0; _i < 2; ++_i) \
        __builtin_amdgcn_global_load_lds((const unsigned*)((const char*)(gbase) + (voff)[_i]), (PG8_LAS unsigned*)(lds + (bufoff) + ldsw + _i * 8192), 16, 0, 0); } while (0)
#define PG8_LDA(dst, b, h) do { _Pragma("unroll") for (int m = 0; m < 4; ++m) _Pragma("unroll") for (int k = 0; k < 2; ++k) dst[m][k] = *(const PG8_LAS bf16x8*)(lds + PG8_SA(b, h) + aoff + m * 2048 + k * 1024); } while (0)
#define PG8_LDB(dst, b, h) do { _Pragma("unroll") for (int n = 0; n < 2; ++n) _Pragma("unroll") for (int k = 0; k < 2; ++k) dst[n][k] = *(const PG8_LAS bf16x8*)(lds + PG8_SB(b, h) + boff + n * 2048 + k * 1024); } while (0)
#define PG8_MMA(ai, bj, At, Bt) do { __builtin_amdgcn_s_setprio(1); _Pragma("unroll") for (int m = 0; m < 4; ++m) _Pragma("unroll") for (int n = 0; n < 2; ++n) _Pragma("unroll") for (int k = 0; k < 2; ++k) \
        acc[ai][bj][m][n] = __builtin_amdgcn_mfma_f32_16x16x32_bf16(Bt[n][k], At[m][k], acc[ai][bj][m][n], 0, 0, 0); __builtin_amdgcn_s_setprio(0); } while (0)
#define PG8_WAIT_V(n) asm volatile("s_waitcnt vmcnt(" #n ")" ::: "memory")
#define PG8_WAIT_L(n) asm volatile("s_waitcnt lgkmcnt(" #n ")" ::: "memory")
#define PG8_BAR __builtin_amdgcn_s_barrier()
#define PG8_SCHED __builtin_amdgcn_sched_barrier(0)
    Unit cur, nxt; int ui = 0;
    if (!S.next(0, cur)) return;
    f32x4 acc[2][2][4][2];
#pragma unroll
    for (int a = 0; a < 2; ++a)
#pragma unroll
        for (int b = 0; b < 2; ++b)
#pragma unroll
            for (int m = 0; m < 4; ++m)
#pragma unroll
                for (int n = 0; n < 2; ++n) acc[a][b][m][n] = (f32x4){0.f, 0.f, 0.f, 0.f};
    bf16x8 At[4][2], B0[2][2], B1[2][2];
    const char* cA = (const char*)g.A + (size_t)cur.pm * tstepA; const char* cB = (const char*)g.Bt + (size_t)cur.pn * tstepB;
    S.a_ready(cur);
    if constexpr (SP2) {
        PG8_STAGE(PG8_SB(0, 0), cB, voffB); PG8_STAGE(PG8_SB(0, 1), cB + hstepB, voffB); PG8_STAGE(PG8_SA(0, 0), cA, voffA); PG8_STAGE(PG8_SA(0, 1), cA + hstepA, voffA);
        if (wr == 1) PG8_BAR;
        PG8_WAIT_V(2); PG8_BAR;
        PG8_STAGE(PG8_SB(1, 0), cB + kstep, voffB); PG8_STAGE(PG8_SA(1, 0), cA + kstep, voffA); PG8_STAGE(PG8_SB(1, 1), cB + hstepB + kstep, voffB);
        PG8_WAIT_V(6); PG8_BAR;
    } else {
        PG8_STAGE(PG8_SB(0, 0), cB, voffB); PG8_STAGE(PG8_SA(0, 0), cA, voffA); PG8_STAGE(PG8_SB(0, 1), cB + hstepB, voffB); PG8_STAGE(PG8_SA(0, 1), cA + hstepA, voffA);
        if (wr == 1) PG8_BAR;
        PG8_WAIT_V(4); PG8_BAR;
        PG8_STAGE(PG8_SB(1, 0), cB + kstep, voffB); PG8_STAGE(PG8_SA(1, 0), cA + kstep, voffA); PG8_STAGE(PG8_SB(1, 1), cB + hstepB + kstep, voffB);
        PG8_WAIT_V(6); PG8_BAR;
    }
    for (;;) {
        const bool has_next = S.next(ui + 1, nxt);
        const char* nA = has_next ? (const char*)g.A + (size_t)nxt.pm * tstepA : cA; const char* nB = has_next ? (const char*)g.Bt + (size_t)nxt.pn * tstepB : cB;
        for (int t = 0; t < nt; t += 2) {
            const bool last = (t == nt - 2);
            const char* a1 = cA + (size_t)(t + 1) * kstep;
            const char* a2 = last ? nA : cA + (size_t)(t + 2) * kstep; const char* b2 = last ? nB : cB + (size_t)(t + 2) * kstep;
            const char* a3 = a2 + kstep; const char* b3 = b2 + kstep;
            if (last && has_next) S.a_ready(nxt);
            if constexpr (SP2) {
            PG8_LDB(B0, 0, 0); PG8_LDB(B1, 0, 1); PG8_SCHED; PG8_LDA(At, 0, 0); PG8_STAGE(PG8_SA(1, 1), a1 + hstepA, voffA);
            PG8_WAIT_V(8); PG8_WAIT_L(0); PG8_BAR; PG8_MMA(0, 0, At, B0); PG8_MMA(0, 1, At, B1); PG8_BAR; PG8_SCHED;
            PG8_LDA(At, 0, 1); PG8_STAGE(PG8_SB(0, 0), b2, voffB); PG8_STAGE(PG8_SB(0, 1), b2 + hstepB, voffB); PG8_STAGE(PG8_SA(0, 0), a2, voffA);
            PG8_WAIT_V(8); PG8_WAIT_L(0); PG8_BAR; PG8_MMA(1, 0, At, B0); PG8_MMA(1, 1, At, B1); PG8_BAR; PG8_SCHED;
            PG8_LDB(B0, 1, 0); PG8_LDB(B1, 1, 1); PG8_SCHED; PG8_LDA(At, 1, 0); PG8_STAGE(PG8_SA(0, 1), a2 + hstepA, voffA);
            PG8_WAIT_V(8); PG8_WAIT_L(0); PG8_BAR; PG8_MMA(0, 0, At, B0); PG8_MMA(0, 1, At, B1); PG8_BAR; PG8_SCHED;
            PG8_LDA(At, 1, 1); PG8_STAGE(PG8_SB(1, 0), b3, voffB); PG8_STAGE(PG8_SB(1, 1), b3 + hstepB, voffB); PG8_STAGE(PG8_SA(1, 0), a3, voffA);
            PG8_WAIT_V(8); PG8_WAIT_L(0); PG8_BAR; PG8_MMA(1, 0, At, B0); PG8_MMA(1, 1, At, B1); PG8_BAR; PG8_SCHED;
            } else {
            PG8_LDB(B0, 0, 0); PG8_SCHED; PG8_LDA(At, 0, 0); PG8_STAGE(PG8_SA(1, 1), a1 + hstepA, voffA);
            PG8_WAIT_L(8); PG8_BAR; PG8_WAIT_L(0); PG8_MMA(0, 0, At, B0); PG8_BAR; PG8_SCHED;
            PG8_LDB(B1, 0, 1); PG8_STAGE(PG8_SB(0, 0), b2, voffB);
            PG8_BAR; PG8_WAIT_L(0); PG8_MMA(0, 1, At, B1); PG8_BAR;
            PG8_LDA(At, 0, 1); PG8_STAGE(PG8_SA(0, 0), a2, voffA);
            PG8_BAR; PG8_WAIT_L(0); PG8_MMA(1, 0, At, B0); PG8_BAR; PG8_SCHED;
            PG8_STAGE(PG8_SB(0, 1), b2 + hstepB, voffB);
            PG8_WAIT_V(6); PG8_BAR; PG8_MMA(1, 1, At, B1); PG8_BAR;
            PG8_LDB(B0, 1, 0); PG8_SCHED; PG8_LDA(At, 1, 0); PG8_STAGE(PG8_SA(0, 1), a2 + hstepA, voffA);
            PG8_WAIT_L(8); PG8_BAR; PG8_WAIT_L(0); PG8_MMA(0, 0, At, B0); PG8_BAR; PG8_SCHED;
            PG8_LDB(B1, 1, 1); PG8_STAGE(PG8_SB(1, 0), b3, voffB);
            PG8_BAR; PG8_WAIT_L(0); PG8_MMA(0, 1, At, B1); PG8_BAR;
            PG8_LDA(At, 1, 1); PG8_STAGE(PG8_SA(1, 0), a3, voffA);
            PG8_BAR; PG8_WAIT_L(0); PG8_MMA(1, 0, At, B0); PG8_BAR; PG8_SCHED;
            PG8_STAGE(PG8_SB(1, 1), b3 + hstepB, voffB);
            PG8_WAIT_V(6); PG8_BAR; PG8_MMA(1, 1, At, B1); PG8_BAR;
            }
        }
        if constexpr (ALIGN_EPI) { if (wr == 0) PG8_BAR; }
        if constexpr (!Epi::AFTER_DRAIN) { E(acc, cur, wr, wc, fr, fq); S.done(cur); }
        if (!has_next) break;
#pragma unroll
        for (int a = 0; a < 2; ++a)
#pragma unroll
            for (int b = 0; b < 2; ++b)
#pragma unroll
                for (int m = 0; m < 4; ++m)
#pragma unroll
                    for (int n = 0; n < 2; ++n) acc[a][b][m][n] = (f32x4){0.f, 0.f, 0.f, 0.f};
        cur = nxt; cA = nA; cB = nB; ++ui;
        if constexpr (ALIGN_EPI) { if (wr == 1) PG8_BAR; }
    }
    PG8_WAIT_V(0);
    if constexpr (!ALIGN_EPI) { if (wr == 0) PG8_BAR; }
    PG8_BAR;
    if constexpr (Epi::AFTER_DRAIN) { E.fused(acc, cur, wr, wc, fr, fq, lds, wid, lane); S.done(cur); }
#undef PG8_SA
#undef PG8_SB
#undef PG8_STAGE
#undef PG8_LDA
#undef PG8_LDB
#undef PG8_MMA
#undef PG8_WAIT_V
#undef PG8_WAIT_L
#undef PG8_BAR
#undef PG8_SCHED
}
}

#define LAS __attribute__((address_space(3)))
#define GAS __attribute__((address_space(1)))
typedef unsigned short bf16;
typedef short bf16x8 __attribute__((ext_vector_type(8)));
typedef short s16x4 __attribute__((ext_vector_type(4)));
typedef float f32x4 __attribute__((ext_vector_type(4)));
typedef float f32x16 __attribute__((ext_vector_type(16)));
typedef unsigned u32x4 __attribute__((ext_vector_type(4)));
typedef unsigned u32x2 __attribute__((ext_vector_type(2)));
typedef float f32x2_t __attribute__((ext_vector_type(2)));
typedef __bf16 bf16x2_t __attribute__((ext_vector_type(2)));

constexpr int BATCH = 4, SEQ = 8192, DM = 1024, M = BATCH * SEQ;
constexpr int NMEM = 256;
constexpr int PLD = 6400;
constexpr int C_AQ = 0, C_AK = 512, C_AV = 640, C_DQ = 768, C_DK = 1280, C_DV = 1792, C_DZ = 2304, C_MQ = 2816, C_GATE = 3328;
constexpr int C_MG = 768, C_X1B = 1792, C_ACT = 2816;
constexpr int NIN = 6656;
constexpr int DFF = 2816, NUP = 5632;
constexpr float EPS = 1e-6f;
constexpr float LOG2E = 1.4426950408889634f;

__device__ __forceinline__ float bf_lo(unsigned w) { return __uint_as_float(w << 16); }
__device__ __forceinline__ float bf_hi(unsigned w) { return __uint_as_float(w & 0xffff0000u); }
__device__ __forceinline__ unsigned pk2(float lo, float hi) { f32x2_t v = {lo, hi}; bf16x2_t b = __builtin_convertvector(v, bf16x2_t); return __builtin_bit_cast(unsigned, b); }
__device__ __forceinline__ float fexp2(float x) { return __builtin_amdgcn_exp2f(x); }
__device__ __forceinline__ float frcp(float x) { return __builtin_amdgcn_rcpf(x); }
__device__ __forceinline__ float sigmoidf_(float x) { return frcp(1.0f + fexp2(-x * LOG2E)); }
__device__ __forceinline__ float siluf_(float x) { return x * sigmoidf_(x); }
__device__ __forceinline__ void unpack8(const u32x4 w, float (&v)[8]) {
    v[0] = bf_lo(w.x); v[1] = bf_hi(w.x); v[2] = bf_lo(w.y); v[3] = bf_hi(w.y); v[4] = bf_lo(w.z); v[5] = bf_hi(w.z); v[6] = bf_lo(w.w); v[7] = bf_hi(w.w); }
__device__ __forceinline__ u32x4 pack8(const float (&v)[8]) { u32x4 w; w.x = pk2(v[0], v[1]); w.y = pk2(v[2], v[3]); w.z = pk2(v[4], v[5]); w.w = pk2(v[6], v[7]); return w; }

using pg8::Unit;
constexpr int HALF = pg8::HALF, BM = pg8::BM;

struct EpiInProj {
    static constexpr bool PERM = true, AFTER_DRAIN = false;
    bf16* P; float* BA;
    __device__ __forceinline__ void operator()(const f32x4 (&acc)[2][2][4][2], const Unit& u, int wr, int wc, int fr, int fq) const {
        const int row0 = u.pm * BM + wr * 64 + fr;
        if (u.pn < 13) {
            const int col0 = u.pn * BM + wc * 32 + 8 * fq;
#pragma unroll
            for (int ai = 0; ai < 2; ++ai)
#pragma unroll
                for (int m = 0; m < 4; ++m) { bf16* rowp = P + (size_t)(row0 + ai * HALF + m * 16) * PLD + col0;
#pragma unroll
                    for (int bj = 0; bj < 2; ++bj) { const f32x4 v0 = acc[ai][bj][m][0], v1 = acc[ai][bj][m][1];
                        u32x4 w; w.x = pk2(v0[0], v0[1]); w.y = pk2(v0[2], v0[3]); w.z = pk2(v1[0], v1[1]); w.w = pk2(v1[2], v1[3]);
                        *(u32x4*)(rowp + bj * HALF) = w; } }
        } else if (wc == 0) {
#pragma unroll
            for (int ai = 0; ai < 2; ++ai)
#pragma unroll
                for (int m = 0; m < 4; ++m) { float* rp = BA + (size_t)(row0 + ai * HALF + m * 16) * 32 + 8 * fq;
                    *(f32x4*)rp = acc[ai][0][m][0]; *(f32x4*)(rp + 4) = acc[ai][0][m][1]; }
        }
    }
};
struct EpiBf16 {
    static constexpr bool PERM = true, AFTER_DRAIN = false;
    bf16* O; int ldc;
    __device__ __forceinline__ void operator()(const f32x4 (&acc)[2][2][4][2], const Unit& u, int wr, int wc, int fr, int fq) const {
        const int row0 = u.pm * BM + wr * 64 + fr, col0 = u.pn * BM + wc * 32 + 8 * fq;
#pragma unroll
        for (int ai = 0; ai < 2; ++ai)
#pragma unroll
            for (int m = 0; m < 4; ++m) { bf16* rowp = O + (size_t)(row0 + ai * HALF + m * 16) * ldc + col0;
#pragma unroll
                for (int bj = 0; bj < 2; ++bj) { const f32x4 v0 = acc[ai][bj][m][0], v1 = acc[ai][bj][m][1];
                    u32x4 w; w.x = pk2(v0[0], v0[1]); w.y = pk2(v0[2], v0[3]); w.z = pk2(v1[0], v1[1]); w.w = pk2(v1[2], v1[3]);
                    *(u32x4*)(rowp + bj * HALF) = w; } }
    }
};
template <int PASS> struct EpiBranch {
    static constexpr bool PERM = true, AFTER_DRAIN = false;
    bf16* P;
    __device__ __forceinline__ void operator()(const f32x4 (&acc)[2][2][4][2], const Unit& u, int wr, int wc, int fr, int fq) const {
        const int row0 = u.pm * BM + wr * 64 + fr, col0 = u.pn * BM + wc * 32 + 8 * fq;
#pragma unroll
        for (int ai = 0; ai < 2; ++ai)
#pragma unroll
            for (int m = 0; m < 4; ++m) { bf16* rowp = P + (size_t)(row0 + ai * HALF + m * 16) * PLD;
#pragma unroll
                for (int bj = 0; bj < 2; ++bj) {
                    const int c = col0 + bj * HALF;
                    const u32x4 gw = *(const u32x4*)(rowp + C_GATE + 1024 * PASS + c);
                    float g[8]; unpack8(gw, g);
                    float pv[8];
                    if (PASS > 0) { const u32x4 mw = *(const u32x4*)(rowp + C_MG + c); unpack8(mw, pv); }
                    else {
#pragma unroll
                        for (int i = 0; i < 8; ++i) pv[i] = 0.f; }
                    const f32x4 v0 = acc[ai][bj][m][0], v1 = acc[ai][bj][m][1];
                    float o[8];
#pragma unroll
                    for (int i = 0; i < 4; ++i) { o[i] = pv[i] + sigmoidf_(g[i]) * v0[i]; o[4 + i] = pv[4 + i] + sigmoidf_(g[4 + i]) * v1[i]; }
                    *(u32x4*)(rowp + C_MG + c) = pack8(o); } }
    }
};
struct EpiWout {
    static constexpr bool PERM = true, AFTER_DRAIN = false;
    const float* x; float* out; bf16* P; float* SSQ;
    __device__ __forceinline__ void operator()(const f32x4 (&acc)[2][2][4][2], const Unit& u, int wr, int wc, int fr, int fq) const {
        const int row0 = u.pm * BM + wr * 64 + fr, col0 = u.pn * BM + wc * 32 + 8 * fq;
#pragma unroll
        for (int ai = 0; ai < 2; ++ai)
#pragma unroll
            for (int m = 0; m < 4; ++m) { const int row = row0 + ai * HALF + m * 16; float ss = 0.f;
#pragma unroll
                for (int bj = 0; bj < 2; ++bj) { const int c = col0 + bj * HALF; const size_t off = (size_t)row * DM + c;
                    const f32x4 a0 = *(const f32x4*)(x + off), a1 = *(const f32x4*)(x + off + 4);
                    const f32x4 r0 = a0 + acc[ai][bj][m][0], r1 = a1 + acc[ai][bj][m][1];
                    *(f32x4*)(out + off) = r0; *(f32x4*)(out + off + 4) = r1;
                    ss += (r0[0] * r0[0] + r0[1] * r0[1]) + (r0[2] * r0[2] + r0[3] * r0[3]) + (r1[0] * r1[0] + r1[1] * r1[1]) + (r1[2] * r1[2] + r1[3] * r1[3]);
                    u32x4 w; w.x = pk2(r0[0], r0[1]); w.y = pk2(r0[2], r0[3]); w.z = pk2(r1[0], r1[1]); w.w = pk2(r1[2], r1[3]);
                    *(u32x4*)(P + (size_t)row * PLD + C_X1B + c) = w; }
                ss += __shfl_xor(ss, 16); ss += __shfl_xor(ss, 32);
                if (fq == 0) SSQ[(size_t)row * 16 + u.pn * 4 + wc] = ss; }
    }
};
struct EpiUp {
    static constexpr bool PERM = true, AFTER_DRAIN = false;
    const float* SSQ; const float* cw; const float* cb; bf16* P; float* UE;
    __device__ __forceinline__ void operator()(const f32x4 (&acc)[2][2][4][2], const Unit& u, int wr, int wc, int fr, int fq) const {
        const int lane = fq * 16 + fr;
        const int row0 = u.pm * BM + wr * 64 + fr;
        float rs[2][4];
#pragma unroll
        for (int ai = 0; ai < 2; ++ai)
#pragma unroll
            for (int m = 0; m < 4; ++m) { const float* sp = SSQ + (size_t)(row0 + ai * HALF + m * 16) * 16;
                const f32x4 a = *(const f32x4*)sp, b = *(const f32x4*)(sp + 4), c = *(const f32x4*)(sp + 8), d = *(const f32x4*)(sp + 12);
                const float s = ((a[0] + a[1]) + (a[2] + a[3])) + ((b[0] + b[1]) + (b[2] + b[3])) + ((c[0] + c[1]) + (c[2] + c[3])) + ((d[0] + d[1]) + (d[2] + d[3]));
                rs[ai][m] = __builtin_amdgcn_rsqf(s * (1.0f / DM) + EPS); asm volatile("" : "+v"(rs[ai][m]) :: "memory"); }
        const int src_prev = (fr == 0) ? lane + 15 : lane - 1, src_next = (fr == 15) ? lane - 15 : lane + 1;
#pragma unroll
        for (int n = 0; n < 2; ++n) {
            const int a0 = u.pn * 128 + wc * 32 + 8 * fq + 4 * n;
            const f32x4 wg0 = *(const f32x4*)(cw + a0), wg1 = *(const f32x4*)(cw + NUP + a0), wg2 = *(const f32x4*)(cw + 2 * NUP + a0), bg = *(const f32x4*)(cb + a0);
            const f32x4 wv0 = *(const f32x4*)(cw + DFF + a0), wv1 = *(const f32x4*)(cw + NUP + DFF + a0), wv2 = *(const f32x4*)(cw + 2 * NUP + DFF + a0), bv = *(const f32x4*)(cb + DFF + a0);
#pragma unroll
            for (int ai = 0; ai < 2; ++ai) {
                f32x4 ug[4], uv[4];
#pragma unroll
                for (int m = 0; m < 4; ++m) { ug[m] = acc[ai][0][m][n] * rs[ai][m]; uv[m] = acc[ai][1][m][n] * rs[ai][m]; }
                const int g64 = u.pm * 4 + ai * 2 + wr;
#pragma unroll
                for (int m = 0; m < 4; ++m) {
                    f32x4 pg, ng, pvv, nv;
#pragma unroll
                    for (int i = 0; i < 4; ++i) {
                        const float tpg = (fr == 15) ? ug[(m + 3) & 3][i] : ug[m][i];
                        const float tng = (fr == 0) ? ug[(m + 1) & 3][i] : ug[m][i];
                        const float tpv = (fr == 15) ? uv[(m + 3) & 3][i] : uv[m][i];
                        const float tnv = (fr == 0) ? uv[(m + 1) & 3][i] : uv[m][i];
                        pg[i] = __shfl(tpg, src_prev); ng[i] = __shfl(tng, src_next); pvv[i] = __shfl(tpv, src_prev); nv[i] = __shfl(tnv, src_next); }
                    const f32x4 gate = wg0 * pg + wg1 * ug[m] + wg2 * ng + bg;
                    const f32x4 val = wv0 * pvv + wv1 * uv[m] + wv2 * nv + bv;
                    const int row = row0 + ai * HALF + m * 16;
                    const bool edge = (m == 0 && fr == 0) || (m == 3 && fr == 15);
                    if (!edge) { u32x2 w; w.x = pk2(siluf_(gate[0]) * val[0], siluf_(gate[1]) * val[1]); w.y = pk2(siluf_(gate[2]) * val[2], siluf_(gate[3]) * val[3]);
                        *(u32x2*)(P + (size_t)row * PLD + C_ACT + a0) = w; }
                    if ((m == 0 && fr < 2) || (m == 3 && fr >= 14)) { const int slot = (m == 0) ? fr : fr - 12;
                        float* ue = UE + ((size_t)g64 * 4 + slot) * NUP;
                        *(f32x4*)(ue + a0) = ug[m]; *(f32x4*)(ue + DFF + a0) = uv[m]; }
                }
                asm volatile("" ::: "memory");
            }
        }
    }
};
struct EpiDown {
    static constexpr bool PERM = true, AFTER_DRAIN = false;
    float* out;
    __device__ __forceinline__ void operator()(const f32x4 (&acc)[2][2][4][2], const Unit& u, int wr, int wc, int fr, int fq) const {
        const int row0 = u.pm * BM + wr * 64 + fr, col0 = u.pn * BM + wc * 32 + 8 * fq;
#pragma unroll
        for (int ai = 0; ai < 2; ++ai)
#pragma unroll
            for (int m = 0; m < 4; ++m) {
#pragma unroll
                for (int bj = 0; bj < 2; ++bj) { const size_t off = (size_t)(row0 + ai * HALF + m * 16) * DM + col0 + bj * HALF;
                    const f32x4 a0 = *(const f32x4*)(out + off), a1 = *(const f32x4*)(out + off + 4);
                    *(f32x4*)(out + off) = a0 + acc[ai][bj][m][0]; *(f32x4*)(out + off + 4) = a1 + acc[ai][bj][m][1]; } }
    }
};

template <int DH, int RSK, int RSV, bool BIAS>
__device__ __forceinline__ void attn_tile(const LAS unsigned char* Kl, const LAS unsigned char* Vl, int jk, const bf16x8 (&qf)[DH / 16], const float* biasrow,
                                          float& m, float& l, f32x16 (&o)[DH / 32], int lane) {
    const int r32 = lane & 31, hi = lane >> 5;
    f32x16 s0, s1;
    if (BIAS) {
#pragma unroll
        for (int g4 = 0; g4 < 4; ++g4) { const f32x4 c0 = *(const f32x4*)(biasrow + 8 * g4 + 4 * hi), c1 = *(const f32x4*)(biasrow + 32 + 8 * g4 + 4 * hi);
#pragma unroll
            for (int i = 0; i < 4; ++i) { s0[4 * g4 + i] = c0[i]; s1[4 * g4 + i] = c1[i]; } }
    } else {
#pragma unroll
        for (int r = 0; r < 16; ++r) { s0[r] = 0.f; s1[r] = 0.f; }
    }
    const LAS unsigned char* kp = Kl + (size_t)(jk + r32) * RSK + 16 * hi;
#pragma unroll
    for (int ks = 0; ks < DH / 16; ++ks) {
        const bf16x8 k0 = *(const LAS bf16x8*)(kp + 32 * ks), k1 = *(const LAS bf16x8*)(kp + 32 * RSK + 32 * ks);
        s0 = __builtin_amdgcn_mfma_f32_32x32x16_bf16(k0, qf[ks], s0, 0, 0, 0);
        s1 = __builtin_amdgcn_mfma_f32_32x32x16_bf16(k1, qf[ks], s1, 0, 0, 0);
    }
    float mx = fmaxf(s0[0], s1[0]);
#pragma unroll
    for (int r = 1; r < 16; ++r) mx = fmaxf(mx, fmaxf(s0[r], s1[r]));
    mx = fmaxf(mx, __shfl_xor(mx, 32));
    const float mn = fmaxf(m, mx), f = fexp2(m - mn);
    m = mn; l *= f;
#pragma unroll
    for (int db = 0; db < DH / 32; ++db)
#pragma unroll
        for (int r = 0; r < 16; ++r) o[db][r] *= f;
    float ps = 0.f;
#pragma unroll
    for (int r = 0; r < 16; ++r) { s0[r] = fexp2(s0[r] - mn); s1[r] = fexp2(s1[r] - mn); ps += s0[r] + s1[r]; }
    l += ps;
    bf16x8 pf[4];
    { u32x4 w;
      w.x = pk2(s0[0], s0[1]); w.y = pk2(s0[2], s0[3]); w.z = pk2(s0[4], s0[5]); w.w = pk2(s0[6], s0[7]); pf[0] = __builtin_bit_cast(bf16x8, w);
      w.x = pk2(s0[8], s0[9]); w.y = pk2(s0[10], s0[11]); w.z = pk2(s0[12], s0[13]); w.w = pk2(s0[14], s0[15]); pf[1] = __builtin_bit_cast(bf16x8, w);
      w.x = pk2(s1[0], s1[1]); w.y = pk2(s1[2], s1[3]); w.z = pk2(s1[4], s1[5]); w.w = pk2(s1[6], s1[7]); pf[2] = __builtin_bit_cast(bf16x8, w);
      w.x = pk2(s1[8], s1[9]); w.y = pk2(s1[10], s1[11]); w.z = pk2(s1[12], s1[13]); w.w = pk2(s1[14], s1[15]); pf[3] = __builtin_bit_cast(bf16x8, w); }
    const int g = lane >> 4, q4 = (lane & 15) >> 2, p = lane & 3;
    const LAS unsigned char* vp = Vl + (size_t)(jk + 4 * hi + q4) * RSV + (16 * (g & 1) + 4 * p) * 2;
#pragma unroll
    for (int db = 0; db < DH / 32; ++db)
#pragma unroll
        for (int kk = 0; kk < 4; ++kk) {
            const s16x4 lo = __builtin_bit_cast(s16x4, __builtin_amdgcn_ds_read_tr16_b64_v4i16((LAS s16x4*)(vp + (size_t)(16 * kk) * RSV + 64 * db)));
            const s16x4 h4 = __builtin_bit_cast(s16x4, __builtin_amdgcn_ds_read_tr16_b64_v4i16((LAS s16x4*)(vp + (size_t)(16 * kk + 8) * RSV + 64 * db)));
            const bf16x8 vf = (bf16x8){lo[0], lo[1], lo[2], lo[3], h4[0], h4[1], h4[2], h4[3]};
            o[db] = __builtin_amdgcn_mfma_f32_32x32x16_bf16(vf, pf[kk], o[db], 0, 0, 0);
        }
}
template <int DH>
__device__ __forceinline__ void load_q(const bf16* qrow, const float* gq, float scale, bf16x8 (&qf)[DH / 16], int lane) {
    const int hi = lane >> 5;
    u32x4 w[DH / 16]; float ss = 0.f;
#pragma unroll
    for (int ks = 0; ks < DH / 16; ++ks) { w[ks] = *(const u32x4*)(qrow + 16 * ks + 8 * hi); float v[8]; unpack8(w[ks], v);
#pragma unroll
        for (int j = 0; j < 8; ++j) ss += v[j] * v[j]; }
    ss += __shfl_xor(ss, 32);
    const float rstd = __builtin_amdgcn_rsqf(ss * (1.0f / DH) + EPS) * scale;
#pragma unroll
    for (int ks = 0; ks < DH / 16; ++ks) { float v[8]; unpack8(w[ks], v);
        const f32x4 g0 = *(const f32x4*)(gq + 16 * ks + 8 * hi), g1 = *(const f32x4*)(gq + 16 * ks + 8 * hi + 4);
#pragma unroll
        for (int j = 0; j < 4; ++j) { v[j] *= rstd * g0[j]; v[4 + j] *= rstd * g1[j]; }
        qf[ks] = __builtin_bit_cast(bf16x8, pack8(v)); }
}
template <int DH>
__device__ __forceinline__ void store_o(bf16* yrow, const f32x16 (&o)[DH / 32], float l, int lane) {
    const int hi = lane >> 5;
    const float inv = frcp(l + __shfl_xor(l, 32));
#pragma unroll
    for (int db = 0; db < DH / 32; ++db)
#pragma unroll
        for (int g4 = 0; g4 < 4; ++g4) { u32x2 w; w.x = pk2(o[db][4 * g4] * inv, o[db][4 * g4 + 1] * inv); w.y = pk2(o[db][4 * g4 + 2] * inv, o[db][4 * g4 + 3] * inv);
            *(u32x2*)(yrow + 32 * db + 8 * g4 + 4 * hi) = w; }
}
template <int DH, int RSK, int RSV>
__device__ __forceinline__ void stage_kv(LAS unsigned char* Kl, LAS unsigned char* Vl, int ldsrow0, const bf16* src, size_t pitch, int kcol, int vcol, int nrows, const float* gk, int tid) {
    constexpr int CPR = DH / 8;
    for (int c = tid; c < nrows * CPR; c += 512) {
        const int row = c / CPR, ch = c % CPR;
        const bf16* rp = src + (size_t)row * pitch;
        const u32x4 kw = *(const u32x4*)(rp + kcol + ch * 8), vw = *(const u32x4*)(rp + vcol + ch * 8);
        float v[8]; unpack8(kw, v); float ss = 0.f;
#pragma unroll
        for (int j = 0; j < 8; ++j) ss += v[j] * v[j];
#pragma unroll
        for (int o = 1; o < CPR; o <<= 1) ss += __shfl_xor(ss, o);
        const float rstd = __builtin_amdgcn_rsqf(ss * (1.0f / DH) + EPS);
        const f32x4 g0 = *(const f32x4*)(gk + ch * 8), g1 = *(const f32x4*)(gk + ch * 8 + 4);
#pragma unroll
        for (int j = 0; j < 4; ++j) { v[j] *= rstd * g0[j]; v[4 + j] *= rstd * g1[j]; }
        *(LAS u32x4*)(Kl + (size_t)(ldsrow0 + row) * RSK + ch * 16) = pack8(v);
        *(LAS u32x4*)(Vl + (size_t)(ldsrow0 + row) * RSV + ch * 16) = vw;
    }
}

constexpr int NWAVES = 8;
constexpr size_t MiB = 1u << 20;
constexpr size_t WS_CTL = 0, CTL_ZERO_BYTES = 1 * MiB;
constexpr size_t WS_WIN = 2 * MiB;
constexpr size_t WS_WBR = 15 * MiB;
constexpr size_t WS_WOUT = 18 * MiB;
constexpr size_t WS_WUP = 20 * MiB;
constexpr size_t WS_WDN = 31 * MiB;
constexpr size_t WS_WKV = 37 * MiB;
constexpr size_t WS_MEMN = 39 * MiB;
constexpr size_t WS_KV = 41 * MiB;
constexpr size_t WS_BT = 43 * MiB;
constexpr size_t WS_BA = 45 * MiB;
constexpr size_t WS_SSQ = 49 * MiB;
constexpr size_t WS_P = 52 * MiB;
constexpr size_t WS_UE = 452 * MiB;
constexpr size_t WS_END = 512 * MiB;
static_assert(WS_P + (size_t)M * PLD * 2 == WS_UE && WS_UE + (size_t)512 * 4 * NUP * 4 <= WS_END, "d_ws map");

constexpr int CW_TMO = 0, CW_CODE = 1;
constexpr int CW_BAR = 4096;
constexpr int RING_OFF = 0, RING_BYTES = 131072;
constexpr int LDSCTL_OFF = RING_BYTES, MISC_OFF = LDSCTL_OFF + 320;
constexpr int LDS_BYTES = 147456;

typedef GAS unsigned gu32;
#define RLX_AGENT __ATOMIC_RELAXED, __HIP_MEMORY_SCOPE_AGENT
#define LDS_WAIT() asm volatile("s_waitcnt lgkmcnt(0)" ::: "memory")
#define VM_WAIT() asm volatile("s_waitcnt vmcnt(0)" ::: "memory")

#define XB_TMO      128
#define XB_XCNT(j)  (256  + 64 * (j))
#define XB_XSUB(j)  (1280 + 64 * (j))
#define XB_XGEN(j)  (2304 + 64 * (j))
#define XB_TOP      3328
#define XB_TOPGEN   3392
#define XCD_BAR_WORDS 3456
#define XB_SPIN_CAP (1u << 22)

__device__ __forceinline__ unsigned xb_ld(unsigned* p)              { return __hip_atomic_load(p, __ATOMIC_RELAXED, __HIP_MEMORY_SCOPE_AGENT); }
__device__ __forceinline__ unsigned xb_add(unsigned* p, unsigned v) { return __hip_atomic_fetch_add(p, v, __ATOMIC_RELAXED, __HIP_MEMORY_SCOPE_AGENT); }
__device__ __forceinline__ unsigned xb_xcc_id() { return (unsigned)__builtin_amdgcn_s_getreg((3 << 11) | 20) & 0xFu; }
#define XB_SPIN(cond, bar) do { unsigned _sp = 0; while (cond) { __builtin_amdgcn_s_sleep(1); \
    if ((++_sp & 255u) == 0u) { if (xb_ld(&(bar)[XB_TMO])) break; if (_sp > XB_SPIN_CAP) { atomicAdd(&(bar)[XB_TMO], 1u); break; } } } } while (0)

struct XcdBarrier { unsigned* bar; unsigned x; volatile LAS unsigned* st; };

__device__ __forceinline__ XcdBarrier xcd_barrier_post(unsigned* bar, volatile LAS unsigned* st) {
    XcdBarrier b; b.bar = bar; b.x = xb_xcc_id(); b.st = st;
    if (threadIdx.x == 0) (void)xb_add(&bar[XB_XCNT(b.x)], 1u);
    return b;
}
__device__ __forceinline__ void xcd_barrier_complete(unsigned* bar, unsigned x, unsigned& nloc, unsigned& nx) {
    const unsigned G = gridDim.x * gridDim.y * gridDim.z;
    unsigned sum, cnt, mine, sp = 0u;
    for (;;) {
        sum = 0u; cnt = 0u; mine = 0u;
#pragma unroll
        for (unsigned j = 0; j < 16; ++j) { const unsigned c = xb_ld(&bar[XB_XCNT(j)]); sum += c; cnt += (c > 0u) ? 1u : 0u; mine = (j == x) ? c : mine; }
        if (sum == G) break;
        __builtin_amdgcn_s_sleep(1);
        if ((++sp & 255u) == 0u) { if (xb_ld(&bar[XB_TMO])) break; if (sp > XB_SPIN_CAP) { atomicAdd(&bar[XB_TMO], 1u); break; } }
    }
    nloc = mine > 0u ? mine : 1u; nx = cnt > 0u ? cnt : 1u;
}
__device__ __forceinline__ void xcd_barrier(const XcdBarrier& b) {
    asm volatile("s_waitcnt vmcnt(0)" ::: "memory");
    __syncthreads();
    if (threadIdx.x == 0) {
        unsigned* bar = b.bar;
        __builtin_amdgcn_s_waitcnt(0);
        unsigned nloc = b.st[0], nx = b.st[1];
        if (nloc == 0u) { xcd_barrier_complete(bar, b.x, nloc, nx); b.st[0] = nloc; b.st[1] = nx; }
        const unsigned old = xb_add(&bar[XB_XSUB(b.x)], 1u);
        const unsigned gen = old / nloc;
        if (old + 1u == (gen + 1u) * nloc) {
            __builtin_amdgcn_fence(__ATOMIC_RELEASE, "agent");
            asm volatile("s_waitcnt vmcnt(0)" ::: "memory");
            const unsigned og = xb_add(&bar[XB_TOP], 1u);
            const unsigned tg = og / nx;
            if (og + 1u == (tg + 1u) * nx) xb_add(&bar[XB_TOPGEN], 1u);
            else XB_SPIN(xb_ld(&bar[XB_TOPGEN]) == tg, bar);
            __builtin_amdgcn_fence(__ATOMIC_ACQUIRE, "agent");
            xb_add(&bar[XB_XGEN(b.x)], 1u);
            asm volatile("s_waitcnt vmcnt(0)" ::: "memory");
        } else {
            XB_SPIN(xb_ld(&bar[XB_XGEN(b.x)]) == gen, bar);
            __builtin_amdgcn_fence(__ATOMIC_ACQUIRE, "agent");
            asm volatile("s_waitcnt vmcnt(0)" ::: "memory");
        }
    }
    __syncthreads();
}

struct Frame {
    LAS unsigned char* lds;
    volatile LAS unsigned* MISC;
    gu32* ctl;
    int tid, lane, wave, vcu, G;
};

__device__ __forceinline__ float wave_sum(float v) {
#pragma unroll
    for (int o = 1; o < 64; o <<= 1) v += __shfl_xor(v, o);
    return v;
}
__device__ __forceinline__ int t5_bucket(int rel) {
    const int n = rel < 0 ? -rel : rel;
    const int mag = n < 8 ? n : n < 12 ? 8 : n < 16 ? 9 : n < 23 ? 10 : n < 32 ? 11 : n < 46 ? 12 : n < 64 ? 13 : n < 91 ? 14 : 15;
    return (rel > 0 ? 16 : 0) + mag;
}

__device__ __forceinline__ void transpose_item(const float* W, int K, int N, int k0, int n0, bf16* WT, int drow0, const float* gk, LAS float* scr, int lane) {
    { f32x4 v[8];
#pragma unroll
      for (int i = 0; i < 8; ++i) v[i] = *(const f32x4*)(W + (size_t)(k0 + 8 * i + (lane >> 3)) * N + n0 + 4 * (lane & 7));
#pragma unroll
      for (int i = 0; i < 8; ++i) { const int kk = 8 * i + (lane >> 3); const float gs = gk ? gk[k0 + kk] : 1.0f; LAS float* d = scr + kk * 33 + 4 * (lane & 7);
          d[0] = v[i][0] * gs; d[1] = v[i][1] * gs; d[2] = v[i][2] * gs; d[3] = v[i][3] * gs; } }
    LDS_WAIT(); asm volatile("" ::: "memory");
    const int c = lane & 7;
#pragma unroll
    for (int j = 0; j < 4; ++j) { const int n = (lane >> 3) + 8 * j; const LAS float* s = scr + (8 * c) * 33 + n;
        u32x4 o; o.x = pk2(s[0 * 33], s[1 * 33]); o.y = pk2(s[2 * 33], s[3 * 33]); o.z = pk2(s[4 * 33], s[5 * 33]); o.w = pk2(s[6 * 33], s[7 * 33]);
        *(GAS u32x4*)(WT + (size_t)(drow0 + n) * K + k0 + 8 * c) = o; }
    LDS_WAIT(); asm volatile("" ::: "memory");
}
__device__ __forceinline__ void rms_row_to_bf16(const float* xrow, const float* g, bf16* orow, int lane) {
    const GAS f32x4* xr = (const GAS f32x4*)xrow + lane;
    const GAS f32x4* gr = (const GAS f32x4*)g + lane;
    f32x4 v[4]; float s = 0.f;
#pragma unroll
    for (int j = 0; j < 4; ++j) { v[j] = xr[64 * j]; s += (v[j].x * v[j].x + v[j].y * v[j].y) + (v[j].z * v[j].z + v[j].w * v[j].w); }
    const float rstd = __builtin_amdgcn_rsqf(wave_sum(s) * (1.f / DM) + EPS);
    GAS unsigned long long* o8 = (GAS unsigned long long*)orow + lane;
#pragma unroll
    for (int j = 0; j < 4; ++j) { const f32x4 gg = gr[64 * j];
        o8[64 * j] = (unsigned long long)pk2(v[j].x * rstd * gg.x, v[j].y * rstd * gg.y) | ((unsigned long long)pk2(v[j].z * rstd * gg.z, v[j].w * rstd * gg.w) << 32); }
}

__device__ __forceinline__ void rms_row2_to_bf16(const float* xa, const float* xb, const float* g, bf16* oa, bf16* ob, int lane) {
    const GAS f32x4* xr0 = (const GAS f32x4*)xa + lane; const GAS f32x4* xr1 = (const GAS f32x4*)xb + lane;
    const GAS f32x4* gr = (const GAS f32x4*)g + lane;
    f32x4 v0[4], v1[4]; float s0 = 0.f, s1 = 0.f;
#pragma unroll
    for (int j = 0; j < 4; ++j) { v0[j] = xr0[64 * j]; v1[j] = xr1[64 * j]; }
#pragma unroll
    for (int j = 0; j < 4; ++j) { s0 += (v0[j].x * v0[j].x + v0[j].y * v0[j].y) + (v0[j].z * v0[j].z + v0[j].w * v0[j].w); s1 += (v1[j].x * v1[j].x + v1[j].y * v1[j].y) + (v1[j].z * v1[j].z + v1[j].w * v1[j].w); }
#pragma unroll
    for (int o = 1; o < 64; o <<= 1) { s0 += __shfl_xor(s0, o); s1 += __shfl_xor(s1, o); }
    const float r0 = __builtin_amdgcn_rsqf(s0 * (1.f / DM) + EPS), r1 = __builtin_amdgcn_rsqf(s1 * (1.f / DM) + EPS);
    GAS unsigned long long* o0 = (GAS unsigned long long*)oa + lane; GAS unsigned long long* o1 = (GAS unsigned long long*)ob + lane;
#pragma unroll
    for (int j = 0; j < 4; ++j) { const f32x4 gg = gr[64 * j];
        o0[64 * j] = (unsigned long long)pk2(v0[j].x * r0 * gg.x, v0[j].y * r0 * gg.y) | ((unsigned long long)pk2(v0[j].z * r0 * gg.z, v0[j].w * r0 * gg.w) << 32);
        o1[64 * j] = (unsigned long long)pk2(v1[j].x * r1 * gg.x, v1[j].y * r1 * gg.y) | ((unsigned long long)pk2(v1[j].z * r1 * gg.z, v1[j].w * r1 * gg.w) << 32); }
}

struct Args { const float* in[25]; float* out; unsigned char* ws; int ph_lo, ph_hi; };

__device__ __forceinline__ void p0_prologue(Frame& F, const Args& a) {
    unsigned char* ws = a.ws;
    LAS float* scr = (LAS float*)(F.lds + RING_OFF + F.wave * 16384);
    const int gw = F.vcu * NWAVES + F.wave, NGW = F.G * NWAVES;
    constexpr int I_IN = 16 * 201, I_BR = 8 * 32, I_OUT = 16 * 32, I_UP = 16 * 176, I_DN = 44 * 32, I_KV = 16 * 32;
    constexpr int NITEMS = I_IN + 3 * I_BR + I_OUT + I_UP + I_DN + I_KV;
    for (int it = gw; it < NITEMS; it += NGW) {
        int r = it;
        if (r < I_IN) { const int kb = r / 201, nb = r % 201, n0 = nb * 32;
            const int d0 = n0 < 2816 ? n0 : (n0 < 2848 ? 3328 + (n0 - 2816) : (n0 < 3360 ? n0 - 32 : 3584 + (n0 - 3360)));
            transpose_item(a.in[4], 1024, 6432, kb * 64, n0, (bf16*)(ws + WS_WIN), d0, nullptr, scr, F.lane); continue; }
        r -= I_IN;
        if (r < 3 * I_BR) { const int br = r / I_BR, q = r % I_BR, kb = q / 32, nb = q % 32;
            transpose_item(a.in[16 + br], 512, 1024, kb * 64, nb * 32, (bf16*)(ws + WS_WBR) + (size_t)br * 1024 * 512, nb * 32, nullptr, scr, F.lane); continue; }
        r -= 3 * I_BR;
        if (r < I_OUT) { const int kb = r / 32, nb = r % 32;
            transpose_item(a.in[19], 1024, 1024, kb * 64, nb * 32, (bf16*)(ws + WS_WOUT), nb * 32, nullptr, scr, F.lane); continue; }
        r -= I_OUT;
        if (r < I_UP) { const int kb = r / 176, nb = r % 176, n0 = nb * 32;
            const int isv = n0 >= DFF, nn = isv ? n0 - DFF : n0, d0 = (nn >> 7) * 256 + isv * 128 + (nn & 127);
            transpose_item(a.in[21], 1024, NUP, kb * 64, n0, (bf16*)(ws + WS_WUP), d0, a.in[20], scr, F.lane); continue; }
        r -= I_UP;
        if (r < I_DN) { const int kb = r / 32, nb = r % 32;
            transpose_item(a.in[24], DFF, 1024, kb * 64, nb * 32, (bf16*)(ws + WS_WDN), nb * 32, nullptr, scr, F.lane); continue; }
        r -= I_DN;
        { const int kb = r / 32, nb = r % 32;
            transpose_item(a.in[13], 1024, 1024, kb * 64, nb * 32, (bf16*)(ws + WS_WKV), nb * 32, nullptr, scr, F.lane); }
    }
    { u32x4* z = (u32x4*)((bf16*)(ws + WS_WIN) + (size_t)3360 * 1024); const int n16 = 224 * 1024 * 2 / 16;
      for (int i = blockIdx.x * 512 + F.tid; i < n16; i += F.G * 512) z[i] = (u32x4){0u, 0u, 0u, 0u}; }
    bf16* H = (bf16*)a.out;
    if (M % (2 * NGW) != 0) { for (int m = gw; m < M; m += NGW) rms_row_to_bf16(a.in[0] + (size_t)m * DM, a.in[3], H + (size_t)m * DM, F.lane); }
    else for (int m = gw; m < M; m += 2 * NGW) rms_row2_to_bf16(a.in[0] + (size_t)m * DM, a.in[0] + (size_t)(m + NGW) * DM, a.in[3], H + (size_t)m * DM, H + (size_t)(m + NGW) * DM, F.lane);
    for (int m = gw; m < BATCH * NMEM; m += NGW) rms_row_to_bf16(a.in[1] + (size_t)m * DM, a.in[12], (bf16*)(ws + WS_MEMN) + (size_t)m * DM, F.lane);
    { float* BT = (float*)(ws + WS_BT); const float* tab = a.in[2];
      for (int i = blockIdx.x * 512 + F.tid; i < 8 * 128 * 384; i += F.G * 512) { const int j = i % 384, t = (i / 384) % 128, h = i / (384 * 128);
          const int rel = j - 128 - t; const bool ok = rel >= -128 && rel <= 128;
          BT[i] = ok ? tab[t5_bucket(rel) * 8 + h] * LOG2E : -INFINITY; } }
}

__device__ __forceinline__ void attnA_unit(Frame& F, const Args& a, int b, int n, int kvh) {
    constexpr int RSK = 144, RSV = 128;
    LAS unsigned char* Kl = F.lds; LAS unsigned char* Vl = F.lds + 384 * RSK;
    bf16* P = (bf16*)(a.ws + WS_P);
    const float* BT = (const float*)(a.ws + WS_BT);
    for (int blk = 0; blk < 3; ++blk) { const int pos0 = n * 128 - 128 + blk * 128; if (pos0 < 0 || pos0 >= SEQ) continue;
        stage_kv<64, RSK, RSV>(Kl, Vl, blk * 128, P + (size_t)(b * SEQ + pos0) * PLD, PLD, C_AK + kvh * 64, C_AV + kvh * 64, 128, a.in[6], F.tid); }
    LDS_WAIT(); __syncthreads();
    const int h = kvh * 4 + (F.wave >> 1), r32 = F.lane & 31, hi = F.lane >> 5;
    const float sink = a.in[7][h] * LOG2E;
#pragma unroll 1
    for (int qb = 0; qb < 2; ++qb) {
        const int t0 = (F.wave & 1) * 64 + qb * 32, t = t0 + r32;
        bf16* qrow = P + (size_t)(b * SEQ + n * 128 + t) * PLD + C_AQ + h * 64;
        bf16x8 qf[4]; load_q<64>(qrow, a.in[5], 0.125f * LOG2E, qf, F.lane);
        float m = sink, l = hi == 0 ? 1.f : 0.f; f32x16 o[2];
#pragma unroll
        for (int r = 0; r < 16; ++r) { o[0][r] = 0.f; o[1][r] = 0.f; }
#pragma unroll 1
        for (int kt = 0; kt < 6; ++kt) { const int j0 = 64 * kt, pos0 = n * 128 - 128 + (kt >> 1) * 128;
            if (pos0 < 0 || pos0 >= SEQ) continue;
            if (j0 + 63 < t0 || j0 > t0 + 31 + 256) continue;
            attn_tile<64, RSK, RSV, true>(Kl, Vl, j0, qf, BT + ((size_t)h * 128 + t) * 384 + j0, m, l, o, F.lane); }
        store_o<64>(qrow, o, l, F.lane);
    }
    LDS_WAIT(); __syncthreads();
}
__device__ __forceinline__ void xattn_unit(Frame& F, const Args& a, int b, int tb, int h) {
    constexpr int RSK = 272, RSV = 320;
    LAS unsigned char* Kl = F.lds; LAS unsigned char* Vl = F.lds + 128 * RSK;
    bf16* P = (bf16*)(a.ws + WS_P);
    const bf16* KV = (const bf16*)(a.ws + WS_KV);
    const int r32 = F.lane & 31;
    bf16* qrow = P + (size_t)(b * SEQ + tb * 256 + F.wave * 32 + r32) * PLD + C_MQ + h * 128;
    bf16x8 qf[8]; load_q<128>(qrow, a.in[14], 0.08838834764831845f * LOG2E, qf, F.lane);
    float m = -1e30f, l = 0.f; f32x16 o[4];
#pragma unroll
    for (int db = 0; db < 4; ++db)
#pragma unroll
        for (int r = 0; r < 16; ++r) o[db][r] = 0.f;
#pragma unroll 1
    for (int half = 0; half < 2; ++half) {
        stage_kv<128, RSK, RSV>(Kl, Vl, 0, KV + (size_t)(b * NMEM + half * 128) * 1024, 1024, h * 128, 512 + h * 128, 128, a.in[15], F.tid);
        LDS_WAIT(); __syncthreads();
#pragma unroll 1
        for (int kt = 0; kt < 2; ++kt) attn_tile<128, RSK, RSV, false>(Kl, Vl, 64 * kt, qf, nullptr, m, l, o, F.lane);
        LDS_WAIT(); __syncthreads();
    }
    store_o<128>(qrow, o, l, F.lane);
}


constexpr int SQ = C_GATE, SK = C_GATE + 512, SWF = C_GATE + 1024, SUF = C_GATE + 1536, SWB = C_GATE + 2048, SUB = C_GATE + 2560;
constexpr int C_OF = C_DQ, C_OB = C_DK;
__device__ __forceinline__ bf16x8 frag_lo(const LAS unsigned char* p) { const u32x2 a0 = *(const LAS u32x2*)p; u32x4 w; w.x = a0.x; w.y = a0.y; w.z = 0u; w.w = 0u; return __builtin_bit_cast(bf16x8, w); }
__device__ __forceinline__ bf16x8 frag_2(const LAS unsigned char* p) { const u32x2 a0 = *(const LAS u32x2*)p, a1 = *(const LAS u32x2*)(p + 32); u32x4 w; w.x = a0.x; w.y = a0.y; w.z = a1.x; w.w = a1.y; return __builtin_bit_cast(bf16x8, w); }
__device__ __forceinline__ bf16x8 pack_f4z(const f32x4 a) { u32x4 w; w.x = pk2(a[0], a[1]); w.y = pk2(a[2], a[3]); w.z = 0u; w.w = 0u; return __builtin_bit_cast(bf16x8, w); }
__device__ __forceinline__ bf16x8 pack_f4f4(const f32x4 a, const f32x4 b) { u32x4 w; w.x = pk2(a[0], a[1]); w.y = pk2(a[2], a[3]); w.z = pk2(b[0], b[1]); w.w = pk2(b[2], b[3]); return __builtin_bit_cast(bf16x8, w); }
__device__ __forceinline__ void dn_prep_block(Frame& F, const Args& a, int b, int h, int c0, int nch) {
    LAS float* raw = (LAS float*)(F.lds);
    LAS unsigned char* NL = F.lds;
    LAS unsigned char* TD = F.lds + 18432;
    LAS unsigned char* Qb = F.lds + 53248;
    LAS unsigned char* Kb = F.lds + 62464;
    LAS unsigned char* Vb = F.lds + 71680;
    LAS float* sm = (LAS float*)(F.lds + 80896);
    LAS float* gt = sm;
    LAS float* btk = sm + 128;
    LAS float* gct = sm + 256;
    LAS float* cu = sm + 384;
    LAS float* cwp = sm + 512;
    bf16* P = (bf16*)(a.ws + WS_P);
    float* BA = (float*)(a.ws + WS_BA);
    bf16* QKB = (bf16*)a.out + (size_t)M * 1024;
    const float* cw = a.in[8];
    const int w = F.wave, lane = F.lane, tid = F.tid;
    float wt[3][5];
#pragma unroll
    for (int which = 0; which < 3; ++which)
#pragma unroll
        for (int j = 0; j < 5; ++j) wt[which][j] = cw[j * 1536 + which * 512 + h * 64 + lane];
    const float Ah = expf(a.in[9][(tid >> 6 & 1) * 8 + h]), dtb = a.in[10][(tid >> 6 & 1) * 8 + h];
    u32x4 rr[4]; float pa = 0.f, pb = 0.f;
#define DN_PREFETCH(cidx) do { const int t0p_ = (cidx) * 64; \
        _Pragma("unroll") for (int i_ = 0; i_ < 4; ++i_) { const int e = tid + 512 * i_, row = e / 24, c8 = e % 24, which = c8 >> 3, t = t0p_ - 2 + row; \
            rr[i_] = (u32x4){0u, 0u, 0u, 0u}; \
            if (e < 68 * 24 && t >= 0 && t < SEQ) rr[i_] = *(const u32x4*)(P + ((size_t)b * SEQ + t) * PLD + (which == 0 ? C_DQ : which == 1 ? C_DK : C_DV) + h * 64 + (c8 & 7) * 8); } \
        if (tid < 128) { const size_t tok = (size_t)b * SEQ + t0p_ + (tid & 63); pa = BA[tok * 32 + 16 + (tid >> 6) * 8 + h]; pb = BA[tok * 32 + (tid >> 6) * 8 + h]; } } while (0)
    DN_PREFETCH(c0);
#pragma unroll 1
  for (int ci = 0; ci < nch; ++ci) {
    const int c = c0 + ci, t0 = c * 64;
    const size_t tok0 = (size_t)b * SEQ + t0;
#pragma unroll
    for (int i_ = 0; i_ < 4; ++i_) { const int e = tid + 512 * i_, row = e / 24, c8 = e % 24;
        if (e < 68 * 24) { float v[8]; unpack8(rr[i_], v);
            *(LAS f32x4*)(raw + row * 192 + c8 * 8) = (f32x4){v[0], v[1], v[2], v[3]}; *(LAS f32x4*)(raw + row * 192 + c8 * 8 + 4) = (f32x4){v[4], v[5], v[6], v[7]}; } }
    if (tid < 128) { const int d = tid >> 6, i = tid & 63; const float xa = pa + dtb;
        gt[d * 64 + i] = -Ah * (fmaxf(xa, 0.f) + log1pf(expf(-fabsf(xa))));
        btk[d * 64 + i] = sigmoidf_(pb); }
    if (ci + 1 < nch) DN_PREFETCH(c + 1);
    LDS_WAIT(); __syncthreads();
#pragma unroll
    for (int which = 0; which < 3; ++which) {
        float x[12], y[8];
#pragma unroll
        for (int j = 0; j < 12; ++j) x[j] = raw[(w * 8 + j) * 192 + which * 64 + lane];
#pragma unroll
        for (int r = 0; r < 8; ++r) { float acc = 0.f;
#pragma unroll
            for (int j = 0; j < 5; ++j) acc += x[r + j] * wt[which][j];
            y[r] = siluf_(acc); }
        if (which < 2) {
            float ss[8];
#pragma unroll
            for (int r = 0; r < 8; ++r) ss[r] = y[r] * y[r];
#pragma unroll
            for (int o = 1; o < 64; o <<= 1)
#pragma unroll
                for (int r = 0; r < 8; ++r) ss[r] += __shfl_xor(ss[r], o);
#pragma unroll
            for (int r = 0; r < 8; ++r) y[r] *= __builtin_amdgcn_rsqf(ss[r] + EPS) * (which == 0 ? 0.125f : 1.0f);
        }
        LAS unsigned char* X = which == 0 ? Qb : which == 1 ? Kb : Vb;
#pragma unroll
        for (int r = 0; r < 8; ++r) *(LAS bf16*)(X + (w * 8 + r) * 144 + lane * 2) = (bf16)(pk2(y[r], 0.f) & 0xffffu);
        asm volatile("" ::: "memory");
    }
    if (w < 2) { const int i = w ? 63 - lane : lane; float gv = gt[w * 64 + i];
#pragma unroll
        for (int o = 1; o < 64; o <<= 1) { const float t = __shfl_up(gv, o); if (lane >= o) gv += t; }
        const float glast = __shfl(gv, 63), bt = btk[w * 64 + i], eg = __expf(gv);
        gct[w * 64 + i] = gv; cu[w * 64 + lane] = bt; cwp[w * 64 + lane] = bt * eg;
        BA[(tok0 + lane) * 32 + w * 8 + h] = eg; BA[(tok0 + lane) * 32 + 16 + w * 8 + h] = __expf(glast - gv); }
    LDS_WAIT(); __syncthreads();
    { const int row = tid >> 3, c8 = (tid & 7) * 8;
      *(u32x4*)(P + (tok0 + row) * PLD + SQ + h * 64 + c8) = *(const LAS u32x4*)(Qb + row * 144 + c8 * 2);
      *(u32x4*)(P + (tok0 + row) * PLD + SK + h * 64 + c8) = *(const LAS u32x4*)(Kb + row * 144 + c8 * 2); }
    { const int wq = w & 3, tm = wq >> 1, tn = wq & 1, r32 = lane & 31, hi = lane >> 5;
      const LAS unsigned char* X = (w < 4) ? Kb : Qb;
      f32x16 acc;
#pragma unroll
      for (int r = 0; r < 16; ++r) acc[r] = 0.f;
#pragma unroll
      for (int kst = 0; kst < 4; ++kst) {
          const bf16x8 af = *(const LAS bf16x8*)(X + (32 * tm + r32) * 144 + (16 * kst + 8 * hi) * 2), bfr = *(const LAS bf16x8*)(Kb + (32 * tn + r32) * 144 + (16 * kst + 8 * hi) * 2);
          acc = __builtin_amdgcn_mfma_f32_32x32x16_bf16(af, bfr, acc, 0, 0, 0); }
      const int j = 32 * tn + r32; const float gjf = gct[j], gjb = gct[64 + j];
#pragma unroll
      for (int g4 = 0; g4 < 4; ++g4) { const int i0 = 32 * tm + 8 * g4 + 4 * hi;
          const f32x4 gif = *(const LAS f32x4*)(gct + i0), gib = *(const LAS f32x4*)(gct + 64 + i0), bif = *(const LAS f32x4*)(btk + i0), bib = *(const LAS f32x4*)(btk + 64 + i0);
#pragma unroll
          for (int q = 0; q < 4; ++q) { const int i = i0 + q; const float v = acc[4 * g4 + q];
              const float ef = __expf(fminf(gif[q] - gjf, 0.f)), eb = __expf(fminf(gib[q] - gjb, 0.f));
              if (w < 4) {
                  const float lf = (j < i) ? -bif[q] * v * ef : 0.f, lb = (j > i) ? -bib[q] * v * eb : 0.f;
                  *(LAS bf16*)(NL + i * 144 + j * 2) = (bf16)(pk2(lf, 0.f) & 0xffffu);
                  *(LAS bf16*)(NL + 9216 + (63 - i) * 144 + (63 - j) * 2) = (bf16)(pk2(lb, 0.f) & 0xffffu);
              } else {
                  const float qf = (j <= i) ? v * ef : 0.f, qb = (j >= i) ? v * eb : 0.f;
                  QKB[(tok0 + i) * 512 + h * 64 + j] = (bf16)(pk2(qf, 0.f) & 0xffffu);
                  QKB[(size_t)M * 512 + (tok0 + 63 - i) * 512 + h * 64 + (63 - j)] = (bf16)(pk2(qb, 0.f) & 0xffffu);
              } } } }
    LDS_WAIT(); __syncthreads();
    if (w < 2) { const int blk = lane >> 4, col = lane & 15; const LAS unsigned char* nl = NL + w * 9216 + (16 * blk) * 144 + (16 * blk) * 2;
        float t[16];
#pragma unroll
        for (int r = 0; r < 16; ++r) { float acc = (r == col) ? 1.f : 0.f;
            if (r > 0) { float l[16]; { float l8[8]; unpack8(*(const LAS u32x4*)(nl + r * 144), l8);
#pragma unroll
                    for (int q = 0; q < 8; ++q) l[q] = l8[q]; }
                if (r > 8) { float l8[8]; unpack8(*(const LAS u32x4*)(nl + r * 144 + 16), l8);
#pragma unroll
                    for (int q = 0; q < 8; ++q) l[8 + q] = l8[q]; }
#pragma unroll
                for (int q = 0; q < r; ++q) acc += l[q] * t[q]; }
            t[r] = acc; }
#pragma unroll
        for (int r = 0; r < 16; ++r) *(LAS bf16*)(TD + w * 3072 + blk * 768 + r * 48 + col * 2) = (bf16)(pk2(t[r], 0.f) & 0xffffu);
    }
    LDS_WAIT(); __syncthreads();
    { const int d = w >> 2, cc = lane & 15, g = lane >> 4;
      const LAS unsigned char* nl = NL + d * 9216; const LAS unsigned char* td = TD + d * 3072 + cc * 48 + 8 * g;
#pragma unroll
      for (int jj = 0; jj < 2; ++jj) { const int ct = 2 * (w & 3) + jj, part = ct >> 2, colb = 16 * (ct & 3);
          const LAS unsigned char* src = part ? Kb : Vb; const LAS float* coef = (part ? cwp : cu) + d * 64;
          f32x4 R[4];
#pragma unroll
          for (int bq = 0; bq < 4; ++bq) { const f32x4 cf = *(const LAS f32x4*)(coef + 16 * bq + 4 * g);
#pragma unroll
              for (int r = 0; r < 4; ++r) { const int p = 16 * bq + 4 * g + r, i = d ? 63 - p : p;
                  R[bq][r] = cf[r] * __uint_as_float((unsigned)(*(const LAS bf16*)(src + i * 144 + (colb + cc) * 2)) << 16); } }
          const f32x4 z4 = (f32x4){0.f, 0.f, 0.f, 0.f};
          f32x4 X0, X1, X2, X3, Y;
          X0 = __builtin_amdgcn_mfma_f32_16x16x32_bf16(frag_lo(td), pack_f4z(R[0]), z4, 0, 0, 0);
          Y = __builtin_amdgcn_mfma_f32_16x16x32_bf16(frag_lo(nl + (16 + cc) * 144 + 8 * g), pack_f4z(X0), R[1], 0, 0, 0);
          X1 = __builtin_amdgcn_mfma_f32_16x16x32_bf16(frag_lo(td + 768), pack_f4z(Y), z4, 0, 0, 0);
          const bf16x8 x01 = pack_f4f4(X0, X1);
          Y = __builtin_amdgcn_mfma_f32_16x16x32_bf16(frag_2(nl + (32 + cc) * 144 + 8 * g), x01, R[2], 0, 0, 0);
          X2 = __builtin_amdgcn_mfma_f32_16x16x32_bf16(frag_lo(td + 2 * 768), pack_f4z(Y), z4, 0, 0, 0);
          Y = __builtin_amdgcn_mfma_f32_16x16x32_bf16(frag_2(nl + (48 + cc) * 144 + 8 * g), x01, R[3], 0, 0, 0);
          Y = __builtin_amdgcn_mfma_f32_16x16x32_bf16(frag_lo(nl + (48 + cc) * 144 + 64 + 8 * g), pack_f4z(X2), Y, 0, 0, 0);
          X3 = __builtin_amdgcn_mfma_f32_16x16x32_bf16(frag_lo(td + 3 * 768), pack_f4z(Y), z4, 0, 0, 0);
          if (part == 0) { bf16* up = P + (tok0 + colb + cc) * PLD + (d ? SUB : SUF) + h * 64 + 4 * g;
              u32x2 o;
              o.x = pk2(X0[0], X0[1]); o.y = pk2(X0[2], X0[3]); *(u32x2*)(up) = o;
              o.x = pk2(X1[0], X1[1]); o.y = pk2(X1[2], X1[3]); *(u32x2*)(up + 16) = o;
              o.x = pk2(X2[0], X2[1]); o.y = pk2(X2[2], X2[3]); *(u32x2*)(up + 32) = o;
              o.x = pk2(X3[0], X3[1]); o.y = pk2(X3[2], X3[3]); *(u32x2*)(up + 48) = o; }
          else { bf16* wp = P + (tok0 + 4 * g) * PLD + (d ? SWB : SWF) + h * 64 + colb + cc;
#pragma unroll
              for (int r = 0; r < 4; ++r) { wp[(size_t)r * PLD] = (bf16)(pk2(-X0[r], 0.f) & 0xffffu); wp[(size_t)(16 + r) * PLD] = (bf16)(pk2(-X1[r], 0.f) & 0xffffu);
                  wp[(size_t)(32 + r) * PLD] = (bf16)(pk2(-X2[r], 0.f) & 0xffffu); wp[(size_t)(48 + r) * PLD] = (bf16)(pk2(-X3[r], 0.f) & 0xffffu); } }
      } }
    LDS_WAIT(); __syncthreads();
  }
#undef DN_PREFETCH
}

constexpr int DNX_W = 0, DNX_Q = 8192, DNX_QK = 16384, DNX_UT = 24576, DNX_K = 32768, DNX_GC = 40960, DNX_SZ = 43008;
__device__ __forceinline__ bf16x8 lds_frag_x(const LAS unsigned char* base, unsigned off) { const u32x2 a0 = *(const LAS u32x2*)(base + off), a1 = *(const LAS u32x2*)(base + (off ^ 32u)); u32x4 w; w.x = a0.x; w.y = a0.y; w.z = a1.x; w.w = a1.y; return __builtin_bit_cast(bf16x8, w); }
__device__ __forceinline__ void dn_scan_step(const LAS unsigned char* buf, f32x4 (&Sacc)[4], int ws, int lane, bf16* Oout, int dir) {
    const int c = lane & 15, g = lane >> 4;
    const LAS float* EGs = (const LAS float*)(buf + DNX_GC);
    const unsigned utrow = 16 * ws + c, ut0 = utrow * 128u + ((((unsigned)(g >> 1)) ^ ((utrow >> 1) & 7u)) << 4) + 8u * (g & 1);
    unsigned a0r[4];
#pragma unroll
    for (int mt = 0; mt < 4; ++mt) { const unsigned row = 16 * mt + c; a0r[mt] = row * 128u + ((((unsigned)(g >> 1)) ^ ((row >> 1) & 7u)) << 4) + 8u * (g & 1); }
    u32x2 uw[4]; bf16x8 wf[4][2], qf[4][2], af[4][2]; f32x4 eg[4], es[4]; s16x4 klo[4][2], khi[4][2];
#pragma unroll
    for (int mt = 0; mt < 4; ++mt) { uw[mt] = *(const LAS u32x2*)(buf + DNX_UT + (ut0 ^ ((unsigned)mt << 5)));
#pragma unroll
        for (int ks = 0; ks < 2; ++ks) { wf[mt][ks] = lds_frag_x(buf + DNX_W, a0r[mt] ^ ((unsigned)ks << 6)); qf[mt][ks] = lds_frag_x(buf + DNX_Q, a0r[mt] ^ ((unsigned)ks << 6)); } }
    bf16x8 Sb[2];
#pragma unroll
    for (int ks = 0; ks < 2; ++ks) Sb[ks] = pack_f4f4(Sacc[2 * ks], Sacc[2 * ks + 1]);
    __builtin_amdgcn_sched_barrier(0);
    f32x4 Vn[4], Oa[4];
    const int q4 = (lane & 15) >> 2, pp = lane & 3; const unsigned kkey = 4u * (g & 1) + q4;
#define DN_KT(mt) do { const unsigned ka = (unsigned)(uintptr_t)(buf + DNX_K) + (4 * g + q4) * 128u + ((((unsigned)(2 * (mt) + (pp >> 1))) ^ kkey) << 4) + 8u * (pp & 1); \
        asm volatile("ds_read_b64_tr_b16 %0, %1" : "=&v"(klo[mt][0]) : "v"(ka) : "memory"); \
        asm volatile("ds_read_b64_tr_b16 %0, %1 offset:2048" : "=&v"(khi[mt][0]) : "v"(ka) : "memory"); \
        asm volatile("ds_read_b64_tr_b16 %0, %1 offset:4096" : "=&v"(klo[mt][1]) : "v"(ka) : "memory"); \
        asm volatile("ds_read_b64_tr_b16 %0, %1 offset:6144" : "=&v"(khi[mt][1]) : "v"(ka) : "memory"); } while (0)
#define DN_G1(mt) do { Vn[mt] = (f32x4){bf_lo(uw[mt].x), bf_hi(uw[mt].x), bf_lo(uw[mt].y), bf_hi(uw[mt].y)}; Oa[mt] = (f32x4){0.f, 0.f, 0.f, 0.f}; \
        _Pragma("unroll") for (int ks = 0; ks < 2; ++ks) { Vn[mt] = __builtin_amdgcn_mfma_f32_16x16x32_bf16(wf[mt][ks], Sb[ks], Vn[mt], 0, 0, 0); \
            Oa[mt] = __builtin_amdgcn_mfma_f32_16x16x32_bf16(qf[mt][ks], Sb[ks], Oa[mt], 0, 0, 0); } } while (0)
    DN_G1(0); DN_KT(0); DN_KT(1); __builtin_amdgcn_sched_barrier(0);
    DN_G1(1); DN_KT(2); DN_KT(3); __builtin_amdgcn_sched_barrier(0);
    DN_G1(2);
#pragma unroll
    for (int mt = 0; mt < 4; ++mt) { eg[mt] = *(const LAS f32x4*)(EGs + 16 * mt + 4 * g); es[mt] = *(const LAS f32x4*)(EGs + 64 + 16 * mt + 4 * g); }
    const float gm = EGs[63];
    __builtin_amdgcn_sched_barrier(0);
    DN_G1(3);
#pragma unroll
    for (int mt = 0; mt < 4; ++mt)
#pragma unroll
        for (int ks = 0; ks < 2; ++ks) { if (ks == 1 && mt < 2) continue; af[mt][ks] = lds_frag_x(buf + DNX_QK, a0r[mt] ^ ((unsigned)ks << 6)); }
    __builtin_amdgcn_sched_barrier(0);
#undef DN_KT
#undef DN_G1
#pragma unroll
    for (int mt = 0; mt < 4; ++mt) Oa[mt] *= eg[mt];
    bf16x8 Vb[2], Vsb[2];
#pragma unroll
    for (int ks = 0; ks < 2; ++ks) { Vb[ks] = pack_f4f4(Vn[2 * ks], Vn[2 * ks + 1]); Vsb[ks] = pack_f4f4(Vn[2 * ks] * es[2 * ks], Vn[2 * ks + 1] * es[2 * ks + 1]); }
#pragma unroll
    for (int mt = 0; mt < 4; ++mt) Sacc[mt] *= gm;
    asm volatile("s_waitcnt lgkmcnt(0)" ::: "memory"); __builtin_amdgcn_sched_barrier(0);
#pragma unroll
    for (int mt = 0; mt < 4; ++mt)
#pragma unroll
        for (int ks = 0; ks < 2; ++ks) { const bf16x8 kf = (bf16x8){klo[mt][ks][0], klo[mt][ks][1], klo[mt][ks][2], klo[mt][ks][3], khi[mt][ks][0], khi[mt][ks][1], khi[mt][ks][2], khi[mt][ks][3]};
            Sacc[mt] = __builtin_amdgcn_mfma_f32_16x16x32_bf16(kf, Vsb[ks], Sacc[mt], 0, 0, 0); }
#pragma unroll
    for (int mt = 0; mt < 4; ++mt)
#pragma unroll
        for (int ks = 0; ks < 2; ++ks) { if (ks == 1 && mt < 2) continue;
            Oa[mt] = __builtin_amdgcn_mfma_f32_16x16x32_bf16(af[mt][ks], Vb[ks], Oa[mt], 0, 0, 0); }
#pragma unroll
    for (int mt = 0; mt < 4; ++mt)
#pragma unroll
        for (int r = 0; r < 4; ++r) { const int p = 16 * mt + 4 * g + r, i = dir ? 63 - p : p;
            Oout[(size_t)i * PLD + c] = (bf16)(pk2(Oa[mt][r], 0.f) & 0xffffu); }
}
__device__ __forceinline__ void dn_scan_unit(Frame& F, const Args& a, int b, int h, int dir) {
    bf16* P = (bf16*)(a.ws + WS_P);
    const int w = F.wave, lane = F.lane;
#define DN_BAR() do { asm volatile("s_waitcnt lgkmcnt(0)" ::: "memory"); __builtin_amdgcn_s_barrier(); asm volatile("" ::: "memory"); } while (0)
    if (w < 4) {
        f32x4 Sacc[4];
#pragma unroll
        for (int mt = 0; mt < 4; ++mt) Sacc[mt] = (f32x4){0.f, 0.f, 0.f, 0.f};
        bf16* Ob = P + (size_t)b * SEQ * PLD + (dir ? C_OB : C_OF) + h * 64 + 16 * w;
        DN_BAR();
        int slot = 0;
#pragma unroll 1
        for (int s = 0; s < 128; ++s) {
            const int cc = dir ? 127 - s : s;
            dn_scan_step(F.lds + slot * DNX_SZ, Sacc, w, lane, Ob + (size_t)cc * 64 * PLD, dir);
            slot = slot == 2 ? 0 : slot + 1;
            DN_BAR();
        }
    } else {
        const int hw = w - 4;
        const bf16* QKB = (const bf16*)a.out + (size_t)M * 1024 + (size_t)dir * M * 512;
        const float* BAg = (const float*)(a.ws + WS_BA);
        const char* gp[10]; long gstep[10];
#pragma unroll
        for (int i = 0; i < 10; ++i) { const int pid = hw * 10 + i, blk = pid >> 3, pc = pid & 7, r = 8 * pc + (lane >> 3), cp = lane & 7;
            const int key = blk == 4 ? (r & 7) : ((r >> 1) & 7), cs = cp ^ key, srow = (blk == 1 || blk == 4) ? (dir ? 63 - r : r) : r;
            const size_t tokb = (size_t)b * SEQ;
            if (blk == 2) { gp[i] = (const char*)(QKB + (tokb + srow) * 512 + h * 64 + cs * 8); gstep[i] = 64L * 512 * 2; }
            else { const int col = blk == 0 ? (dir ? SWB : SWF) : blk == 1 ? SQ : blk == 3 ? (dir ? SUB : SUF) : SK;
                   gp[i] = (const char*)(P + (tokb + srow) * PLD + col + h * 64 + cs * 8); gstep[i] = 64L * PLD * 2; } }
        const char* ggc = (const char*)(BAg + ((size_t)b * SEQ + lane) * 32 + dir * 8 + h);
#define DN_ISSUE(n, slot_) do { const int cn_ = dir ? 127 - (n) : (n); LAS unsigned char* sb_ = F.lds + (slot_) * DNX_SZ; \
        _Pragma("unroll") for (int i = 0; i < 10; ++i) { const int pid = hw * 10 + i; \
            __builtin_amdgcn_global_load_lds((const unsigned*)(gp[i] + (long)cn_ * gstep[i]), (LAS unsigned*)(sb_ + (pid >> 3) * 8192 + (pid & 7) * 1024), 16, 0, 0); } \
        __builtin_amdgcn_global_load_lds((const unsigned*)(ggc + (long)cn_ * (64L * 32 * 4)), (LAS unsigned*)(sb_ + DNX_GC + hw * 512), 4, 0, 0); \
        __builtin_amdgcn_global_load_lds((const unsigned*)(ggc + (long)cn_ * (64L * 32 * 4) + 64), (LAS unsigned*)(sb_ + DNX_GC + hw * 512 + 256), 4, 0, 0); } while (0)
        DN_ISSUE(0, 0); DN_ISSUE(1, 1);
        asm volatile("s_waitcnt vmcnt(12)" ::: "memory");
        DN_BAR();
        int slot2 = 2;
#pragma unroll 1
        for (int s = 0; s < 128; ++s) {
            if (s + 2 < 128) { DN_ISSUE(s + 2, slot2); asm volatile("s_waitcnt vmcnt(12)" ::: "memory"); }
            else { asm volatile("s_waitcnt vmcnt(0)" ::: "memory"); }
            slot2 = slot2 == 2 ? 0 : slot2 + 1;
            DN_BAR();
        }
#undef DN_ISSUE
    }
#undef DN_BAR
    __syncthreads();
}
__device__ __forceinline__ void dn_combine(Frame& F, const Args& a) {
    bf16* P = (bf16*)(a.ws + WS_P);
    const float* og = a.in[11];
    const int gw = F.vcu * NWAVES + F.wave, NGW = F.G * NWAVES, c0 = F.lane * 8;
    for (int row = gw; row < M; row += NGW) {
        bf16* rp = P + (size_t)row * PLD;
        float of[8], ob[8]; unpack8(*(const u32x4*)(rp + C_OF + c0), of); unpack8(*(const u32x4*)(rp + C_OB + c0), ob);
        float s[8], ss = 0.f;
#pragma unroll
        for (int j = 0; j < 8; ++j) { s[j] = of[j] + ob[j]; ss += s[j] * s[j]; }
        ss += __shfl_xor(ss, 1); ss += __shfl_xor(ss, 2); ss += __shfl_xor(ss, 4);
        const float rstd = __builtin_amdgcn_rsqf(ss * (1.0f / 64) + EPS);
        bf16* zp = rp + C_DZ + c0; float z[8]; unpack8(*(const u32x4*)zp, z);
        const f32x4 g0 = *(const f32x4*)(og + (c0 & 63)), g1 = *(const f32x4*)(og + (c0 & 63) + 4);
        float y[8];
#pragma unroll
        for (int j = 0; j < 4; ++j) { y[j] = s[j] * rstd * g0[j] * siluf_(z[j]); y[4 + j] = s[4 + j] * rstd * g1[j] * siluf_(z[4 + j]); }
        *(u32x4*)zp = pack8(y);
    }
}
__device__ __forceinline__ void ffn_fixup_panel(Frame& F, const Args& a, int pm) {
    bf16* P = (bf16*)(a.ws + WS_P); const float* UE = (const float*)(a.ws + WS_UE);
    const float* cw = a.in[22]; const float* cb = a.in[23];
    for (int e = F.tid; e < 8 * DFF; e += 512) { const int k = e / DFF, ch = e % DFF, g = pm * 4 + (k >> 1), last = k & 1;
        const int row = g * 64 + (last ? 63 : 0);
        const float* pu; const float* cu; const float* nu; bool hp = true, hn = true;
        if (!last) { hp = (row % SEQ) != 0; pu = UE + ((size_t)(g > 0 ? g - 1 : 0) * 4 + 3) * NUP; cu = UE + ((size_t)g * 4 + 0) * NUP; nu = UE + ((size_t)g * 4 + 1) * NUP; }
        else { hn = (row % SEQ) != SEQ - 1; pu = UE + ((size_t)g * 4 + 2) * NUP; cu = UE + ((size_t)g * 4 + 3) * NUP; nu = UE + ((size_t)(g < 511 ? g + 1 : 511) * 4 + 0) * NUP; }
        const float pg = hp ? pu[ch] : 0.f, pv = hp ? pu[DFF + ch] : 0.f, ng = hn ? nu[ch] : 0.f, nv = hn ? nu[DFF + ch] : 0.f;
        const float gate = cw[ch] * pg + cw[NUP + ch] * cu[ch] + cw[2 * NUP + ch] * ng + cb[ch];
        const float val = cw[DFF + ch] * pv + cw[NUP + DFF + ch] * cu[DFF + ch] + cw[2 * NUP + DFF + ch] * nv + cb[DFF + ch];
        P[(size_t)row * PLD + C_ACT + ch] = (bf16)(pk2(siluf_(gate) * val, 0.f) & 0xffffu); }
}

__global__ void __launch_bounds__(NWAVES * 64, 2) fwd_kernel(Args args) {
    extern __shared__ __attribute__((aligned(16))) unsigned char lds[];
    Frame F;
    F.lds = (LAS unsigned char*)lds;
    F.MISC = (volatile LAS unsigned*)(F.lds + MISC_OFF);
    F.tid = threadIdx.x; F.lane = F.tid & 63; F.wave = __builtin_amdgcn_readfirstlane(F.tid >> 6);
    F.G = gridDim.x; { const int bx = blockIdx.x; F.vcu = (F.G % 8 == 0) ? (bx % 8) * (F.G / 8) + bx / 8 : bx; }
    unsigned char* ws = args.ws;
    F.ctl = (gu32*)(ws + WS_CTL);
    for (int u = F.tid; u < (LDS_BYTES - LDSCTL_OFF) / 4; u += NWAVES * 64) ((LAS unsigned*)(F.lds + LDSCTL_OFF))[u] = 0u;
    __syncthreads();
    const int lo = args.ph_lo, hi = args.ph_hi;
    const bool single = (hi - lo) > 1;
    XcdBarrier bar; bar.bar = (unsigned*)(F.ctl + CW_BAR); bar.x = 0; bar.st = nullptr;
    if (single) bar = xcd_barrier_post((unsigned*)(F.ctl + CW_BAR), F.MISC + 8);
#ifndef PH_MASK
#define PH_MASK 0x1FF
#endif
#define IN(k) (((PH_MASK >> (k)) & 1) && lo <= (k) && (k) < hi)
#define SEAM(k) do { if (IN(k) && IN((k) + 1)) xcd_barrier(bar); } while (0)
    bf16* P = (bf16*)(ws + WS_P);
    const int bid = (int)blockIdx.x;
#ifdef DBG_TIME
    unsigned long long* tsb = (unsigned long long*)(ws + WS_CTL + 65536);
#define TS(k) do { if (bid == 0 && F.tid == 0) __hip_atomic_store(&tsb[k], (unsigned long long)__builtin_amdgcn_s_memrealtime(), __ATOMIC_RELAXED, __HIP_MEMORY_SCOPE_AGENT); } while (0)
#define TSB(k, blk) do { if (bid == (blk) && F.tid == 0) __hip_atomic_store(&tsb[k], (unsigned long long)__builtin_amdgcn_s_memrealtime(), __ATOMIC_RELAXED, __HIP_MEMORY_SCOPE_AGENT); } while (0)
#else
#define TS(k) do {} while (0)
#define TSB(k, blk) do {} while (0)
#endif
    TS(0);

    if (IN(0)) { p0_prologue(F, args); }
    SEAM(0); TS(1);
    if (IN(1)) {
        { pg8::Gemm g{(const bf16*)args.out, (const bf16*)(ws + WS_WIN), M, 3584, 1024, 1024, 1024}; pg8::StaticOrder S; S.init(M, 3584, F.G, bid);
          EpiInProj E{P, (float*)(ws + WS_BA)};
          pg8::gemm_phase<EpiInProj, pg8::StaticOrder, true, true>(F.lds + RING_OFF, g, S, E); }
        { pg8::Gemm g{(const bf16*)(ws + WS_MEMN), (const bf16*)(ws + WS_WKV), BATCH * NMEM, 1024, 1024, 1024, 1024}; pg8::StaticOrder S; S.init(BATCH * NMEM, 1024, F.G, bid);
          EpiBf16 E{(bf16*)(ws + WS_KV), 1024};
          pg8::gemm_phase<EpiBf16, pg8::StaticOrder, true, true>(F.lds + RING_OFF, g, S, E); }
    }
    SEAM(1); TS(2);
    if (IN(2)) {
        if (F.G == 256) dn_prep_block(F, args, bid >> 6, (bid >> 3) & 7, (bid & 7) * 16, 16);
        else for (int u = bid; u < 4096; u += F.G) dn_prep_block(F, args, u >> 10, (u >> 7) & 7, u & 127, 1);
    }
    TS(12); SEAM(2); TS(3);
    if (IN(3)) {
        const int ndn = F.G >= 128 ? 64 : 0;
        if (bid < ndn) { dn_scan_unit(F, args, bid >> 4, (bid >> 1) & 7, bid & 1); }
        else {
            if (ndn == 0) for (int u = bid; u < 64; u += F.G) dn_scan_unit(F, args, u >> 4, (u >> 1) & 7, u & 1);
            const int nb = F.G - ndn, me = bid - ndn;
            for (int u = me; u < 1024; u += nb) {
                if (u < 512) attnA_unit(F, args, u >> 7, (u >> 1) & 63, u & 1);
                else { const int v = u - 512; xattn_unit(F, args, v >> 7, (v >> 2) & 31, v & 3); }
            }
        }
    }
    TS(10); TSB(11, 64); SEAM(3); TS(4);
    if (IN(4)) {
        dn_combine(F, args);
        pg8::Gemm g{(const bf16*)args.out, (const bf16*)(ws + WS_WIN) + (size_t)3584 * 1024, M, 3072, 1024, 1024, 1024}; pg8::StaticOrder S; S.init(M, 3072, F.G, bid);
        EpiBf16 E{P + C_GATE, PLD};
        pg8::gemm_phase<EpiBf16, pg8::StaticOrder, true, true>(F.lds + RING_OFF, g, S, E);
    }
    SEAM(4); TS(5);
    if (IN(5)) {
        { pg8::Gemm g{P + C_AQ, (const bf16*)(ws + WS_WBR), M, 1024, 512, PLD, 512}; pg8::StaticOrder S; S.init(M, 1024, F.G, bid);
          EpiBranch<0> E{P}; pg8::gemm_phase<EpiBranch<0>, pg8::StaticOrder, true, true>(F.lds + RING_OFF, g, S, E); }
        VM_WAIT(); __syncthreads();
        { pg8::Gemm g{P + C_DZ, (const bf16*)(ws + WS_WBR) + (size_t)1024 * 512, M, 1024, 512, PLD, 512}; pg8::StaticOrder S; S.init(M, 1024, F.G, bid);
          EpiBranch<1> E{P}; pg8::gemm_phase<EpiBranch<1>, pg8::StaticOrder, true, true>(F.lds + RING_OFF, g, S, E); }
        VM_WAIT(); __syncthreads();
        { pg8::Gemm g{P + C_MQ, (const bf16*)(ws + WS_WBR) + (size_t)2 * 1024 * 512, M, 1024, 512, PLD, 512}; pg8::StaticOrder S; S.init(M, 1024, F.G, bid);
          EpiBranch<2> E{P}; pg8::gemm_phase<EpiBranch<2>, pg8::StaticOrder, true, true>(F.lds + RING_OFF, g, S, E); }
    }
    SEAM(5); TS(6);
    if (IN(6)) {
        pg8::Gemm g{P + C_MG, (const bf16*)(ws + WS_WOUT), M, 1024, 1024, PLD, 1024}; pg8::StaticOrder S; S.init(M, 1024, F.G, bid);
        EpiWout E{args.in[0], args.out, P, (float*)(ws + WS_SSQ)};
        pg8::gemm_phase<EpiWout, pg8::StaticOrder, true, true>(F.lds + RING_OFF, g, S, E);
    }
    SEAM(6); TS(7);
    if (IN(7)) {
        pg8::Gemm g{P + C_X1B, (const bf16*)(ws + WS_WUP), M, NUP, 1024, PLD, 1024}; pg8::StaticOrder S; S.init(M, NUP, F.G, bid);
        EpiUp E{(const float*)(ws + WS_SSQ), args.in[22], args.in[23], P, (float*)(ws + WS_UE)};
        pg8::gemm_phase<EpiUp, pg8::StaticOrder, true, true>(F.lds + RING_OFF, g, S, E);
    }
    SEAM(7); TS(8);
    if (IN(8)) {
        pg8::Gemm g{P + C_ACT, (const bf16*)(ws + WS_WDN), M, 1024, DFF, PLD, DFF}; pg8::StaticOrder S; S.init(M, 1024, F.G, bid);
        { Unit u; int prev = -1; for (int i = 0; S.next(i, u); ++i) { if (u.pm != prev) ffn_fixup_panel(F, args, u.pm); prev = u.pm; } }
        VM_WAIT(); __syncthreads();
        EpiDown E{args.out};
        pg8::gemm_phase<EpiDown, pg8::StaticOrder, true, true>(F.lds + RING_OFF, g, S, E);
    }
    TS(9);
#ifdef DBG_TIME
    if (bid == 0 && F.tid == 0) {
        const unsigned long long te = __builtin_amdgcn_s_memrealtime();
        const unsigned long long d1 = __hip_atomic_load(&tsb[DBG_A1], __ATOMIC_RELAXED, __HIP_MEMORY_SCOPE_AGENT) - __hip_atomic_load(&tsb[DBG_A0], __ATOMIC_RELAXED, __HIP_MEMORY_SCOPE_AGENT);
        const unsigned long long d2 = __hip_atomic_load(&tsb[DBG_B1], __ATOMIC_RELAXED, __HIP_MEMORY_SCOPE_AGENT) - __hip_atomic_load(&tsb[DBG_B0], __ATOMIC_RELAXED, __HIP_MEMORY_SCOPE_AGENT);
        const unsigned long long W = d1 + 100000ull * (d2 / 1000ull);
        while (__builtin_amdgcn_s_memrealtime() - te < W) __builtin_amdgcn_s_sleep(32);
    }
#endif
#undef IN
#undef SEAM
}

constexpr int N_PHASES = 9;
#ifndef MK_PER_PHASE
#define MK_PER_PHASE 0
#endif
extern "C" void kernel_launch(void* const* d_in, const int* in_sizes, int n_in, void* d_out, int out_size, void* d_ws, size_t ws_size, hipStream_t stream) {
    static int grid = 0;
    if (grid == 0) {
        if (n_in != 25 || in_sizes[0] != M * DM || out_size != M * DM || ws_size < WS_END) {
            fprintf(stderr, "kernel_launch: unexpected shapes (n_in %d, in0 %d, out %d, ws %zu); nothing launched\n", n_in, n_in > 0 ? in_sizes[0] : -1, out_size, ws_size); grid = -1; return; }
        int dev = 0, cus = 0, per_cu = 0;
        if (hipGetDevice(&dev) != hipSuccess || hipDeviceGetAttribute(&cus, hipDeviceAttributeMultiprocessorCount, dev) != hipSuccess) { grid = -1; return; }
        if (hipFuncSetAttribute((const void*)fwd_kernel, hipFuncAttributeMaxDynamicSharedMemorySize, LDS_BYTES) != hipSuccess) { fprintf(stderr, "kernel_launch: hipFuncSetAttribute failed\n"); grid = -1; return; }
        if (hipOccupancyMaxActiveBlocksPerMultiprocessor(&per_cu, (const void*)fwd_kernel, NWAVES * 64, LDS_BYTES) != hipSuccess || per_cu < 1) { fprintf(stderr, "kernel_launch: occupancy query reports %d\n", per_cu); }
        (void)hipGetLastError();
        grid = cus;
    }
    if (grid < 0) return;
    if (hipMemsetAsync((char*)d_ws + WS_CTL, 0, CTL_ZERO_BYTES, stream) != hipSuccess) return;
    Args a{};
    for (int i = 0; i < 25; ++i) a.in[i] = (const float*)d_in[i];
    a.out = (float*)d_out; a.ws = (unsigned char*)d_ws;
    if (MK_PER_PHASE) {
        for (int p = 0; p < N_PHASES; ++p) { a.ph_lo = p; a.ph_hi = p + 1; hipLaunchKernelGGL(fwd_kernel, dim3(grid), dim3(NWAVES * 64), LDS_BYTES, stream, a); }
    } else {
        a.ph_lo = 0; a.ph_hi = N_PHASES; hipLaunchKernelGGL(fwd_kernel, dim3(grid), dim3(NWAVES * 64), LDS_BYTES, stream, a);
    }
}
```

```cpp
#include <hip/hip_runtime.h>
#include <cstdio>
#include <cstdint>
#include <cmath>
namespace pg8 {
#define PG8_LAS __attribute__((address_space(3)))
typedef unsigned short bf16_t;
typedef short bf16x8 __attribute__((ext_vector_type(8)));
typedef float f32x4 __attribute__((ext_vector_type(4)));
typedef unsigned u32x4 __attribute__((ext_vector_type(4)));
constexpr int BM = 256, BK = 64, HALF = 128, HTB = HALF * BK * 2  , STAGE_BYTES = 8 * HTB, NXCD = 8, WGM = 8;

__host__ __device__ __forceinline__ int lds_byte(int r, int c) { const int st = (r >> 4) * 2 + (c >> 5), rr = r & 15, cc = c & 31, ob = rr * 64 + cc * 2; return st * 1024 + (ob ^ (((ob >> 9) & 1) << 5)); }
__host__ __device__ __forceinline__ void stage_rc(int b, int& R, int& C) { const int st = b / 1024, sb = b % 1024, swz = sb ^ (((sb >> 9) & 1) << 5); R = (st >> 1) * 16 + swz / 64; C = (st & 1) * 32 + (swz % 64) / 2; }
__host__ __device__ __forceinline__ int perm32(int rho) { const int n = rho >> 4, i = rho & 15; return 8 * (i >> 2) + 4 * n + (i & 3); }

struct Unit { int pm, pn; };
struct Gemm { const bf16_t* A; const bf16_t* Bt; int M, N, K, lda, ldb; };

struct StaticOrder {
    int nM, nN, nwg, G, c;
    __host__ __device__ __forceinline__ void init(int M, int N, int G_, int c_) { nM = M / BM; nN = N / BM; nwg = nM * nN; G = G_; c = c_; }
    __host__ __device__ __forceinline__ bool next(int i, Unit& u) const {
        const long L = (long)i * G + c; if (L >= nwg) return false;
        int wgid = (int)L; { const int q = nwg / NXCD, r = nwg % NXCD, xcd = wgid % NXCD, off = wgid / NXCD; wgid = (xcd < r ? xcd * (q + 1) : r * (q + 1) + (xcd - r) * q) + off; }
        const int nig = WGM * nN, gid = wgid / nig, fm = gid * WGM, gsz = (nM - fm) < WGM ? (nM - fm) : WGM;
        u.pm = fm + ((wgid % nig) % gsz); u.pn = (wgid % nig) / gsz; return true;
    }
    __device__ __forceinline__ void a_ready(const Unit&) const {}
    __device__ __forceinline__ void done(const Unit&) const {}
};

template <class Epi, class Sched, bool ALIGN_EPI = false, bool SP2 = false>
__device__ __forceinline__ void gemm_phase(PG8_LAS unsigned char* lds, const Gemm g, const Sched& S, const Epi& E) {
    const int tid = threadIdx.x, wid = __builtin_amdgcn_readfirstlane(tid >> 6), lane = tid & 63, wr = wid >> 2, wc = wid & 3, fr = lane & 15, fq = lane >> 4;
    const int K = g.K, nt = K / BK;
    unsigned voffA[2], voffB[2];
#pragma unroll
    for (int i = 0; i < 2; ++i) { int R, C; stage_rc(tid * 16 + i * 8192, R, C); const int Rb = Epi::PERM ? ((R & ~31) + perm32(R & 31)) : R;
        voffA[i] = (unsigned)(R * g.lda + C) * 2u; voffB[i] = (unsigned)(Rb * g.ldb + C) * 2u; }
    const size_t kstep = (size_t)(BK * 2);
    const size_t hstepA = (size_t)HALF * g.lda * 2, hstepB = (size_t)HALF * g.ldb * 2;
    const size_t tstepA = 2 * hstepA, tstepB = 2 * hstepB;
    const unsigned ldsw = (unsigned)wid * 1024u;
    const int aoff = lds_byte(wr * 64 + fr, fq * 8), boff = lds_byte(wc * 32 + fr, fq * 8);
#define PG8_SA(b, h) (((b) * 2 + (h)) * HTB)
#define PG8_SB(b, h) ((4 + (b) * 2 + (h)) * HTB)
#define PG8_STAGE(bufoff, gbase, voff) do { _Pragma("unroll") for (int _i = 0; _i < 2; ++_i) \
        __builtin_amdgcn_global_load_lds((const unsigned*)((const char*)(gbase) + (voff)[_i]), (PG8_LAS unsigned*)(lds + (bufoff) + ldsw + _i * 8192), 16, 0, 0); } while (0)
#define PG8_LDA(dst, b, h) do { _Pragma("unroll") for (int m = 0; m < 4; ++m) _Pragma("unroll") for (int k = 0; k < 2; ++k) dst[m][k] = *(const PG8_LAS bf16x8*)(lds + PG8_SA(b, h) + aoff + m * 2048 + k * 1024); } while (0)
#define PG8_LDB(dst, b, h) do { _Pragma("unroll") for (int n = 0; n < 2; ++n) _Pragma("unroll") for (int k = 0; k < 2; ++k) dst[n][k] = *(const PG8_LAS bf16x8*)(lds + PG8_SB(b, h) + boff + n * 2048 + k * 1024); } while (0)
#define PG8_MMA(ai, bj, At, Bt) do { __builtin_amdgcn_s_setprio(1); _Pragma("unroll") for (int m = 0; m < 4; ++m) _Pragma("unroll") for (int n = 0; n < 2; ++n) _Pragma("unroll") for (int k = 0; k < 2; ++k) \
        acc[ai][bj][m][n] = __builtin_amdgcn_mfma_f32_16x16x32_bf16(Bt[n][k], At[m][k], acc[ai][bj][m][n], 0, 0, 0); __builtin_amdgcn_s_setprio(0); } while (0)
#define PG8_WAIT_V(n) asm volatile("s_waitcnt vmcnt(" #n ")" ::: "memory")
#define PG8_WAIT_L(n) asm volatile("s_waitcnt lgkmcnt(" #n ")" ::: "memory")
#define PG8_BAR __builtin_amdgcn_s_barrier()
#define PG8_SCHED __builtin_amdgcn_sched_barrier(0)
    Unit cur, nxt; int ui = 0;
    if (!S.next(0, cur)) return;
    f32x4 acc[2][2][4][2];
#pragma unroll
    for (int a = 0; a < 2; ++a)
#pragma unroll
        for (int b = 0; b < 2; ++b)
#pragma unroll
            for (int m = 0; m < 4; ++m)
#pragma unroll
                for (int n = 0; n < 2; ++n) acc[a][b][m][n] = (f32x4){0.f, 0.f, 0.f, 0.f};
    bf16x8 At[4][2], B0[2][2], B1[2][2];
    const char* cA = (const char*)g.A + (size_t)cur.pm * tstepA; const char* cB = (const char*)g.Bt + (size_t)cur.pn * tstepB;
    S.a_ready(cur);
    if constexpr (SP2) {
        PG8_STAGE(PG8_SB(0, 0), cB, voffB); PG8_STAGE(PG8_SB(0, 1), cB + hstepB, voffB); PG8_STAGE(PG8_SA(0, 0), cA, voffA); PG8_STAGE(PG8_SA(0, 1), cA + hstepA, voffA);
        if (wr == 1) PG8_BAR;
        PG8_WAIT_V(2); PG8_BAR;
        PG8_STAGE(PG8_SB(1, 0), cB + kstep, voffB); PG8_STAGE(PG8_SA(1, 0), cA + kstep, voffA); PG8_STAGE(PG8_SB(1, 1), cB + hstepB + kstep, voffB);
        PG8_WAIT_V(6); PG8_BAR;
    } else {
        PG8_STAGE(PG8_SB(0, 0), cB, voffB); PG8_STAGE(PG8_SA(0, 0), cA, voffA); PG8_STAGE(PG8_SB(0, 1), cB + hstepB, voffB); PG8_STAGE(PG8_SA(0, 1), cA + hstepA, voffA);
        if (wr == 1) PG8_BAR;
        PG8_WAIT_V(4); PG8_BAR;
        PG8_STAGE(PG8_SB(1, 0), cB + kstep, voffB); PG8_STAGE(PG8_SA(1, 0), cA + kstep, voffA); PG8_STAGE(PG8_SB(1, 1), cB + hstepB + kstep, voffB);
        PG8_WAIT_V(6); PG8_BAR;
    }
    for (;;) {
        const bool has_next = S.next(ui + 1, nxt);
        const char* nA = has_next ? (const char*)g.A + (size_t)nxt.pm * tstepA : cA; const char* nB = has_next ? (const char*)g.Bt + (size_t)nxt.pn * tstepB : cB;
        for (int t = 0; t < nt; t += 2) {
            const bool last = (t == nt - 2);
            const char* a1 = cA + (size_t)(t + 1) * kstep;
            const char* a2 = last ? nA : cA + (size_t)(t + 2) * kstep; const char* b2 = last ? nB : cB + (size_t)(t + 2) * kstep;
            const char* a3 = a2 + kstep; const char* b3 = b2 + kstep;
            if (last && has_next) S.a_ready(nxt);
            if constexpr (SP2) {
            PG8_LDB(B0, 0, 0); PG8_LDB(B1, 0, 1); PG8_SCHED; PG8_LDA(At, 0, 0); PG8_STAGE(PG8_SA(1, 1), a1 + hstepA, voffA);
            PG8_WAIT_V(8); PG8_WAIT_L(0); PG8_BAR; PG8_MMA(0, 0, At, B0); PG8_MMA(0, 1, At, B1); PG8_BAR; PG8_SCHED;
            PG8_LDA(At, 0, 1); PG8_STAGE(PG8_SB(0, 0), b2, voffB); PG8_STAGE(PG8_SB(0, 1), b2 + hstepB, voffB); PG8_STAGE(PG8_SA(0, 0), a2, voffA);
            PG8_WAIT_V(8); PG8_WAIT_L(0); PG8_BAR; PG8_MMA(1, 0, At, B0); PG8_MMA(1, 1, At, B1); PG8_BAR; PG8_SCHED;
            PG8_LDB(B0, 1, 0); PG8_LDB(B1, 1, 1); PG8_SCHED; PG8_LDA(At, 1, 0); PG8_STAGE(PG8_SA(0, 1), a2 + hstepA, voffA);
            PG8_WAIT_V(8); PG8_WAIT_L(0); PG8_BAR; PG8_MMA(0, 0, At, B0); PG8_MMA(0, 1, At, B1); PG8_BAR; PG8_SCHED;
            PG8_LDA(At, 1, 1); PG8_STAGE(PG8_SB(1, 0), b3, voffB); PG8_STAGE(PG8_SB(1, 1), b3 + hstepB, voffB); PG8_STAGE(PG8_SA(1, 0), a3, voffA);
            PG8_WAIT_V(8); PG8_WAIT_L(0); PG8_BAR; PG8_MMA(1, 0, At, B0); PG8_MMA(1, 1, At, B1); PG8_BAR; PG8_SCHED;
            } else {
            PG8_LDB(B0, 0, 0); PG8_SCHED; PG8_LDA(At, 0, 0); PG8_STAGE(PG8_SA(1, 1), a1 + hstepA, voffA);
            PG8_WAIT_L(8); PG8_BAR; PG8_WAIT_L(0); PG8_MMA(0, 0, At, B0); PG8_BAR; PG8_SCHED;
            PG8_LDB(B1, 0, 1); PG8_STAGE(PG8_SB(0, 0), b2, voffB);
            PG8_BAR; PG8_WAIT_L(0); PG8_MMA(0, 1, At, B1); PG8_BAR;
            PG8_LDA(At, 0, 1); PG8_STAGE(PG8_SA(0, 0), a2, voffA);
            PG8_BAR; PG8_WAIT_L(0); PG8_MMA(1, 0, At, B0); PG8_BAR; PG8_SCHED;
            PG8_STAGE(PG8_SB(0, 1), b2 + hstepB, voffB);
            PG8_WAIT_V(6); PG8_BAR; PG8_MMA(1, 1, At, B1); PG8_BAR;
            PG8_LDB(B0, 1, 0); PG8_SCHED; PG8_LDA(At, 1, 0); PG8_STAGE(PG8_SA(0, 1), a2 + hstepA, voffA);
            PG8_WAIT_L(8); PG8_BAR; PG8_WAIT_L(0); PG8_MMA(0, 0, At, B0); PG8_BAR; PG8_SCHED;
            PG8_LDB(B1, 1, 1); PG8_STAGE(PG8_SB(1, 0), b3, voffB);
            PG8_BAR; PG8_WAIT_L(0); PG8_MMA(0, 1, At, B1); PG8_BAR;
            PG8_LDA(At, 1, 1); PG8_STAGE(PG8_SA(1, 0), a3, voffA);
            PG8_BAR; PG8_WAIT_L(0); PG8_MMA(1, 0, At, B0); PG8_BAR; PG8_SCHED;
            PG8_STAGE(PG8_SB(1, 1), b3 + hstepB, voffB);
            PG8_WAIT_V(6); PG8_BAR; PG8_MMA(1, 1, At, B1); PG8_BAR;
            }
        }
        if constexpr (ALIGN_EPI) { if (wr == 0) PG8_BAR; }
        if constexpr (!Epi::AFTER_DRAIN) { E(acc, cur, wr, wc, fr, fq); S.done(cur); }
        if (!has_next) break;
#pragma unroll
        for (int a = 0; a < 2; ++a)
#pragma unroll
            for (int b = 0; b < 2; ++b)
#pragma unroll
                for (int m = 0; m < 4; ++m)
#pragma unroll
                    for (int n = 0; n < 2; ++n) acc[a][b][m][n] = (f32x4){0.f, 0.f, 0.f, 0.f};
        cur = nxt; cA = nA; cB = nB; ++ui;
        if constexpr (ALIGN_EPI) { if (wr == 1) PG8_BAR; }
    }
    PG8_WAIT_V(0);
    if constexpr (!ALIGN_EPI) { if (wr == 0) PG8_BAR; }
    PG8_BAR;
    if constexpr (Epi::AFTER_DRAIN) { E.fused(acc, cur, wr, wc, fr, fq, lds, wid, lane); S.done(cur); }
#undef PG8_SA
#undef PG8_SB
#undef PG8_STAGE
#undef PG8_LDA
#undef PG8_LDB
#undef PG8_MMA
#undef PG8_WAIT_V
#undef PG8_WAIT_L
#undef PG8_BAR
#undef PG8_SCHED
}
}

#define LAS __attribute__((address_space(3)))
#define GAS __attribute__((address_space(1)))
typedef unsigned short bf16;
typedef short bf16x8 __attribute__((ext_vector_type(8)));
typedef short s16x4 __attribute__((ext_vector_type(4)));
typedef float f32x4 __attribute__((ext_vector_type(4)));
typedef float f32x16 __attribute__((ext_vector_type(16)));
typedef unsigned u32x4 __attribute__((ext_vector_type(4)));
typedef unsigned u32x2 __attribute__((ext_vector_type(2)));
typedef float f32x2_t __attribute__((ext_vector_type(2)));
typedef __bf16 bf16x2_t __attribute__((ext_vector_type(2)));

constexpr int BATCH = 4, SEQ = 8192, DM = 1024, M = BATCH * SEQ;
constexpr int NMEM = 256;
constexpr int PLD = 6400;
constexpr int C_AQ = 0, C_AK = 512, C_AV = 640, C_DQ = 768, C_DK = 1280, C_DV = 1792, C_DZ = 2304, C_MQ = 2816, C_GATE = 3328;
constexpr int C_MG = 768, C_X1B = 1792, C_ACT = 2816;
constexpr int NIN = 6656;
constexpr int DFF = 2816, NUP = 5632;
constexpr float EPS = 1e-6f;
constexpr float LOG2E = 1.4426950408889634f;

__device__ __forceinline__ float bf_lo(unsigned w) { return __uint_as_float(w << 16); }
__device__ __forceinline__ float bf_hi(unsigned w) { return __uint_as_float(w & 0xffff0000u); }
__device__ __forceinline__ unsigned pk2(float lo, float hi) { f32x2_t v = {lo, hi}; bf16x2_t b = __builtin_convertvector(v, bf16x2_t); return __builtin_bit_cast(unsigned, b); }
__device__ __forceinline__ float fexp2(float x) { return __builtin_amdgcn_exp2f(x); }
__device__ __forceinline__ float frcp(float x) { return __builtin_amdgcn_rcpf(x); }
__device__ __forceinline__ float sigmoidf_(float x) { return frcp(1.0f + fexp2(-x * LOG2E)); }
__device__ __forceinline__ float siluf_(float x) { return x * sigmoidf_(x); }
__device__ __forceinline__ void unpack8(const u32x4 w, float (&v)[8]) {
    v[0] = bf_lo(w.x); v[1] = bf_hi(w.x); v[2] = bf_lo(w.y); v[3] = bf_hi(w.y); v[4] = bf_lo(w.z); v[5] = bf_hi(w.z); v[6] = bf_lo(w.w); v[7] = bf_hi(w.w); }
__device__ __forceinline__ u32x4 pack8(const float (&v)[8]) { u32x4 w; w.x = pk2(v[0], v[1]); w.y = pk2(v[2], v[3]); w.z = pk2(v[4], v[5]); w.w = pk2(v[6], v[7]); return w; }

using pg8::Unit;
constexpr int HALF = pg8::HALF, BM = pg8::BM;

struct EpiInProj {
    static constexpr bool PERM = true, AFTER_DRAIN = false;
    bf16* P; float* BA;
    __device__ __forceinline__ void operator()(const f32x4 (&acc)[2][2][4][2], const Unit& u, int wr, int wc, int fr, int fq) const {
        const int row0 = u.pm * BM + wr * 64 + fr;
        if (u.pn < 13) {
            const int col0 = u.pn * BM + wc * 32 + 8 * fq;
#pragma unroll
            for (int ai = 0; ai < 2; ++ai)
#pragma unroll
                for (int m = 0; m < 4; ++m) { bf16* rowp = P + (size_t)(row0 + ai * HALF + m * 16) * PLD + col0;
#pragma unroll
                    for (int bj = 0; bj < 2; ++bj) { const f32x4 v0 = acc[ai][bj][m][0], v1 = acc[ai][bj][m][1];
                        u32x4 w; w.x = pk2(v0[0], v0[1]); w.y = pk2(v0[2], v0[3]); w.z = pk2(v1[0], v1[1]); w.w = pk2(v1[2], v1[3]);
                        *(u32x4*)(rowp + bj * HALF) = w; } }
        } else if (wc == 0) {
#pragma unroll
            for (int ai = 0; ai < 2; ++ai)
#pragma unroll
                for (int m = 0; m < 4; ++m) { float* rp = BA + (size_t)(row0 + ai * HALF + m * 16) * 32 + 8 * fq;
                    *(f32x4*)rp = acc[ai][0][m][0]; *(f32x4*)(rp + 4) = acc[ai][0][m][1]; }
        }
    }
};
struct EpiBf16 {
    static constexpr bool PERM = true, AFTER_DRAIN = false;
    bf16* O; int ldc;
    __device__ __forceinline__ void operator()(const f32x4 (&acc)[2][2][4][2], const Unit& u, int wr, int wc, int fr, int fq) const {
        const int row0 = u.pm * BM + wr * 64 + fr, col0 = u.pn * BM + wc * 32 + 8 * fq;
#pragma unroll
        for (int ai = 0; ai < 2; ++ai)
#pragma unroll
            for (int m = 0; m < 4; ++m) { bf16* rowp = O + (size_t)(row0 + ai * HALF + m * 16) * ldc + col0;
#pragma unroll
                for (int bj = 0; bj < 2; ++bj) { const f32x4 v0 = acc[ai][bj][m][0], v1 = acc[ai][bj][m][1];
                    u32x4 w; w.x = pk2(v0[0], v0[1]); w.y = pk2(v0[2], v0[3]); w.z = pk2(v1[0], v1[1]); w.w = pk2(v1[2], v1[3]);
                    *(u32x4*)(rowp + bj * HALF) = w; } }
    }
};
template <int PASS> struct EpiBranch {
    static constexpr bool PERM = true, AFTER_DRAIN = false;
    bf16* P;
    __device__ __forceinline__ void operator()(const f32x4 (&acc)[2][2][4][2], const Unit& u, int wr, int wc, int fr, int fq) const {
        const int row0 = u.pm * BM + wr * 64 + fr, col0 = u.pn * BM + wc * 32 + 8 * fq;
#pragma unroll
        for (int ai = 0; ai < 2; ++ai)
#pragma unroll
            for (int m = 0; m < 4; ++m) { bf16* rowp = P + (size_t)(row0 + ai * HALF + m * 16) * PLD;
#pragma unroll
                for (int bj = 0; bj < 2; ++bj) {
                    const int c = col0 + bj * HALF;
                    const u32x4 gw = *(const u32x4*)(rowp + C_GATE + 1024 * PASS + c);
                    float g[8]; unpack8(gw, g);
                    float pv[8];
                    if (PASS > 0) { const u32x4 mw = *(const u32x4*)(rowp + C_MG + c); unpack8(mw, pv); }
                    else {
#pragma unroll
                        for (int i = 0; i < 8; ++i) pv[i] = 0.f; }
                    const f32x4 v0 = acc[ai][bj][m][0], v1 = acc[ai][bj][m][1];
                    float o[8];
#pragma unroll
                    for (int i = 0; i < 4; ++i) { o[i] = pv[i] + sigmoidf_(g[i]) * v0[i]; o[4 + i] = pv[4 + i] + sigmoidf_(g[4 + i]) * v1[i]; }
                    *(u32x4*)(rowp + C_MG + c) = pack8(o); } }
    }
};
struct EpiWout {
    static constexpr bool PERM = true, AFTER_DRAIN = false;
    const float* x; float* out; bf16* P; float* SSQ; LAS float* xl;
    __device__ __forceinline__ void operator()(const f32x4 (&acc)[2][2][4][2], const Unit& u, int wr, int wc, int fr, int fq) const {
        const int row0 = u.pm * BM + wr * 64 + fr, col0 = u.pn * BM + wc * 32 + 8 * fq;
#pragma unroll
        for (int ai = 0; ai < 2; ++ai)
#pragma unroll
            for (int m = 0; m < 4; ++m) { const int row = row0 + ai * HALF + m * 16; float ss = 0.f;
#pragma unroll
                for (int bj = 0; bj < 2; ++bj) { const int c = col0 + bj * HALF; const size_t off = (size_t)row * DM + c;
                    const f32x4 a0 = *(const f32x4*)(x + off), a1 = *(const f32x4*)(x + off + 4);
                    const f32x4 r0 = a0 + acc[ai][bj][m][0], r1 = a1 + acc[ai][bj][m][1];
                    *(f32x4*)(out + off) = r0; *(f32x4*)(out + off + 4) = r1;
                    ss += (r0[0] * r0[0] + r0[1] * r0[1]) + (r0[2] * r0[2] + r0[3] * r0[3]) + (r1[0] * r1[0] + r1[1] * r1[1]) + (r1[2] * r1[2] + r1[3] * r1[3]);
                    u32x4 w; w.x = pk2(r0[0], r0[1]); w.y = pk2(r0[2], r0[3]); w.z = pk2(r1[0], r1[1]); w.w = pk2(r1[2], r1[3]);
                    *(u32x4*)(P + (size_t)row * PLD + C_X1B + c) = w; }
                ss += __shfl_xor(ss, 16); ss += __shfl_xor(ss, 32);
                if (fq == 0) xl[(ai * HALF + wr * 64 + m * 16 + fr) * 4 + wc] = ss; }
        asm volatile("s_waitcnt lgkmcnt(0)" ::: "memory"); __builtin_amdgcn_s_barrier(); asm volatile("" ::: "memory");
        { const int t = (wr * 4 + wc) * 64 + fq * 16 + fr;
          if (t < 256) { const f32x4 p = *(const LAS f32x4*)(xl + t * 4); SSQ[(size_t)(u.pm * BM + t) * 4 + u.pn] = (p[0] + p[1]) + (p[2] + p[3]); } }
        asm volatile("s_waitcnt lgkmcnt(0)" ::: "memory"); __builtin_amdgcn_s_barrier(); asm volatile("" ::: "memory");
    }
};
template <int CTRL> __device__ __forceinline__ float dpp_mov(float old, float src) {
    return __builtin_bit_cast(float, __builtin_amdgcn_update_dpp(__builtin_bit_cast(int, old), __builtin_bit_cast(int, src), CTRL, 0xF, 0xF, false)); }
struct EpiUp {
    static constexpr bool PERM = true, AFTER_DRAIN = false;
    const float* SSQ; const float* cw; const float* cb; bf16* P; float* UE;
    __device__ __forceinline__ void operator()(f32x4 (&acc)[2][2][4][2], const Unit& u, int wr, int wc, int fr, int fq) const {
        const int row0 = u.pm * BM + wr * 64 + fr;
        { f32x4 sq[2][4];
#pragma unroll
          for (int ai = 0; ai < 2; ++ai)
#pragma unroll
              for (int m = 0; m < 4; ++m) sq[ai][m] = *(const f32x4*)(SSQ + (size_t)(row0 + ai * HALF + m * 16) * 4);
#pragma unroll
          for (int ai = 0; ai < 2; ++ai)
#pragma unroll
              for (int m = 0; m < 4; ++m) { const float rs = __builtin_amdgcn_rsqf(((sq[ai][m][0] + sq[ai][m][1]) + (sq[ai][m][2] + sq[ai][m][3])) * (1.0f / DM) + EPS);
#pragma unroll
                  for (int bj = 0; bj < 2; ++bj)
#pragma unroll
                      for (int n = 0; n < 2; ++n) acc[ai][bj][m][n] *= rs; } }
#pragma unroll
        for (int n = 0; n < 2; ++n) {
            const int a0 = u.pn * 128 + wc * 32 + 8 * fq + 4 * n;
            const f32x4 wg0 = *(const f32x4*)(cw + a0), wg1 = *(const f32x4*)(cw + NUP + a0), wg2 = *(const f32x4*)(cw + 2 * NUP + a0), bg = *(const f32x4*)(cb + a0);
            const f32x4 wv0 = *(const f32x4*)(cw + DFF + a0), wv1 = *(const f32x4*)(cw + NUP + DFF + a0), wv2 = *(const f32x4*)(cw + 2 * NUP + DFF + a0), bv = *(const f32x4*)(cb + DFF + a0);
#pragma unroll
            for (int ai = 0; ai < 2; ++ai) {
                const int g64 = u.pm * 4 + ai * 2 + wr;
#pragma unroll
                for (int m = 0; m < 4; ++m) {
                    const f32x4 ugm = acc[ai][0][m][n], uvm = acc[ai][1][m][n], ugp = acc[ai][0][(m + 3) & 3][n], ugn = acc[ai][0][(m + 1) & 3][n], uvp = acc[ai][1][(m + 3) & 3][n], uvn = acc[ai][1][(m + 1) & 3][n];
                    f32x4 pg, ng, pvv, nv;
#pragma unroll
                    for (int i = 0; i < 4; ++i) {
                        pg[i] = dpp_mov<0x111>(dpp_mov<0x121>(0.f, ugp[i]), ugm[i]);
                        ng[i] = dpp_mov<0x101>(dpp_mov<0x12F>(0.f, ugn[i]), ugm[i]);
                        pvv[i] = dpp_mov<0x111>(dpp_mov<0x121>(0.f, uvp[i]), uvm[i]);
                        nv[i] = dpp_mov<0x101>(dpp_mov<0x12F>(0.f, uvn[i]), uvm[i]); }
                    const f32x4 gate = wg0 * pg + wg1 * ugm + wg2 * ng + bg;
                    const f32x4 val = wv0 * pvv + wv1 * uvm + wv2 * nv + bv;
                    const int row = row0 + ai * HALF + m * 16;
                    const bool edge = (m == 0 && fr == 0) || (m == 3 && fr == 15);
                    if (!edge) { u32x2 w; w.x = pk2(siluf_(gate[0]) * val[0], siluf_(gate[1]) * val[1]); w.y = pk2(siluf_(gate[2]) * val[2], siluf_(gate[3]) * val[3]);
                        *(u32x2*)(P + (size_t)row * PLD + C_ACT + a0) = w; }
                    if ((m == 0 && fr < 2) || (m == 3 && fr >= 14)) { const int slot = (m == 0) ? fr : fr - 12;
                        float* ue = UE + ((size_t)g64 * 4 + slot) * NUP;
                        *(f32x4*)(ue + a0) = ugm; *(f32x4*)(ue + DFF + a0) = uvm; }
                }
                asm volatile("" ::: "memory");
            }
        }
    }
};
struct EpiDown {
    static constexpr bool PERM = true, AFTER_DRAIN = false;
    float* out;
    __device__ __forceinline__ void operator()(const f32x4 (&acc)[2][2][4][2], const Unit& u, int wr, int wc, int fr, int fq) const {
        const int row0 = u.pm * BM + wr * 64 + fr, col0 = u.pn * BM + wc * 32 + 8 * fq;
#pragma unroll
        for (int ai = 0; ai < 2; ++ai)
#pragma unroll
            for (int m = 0; m < 4; ++m) {
#pragma unroll
                for (int bj = 0; bj < 2; ++bj) { const size_t off = (size_t)(row0 + ai * HALF + m * 16) * DM + col0 + bj * HALF;
                    const f32x4 a0 = *(const f32x4*)(out + off), a1 = *(const f32x4*)(out + off + 4);
                    *(f32x4*)(out + off) = a0 + acc[ai][bj][m][0]; *(f32x4*)(out + off + 4) = a1 + acc[ai][bj][m][1]; } }
    }
};

template <int DH, int RSK, int RSV, bool BIAS>
__device__ __forceinline__ void attn_tile(const LAS unsigned char* Kl, const LAS unsigned char* Vl, int jk, const bf16x8 (&qf)[DH / 16], const float* biasrow,
                                          float& m, float& l, f32x16 (&o)[DH / 32], int lane) {
    const int r32 = lane & 31, hi = lane >> 5;
    f32x16 s0, s1;
    if (BIAS) {
#pragma unroll
        for (int g4 = 0; g4 < 4; ++g4) { const f32x4 c0 = *(const f32x4*)(biasrow + 8 * g4 + 4 * hi), c1 = *(const f32x4*)(biasrow + 32 + 8 * g4 + 4 * hi);
#pragma unroll
            for (int i = 0; i < 4; ++i) { s0[4 * g4 + i] = c0[i]; s1[4 * g4 + i] = c1[i]; } }
    } else {
#pragma unroll
        for (int r = 0; r < 16; ++r) { s0[r] = 0.f; s1[r] = 0.f; }
    }
    const LAS unsigned char* kp = Kl + (size_t)(jk + r32) * RSK + 16 * hi;
#pragma unroll
    for (int ks = 0; ks < DH / 16; ++ks) {
        const bf16x8 k0 = *(const LAS bf16x8*)(kp + 32 * ks), k1 = *(const LAS bf16x8*)(kp + 32 * RSK + 32 * ks);
        s0 = __builtin_amdgcn_mfma_f32_32x32x16_bf16(k0, qf[ks], s0, 0, 0, 0);
        s1 = __builtin_amdgcn_mfma_f32_32x32x16_bf16(k1, qf[ks], s1, 0, 0, 0);
    }
    float mx = fmaxf(s0[0], s1[0]);
#pragma unroll
    for (int r = 1; r < 16; ++r) mx = fmaxf(mx, fmaxf(s0[r], s1[r]));
    mx = fmaxf(mx, __shfl_xor(mx, 32));
    const float mn = fmaxf(m, mx), f = fexp2(m - mn);
    m = mn; l *= f;
#pragma unroll
    for (int db = 0; db < DH / 32; ++db)
#pragma unroll
        for (int r = 0; r < 16; ++r) o[db][r] *= f;
    float ps = 0.f;
#pragma unroll
    for (int r = 0; r < 16; ++r) { s0[r] = fexp2(s0[r] - mn); s1[r] = fexp2(s1[r] - mn); ps += s0[r] + s1[r]; }
    l += ps;
    bf16x8 pf[4];
    { u32x4 w;
      w.x = pk2(s0[0], s0[1]); w.y = pk2(s0[2], s0[3]); w.z = pk2(s0[4], s0[5]); w.w = pk2(s0[6], s0[7]); pf[0] = __builtin_bit_cast(bf16x8, w);
      w.x = pk2(s0[8], s0[9]); w.y = pk2(s0[10], s0[11]); w.z = pk2(s0[12], s0[13]); w.w = pk2(s0[14], s0[15]); pf[1] = __builtin_bit_cast(bf16x8, w);
      w.x = pk2(s1[0], s1[1]); w.y = pk2(s1[2], s1[3]); w.z = pk2(s1[4], s1[5]); w.w = pk2(s1[6], s1[7]); pf[2] = __builtin_bit_cast(bf16x8, w);
      w.x = pk2(s1[8], s1[9]); w.y = pk2(s1[10], s1[11]); w.z = pk2(s1[12], s1[13]); w.w = pk2(s1[14], s1[15]); pf[3] = __builtin_bit_cast(bf16x8, w); }
    const int g = lane >> 4, q4 = (lane & 15) >> 2, p = lane & 3;
    const LAS unsigned char* vp = Vl + (size_t)(jk + 4 * hi + q4) * RSV + (16 * (g & 1) + 4 * p) * 2;
#pragma unroll
    for (int db = 0; db < DH / 32; ++db)
#pragma unroll
        for (int kk = 0; kk < 4; ++kk) {
            const s16x4 lo = __builtin_bit_cast(s16x4, __builtin_amdgcn_ds_read_tr16_b64_v4i16((LAS s16x4*)(vp + (size_t)(16 * kk) * RSV + 64 * db)));
            const s16x4 h4 = __builtin_bit_cast(s16x4, __builtin_amdgcn_ds_read_tr16_b64_v4i16((LAS s16x4*)(vp + (size_t)(16 * kk + 8) * RSV + 64 * db)));
            const bf16x8 vf = (bf16x8){lo[0], lo[1], lo[2], lo[3], h4[0], h4[1], h4[2], h4[3]};
            o[db] = __builtin_amdgcn_mfma_f32_32x32x16_bf16(vf, pf[kk], o[db], 0, 0, 0);
        }
}
template <int DH>
__device__ __forceinline__ void load_q(const bf16* qrow, const float* gq, float scale, bf16x8 (&qf)[DH / 16], int lane) {
    const int hi = lane >> 5;
    u32x4 w[DH / 16]; float ss = 0.f;
#pragma unroll
    for (int ks = 0; ks < DH / 16; ++ks) { w[ks] = *(const u32x4*)(qrow + 16 * ks + 8 * hi); float v[8]; unpack8(w[ks], v);
#pragma unroll
        for (int j = 0; j < 8; ++j) ss += v[j] * v[j]; }
    ss += __shfl_xor(ss, 32);
    const float rstd = __builtin_amdgcn_rsqf(ss * (1.0f / DH) + EPS) * scale;
#pragma unroll
    for (int ks = 0; ks < DH / 16; ++ks) { float v[8]; unpack8(w[ks], v);
        const f32x4 g0 = *(const f32x4*)(gq + 16 * ks + 8 * hi), g1 = *(const f32x4*)(gq + 16 * ks + 8 * hi + 4);
#pragma unroll
        for (int j = 0; j < 4; ++j) { v[j] *= rstd * g0[j]; v[4 + j] *= rstd * g1[j]; }
        qf[ks] = __builtin_bit_cast(bf16x8, pack8(v)); }
}
template <int DH>
__device__ __forceinline__ void store_o(bf16* yrow, const f32x16 (&o)[DH / 32], float l, int lane) {
    const int hi = lane >> 5;
    const float inv = frcp(l + __shfl_xor(l, 32));
#pragma unroll
    for (int db = 0; db < DH / 32; ++db)
#pragma unroll
        for (int g4 = 0; g4 < 4; ++g4) { u32x2 w; w.x = pk2(o[db][4 * g4] * inv, o[db][4 * g4 + 1] * inv); w.y = pk2(o[db][4 * g4 + 2] * inv, o[db][4 * g4 + 3] * inv);
            *(u32x2*)(yrow + 32 * db + 8 * g4 + 4 * hi) = w; }
}
template <int DH, int RSK, int RSV>
__device__ __forceinline__ void stage_kv(LAS unsigned char* Kl, LAS unsigned char* Vl, int ldsrow0, const bf16* src, size_t pitch, int kcol, int vcol, int nrows, const float* gk, int tid) {
    constexpr int CPR = DH / 8;
    for (int c = tid; c < nrows * CPR; c += 512) {
        const int row = c / CPR, ch = c % CPR;
        const bf16* rp = src + (size_t)row * pitch;
        const u32x4 kw = *(const u32x4*)(rp + kcol + ch * 8), vw = *(const u32x4*)(rp + vcol + ch * 8);
        float v[8]; unpack8(kw, v); float ss = 0.f;
#pragma unroll
        for (int j = 0; j < 8; ++j) ss += v[j] * v[j];
#pragma unroll
        for (int o = 1; o < CPR; o <<= 1) ss += __shfl_xor(ss, o);
        const float rstd = __builtin_amdgcn_rsqf(ss * (1.0f / DH) + EPS);
        const f32x4 g0 = *(const f32x4*)(gk + ch * 8), g1 = *(const f32x4*)(gk + ch * 8 + 4);
#pragma unroll
        for (int j = 0; j < 4; ++j) { v[j] *= rstd * g0[j]; v[4 + j] *= rstd * g1[j]; }
        *(LAS u32x4*)(Kl + (size_t)(ldsrow0 + row) * RSK + ch * 16) = pack8(v);
        *(LAS u32x4*)(Vl + (size_t)(ldsrow0 + row) * RSV + ch * 16) = vw;
    }
}

constexpr int NWAVES = 8;
constexpr size_t MiB = 1u << 20;
constexpr size_t WS_CTL = 0, CTL_ZERO_BYTES = 1 * MiB;
constexpr size_t WS_WIN = 2 * MiB;
constexpr size_t WS_WBR = 15 * MiB;
constexpr size_t WS_WOUT = 18 * MiB;
constexpr size_t WS_WUP = 20 * MiB;
constexpr size_t WS_WDN = 31 * MiB;
constexpr size_t WS_WKV = 37 * MiB;
constexpr size_t WS_MEMN = 39 * MiB;
constexpr size_t WS_KV = 41 * MiB;
constexpr size_t WS_BT = 43 * MiB;
constexpr size_t WS_BA = 45 * MiB;
constexpr size_t WS_SSQ = 49 * MiB;
constexpr size_t WS_P = 52 * MiB;
constexpr size_t WS_UE = 452 * MiB;
constexpr size_t WS_END = 512 * MiB;
static_assert(WS_P + (size_t)M * PLD * 2 == WS_UE && WS_UE + (size_t)512 * 4 * NUP * 4 <= WS_END, "d_ws map");

constexpr int CW_TMO = 0, CW_CODE = 1;
constexpr int CW_BAR = 4096;
constexpr int RING_OFF = 0, RING_BYTES = 147456;
constexpr int LDSCTL_OFF = RING_BYTES, MISC_OFF = LDSCTL_OFF + 320;
constexpr int XCH_OFF = MISC_OFF + 256;
constexpr int LDS_BYTES = 163840;
static_assert(XCH_OFF + 4096 <= LDS_BYTES && XCH_OFF % 16 == 0, "LDS map");

typedef GAS unsigned gu32;
#define RLX_AGENT __ATOMIC_RELAXED, __HIP_MEMORY_SCOPE_AGENT
#define LDS_WAIT() asm volatile("s_waitcnt lgkmcnt(0)" ::: "memory")
#define VM_WAIT() asm volatile("s_waitcnt vmcnt(0)" ::: "memory")

#define XB_TMO      128
#define XB_XCNT(j)  (256  + 64 * (j))
#define XB_XSUB(j)  (1280 + 64 * (j))
#define XB_XGEN(j)  (2304 + 64 * (j))
#define XB_TOP      3328
#define XB_TOPGEN   3392
#define XCD_BAR_WORDS 3456
#define XB_SPIN_CAP (1u << 22)

__device__ __forceinline__ unsigned xb_ld(unsigned* p)              { return __hip_atomic_load(p, __ATOMIC_RELAXED, __HIP_MEMORY_SCOPE_AGENT); }
__device__ __forceinline__ unsigned xb_add(unsigned* p, unsigned v) { return __hip_atomic_fetch_add(p, v, __ATOMIC_RELAXED, __HIP_MEMORY_SCOPE_AGENT); }
__device__ __forceinline__ unsigned xb_xcc_id() { return (unsigned)__builtin_amdgcn_s_getreg((3 << 11) | 20) & 0xFu; }
#define XB_SPIN(cond, bar) do { unsigned _sp = 0; while (cond) { __builtin_amdgcn_s_sleep(1); \
    if ((++_sp & 255u) == 0u) { if (xb_ld(&(bar)[XB_TMO])) break; if (_sp > XB_SPIN_CAP) { atomicAdd(&(bar)[XB_TMO], 1u); break; } } } } while (0)

struct XcdBarrier { unsigned* bar; unsigned x; volatile LAS unsigned* st; };

__device__ __forceinline__ XcdBarrier xcd_barrier_post(unsigned* bar, volatile LAS unsigned* st) {
    XcdBarrier b; b.bar = bar; b.x = xb_xcc_id(); b.st = st;
    if (threadIdx.x == 0) (void)xb_add(&bar[XB_XCNT(b.x)], 1u);
    return b;
}
__device__ __forceinline__ void xcd_barrier_complete(unsigned* bar, unsigned x, unsigned& nloc, unsigned& nx) {
    const unsigned G = gridDim.x * gridDim.y * gridDim.z;
    unsigned sum, cnt, mine, sp = 0u;
    for (;;) {
        sum = 0u; cnt = 0u; mine = 0u;
#pragma unroll
        for (unsigned j = 0; j < 16; ++j) { const unsigned c = xb_ld(&bar[XB_XCNT(j)]); sum += c; cnt += (c > 0u) ? 1u : 0u; mine = (j == x) ? c : mine; }
        if (sum == G) break;
        __builtin_amdgcn_s_sleep(1);
        if ((++sp & 255u) == 0u) { if (xb_ld(&bar[XB_TMO])) break; if (sp > XB_SPIN_CAP) { atomicAdd(&bar[XB_TMO], 1u); break; } }
    }
    nloc = mine > 0u ? mine : 1u; nx = cnt > 0u ? cnt : 1u;
}
__device__ __forceinline__ void xcd_barrier(const XcdBarrier& b) {
    asm volatile("s_waitcnt vmcnt(0)" ::: "memory");
    __syncthreads();
    if (threadIdx.x == 0) {
        unsigned* bar = b.bar;
        __builtin_amdgcn_s_waitcnt(0);
        unsigned nloc = b.st[0], nx = b.st[1];
        if (nloc == 0u) { xcd_barrier_complete(bar, b.x, nloc, nx); b.st[0] = nloc; b.st[1] = nx; }
        const unsigned old = xb_add(&bar[XB_XSUB(b.x)], 1u);
        const unsigned gen = old / nloc;
        if (old + 1u == (gen + 1u) * nloc) {
            __builtin_amdgcn_fence(__ATOMIC_RELEASE, "agent");
            asm volatile("s_waitcnt vmcnt(0)" ::: "memory");
            const unsigned og = xb_add(&bar[XB_TOP], 1u);
            const unsigned tg = og / nx;
            if (og + 1u == (tg + 1u) * nx) xb_add(&bar[XB_TOPGEN], 1u);
            else XB_SPIN(xb_ld(&bar[XB_TOPGEN]) == tg, bar);
            __builtin_amdgcn_fence(__ATOMIC_ACQUIRE, "agent");
            xb_add(&bar[XB_XGEN(b.x)], 1u);
            asm volatile("s_waitcnt vmcnt(0)" ::: "memory");
        } else {
            XB_SPIN(xb_ld(&bar[XB_XGEN(b.x)]) == gen, bar);
            __builtin_amdgcn_fence(__ATOMIC_ACQUIRE, "agent");
            asm volatile("s_waitcnt vmcnt(0)" ::: "memory");
        }
    }
    __syncthreads();
}

struct Frame {
    LAS unsigned char* lds;
    volatile LAS unsigned* MISC;
    gu32* ctl;
    int tid, lane, wave, vcu, G;
};

__device__ __forceinline__ float wave_sum(float v) {
#pragma unroll
    for (int o = 1; o < 64; o <<= 1) v += __shfl_xor(v, o);
    return v;
}
__device__ __forceinline__ int t5_bucket(int rel) {
    const int n = rel < 0 ? -rel : rel;
    const int mag = n < 8 ? n : n < 12 ? 8 : n < 16 ? 9 : n < 23 ? 10 : n < 32 ? 11 : n < 46 ? 12 : n < 64 ? 13 : n < 91 ? 14 : 15;
    return (rel > 0 ? 16 : 0) + mag;
}

__device__ __forceinline__ void transpose_item(const float* W, int K, int N, int k0, int n0, bf16* WT, int drow0, const float* gk, LAS float* scr, int lane) {
    { f32x4 v[8];
#pragma unroll
      for (int i = 0; i < 8; ++i) v[i] = *(const f32x4*)(W + (size_t)(k0 + 8 * i + (lane >> 3)) * N + n0 + 4 * (lane & 7));
#pragma unroll
      for (int i = 0; i < 8; ++i) { const int kk = 8 * i + (lane >> 3); const float gs = gk ? gk[k0 + kk] : 1.0f; LAS float* d = scr + kk * 33 + 4 * (lane & 7);
          d[0] = v[i][0] * gs; d[1] = v[i][1] * gs; d[2] = v[i][2] * gs; d[3] = v[i][3] * gs; } }
    LDS_WAIT(); asm volatile("" ::: "memory");
    const int c = lane & 7;
#pragma unroll
    for (int j = 0; j < 4; ++j) { const int n = (lane >> 3) + 8 * j; const LAS float* s = scr + (8 * c) * 33 + n;
        u32x4 o; o.x = pk2(s[0 * 33], s[1 * 33]); o.y = pk2(s[2 * 33], s[3 * 33]); o.z = pk2(s[4 * 33], s[5 * 33]); o.w = pk2(s[6 * 33], s[7 * 33]);
        *(GAS u32x4*)(WT + (size_t)(drow0 + n) * K + k0 + 8 * c) = o; }
    LDS_WAIT(); asm volatile("" ::: "memory");
}
__device__ __forceinline__ void rms_row_to_bf16(const float* xrow, const float* g, bf16* orow, int lane) {
    const GAS f32x4* xr = (const GAS f32x4*)xrow + lane;
    const GAS f32x4* gr = (const GAS f32x4*)g + lane;
    f32x4 v[4]; float s = 0.f;
#pragma unroll
    for (int j = 0; j < 4; ++j) { v[j] = xr[64 * j]; s += (v[j].x * v[j].x + v[j].y * v[j].y) + (v[j].z * v[j].z + v[j].w * v[j].w); }
    const float rstd = __builtin_amdgcn_rsqf(wave_sum(s) * (1.f / DM) + EPS);
    GAS unsigned long long* o8 = (GAS unsigned long long*)orow + lane;
#pragma unroll
    for (int j = 0; j < 4; ++j) { const f32x4 gg = gr[64 * j];
        o8[64 * j] = (unsigned long long)pk2(v[j].x * rstd * gg.x, v[j].y * rstd * gg.y) | ((unsigned long long)pk2(v[j].z * rstd * gg.z, v[j].w * rstd * gg.w) << 32); }
}

__device__ __forceinline__ void rms_row2_to_bf16(const float* xa, const float* xb, const float* g, bf16* oa, bf16* ob, int lane) {
    const GAS f32x4* xr0 = (const GAS f32x4*)xa + lane; const GAS f32x4* xr1 = (const GAS f32x4*)xb + lane;
    const GAS f32x4* gr = (const GAS f32x4*)g + lane;
    f32x4 v0[4], v1[4]; float s0 = 0.f, s1 = 0.f;
#pragma unroll
    for (int j = 0; j < 4; ++j) { v0[j] = xr0[64 * j]; v1[j] = xr1[64 * j]; }
#pragma unroll
    for (int j = 0; j < 4; ++j) { s0 += (v0[j].x * v0[j].x + v0[j].y * v0[j].y) + (v0[j].z * v0[j].z + v0[j].w * v0[j].w); s1 += (v1[j].x * v1[j].x + v1[j].y * v1[j].y) + (v1[j].z * v1[j].z + v1[j].w * v1[j].w); }
#pragma unroll
    for (int o = 1; o < 64; o <<= 1) { s0 += __shfl_xor(s0, o); s1 += __shfl_xor(s1, o); }
    const float r0 = __builtin_amdgcn_rsqf(s0 * (1.f / DM) + EPS), r1 = __builtin_amdgcn_rsqf(s1 * (1.f / DM) + EPS);
    GAS unsigned long long* o0 = (GAS unsigned long long*)oa + lane; GAS unsigned long long* o1 = (GAS unsigned long long*)ob + lane;
#pragma unroll
    for (int j = 0; j < 4; ++j) { const f32x4 gg = gr[64 * j];
        o0[64 * j] = (unsigned long long)pk2(v0[j].x * r0 * gg.x, v0[j].y * r0 * gg.y) | ((unsigned long long)pk2(v0[j].z * r0 * gg.z, v0[j].w * r0 * gg.w) << 32);
        o1[64 * j] = (unsigned long long)pk2(v1[j].x * r1 * gg.x, v1[j].y * r1 * gg.y) | ((unsigned long long)pk2(v1[j].z * r1 * gg.z, v1[j].w * r1 * gg.w) << 32); }
}

struct Args { const float* in[25]; float* out; unsigned char* ws; int ph_lo, ph_hi, mode, pad; };

__device__ __forceinline__ void p0_prologue(Frame& F, const Args& a) {
    unsigned char* ws = a.ws;
    LAS float* scr = (LAS float*)(F.lds + RING_OFF + F.wave * 16384);
    const int gw = F.vcu * NWAVES + F.wave, NGW = F.G * NWAVES;
    constexpr int I_IN = 16 * 201, I_BR = 8 * 32, I_OUT = 16 * 32, I_UP = 16 * 176, I_DN = 44 * 32, I_KV = 16 * 32;
    constexpr int NITEMS = I_IN + 3 * I_BR + I_OUT + I_UP + I_DN + I_KV;
    for (int it = gw; it < NITEMS; it += NGW) {
        int r = it;
        if (r < I_IN) { const int kb = r / 201, nb = r % 201, n0 = nb * 32;
            const int d0 = n0 < 2816 ? n0 : (n0 < 2848 ? 3328 + (n0 - 2816) : (n0 < 3360 ? n0 - 32 : 3584 + (n0 - 3360)));
            transpose_item(a.in[4], 1024, 6432, kb * 64, n0, (bf16*)(ws + WS_WIN), d0, nullptr, scr, F.lane); continue; }
        r -= I_IN;
        if (r < 3 * I_BR) { const int br = r / I_BR, q = r % I_BR, kb = q / 32, nb = q % 32;
            transpose_item(a.in[16 + br], 512, 1024, kb * 64, nb * 32, (bf16*)(ws + WS_WBR) + (size_t)br * 1024 * 512, nb * 32, nullptr, scr, F.lane); continue; }
        r -= 3 * I_BR;
        if (r < I_OUT) { const int kb = r / 32, nb = r % 32;
            transpose_item(a.in[19], 1024, 1024, kb * 64, nb * 32, (bf16*)(ws + WS_WOUT), nb * 32, nullptr, scr, F.lane); continue; }
        r -= I_OUT;
        if (r < I_UP) { const int kb = r / 176, nb = r % 176, n0 = nb * 32;
            const int isv = n0 >= DFF, nn = isv ? n0 - DFF : n0, d0 = (nn >> 7) * 256 + isv * 128 + (nn & 127);
            transpose_item(a.in[21], 1024, NUP, kb * 64, n0, (bf16*)(ws + WS_WUP), d0, a.in[20], scr, F.lane); continue; }
        r -= I_UP;
        if (r < I_DN) { const int kb = r / 32, nb = r % 32;
            transpose_item(a.in[24], DFF, 1024, kb * 64, nb * 32, (bf16*)(ws + WS_WDN), nb * 32, nullptr, scr, F.lane); continue; }
        r -= I_DN;
        { const int kb = r / 32, nb = r % 32;
            transpose_item(a.in[13], 1024, 1024, kb * 64, nb * 32, (bf16*)(ws + WS_WKV), nb * 32, nullptr, scr, F.lane); }
    }
    { u32x4* z = (u32x4*)((bf16*)(ws + WS_WIN) + (size_t)3360 * 1024); const int n16 = 224 * 1024 * 2 / 16;
      for (int i = blockIdx.x * 512 + F.tid; i < n16; i += F.G * 512) z[i] = (u32x4){0u, 0u, 0u, 0u}; }
    bf16* H = (bf16*)a.out;
    if (M % (2 * NGW) != 0) { for (int m = gw; m < M; m += NGW) rms_row_to_bf16(a.in[0] + (size_t)m * DM, a.in[3], H + (size_t)m * DM, F.lane); }
    else for (int m = gw; m < M; m += 2 * NGW) rms_row2_to_bf16(a.in[0] + (size_t)m * DM, a.in[0] + (size_t)(m + NGW) * DM, a.in[3], H + (size_t)m * DM, H + (size_t)(m + NGW) * DM, F.lane);
    for (int m = gw; m < BATCH * NMEM; m += NGW) rms_row_to_bf16(a.in[1] + (size_t)m * DM, a.in[12], (bf16*)(ws + WS_MEMN) + (size_t)m * DM, F.lane);
    { float* BT = (float*)(ws + WS_BT); const float* tab = a.in[2];
      for (int i = blockIdx.x * 512 + F.tid; i < 8 * 128 * 384; i += F.G * 512) { const int j = i % 384, t = (i / 384) % 128, h = i / (384 * 128);
          const int rel = j - 128 - t; const bool ok = rel >= -128 && rel <= 128;
          BT[i] = ok ? tab[t5_bucket(rel) * 8 + h] * LOG2E : -INFINITY; } }
}

__device__ __forceinline__ void attnA_unit(Frame& F, const Args& a, int b, int n, int kvh) {
    constexpr int RSK = 144, RSV = 128;
    LAS unsigned char* Kl = F.lds; LAS unsigned char* Vl = F.lds + 384 * RSK;
    bf16* P = (bf16*)(a.ws + WS_P);
    const float* BT = (const float*)(a.ws + WS_BT);
    for (int blk = 0; blk < 3; ++blk) { const int pos0 = n * 128 - 128 + blk * 128; if (pos0 < 0 || pos0 >= SEQ) continue;
        stage_kv<64, RSK, RSV>(Kl, Vl, blk * 128, P + (size_t)(b * SEQ + pos0) * PLD, PLD, C_AK + kvh * 64, C_AV + kvh * 64, 128, a.in[6], F.tid); }
    LDS_WAIT(); __syncthreads();
    const int h = kvh * 4 + (F.wave >> 1), r32 = F.lane & 31, hi = F.lane >> 5;
    const float sink = a.in[7][h] * LOG2E;
#pragma unroll 1
    for (int qb = 0; qb < 2; ++qb) {
        const int t0 = (F.wave & 1) * 64 + qb * 32, t = t0 + r32;
        bf16* qrow = P + (size_t)(b * SEQ + n * 128 + t) * PLD + C_AQ + h * 64;
        bf16x8 qf[4]; load_q<64>(qrow, a.in[5], 0.125f * LOG2E, qf, F.lane);
        float m = sink, l = hi == 0 ? 1.f : 0.f; f32x16 o[2];
#pragma unroll
        for (int r = 0; r < 16; ++r) { o[0][r] = 0.f; o[1][r] = 0.f; }
#pragma unroll 1
        for (int kt = 0; kt < 6; ++kt) { const int j0 = 64 * kt, pos0 = n * 128 - 128 + (kt >> 1) * 128;
            if (pos0 < 0 || pos0 >= SEQ) continue;
            if (j0 + 63 < t0 || j0 > t0 + 31 + 256) continue;
            attn_tile<64, RSK, RSV, true>(Kl, Vl, j0, qf, BT + ((size_t)h * 128 + t) * 384 + j0, m, l, o, F.lane); }
        store_o<64>(qrow, o, l, F.lane);
    }
    LDS_WAIT(); __syncthreads();
}
__device__ __forceinline__ void xattn_unit(Frame& F, const Args& a, int b, int tb, int h) {
    constexpr int RSK = 272, RSV = 320;
    LAS unsigned char* Kl = F.lds; LAS unsigned char* Vl = F.lds + 128 * RSK;
    bf16* P = (bf16*)(a.ws + WS_P);
    const bf16* KV = (const bf16*)(a.ws + WS_KV);
    const int r32 = F.lane & 31;
    bf16* qrow = P + (size_t)(b * SEQ + tb * 256 + F.wave * 32 + r32) * PLD + C_MQ + h * 128;
    bf16x8 qf[8]; load_q<128>(qrow, a.in[14], 0.08838834764831845f * LOG2E, qf, F.lane);
    float m = -1e30f, l = 0.f; f32x16 o[4];
#pragma unroll
    for (int db = 0; db < 4; ++db)
#pragma unroll
        for (int r = 0; r < 16; ++r) o[db][r] = 0.f;
#pragma unroll 1
    for (int half = 0; half < 2; ++half) {
        stage_kv<128, RSK, RSV>(Kl, Vl, 0, KV + (size_t)(b * NMEM + half * 128) * 1024, 1024, h * 128, 512 + h * 128, 128, a.in[15], F.tid);
        LDS_WAIT(); __syncthreads();
#pragma unroll 1
        for (int kt = 0; kt < 2; ++kt) attn_tile<128, RSK, RSV, false>(Kl, Vl, 64 * kt, qf, nullptr, m, l, o, F.lane);
        LDS_WAIT(); __syncthreads();
    }
    store_o<128>(qrow, o, l, F.lane);
}


constexpr int SAF = C_GATE, SCF = C_GATE + 512, SBF = C_GATE + 1024, SDF = C_GATE + 1536, SAB = C_GATE + 2048, SCB = C_GATE + 2560;
constexpr int C_OF = C_DQ, C_OB = C_DK;
__device__ __forceinline__ int dn_pcol(int x) { return (x & 32) + 8 * ((x & 15) >> 2) + 4 * ((x >> 4) & 1) + (x & 3); }
__device__ __forceinline__ bf16x8 frag_lo(const LAS unsigned char* p) { const u32x2 a0 = *(const LAS u32x2*)p; u32x4 w; w.x = a0.x; w.y = a0.y; w.z = 0u; w.w = 0u; return __builtin_bit_cast(bf16x8, w); }
__device__ __forceinline__ bf16x8 frag_2(const LAS unsigned char* p) { const u32x2 a0 = *(const LAS u32x2*)p, a1 = *(const LAS u32x2*)(p + 32); u32x4 w; w.x = a0.x; w.y = a0.y; w.z = a1.x; w.w = a1.y; return __builtin_bit_cast(bf16x8, w); }
__device__ __forceinline__ bf16x8 pack_f4z(const f32x4 a) { u32x4 w; w.x = pk2(a[0], a[1]); w.y = pk2(a[2], a[3]); w.z = 0u; w.w = 0u; return __builtin_bit_cast(bf16x8, w); }
__device__ __forceinline__ bf16x8 pack_f4f4(const f32x4 a, const f32x4 b) { u32x4 w; w.x = pk2(a[0], a[1]); w.y = pk2(a[2], a[3]); w.z = pk2(b[0], b[1]); w.w = pk2(b[2], b[3]); return __builtin_bit_cast(bf16x8, w); }
__device__ __forceinline__ void dn_prep_block(Frame& F, const Args& a, int b, int h, int c0, int nch) {
    LAS float* raw = (LAS float*)(F.lds);
    LAS unsigned char* NL = F.lds;
    LAS unsigned char* TD = F.lds + 18432;
    LAS unsigned char* Qb = F.lds + 53248;
    LAS unsigned char* Kb = F.lds + 62464;
    LAS unsigned char* Vb = F.lds + 71680;
    LAS float* sm = (LAS float*)(F.lds + 80896);
    LAS float* gt = sm;
    LAS float* btk = sm + 128;
    LAS float* gct = sm + 256;
    LAS float* cu = sm + 384;
    LAS float* cwp = sm + 512;
    LAS float* egp = sm + 640;
    LAS float* esp = sm + 768;
    LAS unsigned char* QKL = F.lds + 24576;
    LAS unsigned char* KT = F.lds + 84480;
    LAS unsigned char* QT = F.lds + 104960;
    bf16* P = (bf16*)(a.ws + WS_P);
    float* BA = (float*)(a.ws + WS_BA);
    bf16* XB2 = (bf16*)a.out + (size_t)M * 1024;
    const float* cw = a.in[8];
    const int w = F.wave, lane = F.lane, tid = F.tid;
    float wt[3][5];
#pragma unroll
    for (int which = 0; which < 3; ++which)
#pragma unroll
        for (int j = 0; j < 5; ++j) wt[which][j] = cw[j * 1536 + which * 512 + h * 64 + lane];
    const float Ah = expf(a.in[9][(tid >> 6 & 1) * 8 + h]), dtb = a.in[10][(tid >> 6 & 1) * 8 + h];
    u32x4 rr[4]; float pa = 0.f, pb = 0.f;
#define DN_PREFETCH(cidx) do { const int t0p_ = (cidx) * 64; \
        _Pragma("unroll") for (int i_ = 0; i_ < 4; ++i_) { const int e = tid + 512 * i_, row = e / 24, c8 = e % 24, which = c8 >> 3, t = t0p_ - 2 + row; \
            rr[i_] = (u32x4){0u, 0u, 0u, 0u}; \
            if (e < 68 * 24 && t >= 0 && t < SEQ) rr[i_] = *(const u32x4*)(P + ((size_t)b * SEQ + t) * PLD + (which == 0 ? C_DQ : which == 1 ? C_DK : C_DV) + h * 64 + (c8 & 7) * 8); } \
        if (tid < 128) { const size_t tok = (size_t)b * SEQ + t0p_ + (tid & 63); pa = BA[tok * 32 + 16 + (tid >> 6) * 8 + h]; pb = BA[tok * 32 + (tid >> 6) * 8 + h]; } } while (0)
    DN_PREFETCH(c0);
#pragma unroll 1
  for (int ci = 0; ci < nch; ++ci) {
    int tid_o = F.tid; asm volatile("" : "+v"(tid_o));
    const int tid = tid_o, lane = tid & 63;
    const int c = c0 + ci, t0 = c * 64;
    const size_t tok0 = (size_t)b * SEQ + t0;
#pragma unroll
    for (int i_ = 0; i_ < 4; ++i_) { const int e = tid + 512 * i_, row = e / 24, c8 = e % 24;
        if (e < 68 * 24) { float v[8]; unpack8(rr[i_], v);
            *(LAS f32x4*)(raw + row * 192 + c8 * 8) = (f32x4){v[0], v[1], v[2], v[3]}; *(LAS f32x4*)(raw + row * 192 + c8 * 8 + 4) = (f32x4){v[4], v[5], v[6], v[7]}; } }
    if (tid < 128) { const int d = tid >> 6, i = tid & 63; const float xa = pa + dtb;
        gt[d * 64 + i] = -Ah * (fmaxf(xa, 0.f) + log1pf(expf(-fabsf(xa))));
        btk[d * 64 + i] = sigmoidf_(pb); }
    if (ci + 1 < nch) DN_PREFETCH(c + 1);
    LDS_WAIT(); __syncthreads();
#pragma unroll
    for (int which = 0; which < 3; ++which) {
        float x[12], y[8];
#pragma unroll
        for (int j = 0; j < 12; ++j) x[j] = raw[(w * 8 + j) * 192 + which * 64 + lane];
#pragma unroll
        for (int r = 0; r < 8; ++r) { float acc = 0.f;
#pragma unroll
            for (int j = 0; j < 5; ++j) acc += x[r + j] * wt[which][j];
            y[r] = siluf_(acc); }
        if (which < 2) {
            float ss[8];
#pragma unroll
            for (int r = 0; r < 8; ++r) ss[r] = y[r] * y[r];
#pragma unroll
            for (int o = 1; o < 64; o <<= 1)
#pragma unroll
                for (int r = 0; r < 8; ++r) ss[r] += __shfl_xor(ss[r], o);
#pragma unroll
            for (int r = 0; r < 8; ++r) y[r] *= __builtin_amdgcn_rsqf(ss[r] + EPS) * (which == 0 ? 0.125f : 1.0f);
        }
        LAS unsigned char* X = which == 0 ? Qb : which == 1 ? Kb : Vb;
#pragma unroll
        for (int r = 0; r < 8; ++r) *(LAS bf16*)(X + (w * 8 + r) * 144 + lane * 2) = (bf16)(pk2(y[r], 0.f) & 0xffffu);
        asm volatile("" ::: "memory");
    }
    if (w < 2) { const int i = w ? 63 - lane : lane; float gv = gt[w * 64 + i];
#pragma unroll
        for (int o = 1; o < 64; o <<= 1) { const float t = __shfl_up(gv, o); if (lane >= o) gv += t; }
        const float glast = __shfl(gv, 63), bt = btk[w * 64 + i], eg = __expf(gv);
        const float es = __expf(glast - gv);
        gct[w * 64 + i] = gv; cu[w * 64 + lane] = bt; cwp[w * 64 + lane] = bt * eg; egp[w * 64 + lane] = eg; esp[w * 64 + lane] = es;
        BA[(tok0 + lane) * 32 + w * 8 + h] = eg; }
    LDS_WAIT(); __syncthreads();
    { const int p = tid >> 3, c8 = tid & 7;
#pragma unroll
      for (int d = 0; d < 2; ++d) { const int i = d ? 63 - p : p; const float es = esp[d * 64 + p], eg = egp[d * 64 + p]; float v[8];
          unpack8(*(const LAS u32x4*)(Kb + i * 144 + c8 * 16), v);
#pragma unroll
          for (int j = 0; j < 8; ++j) v[j] *= es;
          *(LAS u32x4*)(KT + d * 10240 + p * 160 + c8 * 16) = pack8(v);
          unpack8(*(const LAS u32x4*)(Qb + i * 144 + c8 * 16), v);
#pragma unroll
          for (int j = 0; j < 8; ++j) v[j] *= eg;
          *(LAS u32x4*)(QT + d * 9216 + p * 144 + c8 * 16) = pack8(v); } }
    { const int wq = w & 3, tm = wq >> 1, tn = wq & 1, r32 = lane & 31, hi = lane >> 5;
      const LAS unsigned char* X = (w < 4) ? Kb : Qb;
      f32x16 acc;
#pragma unroll
      for (int r = 0; r < 16; ++r) acc[r] = 0.f;
#pragma unroll
      for (int kst = 0; kst < 4; ++kst) {
          const bf16x8 af = *(const LAS bf16x8*)(X + (32 * tm + r32) * 144 + (16 * kst + 8 * hi) * 2), bfr = *(const LAS bf16x8*)(Kb + (32 * tn + r32) * 144 + (16 * kst + 8 * hi) * 2);
          acc = __builtin_amdgcn_mfma_f32_32x32x16_bf16(af, bfr, acc, 0, 0, 0); }
      const int j = 32 * tn + r32; const float gjf = gct[j], gjb = gct[64 + j];
#pragma unroll
      for (int g4 = 0; g4 < 4; ++g4) { const int i0 = 32 * tm + 8 * g4 + 4 * hi;
          const f32x4 gif = *(const LAS f32x4*)(gct + i0), gib = *(const LAS f32x4*)(gct + 64 + i0), bif = *(const LAS f32x4*)(btk + i0), bib = *(const LAS f32x4*)(btk + 64 + i0);
#pragma unroll
          for (int q = 0; q < 4; ++q) { const int i = i0 + q; const float v = acc[4 * g4 + q];
              const float ef = __expf(fminf(gif[q] - gjf, 0.f)), eb = __expf(fminf(gib[q] - gjb, 0.f));
              if (w < 4) {
                  const float lf = (j < i) ? -bif[q] * v * ef : 0.f, lb = (j > i) ? -bib[q] * v * eb : 0.f;
                  *(LAS bf16*)(NL + i * 144 + j * 2) = (bf16)(pk2(lf, 0.f) & 0xffffu);
                  *(LAS bf16*)(NL + 9216 + (63 - i) * 144 + (63 - j) * 2) = (bf16)(pk2(lb, 0.f) & 0xffffu);
              } else {
                  const float qf = (j <= i) ? v * ef : 0.f, qb = (j >= i) ? v * eb : 0.f;
                  *(LAS bf16*)(QKL + i * 144 + j * 2) = (bf16)(pk2(qf, 0.f) & 0xffffu);
                  *(LAS bf16*)(QKL + 9216 + (63 - i) * 144 + (63 - j) * 2) = (bf16)(pk2(qb, 0.f) & 0xffffu);
              } } } }
    LDS_WAIT(); __syncthreads();
    if (w < 2) { const int blk = lane >> 4, col = lane & 15; const LAS unsigned char* nl = NL + w * 9216 + (16 * blk) * 144 + (16 * blk) * 2;
        float t[16];
#pragma unroll
        for (int r = 0; r < 16; ++r) { float acc = (r == col) ? 1.f : 0.f;
            if (r > 0) { float l[16]; { float l8[8]; unpack8(*(const LAS u32x4*)(nl + r * 144), l8);
#pragma unroll
                    for (int q = 0; q < 8; ++q) l[q] = l8[q]; }
                if (r > 8) { float l8[8]; unpack8(*(const LAS u32x4*)(nl + r * 144 + 16), l8);
#pragma unroll
                    for (int q = 0; q < 8; ++q) l[8 + q] = l8[q]; }
#pragma unroll
                for (int q = 0; q < r; ++q) acc += l[q] * t[q]; }
            t[r] = acc; }
#pragma unroll
        for (int r = 0; r < 16; ++r) *(LAS bf16*)(TD + w * 3072 + blk * 768 + r * 48 + col * 2) = (bf16)(pk2(t[r], 0.f) & 0xffffu);
    }
    LDS_WAIT(); __syncthreads();
    { const int d = w >> 2, cc = lane & 15, g = lane >> 4;
      const LAS unsigned char* nl = NL + d * 9216; const LAS unsigned char* td = TD + d * 3072 + cc * 48 + 8 * g;
#pragma unroll
      for (int jj = 0; jj < 2; ++jj) { const int ct = 2 * (w & 3) + jj, part = ct >> 2, colb = 16 * (ct & 3);
          const LAS unsigned char* src = part ? Kb : Vb; const LAS float* coef = (part ? cwp : cu) + d * 64;
          f32x4 R[4];
#pragma unroll
          for (int bq = 0; bq < 4; ++bq) { const f32x4 cf = *(const LAS f32x4*)(coef + 16 * bq + 4 * g);
#pragma unroll
              for (int r = 0; r < 4; ++r) { const int p = 16 * bq + 4 * g + r, i = d ? 63 - p : p;
                  R[bq][r] = cf[r] * __uint_as_float((unsigned)(*(const LAS bf16*)(src + i * 144 + (colb + cc) * 2)) << 16); } }
          const f32x4 z4 = (f32x4){0.f, 0.f, 0.f, 0.f};
          f32x4 X0, X1, X2, X3, Y;
          X0 = __builtin_amdgcn_mfma_f32_16x16x32_bf16(frag_lo(td), pack_f4z(R[0]), z4, 0, 0, 0);
          Y = __builtin_amdgcn_mfma_f32_16x16x32_bf16(frag_lo(nl + (16 + cc) * 144 + 8 * g), pack_f4z(X0), R[1], 0, 0, 0);
          X1 = __builtin_amdgcn_mfma_f32_16x16x32_bf16(frag_lo(td + 768), pack_f4z(Y), z4, 0, 0, 0);
          const bf16x8 x01 = pack_f4f4(X0, X1);
          Y = __builtin_amdgcn_mfma_f32_16x16x32_bf16(frag_2(nl + (32 + cc) * 144 + 8 * g), x01, R[2], 0, 0, 0);
          X2 = __builtin_amdgcn_mfma_f32_16x16x32_bf16(frag_lo(td + 2 * 768), pack_f4z(Y), z4, 0, 0, 0);
          Y = __builtin_amdgcn_mfma_f32_16x16x32_bf16(frag_2(nl + (48 + cc) * 144 + 8 * g), x01, R[3], 0, 0, 0);
          Y = __builtin_amdgcn_mfma_f32_16x16x32_bf16(frag_lo(nl + (48 + cc) * 144 + 64 + 8 * g), pack_f4z(X2), Y, 0, 0, 0);
          X3 = __builtin_amdgcn_mfma_f32_16x16x32_bf16(frag_lo(td + 3 * 768), pack_f4z(Y), z4, 0, 0, 0);
          const float sgn = part ? -1.f : 1.f;
          const bf16x8 xb0 = pack_f4f4(X0 * sgn, X1 * sgn), xb1 = pack_f4f4(X2 * sgn, X3 * sgn);
          const int q4 = (lane & 15) >> 2, pp = lane & 3;
          const LAS unsigned char* qkl = QKL + d * 9216; const LAS unsigned char* qtl = QT + d * 9216;
          bf16* pA = (d == 0 || part == 1) ? P + tok0 * PLD + h * 64 + (part ? (d ? SAB : SAF) : SBF) : XB2 + tok0 * 512 + h * 64;
          bf16* pC = (d == 0 || part == 1) ? P + tok0 * PLD + h * 64 + (part ? (d ? SCB : SCF) : SDF) : XB2 + (size_t)M * 512 + tok0 * 512 + h * 64;
          const size_t pit = (d == 0 || part == 1) ? PLD : 512;
          const int pc = dn_pcol(colb + cc);
#pragma unroll
          for (int mt = 0; mt < 4; ++mt) {
              s16x4 klo[2], khi[2]; bf16x8 qkf[2]; f32x4 acc2;
              { const unsigned ka = (unsigned)(uintptr_t)(KT + d * 10240) + (4 * g + q4) * 160u + (16 * mt + 4 * pp) * 2u;
                asm volatile("ds_read_b64_tr_b16 %0, %1" : "=&v"(klo[0]) : "v"(ka) : "memory");
                asm volatile("ds_read_b64_tr_b16 %0, %1 offset:2560" : "=&v"(khi[0]) : "v"(ka) : "memory");
                asm volatile("ds_read_b64_tr_b16 %0, %1 offset:5120" : "=&v"(klo[1]) : "v"(ka) : "memory");
                asm volatile("ds_read_b64_tr_b16 %0, %1 offset:7680" : "=&v"(khi[1]) : "v"(ka) : "memory"); }
#pragma unroll
              for (int ks = 0; ks < 2; ++ks) { if (ks == 1 && mt < 2) continue; qkf[ks] = frag_2(qkl + (16 * mt + cc) * 144 + (32 * ks + 4 * g) * 2); }
#pragma unroll
              for (int r = 0; r < 4; ++r) acc2[r] = part ? __uint_as_float((unsigned)(*(const LAS bf16*)(qtl + (16 * mt + 4 * g + r) * 144 + (colb + cc) * 2)) << 16) : 0.f;
              asm volatile("s_waitcnt lgkmcnt(0)" ::: "memory"); __builtin_amdgcn_sched_barrier(0);
              f32x4 acc = z4;
#pragma unroll
              for (int ks = 0; ks < 2; ++ks) { const bf16x8 kf = (bf16x8){klo[ks][0], klo[ks][1], klo[ks][2], klo[ks][3], khi[ks][0], khi[ks][1], khi[ks][2], khi[ks][3]};
                  acc = __builtin_amdgcn_mfma_f32_16x16x32_bf16(kf, ks ? xb1 : xb0, acc, 0, 0, 0); }
#pragma unroll
              for (int ks = 0; ks < 2; ++ks) { if (ks == 1 && mt < 2) continue; acc2 = __builtin_amdgcn_mfma_f32_16x16x32_bf16(qkf[ks], ks ? xb1 : xb0, acc2, 0, 0, 0); }
              if (part == 0) {
                  u32x2 o; o.x = pk2(acc[0], acc[1]); o.y = pk2(acc[2], acc[3]); *(u32x2*)(pA + (size_t)(colb + cc) * pit + 16 * mt + 4 * g) = o;
                  o.x = pk2(acc2[0], acc2[1]); o.y = pk2(acc2[2], acc2[3]); *(u32x2*)(pC + (size_t)(colb + cc) * pit + 16 * mt + 4 * g) = o; }
              else {
#pragma unroll
                  for (int r = 0; r < 4; ++r) { pA[(size_t)(16 * mt + 4 * g + r) * pit + pc] = (bf16)(pk2(acc[r], 0.f) & 0xffffu); pC[(size_t)(16 * mt + 4 * g + r) * pit + pc] = (bf16)(pk2(acc2[r], 0.f) & 0xffffu); } }
              __builtin_amdgcn_sched_barrier(0);
          }
          asm volatile("" ::: "memory"); __builtin_amdgcn_sched_barrier(0);
      } }
    LDS_WAIT(); __syncthreads();
  }
#undef DN_PREFETCH
}

constexpr int DNX_A = 0, DNX_C = 8192, DNX_BT = 16384, DNX_DT = 24576, DNX_EG = 32768, DNX_SZ = 33792, DNX_OST = 3 * DNX_SZ;
__device__ __forceinline__ void dn_scan_step(const LAS unsigned char* buf, f32x4 (&Sacc)[4], int ws, int lane, LAS unsigned char* ost, int dir) {
    const int c = lane & 15, g = lane >> 4;
    const unsigned trow = 16 * ws + c, t0 = trow * 128u + ((((unsigned)(g >> 1)) ^ ((trow >> 1) & 7u)) << 4) + 8u * (g & 1);
    u32x2 bt[4], dt[4]; bf16x8 af[4][2], cf[4][2];
#pragma unroll
    for (int mt = 0; mt < 4; ++mt) { const unsigned row = 16 * mt + c, a0 = row * 128u + ((((unsigned)g) ^ ((row >> 1) & 7u)) << 4);
        bt[mt] = *(const LAS u32x2*)(buf + DNX_BT + (t0 ^ ((unsigned)mt << 5)));
#pragma unroll
        for (int ks = 0; ks < 2; ++ks) af[mt][ks] = *(const LAS bf16x8*)(buf + DNX_A + (a0 ^ ((unsigned)ks << 6))); }
#pragma unroll
    for (int mt = 0; mt < 4; ++mt) { const unsigned row = 16 * mt + c, a0 = row * 128u + ((((unsigned)g) ^ ((row >> 1) & 7u)) << 4);
        dt[mt] = *(const LAS u32x2*)(buf + DNX_DT + (t0 ^ ((unsigned)mt << 5)));
#pragma unroll
        for (int ks = 0; ks < 2; ++ks) cf[mt][ks] = *(const LAS bf16x8*)(buf + DNX_C + (a0 ^ ((unsigned)ks << 6))); }
    const float gm = ((const LAS float*)(buf + DNX_EG))[63];
    bf16x8 Sb[2];
#pragma unroll
    for (int ks = 0; ks < 2; ++ks) Sb[ks] = pack_f4f4(Sacc[2 * ks], Sacc[2 * ks + 1]);
    __builtin_amdgcn_sched_barrier(0);
#pragma unroll
    for (int mt = 0; mt < 4; ++mt) { f32x4 sn = Sacc[mt] * gm + (f32x4){bf_lo(bt[mt].x), bf_hi(bt[mt].x), bf_lo(bt[mt].y), bf_hi(bt[mt].y)};
#pragma unroll
        for (int ks = 0; ks < 2; ++ks) sn = __builtin_amdgcn_mfma_f32_16x16x32_bf16(af[mt][ks], Sb[ks], sn, 0, 0, 0);
        Sacc[mt] = sn; }
#pragma unroll
    for (int mt = 0; mt < 4; ++mt) { f32x4 oa = (f32x4){bf_lo(dt[mt].x), bf_hi(dt[mt].x), bf_lo(dt[mt].y), bf_hi(dt[mt].y)};
#pragma unroll
        for (int ks = 0; ks < 2; ++ks) oa = __builtin_amdgcn_mfma_f32_16x16x32_bf16(cf[mt][ks], Sb[ks], oa, 0, 0, 0);
#pragma unroll
        for (int r = 0; r < 4; ++r) { const int p = 16 * mt + 4 * g + r, i = dir ? 63 - p : p;
            *(LAS bf16*)(ost + i * 128 + (16 * ws + c) * 2) = (bf16)(pk2(oa[r], 0.f) & 0xffffu); } }
}
__device__ __forceinline__ void dn_scan_unit(Frame& F, const Args& a, int b, int h, int dir) {
    bf16* P = (bf16*)(a.ws + WS_P);
    const int w = F.wave, lane = F.lane;
#define DN_BAR() do { asm volatile("s_waitcnt lgkmcnt(0)" ::: "memory"); __builtin_amdgcn_s_barrier(); asm volatile("" ::: "memory"); } while (0)
    if (w < 4) {
        f32x4 Sacc[4];
#pragma unroll
        for (int mt = 0; mt < 4; ++mt) Sacc[mt] = (f32x4){0.f, 0.f, 0.f, 0.f};
        bf16* Ob = P + (size_t)b * SEQ * PLD + (dir ? C_OB : C_OF) + h * 64;
        DN_BAR();
        int slot = 0;
#pragma unroll 1
        for (int s = 0; s <= 128; ++s) {
            if (s > 0) { const int cp = dir ? 128 - s : s - 1; const LAS unsigned char* st = F.lds + DNX_OST + ((s - 1) & 1) * 8192;
#pragma unroll
                for (int k = 0; k < 2; ++k) { const int idx = F.tid + 256 * k, row = idx >> 3, ch = idx & 7;
                    *(u32x4*)(Ob + ((size_t)cp * 64 + row) * PLD + ch * 8) = *(const LAS u32x4*)(st + row * 128 + ch * 16); } }
            if (s < 128) dn_scan_step(F.lds + slot * DNX_SZ, Sacc, w, lane, F.lds + DNX_OST + (s & 1) * 8192, dir);
            slot = slot == 2 ? 0 : slot + 1;
            DN_BAR();
        }
    } else {
        const int hw = w - 4;
        const bf16* XB2 = (const bf16*)a.out + (size_t)M * 1024;
        const float* BAg = (const float*)(a.ws + WS_BA);
        const char* gp[8]; long gstep[8];
#pragma unroll
        for (int i = 0; i < 8; ++i) { const int pid = hw * 8 + i, blk = pid >> 3, pc = pid & 7, r = 8 * pc + (lane >> 3), cp = lane & 7;
            const int key = (r >> 1) & 7, cs = cp ^ key;
            const size_t tokb = (size_t)b * SEQ;
            if (dir == 1 && blk >= 2) { gp[i] = (const char*)(XB2 + (size_t)(blk - 2) * M * 512 + (tokb + r) * 512 + h * 64 + cs * 8); gstep[i] = 64L * 512 * 2; }
            else { const int col = blk == 0 ? (dir ? SAB : SAF) : blk == 1 ? (dir ? SCB : SCF) : blk == 2 ? SBF : SDF;
                   gp[i] = (const char*)(P + (tokb + r) * PLD + col + h * 64 + cs * 8); gstep[i] = 64L * PLD * 2; } }
        const char* ggc = (const char*)(BAg + ((size_t)b * SEQ + lane) * 32 + dir * 8 + h);
#define DN_ISSUE(n, slot_) do { const int cn_ = dir ? 127 - (n) : (n); LAS unsigned char* sb_ = F.lds + (slot_) * DNX_SZ; \
        _Pragma("unroll") for (int i = 0; i < 8; ++i) { const int pid = hw * 8 + i; \
            __builtin_amdgcn_global_load_lds((const unsigned*)(gp[i] + (long)cn_ * gstep[i]), (LAS unsigned*)(sb_ + (pid >> 3) * 8192 + (pid & 7) * 1024), 16, 0, 0); } \
        __builtin_amdgcn_global_load_lds((const unsigned*)(ggc + (long)cn_ * (64L * 32 * 4)), (LAS unsigned*)(sb_ + DNX_EG + hw * 256), 4, 0, 0); } while (0)
        DN_ISSUE(0, 0); DN_ISSUE(1, 1);
        asm volatile("s_waitcnt vmcnt(9)" ::: "memory");
        DN_BAR();
        int slot2 = 2;
#pragma unroll 1
        for (int s = 0; s <= 128; ++s) {
            if (s + 2 < 128) { DN_ISSUE(s + 2, slot2); asm volatile("s_waitcnt vmcnt(9)" ::: "memory"); }
            else { asm volatile("s_waitcnt vmcnt(0)" ::: "memory"); }
            slot2 = slot2 == 2 ? 0 : slot2 + 1;
            DN_BAR();
        }
#undef DN_ISSUE
    }
#undef DN_BAR
    __syncthreads();
}
__device__ __forceinline__ void dn_combine(Frame& F, const Args& a) {
    bf16* P = (bf16*)(a.ws + WS_P);
    const float* og = a.in[11];
    const int gw = F.vcu * NWAVES + F.wave, NGW = F.G * NWAVES, c0 = F.lane * 8;
    for (int row = gw; row < M; row += NGW) {
        bf16* rp = P + (size_t)row * PLD;
        float of[8], ob[8]; unpack8(*(const u32x4*)(rp + C_OF + c0), of); unpack8(*(const u32x4*)(rp + C_OB + c0), ob);
        float s[8], ss = 0.f;
#pragma unroll
        for (int j = 0; j < 8; ++j) { s[j] = of[j] + ob[j]; ss += s[j] * s[j]; }
        ss += __shfl_xor(ss, 1); ss += __shfl_xor(ss, 2); ss += __shfl_xor(ss, 4);
        const float rstd = __builtin_amdgcn_rsqf(ss * (1.0f / 64) + EPS);
        bf16* zp = rp + C_DZ + c0; float z[8]; unpack8(*(const u32x4*)zp, z);
        const f32x4 g0 = *(const f32x4*)(og + (c0 & 63)), g1 = *(const f32x4*)(og + (c0 & 63) + 4);
        float y[8];
#pragma unroll
        for (int j = 0; j < 4; ++j) { y[j] = s[j] * rstd * g0[j] * siluf_(z[j]); y[4 + j] = s[4 + j] * rstd * g1[j] * siluf_(z[4 + j]); }
        *(u32x4*)zp = pack8(y);
    }
}
__device__ __forceinline__ void ffn_fixup_panel(Frame& F, const Args& a, int pm) {
    bf16* P = (bf16*)(a.ws + WS_P); const float* UE = (const float*)(a.ws + WS_UE);
    const float* cw = a.in[22]; const float* cb = a.in[23];
    for (int e = F.tid; e < 8 * DFF; e += 512) { const int k = e / DFF, ch = e % DFF, g = pm * 4 + (k >> 1), last = k & 1;
        const int row = g * 64 + (last ? 63 : 0);
        const float* pu; const float* cu; const float* nu; bool hp = true, hn = true;
        if (!last) { hp = (row % SEQ) != 0; pu = UE + ((size_t)(g > 0 ? g - 1 : 0) * 4 + 3) * NUP; cu = UE + ((size_t)g * 4 + 0) * NUP; nu = UE + ((size_t)g * 4 + 1) * NUP; }
        else { hn = (row % SEQ) != SEQ - 1; pu = UE + ((size_t)g * 4 + 2) * NUP; cu = UE + ((size_t)g * 4 + 3) * NUP; nu = UE + ((size_t)(g < 511 ? g + 1 : 511) * 4 + 0) * NUP; }
        const float pg = hp ? pu[ch] : 0.f, pv = hp ? pu[DFF + ch] : 0.f, ng = hn ? nu[ch] : 0.f, nv = hn ? nu[DFF + ch] : 0.f;
        const float gate = cw[ch] * pg + cw[NUP + ch] * cu[ch] + cw[2 * NUP + ch] * ng + cb[ch];
        const float val = cw[DFF + ch] * pv + cw[NUP + DFF + ch] * cu[DFF + ch] + cw[2 * NUP + DFF + ch] * nv + cb[DFF + ch];
        P[(size_t)row * PLD + C_ACT + ch] = (bf16)(pk2(siluf_(gate) * val, 0.f) & 0xffffu); }
}

__global__ void __launch_bounds__(NWAVES * 64, 2) fwd_kernel(Args args) {
    extern __shared__ __attribute__((aligned(16))) unsigned char lds[];
    Frame F;
    F.lds = (LAS unsigned char*)lds;
    F.MISC = (volatile LAS unsigned*)(F.lds + MISC_OFF);
    F.tid = threadIdx.x; F.lane = F.tid & 63; F.wave = __builtin_amdgcn_readfirstlane(F.tid >> 6);
    F.G = gridDim.x; { const int bx = blockIdx.x; F.vcu = (F.G % 8 == 0) ? (bx % 8) * (F.G / 8) + bx / 8 : bx; }
    unsigned char* ws = args.ws;
    F.ctl = (gu32*)(ws + WS_CTL);
    for (int u = F.tid; u < (LDS_BYTES - LDSCTL_OFF) / 4; u += NWAVES * 64) ((LAS unsigned*)(F.lds + LDSCTL_OFF))[u] = 0u;
    __syncthreads();
    const int lo = args.ph_lo, hi = args.ph_hi;
    const bool single = (hi - lo) > 1;
    XcdBarrier bar; bar.bar = (unsigned*)(F.ctl + CW_BAR); bar.x = 0; bar.st = nullptr;
    if (single) bar = xcd_barrier_post((unsigned*)(F.ctl + CW_BAR), F.MISC + 8);
#ifndef PH_MASK
#define PH_MASK 0x1FF
#endif
#define IN(k) (((PH_MASK >> (k)) & 1) && lo <= (k) && (k) < hi)
#define SEAM(k) do { if (IN(k) && IN((k) + 1)) xcd_barrier(bar); } while (0)
    bf16* P = (bf16*)(ws + WS_P);
    const int bid = (int)blockIdx.x;
#define TS(k) do {} while (0)
#define TSB(k, blk) do {} while (0)
    TS(0);

    if (IN(0)) { p0_prologue(F, args); }
    SEAM(0); TS(1);
    if (IN(1)) {
        { pg8::Gemm g{(const bf16*)args.out, (const bf16*)(ws + WS_WIN), M, 3584, 1024, 1024, 1024}; pg8::StaticOrder S; S.init(M, 3584, F.G, bid);
          EpiInProj E{P, (float*)(ws + WS_BA)};
          pg8::gemm_phase<EpiInProj, pg8::StaticOrder, true, true>(F.lds + RING_OFF, g, S, E); }
        { pg8::Gemm g{(const bf16*)(ws + WS_MEMN), (const bf16*)(ws + WS_WKV), BATCH * NMEM, 1024, 1024, 1024, 1024}; pg8::StaticOrder S; S.init(BATCH * NMEM, 1024, F.G, bid);
          EpiBf16 E{(bf16*)(ws + WS_KV), 1024};
          pg8::gemm_phase<EpiBf16, pg8::StaticOrder, true, true>(F.lds + RING_OFF, g, S, E); }
    }
    SEAM(1); TS(2);
    if (IN(2)) {
        if (F.G == 256) dn_prep_block(F, args, bid >> 6, (bid >> 3) & 7, (bid & 7) * 16, 16);
        else for (int u = bid; u < 4096; u += F.G) dn_prep_block(F, args, u >> 10, (u >> 7) & 7, u & 127, 1);
    }
    TS(12); SEAM(2); TS(3);
    if (IN(3)) {
        const int ndn = F.G >= 128 ? 64 : 0;
        if (bid < ndn) { if (args.mode != 2) dn_scan_unit(F, args, bid >> 4, (bid >> 1) & 7, bid & 1); }
        else if (args.mode != 1) {
            if (ndn == 0) for (int u = bid; u < 64; u += F.G) dn_scan_unit(F, args, u >> 4, (u >> 1) & 7, u & 1);
            const int nb = F.G - ndn, me = bid - ndn;
            for (int u = me; u < 1024; u += nb) {
                if (u < 512) attnA_unit(F, args, u >> 7, (u >> 1) & 63, u & 1);
                else { const int v = u - 512; xattn_unit(F, args, v >> 7, (v >> 2) & 31, v & 3); }
            }
        }
    }
    TS(10); TSB(11, 64); SEAM(3); TS(4);
    if (IN(4)) {
        dn_combine(F, args);
        pg8::Gemm g{(const bf16*)args.out, (const bf16*)(ws + WS_WIN) + (size_t)3584 * 1024, M, 3072, 1024, 1024, 1024}; pg8::StaticOrder S; S.init(M, 3072, F.G, bid);
        EpiBf16 E{P + C_GATE, PLD};
        pg8::gemm_phase<EpiBf16, pg8::StaticOrder, true, true>(F.lds + RING_OFF, g, S, E);
    }
    SEAM(4); TS(5);
    if (IN(5)) {
        { pg8::Gemm g{P + C_AQ, (const bf16*)(ws + WS_WBR), M, 1024, 512, PLD, 512}; pg8::StaticOrder S; S.init(M, 1024, F.G, bid);
          EpiBranch<0> E{P}; pg8::gemm_phase<EpiBranch<0>, pg8::StaticOrder, true, true>(F.lds + RING_OFF, g, S, E); }
        VM_WAIT(); __syncthreads();
        { pg8::Gemm g{P + C_DZ, (const bf16*)(ws + WS_WBR) + (size_t)1024 * 512, M, 1024, 512, PLD, 512}; pg8::StaticOrder S; S.init(M, 1024, F.G, bid);
          EpiBranch<1> E{P}; pg8::gemm_phase<EpiBranch<1>, pg8::StaticOrder, true, true>(F.lds + RING_OFF, g, S, E); }
        VM_WAIT(); __syncthreads();
        { pg8::Gemm g{P + C_MQ, (const bf16*)(ws + WS_WBR) + (size_t)2 * 1024 * 512, M, 1024, 512, PLD, 512}; pg8::StaticOrder S; S.init(M, 1024, F.G, bid);
          EpiBranch<2> E{P}; pg8::gemm_phase<EpiBranch<2>, pg8::StaticOrder, true, true>(F.lds + RING_OFF, g, S, E); }
    }
    SEAM(5); TS(6);
    if (IN(6)) {
        pg8::Gemm g{P + C_MG, (const bf16*)(ws + WS_WOUT), M, 1024, 1024, PLD, 1024}; pg8::StaticOrder S; S.init(M, 1024, F.G, bid);
        EpiWout E{args.in[0], args.out, P, (float*)(ws + WS_SSQ), (LAS float*)(F.lds + XCH_OFF)};
        pg8::gemm_phase<EpiWout, pg8::StaticOrder, true, true>(F.lds + RING_OFF, g, S, E);
    }
    SEAM(6); TS(7);
    if (IN(7)) {
        pg8::Gemm g{P + C_X1B, (const bf16*)(ws + WS_WUP), M, NUP, 1024, PLD, 1024}; pg8::StaticOrder S; S.init(M, NUP, F.G, bid);
        EpiUp E{(const float*)(ws + WS_SSQ), args.in[22], args.in[23], P, (float*)(ws + WS_UE)};
        pg8::gemm_phase<EpiUp, pg8::StaticOrder, true, true>(F.lds + RING_OFF, g, S, E);
    }
    SEAM(7); TS(8);
    if (IN(8)) {
        pg8::Gemm g{P + C_ACT, (const bf16*)(ws + WS_WDN), M, 1024, DFF, PLD, DFF}; pg8::StaticOrder S; S.init(M, 1024, F.G, bid);
        { Unit u; int prev = -1; for (int i = 0; S.next(i, u); ++i) { if (u.pm != prev) ffn_fixup_panel(F, args, u.pm); prev = u.pm; } }
        VM_WAIT(); __syncthreads();
        EpiDown E{args.out};
        pg8::gemm_phase<EpiDown, pg8::StaticOrder, true, true>(F.lds + RING_OFF, g, S, E);
    }
    TS(9);
#undef IN
#undef SEAM
}

#ifdef DBG_TIME
__global__ void dbg_ts_kernel(unsigned char* ws, int k) { if (threadIdx.x == 0) ((unsigned long long*)(ws + WS_CTL + 65536))[k] = __builtin_amdgcn_s_memrealtime(); }
__global__ void dbg_wait_kernel(unsigned char* ws) {
    if (threadIdx.x == 0) { const unsigned long long* tsb = (const unsigned long long*)(ws + WS_CTL + 65536);
        const unsigned long long te = __builtin_amdgcn_s_memrealtime();
        const unsigned long long d1 = tsb[DBG_A1] - tsb[DBG_A0], d2 = tsb[DBG_B1] - tsb[DBG_B0];
        const unsigned long long W = d1 + 100000ull * (d2 / 1000ull);
        while (__builtin_amdgcn_s_memrealtime() - te < W) __builtin_amdgcn_s_sleep(32); }
}
#endif
constexpr int N_PHASES = 9;
#ifndef MK_PER_PHASE
#define MK_PER_PHASE 0
#endif
extern "C" void kernel_launch(void* const* d_in, const int* in_sizes, int n_in, void* d_out, int out_size, void* d_ws, size_t ws_size, hipStream_t stream) {
    static int grid = 0;
    if (grid == 0) {
        if (n_in != 25 || in_sizes[0] != M * DM || out_size != M * DM || ws_size < WS_END) {
            fprintf(stderr, "kernel_launch: unexpected shapes (n_in %d, in0 %d, out %d, ws %zu); nothing launched\n", n_in, n_in > 0 ? in_sizes[0] : -1, out_size, ws_size); grid = -1; return; }
        int dev = 0, cus = 0, per_cu = 0;
        if (hipGetDevice(&dev) != hipSuccess || hipDeviceGetAttribute(&cus, hipDeviceAttributeMultiprocessorCount, dev) != hipSuccess) { grid = -1; return; }
        if (hipFuncSetAttribute((const void*)fwd_kernel, hipFuncAttributeMaxDynamicSharedMemorySize, LDS_BYTES) != hipSuccess) { fprintf(stderr, "kernel_launch: hipFuncSetAttribute failed\n"); grid = -1; return; }
        if (hipOccupancyMaxActiveBlocksPerMultiprocessor(&per_cu, (const void*)fwd_kernel, NWAVES * 64, LDS_BYTES) != hipSuccess || per_cu < 1) { fprintf(stderr, "kernel_launch: occupancy query reports %d\n", per_cu); }
        (void)hipGetLastError();
        grid = cus;
    }
    if (grid < 0) return;
    if (hipMemsetAsync((char*)d_ws + WS_CTL, 0, CTL_ZERO_BYTES, stream) != hipSuccess) return;
    Args a{};
    for (int i = 0; i < 25; ++i) a.in[i] = (const float*)d_in[i];
    a.out = (float*)d_out; a.ws = (unsigned char*)d_ws;
#ifdef DBG_TIME
    for (int p = 0; p < N_PHASES; ++p) { hipLaunchKernelGGL(dbg_ts_kernel, dim3(1), dim3(64), 0, stream, (unsigned char*)d_ws, p);
        a.ph_lo = p; a.ph_hi = p + 1;
        if (p == 3) { a.mode = 1; hipLaunchKernelGGL(fwd_kernel, dim3(grid), dim3(NWAVES * 64), LDS_BYTES, stream, a); hipLaunchKernelGGL(dbg_ts_kernel, dim3(1), dim3(64), 0, stream, (unsigned char*)d_ws, 12); a.mode = 2; }
        hipLaunchKernelGGL(fwd_kernel, dim3(grid), dim3(NWAVES * 64), LDS_BYTES, stream, a); a.mode = 0; }
    hipLaunchKernelGGL(dbg_ts_kernel, dim3(1), dim3(64), 0, stream, (unsigned char*)d_ws, N_PHASES);
    hipLaunchKernelGGL(dbg_wait_kernel, dim3(1), dim3(64), 0, stream, (unsigned char*)d_ws);
    return;
#endif
    if (MK_PER_PHASE) {
        for (int p = 0; p < N_PHASES; ++p) { a.ph_lo = p; a.ph_hi = p + 1; hipLaunchKernelGGL(fwd_kernel, dim3(grid), dim3(NWAVES * 64), LDS_BYTES, stream, a); }
    } else {
        a.ph_lo = 0; a.ph_hi = N_PHASES; hipLaunchKernelGGL(fwd_kernel, dim3(grid), dim3(NWAVES * 64), LDS_BYTES, stream, a);
    }
}
```

```cpp
#include <hip/hip_runtime.h>
#include <cstdio>
#include <cstdint>
#include <cmath>
namespace pg8 {
#define PG8_LAS __attribute__((address_space(3)))
typedef unsigned short bf16_t;
typedef short bf16x8 __attribute__((ext_vector_type(8)));
typedef float f32x4 __attribute__((ext_vector_type(4)));
typedef unsigned u32x4 __attribute__((ext_vector_type(4)));
constexpr int BM = 256, BK = 64, HALF = 128, HTB = HALF * BK * 2  , STAGE_BYTES = 8 * HTB, NXCD = 8, WGM = 8;

__host__ __device__ __forceinline__ int lds_byte(int r, int c) { const int st = (r >> 4) * 2 + (c >> 5), rr = r & 15, cc = c & 31, ob = rr * 64 + cc * 2; return st * 1024 + (ob ^ (((ob >> 9) & 1) << 5)); }
__host__ __device__ __forceinline__ void stage_rc(int b, int& R, int& C) { const int st = b / 1024, sb = b % 1024, swz = sb ^ (((sb >> 9) & 1) << 5); R = (st >> 1) * 16 + swz / 64; C = (st & 1) * 32 + (swz % 64) / 2; }
__host__ __device__ __forceinline__ int perm32(int rho) { const int n = rho >> 4, i = rho & 15; return 8 * (i >> 2) + 4 * n + (i & 3); }

struct Unit { int pm, pn; };
struct Gemm { const bf16_t* A; const bf16_t* Bt; int M, N, K, lda, ldb; };

struct StaticOrder {
    int nM, nN, nwg, G, c;
    __host__ __device__ __forceinline__ void init(int M, int N, int G_, int c_) { nM = M / BM; nN = N / BM; nwg = nM * nN; G = G_; c = c_; }
    __host__ __device__ __forceinline__ bool next(int i, Unit& u) const {
        const long L = (long)i * G + c; if (L >= nwg) return false;
        int wgid = (int)L; { const int q = nwg / NXCD, r = nwg % NXCD, xcd = wgid % NXCD, off = wgid / NXCD; wgid = (xcd < r ? xcd * (q + 1) : r * (q + 1) + (xcd - r) * q) + off; }
        const int nig = WGM * nN, gid = wgid / nig, fm = gid * WGM, gsz = (nM - fm) < WGM ? (nM - fm) : WGM;
        u.pm = fm + ((wgid % nig) % gsz); u.pn = (wgid % nig) / gsz; return true;
    }
    __device__ __forceinline__ void a_ready(const Unit&) const {}
    __device__ __forceinline__ void done(const Unit&) const {}
};

template <class Epi, class Sched, bool ALIGN_EPI = false, bool SP2 = false>
__device__ __forceinline__ void gemm_phase(PG8_LAS unsigned char* lds, const Gemm g, const Sched& S, const Epi& E) {
    const int tid = threadIdx.x, wid = __builtin_amdgcn_readfirstlane(tid >> 6), lane = tid & 63, wr = wid >> 2, wc = wid & 3, fr = lane & 15, fq = lane >> 4;
    const int K = g.K, nt = K / BK;
    unsigned voffA[2], voffB[2];
#pragma unroll
    for (int i = 0; i < 2; ++i) { int R, C; stage_rc(tid * 16 + i * 8192, R, C); const int Rb = Epi::PERM ? ((R & ~31) + perm32(R & 31)) : R;
        voffA[i] = (unsigned)(R * g.lda + C) * 2u; voffB[i] = (unsigned)(Rb * g.ldb + C) * 2u; }
    const size_t kstep = (size_t)(BK * 2);
    const size_t hstepA = (size_t)HALF * g.lda * 2, hstepB = (size_t)HALF * g.ldb * 2;
    const size_t tstepA = 2 * hstepA, tstepB = 2 * hstepB;
    const unsigned ldsw = (unsigned)wid * 1024u;
    const int aoff = lds_byte(wr * 64 + fr, fq * 8), boff = lds_byte(wc * 32 + fr, fq * 8);
#define PG8_SA(b, h) (((b) * 2 + (h)) * HTB)
#define PG8_SB(b, h) ((4 + (b) * 2 + (h)) * HTB)
#define PG8_STAGE(bufoff, gbase, voff) do { _Pragma("unroll") for (int _i = 0; _i < 2; ++_i) \
        __builtin_amdgcn_global_load_lds((const unsigned*)((const char*)(gbase) + (voff)[_i]), (PG8_LAS unsigned*)(lds + (bufoff) + ldsw + _i * 8192), 16, 0, 0); } while (0)
#define PG8_LDA(dst, b, h) do { _Pragma("unroll") for (int m = 0; m < 4; ++m) _Pragma("unroll") for (int k = 0; k < 2; ++k) dst[m][k] = *(const PG8_LAS bf16x8*)(lds + PG8_SA(b, h) + aoff + m * 2048 + k * 1024); } while (0)
#define PG8_LDB(dst, b, h) do { _Pragma("unroll") for (int n = 0; n < 2; ++n) _Pragma("unroll") for (int k = 0; k < 2; ++k) dst[n][k] = *(const PG8_LAS bf16x8*)(lds + PG8_SB(b, h) + boff + n * 2048 + k * 1024); } while (0)
#define PG8_MMA(ai, bj, At, Bt) do { __builtin_amdgcn_s_setprio(1); _Pragma("unroll") for (int m = 0; m < 4; ++m) _Pragma("unroll") for (int n = 0; n < 2; ++n) _Pragma("unroll") for (int k = 0; k < 2; ++k) \
        acc[ai][bj][m][n] = __builtin_amdgcn_mfma_f32_16x16x32_bf16(Bt[n][k], At[m][k], acc[ai][bj][m][n], 0, 0, 0); __builtin_amdgcn_s_setprio(0); } while (0)
#define PG8_WAIT_V(n) asm volatile("s_waitcnt vmcnt(" #n ")" ::: "memory")
#define PG8_WAIT_L(n) asm volatile("s_waitcnt lgkmcnt(" #n ")" ::: "memory")
#define PG8_BAR __builtin_amdgcn_s_barrier()
#define PG8_SCHED __builtin_amdgcn_sched_barrier(0)
    Unit cur, nxt; int ui = 0;
    if (!S.next(0, cur)) return;
    f32x4 acc[2][2][4][2];
#pragma unroll
    for (int a = 0; a < 2; ++a)
#pragma unroll
        for (int b = 0; b < 2; ++b)
#pragma unroll
            for (int m = 0; m < 4; ++m)
#pragma unroll
                for (int n = 0; n < 2; ++n) acc[a][b][m][n] = (f32x4){0.f, 0.f, 0.f, 0.f};
    bf16x8 At[4][2], B0[2][2], B1[2][2];
    const char* cA = (const char*)g.A + (size_t)cur.pm * tstepA; const char* cB = (const char*)g.Bt + (size_t)cur.pn * tstepB;
    S.a_ready(cur);
    if constexpr (SP2) {
        PG8_STAGE(PG8_SB(0, 0), cB, voffB); PG8_STAGE(PG8_SB(0, 1), cB + hstepB, voffB); PG8_STAGE(PG8_SA(0, 0), cA, voffA); PG8_STAGE(PG8_SA(0, 1), cA + hstepA, voffA);
        if (wr == 1) PG8_BAR;
        PG8_WAIT_V(2); PG8_BAR;
        PG8_STAGE(PG8_SB(1, 0), cB + kstep, voffB); PG8_STAGE(PG8_SA(1, 0), cA + kstep, voffA); PG8_STAGE(PG8_SB(1, 1), cB + hstepB + kstep, voffB);
        PG8_WAIT_V(6); PG8_BAR;
    } else {
        PG8_STAGE(PG8_SB(0, 0), cB, voffB); PG8_STAGE(PG8_SA(0, 0), cA, voffA); PG8_STAGE(PG8_SB(0, 1), cB + hstepB, voffB); PG8_STAGE(PG8_SA(0, 1), cA + hstepA, voffA);
        if (wr == 1) PG8_BAR;
        PG8_WAIT_V(4); PG8_BAR;
        PG8_STAGE(PG8_SB(1, 0), cB + kstep, voffB); PG8_STAGE(PG8_SA(1, 0), cA + kstep, voffA); PG8_STAGE(PG8_SB(1, 1), cB + hstepB + kstep, voffB);
        PG8_WAIT_V(6); PG8_BAR;
    }
    for (;;) {
        const bool has_next = S.next(ui + 1, nxt);
        const char* nA = has_next ? (const char*)g.A + (size_t)nxt.pm * tstepA : cA; const char* nB = has_next ? (const char*)g.Bt + (size_t)nxt.pn * tstepB : cB;
        for (int t = 0; t < nt; t += 2) {
            const bool last = (t == nt - 2);
            const char* a1 = cA + (size_t)(t + 1) * kstep;
            const char* a2 = last ? nA : cA + (size_t)(t + 2) * kstep; const char* b2 = last ? nB : cB + (size_t)(t + 2) * kstep;
            const char* a3 = a2 + kstep; const char* b3 = b2 + kstep;
            if (last && has_next) S.a_ready(nxt);
            if constexpr (SP2) {
            PG8_LDB(B0, 0, 0); PG8_LDB(B1, 0, 1); PG8_SCHED; PG8_LDA(At, 0, 0); PG8_STAGE(PG8_SA(1, 1), a1 + hstepA, voffA);
            PG8_WAIT_V(8); PG8_WAIT_L(0); PG8_BAR; PG8_MMA(0, 0, At, B0); PG8_MMA(0, 1, At, B1); PG8_BAR; PG8_SCHED;
            PG8_LDA(At, 0, 1); PG8_STAGE(PG8_SB(0, 0), b2, voffB); PG8_STAGE(PG8_SB(0, 1), b2 + hstepB, voffB); PG8_STAGE(PG8_SA(0, 0), a2, voffA);
            PG8_WAIT_V(8); PG8_WAIT_L(0); PG8_BAR; PG8_MMA(1, 0, At, B0); PG8_MMA(1, 1, At, B1); PG8_BAR; PG8_SCHED;
            PG8_LDB(B0, 1, 0); PG8_LDB(B1, 1, 1); PG8_SCHED; PG8_LDA(At, 1, 0); PG8_STAGE(PG8_SA(0, 1), a2 + hstepA, voffA);
            PG8_WAIT_V(8); PG8_WAIT_L(0); PG8_BAR; PG8_MMA(0, 0, At, B0); PG8_MMA(0, 1, At, B1); PG8_BAR; PG8_SCHED;
            PG8_LDA(At, 1, 1); PG8_STAGE(PG8_SB(1, 0), b3, voffB); PG8_STAGE(PG8_SB(1, 1), b3 + hstepB, voffB); PG8_STAGE(PG8_SA(1, 0), a3, voffA);
            PG8_WAIT_V(8); PG8_WAIT_L(0); PG8_BAR; PG8_MMA(1, 0, At, B0); PG8_MMA(1, 1, At, B1); PG8_BAR; PG8_SCHED;
            } else {
            PG8_LDB(B0, 0, 0); PG8_SCHED; PG8_LDA(At, 0, 0); PG8_STAGE(PG8_SA(1, 1), a1 + hstepA, voffA);
            PG8_WAIT_L(8); PG8_BAR; PG8_WAIT_L(0); PG8_MMA(0, 0, At, B0); PG8_BAR; PG8_SCHED;
            PG8_LDB(B1, 0, 1); PG8_STAGE(PG8_SB(0, 0), b2, voffB);
            PG8_BAR; PG8_WAIT_L(0); PG8_MMA(0, 1, At, B1); PG8_BAR;
            PG8_LDA(At, 0, 1); PG8_STAGE(PG8_SA(0, 0), a2, voffA);
            PG8_BAR; PG8_WAIT_L(0); PG8_MMA(1, 0, At, B0); PG8_BAR; PG8_SCHED;
            PG8_STAGE(PG8_SB(0, 1), b2 + hstepB, voffB);
            PG8_WAIT_V(6); PG8_BAR; PG8_MMA(1, 1, At, B1); PG8_BAR;
            PG8_LDB(B0, 1, 0); PG8_SCHED; PG8_LDA(At, 1, 0); PG8_STAGE(PG8_SA(0, 1), a2 + hstepA, voffA);
            PG8_WAIT_L(8); PG8_BAR; PG8_WAIT_L(0); PG8_MMA(0, 0, At, B0); PG8_BAR; PG8_SCHED;
            PG8_LDB(B1, 1, 1); PG8_STAGE(PG8_SB(1, 0), b3, voffB);
            PG8_BAR; PG8_WAIT_L(0); PG8_MMA(0, 1, At, B1); PG8_BAR;
            PG8_LDA(At, 1, 1); PG8_STAGE(PG8_SA(1, 0), a3, voffA);
            PG8_BAR; PG8_WAIT_L(0); PG8_MMA(1, 0, At, B0); PG8_BAR; PG8_SCHED;
            PG8_STAGE(PG8_SB(1, 1), b3 + hstepB, voffB);
            PG8_WAIT_V(6); PG8_BAR; PG8_MMA(1, 1, At, B1); PG8_BAR;
            }
        }
        if constexpr (ALIGN_EPI) { if (wr == 0) PG8_BAR; }
        if constexpr (!Epi::AFTER_DRAIN) { E(acc, cur, wr, wc, fr, fq); S.done(cur); }
        if (!has_next) break;
#pragma unroll
        for (int a = 0; a < 2; ++a)
#pragma unroll
            for (int b = 0; b < 2; ++b)
#pragma unroll
                for (int m = 0; m < 4; ++m)
#pragma unroll
                    for (int n = 0; n < 2; ++n) acc[a][b][m][n] = (f32x4){0.f, 0.f, 0.f, 0.f};
        cur = nxt; cA = nA; cB = nB; ++ui;
        if constexpr (ALIGN_EPI) { if (wr == 1) PG8_BAR; }
    }
    PG8_WAIT_V(0);
    if constexpr (!ALIGN_EPI) { if (wr == 0) PG8_BAR; }
    PG8_BAR;
    if constexpr (Epi::AFTER_DRAIN) { E.fused(acc, cur, wr, wc, fr, fq, lds, wid, lane); S.done(cur); }
#undef PG8_SA
#undef PG8_SB
#undef PG8_STAGE
#undef PG8_LDA
#undef PG8_LDB
#undef PG8_MMA
#undef PG8_WAIT_V
#undef PG8_WAIT_L
#undef PG8_BAR
#undef PG8_SCHED
}
}

#define LAS __attribute__((address_space(3)))
#define GAS __attribute__((address_space(1)))
typedef unsigned short bf16;
typedef short bf16x8 __attribute__((ext_vector_type(8)));
typedef short s16x4 __attribute__((ext_vector_type(4)));
typedef float f32x4 __attribute__((ext_vector_type(4)));
typedef float f32x16 __attribute__((ext_vector_type(16)));
typedef unsigned u32x4 __attribute__((ext_vector_type(4)));
typedef unsigned u32x2 __attribute__((ext_vector_type(2)));
typedef float f32x2_t __attribute__((ext_vector_type(2)));
typedef __bf16 bf16x2_t __attribute__((ext_vector_type(2)));

constexpr int BATCH = 4, SEQ = 8192, DM = 1024, M = BATCH * SEQ;
constexpr int NMEM = 256;
constexpr int PLD = 6400;
constexpr int C_AQ = 0, C_AK = 512, C_AV = 640, C_DQ = 768, C_DK = 1280, C_DV = 1792, C_DZ = 2304, C_MQ = 2816, C_GATE = 3328;
constexpr int C_MG = 768, C_X1B = 1792, C_ACT = 2816;
constexpr int NIN = 6656;
constexpr int DFF = 2816, NUP = 5632;
constexpr float EPS = 1e-6f;
constexpr float LOG2E = 1.4426950408889634f;

__device__ __forceinline__ float bf_lo(unsigned w) { return __uint_as_float(w << 16); }
__device__ __forceinline__ float bf_hi(unsigned w) { return __uint_as_float(w & 0xffff0000u); }
__device__ __forceinline__ unsigned pk2(float lo, float hi) { f32x2_t v = {lo, hi}; bf16x2_t b = __builtin_convertvector(v, bf16x2_t); return __builtin_bit_cast(unsigned, b); }
__device__ __forceinline__ float fexp2(float x) { return __builtin_amdgcn_exp2f(x); }
__device__ __forceinline__ float frcp(float x) { return __builtin_amdgcn_rcpf(x); }
__device__ __forceinline__ float sigmoidf_(float x) { return frcp(1.0f + fexp2(-x * LOG2E)); }
__device__ __forceinline__ float siluf_(float x) { return x * sigmoidf_(x); }
__device__ __forceinline__ void unpack8(const u32x4 w, float (&v)[8]) {
    v[0] = bf_lo(w.x); v[1] = bf_hi(w.x); v[2] = bf_lo(w.y); v[3] = bf_hi(w.y); v[4] = bf_lo(w.z); v[5] = bf_hi(w.z); v[6] = bf_lo(w.w); v[7] = bf_hi(w.w); }
__device__ __forceinline__ u32x4 pack8(const float (&v)[8]) { u32x4 w; w.x = pk2(v[0], v[1]); w.y = pk2(v[2], v[3]); w.z = pk2(v[4], v[5]); w.w = pk2(v[6], v[7]); return w; }

using pg8::Unit;
constexpr int HALF = pg8::HALF, BM = pg8::BM;

struct EpiInProj {
    static constexpr bool PERM = true, AFTER_DRAIN = false;
    bf16* P; float* BA;
    __device__ __forceinline__ void operator()(const f32x4 (&acc)[2][2][4][2], const Unit& u, int wr, int wc, int fr, int fq) const {
        const int row0 = u.pm * BM + wr * 64 + fr;
        if (u.pn < 13) {
            const int col0 = u.pn * BM + wc * 32 + 8 * fq;
#pragma unroll
            for (int ai = 0; ai < 2; ++ai)
#pragma unroll
                for (int m = 0; m < 4; ++m) { bf16* rowp = P + (size_t)(row0 + ai * HALF + m * 16) * PLD + col0;
#pragma unroll
                    for (int bj = 0; bj < 2; ++bj) { const f32x4 v0 = acc[ai][bj][m][0], v1 = acc[ai][bj][m][1];
                        u32x4 w; w.x = pk2(v0[0], v0[1]); w.y = pk2(v0[2], v0[3]); w.z = pk2(v1[0], v1[1]); w.w = pk2(v1[2], v1[3]);
                        *(u32x4*)(rowp + bj * HALF) = w; } }
        } else if (wc == 0) {
#pragma unroll
            for (int ai = 0; ai < 2; ++ai)
#pragma unroll
                for (int m = 0; m < 4; ++m) { float* rp = BA + (size_t)(row0 + ai * HALF + m * 16) * 32 + 8 * fq;
                    *(f32x4*)rp = acc[ai][0][m][0]; *(f32x4*)(rp + 4) = acc[ai][0][m][1]; }
        }
    }
};
struct EpiBf16 {
    static constexpr bool PERM = true, AFTER_DRAIN = false;
    bf16* O; int ldc;
    __device__ __forceinline__ void operator()(const f32x4 (&acc)[2][2][4][2], const Unit& u, int wr, int wc, int fr, int fq) const {
        const int row0 = u.pm * BM + wr * 64 + fr, col0 = u.pn * BM + wc * 32 + 8 * fq;
#pragma unroll
        for (int ai = 0; ai < 2; ++ai)
#pragma unroll
            for (int m = 0; m < 4; ++m) { bf16* rowp = O + (size_t)(row0 + ai * HALF + m * 16) * ldc + col0;
#pragma unroll
                for (int bj = 0; bj < 2; ++bj) { const f32x4 v0 = acc[ai][bj][m][0], v1 = acc[ai][bj][m][1];
                    u32x4 w; w.x = pk2(v0[0], v0[1]); w.y = pk2(v0[2], v0[3]); w.z = pk2(v1[0], v1[1]); w.w = pk2(v1[2], v1[3]);
                    *(u32x4*)(rowp + bj * HALF) = w; } }
    }
};
template <int PASS> struct EpiBranch {
    static constexpr bool PERM = true, AFTER_DRAIN = false;
    bf16* P;
    __device__ __forceinline__ void operator()(const f32x4 (&acc)[2][2][4][2], const Unit& u, int wr, int wc, int fr, int fq) const {
        const int row0 = u.pm * BM + wr * 64 + fr, col0 = u.pn * BM + wc * 32 + 8 * fq;
#pragma unroll
        for (int ai = 0; ai < 2; ++ai)
#pragma unroll
            for (int m = 0; m < 4; ++m) { bf16* rowp = P + (size_t)(row0 + ai * HALF + m * 16) * PLD;
#pragma unroll
                for (int bj = 0; bj < 2; ++bj) {
                    const int c = col0 + bj * HALF;
                    const u32x4 gw = *(const u32x4*)(rowp + C_GATE + 1024 * PASS + c);
                    float g[8]; unpack8(gw, g);
                    float pv[8];
                    if (PASS > 0) { const u32x4 mw = *(const u32x4*)(rowp + C_MG + c); unpack8(mw, pv); }
                    else {
#pragma unroll
                        for (int i = 0; i < 8; ++i) pv[i] = 0.f; }
                    const f32x4 v0 = acc[ai][bj][m][0], v1 = acc[ai][bj][m][1];
                    float o[8];
#pragma unroll
                    for (int i = 0; i < 4; ++i) { o[i] = pv[i] + sigmoidf_(g[i]) * v0[i]; o[4 + i] = pv[4 + i] + sigmoidf_(g[4 + i]) * v1[i]; }
                    *(u32x4*)(rowp + C_MG + c) = pack8(o); } }
    }
};
struct EpiWout {
    static constexpr bool PERM = true, AFTER_DRAIN = false;
    const float* x; float* out; bf16* P; float* SSQ; LAS float* xl;
    __device__ __forceinline__ void operator()(const f32x4 (&acc)[2][2][4][2], const Unit& u, int wr, int wc, int fr, int fq) const {
        const int row0 = u.pm * BM + wr * 64 + fr, col0 = u.pn * BM + wc * 32 + 8 * fq;
#pragma unroll
        for (int ai = 0; ai < 2; ++ai)
#pragma unroll
            for (int m = 0; m < 4; ++m) { const int row = row0 + ai * HALF + m * 16; float ss = 0.f;
#pragma unroll
                for (int bj = 0; bj < 2; ++bj) { const int c = col0 + bj * HALF; const size_t off = (size_t)row * DM + c;
                    const f32x4 a0 = *(const f32x4*)(x + off), a1 = *(const f32x4*)(x + off + 4);
                    const f32x4 r0 = a0 + acc[ai][bj][m][0], r1 = a1 + acc[ai][bj][m][1];
                    *(f32x4*)(out + off) = r0; *(f32x4*)(out + off + 4) = r1;
                    ss += (r0[0] * r0[0] + r0[1] * r0[1]) + (r0[2] * r0[2] + r0[3] * r0[3]) + (r1[0] * r1[0] + r1[1] * r1[1]) + (r1[2] * r1[2] + r1[3] * r1[3]);
                    u32x4 w; w.x = pk2(r0[0], r0[1]); w.y = pk2(r0[2], r0[3]); w.z = pk2(r1[0], r1[1]); w.w = pk2(r1[2], r1[3]);
                    *(u32x4*)(P + (size_t)row * PLD + C_X1B + c) = w; }
                ss += __shfl_xor(ss, 16); ss += __shfl_xor(ss, 32);
                if (fq == 0) xl[(ai * HALF + wr * 64 + m * 16 + fr) * 4 + wc] = ss; }
        asm volatile("s_waitcnt lgkmcnt(0)" ::: "memory"); __builtin_amdgcn_s_barrier(); asm volatile("" ::: "memory");
        { const int t = (wr * 4 + wc) * 64 + fq * 16 + fr;
          if (t < 256) { const f32x4 p = *(const LAS f32x4*)(xl + t * 4); SSQ[(size_t)(u.pm * BM + t) * 4 + u.pn] = (p[0] + p[1]) + (p[2] + p[3]); } }
        asm volatile("s_waitcnt lgkmcnt(0)" ::: "memory"); __builtin_amdgcn_s_barrier(); asm volatile("" ::: "memory");
    }
};
template <int CTRL> __device__ __forceinline__ float dpp_mov(float old, float src) {
    return __builtin_bit_cast(float, __builtin_amdgcn_update_dpp(__builtin_bit_cast(int, old), __builtin_bit_cast(int, src), CTRL, 0xF, 0xF, false)); }
struct EpiUp {
    static constexpr bool PERM = true, AFTER_DRAIN = false;
    const float* SSQ; const float* cw; const float* cb; bf16* P; float* UE;
    __device__ __forceinline__ void operator()(f32x4 (&acc)[2][2][4][2], const Unit& u, int wr, int wc, int fr, int fq) const {
        const int row0 = u.pm * BM + wr * 64 + fr;
        { f32x4 sq[2][4];
#pragma unroll
          for (int ai = 0; ai < 2; ++ai)
#pragma unroll
              for (int m = 0; m < 4; ++m) sq[ai][m] = *(const f32x4*)(SSQ + (size_t)(row0 + ai * HALF + m * 16) * 4);
#pragma unroll
          for (int ai = 0; ai < 2; ++ai)
#pragma unroll
              for (int m = 0; m < 4; ++m) { const float rs = __builtin_amdgcn_rsqf(((sq[ai][m][0] + sq[ai][m][1]) + (sq[ai][m][2] + sq[ai][m][3])) * (1.0f / DM) + EPS);
#pragma unroll
                  for (int bj = 0; bj < 2; ++bj)
#pragma unroll
                      for (int n = 0; n < 2; ++n) acc[ai][bj][m][n] *= rs; } }
#pragma unroll
        for (int n = 0; n < 2; ++n) {
            const int a0 = u.pn * 128 + wc * 32 + 8 * fq + 4 * n;
            const f32x4 wg0 = *(const f32x4*)(cw + a0), wg1 = *(const f32x4*)(cw + NUP + a0), wg2 = *(const f32x4*)(cw + 2 * NUP + a0), bg = *(const f32x4*)(cb + a0);
            const f32x4 wv0 = *(const f32x4*)(cw + DFF + a0), wv1 = *(const f32x4*)(cw + NUP + DFF + a0), wv2 = *(const f32x4*)(cw + 2 * NUP + DFF + a0), bv = *(const f32x4*)(cb + DFF + a0);
#pragma unroll
            for (int ai = 0; ai < 2; ++ai) {
                const int g64 = u.pm * 4 + ai * 2 + wr;
#pragma unroll
                for (int m = 0; m < 4; ++m) {
                    const f32x4 ugm = acc[ai][0][m][n], uvm = acc[ai][1][m][n], ugp = acc[ai][0][(m + 3) & 3][n], ugn = acc[ai][0][(m + 1) & 3][n], uvp = acc[ai][1][(m + 3) & 3][n], uvn = acc[ai][1][(m + 1) & 3][n];
                    f32x4 pg, ng, pvv, nv;
#pragma unroll
                    for (int i = 0; i < 4; ++i) {
                        pg[i] = dpp_mov<0x111>(dpp_mov<0x121>(0.f, ugp[i]), ugm[i]);
                        ng[i] = dpp_mov<0x101>(dpp_mov<0x12F>(0.f, ugn[i]), ugm[i]);
                        pvv[i] = dpp_mov<0x111>(dpp_mov<0x121>(0.f, uvp[i]), uvm[i]);
                        nv[i] = dpp_mov<0x101>(dpp_mov<0x12F>(0.f, uvn[i]), uvm[i]); }
                    const f32x4 gate = wg0 * pg + wg1 * ugm + wg2 * ng + bg;
                    const f32x4 val = wv0 * pvv + wv1 * uvm + wv2 * nv + bv;
                    const int row = row0 + ai * HALF + m * 16;
                    const bool edge = (m == 0 && fr == 0) || (m == 3 && fr == 15);
                    if (!edge) { u32x2 w; w.x = pk2(siluf_(gate[0]) * val[0], siluf_(gate[1]) * val[1]); w.y = pk2(siluf_(gate[2]) * val[2], siluf_(gate[3]) * val[3]);
                        *(u32x2*)(P + (size_t)row * PLD + C_ACT + a0) = w; }
                    if ((m == 0 && fr < 2) || (m == 3 && fr >= 14)) { const int slot = (m == 0) ? fr : fr - 12;
                        float* ue = UE + ((size_t)g64 * 4 + slot) * NUP;
                        *(f32x4*)(ue + a0) = ugm; *(f32x4*)(ue + DFF + a0) = uvm; }
                }
                asm volatile("" ::: "memory");
            }
        }
    }
};
struct EpiDown {
    static constexpr bool PERM = true, AFTER_DRAIN = false;
    float* out;
    __device__ __forceinline__ void operator()(const f32x4 (&acc)[2][2][4][2], const Unit& u, int wr, int wc, int fr, int fq) const {
        const int row0 = u.pm * BM + wr * 64 + fr, col0 = u.pn * BM + wc * 32 + 8 * fq;
#pragma unroll
        for (int ai = 0; ai < 2; ++ai)
#pragma unroll
            for (int m = 0; m < 4; ++m) {
#pragma unroll
                for (int bj = 0; bj < 2; ++bj) { const size_t off = (size_t)(row0 + ai * HALF + m * 16) * DM + col0 + bj * HALF;
                    const f32x4 a0 = *(const f32x4*)(out + off), a1 = *(const f32x4*)(out + off + 4);
                    *(f32x4*)(out + off) = a0 + acc[ai][bj][m][0]; *(f32x4*)(out + off + 4) = a1 + acc[ai][bj][m][1]; } }
    }
};

template <int DH, int RSK, int RSV>
__device__ __forceinline__ void attn_tile(const LAS unsigned char* Kl, const LAS unsigned char* Vl, int jk, const bf16x8 (&qf)[DH / 16], f32x16 s0, f32x16 s1,
                                          float& m, float& l, f32x16 (&o)[DH / 32], int lane) {
    const int r32 = lane & 31, hi = lane >> 5;
    const LAS unsigned char* kp = Kl + (size_t)(jk + r32) * RSK + 16 * hi;
#pragma unroll
    for (int ks = 0; ks < DH / 16; ++ks) {
        const bf16x8 k0 = *(const LAS bf16x8*)(kp + 32 * ks), k1 = *(const LAS bf16x8*)(kp + 32 * RSK + 32 * ks);
        s0 = __builtin_amdgcn_mfma_f32_32x32x16_bf16(k0, qf[ks], s0, 0, 0, 0);
        s1 = __builtin_amdgcn_mfma_f32_32x32x16_bf16(k1, qf[ks], s1, 0, 0, 0);
    }
    const int g = lane >> 4, q4 = (lane & 15) >> 2, p = lane & 3;
    const unsigned va = (unsigned)(uintptr_t)Vl + (unsigned)(jk + 4 * hi + q4) * RSV + (16 * (g & 1) + 4 * p) * 2;
    s16x4 vlo[2][4], vhi[2][4];
#define ATT_VREAD(set, db) do { _Pragma("unroll") for (int kk = 0; kk < 4; ++kk) { \
        asm volatile("ds_read_b64_tr_b16 %0, %1 offset:%c2" : "=&v"(vlo[set][kk]) : "v"(va), "i"((16 * kk) * RSV + 64 * (db)) : "memory"); \
        asm volatile("ds_read_b64_tr_b16 %0, %1 offset:%c2" : "=&v"(vhi[set][kk]) : "v"(va), "i"((16 * kk + 8) * RSV + 64 * (db)) : "memory"); } } while (0)
    ATT_VREAD(0, 0);
    float mx = fmaxf(s0[0], s1[0]);
#pragma unroll
    for (int r = 1; r < 16; ++r) mx = fmaxf(mx, fmaxf(s0[r], s1[r]));
    mx = fmaxf(mx, __shfl_xor(mx, 32));
    const float mn = fmaxf(m, mx), f = fexp2(m - mn);
    m = mn; l *= f;
#pragma unroll
    for (int db = 0; db < DH / 32; ++db)
#pragma unroll
        for (int r = 0; r < 16; ++r) o[db][r] *= f;
    float ps = 0.f;
#pragma unroll
    for (int r = 0; r < 16; ++r) { s0[r] = fexp2(s0[r] - mn); s1[r] = fexp2(s1[r] - mn); ps += s0[r] + s1[r]; }
    l += ps;
    bf16x8 pf[4];
    { u32x4 w;
      w.x = pk2(s0[0], s0[1]); w.y = pk2(s0[2], s0[3]); w.z = pk2(s0[4], s0[5]); w.w = pk2(s0[6], s0[7]); pf[0] = __builtin_bit_cast(bf16x8, w);
      w.x = pk2(s0[8], s0[9]); w.y = pk2(s0[10], s0[11]); w.z = pk2(s0[12], s0[13]); w.w = pk2(s0[14], s0[15]); pf[1] = __builtin_bit_cast(bf16x8, w);
      w.x = pk2(s1[0], s1[1]); w.y = pk2(s1[2], s1[3]); w.z = pk2(s1[4], s1[5]); w.w = pk2(s1[6], s1[7]); pf[2] = __builtin_bit_cast(bf16x8, w);
      w.x = pk2(s1[8], s1[9]); w.y = pk2(s1[10], s1[11]); w.z = pk2(s1[12], s1[13]); w.w = pk2(s1[14], s1[15]); pf[3] = __builtin_bit_cast(bf16x8, w); }
#pragma unroll
    for (int db = 0; db < DH / 32; ++db) {
        asm volatile("s_waitcnt lgkmcnt(0)" ::: "memory"); __builtin_amdgcn_sched_barrier(0);
        if (db + 1 < DH / 32) { if ((db & 1) == 0) ATT_VREAD(1, db + 1); else ATT_VREAD(0, db + 1); }
#pragma unroll
        for (int kk = 0; kk < 4; ++kk) { const s16x4 lo = vlo[db & 1][kk], h4 = vhi[db & 1][kk];
            const bf16x8 vf = (bf16x8){lo[0], lo[1], lo[2], lo[3], h4[0], h4[1], h4[2], h4[3]};
            o[db] = __builtin_amdgcn_mfma_f32_32x32x16_bf16(vf, pf[kk], o[db], 0, 0, 0); }
        __builtin_amdgcn_sched_barrier(0);
    }
#undef ATT_VREAD
}
__device__ __forceinline__ void load_bias(const float* biasrow, int hi, f32x16& s0, f32x16& s1) {
#pragma unroll
    for (int g4 = 0; g4 < 4; ++g4) { const f32x4 c0 = *(const f32x4*)(biasrow + 8 * g4 + 4 * hi), c1 = *(const f32x4*)(biasrow + 32 + 8 * g4 + 4 * hi);
#pragma unroll
        for (int i = 0; i < 4; ++i) { s0[4 * g4 + i] = c0[i]; s1[4 * g4 + i] = c1[i]; } }
}
template <int DH>
__device__ __forceinline__ void load_q(const bf16* qrow, const float* gq, float scale, bf16x8 (&qf)[DH / 16], int lane) {
    const int hi = lane >> 5;
    u32x4 w[DH / 16]; float ss = 0.f;
#pragma unroll
    for (int ks = 0; ks < DH / 16; ++ks) { w[ks] = *(const u32x4*)(qrow + 16 * ks + 8 * hi); float v[8]; unpack8(w[ks], v);
#pragma unroll
        for (int j = 0; j < 8; ++j) ss += v[j] * v[j]; }
    ss += __shfl_xor(ss, 32);
    const float rstd = __builtin_amdgcn_rsqf(ss * (1.0f / DH) + EPS) * scale;
#pragma unroll
    for (int ks = 0; ks < DH / 16; ++ks) { float v[8]; unpack8(w[ks], v);
        const f32x4 g0 = *(const f32x4*)(gq + 16 * ks + 8 * hi), g1 = *(const f32x4*)(gq + 16 * ks + 8 * hi + 4);
#pragma unroll
        for (int j = 0; j < 4; ++j) { v[j] *= rstd * g0[j]; v[4 + j] *= rstd * g1[j]; }
        qf[ks] = __builtin_bit_cast(bf16x8, pack8(v)); }
}
template <int DH>
__device__ __forceinline__ void store_o(bf16* yrow, const f32x16 (&o)[DH / 32], float l, int lane) {
    const int hi = lane >> 5;
    const float inv = frcp(l + __shfl_xor(l, 32));
#pragma unroll
    for (int db = 0; db < DH / 32; ++db)
#pragma unroll
        for (int g4 = 0; g4 < 4; ++g4) { u32x2 w; w.x = pk2(o[db][4 * g4] * inv, o[db][4 * g4 + 1] * inv); w.y = pk2(o[db][4 * g4 + 2] * inv, o[db][4 * g4 + 3] * inv);
            *(u32x2*)(yrow + 32 * db + 8 * g4 + 4 * hi) = w; }
}
template <int DH, int RSK, int RSV>
__device__ __forceinline__ void stage_kv(LAS unsigned char* Kl, LAS unsigned char* Vl, int ldsrow0, const bf16* src, size_t pitch, int kcol, int vcol, int nrows, const float* gk, int tid) {
    constexpr int CPR = DH / 8;
    for (int c = tid; c < nrows * CPR; c += 512) {
        const int row = c / CPR, ch = c % CPR;
        const bf16* rp = src + (size_t)row * pitch;
        const u32x4 kw = *(const u32x4*)(rp + kcol + ch * 8), vw = *(const u32x4*)(rp + vcol + ch * 8);
        float v[8]; unpack8(kw, v); float ss = 0.f;
#pragma unroll
        for (int j = 0; j < 8; ++j) ss += v[j] * v[j];
#pragma unroll
        for (int o = 1; o < CPR; o <<= 1) ss += __shfl_xor(ss, o);
        const float rstd = __builtin_amdgcn_rsqf(ss * (1.0f / DH) + EPS);
        const f32x4 g0 = *(const f32x4*)(gk + ch * 8), g1 = *(const f32x4*)(gk + ch * 8 + 4);
#pragma unroll
        for (int j = 0; j < 4; ++j) { v[j] *= rstd * g0[j]; v[4 + j] *= rstd * g1[j]; }
        *(LAS u32x4*)(Kl + (size_t)(ldsrow0 + row) * RSK + ch * 16) = pack8(v);
        *(LAS u32x4*)(Vl + (size_t)(ldsrow0 + row) * RSV + ch * 16) = vw;
    }
}

constexpr int NWAVES = 8;
constexpr size_t MiB = 1u << 20;
constexpr size_t WS_CTL = 0, CTL_ZERO_BYTES = 1 * MiB;
constexpr size_t WS_WIN = 2 * MiB;
constexpr size_t WS_WBR = 15 * MiB;
constexpr size_t WS_WOUT = 18 * MiB;
constexpr size_t WS_WUP = 20 * MiB;
constexpr size_t WS_WDN = 31 * MiB;
constexpr size_t WS_WKV = 37 * MiB;
constexpr size_t WS_MEMN = 39 * MiB;
constexpr size_t WS_KV = 41 * MiB;
constexpr size_t WS_BT = 43 * MiB;
constexpr size_t WS_BA = 45 * MiB;
constexpr size_t WS_SSQ = 49 * MiB;
constexpr size_t WS_P = 52 * MiB;
constexpr size_t WS_UE = 452 * MiB;
constexpr size_t WS_END = 512 * MiB;
static_assert(WS_P + (size_t)M * PLD * 2 == WS_UE && WS_UE + (size_t)512 * 4 * NUP * 4 <= WS_END, "d_ws map");

constexpr int CW_TMO = 0, CW_CODE = 1;
constexpr int CW_BAR = 4096;
constexpr int RING_OFF = 0, RING_BYTES = 147456;
constexpr int LDSCTL_OFF = RING_BYTES, MISC_OFF = LDSCTL_OFF + 320;
constexpr int XCH_OFF = MISC_OFF + 256;
constexpr int LDS_BYTES = 163840;
static_assert(XCH_OFF + 4096 <= LDS_BYTES && XCH_OFF % 16 == 0, "LDS map");

typedef GAS unsigned gu32;
#define RLX_AGENT __ATOMIC_RELAXED, __HIP_MEMORY_SCOPE_AGENT
#define LDS_WAIT() asm volatile("s_waitcnt lgkmcnt(0)" ::: "memory")
#define VM_WAIT() asm volatile("s_waitcnt vmcnt(0)" ::: "memory")

#define XB_TMO      128
#define XB_XCNT(j)  (256  + 64 * (j))
#define XB_XSUB(j)  (1280 + 64 * (j))
#define XB_XGEN(j)  (2304 + 64 * (j))
#define XB_TOP      3328
#define XB_TOPGEN   3392
#define XCD_BAR_WORDS 3456
#define XB_SPIN_CAP (1u << 22)

__device__ __forceinline__ unsigned xb_ld(unsigned* p)              { return __hip_atomic_load(p, __ATOMIC_RELAXED, __HIP_MEMORY_SCOPE_AGENT); }
__device__ __forceinline__ unsigned xb_add(unsigned* p, unsigned v) { return __hip_atomic_fetch_add(p, v, __ATOMIC_RELAXED, __HIP_MEMORY_SCOPE_AGENT); }
__device__ __forceinline__ unsigned xb_xcc_id() { return (unsigned)__builtin_amdgcn_s_getreg((3 << 11) | 20) & 0xFu; }
#define XB_SPIN(cond, bar) do { unsigned _sp = 0; while (cond) { __builtin_amdgcn_s_sleep(1); \
    if ((++_sp & 255u) == 0u) { if (xb_ld(&(bar)[XB_TMO])) break; if (_sp > XB_SPIN_CAP) { atomicAdd(&(bar)[XB_TMO], 1u); break; } } } } while (0)

struct XcdBarrier { unsigned* bar; unsigned x; volatile LAS unsigned* st; };

__device__ __forceinline__ XcdBarrier xcd_barrier_post(unsigned* bar, volatile LAS unsigned* st) {
    XcdBarrier b; b.bar = bar; b.x = xb_xcc_id(); b.st = st;
    if (threadIdx.x == 0) (void)xb_add(&bar[XB_XCNT(b.x)], 1u);
    return b;
}
__device__ __forceinline__ void xcd_barrier_complete(unsigned* bar, unsigned x, unsigned& nloc, unsigned& nx) {
    const unsigned G = gridDim.x * gridDim.y * gridDim.z;
    unsigned sum, cnt, mine, sp = 0u;
    for (;;) {
        sum = 0u; cnt = 0u; mine = 0u;
#pragma unroll
        for (unsigned j = 0; j < 16; ++j) { const unsigned c = xb_ld(&bar[XB_XCNT(j)]); sum += c; cnt += (c > 0u) ? 1u : 0u; mine = (j == x) ? c : mine; }
        if (sum == G) break;
        __builtin_amdgcn_s_sleep(1);
        if ((++sp & 255u) == 0u) { if (xb_ld(&bar[XB_TMO])) break; if (sp > XB_SPIN_CAP) { atomicAdd(&bar[XB_TMO], 1u); break; } }
    }
    nloc = mine > 0u ? mine : 1u; nx = cnt > 0u ? cnt : 1u;
}
__device__ __forceinline__ void xcd_barrier(const XcdBarrier& b) {
    asm volatile("s_waitcnt vmcnt(0)" ::: "memory");
    __syncthreads();
    if (threadIdx.x == 0) {
        unsigned* bar = b.bar;
        __builtin_amdgcn_s_waitcnt(0);
        unsigned nloc = b.st[0], nx = b.st[1];
        if (nloc == 0u) { xcd_barrier_complete(bar, b.x, nloc, nx); b.st[0] = nloc; b.st[1] = nx; }
        const unsigned old = xb_add(&bar[XB_XSUB(b.x)], 1u);
        const unsigned gen = old / nloc;
        if (old + 1u == (gen + 1u) * nloc) {
            __builtin_amdgcn_fence(__ATOMIC_RELEASE, "agent");
            asm volatile("s_waitcnt vmcnt(0)" ::: "memory");
            const unsigned og = xb_add(&bar[XB_TOP], 1u);
            const unsigned tg = og / nx;
            if (og + 1u == (tg + 1u) * nx) xb_add(&bar[XB_TOPGEN], 1u);
            else XB_SPIN(xb_ld(&bar[XB_TOPGEN]) == tg, bar);
            __builtin_amdgcn_fence(__ATOMIC_ACQUIRE, "agent");
            xb_add(&bar[XB_XGEN(b.x)], 1u);
            asm volatile("s_waitcnt vmcnt(0)" ::: "memory");
        } else {
            XB_SPIN(xb_ld(&bar[XB_XGEN(b.x)]) == gen, bar);
            __builtin_amdgcn_fence(__ATOMIC_ACQUIRE, "agent");
            asm volatile("s_waitcnt vmcnt(0)" ::: "memory");
        }
    }
    __syncthreads();
}

struct Frame {
    LAS unsigned char* lds;
    volatile LAS unsigned* MISC;
    gu32* ctl;
    int tid, lane, wave, vcu, G;
};

__device__ __forceinline__ float wave_sum(float v) {
#pragma unroll
    for (int o = 1; o < 64; o <<= 1) v += __shfl_xor(v, o);
    return v;
}
__device__ __forceinline__ int t5_bucket(int rel) {
    const int n = rel < 0 ? -rel : rel;
    const int mag = n < 8 ? n : n < 12 ? 8 : n < 16 ? 9 : n < 23 ? 10 : n < 32 ? 11 : n < 46 ? 12 : n < 64 ? 13 : n < 91 ? 14 : 15;
    return (rel > 0 ? 16 : 0) + mag;
}

__device__ __forceinline__ void transpose_item(const float* W, int K, int N, int k0, int n0, bf16* WT, int drow0, const float* gk, LAS float* scr, int lane) {
    { f32x4 v[8];
#pragma unroll
      for (int i = 0; i < 8; ++i) v[i] = *(const f32x4*)(W + (size_t)(k0 + 8 * i + (lane >> 3)) * N + n0 + 4 * (lane & 7));
#pragma unroll
      for (int i = 0; i < 8; ++i) { const int kk = 8 * i + (lane >> 3); const float gs = gk ? gk[k0 + kk] : 1.0f; LAS float* d = scr + kk * 33 + 4 * (lane & 7);
          d[0] = v[i][0] * gs; d[1] = v[i][1] * gs; d[2] = v[i][2] * gs; d[3] = v[i][3] * gs; } }
    LDS_WAIT(); asm volatile("" ::: "memory");
    const int c = lane & 7;
#pragma unroll
    for (int j = 0; j < 4; ++j) { const int n = (lane >> 3) + 8 * j; const LAS float* s = scr + (8 * c) * 33 + n;
        u32x4 o; o.x = pk2(s[0 * 33], s[1 * 33]); o.y = pk2(s[2 * 33], s[3 * 33]); o.z = pk2(s[4 * 33], s[5 * 33]); o.w = pk2(s[6 * 33], s[7 * 33]);
        *(GAS u32x4*)(WT + (size_t)(drow0 + n) * K + k0 + 8 * c) = o; }
    LDS_WAIT(); asm volatile("" ::: "memory");
}
__device__ __forceinline__ void rms_row_to_bf16(const float* xrow, const float* g, bf16* orow, int lane) {
    const GAS f32x4* xr = (const GAS f32x4*)xrow + lane;
    const GAS f32x4* gr = (const GAS f32x4*)g + lane;
    f32x4 v[4]; float s = 0.f;
#pragma unroll
    for (int j = 0; j < 4; ++j) { v[j] = xr[64 * j]; s += (v[j].x * v[j].x + v[j].y * v[j].y) + (v[j].z * v[j].z + v[j].w * v[j].w); }
    const float rstd = __builtin_amdgcn_rsqf(wave_sum(s) * (1.f / DM) + EPS);
    GAS unsigned long long* o8 = (GAS unsigned long long*)orow + lane;
#pragma unroll
    for (int j = 0; j < 4; ++j) { const f32x4 gg = gr[64 * j];
        o8[64 * j] = (unsigned long long)pk2(v[j].x * rstd * gg.x, v[j].y * rstd * gg.y) | ((unsigned long long)pk2(v[j].z * rstd * gg.z, v[j].w * rstd * gg.w) << 32); }
}

__device__ __forceinline__ void rms_row2_to_bf16(const float* xa, const float* xb, const float* g, bf16* oa, bf16* ob, int lane) {
    const GAS f32x4* xr0 = (const GAS f32x4*)xa + lane; const GAS f32x4* xr1 = (const GAS f32x4*)xb + lane;
    const GAS f32x4* gr = (const GAS f32x4*)g + lane;
    f32x4 v0[4], v1[4]; float s0 = 0.f, s1 = 0.f;
#pragma unroll
    for (int j = 0; j < 4; ++j) { v0[j] = xr0[64 * j]; v1[j] = xr1[64 * j]; }
#pragma unroll
    for (int j = 0; j < 4; ++j) { s0 += (v0[j].x * v0[j].x + v0[j].y * v0[j].y) + (v0[j].z * v0[j].z + v0[j].w * v0[j].w); s1 += (v1[j].x * v1[j].x + v1[j].y * v1[j].y) + (v1[j].z * v1[j].z + v1[j].w * v1[j].w); }
#pragma unroll
    for (int o = 1; o < 64; o <<= 1) { s0 += __shfl_xor(s0, o); s1 += __shfl_xor(s1, o); }
    const float r0 = __builtin_amdgcn_rsqf(s0 * (1.f / DM) + EPS), r1 = __builtin_amdgcn_rsqf(s1 * (1.f / DM) + EPS);
    GAS unsigned long long* o0 = (GAS unsigned long long*)oa + lane; GAS unsigned long long* o1 = (GAS unsigned long long*)ob + lane;
#pragma unroll
    for (int j = 0; j < 4; ++j) { const f32x4 gg = gr[64 * j];
        o0[64 * j] = (unsigned long long)pk2(v0[j].x * r0 * gg.x, v0[j].y * r0 * gg.y) | ((unsigned long long)pk2(v0[j].z * r0 * gg.z, v0[j].w * r0 * gg.w) << 32);
        o1[64 * j] = (unsigned long long)pk2(v1[j].x * r1 * gg.x, v1[j].y * r1 * gg.y) | ((unsigned long long)pk2(v1[j].z * r1 * gg.z, v1[j].w * r1 * gg.w) << 32); }
}

struct Args { const float* in[25]; float* out; unsigned char* ws; int ph_lo, ph_hi, mode, pad; };

__device__ __forceinline__ void p0_prologue(Frame& F, const Args& a) {
    unsigned char* ws = a.ws;
    LAS float* scr = (LAS float*)(F.lds + RING_OFF + F.wave * 16384);
    const int gw = F.vcu * NWAVES + F.wave, NGW = F.G * NWAVES;
    constexpr int I_IN = 16 * 201, I_BR = 8 * 32, I_OUT = 16 * 32, I_UP = 16 * 176, I_DN = 44 * 32, I_KV = 16 * 32;
    constexpr int NITEMS = I_IN + 3 * I_BR + I_OUT + I_UP + I_DN + I_KV;
    for (int it = gw; it < NITEMS; it += NGW) {
        int r = it;
        if (r < I_IN) { const int kb = r / 201, nb = r % 201, n0 = nb * 32;
            const int d0 = n0 < 2816 ? n0 : (n0 < 2848 ? 3328 + (n0 - 2816) : (n0 < 3360 ? n0 - 32 : 3584 + (n0 - 3360)));
            transpose_item(a.in[4], 1024, 6432, kb * 64, n0, (bf16*)(ws + WS_WIN), d0, nullptr, scr, F.lane); continue; }
        r -= I_IN;
        if (r < 3 * I_BR) { const int br = r / I_BR, q = r % I_BR, kb = q / 32, nb = q % 32;
            transpose_item(a.in[16 + br], 512, 1024, kb * 64, nb * 32, (bf16*)(ws + WS_WBR) + (size_t)br * 1024 * 512, nb * 32, nullptr, scr, F.lane); continue; }
        r -= 3 * I_BR;
        if (r < I_OUT) { const int kb = r / 32, nb = r % 32;
            transpose_item(a.in[19], 1024, 1024, kb * 64, nb * 32, (bf16*)(ws + WS_WOUT), nb * 32, nullptr, scr, F.lane); continue; }
        r -= I_OUT;
        if (r < I_UP) { const int kb = r / 176, nb = r % 176, n0 = nb * 32;
            const int isv = n0 >= DFF, nn = isv ? n0 - DFF : n0, d0 = (nn >> 7) * 256 + isv * 128 + (nn & 127);
            transpose_item(a.in[21], 1024, NUP, kb * 64, n0, (bf16*)(ws + WS_WUP), d0, a.in[20], scr, F.lane); continue; }
        r -= I_UP;
        if (r < I_DN) { const int kb = r / 32, nb = r % 32;
            transpose_item(a.in[24], DFF, 1024, kb * 64, nb * 32, (bf16*)(ws + WS_WDN), nb * 32, nullptr, scr, F.lane); continue; }
        r -= I_DN;
        { const int kb = r / 32, nb = r % 32;
            transpose_item(a.in[13], 1024, 1024, kb * 64, nb * 32, (bf16*)(ws + WS_WKV), nb * 32, nullptr, scr, F.lane); }
    }
    { u32x4* z = (u32x4*)((bf16*)(ws + WS_WIN) + (size_t)3360 * 1024); const int n16 = 224 * 1024 * 2 / 16;
      for (int i = blockIdx.x * 512 + F.tid; i < n16; i += F.G * 512) z[i] = (u32x4){0u, 0u, 0u, 0u}; }
    bf16* H = (bf16*)a.out;
    if (M % (2 * NGW) != 0) { for (int m = gw; m < M; m += NGW) rms_row_to_bf16(a.in[0] + (size_t)m * DM, a.in[3], H + (size_t)m * DM, F.lane); }
    else for (int m = gw; m < M; m += 2 * NGW) rms_row2_to_bf16(a.in[0] + (size_t)m * DM, a.in[0] + (size_t)(m + NGW) * DM, a.in[3], H + (size_t)m * DM, H + (size_t)(m + NGW) * DM, F.lane);
    for (int m = gw; m < BATCH * NMEM; m += NGW) rms_row_to_bf16(a.in[1] + (size_t)m * DM, a.in[12], (bf16*)(ws + WS_MEMN) + (size_t)m * DM, F.lane);
    { float* BT = (float*)(ws + WS_BT); const float* tab = a.in[2];
      for (int i = blockIdx.x * 512 + F.tid; i < 8 * 128 * 384; i += F.G * 512) { const int j = i % 384, t = (i / 384) % 128, h = i / (384 * 128);
          const int rel = j - 128 - t; const bool ok = rel >= -128 && rel <= 128;
          BT[i] = ok ? tab[t5_bucket(rel) * 8 + h] * LOG2E : -INFINITY; } }
}

__device__ __forceinline__ void attnA_unit(Frame& F, const Args& a, int b, int n, int kvh) {
    constexpr int RSK = 144, RSV = 128;
    LAS unsigned char* Kl = F.lds; LAS unsigned char* Vl = F.lds + 384 * RSK;
    bf16* P = (bf16*)(a.ws + WS_P);
    const float* BT = (const float*)(a.ws + WS_BT);
    for (int blk = 0; blk < 3; ++blk) { const int pos0 = n * 128 - 128 + blk * 128; if (pos0 < 0 || pos0 >= SEQ) continue;
        stage_kv<64, RSK, RSV>(Kl, Vl, blk * 128, P + (size_t)(b * SEQ + pos0) * PLD, PLD, C_AK + kvh * 64, C_AV + kvh * 64, 128, a.in[6], F.tid); }
    LDS_WAIT(); __syncthreads();
    const int h = kvh * 4 + (F.wave >> 1), r32 = F.lane & 31, hi = F.lane >> 5;
    const float sink = a.in[7][h] * LOG2E;
#pragma unroll 1
    for (int qb = 0; qb < 2; ++qb) {
        const int t0 = (F.wave & 1) * 64 + qb * 32, t = t0 + r32;
        bf16* qrow = P + (size_t)(b * SEQ + n * 128 + t) * PLD + C_AQ + h * 64;
        bf16x8 qf[4]; load_q<64>(qrow, a.in[5], 0.125f * LOG2E, qf, F.lane);
        float m = sink, l = hi == 0 ? 1.f : 0.f; f32x16 o[2];
#pragma unroll
        for (int r = 0; r < 16; ++r) { o[0][r] = 0.f; o[1][r] = 0.f; }
        const int lo = max(t0 >= 64 ? 1 : 0, n == 0 ? 2 : 0), hi_t = min(t0 >= 64 ? 5 : 4, n == SEQ / 128 - 1 ? 3 : 5);
        const float* brow = BT + ((size_t)h * 128 + t) * 384;
        f32x16 b0, b1; load_bias(brow + 64 * lo, hi, b0, b1);
#pragma unroll 1
        for (int kt = lo; kt <= hi_t; ++kt) {
            f32x16 nb0 = b0, nb1 = b1;
            if (kt < hi_t) load_bias(brow + 64 * (kt + 1), hi, nb0, nb1);
            attn_tile<64, RSK, RSV>(Kl, Vl, 64 * kt, qf, b0, b1, m, l, o, F.lane);
            b0 = nb0; b1 = nb1; }
        store_o<64>(qrow, o, l, F.lane);
    }
    LDS_WAIT(); __syncthreads();
}
__device__ __forceinline__ void xattn_unit(Frame& F, const Args& a, int b, int tb, int h) {
    constexpr int RSK = 272, RSV = 320;
    LAS unsigned char* Kl = F.lds; LAS unsigned char* Vl = F.lds + 128 * RSK;
    bf16* P = (bf16*)(a.ws + WS_P);
    const bf16* KV = (const bf16*)(a.ws + WS_KV);
    const int r32 = F.lane & 31;
    bf16* qrow = P + (size_t)(b * SEQ + tb * 256 + F.wave * 32 + r32) * PLD + C_MQ + h * 128;
    bf16x8 qf[8]; load_q<128>(qrow, a.in[14], 0.08838834764831845f * LOG2E, qf, F.lane);
    float m = -1e30f, l = 0.f; f32x16 o[4];
#pragma unroll
    for (int db = 0; db < 4; ++db)
#pragma unroll
        for (int r = 0; r < 16; ++r) o[db][r] = 0.f;
#pragma unroll 1
    for (int half = 0; half < 2; ++half) {
        stage_kv<128, RSK, RSV>(Kl, Vl, 0, KV + (size_t)(b * NMEM + half * 128) * 1024, 1024, h * 128, 512 + h * 128, 128, a.in[15], F.tid);
        LDS_WAIT(); __syncthreads();
#pragma unroll 1
        for (int kt = 0; kt < 2; ++kt) { f32x16 z0, z1;
#pragma unroll
            for (int r = 0; r < 16; ++r) { z0[r] = 0.f; z1[r] = 0.f; }
            attn_tile<128, RSK, RSV>(Kl, Vl, 64 * kt, qf, z0, z1, m, l, o, F.lane); }
        LDS_WAIT(); __syncthreads();
    }
    store_o<128>(qrow, o, l, F.lane);
}


constexpr int SAF = C_GATE, SCF = C_GATE + 512, SBF = C_GATE + 1024, SDF = C_GATE + 1536, SAB = C_GATE + 2048, SCB = C_GATE + 2560;
constexpr int C_OF = C_DQ, C_OB = C_DK;
__device__ __forceinline__ int dn_pcol(int x) { return (x & 32) + 8 * ((x & 15) >> 2) + 4 * ((x >> 4) & 1) + (x & 3); }
__device__ __forceinline__ bf16x8 frag_lo(const LAS unsigned char* p) { const u32x2 a0 = *(const LAS u32x2*)p; u32x4 w; w.x = a0.x; w.y = a0.y; w.z = 0u; w.w = 0u; return __builtin_bit_cast(bf16x8, w); }
__device__ __forceinline__ bf16x8 frag_2(const LAS unsigned char* p) { const u32x2 a0 = *(const LAS u32x2*)p, a1 = *(const LAS u32x2*)(p + 32); u32x4 w; w.x = a0.x; w.y = a0.y; w.z = a1.x; w.w = a1.y; return __builtin_bit_cast(bf16x8, w); }
__device__ __forceinline__ bf16x8 pack_f4z(const f32x4 a) { u32x4 w; w.x = pk2(a[0], a[1]); w.y = pk2(a[2], a[3]); w.z = 0u; w.w = 0u; return __builtin_bit_cast(bf16x8, w); }
__device__ __forceinline__ bf16x8 pack_f4f4(const f32x4 a, const f32x4 b) { u32x4 w; w.x = pk2(a[0], a[1]); w.y = pk2(a[2], a[3]); w.z = pk2(b[0], b[1]); w.w = pk2(b[2], b[3]); return __builtin_bit_cast(bf16x8, w); }
__device__ __forceinline__ void dn_prep_block(Frame& F, const Args& a, int b, int h, int c0, int nch) {
    LAS float* raw = (LAS float*)(F.lds);
    LAS unsigned char* NL = F.lds;
    LAS unsigned char* TD = F.lds + 18432;
    LAS unsigned char* Qb = F.lds + 53248;
    LAS unsigned char* Kb = F.lds + 62464;
    LAS unsigned char* Vb = F.lds + 71680;
    LAS float* sm = (LAS float*)(F.lds + 80896);
    LAS float* gt = sm;
    LAS float* btk = sm + 128;
    LAS float* gct = sm + 256;
    LAS float* cu = sm + 384;
    LAS float* cwp = sm + 512;
    LAS float* egp = sm + 640;
    LAS float* esp = sm + 768;
    LAS unsigned char* QKL = F.lds + 24576;
    LAS unsigned char* KT = F.lds + 84480;
    LAS unsigned char* QT = F.lds + 104960;
    bf16* P = (bf16*)(a.ws + WS_P);
    float* BA = (float*)(a.ws + WS_BA);
    bf16* XB2 = (bf16*)a.out + (size_t)M * 1024;
    const float* cw = a.in[8];
    const int w = F.wave, lane = F.lane, tid = F.tid;
    float wt[3][5];
#pragma unroll
    for (int which = 0; which < 3; ++which)
#pragma unroll
        for (int j = 0; j < 5; ++j) wt[which][j] = cw[j * 1536 + which * 512 + h * 64 + lane];
    const float Ah = expf(a.in[9][(tid >> 6 & 1) * 8 + h]), dtb = a.in[10][(tid >> 6 & 1) * 8 + h];
    u32x4 rr[4]; float pa = 0.f, pb = 0.f;
#define DN_PREFETCH(cidx) do { const int t0p_ = (cidx) * 64; \
        _Pragma("unroll") for (int i_ = 0; i_ < 4; ++i_) { const int e = tid + 512 * i_, row = e / 24, c8 = e % 24, which = c8 >> 3, t = t0p_ - 2 + row; \
            rr[i_] = (u32x4){0u, 0u, 0u, 0u}; \
            if (e < 68 * 24 && t >= 0 && t < SEQ) rr[i_] = *(const u32x4*)(P + ((size_t)b * SEQ + t) * PLD + (which == 0 ? C_DQ : which == 1 ? C_DK : C_DV) + h * 64 + (c8 & 7) * 8); } \
        if (tid < 128) { const size_t tok = (size_t)b * SEQ + t0p_ + (tid & 63); pa = BA[tok * 32 + 16 + (tid >> 6) * 8 + h]; pb = BA[tok * 32 + (tid >> 6) * 8 + h]; } } while (0)
    DN_PREFETCH(c0);
#pragma unroll 1
  for (int ci = 0; ci < nch; ++ci) {
    int tid_o = F.tid; asm volatile("" : "+v"(tid_o));
    const int tid = tid_o, lane = tid & 63;
    const int c = c0 + ci, t0 = c * 64;
    const size_t tok0 = (size_t)b * SEQ + t0;
#pragma unroll
    for (int i_ = 0; i_ < 4; ++i_) { const int e = tid + 512 * i_, row = e / 24, c8 = e % 24;
        if (e < 68 * 24) { float v[8]; unpack8(rr[i_], v);
            *(LAS f32x4*)(raw + row * 192 + c8 * 8) = (f32x4){v[0], v[1], v[2], v[3]}; *(LAS f32x4*)(raw + row * 192 + c8 * 8 + 4) = (f32x4){v[4], v[5], v[6], v[7]}; } }
    if (tid < 128) { const int d = tid >> 6, i = tid & 63; const float xa = pa + dtb;
        gt[d * 64 + i] = -Ah * (fmaxf(xa, 0.f) + __logf(1.0f + __expf(-fabsf(xa))));
        btk[d * 64 + i] = sigmoidf_(pb); }
    if (ci + 1 < nch) DN_PREFETCH(c + 1);
    LDS_WAIT(); __syncthreads();
#pragma unroll
    for (int which = 0; which < 3; ++which) {
        float x[12], y[8];
#pragma unroll
        for (int j = 0; j < 12; ++j) x[j] = raw[(w * 8 + j) * 192 + which * 64 + lane];
#pragma unroll
        for (int r = 0; r < 8; ++r) { float acc = 0.f;
#pragma unroll
            for (int j = 0; j < 5; ++j) acc += x[r + j] * wt[which][j];
            y[r] = siluf_(acc); }
        if (which < 2) {
            float ss[8];
#pragma unroll
            for (int r = 0; r < 8; ++r) ss[r] = y[r] * y[r];
#pragma unroll
            for (int o = 1; o < 64; o <<= 1)
#pragma unroll
                for (int r = 0; r < 8; ++r) ss[r] += __shfl_xor(ss[r], o);
#pragma unroll
            for (int r = 0; r < 8; ++r) y[r] *= __builtin_amdgcn_rsqf(ss[r] + EPS) * (which == 0 ? 0.125f : 1.0f);
        }
        LAS unsigned char* X = which == 0 ? Qb : which == 1 ? Kb : Vb;
#pragma unroll
        for (int r = 0; r < 8; ++r) *(LAS bf16*)(X + (w * 8 + r) * 144 + lane * 2) = (bf16)(pk2(y[r], 0.f) & 0xffffu);
        asm volatile("" ::: "memory");
    }
    if (w < 2) { const int i = w ? 63 - lane : lane; float gv = gt[w * 64 + i];
#pragma unroll
        for (int o = 1; o < 64; o <<= 1) { const float t = __shfl_up(gv, o); if (lane >= o) gv += t; }
        const float glast = __shfl(gv, 63), bt = btk[w * 64 + i], eg = __expf(gv);
        const float es = __expf(glast - gv);
        gct[w * 64 + i] = gv; cu[w * 64 + lane] = bt; cwp[w * 64 + lane] = bt * eg; egp[w * 64 + lane] = eg; esp[w * 64 + lane] = es;
        BA[(tok0 + lane) * 32 + w * 8 + h] = eg; }
    LDS_WAIT(); __syncthreads();
    { const int p = tid >> 3, c8 = tid & 7;
#pragma unroll
      for (int d = 0; d < 2; ++d) { const int i = d ? 63 - p : p; const float es = esp[d * 64 + p], eg = egp[d * 64 + p]; float v[8];
          unpack8(*(const LAS u32x4*)(Kb + i * 144 + c8 * 16), v);
#pragma unroll
          for (int j = 0; j < 8; ++j) v[j] *= es;
          *(LAS u32x4*)(KT + d * 10240 + p * 160 + c8 * 16) = pack8(v);
          unpack8(*(const LAS u32x4*)(Qb + i * 144 + c8 * 16), v);
#pragma unroll
          for (int j = 0; j < 8; ++j) v[j] *= eg;
          *(LAS u32x4*)(QT + d * 9216 + p * 144 + c8 * 16) = pack8(v); } }
    { const int wq = w & 3, tm = wq >> 1, tn = wq & 1, r32 = lane & 31, hi = lane >> 5;
      const LAS unsigned char* X = (w < 4) ? Kb : Qb;
      f32x16 acc;
#pragma unroll
      for (int r = 0; r < 16; ++r) acc[r] = 0.f;
#pragma unroll
      for (int kst = 0; kst < 4; ++kst) {
          const bf16x8 af = *(const LAS bf16x8*)(X + (32 * tm + r32) * 144 + (16 * kst + 8 * hi) * 2), bfr = *(const LAS bf16x8*)(Kb + (32 * tn + r32) * 144 + (16 * kst + 8 * hi) * 2);
          acc = __builtin_amdgcn_mfma_f32_32x32x16_bf16(af, bfr, acc, 0, 0, 0); }
      const int j = 32 * tn + r32; const float gjf = gct[j], gjb = gct[64 + j];
#pragma unroll
      for (int g4 = 0; g4 < 4; ++g4) { const int i0 = 32 * tm + 8 * g4 + 4 * hi;
          const f32x4 gif = *(const LAS f32x4*)(gct + i0), gib = *(const LAS f32x4*)(gct + 64 + i0), bif = *(const LAS f32x4*)(btk + i0), bib = *(const LAS f32x4*)(btk + 64 + i0);
#pragma unroll
          for (int q = 0; q < 4; ++q) { const int i = i0 + q; const float v = acc[4 * g4 + q];
              const float ef = __expf(fminf(gif[q] - gjf, 0.f)), eb = __expf(fminf(gib[q] - gjb, 0.f));
              if (w < 4) {
                  const float lf = (j < i) ? -bif[q] * v * ef : 0.f, lb = (j > i) ? -bib[q] * v * eb : 0.f;
                  *(LAS bf16*)(NL + i * 144 + j * 2) = (bf16)(pk2(lf, 0.f) & 0xffffu);
                  *(LAS bf16*)(NL + 9216 + (63 - i) * 144 + (63 - j) * 2) = (bf16)(pk2(lb, 0.f) & 0xffffu);
              } else {
                  const float qf = (j <= i) ? v * ef : 0.f, qb = (j >= i) ? v * eb : 0.f;
                  *(LAS bf16*)(QKL + i * 144 + j * 2) = (bf16)(pk2(qf, 0.f) & 0xffffu);
                  *(LAS bf16*)(QKL + 9216 + (63 - i) * 144 + (63 - j) * 2) = (bf16)(pk2(qb, 0.f) & 0xffffu);
              } } } }
    LDS_WAIT(); __syncthreads();
    if (w < 2) { const int blk = lane >> 4, col = lane & 15; const LAS unsigned char* nl = NL + w * 9216 + (16 * blk) * 144 + (16 * blk) * 2;
        u32x4 lr[16][2];
#pragma unroll
        for (int r = 1; r < 16; ++r) { lr[r][0] = *(const LAS u32x4*)(nl + r * 144); if (r > 8) lr[r][1] = *(const LAS u32x4*)(nl + r * 144 + 16); }
        float t[16];
#pragma unroll
        for (int r = 0; r < 16; ++r) { float a0 = (r == col) ? 1.f : 0.f, a1 = 0.f;
            if (r > 0) { float l[16]; { float l8[8]; unpack8(lr[r][0], l8);
#pragma unroll
                    for (int q = 0; q < 8; ++q) l[q] = l8[q]; }
                if (r > 8) { float l8[8]; unpack8(lr[r][1], l8);
#pragma unroll
                    for (int q = 0; q < 8; ++q) l[8 + q] = l8[q]; }
#pragma unroll
                for (int q = 0; q < r; ++q) { if (q & 1) a1 += l[q] * t[q]; else a0 += l[q] * t[q]; } }
            t[r] = a0 + a1; }
#pragma unroll
        for (int r = 0; r < 16; ++r) *(LAS bf16*)(TD + w * 3072 + blk * 768 + r * 48 + col * 2) = (bf16)(pk2(t[r], 0.f) & 0xffffu);
    }
    LDS_WAIT(); __syncthreads();
    { const int d = w >> 2, cc = lane & 15, g = lane >> 4;
      const LAS unsigned char* nl = NL + d * 9216; const LAS unsigned char* td = TD + d * 3072 + cc * 48 + 8 * g;
#pragma unroll
      for (int jj = 0; jj < 2; ++jj) { const int ct = 2 * (w & 3) + jj, part = ct >> 2, colb = 16 * (ct & 3);
          const LAS unsigned char* src = part ? Kb : Vb; const LAS float* coef = (part ? cwp : cu) + d * 64;
          f32x4 R[4];
#pragma unroll
          for (int bq = 0; bq < 4; ++bq) { const f32x4 cf = *(const LAS f32x4*)(coef + 16 * bq + 4 * g);
#pragma unroll
              for (int r = 0; r < 4; ++r) { const int p = 16 * bq + 4 * g + r, i = d ? 63 - p : p;
                  R[bq][r] = cf[r] * __uint_as_float((unsigned)(*(const LAS bf16*)(src + i * 144 + (colb + cc) * 2)) << 16); } }
          const f32x4 z4 = (f32x4){0.f, 0.f, 0.f, 0.f};
          f32x4 X0, X1, X2, X3, Y;
          const bf16x8 t0f = frag_lo(td), t1f = frag_lo(td + 768), t2f = frag_lo(td + 2 * 768), t3f = frag_lo(td + 3 * 768);
          const bf16x8 n1f = frag_lo(nl + (16 + cc) * 144 + 8 * g), n2f = frag_2(nl + (32 + cc) * 144 + 8 * g), n3f = frag_2(nl + (48 + cc) * 144 + 8 * g), n3g = frag_lo(nl + (48 + cc) * 144 + 64 + 8 * g);
          __builtin_amdgcn_sched_barrier(0);
          X0 = __builtin_amdgcn_mfma_f32_16x16x32_bf16(t0f, pack_f4z(R[0]), z4, 0, 0, 0);
          Y = __builtin_amdgcn_mfma_f32_16x16x32_bf16(n1f, pack_f4z(X0), R[1], 0, 0, 0);
          X1 = __builtin_amdgcn_mfma_f32_16x16x32_bf16(t1f, pack_f4z(Y), z4, 0, 0, 0);
          const bf16x8 x01 = pack_f4f4(X0, X1);
          Y = __builtin_amdgcn_mfma_f32_16x16x32_bf16(n2f, x01, R[2], 0, 0, 0);
          X2 = __builtin_amdgcn_mfma_f32_16x16x32_bf16(t2f, pack_f4z(Y), z4, 0, 0, 0);
          Y = __builtin_amdgcn_mfma_f32_16x16x32_bf16(n3f, x01, R[3], 0, 0, 0);
          Y = __builtin_amdgcn_mfma_f32_16x16x32_bf16(n3g, pack_f4z(X2), Y, 0, 0, 0);
          X3 = __builtin_amdgcn_mfma_f32_16x16x32_bf16(t3f, pack_f4z(Y), z4, 0, 0, 0);
          const float sgn = part ? -1.f : 1.f;
          const bf16x8 xb0 = pack_f4f4(X0 * sgn, X1 * sgn), xb1 = pack_f4f4(X2 * sgn, X3 * sgn);
          const int q4 = (lane & 15) >> 2, pp = lane & 3;
          const LAS unsigned char* qkl = QKL + d * 9216; const LAS unsigned char* qtl = QT + d * 9216;
          bf16* pA = (d == 0 || part == 1) ? P + tok0 * PLD + h * 64 + (part ? (d ? SAB : SAF) : SBF) : XB2 + tok0 * 512 + h * 64;
          bf16* pC = (d == 0 || part == 1) ? P + tok0 * PLD + h * 64 + (part ? (d ? SCB : SCF) : SDF) : XB2 + (size_t)M * 512 + tok0 * 512 + h * 64;
          const size_t pit = (d == 0 || part == 1) ? PLD : 512;
          const int pc = dn_pcol(colb + cc);
#pragma unroll
          for (int mt = 0; mt < 4; ++mt) {
              s16x4 klo[2], khi[2]; bf16x8 qkf[2]; f32x4 acc2;
              { const unsigned ka = (unsigned)(uintptr_t)(KT + d * 10240) + (4 * g + q4) * 160u + (16 * mt + 4 * pp) * 2u;
                asm volatile("ds_read_b64_tr_b16 %0, %1" : "=&v"(klo[0]) : "v"(ka) : "memory");
                asm volatile("ds_read_b64_tr_b16 %0, %1 offset:2560" : "=&v"(khi[0]) : "v"(ka) : "memory");
                asm volatile("ds_read_b64_tr_b16 %0, %1 offset:5120" : "=&v"(klo[1]) : "v"(ka) : "memory");
                asm volatile("ds_read_b64_tr_b16 %0, %1 offset:7680" : "=&v"(khi[1]) : "v"(ka) : "memory"); }
#pragma unroll
              for (int ks = 0; ks < 2; ++ks) { if (ks == 1 && mt < 2) continue; qkf[ks] = frag_2(qkl + (16 * mt + cc) * 144 + (32 * ks + 4 * g) * 2); }
#pragma unroll
              for (int r = 0; r < 4; ++r) acc2[r] = part ? __uint_as_float((unsigned)(*(const LAS bf16*)(qtl + (16 * mt + 4 * g + r) * 144 + (colb + cc) * 2)) << 16) : 0.f;
              asm volatile("s_waitcnt lgkmcnt(0)" ::: "memory"); __builtin_amdgcn_sched_barrier(0);
              f32x4 acc = z4;
#pragma unroll
              for (int ks = 0; ks < 2; ++ks) { const bf16x8 kf = (bf16x8){klo[ks][0], klo[ks][1], klo[ks][2], klo[ks][3], khi[ks][0], khi[ks][1], khi[ks][2], khi[ks][3]};
                  acc = __builtin_amdgcn_mfma_f32_16x16x32_bf16(kf, ks ? xb1 : xb0, acc, 0, 0, 0); }
#pragma unroll
              for (int ks = 0; ks < 2; ++ks) { if (ks == 1 && mt < 2) continue; acc2 = __builtin_amdgcn_mfma_f32_16x16x32_bf16(qkf[ks], ks ? xb1 : xb0, acc2, 0, 0, 0); }
              if (part == 0) {
                  u32x2 o; o.x = pk2(acc[0], acc[1]); o.y = pk2(acc[2], acc[3]); *(u32x2*)(pA + (size_t)(colb + cc) * pit + 16 * mt + 4 * g) = o;
                  o.x = pk2(acc2[0], acc2[1]); o.y = pk2(acc2[2], acc2[3]); *(u32x2*)(pC + (size_t)(colb + cc) * pit + 16 * mt + 4 * g) = o; }
              else {
#pragma unroll
                  for (int r = 0; r < 4; ++r) { pA[(size_t)(16 * mt + 4 * g + r) * pit + pc] = (bf16)(pk2(acc[r], 0.f) & 0xffffu); pC[(size_t)(16 * mt + 4 * g + r) * pit + pc] = (bf16)(pk2(acc2[r], 0.f) & 0xffffu); } }
              __builtin_amdgcn_sched_barrier(0);
          }
          asm volatile("" ::: "memory"); __builtin_amdgcn_sched_barrier(0);
      } }
    LDS_WAIT(); __syncthreads();
  }
#undef DN_PREFETCH
}

constexpr int DNX_A = 0, DNX_C = 8192, DNX_BT = 16384, DNX_DT = 24576, DNX_EG = 32768, DNX_SZ = 33792, DNX_OST = 3 * DNX_SZ;
__device__ __forceinline__ void dn_scan_step(const LAS unsigned char* buf, f32x4 (&Sacc)[4], int ws, int lane, LAS unsigned char* ost, int dir) {
    const int c = lane & 15, g = lane >> 4;
    const unsigned trow = 16 * ws + c, t0 = trow * 128u + ((((unsigned)(g >> 1)) ^ ((trow >> 1) & 7u)) << 4) + 8u * (g & 1);
    u32x2 bt[4], dt[4]; bf16x8 af[4][2], cf[4][2];
#pragma unroll
    for (int mt = 0; mt < 4; ++mt) { const unsigned row = 16 * mt + c, a0 = row * 128u + ((((unsigned)g) ^ ((row >> 1) & 7u)) << 4);
        bt[mt] = *(const LAS u32x2*)(buf + DNX_BT + (t0 ^ ((unsigned)mt << 5)));
#pragma unroll
        for (int ks = 0; ks < 2; ++ks) af[mt][ks] = *(const LAS bf16x8*)(buf + DNX_A + (a0 ^ ((unsigned)ks << 6))); }
#pragma unroll
    for (int mt = 0; mt < 4; ++mt) { const unsigned row = 16 * mt + c, a0 = row * 128u + ((((unsigned)g) ^ ((row >> 1) & 7u)) << 4);
        dt[mt] = *(const LAS u32x2*)(buf + DNX_DT + (t0 ^ ((unsigned)mt << 5)));
#pragma unroll
        for (int ks = 0; ks < 2; ++ks) cf[mt][ks] = *(const LAS bf16x8*)(buf + DNX_C + (a0 ^ ((unsigned)ks << 6))); }
    const float gm = ((const LAS float*)(buf + DNX_EG))[63];
    bf16x8 Sb[2];
#pragma unroll
    for (int ks = 0; ks < 2; ++ks) Sb[ks] = pack_f4f4(Sacc[2 * ks], Sacc[2 * ks + 1]);
    __builtin_amdgcn_sched_barrier(0);
#pragma unroll
    for (int mt = 0; mt < 4; ++mt) { f32x4 sn = Sacc[mt] * gm + (f32x4){bf_lo(bt[mt].x), bf_hi(bt[mt].x), bf_lo(bt[mt].y), bf_hi(bt[mt].y)};
#pragma unroll
        for (int ks = 0; ks < 2; ++ks) sn = __builtin_amdgcn_mfma_f32_16x16x32_bf16(af[mt][ks], Sb[ks], sn, 0, 0, 0);
        Sacc[mt] = sn; }
#pragma unroll
    for (int mt = 0; mt < 4; ++mt) { f32x4 oa = (f32x4){bf_lo(dt[mt].x), bf_hi(dt[mt].x), bf_lo(dt[mt].y), bf_hi(dt[mt].y)};
#pragma unroll
        for (int ks = 0; ks < 2; ++ks) oa = __builtin_amdgcn_mfma_f32_16x16x32_bf16(cf[mt][ks], Sb[ks], oa, 0, 0, 0);
#pragma unroll
        for (int r = 0; r < 4; ++r) { const int p = 16 * mt + 4 * g + r, i = dir ? 63 - p : p;
            *(LAS bf16*)(ost + i * 128 + (16 * ws + c) * 2) = (bf16)(pk2(oa[r], 0.f) & 0xffffu); } }
}
__device__ __forceinline__ void dn_scan_unit(Frame& F, const Args& a, int b, int h, int dir) {
    bf16* P = (bf16*)(a.ws + WS_P);
    const int w = F.wave, lane = F.lane;
#define DN_BAR() do { asm volatile("s_waitcnt lgkmcnt(0)" ::: "memory"); __builtin_amdgcn_s_barrier(); asm volatile("" ::: "memory"); } while (0)
    if (w < 4) {
        f32x4 Sacc[4];
#pragma unroll
        for (int mt = 0; mt < 4; ++mt) Sacc[mt] = (f32x4){0.f, 0.f, 0.f, 0.f};
        bf16* Ob = P + (size_t)b * SEQ * PLD + (dir ? C_OB : C_OF) + h * 64;
        DN_BAR();
        int slot = 0;
#pragma unroll 1
        for (int s = 0; s <= 128; ++s) {
            if (s > 0) { const int cp = dir ? 128 - s : s - 1; const LAS unsigned char* st = F.lds + DNX_OST + ((s - 1) & 1) * 8192;
#pragma unroll
                for (int k = 0; k < 2; ++k) { const int idx = F.tid + 256 * k, row = idx >> 3, ch = idx & 7;
                    *(u32x4*)(Ob + ((size_t)cp * 64 + row) * PLD + ch * 8) = *(const LAS u32x4*)(st + row * 128 + ch * 16); } }
            if (s < 128) dn_scan_step(F.lds + slot * DNX_SZ, Sacc, w, lane, F.lds + DNX_OST + (s & 1) * 8192, dir);
            slot = slot == 2 ? 0 : slot + 1;
            DN_BAR();
        }
    } else {
        const int hw = w - 4;
        const bf16* XB2 = (const bf16*)a.out + (size_t)M * 1024;
        const float* BAg = (const float*)(a.ws + WS_BA);
        const char* gp[8]; long gstep[8];
#pragma unroll
        for (int i = 0; i < 8; ++i) { const int pid = hw * 8 + i, blk = pid >> 3, pc = pid & 7, r = 8 * pc + (lane >> 3), cp = lane & 7;
            const int key = (r >> 1) & 7, cs = cp ^ key;
            const size_t tokb = (size_t)b * SEQ;
            if (dir == 1 && blk >= 2) { gp[i] = (const char*)(XB2 + (size_t)(blk - 2) * M * 512 + (tokb + r) * 512 + h * 64 + cs * 8); gstep[i] = 64L * 512 * 2; }
            else { const int col = blk == 0 ? (dir ? SAB : SAF) : blk == 1 ? (dir ? SCB : SCF) : blk == 2 ? SBF : SDF;
                   gp[i] = (const char*)(P + (tokb + r) * PLD + col + h * 64 + cs * 8); gstep[i] = 64L * PLD * 2; } }
        const char* ggc = (const char*)(BAg + ((size_t)b * SEQ + lane) * 32 + dir * 8 + h);
#define DN_ISSUE(n, slot_) do { const int cn_ = dir ? 127 - (n) : (n); LAS unsigned char* sb_ = F.lds + (slot_) * DNX_SZ; \
        _Pragma("unroll") for (int i = 0; i < 8; ++i) { const int pid = hw * 8 + i; \
            __builtin_amdgcn_global_load_lds((const unsigned*)(gp[i] + (long)cn_ * gstep[i]), (LAS unsigned*)(sb_ + (pid >> 3) * 8192 + (pid & 7) * 1024), 16, 0, 0); } \
        __builtin_amdgcn_global_load_lds((const unsigned*)(ggc + (long)cn_ * (64L * 32 * 4)), (LAS unsigned*)(sb_ + DNX_EG + hw * 256), 4, 0, 0); } while (0)
        DN_ISSUE(0, 0); DN_ISSUE(1, 1);
        asm volatile("s_waitcnt vmcnt(9)" ::: "memory");
        DN_BAR();
        int slot2 = 2;
#pragma unroll 1
        for (int s = 0; s <= 128; ++s) {
            if (s + 2 < 128) { DN_ISSUE(s + 2, slot2); asm volatile("s_waitcnt vmcnt(9)" ::: "memory"); }
            else { asm volatile("s_waitcnt vmcnt(0)" ::: "memory"); }
            slot2 = slot2 == 2 ? 0 : slot2 + 1;
            DN_BAR();
        }
#undef DN_ISSUE
    }
#undef DN_BAR
    __syncthreads();
}
__device__ __forceinline__ void dn_combine(Frame& F, const Args& a) {
    bf16* P = (bf16*)(a.ws + WS_P);
    const float* og = a.in[11];
    const int gw = F.vcu * NWAVES + F.wave, NGW = F.G * NWAVES, c0 = F.lane * 8;
    for (int row = gw; row < M; row += NGW) {
        bf16* rp = P + (size_t)row * PLD;
        float of[8], ob[8]; unpack8(*(const u32x4*)(rp + C_OF + c0), of); unpack8(*(const u32x4*)(rp + C_OB + c0), ob);
        float s[8], ss = 0.f;
#pragma unroll
        for (int j = 0; j < 8; ++j) { s[j] = of[j] + ob[j]; ss += s[j] * s[j]; }
        ss += __shfl_xor(ss, 1); ss += __shfl_xor(ss, 2); ss += __shfl_xor(ss, 4);
        const float rstd = __builtin_amdgcn_rsqf(ss * (1.0f / 64) + EPS);
        bf16* zp = rp + C_DZ + c0; float z[8]; unpack8(*(const u32x4*)zp, z);
        const f32x4 g0 = *(const f32x4*)(og + (c0 & 63)), g1 = *(const f32x4*)(og + (c0 & 63) + 4);
        float y[8];
#pragma unroll
        for (int j = 0; j < 4; ++j) { y[j] = s[j] * rstd * g0[j] * siluf_(z[j]); y[4 + j] = s[4 + j] * rstd * g1[j] * siluf_(z[4 + j]); }
        *(u32x4*)zp = pack8(y);
    }
}
__device__ __forceinline__ void ffn_fixup_panel(Frame& F, const Args& a, int pm) {
    bf16* P = (bf16*)(a.ws + WS_P); const float* UE = (const float*)(a.ws + WS_UE);
    const float* cw = a.in[22]; const float* cb = a.in[23];
#pragma unroll 2
    for (int e = F.tid; e < 8 * (DFF / 4); e += 512) { const int k = e / (DFF / 4), ch = (e % (DFF / 4)) * 4, g = pm * 4 + (k >> 1), last = k & 1;
        const int row = g * 64 + (last ? 63 : 0);
        const bool hp = last ? true : (row % SEQ) != 0, hn = last ? (row % SEQ) != SEQ - 1 : true;
        const float* pu = UE + ((size_t)(last ? g : (g > 0 ? g - 1 : 0)) * 4 + (last ? 2 : 3)) * NUP;
        const float* cu = UE + ((size_t)g * 4 + (last ? 3 : 0)) * NUP;
        const float* nu = UE + ((size_t)(last ? (g < 511 ? g + 1 : 511) : g) * 4 + (last ? 0 : 1)) * NUP;
        const f32x4 z = (f32x4){0.f, 0.f, 0.f, 0.f};
        const f32x4 pg = hp ? *(const f32x4*)(pu + ch) : z, pv = hp ? *(const f32x4*)(pu + DFF + ch) : z, ng = hn ? *(const f32x4*)(nu + ch) : z, nv = hn ? *(const f32x4*)(nu + DFF + ch) : z;
        const f32x4 cg = *(const f32x4*)(cu + ch), cv = *(const f32x4*)(cu + DFF + ch);
        const f32x4 gate = *(const f32x4*)(cw + ch) * pg + *(const f32x4*)(cw + NUP + ch) * cg + *(const f32x4*)(cw + 2 * NUP + ch) * ng + *(const f32x4*)(cb + ch);
        const f32x4 val = *(const f32x4*)(cw + DFF + ch) * pv + *(const f32x4*)(cw + NUP + DFF + ch) * cv + *(const f32x4*)(cw + 2 * NUP + DFF + ch) * nv + *(const f32x4*)(cb + DFF + ch);
        u32x2 w; w.x = pk2(siluf_(gate[0]) * val[0], siluf_(gate[1]) * val[1]); w.y = pk2(siluf_(gate[2]) * val[2], siluf_(gate[3]) * val[3]);
        *(u32x2*)(P + (size_t)row * PLD + C_ACT + ch) = w; }
}

__global__ void __launch_bounds__(NWAVES * 64, 2) fwd_kernel(Args args) {
    extern __shared__ __attribute__((aligned(16))) unsigned char lds[];
    Frame F;
    F.lds = (LAS unsigned char*)lds;
    F.MISC = (volatile LAS unsigned*)(F.lds + MISC_OFF);
    F.tid = threadIdx.x; F.lane = F.tid & 63; F.wave = __builtin_amdgcn_readfirstlane(F.tid >> 6);
    F.G = gridDim.x; { const int bx = blockIdx.x; F.vcu = (F.G % 8 == 0) ? (bx % 8) * (F.G / 8) + bx / 8 : bx; }
    unsigned char* ws = args.ws;
    F.ctl = (gu32*)(ws + WS_CTL);
    for (int u = F.tid; u < (LDS_BYTES - LDSCTL_OFF) / 4; u += NWAVES * 64) ((LAS unsigned*)(F.lds + LDSCTL_OFF))[u] = 0u;
    __syncthreads();
    const int lo = args.ph_lo, hi = args.ph_hi;
    const bool single = (hi - lo) > 1;
    XcdBarrier bar; bar.bar = (unsigned*)(F.ctl + CW_BAR); bar.x = 0; bar.st = nullptr;
    if (single) bar = xcd_barrier_post((unsigned*)(F.ctl + CW_BAR), F.MISC + 8);
#ifndef PH_MASK
#define PH_MASK 0x1FF
#endif
#define IN(k) (((PH_MASK >> (k)) & 1) && lo <= (k) && (k) < hi)
#define SEAM(k) do { if (IN(k) && IN((k) + 1)) xcd_barrier(bar); } while (0)
    bf16* P = (bf16*)(ws + WS_P);
    const int bid = (int)blockIdx.x;
#define TS(k) do {} while (0)
#define TSB(k, blk) do {} while (0)
    TS(0);

    if (IN(0)) { p0_prologue(F, args); }
    SEAM(0); TS(1);
    if (IN(1)) {
        { pg8::Gemm g{(const bf16*)args.out, (const bf16*)(ws + WS_WIN), M, 3584, 1024, 1024, 1024}; pg8::StaticOrder S; S.init(M, 3584, F.G, bid);
          EpiInProj E{P, (float*)(ws + WS_BA)};
          pg8::gemm_phase<EpiInProj, pg8::StaticOrder, true, true>(F.lds + RING_OFF, g, S, E); }
        { pg8::Gemm g{(const bf16*)(ws + WS_MEMN), (const bf16*)(ws + WS_WKV), BATCH * NMEM, 1024, 1024, 1024, 1024}; pg8::StaticOrder S; S.init(BATCH * NMEM, 1024, F.G, bid);
          EpiBf16 E{(bf16*)(ws + WS_KV), 1024};
          pg8::gemm_phase<EpiBf16, pg8::StaticOrder, true, true>(F.lds + RING_OFF, g, S, E); }
    }
    SEAM(1); TS(2);
    if (IN(2)) {
        if (F.G == 256) dn_prep_block(F, args, bid >> 6, (bid >> 3) & 7, (bid & 7) * 16, 16);
        else for (int u = bid; u < 4096; u += F.G) dn_prep_block(F, args, u >> 10, (u >> 7) & 7, u & 127, 1);
    }
    TS(12); SEAM(2); TS(3);
    if (IN(3)) {
        const int ndn = F.G >= 128 ? 64 : 0;
        if (bid < ndn) { if (args.mode != 2) dn_scan_unit(F, args, bid >> 4, (bid >> 1) & 7, bid & 1); }
        else if (args.mode != 1) {
            if (ndn == 0) for (int u = bid; u < 64; u += F.G) dn_scan_unit(F, args, u >> 4, (u >> 1) & 7, u & 1);
            const int nb = F.G - ndn, me = bid - ndn;
            for (int u = me; u < 1024; u += nb) {
                if (u < 512) attnA_unit(F, args, u >> 7, (u >> 1) & 63, u & 1);
                else { const int v = u - 512; xattn_unit(F, args, v >> 7, (v >> 2) & 31, v & 3); }
            }
        }
    }
    TS(10); TSB(11, 64); SEAM(3); TS(4);
    if (IN(4)) {
        dn_combine(F, args);
        pg8::Gemm g{(const bf16*)args.out, (const bf16*)(ws + WS_WIN) + (size_t)3584 * 1024, M, 3072, 1024, 1024, 1024}; pg8::StaticOrder S; S.init(M, 3072, F.G, bid);
        EpiBf16 E{P + C_GATE, PLD};
        pg8::gemm_phase<EpiBf16, pg8::StaticOrder, true, true>(F.lds + RING_OFF, g, S, E);
    }
    SEAM(4); TS(5);
    if (IN(5)) {
        { pg8::Gemm g{P + C_AQ, (const bf16*)(ws + WS_WBR), M, 1024, 512, PLD, 512}; pg8::StaticOrder S; S.init(M, 1024, F.G, bid);
          EpiBranch<0> E{P}; pg8::gemm_phase<EpiBranch<0>, pg8::StaticOrder, true, true>(F.lds + RING_OFF, g, S, E); }
        VM_WAIT(); __syncthreads();
        { pg8::Gemm g{P + C_DZ, (const bf16*)(ws + WS_WBR) + (size_t)1024 * 512, M, 1024, 512, PLD, 512}; pg8::StaticOrder S; S.init(M, 1024, F.G, bid);
          EpiBranch<1> E{P}; pg8::gemm_phase<EpiBranch<1>, pg8::StaticOrder, true, true>(F.lds + RING_OFF, g, S, E); }
        VM_WAIT(); __syncthreads();
        { pg8::Gemm g{P + C_MQ, (const bf16*)(ws + WS_WBR) + (size_t)2 * 1024 * 512, M, 1024, 512, PLD, 512}; pg8::StaticOrder S; S.init(M, 1024, F.G, bid);
          EpiBranch<2> E{P}; pg8::gemm_phase<EpiBranch<2>, pg8::StaticOrder, true, true>(F.lds + RING_OFF, g, S, E); }
    }
    SEAM(5); TS(6);
    if (IN(6)) {
        pg8::Gemm g{P + C_MG, (const bf16*)(ws + WS_WOUT), M, 1024, 1024, PLD, 1024}; pg8::StaticOrder S; S.init(M, 1024, F.G, bid);
        EpiWout E{args.in[0], args.out, P, (float*)(ws + WS_SSQ), (LAS float*)(F.lds + XCH_OFF)};
        pg8::gemm_phase<EpiWout, pg8::StaticOrder, true, true>(F.lds + RING_OFF, g, S, E);
    }
    SEAM(6); TS(7);
    if (IN(7)) {
        pg8::Gemm g{P + C_X1B, (const bf16*)(ws + WS_WUP), M, NUP, 1024, PLD, 1024}; pg8::StaticOrder S; S.init(M, NUP, F.G, bid);
        EpiUp E{(const float*)(ws + WS_SSQ), args.in[22], args.in[23], P, (float*)(ws + WS_UE)};
        pg8::gemm_phase<EpiUp, pg8::StaticOrder, true, true>(F.lds + RING_OFF, g, S, E);
    }
    SEAM(7); TS(8);
    if (IN(8)) {
        pg8::Gemm g{P + C_ACT, (const bf16*)(ws + WS_WDN), M, 1024, DFF, PLD, DFF}; pg8::StaticOrder S; S.init(M, 1024, F.G, bid);
        { Unit u; int prev = -1; for (int i = 0; S.next(i, u); ++i) { if (u.pm != prev) ffn_fixup_panel(F, args, u.pm); prev = u.pm; } }
        VM_WAIT(); __syncthreads();
        EpiDown E{args.out};
        pg8::gemm_phase<EpiDown, pg8::StaticOrder, true, true>(F.lds + RING_OFF, g, S, E);
    }
    TS(9);
#undef IN
#undef SEAM
}

#ifdef DBG_TIME
__global__ void dbg_ts_kernel(unsigned char* ws, int k) { if (threadIdx.x == 0) ((unsigned long long*)(ws + WS_CTL + 65536))[k] = __builtin_amdgcn_s_memrealtime(); }
__global__ void dbg_wait_kernel(unsigned char* ws) {
    if (threadIdx.x == 0) { const unsigned long long* tsb = (const unsigned long long*)(ws + WS_CTL + 65536);
        const unsigned long long te = __builtin_amdgcn_s_memrealtime();
        const unsigned long long d1 = tsb[DBG_A1] - tsb[DBG_A0], d2 = tsb[DBG_B1] - tsb[DBG_B0];
        const unsigned long long W = d1 + 100000ull * (d2 / 1000ull);
        while (__builtin_amdgcn_s_memrealtime() - te < W) __builtin_amdgcn_s_sleep(32); }
}
#endif
constexpr int N_PHASES = 9;
#ifndef MK_PER_PHASE
#define MK_PER_PHASE 0
#endif
extern "C" void kernel_launch(void* const* d_in, const int* in_sizes, int n_in, void* d_out, int out_size, void* d_ws, size_t ws_size, hipStream_t stream) {
    static int grid = 0;
    if (grid == 0) {
        if (n_in != 25 || in_sizes[0] != M * DM || out_size != M * DM || ws_size < WS_END) {
            fprintf(stderr, "kernel_launch: unexpected shapes (n_in %d, in0 %d, out %d, ws %zu); nothing launched\n", n_in, n_in > 0 ? in_sizes[0] : -1, out_size, ws_size); grid = -1; return; }
        int dev = 0, cus = 0, per_cu = 0;
        if (hipGetDevice(&dev) != hipSuccess || hipDeviceGetAttribute(&cus, hipDeviceAttributeMultiprocessorCount, dev) != hipSuccess) { grid = -1; return; }
        if (hipFuncSetAttribute((const void*)fwd_kernel, hipFuncAttributeMaxDynamicSharedMemorySize, LDS_BYTES) != hipSuccess) { fprintf(stderr, "kernel_launch: hipFuncSetAttribute failed\n"); grid = -1; return; }
        if (hipOccupancyMaxActiveBlocksPerMultiprocessor(&per_cu, (const void*)fwd_kernel, NWAVES * 64, LDS_BYTES) != hipSuccess || per_cu < 1) { fprintf(stderr, "kernel_launch: occupancy query reports %d\n", per_cu); }
        (void)hipGetLastError();
        grid = cus;
    }
    if (grid < 0) return;
    if (hipMemsetAsync((char*)d_ws + WS_CTL, 0, CTL_ZERO_BYTES, stream) != hipSuccess) return;
    Args a{};
    for (int i = 0; i < 25; ++i) a.in[i] = (const float*)d_in[i];
    a.out = (float*)d_out; a.ws = (unsigned char*)d_ws;
#ifdef DBG_TIME
    for (int p = 0; p < N_PHASES; ++p) { hipLaunchKernelGGL(dbg_ts_kernel, dim3(1), dim3(64), 0, stream, (unsigned char*)d_ws, p);
        a.ph_lo = p; a.ph_hi = p + 1;
        if (p == 3) { a.mode = 1; hipLaunchKernelGGL(fwd_kernel, dim3(grid), dim3(NWAVES * 64), LDS_BYTES, stream, a); hipLaunchKernelGGL(dbg_ts_kernel, dim3(1), dim3(64), 0, stream, (unsigned char*)d_ws, 12); a.mode = 2; }
        hipLaunchKernelGGL(fwd_kernel, dim3(grid), dim3(NWAVES * 64), LDS_BYTES, stream, a); a.mode = 0; }
    hipLaunchKernelGGL(dbg_ts_kernel, dim3(1), dim3(64), 0, stream, (unsigned char*)d_ws, N_PHASES);
    hipLaunchKernelGGL(dbg_wait_kernel, dim3(1), dim3(64), 0, stream, (unsigned char*)d_ws);
    return;
#endif
    if (MK_PER_PHASE) {
        for (int p = 0; p < N_PHASES; ++p) { a.ph_lo = p; a.ph_hi = p + 1; hipLaunchKernelGGL(fwd_kernel, dim3(grid), dim3(NWAVES * 64), LDS_BYTES, stream, a); }
    } else {
        a.ph_lo = 0; a.ph_hi = N_PHASES; hipLaunchKernelGGL(fwd_kernel, dim3(grid), dim3(NWAVES * 64), LDS_BYTES, stream, a);
    }
}
```

```cpp
#include <hip/hip_runtime.h>
#include <cstdio>
#include <cstdint>
#include <cmath>
namespace pg8 {
#define PG8_LAS __attribute__((address_space(3)))
typedef unsigned short bf16_t;
typedef short bf16x8 __attribute__((ext_vector_type(8)));
typedef float f32x4 __attribute__((ext_vector_type(4)));
typedef unsigned u32x4 __attribute__((ext_vector_type(4)));
constexpr int BM = 256, BK = 64, HALF = 128, HTB = HALF * BK * 2  , STAGE_BYTES = 8 * HTB, NXCD = 8, WGM = 8;

__host__ __device__ __forceinline__ int lds_byte(int r, int c) { const int st = (r >> 4) * 2 + (c >> 5), rr = r & 15, cc = c & 31, ob = rr * 64 + cc * 2; return st * 1024 + (ob ^ (((ob >> 9) & 1) << 5)); }
__host__ __device__ __forceinline__ void stage_rc(int b, int& R, int& C) { const int st = b / 1024, sb = b % 1024, swz = sb ^ (((sb >> 9) & 1) << 5); R = (st >> 1) * 16 + swz / 64; C = (st & 1) * 32 + (swz % 64) / 2; }
__host__ __device__ __forceinline__ int perm32(int rho) { const int n = rho >> 4, i = rho & 15; return 8 * (i >> 2) + 4 * n + (i & 3); }

struct Unit { int pm, pn, aux; };
struct Gemm { const bf16_t* A; const bf16_t* Bt; int M, N, K, lda, ldb; int segt = 1 << 30; long aoff1 = 0, aoff2 = 0, boff1 = 0, boff2 = 0; };

struct StaticOrder {
    int nM, nN, nwg, G, c;
    __host__ __device__ __forceinline__ void init(int M, int N, int G_, int c_) { nM = M / BM; nN = N / BM; nwg = nM * nN; G = G_; c = c_; }
    __host__ __device__ __forceinline__ bool next(int i, Unit& u) const {
        const long L = (long)i * G + c; if (L >= nwg) return false;
        int wgid = (int)L; { const int q = nwg / NXCD, r = nwg % NXCD, xcd = wgid % NXCD, off = wgid / NXCD; wgid = (xcd < r ? xcd * (q + 1) : r * (q + 1) + (xcd - r) * q) + off; }
        const int nig = WGM * nN, gid = wgid / nig, fm = gid * WGM, gsz = (nM - fm) < WGM ? (nM - fm) : WGM;
        u.pm = fm + ((wgid % nig) % gsz); u.pn = (wgid % nig) / gsz; return true;
    }
    __device__ __forceinline__ void a_ready(const Unit&) const {}
    __device__ __forceinline__ void done(const Unit&) const {}
};

template <class Epi, class Sched, bool ALIGN_EPI = false, bool SP2 = false>
__device__ __forceinline__ void gemm_phase(PG8_LAS unsigned char* lds, const Gemm g, const Sched& S, const Epi& E) {
    const int tid = threadIdx.x, wid = __builtin_amdgcn_readfirstlane(tid >> 6), lane = tid & 63, wr = wid >> 2, wc = wid & 3, fr = lane & 15, fq = lane >> 4;
    const int K = g.K, nt = K / BK;
    unsigned voffA[2], voffB[2];
#pragma unroll
    for (int i = 0; i < 2; ++i) { int R, C; stage_rc(tid * 16 + i * 8192, R, C); const int Rb = Epi::PERM ? ((R & ~31) + perm32(R & 31)) : R;
        voffA[i] = (unsigned)(R * g.lda + C) * 2u; voffB[i] = (unsigned)(Rb * g.ldb + C) * 2u; }
    const size_t kstep = (size_t)(BK * 2);
    const size_t hstepA = (size_t)HALF * g.lda * 2, hstepB = (size_t)HALF * g.ldb * 2;
    const size_t tstepA = 2 * hstepA, tstepB = 2 * hstepB;
    const unsigned ldsw = (unsigned)wid * 1024u;
    const int aoff = lds_byte(wr * 64 + fr, fq * 8), boff = lds_byte(wc * 32 + fr, fq * 8);
#define PG8_SA(b, h) (((b) * 2 + (h)) * HTB)
#define PG8_SB(b, h) ((4 + (b) * 2 + (h)) * HTB)
#define PG8_STAGE(bufoff, gbase, voff) do { _Pragma("unroll") for (int _i = 0; _i < 2; ++_i) \
        __builtin_amdgcn_global_load_lds((const unsigned*)((const char*)(gbase) + (voff)[_i]), (PG8_LAS unsigned*)(lds + (bufoff) + ldsw + _i * 8192), 16, 0, 0); } while (0)
#define PG8_LDA(dst, b, h) do { _Pragma("unroll") for (int m = 0; m < 4; ++m) _Pragma("unroll") for (int k = 0; k < 2; ++k) dst[m][k] = *(const PG8_LAS bf16x8*)(lds + PG8_SA(b, h) + aoff + m * 2048 + k * 1024); } while (0)
#define PG8_LDB(dst, b, h) do { _Pragma("unroll") for (int n = 0; n < 2; ++n) _Pragma("unroll") for (int k = 0; k < 2; ++k) dst[n][k] = *(const PG8_LAS bf16x8*)(lds + PG8_SB(b, h) + boff + n * 2048 + k * 1024); } while (0)
#define PG8_MMA(ai, bj, At, Bt) do { __builtin_amdgcn_s_setprio(1); _Pragma("unroll") for (int m = 0; m < 4; ++m) _Pragma("unroll") for (int n = 0; n < 2; ++n) _Pragma("unroll") for (int k = 0; k < 2; ++k) \
        acc[ai][bj][m][n] = __builtin_amdgcn_mfma_f32_16x16x32_bf16(Bt[n][k], At[m][k], acc[ai][bj][m][n], 0, 0, 0); __builtin_amdgcn_s_setprio(0); } while (0)
#define PG8_WAIT_V(n) asm volatile("s_waitcnt vmcnt(" #n ")" ::: "memory")
#define PG8_WAIT_L(n) asm volatile("s_waitcnt lgkmcnt(" #n ")" ::: "memory")
#define PG8_BAR __builtin_amdgcn_s_barrier()
#define PG8_SCHED __builtin_amdgcn_sched_barrier(0)
    Unit cur, nxt; int ui = 0;
    if (!S.next(0, cur)) return;
    if constexpr (Epi::PREFETCH) E.prefetch(cur, 0, tid);
    f32x4 acc[2][2][4][2];
#pragma unroll
    for (int a = 0; a < 2; ++a)
#pragma unroll
        for (int b = 0; b < 2; ++b)
#pragma unroll
            for (int m = 0; m < 4; ++m)
#pragma unroll
                for (int n = 0; n < 2; ++n) acc[a][b][m][n] = (f32x4){0.f, 0.f, 0.f, 0.f};
    bf16x8 At[4][2], B0[2][2], B1[2][2];
    const char* cA = (const char*)g.A + (size_t)cur.pm * tstepA; const char* cB = (const char*)g.Bt + (size_t)cur.pn * tstepB;
    S.a_ready(cur);
    if constexpr (SP2) {
        PG8_STAGE(PG8_SB(0, 0), cB, voffB); PG8_STAGE(PG8_SB(0, 1), cB + hstepB, voffB); PG8_STAGE(PG8_SA(0, 0), cA, voffA); PG8_STAGE(PG8_SA(0, 1), cA + hstepA, voffA);
        if (wr == 1) PG8_BAR;
        PG8_WAIT_V(2); PG8_BAR;
        PG8_STAGE(PG8_SB(1, 0), cB + kstep, voffB); PG8_STAGE(PG8_SA(1, 0), cA + kstep, voffA); PG8_STAGE(PG8_SB(1, 1), cB + hstepB + kstep, voffB);
        PG8_WAIT_V(6); PG8_BAR;
    } else {
        PG8_STAGE(PG8_SB(0, 0), cB, voffB); PG8_STAGE(PG8_SA(0, 0), cA, voffA); PG8_STAGE(PG8_SB(0, 1), cB + hstepB, voffB); PG8_STAGE(PG8_SA(0, 1), cA + hstepA, voffA);
        if (wr == 1) PG8_BAR;
        PG8_WAIT_V(4); PG8_BAR;
        PG8_STAGE(PG8_SB(1, 0), cB + kstep, voffB); PG8_STAGE(PG8_SA(1, 0), cA + kstep, voffA); PG8_STAGE(PG8_SB(1, 1), cB + hstepB + kstep, voffB);
        PG8_WAIT_V(6); PG8_BAR;
    }
    for (;;) {
        const bool has_next = S.next(ui + 1, nxt);
        const char* nA = has_next ? (const char*)g.A + (size_t)nxt.pm * tstepA : cA; const char* nB = has_next ? (const char*)g.Bt + (size_t)nxt.pn * tstepB : cB;
        for (int t = 0; t < nt; t += 2) {
            const bool last = (t == nt - 2);
            if constexpr (Epi::RESCALE) { if (t == g.segt || t == 2 * g.segt) E.rescale(acc, cur, wr, wc, fr, fq, t / g.segt); }
            const long so1 = (t + 1 >= 2 * g.segt) ? g.aoff2 : ((t + 1 >= g.segt) ? g.aoff1 : 0), so2 = (t + 2 >= 2 * g.segt) ? g.aoff2 : ((t + 2 >= g.segt) ? g.aoff1 : 0), sb2 = (t + 2 >= 2 * g.segt) ? g.boff2 : ((t + 2 >= g.segt) ? g.boff1 : 0);
            const char* a1 = cA + so1 + (size_t)(t + 1) * kstep;
            const char* a2 = last ? nA : cA + so2 + (size_t)(t + 2) * kstep; const char* b2 = last ? nB : cB + sb2 + (size_t)(t + 2) * kstep;
            const char* a3 = a2 + kstep; const char* b3 = b2 + kstep;
            if (last && has_next) S.a_ready(nxt);
            if constexpr (SP2) {
            PG8_LDB(B0, 0, 0); PG8_LDB(B1, 0, 1); PG8_SCHED; PG8_LDA(At, 0, 0); PG8_STAGE(PG8_SA(1, 1), a1 + hstepA, voffA);
            PG8_WAIT_V(8); PG8_WAIT_L(0); PG8_BAR; PG8_MMA(0, 0, At, B0); PG8_MMA(0, 1, At, B1); PG8_BAR; PG8_SCHED;
            PG8_LDA(At, 0, 1); PG8_STAGE(PG8_SB(0, 0), b2, voffB); PG8_STAGE(PG8_SB(0, 1), b2 + hstepB, voffB); PG8_STAGE(PG8_SA(0, 0), a2, voffA);
            PG8_WAIT_V(8); PG8_WAIT_L(0); PG8_BAR; PG8_MMA(1, 0, At, B0); PG8_MMA(1, 1, At, B1); PG8_BAR; PG8_SCHED;
            PG8_LDB(B0, 1, 0); PG8_LDB(B1, 1, 1); PG8_SCHED; PG8_LDA(At, 1, 0); PG8_STAGE(PG8_SA(0, 1), a2 + hstepA, voffA);
            PG8_WAIT_V(8); PG8_WAIT_L(0); PG8_BAR; PG8_MMA(0, 0, At, B0); PG8_MMA(0, 1, At, B1); PG8_BAR; PG8_SCHED;
            PG8_LDA(At, 1, 1); PG8_STAGE(PG8_SB(1, 0), b3, voffB); PG8_STAGE(PG8_SB(1, 1), b3 + hstepB, voffB); PG8_STAGE(PG8_SA(1, 0), a3, voffA);
            PG8_WAIT_V(8); PG8_WAIT_L(0); PG8_BAR; PG8_MMA(1, 0, At, B0); PG8_MMA(1, 1, At, B1); PG8_BAR; PG8_SCHED;
            } else {
            PG8_LDB(B0, 0, 0); PG8_SCHED; PG8_LDA(At, 0, 0); PG8_STAGE(PG8_SA(1, 1), a1 + hstepA, voffA);
            PG8_WAIT_L(8); PG8_BAR; PG8_WAIT_L(0); PG8_MMA(0, 0, At, B0); PG8_BAR; PG8_SCHED;
            PG8_LDB(B1, 0, 1); PG8_STAGE(PG8_SB(0, 0), b2, voffB);
            PG8_BAR; PG8_WAIT_L(0); PG8_MMA(0, 1, At, B1); PG8_BAR;
            PG8_LDA(At, 0, 1); PG8_STAGE(PG8_SA(0, 0), a2, voffA);
            PG8_BAR; PG8_WAIT_L(0); PG8_MMA(1, 0, At, B0); PG8_BAR; PG8_SCHED;
            PG8_STAGE(PG8_SB(0, 1), b2 + hstepB, voffB);
            PG8_WAIT_V(6); PG8_BAR; PG8_MMA(1, 1, At, B1); PG8_BAR;
            PG8_LDB(B0, 1, 0); PG8_SCHED; PG8_LDA(At, 1, 0); PG8_STAGE(PG8_SA(0, 1), a2 + hstepA, voffA);
            PG8_WAIT_L(8); PG8_BAR; PG8_WAIT_L(0); PG8_MMA(0, 0, At, B0); PG8_BAR; PG8_SCHED;
            PG8_LDB(B1, 1, 1); PG8_STAGE(PG8_SB(1, 0), b3, voffB);
            PG8_BAR; PG8_WAIT_L(0); PG8_MMA(0, 1, At, B1); PG8_BAR;
            PG8_LDA(At, 1, 1); PG8_STAGE(PG8_SA(1, 0), a3, voffA);
            PG8_BAR; PG8_WAIT_L(0); PG8_MMA(1, 0, At, B0); PG8_BAR; PG8_SCHED;
            PG8_STAGE(PG8_SB(1, 1), b3 + hstepB, voffB);
            PG8_WAIT_V(6); PG8_BAR; PG8_MMA(1, 1, At, B1); PG8_BAR;
            }
        }
        if constexpr (ALIGN_EPI) { if (wr == 0) PG8_BAR; }
        if constexpr (Epi::PREFETCH) cur.aux = ui & 1;
        if constexpr (!Epi::AFTER_DRAIN) { E(acc, cur, wr, wc, fr, fq); S.done(cur); }
        if constexpr (Epi::PREFETCH) { if (has_next) E.prefetch(nxt, (ui + 1) & 1, tid); }
        if (!has_next) break;
#pragma unroll
        for (int a = 0; a < 2; ++a)
#pragma unroll
            for (int b = 0; b < 2; ++b)
#pragma unroll
                for (int m = 0; m < 4; ++m)
#pragma unroll
                    for (int n = 0; n < 2; ++n) acc[a][b][m][n] = (f32x4){0.f, 0.f, 0.f, 0.f};
        cur = nxt; cA = nA; cB = nB; ++ui;
        if constexpr (ALIGN_EPI) { if (wr == 1) PG8_BAR; }
    }
    PG8_WAIT_V(0);
    if constexpr (!ALIGN_EPI) { if (wr == 0) PG8_BAR; }
    PG8_BAR;
    if constexpr (Epi::AFTER_DRAIN) { E.fused(acc, cur, wr, wc, fr, fq, lds, wid, lane); S.done(cur); }
#undef PG8_SA
#undef PG8_SB
#undef PG8_STAGE
#undef PG8_LDA
#undef PG8_LDB
#undef PG8_MMA
#undef PG8_WAIT_V
#undef PG8_WAIT_L
#undef PG8_BAR
#undef PG8_SCHED
}
}

#define LAS __attribute__((address_space(3)))
#define GAS __attribute__((address_space(1)))
typedef unsigned short bf16;
typedef short bf16x8 __attribute__((ext_vector_type(8)));
typedef short s16x4 __attribute__((ext_vector_type(4)));
typedef float f32x4 __attribute__((ext_vector_type(4)));
typedef float f32x16 __attribute__((ext_vector_type(16)));
typedef unsigned u32x4 __attribute__((ext_vector_type(4)));
typedef unsigned u32x2 __attribute__((ext_vector_type(2)));
typedef float f32x2_t __attribute__((ext_vector_type(2)));
typedef __bf16 bf16x2_t __attribute__((ext_vector_type(2)));

constexpr int BATCH = 4, SEQ = 8192, DM = 1024, M = BATCH * SEQ;
constexpr int NMEM = 256;
constexpr int PLD = 6400;
constexpr int C_AQ = 0, C_AK = 512, C_AV = 640, C_DQ = 768, C_DK = 1280, C_DV = 1792, C_DZ = 2304, C_MQ = 2816, C_GATE = 3328;
constexpr int C_MG = 768, C_X1B = 1792, C_ACT = 2816;
constexpr int NIN = 6656;
constexpr int DFF = 2816, NUP = 5632;
constexpr float EPS = 1e-6f;
constexpr float LOG2E = 1.4426950408889634f;

__device__ __forceinline__ float bf_lo(unsigned w) { return __uint_as_float(w << 16); }
__device__ __forceinline__ float bf_hi(unsigned w) { return __uint_as_float(w & 0xffff0000u); }
__device__ __forceinline__ unsigned pk2(float lo, float hi) { f32x2_t v = {lo, hi}; bf16x2_t b = __builtin_convertvector(v, bf16x2_t); return __builtin_bit_cast(unsigned, b); }
__device__ __forceinline__ float fexp2(float x) { return __builtin_amdgcn_exp2f(x); }
__device__ __forceinline__ float frcp(float x) { return __builtin_amdgcn_rcpf(x); }
__device__ __forceinline__ float sigmoidf_(float x) { return frcp(1.0f + fexp2(-x * LOG2E)); }
__device__ __forceinline__ float siluf_(float x) { return x * sigmoidf_(x); }
__device__ __forceinline__ void unpack8(const u32x4 w, float (&v)[8]) {
    v[0] = bf_lo(w.x); v[1] = bf_hi(w.x); v[2] = bf_lo(w.y); v[3] = bf_hi(w.y); v[4] = bf_lo(w.z); v[5] = bf_hi(w.z); v[6] = bf_lo(w.w); v[7] = bf_hi(w.w); }
__device__ __forceinline__ u32x4 pack8(const float (&v)[8]) { u32x4 w; w.x = pk2(v[0], v[1]); w.y = pk2(v[2], v[3]); w.z = pk2(v[4], v[5]); w.w = pk2(v[6], v[7]); return w; }

using pg8::Unit;
constexpr int HALF = pg8::HALF, BM = pg8::BM;

struct EpiInProj {
    static constexpr bool PERM = true, AFTER_DRAIN = false, PREFETCH = false, RESCALE = false;
    bf16* P; float* BA;
    __device__ __forceinline__ void operator()(const f32x4 (&acc)[2][2][4][2], const Unit& u, int wr, int wc, int fr, int fq) const {
        const int row0 = u.pm * BM + wr * 64 + fr;
        if (u.pn < 13) {
            const int col0 = u.pn * BM + wc * 32 + 8 * fq;
#pragma unroll
            for (int ai = 0; ai < 2; ++ai)
#pragma unroll
                for (int m = 0; m < 4; ++m) { bf16* rowp = P + (size_t)(row0 + ai * HALF + m * 16) * PLD + col0;
#pragma unroll
                    for (int bj = 0; bj < 2; ++bj) { const f32x4 v0 = acc[ai][bj][m][0], v1 = acc[ai][bj][m][1];
                        u32x4 w; w.x = pk2(v0[0], v0[1]); w.y = pk2(v0[2], v0[3]); w.z = pk2(v1[0], v1[1]); w.w = pk2(v1[2], v1[3]);
                        *(u32x4*)(rowp + bj * HALF) = w; } }
        } else if (wc == 0) {
#pragma unroll
            for (int ai = 0; ai < 2; ++ai)
#pragma unroll
                for (int m = 0; m < 4; ++m) { float* rp = BA + (size_t)(row0 + ai * HALF + m * 16) * 32 + 8 * fq;
                    *(f32x4*)rp = acc[ai][0][m][0]; *(f32x4*)(rp + 4) = acc[ai][0][m][1]; }
        }
    }
};
struct EpiBf16 {
    static constexpr bool PERM = true, AFTER_DRAIN = false, PREFETCH = false, RESCALE = false;
    bf16* O; int ldc;
    __device__ __forceinline__ void operator()(const f32x4 (&acc)[2][2][4][2], const Unit& u, int wr, int wc, int fr, int fq) const {
        const int row0 = u.pm * BM + wr * 64 + fr, col0 = u.pn * BM + wc * 32 + 8 * fq;
#pragma unroll
        for (int ai = 0; ai < 2; ++ai)
#pragma unroll
            for (int m = 0; m < 4; ++m) { bf16* rowp = O + (size_t)(row0 + ai * HALF + m * 16) * ldc + col0;
#pragma unroll
                for (int bj = 0; bj < 2; ++bj) { const f32x4 v0 = acc[ai][bj][m][0], v1 = acc[ai][bj][m][1];
                    u32x4 w; w.x = pk2(v0[0], v0[1]); w.y = pk2(v0[2], v0[3]); w.z = pk2(v1[0], v1[1]); w.w = pk2(v1[2], v1[3]);
                    *(u32x4*)(rowp + bj * HALF) = w; } }
    }
};
template <int PASS> struct EpiBranch {
    static constexpr bool PERM = true, AFTER_DRAIN = false, PREFETCH = false, RESCALE = false;
    bf16* P;
    __device__ __forceinline__ void operator()(const f32x4 (&acc)[2][2][4][2], const Unit& u, int wr, int wc, int fr, int fq) const {
        const int row0 = u.pm * BM + wr * 64 + fr, col0 = u.pn * BM + wc * 32 + 8 * fq;
#pragma unroll
        for (int ai = 0; ai < 2; ++ai)
#pragma unroll
            for (int m = 0; m < 4; ++m) { bf16* rowp = P + (size_t)(row0 + ai * HALF + m * 16) * PLD;
#pragma unroll
                for (int bj = 0; bj < 2; ++bj) {
                    const int c = col0 + bj * HALF;
                    const u32x4 gw = *(const u32x4*)(rowp + C_GATE + 1024 * PASS + c);
                    float g[8]; unpack8(gw, g);
                    float pv[8];
                    if (PASS > 0) { const u32x4 mw = *(const u32x4*)(rowp + C_MG + c); unpack8(mw, pv); }
                    else {
#pragma unroll
                        for (int i = 0; i < 8; ++i) pv[i] = 0.f; }
                    const f32x4 v0 = acc[ai][bj][m][0], v1 = acc[ai][bj][m][1];
                    float o[8];
#pragma unroll
                    for (int i = 0; i < 4; ++i) { o[i] = pv[i] + sigmoidf_(g[i]) * v0[i]; o[4 + i] = pv[4 + i] + sigmoidf_(g[4 + i]) * v1[i]; }
                    *(u32x4*)(rowp + C_MG + c) = pack8(o); } }
    }
};
struct EpiMerge {
    static constexpr bool PERM = true, AFTER_DRAIN = false, PREFETCH = false, RESCALE = true;
    bf16* P;
    __device__ __forceinline__ void rescale(f32x4 (&acc)[2][2][4][2], const Unit& u, int wr, int wc, int fr, int fq, int stage) const {
        asm volatile("" : "+v"(fr), "+v"(fq));
        const int row0 = u.pm * BM + wr * 64 + fr, col0 = u.pn * BM + wc * 32 + 8 * fq;
#pragma unroll
        for (int ai = 0; ai < 2; ++ai) {
#pragma unroll
            for (int m = 0; m < 4; ++m) { const bf16* rowp = P + (size_t)(row0 + ai * HALF + m * 16) * PLD + C_GATE + 1024 * (stage - 1) + col0;
#pragma unroll
                for (int bj = 0; bj < 2; ++bj) { float gx[8], gy[8]; unpack8(*(const u32x4*)(rowp + bj * HALF), gx); unpack8(*(const u32x4*)(rowp + 1024 + bj * HALF), gy);
#pragma unroll
                    for (int i = 0; i < 4; ++i) { acc[ai][bj][m][0][i] *= (1.0f + fexp2(-gy[i] * LOG2E)) * frcp(1.0f + fexp2(-gx[i] * LOG2E));
                        acc[ai][bj][m][1][i] *= (1.0f + fexp2(-gy[4 + i] * LOG2E)) * frcp(1.0f + fexp2(-gx[4 + i] * LOG2E)); } }
                if (m == 3) asm volatile("" ::: "memory"); } }
    }
    __device__ __forceinline__ void operator()(const f32x4 (&acc)[2][2][4][2], const Unit& u, int wr, int wc, int fr, int fq) const {
        const int row0 = u.pm * BM + wr * 64 + fr, col0 = u.pn * BM + wc * 32 + 8 * fq;
#pragma unroll
        for (int ai = 0; ai < 2; ++ai)
#pragma unroll
            for (int m = 0; m < 4; ++m) { bf16* rowp = P + (size_t)(row0 + ai * HALF + m * 16) * PLD;
#pragma unroll
                for (int bj = 0; bj < 2; ++bj) { const int c = col0 + bj * HALF; float g[8], o[8]; unpack8(*(const u32x4*)(rowp + C_GATE + 2048 + c), g);
                    const f32x4 v0 = acc[ai][bj][m][0], v1 = acc[ai][bj][m][1];
#pragma unroll
                    for (int i = 0; i < 4; ++i) { o[i] = sigmoidf_(g[i]) * v0[i]; o[4 + i] = sigmoidf_(g[4 + i]) * v1[i]; }
                    *(u32x4*)(rowp + C_MG + c) = pack8(o); } }
    }
};
struct EpiWout {
    static constexpr bool PERM = true, AFTER_DRAIN = false, PREFETCH = false, RESCALE = false;
    const float* x; float* out; bf16* P; float* SSQ; LAS float* xl;
    __device__ __forceinline__ void operator()(const f32x4 (&acc)[2][2][4][2], const Unit& u, int wr, int wc, int fr, int fq) const {
        const int row0 = u.pm * BM + wr * 64 + fr, col0 = u.pn * BM + wc * 32 + 8 * fq;
#pragma unroll
        for (int ai = 0; ai < 2; ++ai)
#pragma unroll
            for (int m = 0; m < 4; ++m) { const int row = row0 + ai * HALF + m * 16; float ss = 0.f;
#pragma unroll
                for (int bj = 0; bj < 2; ++bj) { const int c = col0 + bj * HALF; const size_t off = (size_t)row * DM + c;
                    const f32x4 a0 = *(const f32x4*)(x + off), a1 = *(const f32x4*)(x + off + 4);
                    const f32x4 r0 = a0 + acc[ai][bj][m][0], r1 = a1 + acc[ai][bj][m][1];
                    *(f32x4*)(out + off) = r0; *(f32x4*)(out + off + 4) = r1;
                    ss += (r0[0] * r0[0] + r0[1] * r0[1]) + (r0[2] * r0[2] + r0[3] * r0[3]) + (r1[0] * r1[0] + r1[1] * r1[1]) + (r1[2] * r1[2] + r1[3] * r1[3]);
                    u32x4 w; w.x = pk2(r0[0], r0[1]); w.y = pk2(r0[2], r0[3]); w.z = pk2(r1[0], r1[1]); w.w = pk2(r1[2], r1[3]);
                    *(u32x4*)(P + (size_t)row * PLD + C_X1B + c) = w; }
                ss += __shfl_xor(ss, 16); ss += __shfl_xor(ss, 32);
                if (fq == 0) xl[(ai * HALF + wr * 64 + m * 16 + fr) * 4 + wc] = ss; }
        asm volatile("s_waitcnt lgkmcnt(0)" ::: "memory"); __builtin_amdgcn_s_barrier(); asm volatile("" ::: "memory");
        { const int t = (wr * 4 + wc) * 64 + fq * 16 + fr;
          if (t < 256) { const f32x4 p = *(const LAS f32x4*)(xl + t * 4); SSQ[(size_t)(u.pm * BM + t) * 4 + u.pn] = (p[0] + p[1]) + (p[2] + p[3]); } }
        asm volatile("s_waitcnt lgkmcnt(0)" ::: "memory"); __builtin_amdgcn_s_barrier(); asm volatile("" ::: "memory");
    }
};
template <int CTRL> __device__ __forceinline__ float dpp_mov(float old, float src) {
    return __builtin_bit_cast(float, __builtin_amdgcn_update_dpp(__builtin_bit_cast(int, old), __builtin_bit_cast(int, src), CTRL, 0xF, 0xF, false)); }
struct EpiUp {
    static constexpr bool PERM = true, AFTER_DRAIN = false, PREFETCH = true, RESCALE = false;
    const float* SSQ; const float* cw; const float* cb; bf16* P; float* UE; LAS float* xl;
    __device__ __forceinline__ void prefetch(const Unit& u, int buf, int tid) const {
        LAS float* d = xl + buf * 1280;
        if (tid < 256) { const int a = tid >> 5, c4 = (tid & 31) * 4, ch = u.pn * 128 + c4 + (a >= 4 ? DFF : 0), aa = a & 3;
            *(LAS f32x4*)(d + a * 128 + c4) = *(const f32x4*)((aa < 3 ? cw + aa * NUP : cb) + ch); }
        else { const int r = tid - 256; const f32x4 q = *(const f32x4*)(SSQ + (size_t)(u.pm * BM + r) * 4);
            d[1024 + r] = __builtin_amdgcn_rsqf(((q[0] + q[1]) + (q[2] + q[3])) * (1.0f / DM) + EPS); }
    }
    __device__ __forceinline__ void operator()(f32x4 (&acc)[2][2][4][2], const Unit& u, int wr, int wc, int fr, int fq) const {
        const int row0 = u.pm * BM + wr * 64 + fr;
        const LAS float* lw = xl + u.aux * 1280;
#pragma unroll
        for (int ai = 0; ai < 2; ++ai)
#pragma unroll
            for (int m = 0; m < 4; ++m) { const float rs = lw[1024 + ai * HALF + wr * 64 + m * 16 + fr];
#pragma unroll
                for (int bj = 0; bj < 2; ++bj)
#pragma unroll
                    for (int n = 0; n < 2; ++n) acc[ai][bj][m][n] *= rs; }
#pragma unroll
        for (int n = 0; n < 2; ++n) {
            const int c4 = wc * 32 + 8 * fq + 4 * n, a0 = u.pn * 128 + c4;
            const f32x4 wg0 = *(const LAS f32x4*)(lw + c4), wg1 = *(const LAS f32x4*)(lw + 128 + c4), wg2 = *(const LAS f32x4*)(lw + 256 + c4), bg = *(const LAS f32x4*)(lw + 384 + c4);
            const f32x4 wv0 = *(const LAS f32x4*)(lw + 512 + c4), wv1 = *(const LAS f32x4*)(lw + 640 + c4), wv2 = *(const LAS f32x4*)(lw + 768 + c4), bv = *(const LAS f32x4*)(lw + 896 + c4);
#pragma unroll
            for (int ai = 0; ai < 2; ++ai) {
                const int g64 = u.pm * 4 + ai * 2 + wr;
#pragma unroll
                for (int m = 0; m < 4; ++m) {
                    const f32x4 ugm = acc[ai][0][m][n], uvm = acc[ai][1][m][n], ugp = acc[ai][0][(m + 3) & 3][n], ugn = acc[ai][0][(m + 1) & 3][n], uvp = acc[ai][1][(m + 3) & 3][n], uvn = acc[ai][1][(m + 1) & 3][n];
                    f32x4 pg, ng, pvv, nv;
#pragma unroll
                    for (int i = 0; i < 4; ++i) {
                        pg[i] = dpp_mov<0x111>(dpp_mov<0x121>(0.f, ugp[i]), ugm[i]);
                        ng[i] = dpp_mov<0x101>(dpp_mov<0x12F>(0.f, ugn[i]), ugm[i]);
                        pvv[i] = dpp_mov<0x111>(dpp_mov<0x121>(0.f, uvp[i]), uvm[i]);
                        nv[i] = dpp_mov<0x101>(dpp_mov<0x12F>(0.f, uvn[i]), uvm[i]); }
                    const f32x4 gate = wg0 * pg + wg1 * ugm + wg2 * ng + bg;
                    const f32x4 val = wv0 * pvv + wv1 * uvm + wv2 * nv + bv;
                    const int row = row0 + ai * HALF + m * 16;
                    const bool edge = (m == 0 && fr == 0) || (m == 3 && fr == 15);
                    if (!edge) { u32x2 w; w.x = pk2(siluf_(gate[0]) * val[0], siluf_(gate[1]) * val[1]); w.y = pk2(siluf_(gate[2]) * val[2], siluf_(gate[3]) * val[3]);
                        *(u32x2*)(P + (size_t)row * PLD + C_ACT + a0) = w; }
                    if ((m == 0 && fr < 2) || (m == 3 && fr >= 14)) { const int slot = (m == 0) ? fr : fr - 12;
                        float* ue = UE + ((size_t)g64 * 4 + slot) * NUP;
                        *(f32x4*)(ue + a0) = ugm; *(f32x4*)(ue + DFF + a0) = uvm; }
                }
            }
        }
    }
};
struct EpiDown {
    static constexpr bool PERM = true, AFTER_DRAIN = false, PREFETCH = false, RESCALE = false;
    float* out;
    __device__ __forceinline__ void operator()(const f32x4 (&acc)[2][2][4][2], const Unit& u, int wr, int wc, int fr, int fq) const {
        const int row0 = u.pm * BM + wr * 64 + fr, col0 = u.pn * BM + wc * 32 + 8 * fq;
#pragma unroll
        for (int ai = 0; ai < 2; ++ai)
#pragma unroll
            for (int m = 0; m < 4; ++m) {
#pragma unroll
                for (int bj = 0; bj < 2; ++bj) { const size_t off = (size_t)(row0 + ai * HALF + m * 16) * DM + col0 + bj * HALF;
                    const f32x4 a0 = *(const f32x4*)(out + off), a1 = *(const f32x4*)(out + off + 4);
                    *(f32x4*)(out + off) = a0 + acc[ai][bj][m][0]; *(f32x4*)(out + off + 4) = a1 + acc[ai][bj][m][1]; } }
    }
};

template <int DH, int RSK, int RSV>
__device__ __forceinline__ void attn_tile(const LAS unsigned char* Kl, const LAS unsigned char* Vl, int jk, const bf16x8 (&qf)[DH / 16], f32x16 s0, f32x16 s1,
                                          float& m, float& l, f32x16 (&o)[DH / 32], int lane) {
    const int r32 = lane & 31, hi = lane >> 5;
    const LAS unsigned char* kp = Kl + (size_t)(jk + r32) * RSK + 16 * hi;
#pragma unroll
    for (int ks = 0; ks < DH / 16; ++ks) {
        const bf16x8 k0 = *(const LAS bf16x8*)(kp + 32 * ks), k1 = *(const LAS bf16x8*)(kp + 32 * RSK + 32 * ks);
        s0 = __builtin_amdgcn_mfma_f32_32x32x16_bf16(k0, qf[ks], s0, 0, 0, 0);
        s1 = __builtin_amdgcn_mfma_f32_32x32x16_bf16(k1, qf[ks], s1, 0, 0, 0);
    }
    const int g = lane >> 4, q4 = (lane & 15) >> 2, p = lane & 3;
    const unsigned va = (unsigned)(uintptr_t)Vl + (unsigned)(jk + 4 * hi + q4) * RSV + (16 * (g & 1) + 4 * p) * 2;
    s16x4 vlo[2][4], vhi[2][4];
#define ATT_VREAD(set, db) do { _Pragma("unroll") for (int kk = 0; kk < 4; ++kk) { \
        asm volatile("ds_read_b64_tr_b16 %0, %1 offset:%c2" : "=&v"(vlo[set][kk]) : "v"(va), "i"((16 * kk) * RSV + 64 * (db)) : "memory"); \
        asm volatile("ds_read_b64_tr_b16 %0, %1 offset:%c2" : "=&v"(vhi[set][kk]) : "v"(va), "i"((16 * kk + 8) * RSV + 64 * (db)) : "memory"); } } while (0)
    ATT_VREAD(0, 0);
    float mx = fmaxf(s0[0], s1[0]);
#pragma unroll
    for (int r = 1; r < 16; ++r) mx = fmaxf(mx, fmaxf(s0[r], s1[r]));
    mx = fmaxf(mx, __shfl_xor(mx, 32));
    const float mn = fmaxf(m, mx), f = fexp2(m - mn);
    m = mn; l *= f;
#pragma unroll
    for (int db = 0; db < DH / 32; ++db)
#pragma unroll
        for (int r = 0; r < 16; ++r) o[db][r] *= f;
    float ps = 0.f;
#pragma unroll
    for (int r = 0; r < 16; ++r) { s0[r] = fexp2(s0[r] - mn); s1[r] = fexp2(s1[r] - mn); ps += s0[r] + s1[r]; }
    l += ps;
    bf16x8 pf[4];
    { u32x4 w;
      w.x = pk2(s0[0], s0[1]); w.y = pk2(s0[2], s0[3]); w.z = pk2(s0[4], s0[5]); w.w = pk2(s0[6], s0[7]); pf[0] = __builtin_bit_cast(bf16x8, w);
      w.x = pk2(s0[8], s0[9]); w.y = pk2(s0[10], s0[11]); w.z = pk2(s0[12], s0[13]); w.w = pk2(s0[14], s0[15]); pf[1] = __builtin_bit_cast(bf16x8, w);
      w.x = pk2(s1[0], s1[1]); w.y = pk2(s1[2], s1[3]); w.z = pk2(s1[4], s1[5]); w.w = pk2(s1[6], s1[7]); pf[2] = __builtin_bit_cast(bf16x8, w);
      w.x = pk2(s1[8], s1[9]); w.y = pk2(s1[10], s1[11]); w.z = pk2(s1[12], s1[13]); w.w = pk2(s1[14], s1[15]); pf[3] = __builtin_bit_cast(bf16x8, w); }
#pragma unroll
    for (int db = 0; db < DH / 32; ++db) {
        asm volatile("s_waitcnt lgkmcnt(0)" ::: "memory"); __builtin_amdgcn_sched_barrier(0);
        if (db + 1 < DH / 32) { if ((db & 1) == 0) ATT_VREAD(1, db + 1); else ATT_VREAD(0, db + 1); }
#pragma unroll
        for (int kk = 0; kk < 4; ++kk) { const s16x4 lo = vlo[db & 1][kk], h4 = vhi[db & 1][kk];
            const bf16x8 vf = (bf16x8){lo[0], lo[1], lo[2], lo[3], h4[0], h4[1], h4[2], h4[3]};
            o[db] = __builtin_amdgcn_mfma_f32_32x32x16_bf16(vf, pf[kk], o[db], 0, 0, 0); }
        __builtin_amdgcn_sched_barrier(0);
    }
#undef ATT_VREAD
}
__device__ __forceinline__ void load_bias(const float* biasrow, int hi, f32x16& s0, f32x16& s1) {
#pragma unroll
    for (int g4 = 0; g4 < 4; ++g4) { const f32x4 c0 = *(const f32x4*)(biasrow + 8 * g4 + 4 * hi), c1 = *(const f32x4*)(biasrow + 32 + 8 * g4 + 4 * hi);
#pragma unroll
        for (int i = 0; i < 4; ++i) { s0[4 * g4 + i] = c0[i]; s1[4 * g4 + i] = c1[i]; } }
}
template <int DH>
__device__ __forceinline__ void load_q(const bf16* qrow, const float* gq, float scale, bf16x8 (&qf)[DH / 16], int lane) {
    const int hi = lane >> 5;
    u32x4 w[DH / 16]; float ss = 0.f;
#pragma unroll
    for (int ks = 0; ks < DH / 16; ++ks) { w[ks] = *(const u32x4*)(qrow + 16 * ks + 8 * hi); float v[8]; unpack8(w[ks], v);
#pragma unroll
        for (int j = 0; j < 8; ++j) ss += v[j] * v[j]; }
    ss += __shfl_xor(ss, 32);
    const float rstd = __builtin_amdgcn_rsqf(ss * (1.0f / DH) + EPS) * scale;
#pragma unroll
    for (int ks = 0; ks < DH / 16; ++ks) { float v[8]; unpack8(w[ks], v);
        const f32x4 g0 = *(const f32x4*)(gq + 16 * ks + 8 * hi), g1 = *(const f32x4*)(gq + 16 * ks + 8 * hi + 4);
#pragma unroll
        for (int j = 0; j < 4; ++j) { v[j] *= rstd * g0[j]; v[4 + j] *= rstd * g1[j]; }
        qf[ks] = __builtin_bit_cast(bf16x8, pack8(v)); }
}
template <int DH>
__device__ __forceinline__ void store_o(bf16* yrow, const f32x16 (&o)[DH / 32], float l, int lane) {
    const int hi = lane >> 5;
    const float inv = frcp(l + __shfl_xor(l, 32));
#pragma unroll
    for (int db = 0; db < DH / 32; ++db)
#pragma unroll
        for (int g4 = 0; g4 < 4; ++g4) { u32x2 w; w.x = pk2(o[db][4 * g4] * inv, o[db][4 * g4 + 1] * inv); w.y = pk2(o[db][4 * g4 + 2] * inv, o[db][4 * g4 + 3] * inv);
            *(u32x2*)(yrow + 32 * db + 8 * g4 + 4 * hi) = w; }
}
template <int DH, int RSK, int RSV>
__device__ __forceinline__ void stage_kv(LAS unsigned char* Kl, LAS unsigned char* Vl, int ldsrow0, const bf16* src, size_t pitch, int kcol, int vcol, int nrows, const float* gk, int tid) {
    constexpr int CPR = DH / 8;
    for (int c = tid; c < nrows * CPR; c += 512) {
        const int row = c / CPR, ch = c % CPR;
        const bf16* rp = src + (size_t)row * pitch;
        const u32x4 kw = *(const u32x4*)(rp + kcol + ch * 8), vw = *(const u32x4*)(rp + vcol + ch * 8);
        float v[8]; unpack8(kw, v); float ss = 0.f;
#pragma unroll
        for (int j = 0; j < 8; ++j) ss += v[j] * v[j];
#pragma unroll
        for (int o = 1; o < CPR; o <<= 1) ss += __shfl_xor(ss, o);
        const float rstd = __builtin_amdgcn_rsqf(ss * (1.0f / DH) + EPS);
        const f32x4 g0 = *(const f32x4*)(gk + ch * 8), g1 = *(const f32x4*)(gk + ch * 8 + 4);
#pragma unroll
        for (int j = 0; j < 4; ++j) { v[j] *= rstd * g0[j]; v[4 + j] *= rstd * g1[j]; }
        *(LAS u32x4*)(Kl + (size_t)(ldsrow0 + row) * RSK + ch * 16) = pack8(v);
        *(LAS u32x4*)(Vl + (size_t)(ldsrow0 + row) * RSV + ch * 16) = vw;
    }
}

constexpr int NWAVES = 8;
constexpr size_t MiB = 1u << 20;
constexpr size_t WS_CTL = 0, CTL_ZERO_BYTES = 1 * MiB;
constexpr size_t WS_WIN = 2 * MiB;
constexpr size_t WS_WBR = 15 * MiB;
constexpr size_t WS_WOUT = 18 * MiB;
constexpr size_t WS_WUP = 20 * MiB;
constexpr size_t WS_WDN = 31 * MiB;
constexpr size_t WS_WKV = 37 * MiB;
constexpr size_t WS_MEMN = 39 * MiB;
constexpr size_t WS_KV = 41 * MiB;
constexpr size_t WS_BT = 43 * MiB;
constexpr size_t WS_BA = 45 * MiB;
constexpr size_t WS_SSQ = 49 * MiB;
constexpr size_t WS_P = 52 * MiB;
constexpr size_t WS_UE = 452 * MiB;
constexpr size_t WS_END = 512 * MiB;
static_assert(WS_P + (size_t)M * PLD * 2 == WS_UE && WS_UE + (size_t)512 * 4 * NUP * 4 <= WS_END, "d_ws map");

constexpr int CW_TMO = 0, CW_CODE = 1;
constexpr int CW_BAR = 4096;
constexpr int RING_OFF = 0, RING_BYTES = 147456;
constexpr int LDSCTL_OFF = RING_BYTES, MISC_OFF = LDSCTL_OFF + 320;
constexpr int XCH_OFF = MISC_OFF + 256;
constexpr int LDS_BYTES = 163840;
static_assert(XCH_OFF + 2 * 1280 * 4 <= LDS_BYTES && XCH_OFF % 16 == 0, "LDS map");

typedef GAS unsigned gu32;
#define RLX_AGENT __ATOMIC_RELAXED, __HIP_MEMORY_SCOPE_AGENT
#define LDS_WAIT() asm volatile("s_waitcnt lgkmcnt(0)" ::: "memory")
#define VM_WAIT() asm volatile("s_waitcnt vmcnt(0)" ::: "memory")

#define XB_TMO      128
#define XB_XCNT(j)  (256  + 64 * (j))
#define XB_XSUB(j)  (1280 + 64 * (j))
#define XB_XGEN(j)  (2304 + 64 * (j))
#define XB_TOP      3328
#define XB_TOPGEN   3392
#define XCD_BAR_WORDS 3456
#define XB_SPIN_CAP (1u << 22)

__device__ __forceinline__ unsigned xb_ld(unsigned* p)              { return __hip_atomic_load(p, __ATOMIC_RELAXED, __HIP_MEMORY_SCOPE_AGENT); }
__device__ __forceinline__ unsigned xb_add(unsigned* p, unsigned v) { return __hip_atomic_fetch_add(p, v, __ATOMIC_RELAXED, __HIP_MEMORY_SCOPE_AGENT); }
__device__ __forceinline__ unsigned xb_xcc_id() { return (unsigned)__builtin_amdgcn_s_getreg((3 << 11) | 20) & 0xFu; }
#define XB_SPIN(cond, bar) do { unsigned _sp = 0; while (cond) { __builtin_amdgcn_s_sleep(1); \
    if ((++_sp & 255u) == 0u) { if (xb_ld(&(bar)[XB_TMO])) break; if (_sp > XB_SPIN_CAP) { atomicAdd(&(bar)[XB_TMO], 1u); break; } } } } while (0)

struct XcdBarrier { unsigned* bar; unsigned x; volatile LAS unsigned* st; };

__device__ __forceinline__ XcdBarrier xcd_barrier_post(unsigned* bar, volatile LAS unsigned* st) {
    XcdBarrier b; b.bar = bar; b.x = xb_xcc_id(); b.st = st;
    if (threadIdx.x == 0) (void)xb_add(&bar[XB_XCNT(b.x)], 1u);
    return b;
}
__device__ __forceinline__ void xcd_barrier_complete(unsigned* bar, unsigned x, unsigned& nloc, unsigned& nx) {
    const unsigned G = gridDim.x * gridDim.y * gridDim.z;
    unsigned sum, cnt, mine, sp = 0u;
    for (;;) {
        sum = 0u; cnt = 0u; mine = 0u;
#pragma unroll
        for (unsigned j = 0; j < 16; ++j) { const unsigned c = xb_ld(&bar[XB_XCNT(j)]); sum += c; cnt += (c > 0u) ? 1u : 0u; mine = (j == x) ? c : mine; }
        if (sum == G) break;
        __builtin_amdgcn_s_sleep(1);
        if ((++sp & 255u) == 0u) { if (xb_ld(&bar[XB_TMO])) break; if (sp > XB_SPIN_CAP) { atomicAdd(&bar[XB_TMO], 1u); break; } }
    }
    nloc = mine > 0u ? mine : 1u; nx = cnt > 0u ? cnt : 1u;
}
__device__ __forceinline__ void xcd_barrier(const XcdBarrier& b) {
    asm volatile("s_waitcnt vmcnt(0)" ::: "memory");
    __syncthreads();
    if (threadIdx.x == 0) {
        unsigned* bar = b.bar;
        __builtin_amdgcn_s_waitcnt(0);
        unsigned nloc = b.st[0], nx = b.st[1];
        if (nloc == 0u) { xcd_barrier_complete(bar, b.x, nloc, nx); b.st[0] = nloc; b.st[1] = nx; }
        const unsigned old = xb_add(&bar[XB_XSUB(b.x)], 1u);
        const unsigned gen = old / nloc;
        if (old + 1u == (gen + 1u) * nloc) {
            __builtin_amdgcn_fence(__ATOMIC_RELEASE, "agent");
            asm volatile("s_waitcnt vmcnt(0)" ::: "memory");
            const unsigned og = xb_add(&bar[XB_TOP], 1u);
            const unsigned tg = og / nx;
            if (og + 1u == (tg + 1u) * nx) xb_add(&bar[XB_TOPGEN], 1u);
            else XB_SPIN(xb_ld(&bar[XB_TOPGEN]) == tg, bar);
            __builtin_amdgcn_fence(__ATOMIC_ACQUIRE, "agent");
            xb_add(&bar[XB_XGEN(b.x)], 1u);
            asm volatile("s_waitcnt vmcnt(0)" ::: "memory");
        } else {
            XB_SPIN(xb_ld(&bar[XB_XGEN(b.x)]) == gen, bar);
            __builtin_amdgcn_fence(__ATOMIC_ACQUIRE, "agent");
            asm volatile("s_waitcnt vmcnt(0)" ::: "memory");
        }
    }
    __syncthreads();
}

struct Frame {
    LAS unsigned char* lds;
    volatile LAS unsigned* MISC;
    gu32* ctl;
    int tid, lane, wave, vcu, G;
};

__device__ __forceinline__ float wave_sum(float v) {
#pragma unroll
    for (int o = 1; o < 64; o <<= 1) v += __shfl_xor(v, o);
    return v;
}
__device__ __forceinline__ int t5_bucket(int rel) {
    const int n = rel < 0 ? -rel : rel;
    const int mag = n < 8 ? n : n < 12 ? 8 : n < 16 ? 9 : n < 23 ? 10 : n < 32 ? 11 : n < 46 ? 12 : n < 64 ? 13 : n < 91 ? 14 : 15;
    return (rel > 0 ? 16 : 0) + mag;
}

__device__ __forceinline__ void transpose_item(const float* W, int K, int N, int k0, int n0, bf16* WT, int drow0, const float* gk, LAS float* scr, int lane) {
    { f32x4 v[8];
#pragma unroll
      for (int i = 0; i < 8; ++i) v[i] = *(const f32x4*)(W + (size_t)(k0 + 8 * i + (lane >> 3)) * N + n0 + 4 * (lane & 7));
#pragma unroll
      for (int i = 0; i < 8; ++i) { const int kk = 8 * i + (lane >> 3); const float gs = gk ? gk[k0 + kk] : 1.0f; LAS float* d = scr + kk * 33 + 4 * (lane & 7);
          d[0] = v[i][0] * gs; d[1] = v[i][1] * gs; d[2] = v[i][2] * gs; d[3] = v[i][3] * gs; } }
    LDS_WAIT(); asm volatile("" ::: "memory");
    const int c = lane & 7;
#pragma unroll
    for (int j = 0; j < 4; ++j) { const int n = (lane >> 3) + 8 * j; const LAS float* s = scr + (8 * c) * 33 + n;
        u32x4 o; o.x = pk2(s[0 * 33], s[1 * 33]); o.y = pk2(s[2 * 33], s[3 * 33]); o.z = pk2(s[4 * 33], s[5 * 33]); o.w = pk2(s[6 * 33], s[7 * 33]);
        *(GAS u32x4*)(WT + (size_t)(drow0 + n) * K + k0 + 8 * c) = o; }
    LDS_WAIT(); asm volatile("" ::: "memory");
}
__device__ __forceinline__ void rms_row_to_bf16(const float* xrow, const float* g, bf16* orow, int lane) {
    const GAS f32x4* xr = (const GAS f32x4*)xrow + lane;
    const GAS f32x4* gr = (const GAS f32x4*)g + lane;
    f32x4 v[4]; float s = 0.f;
#pragma unroll
    for (int j = 0; j < 4; ++j) { v[j] = xr[64 * j]; s += (v[j].x * v[j].x + v[j].y * v[j].y) + (v[j].z * v[j].z + v[j].w * v[j].w); }
    const float rstd = __builtin_amdgcn_rsqf(wave_sum(s) * (1.f / DM) + EPS);
    GAS unsigned long long* o8 = (GAS unsigned long long*)orow + lane;
#pragma unroll
    for (int j = 0; j < 4; ++j) { const f32x4 gg = gr[64 * j];
        o8[64 * j] = (unsigned long long)pk2(v[j].x * rstd * gg.x, v[j].y * rstd * gg.y) | ((unsigned long long)pk2(v[j].z * rstd * gg.z, v[j].w * rstd * gg.w) << 32); }
}

__device__ __forceinline__ void rms_row2_to_bf16(const float* xa, const float* xb, const float* g, bf16* oa, bf16* ob, int lane) {
    const GAS f32x4* xr0 = (const GAS f32x4*)xa + lane; const GAS f32x4* xr1 = (const GAS f32x4*)xb + lane;
    const GAS f32x4* gr = (const GAS f32x4*)g + lane;
    f32x4 v0[4], v1[4]; float s0 = 0.f, s1 = 0.f;
#pragma unroll
    for (int j = 0; j < 4; ++j) { v0[j] = xr0[64 * j]; v1[j] = xr1[64 * j]; }
#pragma unroll
    for (int j = 0; j < 4; ++j) { s0 += (v0[j].x * v0[j].x + v0[j].y * v0[j].y) + (v0[j].z * v0[j].z + v0[j].w * v0[j].w); s1 += (v1[j].x * v1[j].x + v1[j].y * v1[j].y) + (v1[j].z * v1[j].z + v1[j].w * v1[j].w); }
#pragma unroll
    for (int o = 1; o < 64; o <<= 1) { s0 += __shfl_xor(s0, o); s1 += __shfl_xor(s1, o); }
    const float r0 = __builtin_amdgcn_rsqf(s0 * (1.f / DM) + EPS), r1 = __builtin_amdgcn_rsqf(s1 * (1.f / DM) + EPS);
    GAS unsigned long long* o0 = (GAS unsigned long long*)oa + lane; GAS unsigned long long* o1 = (GAS unsigned long long*)ob + lane;
#pragma unroll
    for (int j = 0; j < 4; ++j) { const f32x4 gg = gr[64 * j];
        o0[64 * j] = (unsigned long long)pk2(v0[j].x * r0 * gg.x, v0[j].y * r0 * gg.y) | ((unsigned long long)pk2(v0[j].z * r0 * gg.z, v0[j].w * r0 * gg.w) << 32);
        o1[64 * j] = (unsigned long long)pk2(v1[j].x * r1 * gg.x, v1[j].y * r1 * gg.y) | ((unsigned long long)pk2(v1[j].z * r1 * gg.z, v1[j].w * r1 * gg.w) << 32); }
}

struct Args { const float* in[25]; float* out; unsigned char* ws; int ph_lo, ph_hi, mode, pad; };

__device__ __forceinline__ void p0_prologue(Frame& F, const Args& a) {
    unsigned char* ws = a.ws;
    LAS float* scr = (LAS float*)(F.lds + RING_OFF + F.wave * 16384);
    const int gw = F.vcu * NWAVES + F.wave, NGW = F.G * NWAVES;
    constexpr int I_IN = 16 * 201, I_BR = 8 * 32, I_OUT = 16 * 32, I_UP = 16 * 176, I_DN = 44 * 32, I_KV = 16 * 32;
    constexpr int NITEMS = I_IN + 3 * I_BR + I_OUT + I_UP + I_DN + I_KV;
    for (int it = gw; it < NITEMS; it += NGW) {
        int r = it;
        if (r < I_IN) { const int kb = r / 201, nb = r % 201, n0 = nb * 32;
            const int d0 = n0 < 2816 ? n0 : (n0 < 2848 ? 3328 + (n0 - 2816) : (n0 < 3360 ? n0 - 32 : 3584 + (n0 - 3360)));
            transpose_item(a.in[4], 1024, 6432, kb * 64, n0, (bf16*)(ws + WS_WIN), d0, nullptr, scr, F.lane); continue; }
        r -= I_IN;
        if (r < 3 * I_BR) { const int br = r / I_BR, q = r % I_BR, kb = q / 32, nb = q % 32;
            transpose_item(a.in[16 + br], 512, 1024, kb * 64, nb * 32, (bf16*)(ws + WS_WBR) + (size_t)br * 1024 * 512, nb * 32, nullptr, scr, F.lane); continue; }
        r -= 3 * I_BR;
        if (r < I_OUT) { const int kb = r / 32, nb = r % 32;
            transpose_item(a.in[19], 1024, 1024, kb * 64, nb * 32, (bf16*)(ws + WS_WOUT), nb * 32, nullptr, scr, F.lane); continue; }
        r -= I_OUT;
        if (r < I_UP) { const int kb = r / 176, nb = r % 176, n0 = nb * 32;
            const int isv = n0 >= DFF, nn = isv ? n0 - DFF : n0, d0 = (nn >> 7) * 256 + isv * 128 + (nn & 127);
            transpose_item(a.in[21], 1024, NUP, kb * 64, n0, (bf16*)(ws + WS_WUP), d0, a.in[20], scr, F.lane); continue; }
        r -= I_UP;
        if (r < I_DN) { const int kb = r / 32, nb = r % 32;
            transpose_item(a.in[24], DFF, 1024, kb * 64, nb * 32, (bf16*)(ws + WS_WDN), nb * 32, nullptr, scr, F.lane); continue; }
        r -= I_DN;
        { const int kb = r / 32, nb = r % 32;
            transpose_item(a.in[13], 1024, 1024, kb * 64, nb * 32, (bf16*)(ws + WS_WKV), nb * 32, nullptr, scr, F.lane); }
    }
    { u32x4* z = (u32x4*)((bf16*)(ws + WS_WIN) + (size_t)3360 * 1024); const int n16 = 224 * 1024 * 2 / 16;
      for (int i = blockIdx.x * 512 + F.tid; i < n16; i += F.G * 512) z[i] = (u32x4){0u, 0u, 0u, 0u}; }
    bf16* H = (bf16*)a.out;
    if (M % (2 * NGW) != 0) { for (int m = gw; m < M; m += NGW) rms_row_to_bf16(a.in[0] + (size_t)m * DM, a.in[3], H + (size_t)m * DM, F.lane); }
    else for (int m = gw; m < M; m += 2 * NGW) rms_row2_to_bf16(a.in[0] + (size_t)m * DM, a.in[0] + (size_t)(m + NGW) * DM, a.in[3], H + (size_t)m * DM, H + (size_t)(m + NGW) * DM, F.lane);
    for (int m = gw; m < BATCH * NMEM; m += NGW) rms_row_to_bf16(a.in[1] + (size_t)m * DM, a.in[12], (bf16*)(ws + WS_MEMN) + (size_t)m * DM, F.lane);
    { float* BT = (float*)(ws + WS_BT); const float* tab = a.in[2];
      for (int i = blockIdx.x * 512 + F.tid; i < 8 * 128 * 384; i += F.G * 512) { const int j = i % 384, t = (i / 384) % 128, h = i / (384 * 128);
          const int rel = j - 128 - t; const bool ok = rel >= -128 && rel <= 128;
          BT[i] = ok ? tab[t5_bucket(rel) * 8 + h] * LOG2E : -INFINITY; } }
}

__device__ __forceinline__ void attnA_unit(Frame& F, const Args& a, int b, int n, int kvh) {
    constexpr int RSK = 144, RSV = 128;
    LAS unsigned char* Kl = F.lds; LAS unsigned char* Vl = F.lds + 384 * RSK;
    bf16* P = (bf16*)(a.ws + WS_P);
    const float* BT = (const float*)(a.ws + WS_BT);
    for (int blk = 0; blk < 3; ++blk) { const int pos0 = n * 128 - 128 + blk * 128; if (pos0 < 0 || pos0 >= SEQ) continue;
        stage_kv<64, RSK, RSV>(Kl, Vl, blk * 128, P + (size_t)(b * SEQ + pos0) * PLD, PLD, C_AK + kvh * 64, C_AV + kvh * 64, 128, a.in[6], F.tid); }
    LDS_WAIT(); __syncthreads();
    const int h = kvh * 4 + (F.wave >> 1), r32 = F.lane & 31, hi = F.lane >> 5;
    const float sink = a.in[7][h] * LOG2E;
#pragma unroll 1
    for (int qb = 0; qb < 2; ++qb) {
        const int t0 = (F.wave & 1) * 64 + qb * 32, t = t0 + r32;
        bf16* qrow = P + (size_t)(b * SEQ + n * 128 + t) * PLD + C_AQ + h * 64;
        bf16x8 qf[4]; load_q<64>(qrow, a.in[5], 0.125f * LOG2E, qf, F.lane);
        float m = sink, l = hi == 0 ? 1.f : 0.f; f32x16 o[2];
#pragma unroll
        for (int r = 0; r < 16; ++r) { o[0][r] = 0.f; o[1][r] = 0.f; }
        const int lo = max(t0 >= 64 ? 1 : 0, n == 0 ? 2 : 0), hi_t = min(t0 >= 64 ? 5 : 4, n == SEQ / 128 - 1 ? 3 : 5);
        const float* brow = BT + ((size_t)h * 128 + t) * 384;
        f32x16 b0, b1; load_bias(brow + 64 * lo, hi, b0, b1);
#pragma unroll 1
        for (int kt = lo; kt <= hi_t; ++kt) {
            f32x16 nb0 = b0, nb1 = b1;
            if (kt < hi_t) load_bias(brow + 64 * (kt + 1), hi, nb0, nb1);
            attn_tile<64, RSK, RSV>(Kl, Vl, 64 * kt, qf, b0, b1, m, l, o, F.lane);
            b0 = nb0; b1 = nb1; }
        store_o<64>(qrow, o, l, F.lane);
    }
    LDS_WAIT(); __syncthreads();
}
__device__ __forceinline__ void xattn_unit(Frame& F, const Args& a, int b, int tb, int h) {
    constexpr int RSK = 272, RSV = 320;
    LAS unsigned char* Kl = F.lds; LAS unsigned char* Vl = F.lds + 128 * RSK;
    bf16* P = (bf16*)(a.ws + WS_P);
    const bf16* KV = (const bf16*)(a.ws + WS_KV);
    const int r32 = F.lane & 31;
    bf16* qrow = P + (size_t)(b * SEQ + tb * 256 + F.wave * 32 + r32) * PLD + C_MQ + h * 128;
    bf16x8 qf[8]; load_q<128>(qrow, a.in[14], 0.08838834764831845f * LOG2E, qf, F.lane);
    float m = -1e30f, l = 0.f; f32x16 o[4];
#pragma unroll
    for (int db = 0; db < 4; ++db)
#pragma unroll
        for (int r = 0; r < 16; ++r) o[db][r] = 0.f;
#pragma unroll 1
    for (int half = 0; half < 2; ++half) {
        stage_kv<128, RSK, RSV>(Kl, Vl, 0, KV + (size_t)(b * NMEM + half * 128) * 1024, 1024, h * 128, 512 + h * 128, 128, a.in[15], F.tid);
        LDS_WAIT(); __syncthreads();
#pragma unroll 1
        for (int kt = 0; kt < 2; ++kt) { f32x16 z0, z1;
#pragma unroll
            for (int r = 0; r < 16; ++r) { z0[r] = 0.f; z1[r] = 0.f; }
            attn_tile<128, RSK, RSV>(Kl, Vl, 64 * kt, qf, z0, z1, m, l, o, F.lane); }
        LDS_WAIT(); __syncthreads();
    }
    store_o<128>(qrow, o, l, F.lane);
}


constexpr int SAF = C_GATE, SCF = C_GATE + 512, SBF = C_GATE + 1024, SDF = C_GATE + 1536, SAB = C_GATE + 2048, SCB = C_GATE + 2560;
constexpr int C_OF = C_DQ, C_OB = C_DK;
__device__ __forceinline__ int dn_pcol(int x) { return (x & 32) + 8 * ((x & 15) >> 2) + 4 * ((x >> 4) & 1) + (x & 3); }
__device__ __forceinline__ bf16x8 frag_lo(const LAS unsigned char* p) { const u32x2 a0 = *(const LAS u32x2*)p; u32x4 w; w.x = a0.x; w.y = a0.y; w.z = 0u; w.w = 0u; return __builtin_bit_cast(bf16x8, w); }
__device__ __forceinline__ bf16x8 frag_2(const LAS unsigned char* p) { const u32x2 a0 = *(const LAS u32x2*)p, a1 = *(const LAS u32x2*)(p + 32); u32x4 w; w.x = a0.x; w.y = a0.y; w.z = a1.x; w.w = a1.y; return __builtin_bit_cast(bf16x8, w); }
__device__ __forceinline__ bf16x8 pack_f4z(const f32x4 a) { u32x4 w; w.x = pk2(a[0], a[1]); w.y = pk2(a[2], a[3]); w.z = 0u; w.w = 0u; return __builtin_bit_cast(bf16x8, w); }
__device__ __forceinline__ bf16x8 pack_f4f4(const f32x4 a, const f32x4 b) { u32x4 w; w.x = pk2(a[0], a[1]); w.y = pk2(a[2], a[3]); w.z = pk2(b[0], b[1]); w.w = pk2(b[2], b[3]); return __builtin_bit_cast(bf16x8, w); }
__device__ __forceinline__ void dn_prep_block(Frame& F, const Args& a, int b, int h, int c0, int nch) {
    LAS float* raw = (LAS float*)(F.lds);
    LAS unsigned char* NL = F.lds;
    LAS unsigned char* TD = F.lds + 18432;
    LAS unsigned char* Qb = F.lds + 53248;
    LAS unsigned char* Kb = F.lds + 62464;
    LAS unsigned char* Vb = F.lds + 71680;
    LAS float* sm = (LAS float*)(F.lds + 80896);
    LAS float* gt = sm;
    LAS float* btk = sm + 128;
    LAS float* gct = sm + 256;
    LAS float* cu = sm + 384;
    LAS float* cwp = sm + 512;
    LAS float* egp = sm + 640;
    LAS float* esp = sm + 768;
    LAS unsigned char* QKL = F.lds + 24576;
    LAS unsigned char* KT = F.lds + 84480;
    LAS unsigned char* QT = F.lds + 104960;
    bf16* P = (bf16*)(a.ws + WS_P);
    float* BA = (float*)(a.ws + WS_BA);
    bf16* XB2 = (bf16*)a.out + (size_t)M * 1024;
    const float* cw = a.in[8];
    const int w = F.wave, lane = F.lane, tid = F.tid;
    float wt[3][5];
#pragma unroll
    for (int which = 0; which < 3; ++which)
#pragma unroll
        for (int j = 0; j < 5; ++j) wt[which][j] = cw[j * 1536 + which * 512 + h * 64 + lane];
    const float Ah = expf(a.in[9][(tid >> 6 & 1) * 8 + h]), dtb = a.in[10][(tid >> 6 & 1) * 8 + h];
    u32x4 rr[4]; float pa = 0.f, pb = 0.f;
#define DN_PREFETCH(cidx) do { const int t0p_ = (cidx) * 64; \
        _Pragma("unroll") for (int i_ = 0; i_ < 4; ++i_) { const int e = tid + 512 * i_, row = e / 24, c8 = e % 24, which = c8 >> 3, t = t0p_ - 2 + row; \
            rr[i_] = (u32x4){0u, 0u, 0u, 0u}; \
            if (e < 68 * 24 && t >= 0 && t < SEQ) rr[i_] = *(const u32x4*)(P + ((size_t)b * SEQ + t) * PLD + (which == 0 ? C_DQ : which == 1 ? C_DK : C_DV) + h * 64 + (c8 & 7) * 8); } \
        if (tid < 128) { const size_t tok = (size_t)b * SEQ + t0p_ + (tid & 63); pa = BA[tok * 32 + 16 + (tid >> 6) * 8 + h]; pb = BA[tok * 32 + (tid >> 6) * 8 + h]; } } while (0)
    DN_PREFETCH(c0);
#pragma unroll 1
  for (int ci = 0; ci < nch; ++ci) {
    int tid_o = F.tid; asm volatile("" : "+v"(tid_o));
    const int tid = tid_o, lane = tid & 63;
    const int c = c0 + ci, t0 = c * 64;
    const size_t tok0 = (size_t)b * SEQ + t0;
#pragma unroll
    for (int i_ = 0; i_ < 4; ++i_) { const int e = tid + 512 * i_, row = e / 24, c8 = e % 24;
        if (e < 68 * 24) { float v[8]; unpack8(rr[i_], v);
            *(LAS f32x4*)(raw + row * 192 + c8 * 8) = (f32x4){v[0], v[1], v[2], v[3]}; *(LAS f32x4*)(raw + row * 192 + c8 * 8 + 4) = (f32x4){v[4], v[5], v[6], v[7]}; } }
    if (tid < 128) { const int d = tid >> 6, i = tid & 63; const float xa = pa + dtb;
        gt[d * 64 + i] = -Ah * (fmaxf(xa, 0.f) + __logf(1.0f + __expf(-fabsf(xa))));
        btk[d * 64 + i] = sigmoidf_(pb); }
    if (ci + 1 < nch) DN_PREFETCH(c + 1);
    LDS_WAIT(); __syncthreads();
#pragma unroll
    for (int which = 0; which < 3; ++which) {
        float x[12], y[8];
#pragma unroll
        for (int j = 0; j < 12; ++j) x[j] = raw[(w * 8 + j) * 192 + which * 64 + lane];
#pragma unroll
        for (int r = 0; r < 8; ++r) { float acc = 0.f;
#pragma unroll
            for (int j = 0; j < 5; ++j) acc += x[r + j] * wt[which][j];
            y[r] = siluf_(acc); }
        if (which < 2) {
            float ss[8];
#pragma unroll
            for (int r = 0; r < 8; ++r) ss[r] = y[r] * y[r];
#pragma unroll
            for (int o = 1; o < 64; o <<= 1)
#pragma unroll
                for (int r = 0; r < 8; ++r) ss[r] += __shfl_xor(ss[r], o);
#pragma unroll
            for (int r = 0; r < 8; ++r) y[r] *= __builtin_amdgcn_rsqf(ss[r] + EPS) * (which == 0 ? 0.125f : 1.0f);
        }
        LAS unsigned char* X = which == 0 ? Qb : which == 1 ? Kb : Vb;
#pragma unroll
        for (int r = 0; r < 8; ++r) *(LAS bf16*)(X + (w * 8 + r) * 144 + lane * 2) = (bf16)(pk2(y[r], 0.f) & 0xffffu);
        asm volatile("" ::: "memory");
    }
    if (w < 2) { const int i = w ? 63 - lane : lane; float gv = gt[w * 64 + i];
#pragma unroll
        for (int o = 1; o < 64; o <<= 1) { const float t = __shfl_up(gv, o); if (lane >= o) gv += t; }
        const float glast = __shfl(gv, 63), bt = btk[w * 64 + i], eg = __expf(gv);
        const float es = __expf(glast - gv);
        gct[w * 64 + i] = gv; cu[w * 64 + lane] = bt; cwp[w * 64 + lane] = bt * eg; egp[w * 64 + lane] = eg; esp[w * 64 + lane] = es;
        BA[(tok0 + lane) * 32 + w * 8 + h] = eg; }
    LDS_WAIT(); __syncthreads();
    { const int p = tid >> 3, c8 = tid & 7;
#pragma unroll
      for (int d = 0; d < 2; ++d) { const int i = d ? 63 - p : p; const float es = esp[d * 64 + p], eg = egp[d * 64 + p]; float v[8];
          unpack8(*(const LAS u32x4*)(Kb + i * 144 + c8 * 16), v);
#pragma unroll
          for (int j = 0; j < 8; ++j) v[j] *= es;
          *(LAS u32x4*)(KT + d * 10240 + p * 160 + c8 * 16) = pack8(v);
          unpack8(*(const LAS u32x4*)(Qb + i * 144 + c8 * 16), v);
#pragma unroll
          for (int j = 0; j < 8; ++j) v[j] *= eg;
          *(LAS u32x4*)(QT + d * 9216 + p * 144 + c8 * 16) = pack8(v); } }
    { const int wq = w & 3, tm = wq >> 1, tn = wq & 1, r32 = lane & 31, hi = lane >> 5;
      const LAS unsigned char* X = (w < 4) ? Kb : Qb;
      f32x16 acc;
#pragma unroll
      for (int r = 0; r < 16; ++r) acc[r] = 0.f;
#pragma unroll
      for (int kst = 0; kst < 4; ++kst) {
          const bf16x8 af = *(const LAS bf16x8*)(X + (32 * tm + r32) * 144 + (16 * kst + 8 * hi) * 2), bfr = *(const LAS bf16x8*)(Kb + (32 * tn + r32) * 144 + (16 * kst + 8 * hi) * 2);
          acc = __builtin_amdgcn_mfma_f32_32x32x16_bf16(af, bfr, acc, 0, 0, 0); }
      const int j = 32 * tn + r32; const float gjf = gct[j], gjb = gct[64 + j];
#pragma unroll
      for (int g4 = 0; g4 < 4; ++g4) { const int i0 = 32 * tm + 8 * g4 + 4 * hi;
          const f32x4 gif = *(const LAS f32x4*)(gct + i0), gib = *(const LAS f32x4*)(gct + 64 + i0), bif = *(const LAS f32x4*)(btk + i0), bib = *(const LAS f32x4*)(btk + 64 + i0);
#pragma unroll
          for (int q = 0; q < 4; ++q) { const int i = i0 + q; const float v = acc[4 * g4 + q];
              const float ef = __expf(fminf(gif[q] - gjf, 0.f)), eb = __expf(fminf(gib[q] - gjb, 0.f));
              if (w < 4) {
                  const float lf = (j < i) ? -bif[q] * v * ef : 0.f, lb = (j > i) ? -bib[q] * v * eb : 0.f;
                  *(LAS bf16*)(NL + i * 144 + j * 2) = (bf16)(pk2(lf, 0.f) & 0xffffu);
                  *(LAS bf16*)(NL + 9216 + (63 - i) * 144 + (63 - j) * 2) = (bf16)(pk2(lb, 0.f) & 0xffffu);
              } else {
                  const float qf = (j <= i) ? v * ef : 0.f, qb = (j >= i) ? v * eb : 0.f;
                  *(LAS bf16*)(QKL + i * 144 + j * 2) = (bf16)(pk2(qf, 0.f) & 0xffffu);
                  *(LAS bf16*)(QKL + 9216 + (63 - i) * 144 + (63 - j) * 2) = (bf16)(pk2(qb, 0.f) & 0xffffu);
              } } } }
    LDS_WAIT(); __syncthreads();
    if (w < 2) { const int blk = lane >> 4, col = lane & 15; const LAS unsigned char* nl = NL + w * 9216 + (16 * blk) * 144 + (16 * blk) * 2;
        u32x4 lr[16][2];
#pragma unroll
        for (int r = 1; r < 16; ++r) { lr[r][0] = *(const LAS u32x4*)(nl + r * 144); if (r > 8) lr[r][1] = *(const LAS u32x4*)(nl + r * 144 + 16); }
        float t[16];
#pragma unroll
        for (int r = 0; r < 16; ++r) { float a0 = (r == col) ? 1.f : 0.f, a1 = 0.f;
            if (r > 0) { float l[16]; { float l8[8]; unpack8(lr[r][0], l8);
#pragma unroll
                    for (int q = 0; q < 8; ++q) l[q] = l8[q]; }
                if (r > 8) { float l8[8]; unpack8(lr[r][1], l8);
#pragma unroll
                    for (int q = 0; q < 8; ++q) l[8 + q] = l8[q]; }
#pragma unroll
                for (int q = 0; q < r; ++q) { if (q & 1) a1 += l[q] * t[q]; else a0 += l[q] * t[q]; } }
            t[r] = a0 + a1; }
#pragma unroll
        for (int r = 0; r < 16; ++r) *(LAS bf16*)(TD + w * 3072 + blk * 768 + r * 48 + col * 2) = (bf16)(pk2(t[r], 0.f) & 0xffffu);
    }
    LDS_WAIT(); __syncthreads();
    { const int d = w >> 2, cc = lane & 15, g = lane >> 4;
      const LAS unsigned char* nl = NL + d * 9216; const LAS unsigned char* td = TD + d * 3072 + cc * 48 + 8 * g;
#pragma unroll
      for (int jj = 0; jj < 2; ++jj) { const int ct = 2 * (w & 3) + jj, part = ct >> 2, colb = 16 * (ct & 3);
          const LAS unsigned char* src = part ? Kb : Vb; const LAS float* coef = (part ? cwp : cu) + d * 64;
          f32x4 R[4];
#pragma unroll
          for (int bq = 0; bq < 4; ++bq) { const f32x4 cf = *(const LAS f32x4*)(coef + 16 * bq + 4 * g);
#pragma unroll
              for (int r = 0; r < 4; ++r) { const int p = 16 * bq + 4 * g + r, i = d ? 63 - p : p;
                  R[bq][r] = cf[r] * __uint_as_float((unsigned)(*(const LAS bf16*)(src + i * 144 + (colb + cc) * 2)) << 16); } }
          const f32x4 z4 = (f32x4){0.f, 0.f, 0.f, 0.f};
          f32x4 X0, X1, X2, X3, Y;
          const bf16x8 t0f = frag_lo(td), t1f = frag_lo(td + 768), t2f = frag_lo(td + 2 * 768), t3f = frag_lo(td + 3 * 768);
          const bf16x8 n1f = frag_lo(nl + (16 + cc) * 144 + 8 * g), n2f = frag_2(nl + (32 + cc) * 144 + 8 * g), n3f = frag_2(nl + (48 + cc) * 144 + 8 * g), n3g = frag_lo(nl + (48 + cc) * 144 + 64 + 8 * g);
          __builtin_amdgcn_sched_barrier(0);
          X0 = __builtin_amdgcn_mfma_f32_16x16x32_bf16(t0f, pack_f4z(R[0]), z4, 0, 0, 0);
          Y = __builtin_amdgcn_mfma_f32_16x16x32_bf16(n1f, pack_f4z(X0), R[1], 0, 0, 0);
          X1 = __builtin_amdgcn_mfma_f32_16x16x32_bf16(t1f, pack_f4z(Y), z4, 0, 0, 0);
          const bf16x8 x01 = pack_f4f4(X0, X1);
          Y = __builtin_amdgcn_mfma_f32_16x16x32_bf16(n2f, x01, R[2], 0, 0, 0);
          X2 = __builtin_amdgcn_mfma_f32_16x16x32_bf16(t2f, pack_f4z(Y), z4, 0, 0, 0);
          Y = __builtin_amdgcn_mfma_f32_16x16x32_bf16(n3f, x01, R[3], 0, 0, 0);
          Y = __builtin_amdgcn_mfma_f32_16x16x32_bf16(n3g, pack_f4z(X2), Y, 0, 0, 0);
          X3 = __builtin_amdgcn_mfma_f32_16x16x32_bf16(t3f, pack_f4z(Y), z4, 0, 0, 0);
          const float sgn = part ? -1.f : 1.f;
          const bf16x8 xb0 = pack_f4f4(X0 * sgn, X1 * sgn), xb1 = pack_f4f4(X2 * sgn, X3 * sgn);
          const int q4 = (lane & 15) >> 2, pp = lane & 3;
          const LAS unsigned char* qkl = QKL + d * 9216; const LAS unsigned char* qtl = QT + d * 9216;
          bf16* pA = (d == 0 || part == 1) ? P + tok0 * PLD + h * 64 + (part ? (d ? SAB : SAF) : SBF) : XB2 + tok0 * 512 + h * 64;
          bf16* pC = (d == 0 || part == 1) ? P + tok0 * PLD + h * 64 + (part ? (d ? SCB : SCF) : SDF) : XB2 + (size_t)M * 512 + tok0 * 512 + h * 64;
          const size_t pit = (d == 0 || part == 1) ? PLD : 512;
          const int pc = dn_pcol(colb + cc);
#pragma unroll
          for (int mt = 0; mt < 4; ++mt) {
              s16x4 klo[2], khi[2]; bf16x8 qkf[2]; f32x4 acc2;
              { const unsigned ka = (unsigned)(uintptr_t)(KT + d * 10240) + (4 * g + q4) * 160u + (16 * mt + 4 * pp) * 2u;
                asm volatile("ds_read_b64_tr_b16 %0, %1" : "=&v"(klo[0]) : "v"(ka) : "memory");
                asm volatile("ds_read_b64_tr_b16 %0, %1 offset:2560" : "=&v"(khi[0]) : "v"(ka) : "memory");
                asm volatile("ds_read_b64_tr_b16 %0, %1 offset:5120" : "=&v"(klo[1]) : "v"(ka) : "memory");
                asm volatile("ds_read_b64_tr_b16 %0, %1 offset:7680" : "=&v"(khi[1]) : "v"(ka) : "memory"); }
#pragma unroll
              for (int ks = 0; ks < 2; ++ks) { if (ks == 1 && mt < 2) continue; qkf[ks] = frag_2(qkl + (16 * mt + cc) * 144 + (32 * ks + 4 * g) * 2); }
#pragma unroll
              for (int r = 0; r < 4; ++r) acc2[r] = part ? __uint_as_float((unsigned)(*(const LAS bf16*)(qtl + (16 * mt + 4 * g + r) * 144 + (colb + cc) * 2)) << 16) : 0.f;
              asm volatile("s_waitcnt lgkmcnt(0)" ::: "memory"); __builtin_amdgcn_sched_barrier(0);
              f32x4 acc = z4;
#pragma unroll
              for (int ks = 0; ks < 2; ++ks) { const bf16x8 kf = (bf16x8){klo[ks][0], klo[ks][1], klo[ks][2], klo[ks][3], khi[ks][0], khi[ks][1], khi[ks][2], khi[ks][3]};
                  acc = __builtin_amdgcn_mfma_f32_16x16x32_bf16(kf, ks ? xb1 : xb0, acc, 0, 0, 0); }
#pragma unroll
              for (int ks = 0; ks < 2; ++ks) { if (ks == 1 && mt < 2) continue; acc2 = __builtin_amdgcn_mfma_f32_16x16x32_bf16(qkf[ks], ks ? xb1 : xb0, acc2, 0, 0, 0); }
              if (part == 0) {
                  u32x2 o; o.x = pk2(acc[0], acc[1]); o.y = pk2(acc[2], acc[3]); *(u32x2*)(pA + (size_t)(colb + cc) * pit + 16 * mt + 4 * g) = o;
                  o.x = pk2(acc2[0], acc2[1]); o.y = pk2(acc2[2], acc2[3]); *(u32x2*)(pC + (size_t)(colb + cc) * pit + 16 * mt + 4 * g) = o; }
              else {
#pragma unroll
                  for (int r = 0; r < 4; ++r) { pA[(size_t)(16 * mt + 4 * g + r) * pit + pc] = (bf16)(pk2(acc[r], 0.f) & 0xffffu); pC[(size_t)(16 * mt + 4 * g + r) * pit + pc] = (bf16)(pk2(acc2[r], 0.f) & 0xffffu); } }
              __builtin_amdgcn_sched_barrier(0);
          }
          asm volatile("" ::: "memory"); __builtin_amdgcn_sched_barrier(0);
      } }
    LDS_WAIT(); __syncthreads();
  }
#undef DN_PREFETCH
}

constexpr int DNX_A = 0, DNX_C = 8192, DNX_BT = 16384, DNX_DT = 24576, DNX_EG = 32768, DNX_SZ = 33792, DNX_OST = 3 * DNX_SZ;
__device__ __forceinline__ void dn_scan_step(const LAS unsigned char* buf, f32x4 (&Sacc)[4], int ws, int lane, LAS unsigned char* ost, int dir) {
    const int c = lane & 15, g = lane >> 4;
    const unsigned trow = 16 * ws + c, t0 = trow * 128u + ((((unsigned)(g >> 1)) ^ ((trow >> 1) & 7u)) << 4) + 8u * (g & 1);
    u32x2 bt[4], dt[4]; bf16x8 af[4][2], cf[4][2];
#pragma unroll
    for (int mt = 0; mt < 4; ++mt) { const unsigned row = 16 * mt + c, a0 = row * 128u + ((((unsigned)g) ^ ((row >> 1) & 7u)) << 4);
        bt[mt] = *(const LAS u32x2*)(buf + DNX_BT + (t0 ^ ((unsigned)mt << 5)));
#pragma unroll
        for (int ks = 0; ks < 2; ++ks) af[mt][ks] = *(const LAS bf16x8*)(buf + DNX_A + (a0 ^ ((unsigned)ks << 6))); }
#pragma unroll
    for (int mt = 0; mt < 4; ++mt) { const unsigned row = 16 * mt + c, a0 = row * 128u + ((((unsigned)g) ^ ((row >> 1) & 7u)) << 4);
        dt[mt] = *(const LAS u32x2*)(buf + DNX_DT + (t0 ^ ((unsigned)mt << 5)));
#pragma unroll
        for (int ks = 0; ks < 2; ++ks) cf[mt][ks] = *(const LAS bf16x8*)(buf + DNX_C + (a0 ^ ((unsigned)ks << 6))); }
    const float gm = ((const LAS float*)(buf + DNX_EG))[63];
    bf16x8 Sb[2];
#pragma unroll
    for (int ks = 0; ks < 2; ++ks) Sb[ks] = pack_f4f4(Sacc[2 * ks], Sacc[2 * ks + 1]);
    __builtin_amdgcn_sched_barrier(0);
#pragma unroll
    for (int mt = 0; mt < 4; ++mt) { f32x4 sn = Sacc[mt] * gm + (f32x4){bf_lo(bt[mt].x), bf_hi(bt[mt].x), bf_lo(bt[mt].y), bf_hi(bt[mt].y)};
#pragma unroll
        for (int ks = 0; ks < 2; ++ks) sn = __builtin_amdgcn_mfma_f32_16x16x32_bf16(af[mt][ks], Sb[ks], sn, 0, 0, 0);
        Sacc[mt] = sn; }
#pragma unroll
    for (int mt = 0; mt < 4; ++mt) { f32x4 oa = (f32x4){bf_lo(dt[mt].x), bf_hi(dt[mt].x), bf_lo(dt[mt].y), bf_hi(dt[mt].y)};
#pragma unroll
        for (int ks = 0; ks < 2; ++ks) oa = __builtin_amdgcn_mfma_f32_16x16x32_bf16(cf[mt][ks], Sb[ks], oa, 0, 0, 0);
#pragma unroll
        for (int r = 0; r < 4; ++r) { const int p = 16 * mt + 4 * g + r, i = dir ? 63 - p : p;
            *(LAS bf16*)(ost + i * 128 + (16 * ws + c) * 2) = (bf16)(pk2(oa[r], 0.f) & 0xffffu); } }
}
__device__ __forceinline__ void dn_scan_unit(Frame& F, const Args& a, int b, int h, int dir) {
    bf16* P = (bf16*)(a.ws + WS_P);
    const int w = F.wave, lane = F.lane;
#define DN_BAR() do { asm volatile("s_waitcnt lgkmcnt(0)" ::: "memory"); __builtin_amdgcn_s_barrier(); asm volatile("" ::: "memory"); } while (0)
    if (w < 4) {
        f32x4 Sacc[4];
#pragma unroll
        for (int mt = 0; mt < 4; ++mt) Sacc[mt] = (f32x4){0.f, 0.f, 0.f, 0.f};
        bf16* Ob = P + (size_t)b * SEQ * PLD + (dir ? C_OB : C_OF) + h * 64;
        DN_BAR();
        int slot = 0;
#pragma unroll 1
        for (int s = 0; s <= 128; ++s) {
            if (s > 0) { const int cp = dir ? 128 - s : s - 1; const LAS unsigned char* st = F.lds + DNX_OST + ((s - 1) & 1) * 8192;
#pragma unroll
                for (int k = 0; k < 2; ++k) { const int idx = F.tid + 256 * k, row = idx >> 3, ch = idx & 7;
                    *(u32x4*)(Ob + ((size_t)cp * 64 + row) * PLD + ch * 8) = *(const LAS u32x4*)(st + row * 128 + ch * 16); } }
            if (s < 128) dn_scan_step(F.lds + slot * DNX_SZ, Sacc, w, lane, F.lds + DNX_OST + (s & 1) * 8192, dir);
            slot = slot == 2 ? 0 : slot + 1;
            DN_BAR();
        }
    } else {
        const int hw = w - 4;
        const bf16* XB2 = (const bf16*)a.out + (size_t)M * 1024;
        const float* BAg = (const float*)(a.ws + WS_BA);
        const char* gp[8]; long gstep[8];
#pragma unroll
        for (int i = 0; i < 8; ++i) { const int pid = hw * 8 + i, blk = pid >> 3, pc = pid & 7, r = 8 * pc + (lane >> 3), cp = lane & 7;
            const int key = (r >> 1) & 7, cs = cp ^ key;
            const size_t tokb = (size_t)b * SEQ;
            if (dir == 1 && blk >= 2) { gp[i] = (const char*)(XB2 + (size_t)(blk - 2) * M * 512 + (tokb + r) * 512 + h * 64 + cs * 8); gstep[i] = 64L * 512 * 2; }
            else { const int col = blk == 0 ? (dir ? SAB : SAF) : blk == 1 ? (dir ? SCB : SCF) : blk == 2 ? SBF : SDF;
                   gp[i] = (const char*)(P + (tokb + r) * PLD + col + h * 64 + cs * 8); gstep[i] = 64L * PLD * 2; } }
        const char* ggc = (const char*)(BAg + ((size_t)b * SEQ + lane) * 32 + dir * 8 + h);
#define DN_ISSUE(n, slot_) do { const int cn_ = dir ? 127 - (n) : (n); LAS unsigned char* sb_ = F.lds + (slot_) * DNX_SZ; \
        _Pragma("unroll") for (int i = 0; i < 8; ++i) { const int pid = hw * 8 + i; \
            __builtin_amdgcn_global_load_lds((const unsigned*)(gp[i] + (long)cn_ * gstep[i]), (LAS unsigned*)(sb_ + (pid >> 3) * 8192 + (pid & 7) * 1024), 16, 0, 0); } \
        __builtin_amdgcn_global_load_lds((const unsigned*)(ggc + (long)cn_ * (64L * 32 * 4)), (LAS unsigned*)(sb_ + DNX_EG + hw * 256), 4, 0, 0); } while (0)
        DN_ISSUE(0, 0); DN_ISSUE(1, 1);
        asm volatile("s_waitcnt vmcnt(9)" ::: "memory");
        DN_BAR();
        int slot2 = 2;
#pragma unroll 1
        for (int s = 0; s <= 128; ++s) {
            if (s + 2 < 128) { DN_ISSUE(s + 2, slot2); asm volatile("s_waitcnt vmcnt(9)" ::: "memory"); }
            else { asm volatile("s_waitcnt vmcnt(0)" ::: "memory"); }
            slot2 = slot2 == 2 ? 0 : slot2 + 1;
            DN_BAR();
        }
#undef DN_ISSUE
    }
#undef DN_BAR
    __syncthreads();
}
__device__ __forceinline__ void dn_combine(Frame& F, const Args& a) {
    bf16* P = (bf16*)(a.ws + WS_P);
    const float* og = a.in[11];
    const int gw = F.vcu * NWAVES + F.wave, NGW = F.G * NWAVES, c0 = F.lane * 8;
    for (int row = gw; row < M; row += NGW) {
        bf16* rp = P + (size_t)row * PLD;
        float of[8], ob[8]; unpack8(*(const u32x4*)(rp + C_OF + c0), of); unpack8(*(const u32x4*)(rp + C_OB + c0), ob);
        float s[8], ss = 0.f;
#pragma unroll
        for (int j = 0; j < 8; ++j) { s[j] = of[j] + ob[j]; ss += s[j] * s[j]; }
        ss += __shfl_xor(ss, 1); ss += __shfl_xor(ss, 2); ss += __shfl_xor(ss, 4);
        const float rstd = __builtin_amdgcn_rsqf(ss * (1.0f / 64) + EPS);
        bf16* zp = rp + C_DZ + c0; float z[8]; unpack8(*(const u32x4*)zp, z);
        const f32x4 g0 = *(const f32x4*)(og + (c0 & 63)), g1 = *(const f32x4*)(og + (c0 & 63) + 4);
        float y[8];
#pragma unroll
        for (int j = 0; j < 4; ++j) { y[j] = s[j] * rstd * g0[j] * siluf_(z[j]); y[4 + j] = s[4 + j] * rstd * g1[j] * siluf_(z[4 + j]); }
        *(u32x4*)zp = pack8(y);
    }
}
__device__ __forceinline__ void ffn_fixup_panel(Frame& F, const Args& a, int pm) {
    bf16* P = (bf16*)(a.ws + WS_P); const float* UE = (const float*)(a.ws + WS_UE);
    const float* cw = a.in[22]; const float* cb = a.in[23];
#pragma unroll 2
    for (int e = F.tid; e < 8 * (DFF / 4); e += 512) { const int k = e / (DFF / 4), ch = (e % (DFF / 4)) * 4, g = pm * 4 + (k >> 1), last = k & 1;
        const int row = g * 64 + (last ? 63 : 0);
        const bool hp = last ? true : (row % SEQ) != 0, hn = last ? (row % SEQ) != SEQ - 1 : true;
        const float* pu = UE + ((size_t)(last ? g : (g > 0 ? g - 1 : 0)) * 4 + (last ? 2 : 3)) * NUP;
        const float* cu = UE + ((size_t)g * 4 + (last ? 3 : 0)) * NUP;
        const float* nu = UE + ((size_t)(last ? (g < 511 ? g + 1 : 511) : g) * 4 + (last ? 0 : 1)) * NUP;
        const f32x4 z = (f32x4){0.f, 0.f, 0.f, 0.f};
        const f32x4 pg = hp ? *(const f32x4*)(pu + ch) : z, pv = hp ? *(const f32x4*)(pu + DFF + ch) : z, ng = hn ? *(const f32x4*)(nu + ch) : z, nv = hn ? *(const f32x4*)(nu + DFF + ch) : z;
        const f32x4 cg = *(const f32x4*)(cu + ch), cv = *(const f32x4*)(cu + DFF + ch);
        const f32x4 gate = *(const f32x4*)(cw + ch) * pg + *(const f32x4*)(cw + NUP + ch) * cg + *(const f32x4*)(cw + 2 * NUP + ch) * ng + *(const f32x4*)(cb + ch);
        const f32x4 val = *(const f32x4*)(cw + DFF + ch) * pv + *(const f32x4*)(cw + NUP + DFF + ch) * cv + *(const f32x4*)(cw + 2 * NUP + DFF + ch) * nv + *(const f32x4*)(cb + DFF + ch);
        u32x2 w; w.x = pk2(siluf_(gate[0]) * val[0], siluf_(gate[1]) * val[1]); w.y = pk2(siluf_(gate[2]) * val[2], siluf_(gate[3]) * val[3]);
        *(u32x2*)(P + (size_t)row * PLD + C_ACT + ch) = w; }
}

__global__ void __launch_bounds__(NWAVES * 64, 2) fwd_kernel(Args args) {
    extern __shared__ __attribute__((aligned(16))) unsigned char lds[];
    Frame F;
    F.lds = (LAS unsigned char*)lds;
    F.MISC = (volatile LAS unsigned*)(F.lds + MISC_OFF);
    F.tid = threadIdx.x; F.lane = F.tid & 63; F.wave = __builtin_amdgcn_readfirstlane(F.tid >> 6);
    F.G = gridDim.x; { const int bx = blockIdx.x; F.vcu = (F.G % 8 == 0) ? (bx % 8) * (F.G / 8) + bx / 8 : bx; }
    unsigned char* ws = args.ws;
    F.ctl = (gu32*)(ws + WS_CTL);
    for (int u = F.tid; u < (LDS_BYTES - LDSCTL_OFF) / 4; u += NWAVES * 64) ((LAS unsigned*)(F.lds + LDSCTL_OFF))[u] = 0u;
    __syncthreads();
    const int lo = args.ph_lo, hi = args.ph_hi;
    const bool single = (hi - lo) > 1;
    XcdBarrier bar; bar.bar = (unsigned*)(F.ctl + CW_BAR); bar.x = 0; bar.st = nullptr;
    if (single) bar = xcd_barrier_post((unsigned*)(F.ctl + CW_BAR), F.MISC + 8);
#ifndef PH_MASK
#define PH_MASK 0x1FF
#endif
#define IN(k) (((PH_MASK >> (k)) & 1) && lo <= (k) && (k) < hi)
#define SEAM(k) do { if (IN(k) && IN((k) + 1)) xcd_barrier(bar); } while (0)
    bf16* P = (bf16*)(ws + WS_P);
    const int bid = (int)blockIdx.x;
#define TS(k) do {} while (0)
#define TSB(k, blk) do {} while (0)
    TS(0);

    if (IN(0)) { p0_prologue(F, args); }
    SEAM(0); TS(1);
    if (IN(1)) {
        { pg8::Gemm g{(const bf16*)args.out, (const bf16*)(ws + WS_WIN), M, 3584, 1024, 1024, 1024}; pg8::StaticOrder S; S.init(M, 3584, F.G, bid);
          EpiInProj E{P, (float*)(ws + WS_BA)};
          pg8::gemm_phase<EpiInProj, pg8::StaticOrder, true, true>(F.lds + RING_OFF, g, S, E); }
        { pg8::Gemm g{(const bf16*)(ws + WS_MEMN), (const bf16*)(ws + WS_WKV), BATCH * NMEM, 1024, 1024, 1024, 1024}; pg8::StaticOrder S; S.init(BATCH * NMEM, 1024, F.G, bid);
          EpiBf16 E{(bf16*)(ws + WS_KV), 1024};
          pg8::gemm_phase<EpiBf16, pg8::StaticOrder, true, true>(F.lds + RING_OFF, g, S, E); }
    }
    SEAM(1); TS(2);
    if (IN(2)) {
        if (F.G == 256) dn_prep_block(F, args, bid >> 6, (bid >> 3) & 7, (bid & 7) * 16, 16);
        else for (int u = bid; u < 4096; u += F.G) dn_prep_block(F, args, u >> 10, (u >> 7) & 7, u & 127, 1);
    }
    TS(12); SEAM(2); TS(3);
    if (IN(3)) {
        const int ndn = F.G >= 128 ? 64 : 0;
        if (bid < ndn) { if (args.mode != 2) dn_scan_unit(F, args, bid >> 4, (bid >> 1) & 7, bid & 1); }
        else if (args.mode != 1) {
            if (ndn == 0) for (int u = bid; u < 64; u += F.G) dn_scan_unit(F, args, u >> 4, (u >> 1) & 7, u & 1);
            const int nb = F.G - ndn, me = bid - ndn;
            for (int u = me; u < 1024; u += nb) {
                if (u < 512) attnA_unit(F, args, u >> 7, (u >> 1) & 63, u & 1);
                else { const int v = u - 512; xattn_unit(F, args, v >> 7, (v >> 2) & 31, v & 3); }
            }
        }
    }
    TS(10); TSB(11, 64); SEAM(3); TS(4);
    if (IN(4)) {
        dn_combine(F, args);
        pg8::Gemm g{(const bf16*)args.out, (const bf16*)(ws + WS_WIN) + (size_t)3584 * 1024, M, 3072, 1024, 1024, 1024}; pg8::StaticOrder S; S.init(M, 3072, F.G, bid);
        EpiBf16 E{P + C_GATE, PLD};
        pg8::gemm_phase<EpiBf16, pg8::StaticOrder, true, true>(F.lds + RING_OFF, g, S, E);
    }
    SEAM(4); TS(5);
    if (IN(5)) {
        pg8::Gemm g{P + C_AQ, (const bf16*)(ws + WS_WBR), M, 1024, 1536, PLD, 512};
        g.segt = 8; g.aoff1 = (long)(C_DZ - C_AQ) * 2 - 8 * 128; g.aoff2 = (long)(C_MQ - C_AQ) * 2 - 16 * 128;
        g.boff1 = (long)1024 * 512 * 2 - 8 * 128; g.boff2 = (long)2 * 1024 * 512 * 2 - 16 * 128;
        pg8::StaticOrder S; S.init(M, 1024, F.G, bid);
        EpiMerge E{P}; pg8::gemm_phase<EpiMerge, pg8::StaticOrder, true, true>(F.lds + RING_OFF, g, S, E);
    }
    SEAM(5); TS(6);
    if (IN(6)) {
        pg8::Gemm g{P + C_MG, (const bf16*)(ws + WS_WOUT), M, 1024, 1024, PLD, 1024}; pg8::StaticOrder S; S.init(M, 1024, F.G, bid);
        EpiWout E{args.in[0], args.out, P, (float*)(ws + WS_SSQ), (LAS float*)(F.lds + XCH_OFF)};
        pg8::gemm_phase<EpiWout, pg8::StaticOrder, true, true>(F.lds + RING_OFF, g, S, E);
    }
    SEAM(6); TS(7);
    if (IN(7)) {
        pg8::Gemm g{P + C_X1B, (const bf16*)(ws + WS_WUP), M, NUP, 1024, PLD, 1024}; pg8::StaticOrder S; S.init(M, NUP, F.G, bid);
        EpiUp E{(const float*)(ws + WS_SSQ), args.in[22], args.in[23], P, (float*)(ws + WS_UE), (LAS float*)(F.lds + XCH_OFF)};
        pg8::gemm_phase<EpiUp, pg8::StaticOrder, true, true>(F.lds + RING_OFF, g, S, E);
    }
    SEAM(7); TS(8);
    if (IN(8)) {
        pg8::Gemm g{P + C_ACT, (const bf16*)(ws + WS_WDN), M, 1024, DFF, PLD, DFF}; pg8::StaticOrder S; S.init(M, 1024, F.G, bid);
        { Unit u; int prev = -1; for (int i = 0; S.next(i, u); ++i) { if (u.pm != prev) ffn_fixup_panel(F, args, u.pm); prev = u.pm; } }
        VM_WAIT(); __syncthreads();
        EpiDown E{args.out};
        pg8::gemm_phase<EpiDown, pg8::StaticOrder, true, true>(F.lds + RING_OFF, g, S, E);
    }
    TS(9);
#undef IN
#undef SEAM
}

#ifdef DBG_TIME
__global__ void dbg_ts_kernel(unsigned char* ws, int k) { if (threadIdx.x == 0) ((unsigned long long*)(ws + WS_CTL + 65536))[k] = __builtin_amdgcn_s_memrealtime(); }
__global__ void dbg_wait_kernel(unsigned char* ws) {
    if (threadIdx.x == 0) { const unsigned long long* tsb = (const unsigned long long*)(ws + WS_CTL + 65536);
        const unsigned long long te = __builtin_amdgcn_s_memrealtime();
        const unsigned long long d1 = tsb[DBG_A1] - tsb[DBG_A0], d2 = tsb[DBG_B1] - tsb[DBG_B0];
        const unsigned long long W = d1 + 100000ull * (d2 / 1000ull);
        while (__builtin_amdgcn_s_memrealtime() - te < W) __builtin_amdgcn_s_sleep(32); }
}
#endif
constexpr int N_PHASES = 9;
#ifndef MK_PER_PHASE
#define MK_PER_PHASE 0
#endif
extern "C" void kernel_launch(void* const* d_in, const int* in_sizes, int n_in, void* d_out, int out_size, void* d_ws, size_t ws_size, hipStream_t stream) {
    static int grid = 0;
    if (grid == 0) {
        if (n_in != 25 || in_sizes[0] != M * DM || out_size != M * DM || ws_size < WS_END) {
            fprintf(stderr, "kernel_launch: unexpected shapes (n_in %d, in0 %d, out %d, ws %zu); nothing launched\n", n_in, n_in > 0 ? in_sizes[0] : -1, out_size, ws_size); grid = -1; return; }
        int dev = 0, cus = 0, per_cu = 0;
        if (hipGetDevice(&dev) != hipSuccess || hipDeviceGetAttribute(&cus, hipDeviceAttributeMultiprocessorCount, dev) != hipSuccess) { grid = -1; return; }
        if (hipFuncSetAttribute((const void*)fwd_kernel, hipFuncAttributeMaxDynamicSharedMemorySize, LDS_BYTES) != hipSuccess) { fprintf(stderr, "kernel_launch: hipFuncSetAttribute failed\n"); grid = -1; return; }
        if (hipOccupancyMaxActiveBlocksPerMultiprocessor(&per_cu, (const void*)fwd_kernel, NWAVES * 64, LDS_BYTES) != hipSuccess || per_cu < 1) { fprintf(stderr, "kernel_launch: occupancy query reports %d\n", per_cu); }
        (void)hipGetLastError();
        grid = cus;
    }
    if (grid < 0) return;
    if (hipMemsetAsync((char*)d_ws + WS_CTL, 0, CTL_ZERO_BYTES, stream) != hipSuccess) return;
    Args a{};
    for (int i = 0; i < 25; ++i) a.in[i] = (const float*)d_in[i];
    a.out = (float*)d_out; a.ws = (unsigned char*)d_ws;
#ifdef DBG_TIME
    for (int p = 0; p < N_PHASES; ++p) { hipLaunchKernelGGL(dbg_ts_kernel, dim3(1), dim3(64), 0, stream, (unsigned char*)d_ws, p);
        a.ph_lo = p; a.ph_hi = p + 1;
        if (p == 3) { a.mode = 1; hipLaunchKernelGGL(fwd_kernel, dim3(grid), dim3(NWAVES * 64), LDS_BYTES, stream, a); hipLaunchKernelGGL(dbg_ts_kernel, dim3(1), dim3(64), 0, stream, (unsigned char*)d_ws, 12); a.mode = 2; }
        hipLaunchKernelGGL(fwd_kernel, dim3(grid), dim3(NWAVES * 64), LDS_BYTES, stream, a); a.mode = 0; }
    hipLaunchKernelGGL(dbg_ts_kernel, dim3(1), dim3(64), 0, stream, (unsigned char*)d_ws, N_PHASES);
    hipLaunchKernelGGL(dbg_wait_kernel, dim3(1), dim3(64), 0, stream, (unsigned char*)d_ws);
    return;
#endif
    if (MK_PER_PHASE) {
        for (int p = 0; p < N_PHASES; ++p) { a.ph_lo = p; a.ph_hi = p + 1; hipLaunchKernelGGL(fwd_kernel, dim3(grid), dim3(NWAVES * 64), LDS_BYTES, stream, a); }
    } else {
        a.ph_lo = 0; a.ph_hi = N_PHASES; hipLaunchKernelGGL(fwd_kernel, dim3(grid), dim3(NWAVES * 64), LDS_BYTES, stream, a);
    }
}
```

```cpp
#include <hip/hip_runtime.h>
#include <cstdio>
#include <cstdint>
#include <cmath>
namespace pg8 {
#define PG8_LAS __attribute__((address_space(3)))
typedef unsigned short bf16_t;
typedef short bf16x8 __attribute__((ext_vector_type(8)));
typedef float f32x4 __attribute__((ext_vector_type(4)));
typedef unsigned u32x4 __attribute__((ext_vector_type(4)));
constexpr int BM = 256, BK = 64, HALF = 128, HTB = HALF * BK * 2  , STAGE_BYTES = 8 * HTB, NXCD = 8, WGM = 8;

__host__ __device__ __forceinline__ int lds_byte(int r, int c) { const int st = (r >> 4) * 2 + (c >> 5), rr = r & 15, cc = c & 31, ob = rr * 64 + cc * 2; return st * 1024 + (ob ^ (((ob >> 9) & 1) << 5)); }
__host__ __device__ __forceinline__ void stage_rc(int b, int& R, int& C) { const int st = b / 1024, sb = b % 1024, swz = sb ^ (((sb >> 9) & 1) << 5); R = (st >> 1) * 16 + swz / 64; C = (st & 1) * 32 + (swz % 64) / 2; }
__host__ __device__ __forceinline__ int perm32(int rho) { const int n = rho >> 4, i = rho & 15; return 8 * (i >> 2) + 4 * n + (i & 3); }

struct Unit { int pm, pn, aux; };
struct Gemm { const bf16_t* A; const bf16_t* Bt; int M, N, K, lda, ldb; int segt = 1 << 30; long aoff1 = 0, aoff2 = 0, boff1 = 0, boff2 = 0; };

struct StaticOrder {
    int nM, nN, nwg, G, c;
    __host__ __device__ __forceinline__ void init(int M, int N, int G_, int c_) { nM = M / BM; nN = N / BM; nwg = nM * nN; G = G_; c = c_; }
    __host__ __device__ __forceinline__ bool next(int i, Unit& u) const {
        const long L = (long)i * G + c; if (L >= nwg) return false;
        int wgid = (int)L; { const int q = nwg / NXCD, r = nwg % NXCD, xcd = wgid % NXCD, off = wgid / NXCD; wgid = (xcd < r ? xcd * (q + 1) : r * (q + 1) + (xcd - r) * q) + off; }
        const int nig = WGM * nN, gid = wgid / nig, fm = gid * WGM, gsz = (nM - fm) < WGM ? (nM - fm) : WGM;
        u.pm = fm + ((wgid % nig) % gsz); u.pn = (wgid % nig) / gsz; return true;
    }
    __device__ __forceinline__ void a_ready(const Unit&) const {}
    __device__ __forceinline__ void done(const Unit&) const {}
};

template <class Epi, class Sched, bool ALIGN_EPI = false, bool SP2 = false>
__device__ __forceinline__ void gemm_phase(PG8_LAS unsigned char* lds, const Gemm g, const Sched& S, const Epi& E) {
    const int tid = threadIdx.x, wid = __builtin_amdgcn_readfirstlane(tid >> 6), lane = tid & 63, wr = wid >> 2, wc = wid & 3, fr = lane & 15, fq = lane >> 4;
    const int K = g.K, nt = K / BK;
    unsigned voffA[2], voffB[2];
#pragma unroll
    for (int i = 0; i < 2; ++i) { int R, C; stage_rc(tid * 16 + i * 8192, R, C); const int Rb = Epi::PERM ? ((R & ~31) + perm32(R & 31)) : R;
        voffA[i] = (unsigned)(R * g.lda + C) * 2u; voffB[i] = (unsigned)(Rb * g.ldb + C) * 2u; }
    const size_t kstep = (size_t)(BK * 2);
    const size_t hstepA = (size_t)HALF * g.lda * 2, hstepB = (size_t)HALF * g.ldb * 2;
    const size_t tstepA = 2 * hstepA, tstepB = 2 * hstepB;
    const unsigned ldsw = (unsigned)wid * 1024u;
    const int aoff = lds_byte(wr * 64 + fr, fq * 8), boff = lds_byte(wc * 32 + fr, fq * 8);
#define PG8_SA(b, h) (((b) * 2 + (h)) * HTB)
#define PG8_SB(b, h) ((4 + (b) * 2 + (h)) * HTB)
#define PG8_STAGE(bufoff, gbase, voff) do { _Pragma("unroll") for (int _i = 0; _i < 2; ++_i) \
        __builtin_amdgcn_global_load_lds((const unsigned*)((const char*)(gbase) + (voff)[_i]), (PG8_LAS unsigned*)(lds + (bufoff) + ldsw + _i * 8192), 16, 0, 0); } while (0)
#define PG8_LDA(dst, b, h) do { _Pragma("unroll") for (int m = 0; m < 4; ++m) _Pragma("unroll") for (int k = 0; k < 2; ++k) dst[m][k] = *(const PG8_LAS bf16x8*)(lds + PG8_SA(b, h) + aoff + m * 2048 + k * 1024); } while (0)
#define PG8_LDB(dst, b, h) do { _Pragma("unroll") for (int n = 0; n < 2; ++n) _Pragma("unroll") for (int k = 0; k < 2; ++k) dst[n][k] = *(const PG8_LAS bf16x8*)(lds + PG8_SB(b, h) + boff + n * 2048 + k * 1024); } while (0)
#define PG8_MMA(ai, bj, At, Bt) do { __builtin_amdgcn_s_setprio(1); _Pragma("unroll") for (int m = 0; m < 4; ++m) _Pragma("unroll") for (int n = 0; n < 2; ++n) _Pragma("unroll") for (int k = 0; k < 2; ++k) \
        acc[ai][bj][m][n] = __builtin_amdgcn_mfma_f32_16x16x32_bf16(Bt[n][k], At[m][k], acc[ai][bj][m][n], 0, 0, 0); __builtin_amdgcn_s_setprio(0); } while (0)
#define PG8_WAIT_V(n) asm volatile("s_waitcnt vmcnt(" #n ")" ::: "memory")
#define PG8_WAIT_L(n) asm volatile("s_waitcnt lgkmcnt(" #n ")" ::: "memory")
#define PG8_BAR __builtin_amdgcn_s_barrier()
#define PG8_SCHED __builtin_amdgcn_sched_barrier(0)
    Unit cur, nxt; int ui = 0;
    if (!S.next(0, cur)) return;
    if constexpr (Epi::PREFETCH) E.prefetch(cur, 0, tid);
    f32x4 acc[2][2][4][2];
#pragma unroll
    for (int a = 0; a < 2; ++a)
#pragma unroll
        for (int b = 0; b < 2; ++b)
#pragma unroll
            for (int m = 0; m < 4; ++m)
#pragma unroll
                for (int n = 0; n < 2; ++n) acc[a][b][m][n] = (f32x4){0.f, 0.f, 0.f, 0.f};
    bf16x8 At[4][2], B0[2][2], B1[2][2];
    const char* cA = (const char*)g.A + (size_t)cur.pm * tstepA; const char* cB = (const char*)g.Bt + (size_t)cur.pn * tstepB;
    S.a_ready(cur);
    if constexpr (SP2) {
        PG8_STAGE(PG8_SB(0, 0), cB, voffB); PG8_STAGE(PG8_SB(0, 1), cB + hstepB, voffB); PG8_STAGE(PG8_SA(0, 0), cA, voffA); PG8_STAGE(PG8_SA(0, 1), cA + hstepA, voffA);
        if (wr == 1) PG8_BAR;
        PG8_WAIT_V(2); PG8_BAR;
        PG8_STAGE(PG8_SB(1, 0), cB + kstep, voffB); PG8_STAGE(PG8_SA(1, 0), cA + kstep, voffA); PG8_STAGE(PG8_SB(1, 1), cB + hstepB + kstep, voffB);
        PG8_WAIT_V(6); PG8_BAR;
    } else {
        PG8_STAGE(PG8_SB(0, 0), cB, voffB); PG8_STAGE(PG8_SA(0, 0), cA, voffA); PG8_STAGE(PG8_SB(0, 1), cB + hstepB, voffB); PG8_STAGE(PG8_SA(0, 1), cA + hstepA, voffA);
        if (wr == 1) PG8_BAR;
        PG8_WAIT_V(4); PG8_BAR;
        PG8_STAGE(PG8_SB(1, 0), cB + kstep, voffB); PG8_STAGE(PG8_SA(1, 0), cA + kstep, voffA); PG8_STAGE(PG8_SB(1, 1), cB + hstepB + kstep, voffB);
        PG8_WAIT_V(6); PG8_BAR;
    }
    for (;;) {
        const bool has_next = S.next(ui + 1, nxt);
        const char* nA = has_next ? (const char*)g.A + (size_t)nxt.pm * tstepA : cA; const char* nB = has_next ? (const char*)g.Bt + (size_t)nxt.pn * tstepB : cB;
        for (int t = 0; t < nt; t += 2) {
            const bool last = (t == nt - 2);
            if constexpr (Epi::RESCALE) { if (t == g.segt || t == 2 * g.segt) E.rescale(acc, cur, wr, wc, fr, fq, t / g.segt); }
            const long so1 = (t + 1 >= 2 * g.segt) ? g.aoff2 : ((t + 1 >= g.segt) ? g.aoff1 : 0), so2 = (t + 2 >= 2 * g.segt) ? g.aoff2 : ((t + 2 >= g.segt) ? g.aoff1 : 0), sb2 = (t + 2 >= 2 * g.segt) ? g.boff2 : ((t + 2 >= g.segt) ? g.boff1 : 0);
            const char* a1 = cA + so1 + (size_t)(t + 1) * kstep;
            const char* a2 = last ? nA : cA + so2 + (size_t)(t + 2) * kstep; const char* b2 = last ? nB : cB + sb2 + (size_t)(t + 2) * kstep;
            const char* a3 = a2 + kstep; const char* b3 = b2 + kstep;
            if (last && has_next) S.a_ready(nxt);
            if constexpr (SP2) {
            PG8_LDB(B0, 0, 0); PG8_LDB(B1, 0, 1); PG8_SCHED; PG8_LDA(At, 0, 0); PG8_STAGE(PG8_SA(1, 1), a1 + hstepA, voffA);
            PG8_WAIT_V(8); PG8_WAIT_L(0); PG8_BAR; PG8_MMA(0, 0, At, B0); PG8_MMA(0, 1, At, B1); PG8_BAR; PG8_SCHED;
            PG8_LDA(At, 0, 1); PG8_STAGE(PG8_SB(0, 0), b2, voffB); PG8_STAGE(PG8_SB(0, 1), b2 + hstepB, voffB); PG8_STAGE(PG8_SA(0, 0), a2, voffA);
            PG8_WAIT_V(8); PG8_WAIT_L(0); PG8_BAR; PG8_MMA(1, 0, At, B0); PG8_MMA(1, 1, At, B1); PG8_BAR; PG8_SCHED;
            PG8_LDB(B0, 1, 0); PG8_LDB(B1, 1, 1); PG8_SCHED; PG8_LDA(At, 1, 0); PG8_STAGE(PG8_SA(0, 1), a2 + hstepA, voffA);
            PG8_WAIT_V(8); PG8_WAIT_L(0); PG8_BAR; PG8_MMA(0, 0, At, B0); PG8_MMA(0, 1, At, B1); PG8_BAR; PG8_SCHED;
            PG8_LDA(At, 1, 1); PG8_STAGE(PG8_SB(1, 0), b3, voffB); PG8_STAGE(PG8_SB(1, 1), b3 + hstepB, voffB); PG8_STAGE(PG8_SA(1, 0), a3, voffA);
            PG8_WAIT_V(8); PG8_WAIT_L(0); PG8_BAR; PG8_MMA(1, 0, At, B0); PG8_MMA(1, 1, At, B1); PG8_BAR; PG8_SCHED;
            } else {
            PG8_LDB(B0, 0, 0); PG8_SCHED; PG8_LDA(At, 0, 0); PG8_STAGE(PG8_SA(1, 1), a1 + hstepA, voffA);
            PG8_WAIT_L(8); PG8_BAR; PG8_WAIT_L(0); PG8_MMA(0, 0, At, B0); PG8_BAR; PG8_SCHED;
            PG8_LDB(B1, 0, 1); PG8_STAGE(PG8_SB(0, 0), b2, voffB);
            PG8_BAR; PG8_WAIT_L(0); PG8_MMA(0, 1, At, B1); PG8_BAR;
            PG8_LDA(At, 0, 1); PG8_STAGE(PG8_SA(0, 0), a2, voffA);
            PG8_BAR; PG8_WAIT_L(0); PG8_MMA(1, 0, At, B0); PG8_BAR; PG8_SCHED;
            PG8_STAGE(PG8_SB(0, 1), b2 + hstepB, voffB);
            PG8_WAIT_V(6); PG8_BAR; PG8_MMA(1, 1, At, B1); PG8_BAR;
            PG8_LDB(B0, 1, 0); PG8_SCHED; PG8_LDA(At, 1, 0); PG8_STAGE(PG8_SA(0, 1), a2 + hstepA, voffA);
            PG8_WAIT_L(8); PG8_BAR; PG8_WAIT_L(0); PG8_MMA(0, 0, At, B0); PG8_BAR; PG8_SCHED;
            PG8_LDB(B1, 1, 1); PG8_STAGE(PG8_SB(1, 0), b3, voffB);
            PG8_BAR; PG8_WAIT_L(0); PG8_MMA(0, 1, At, B1); PG8_BAR;
            PG8_LDA(At, 1, 1); PG8_STAGE(PG8_SA(1, 0), a3, voffA);
            PG8_BAR; PG8_WAIT_L(0); PG8_MMA(1, 0, At, B0); PG8_BAR; PG8_SCHED;
            PG8_STAGE(PG8_SB(1, 1), b3 + hstepB, voffB);
            PG8_WAIT_V(6); PG8_BAR; PG8_MMA(1, 1, At, B1); PG8_BAR;
            }
        }
        if constexpr (ALIGN_EPI) { if (wr == 0) PG8_BAR; }
        if constexpr (Epi::PREFETCH) cur.aux = ui & 1;
        if constexpr (!Epi::AFTER_DRAIN) { E(acc, cur, wr, wc, fr, fq); S.done(cur); }
        if constexpr (Epi::PREFETCH) { if (has_next) E.prefetch(nxt, (ui + 1) & 1, tid); }
        if (!has_next) break;
#pragma unroll
        for (int a = 0; a < 2; ++a)
#pragma unroll
            for (int b = 0; b < 2; ++b)
#pragma unroll
                for (int m = 0; m < 4; ++m)
#pragma unroll
                    for (int n = 0; n < 2; ++n) acc[a][b][m][n] = (f32x4){0.f, 0.f, 0.f, 0.f};
        cur = nxt; cA = nA; cB = nB; ++ui;
        if constexpr (ALIGN_EPI) { if (wr == 1) PG8_BAR; }
    }
    PG8_WAIT_V(0);
    if constexpr (!ALIGN_EPI) { if (wr == 0) PG8_BAR; }
    PG8_BAR;
    if constexpr (Epi::AFTER_DRAIN) { E.fused(acc, cur, wr, wc, fr, fq, lds, wid, lane); S.done(cur); }
#undef PG8_SA
#undef PG8_SB
#undef PG8_STAGE
#undef PG8_LDA
#undef PG8_LDB
#undef PG8_MMA
#undef PG8_WAIT_V
#undef PG8_WAIT_L
#undef PG8_BAR
#undef PG8_SCHED
}
}

#define LAS __attribute__((address_space(3)))
#define GAS __attribute__((address_space(1)))
typedef unsigned short bf16;
typedef short bf16x8 __attribute__((ext_vector_type(8)));
typedef short s16x4 __attribute__((ext_vector_type(4)));
typedef float f32x4 __attribute__((ext_vector_type(4)));
typedef float f32x16 __attribute__((ext_vector_type(16)));
typedef unsigned u32x4 __attribute__((ext_vector_type(4)));
typedef unsigned u32x2 __attribute__((ext_vector_type(2)));
typedef float f32x2_t __attribute__((ext_vector_type(2)));
typedef __bf16 bf16x2_t __attribute__((ext_vector_type(2)));

constexpr int BATCH = 4, SEQ = 8192, DM = 1024, M = BATCH * SEQ;
constexpr int NMEM = 256;
constexpr int PLD = 6400;
constexpr int C_AQ = 0, C_AK = 512, C_AV = 640, C_DQ = 768, C_DK = 1280, C_DV = 1792, C_DZ = 2304, C_MQ = 2816, C_GATE = 3328;
constexpr int C_MG = 768, C_X1B = 1792, C_ACT = 2816;
constexpr int NIN = 6656;
constexpr int DFF = 2816, NUP = 5632;
constexpr float EPS = 1e-6f;
constexpr float LOG2E = 1.4426950408889634f;

__device__ __forceinline__ float bf_lo(unsigned w) { return __uint_as_float(w << 16); }
__device__ __forceinline__ float bf_hi(unsigned w) { return __uint_as_float(w & 0xffff0000u); }
__device__ __forceinline__ unsigned pk2(float lo, float hi) { f32x2_t v = {lo, hi}; bf16x2_t b = __builtin_convertvector(v, bf16x2_t); return __builtin_bit_cast(unsigned, b); }
__device__ __forceinline__ float fexp2(float x) { return __builtin_amdgcn_exp2f(x); }
__device__ __forceinline__ float frcp(float x) { return __builtin_amdgcn_rcpf(x); }
__device__ __forceinline__ float sigmoidf_(float x) { return frcp(1.0f + fexp2(-x * LOG2E)); }
__device__ __forceinline__ float siluf_(float x) { return x * sigmoidf_(x); }
__device__ __forceinline__ void unpack8(const u32x4 w, float (&v)[8]) {
    v[0] = bf_lo(w.x); v[1] = bf_hi(w.x); v[2] = bf_lo(w.y); v[3] = bf_hi(w.y); v[4] = bf_lo(w.z); v[5] = bf_hi(w.z); v[6] = bf_lo(w.w); v[7] = bf_hi(w.w); }
__device__ __forceinline__ u32x4 pack8(const float (&v)[8]) { u32x4 w; w.x = pk2(v[0], v[1]); w.y = pk2(v[2], v[3]); w.z = pk2(v[4], v[5]); w.w = pk2(v[6], v[7]); return w; }

using pg8::Unit;
constexpr int HALF = pg8::HALF, BM = pg8::BM;

struct EpiInProj {
    static constexpr bool PERM = true, AFTER_DRAIN = false, PREFETCH = false, RESCALE = false;
    bf16* P; float* BA;
    __device__ __forceinline__ void operator()(const f32x4 (&acc)[2][2][4][2], const Unit& u, int wr, int wc, int fr, int fq) const {
        const int row0 = u.pm * BM + wr * 64 + fr;
        if (u.pn < 13) {
            const int col0 = u.pn * BM + wc * 32 + 8 * fq;
#pragma unroll
            for (int ai = 0; ai < 2; ++ai)
#pragma unroll
                for (int m = 0; m < 4; ++m) { bf16* rowp = P + (size_t)(row0 + ai * HALF + m * 16) * PLD + col0;
#pragma unroll
                    for (int bj = 0; bj < 2; ++bj) { const f32x4 v0 = acc[ai][bj][m][0], v1 = acc[ai][bj][m][1];
                        u32x4 w; w.x = pk2(v0[0], v0[1]); w.y = pk2(v0[2], v0[3]); w.z = pk2(v1[0], v1[1]); w.w = pk2(v1[2], v1[3]);
                        *(u32x4*)(rowp + bj * HALF) = w; } }
        } else if (wc == 0) {
#pragma unroll
            for (int ai = 0; ai < 2; ++ai)
#pragma unroll
                for (int m = 0; m < 4; ++m) { float* rp = BA + (size_t)(row0 + ai * HALF + m * 16) * 32 + 8 * fq;
                    *(f32x4*)rp = acc[ai][0][m][0]; *(f32x4*)(rp + 4) = acc[ai][0][m][1]; }
        }
    }
};
struct EpiBf16 {
    static constexpr bool PERM = true, AFTER_DRAIN = false, PREFETCH = false, RESCALE = false;
    bf16* O; int ldc;
    __device__ __forceinline__ void operator()(const f32x4 (&acc)[2][2][4][2], const Unit& u, int wr, int wc, int fr, int fq) const {
        const int row0 = u.pm * BM + wr * 64 + fr, col0 = u.pn * BM + wc * 32 + 8 * fq;
#pragma unroll
        for (int ai = 0; ai < 2; ++ai)
#pragma unroll
            for (int m = 0; m < 4; ++m) { bf16* rowp = O + (size_t)(row0 + ai * HALF + m * 16) * ldc + col0;
#pragma unroll
                for (int bj = 0; bj < 2; ++bj) { const f32x4 v0 = acc[ai][bj][m][0], v1 = acc[ai][bj][m][1];
                    u32x4 w; w.x = pk2(v0[0], v0[1]); w.y = pk2(v0[2], v0[3]); w.z = pk2(v1[0], v1[1]); w.w = pk2(v1[2], v1[3]);
                    *(u32x4*)(rowp + bj * HALF) = w; } }
    }
};
template <int PASS> struct EpiBranch {
    static constexpr bool PERM = true, AFTER_DRAIN = false, PREFETCH = false, RESCALE = false;
    bf16* P;
    __device__ __forceinline__ void operator()(const f32x4 (&acc)[2][2][4][2], const Unit& u, int wr, int wc, int fr, int fq) const {
        const int row0 = u.pm * BM + wr * 64 + fr, col0 = u.pn * BM + wc * 32 + 8 * fq;
#pragma unroll
        for (int ai = 0; ai < 2; ++ai)
#pragma unroll
            for (int m = 0; m < 4; ++m) { bf16* rowp = P + (size_t)(row0 + ai * HALF + m * 16) * PLD;
#pragma unroll
                for (int bj = 0; bj < 2; ++bj) {
                    const int c = col0 + bj * HALF;
                    const u32x4 gw = *(const u32x4*)(rowp + C_GATE + 1024 * PASS + c);
                    float g[8]; unpack8(gw, g);
                    float pv[8];
                    if (PASS > 0) { const u32x4 mw = *(const u32x4*)(rowp + C_MG + c); unpack8(mw, pv); }
                    else {
#pragma unroll
                        for (int i = 0; i < 8; ++i) pv[i] = 0.f; }
                    const f32x4 v0 = acc[ai][bj][m][0], v1 = acc[ai][bj][m][1];
                    float o[8];
#pragma unroll
                    for (int i = 0; i < 4; ++i) { o[i] = pv[i] + sigmoidf_(g[i]) * v0[i]; o[4 + i] = pv[4 + i] + sigmoidf_(g[4 + i]) * v1[i]; }
                    *(u32x4*)(rowp + C_MG + c) = pack8(o); } }
    }
};
struct EpiGatesU8 {
    static constexpr bool PERM = true, AFTER_DRAIN = false, PREFETCH = false, RESCALE = false;
    bf16* P;
    __device__ __forceinline__ void operator()(const f32x4 (&acc)[2][2][4][2], const Unit& u, int wr, int wc, int fr, int fq) const {
        const int row0 = u.pm * BM + wr * 64 + fr, col0 = u.pn * BM + wc * 32 + 8 * fq;
#pragma unroll
        for (int ai = 0; ai < 2; ++ai)
#pragma unroll
            for (int m = 0; m < 4; ++m) { unsigned char* rowp = (unsigned char*)(P + (size_t)(row0 + ai * HALF + m * 16) * PLD + C_GATE) + col0;
#pragma unroll
                for (int bj = 0; bj < 2; ++bj) { const f32x4 v0 = acc[ai][bj][m][0], v1 = acc[ai][bj][m][1]; unsigned q[8];
#pragma unroll
                    for (int i = 0; i < 4; ++i) { q[i] = (unsigned)fminf(fmaxf(sigmoidf_(v0[i]) * 255.0f + 0.5f, 1.0f), 255.0f); q[4 + i] = (unsigned)fminf(fmaxf(sigmoidf_(v1[i]) * 255.0f + 0.5f, 1.0f), 255.0f); }
                    u32x2 w; w.x = q[0] | (q[1] << 8) | (q[2] << 16) | (q[3] << 24); w.y = q[4] | (q[5] << 8) | (q[6] << 16) | (q[7] << 24);
                    *(u32x2*)(rowp + bj * HALF) = w; } }
    }
};
struct EpiMerge {
    static constexpr bool PERM = true, AFTER_DRAIN = false, PREFETCH = false, RESCALE = true;
    bf16* P;
    __device__ __forceinline__ void rescale(f32x4 (&acc)[2][2][4][2], const Unit& u, int wr, int wc, int fr, int fq, int stage) const {
        asm volatile("" : "+v"(fr), "+v"(fq));
        const int row0 = u.pm * BM + wr * 64 + fr, col0 = u.pn * BM + wc * 32 + 8 * fq;
#pragma unroll
        for (int ai = 0; ai < 2; ++ai) {
#pragma unroll
            for (int m = 0; m < 4; ++m) { const unsigned char* rowp = (const unsigned char*)(P + (size_t)(row0 + ai * HALF + m * 16) * PLD + C_GATE) + 1024 * (stage - 1) + col0;
#pragma unroll
                for (int bj = 0; bj < 2; ++bj) { const u32x2 gx = *(const u32x2*)(rowp + bj * HALF), gy = *(const u32x2*)(rowp + 1024 + bj * HALF);
#pragma unroll
                    for (int i = 0; i < 4; ++i) { acc[ai][bj][m][0][i] *= (float)((gx.x >> (8 * i)) & 255u) * frcp((float)((gy.x >> (8 * i)) & 255u));
                        acc[ai][bj][m][1][i] *= (float)((gx.y >> (8 * i)) & 255u) * frcp((float)((gy.y >> (8 * i)) & 255u)); } } }
            asm volatile("" ::: "memory"); }
    }
    __device__ __forceinline__ void operator()(const f32x4 (&acc)[2][2][4][2], const Unit& u, int wr, int wc, int fr, int fq) const {
        const int row0 = u.pm * BM + wr * 64 + fr, col0 = u.pn * BM + wc * 32 + 8 * fq;
#pragma unroll
        for (int ai = 0; ai < 2; ++ai)
#pragma unroll
            for (int m = 0; m < 4; ++m) { bf16* rowp = P + (size_t)(row0 + ai * HALF + m * 16) * PLD;
#pragma unroll
                for (int bj = 0; bj < 2; ++bj) { const int c = col0 + bj * HALF; float o[8];
                    const u32x2 gq = *(const u32x2*)((const unsigned char*)(rowp + C_GATE) + 2048 + c);
                    const f32x4 v0 = acc[ai][bj][m][0], v1 = acc[ai][bj][m][1];
#pragma unroll
                    for (int i = 0; i < 4; ++i) { o[i] = (float)((gq.x >> (8 * i)) & 255u) * (1.0f / 255.0f) * v0[i]; o[4 + i] = (float)((gq.y >> (8 * i)) & 255u) * (1.0f / 255.0f) * v1[i]; }
                    *(u32x4*)(rowp + C_MG + c) = pack8(o); } }
    }
};
struct EpiWout {
    static constexpr bool PERM = true, AFTER_DRAIN = false, PREFETCH = false, RESCALE = false;
    const float* x; float* out; bf16* P; float* SSQ; LAS float* xl;
    __device__ __forceinline__ void operator()(const f32x4 (&acc)[2][2][4][2], const Unit& u, int wr, int wc, int fr, int fq) const {
        const int row0 = u.pm * BM + wr * 64 + fr, col0 = u.pn * BM + wc * 32 + 8 * fq;
#pragma unroll
        for (int ai = 0; ai < 2; ++ai)
#pragma unroll
            for (int m = 0; m < 4; ++m) { const int row = row0 + ai * HALF + m * 16; float ss = 0.f;
#pragma unroll
                for (int bj = 0; bj < 2; ++bj) { const int c = col0 + bj * HALF; const size_t off = (size_t)row * DM + c;
                    const f32x4 a0 = *(const f32x4*)(x + off), a1 = *(const f32x4*)(x + off + 4);
                    const f32x4 r0 = a0 + acc[ai][bj][m][0], r1 = a1 + acc[ai][bj][m][1];
                    ss += (r0[0] * r0[0] + r0[1] * r0[1]) + (r0[2] * r0[2] + r0[3] * r0[3]) + (r1[0] * r1[0] + r1[1] * r1[1]) + (r1[2] * r1[2] + r1[3] * r1[3]);
                    u32x4 w; w.x = pk2(r0[0], r0[1]); w.y = pk2(r0[2], r0[3]); w.z = pk2(r1[0], r1[1]); w.w = pk2(r1[2], r1[3]);
                    *(u32x4*)(P + (size_t)row * PLD + C_X1B + c) = w; }
                ss += __shfl_xor(ss, 16); ss += __shfl_xor(ss, 32);
                if (fq == 0) xl[(ai * HALF + wr * 64 + m * 16 + fr) * 4 + wc] = ss; }
        asm volatile("s_waitcnt lgkmcnt(0)" ::: "memory"); __builtin_amdgcn_s_barrier(); asm volatile("" ::: "memory");
        { const int t = (wr * 4 + wc) * 64 + fq * 16 + fr;
          if (t < 256) { const f32x4 p = *(const LAS f32x4*)(xl + t * 4); SSQ[(size_t)(u.pm * BM + t) * 4 + u.pn] = (p[0] + p[1]) + (p[2] + p[3]); } }
        asm volatile("s_waitcnt lgkmcnt(0)" ::: "memory"); __builtin_amdgcn_s_barrier(); asm volatile("" ::: "memory");
    }
};
template <int CTRL> __device__ __forceinline__ float dpp_mov(float old, float src) {
    return __builtin_bit_cast(float, __builtin_amdgcn_update_dpp(__builtin_bit_cast(int, old), __builtin_bit_cast(int, src), CTRL, 0xF, 0xF, false)); }
struct EpiUp {
    static constexpr bool PERM = true, AFTER_DRAIN = false, PREFETCH = true, RESCALE = false;
    const float* SSQ; const float* cw; const float* cb; bf16* P; float* UE; LAS float* xl;
    __device__ __forceinline__ void prefetch(const Unit& u, int buf, int tid) const {
        LAS float* d = xl + buf * 1280;
        if (tid < 256) { const int a = tid >> 5, c4 = (tid & 31) * 4, ch = u.pn * 128 + c4 + (a >= 4 ? DFF : 0), aa = a & 3;
            *(LAS f32x4*)(d + a * 128 + c4) = *(const f32x4*)((aa < 3 ? cw + aa * NUP : cb) + ch); }
        else { const int r = tid - 256; const f32x4 q = *(const f32x4*)(SSQ + (size_t)(u.pm * BM + r) * 4);
            d[1024 + r] = __builtin_amdgcn_rsqf(((q[0] + q[1]) + (q[2] + q[3])) * (1.0f / DM) + EPS); }
    }
    __device__ __forceinline__ void operator()(f32x4 (&acc)[2][2][4][2], const Unit& u, int wr, int wc, int fr, int fq) const {
        const int row0 = u.pm * BM + wr * 64 + fr;
        const LAS float* lw = xl + u.aux * 1280;
#pragma unroll
        for (int ai = 0; ai < 2; ++ai)
#pragma unroll
            for (int m = 0; m < 4; ++m) { const float rs = lw[1024 + ai * HALF + wr * 64 + m * 16 + fr];
#pragma unroll
                for (int bj = 0; bj < 2; ++bj)
#pragma unroll
                    for (int n = 0; n < 2; ++n) acc[ai][bj][m][n] *= rs; }
#pragma unroll
        for (int n = 0; n < 2; ++n) {
            const int c4 = wc * 32 + 8 * fq + 4 * n, a0 = u.pn * 128 + c4;
            const f32x4 wg0 = *(const LAS f32x4*)(lw + c4), wg1 = *(const LAS f32x4*)(lw + 128 + c4), wg2 = *(const LAS f32x4*)(lw + 256 + c4), bg = *(const LAS f32x4*)(lw + 384 + c4);
            const f32x4 wv0 = *(const LAS f32x4*)(lw + 512 + c4), wv1 = *(const LAS f32x4*)(lw + 640 + c4), wv2 = *(const LAS f32x4*)(lw + 768 + c4), bv = *(const LAS f32x4*)(lw + 896 + c4);
#pragma unroll
            for (int ai = 0; ai < 2; ++ai) {
                const int g64 = u.pm * 4 + ai * 2 + wr;
#pragma unroll
                for (int m = 0; m < 4; ++m) {
                    const f32x4 ugm = acc[ai][0][m][n], uvm = acc[ai][1][m][n], ugp = acc[ai][0][(m + 3) & 3][n], ugn = acc[ai][0][(m + 1) & 3][n], uvp = acc[ai][1][(m + 3) & 3][n], uvn = acc[ai][1][(m + 1) & 3][n];
                    f32x4 pg, ng, pvv, nv;
#pragma unroll
                    for (int i = 0; i < 4; ++i) {
                        pg[i] = dpp_mov<0x111>(dpp_mov<0x121>(0.f, ugp[i]), ugm[i]);
                        ng[i] = dpp_mov<0x101>(dpp_mov<0x12F>(0.f, ugn[i]), ugm[i]);
                        pvv[i] = dpp_mov<0x111>(dpp_mov<0x121>(0.f, uvp[i]), uvm[i]);
                        nv[i] = dpp_mov<0x101>(dpp_mov<0x12F>(0.f, uvn[i]), uvm[i]); }
                    const f32x4 gate = wg0 * pg + wg1 * ugm + wg2 * ng + bg;
                    const f32x4 val = wv0 * pvv + wv1 * uvm + wv2 * nv + bv;
                    const int row = row0 + ai * HALF + m * 16;
                    const bool edge = (m == 0 && fr == 0) || (m == 3 && fr == 15);
                    if (!edge) { u32x2 w; w.x = pk2(siluf_(gate[0]) * val[0], siluf_(gate[1]) * val[1]); w.y = pk2(siluf_(gate[2]) * val[2], siluf_(gate[3]) * val[3]);
                        *(u32x2*)(P + (size_t)row * PLD + C_ACT + a0) = w; }
                    if ((m == 0 && fr < 2) || (m == 3 && fr >= 14)) { const int slot = (m == 0) ? fr : fr - 12;
                        float* ue = UE + ((size_t)g64 * 4 + slot) * NUP;
                        *(f32x4*)(ue + a0) = ugm; *(f32x4*)(ue + DFF + a0) = uvm; }
                }
            }
        }
    }
};
struct EpiDown {
    static constexpr bool PERM = true, AFTER_DRAIN = false, PREFETCH = false, RESCALE = false;
    float* out; const bf16* P;
    __device__ __forceinline__ void operator()(const f32x4 (&acc)[2][2][4][2], const Unit& u, int wr, int wc, int fr, int fq) const {
        const int row0 = u.pm * BM + wr * 64 + fr, col0 = u.pn * BM + wc * 32 + 8 * fq;
#pragma unroll
        for (int ai = 0; ai < 2; ++ai)
#pragma unroll
            for (int m = 0; m < 4; ++m) { const int row = row0 + ai * HALF + m * 16;
#pragma unroll
                for (int bj = 0; bj < 2; ++bj) { const int c = col0 + bj * HALF; float xr[8]; unpack8(*(const u32x4*)(P + (size_t)row * PLD + C_X1B + c), xr);
                    const f32x4 v0 = acc[ai][bj][m][0], v1 = acc[ai][bj][m][1];
                    *(f32x4*)(out + (size_t)row * DM + c) = (f32x4){xr[0] + v0[0], xr[1] + v0[1], xr[2] + v0[2], xr[3] + v0[3]};
                    *(f32x4*)(out + (size_t)row * DM + c + 4) = (f32x4){xr[4] + v1[0], xr[5] + v1[1], xr[6] + v1[2], xr[7] + v1[3]}; } }
    }
};

template <int DH, int RSK, int RSV>
__device__ __forceinline__ void attn_tile(const LAS unsigned char* Kl, const LAS unsigned char* Vl, int jk, const bf16x8 (&qf)[DH / 16], f32x16 s0, f32x16 s1,
                                          float& m, float& l, f32x16 (&o)[DH / 32], int lane) {
    const int r32 = lane & 31, hi = lane >> 5;
    const LAS unsigned char* kp = Kl + (size_t)(jk + r32) * RSK + 16 * hi;
#pragma unroll
    for (int ks = 0; ks < DH / 16; ++ks) {
        const bf16x8 k0 = *(const LAS bf16x8*)(kp + 32 * ks), k1 = *(const LAS bf16x8*)(kp + 32 * RSK + 32 * ks);
        s0 = __builtin_amdgcn_mfma_f32_32x32x16_bf16(k0, qf[ks], s0, 0, 0, 0);
        s1 = __builtin_amdgcn_mfma_f32_32x32x16_bf16(k1, qf[ks], s1, 0, 0, 0);
    }
    const int g = lane >> 4, q4 = (lane & 15) >> 2, p = lane & 3;
    const unsigned va = (unsigned)(uintptr_t)Vl + (unsigned)(jk + 4 * hi + q4) * RSV + (16 * (g & 1) + 4 * p) * 2;
    s16x4 vlo[2][4], vhi[2][4];
#define ATT_VREAD(set, db) do { _Pragma("unroll") for (int kk = 0; kk < 4; ++kk) { \
        asm volatile("ds_read_b64_tr_b16 %0, %1 offset:%c2" : "=&v"(vlo[set][kk]) : "v"(va), "i"((16 * kk) * RSV + 64 * (db)) : "memory"); \
        asm volatile("ds_read_b64_tr_b16 %0, %1 offset:%c2" : "=&v"(vhi[set][kk]) : "v"(va), "i"((16 * kk + 8) * RSV + 64 * (db)) : "memory"); } } while (0)
    ATT_VREAD(0, 0);
    float mx = fmaxf(s0[0], s1[0]);
#pragma unroll
    for (int r = 1; r < 16; ++r) mx = fmaxf(mx, fmaxf(s0[r], s1[r]));
    mx = fmaxf(mx, __shfl_xor(mx, 32));
    const float mn = fmaxf(m, mx), f = fexp2(m - mn);
    m = mn; l *= f;
#pragma unroll
    for (int db = 0; db < DH / 32; ++db)
#pragma unroll
        for (int r = 0; r < 16; ++r) o[db][r] *= f;
    float ps = 0.f;
#pragma unroll
    for (int r = 0; r < 16; ++r) { s0[r] = fexp2(s0[r] - mn); s1[r] = fexp2(s1[r] - mn); ps += s0[r] + s1[r]; }
    l += ps;
    bf16x8 pf[4];
    { u32x4 w;
      w.x = pk2(s0[0], s0[1]); w.y = pk2(s0[2], s0[3]); w.z = pk2(s0[4], s0[5]); w.w = pk2(s0[6], s0[7]); pf[0] = __builtin_bit_cast(bf16x8, w);
      w.x = pk2(s0[8], s0[9]); w.y = pk2(s0[10], s0[11]); w.z = pk2(s0[12], s0[13]); w.w = pk2(s0[14], s0[15]); pf[1] = __builtin_bit_cast(bf16x8, w);
      w.x = pk2(s1[0], s1[1]); w.y = pk2(s1[2], s1[3]); w.z = pk2(s1[4], s1[5]); w.w = pk2(s1[6], s1[7]); pf[2] = __builtin_bit_cast(bf16x8, w);
      w.x = pk2(s1[8], s1[9]); w.y = pk2(s1[10], s1[11]); w.z = pk2(s1[12], s1[13]); w.w = pk2(s1[14], s1[15]); pf[3] = __builtin_bit_cast(bf16x8, w); }
#pragma unroll
    for (int db = 0; db < DH / 32; ++db) {
        asm volatile("s_waitcnt lgkmcnt(0)" ::: "memory"); __builtin_amdgcn_sched_barrier(0);
        if (db + 1 < DH / 32) { if ((db & 1) == 0) ATT_VREAD(1, db + 1); else ATT_VREAD(0, db + 1); }
#pragma unroll
        for (int kk = 0; kk < 4; ++kk) { const s16x4 lo = vlo[db & 1][kk], h4 = vhi[db & 1][kk];
            const bf16x8 vf = (bf16x8){lo[0], lo[1], lo[2], lo[3], h4[0], h4[1], h4[2], h4[3]};
            o[db] = __builtin_amdgcn_mfma_f32_32x32x16_bf16(vf, pf[kk], o[db], 0, 0, 0); }
        __builtin_amdgcn_sched_barrier(0);
    }
#undef ATT_VREAD
}
__device__ __forceinline__ void load_bias(const float* biasrow, int hi, f32x16& s0, f32x16& s1) {
#pragma unroll
    for (int g4 = 0; g4 < 4; ++g4) { const f32x4 c0 = *(const f32x4*)(biasrow + 8 * g4 + 4 * hi), c1 = *(const f32x4*)(biasrow + 32 + 8 * g4 + 4 * hi);
#pragma unroll
        for (int i = 0; i < 4; ++i) { s0[4 * g4 + i] = c0[i]; s1[4 * g4 + i] = c1[i]; } }
}
template <int DH>
__device__ __forceinline__ void load_q(const bf16* qrow, const float* gq, float scale, bf16x8 (&qf)[DH / 16], int lane) {
    const int hi = lane >> 5;
    u32x4 w[DH / 16]; float ss = 0.f;
#pragma unroll
    for (int ks = 0; ks < DH / 16; ++ks) { w[ks] = *(const u32x4*)(qrow + 16 * ks + 8 * hi); float v[8]; unpack8(w[ks], v);
#pragma unroll
        for (int j = 0; j < 8; ++j) ss += v[j] * v[j]; }
    ss += __shfl_xor(ss, 32);
    const float rstd = __builtin_amdgcn_rsqf(ss * (1.0f / DH) + EPS) * scale;
#pragma unroll
    for (int ks = 0; ks < DH / 16; ++ks) { float v[8]; unpack8(w[ks], v);
        const f32x4 g0 = *(const f32x4*)(gq + 16 * ks + 8 * hi), g1 = *(const f32x4*)(gq + 16 * ks + 8 * hi + 4);
#pragma unroll
        for (int j = 0; j < 4; ++j) { v[j] *= rstd * g0[j]; v[4 + j] *= rstd * g1[j]; }
        qf[ks] = __builtin_bit_cast(bf16x8, pack8(v)); }
}
template <int DH>
__device__ __forceinline__ void store_o(bf16* yrow, const f32x16 (&o)[DH / 32], float l, int lane) {
    const int hi = lane >> 5;
    const float inv = frcp(l + __shfl_xor(l, 32));
#pragma unroll
    for (int db = 0; db < DH / 32; ++db)
#pragma unroll
        for (int g4 = 0; g4 < 4; ++g4) { u32x2 w; w.x = pk2(o[db][4 * g4] * inv, o[db][4 * g4 + 1] * inv); w.y = pk2(o[db][4 * g4 + 2] * inv, o[db][4 * g4 + 3] * inv);
            *(u32x2*)(yrow + 32 * db + 8 * g4 + 4 * hi) = w; }
}
template <int DH, int RSK, int RSV>
__device__ __forceinline__ void stage_kv(LAS unsigned char* Kl, LAS unsigned char* Vl, int ldsrow0, const bf16* src, size_t pitch, int kcol, int vcol, int nrows, const float* gk, int tid) {
    constexpr int CPR = DH / 8;
    for (int c = tid; c < nrows * CPR; c += 512) {
        const int row = c / CPR, ch = c % CPR;
        const bf16* rp = src + (size_t)row * pitch;
        const u32x4 kw = *(const u32x4*)(rp + kcol + ch * 8), vw = *(const u32x4*)(rp + vcol + ch * 8);
        float v[8]; unpack8(kw, v); float ss = 0.f;
#pragma unroll
        for (int j = 0; j < 8; ++j) ss += v[j] * v[j];
#pragma unroll
        for (int o = 1; o < CPR; o <<= 1) ss += __shfl_xor(ss, o);
        const float rstd = __builtin_amdgcn_rsqf(ss * (1.0f / DH) + EPS);
        const f32x4 g0 = *(const f32x4*)(gk + ch * 8), g1 = *(const f32x4*)(gk + ch * 8 + 4);
#pragma unroll
        for (int j = 0; j < 4; ++j) { v[j] *= rstd * g0[j]; v[4 + j] *= rstd * g1[j]; }
        *(LAS u32x4*)(Kl + (size_t)(ldsrow0 + row) * RSK + ch * 16) = pack8(v);
        *(LAS u32x4*)(Vl + (size_t)(ldsrow0 + row) * RSV + ch * 16) = vw;
    }
}

constexpr int NWAVES = 8;
constexpr size_t MiB = 1u << 20;
constexpr size_t WS_CTL = 0, CTL_ZERO_BYTES = 1 * MiB;
constexpr size_t WS_WIN = 2 * MiB;
constexpr size_t WS_WBR = 15 * MiB;
constexpr size_t WS_WOUT = 18 * MiB;
constexpr size_t WS_WUP = 20 * MiB;
constexpr size_t WS_WDN = 31 * MiB;
constexpr size_t WS_WKV = 37 * MiB;
constexpr size_t WS_MEMN = 39 * MiB;
constexpr size_t WS_KV = 41 * MiB;
constexpr size_t WS_BT = 43 * MiB;
constexpr size_t WS_BA = 45 * MiB;
constexpr size_t WS_SSQ = 49 * MiB;
constexpr size_t WS_P = 52 * MiB;
constexpr size_t WS_UE = 452 * MiB;
constexpr size_t WS_END = 512 * MiB;
static_assert(WS_P + (size_t)M * PLD * 2 == WS_UE && WS_UE + (size_t)512 * 4 * NUP * 4 <= WS_END, "d_ws map");

constexpr int CW_TMO = 0, CW_CODE = 1;
constexpr int CW_BAR = 4096;
constexpr int RING_OFF = 0, RING_BYTES = 147456;
constexpr int LDSCTL_OFF = RING_BYTES, MISC_OFF = LDSCTL_OFF + 320;
constexpr int XCH_OFF = MISC_OFF + 256;
constexpr int LDS_BYTES = 163840;
static_assert(XCH_OFF + 2 * 1280 * 4 <= LDS_BYTES && XCH_OFF % 16 == 0, "LDS map");

typedef GAS unsigned gu32;
#define RLX_AGENT __ATOMIC_RELAXED, __HIP_MEMORY_SCOPE_AGENT
#define LDS_WAIT() asm volatile("s_waitcnt lgkmcnt(0)" ::: "memory")
#define VM_WAIT() asm volatile("s_waitcnt vmcnt(0)" ::: "memory")

#define XB_TMO      128
#define XB_XCNT(j)  (256  + 64 * (j))
#define XB_XSUB(j)  (1280 + 64 * (j))
#define XB_XGEN(j)  (2304 + 64 * (j))
#define XB_TOP      3328
#define XB_TOPGEN   3392
#define XCD_BAR_WORDS 3456
#define XB_SPIN_CAP (1u << 22)

__device__ __forceinline__ unsigned xb_ld(unsigned* p)              { return __hip_atomic_load(p, __ATOMIC_RELAXED, __HIP_MEMORY_SCOPE_AGENT); }
__device__ __forceinline__ unsigned xb_add(unsigned* p, unsigned v) { return __hip_atomic_fetch_add(p, v, __ATOMIC_RELAXED, __HIP_MEMORY_SCOPE_AGENT); }
__device__ __forceinline__ unsigned xb_xcc_id() { return (unsigned)__builtin_amdgcn_s_getreg((3 << 11) | 20) & 0xFu; }
#define XB_SPIN(cond, bar) do { unsigned _sp = 0; while (cond) { __builtin_amdgcn_s_sleep(1); \
    if ((++_sp & 255u) == 0u) { if (xb_ld(&(bar)[XB_TMO])) break; if (_sp > XB_SPIN_CAP) { atomicAdd(&(bar)[XB_TMO], 1u); break; } } } } while (0)

struct XcdBarrier { unsigned* bar; unsigned x; volatile LAS unsigned* st; };

__device__ __forceinline__ XcdBarrier xcd_barrier_post(unsigned* bar, volatile LAS unsigned* st) {
    XcdBarrier b; b.bar = bar; b.x = xb_xcc_id(); b.st = st;
    if (threadIdx.x == 0) (void)xb_add(&bar[XB_XCNT(b.x)], 1u);
    return b;
}
__device__ __forceinline__ void xcd_barrier_complete(unsigned* bar, unsigned x, unsigned& nloc, unsigned& nx) {
    const unsigned G = gridDim.x * gridDim.y * gridDim.z;
    unsigned sum, cnt, mine, sp = 0u;
    for (;;) {
        sum = 0u; cnt = 0u; mine = 0u;
#pragma unroll
        for (unsigned j = 0; j < 16; ++j) { const unsigned c = xb_ld(&bar[XB_XCNT(j)]); sum += c; cnt += (c > 0u) ? 1u : 0u; mine = (j == x) ? c : mine; }
        if (sum == G) break;
        __builtin_amdgcn_s_sleep(1);
        if ((++sp & 255u) == 0u) { if (xb_ld(&bar[XB_TMO])) break; if (sp > XB_SPIN_CAP) { atomicAdd(&bar[XB_TMO], 1u); break; } }
    }
    nloc = mine > 0u ? mine : 1u; nx = cnt > 0u ? cnt : 1u;
}
__device__ __forceinline__ void xcd_barrier(const XcdBarrier& b) {
    asm volatile("s_waitcnt vmcnt(0)" ::: "memory");
    __syncthreads();
    if (threadIdx.x == 0) {
        unsigned* bar = b.bar;
        __builtin_amdgcn_s_waitcnt(0);
        unsigned nloc = b.st[0], nx = b.st[1];
        if (nloc == 0u) { xcd_barrier_complete(bar, b.x, nloc, nx); b.st[0] = nloc; b.st[1] = nx; }
        const unsigned old = xb_add(&bar[XB_XSUB(b.x)], 1u);
        const unsigned gen = old / nloc;
        if (old + 1u == (gen + 1u) * nloc) {
            __builtin_amdgcn_fence(__ATOMIC_RELEASE, "agent");
            asm volatile("s_waitcnt vmcnt(0)" ::: "memory");
            const unsigned og = xb_add(&bar[XB_TOP], 1u);
            const unsigned tg = og / nx;
            if (og + 1u == (tg + 1u) * nx) xb_add(&bar[XB_TOPGEN], 1u);
            else XB_SPIN(xb_ld(&bar[XB_TOPGEN]) == tg, bar);
            __builtin_amdgcn_fence(__ATOMIC_ACQUIRE, "agent");
            xb_add(&bar[XB_XGEN(b.x)], 1u);
            asm volatile("s_waitcnt vmcnt(0)" ::: "memory");
        } else {
            XB_SPIN(xb_ld(&bar[XB_XGEN(b.x)]) == gen, bar);
            __builtin_amdgcn_fence(__ATOMIC_ACQUIRE, "agent");
            asm volatile("s_waitcnt vmcnt(0)" ::: "memory");
        }
    }
    __syncthreads();
}

struct Frame {
    LAS unsigned char* lds;
    volatile LAS unsigned* MISC;
    gu32* ctl;
    int tid, lane, wave, vcu, G;
};

__device__ __forceinline__ float wave_sum(float v) {
#pragma unroll
    for (int o = 1; o < 64; o <<= 1) v += __shfl_xor(v, o);
    return v;
}
__device__ __forceinline__ int t5_bucket(int rel) {
    const int n = rel < 0 ? -rel : rel;
    const int mag = n < 8 ? n : n < 12 ? 8 : n < 16 ? 9 : n < 23 ? 10 : n < 32 ? 11 : n < 46 ? 12 : n < 64 ? 13 : n < 91 ? 14 : 15;
    return (rel > 0 ? 16 : 0) + mag;
}

__device__ __forceinline__ void transpose_item(const float* W, int K, int N, int k0, int n0, bf16* WT, int drow0, const float* gk, LAS float* scr, int lane) {
    { f32x4 v[8];
#pragma unroll
      for (int i = 0; i < 8; ++i) v[i] = *(const f32x4*)(W + (size_t)(k0 + 8 * i + (lane >> 3)) * N + n0 + 4 * (lane & 7));
#pragma unroll
      for (int i = 0; i < 8; ++i) { const int kk = 8 * i + (lane >> 3); const float gs = gk ? gk[k0 + kk] : 1.0f; LAS float* d = scr + kk * 33 + 4 * (lane & 7);
          d[0] = v[i][0] * gs; d[1] = v[i][1] * gs; d[2] = v[i][2] * gs; d[3] = v[i][3] * gs; } }
    LDS_WAIT(); asm volatile("" ::: "memory");
    const int c = lane & 7;
#pragma unroll
    for (int j = 0; j < 4; ++j) { const int n = (lane >> 3) + 8 * j; const LAS float* s = scr + (8 * c) * 33 + n;
        u32x4 o; o.x = pk2(s[0 * 33], s[1 * 33]); o.y = pk2(s[2 * 33], s[3 * 33]); o.z = pk2(s[4 * 33], s[5 * 33]); o.w = pk2(s[6 * 33], s[7 * 33]);
        *(GAS u32x4*)(WT + (size_t)(drow0 + n) * K + k0 + 8 * c) = o; }
    LDS_WAIT(); asm volatile("" ::: "memory");
}
__device__ __forceinline__ void rms_row_to_bf16(const float* xrow, const float* g, bf16* orow, int lane) {
    const GAS f32x4* xr = (const GAS f32x4*)xrow + lane;
    const GAS f32x4* gr = (const GAS f32x4*)g + lane;
    f32x4 v[4]; float s = 0.f;
#pragma unroll
    for (int j = 0; j < 4; ++j) { v[j] = xr[64 * j]; s += (v[j].x * v[j].x + v[j].y * v[j].y) + (v[j].z * v[j].z + v[j].w * v[j].w); }
    const float rstd = __builtin_amdgcn_rsqf(wave_sum(s) * (1.f / DM) + EPS);
    GAS unsigned long long* o8 = (GAS unsigned long long*)orow + lane;
#pragma unroll
    for (int j = 0; j < 4; ++j) { const f32x4 gg = gr[64 * j];
        o8[64 * j] = (unsigned long long)pk2(v[j].x * rstd * gg.x, v[j].y * rstd * gg.y) | ((unsigned long long)pk2(v[j].z * rstd * gg.z, v[j].w * rstd * gg.w) << 32); }
}

__device__ __forceinline__ void rms_row2_to_bf16(const float* xa, const float* xb, const float* g, bf16* oa, bf16* ob, int lane) {
    const GAS f32x4* xr0 = (const GAS f32x4*)xa + lane; const GAS f32x4* xr1 = (const GAS f32x4*)xb + lane;
    const GAS f32x4* gr = (const GAS f32x4*)g + lane;
    f32x4 v0[4], v1[4]; float s0 = 0.f, s1 = 0.f;
#pragma unroll
    for (int j = 0; j < 4; ++j) { v0[j] = xr0[64 * j]; v1[j] = xr1[64 * j]; }
#pragma unroll
    for (int j = 0; j < 4; ++j) { s0 += (v0[j].x * v0[j].x + v0[j].y * v0[j].y) + (v0[j].z * v0[j].z + v0[j].w * v0[j].w); s1 += (v1[j].x * v1[j].x + v1[j].y * v1[j].y) + (v1[j].z * v1[j].z + v1[j].w * v1[j].w); }
#pragma unroll
    for (int o = 1; o < 64; o <<= 1) { s0 += __shfl_xor(s0, o); s1 += __shfl_xor(s1, o); }
    const float r0 = __builtin_amdgcn_rsqf(s0 * (1.f / DM) + EPS), r1 = __builtin_amdgcn_rsqf(s1 * (1.f / DM) + EPS);
    GAS unsigned long long* o0 = (GAS unsigned long long*)oa + lane; GAS unsigned long long* o1 = (GAS unsigned long long*)ob + lane;
#pragma unroll
    for (int j = 0; j < 4; ++j) { const f32x4 gg = gr[64 * j];
        o0[64 * j] = (unsigned long long)pk2(v0[j].x * r0 * gg.x, v0[j].y * r0 * gg.y) | ((unsigned long long)pk2(v0[j].z * r0 * gg.z, v0[j].w * r0 * gg.w) << 32);
        o1[64 * j] = (unsigned long long)pk2(v1[j].x * r1 * gg.x, v1[j].y * r1 * gg.y) | ((unsigned long long)pk2(v1[j].z * r1 * gg.z, v1[j].w * r1 * gg.w) << 32); }
}

struct Args { const float* in[25]; float* out; unsigned char* ws; int ph_lo, ph_hi, mode, pad; };

__device__ __forceinline__ void p0_prologue(Frame& F, const Args& a) {
    unsigned char* ws = a.ws;
    LAS float* scr = (LAS float*)(F.lds + RING_OFF + F.wave * 16384);
    const int gw = F.vcu * NWAVES + F.wave, NGW = F.G * NWAVES;
    constexpr int I_IN = 16 * 201, I_BR = 8 * 32, I_OUT = 16 * 32, I_UP = 16 * 176, I_DN = 44 * 32, I_KV = 16 * 32;
    constexpr int NITEMS = I_IN + 3 * I_BR + I_OUT + I_UP + I_DN + I_KV;
    for (int it = gw; it < NITEMS; it += NGW) {
        int r = it;
        if (r < I_IN) { const int kb = r / 201, nb = r % 201, n0 = nb * 32;
            const int d0 = n0 < 2816 ? n0 : (n0 < 2848 ? 3328 + (n0 - 2816) : (n0 < 3360 ? n0 - 32 : 3584 + (n0 - 3360)));
            transpose_item(a.in[4], 1024, 6432, kb * 64, n0, (bf16*)(ws + WS_WIN), d0, nullptr, scr, F.lane); continue; }
        r -= I_IN;
        if (r < 3 * I_BR) { const int br = r / I_BR, q = r % I_BR, kb = q / 32, nb = q % 32;
            transpose_item(a.in[16 + br], 512, 1024, kb * 64, nb * 32, (bf16*)(ws + WS_WBR) + (size_t)br * 1024 * 512, nb * 32, nullptr, scr, F.lane); continue; }
        r -= 3 * I_BR;
        if (r < I_OUT) { const int kb = r / 32, nb = r % 32;
            transpose_item(a.in[19], 1024, 1024, kb * 64, nb * 32, (bf16*)(ws + WS_WOUT), nb * 32, nullptr, scr, F.lane); continue; }
        r -= I_OUT;
        if (r < I_UP) { const int kb = r / 176, nb = r % 176, n0 = nb * 32;
            const int isv = n0 >= DFF, nn = isv ? n0 - DFF : n0, d0 = (nn >> 7) * 256 + isv * 128 + (nn & 127);
            transpose_item(a.in[21], 1024, NUP, kb * 64, n0, (bf16*)(ws + WS_WUP), d0, a.in[20], scr, F.lane); continue; }
        r -= I_UP;
        if (r < I_DN) { const int kb = r / 32, nb = r % 32;
            transpose_item(a.in[24], DFF, 1024, kb * 64, nb * 32, (bf16*)(ws + WS_WDN), nb * 32, nullptr, scr, F.lane); continue; }
        r -= I_DN;
        { const int kb = r / 32, nb = r % 32;
            transpose_item(a.in[13], 1024, 1024, kb * 64, nb * 32, (bf16*)(ws + WS_WKV), nb * 32, nullptr, scr, F.lane); }
    }
    { u32x4* z = (u32x4*)((bf16*)(ws + WS_WIN) + (size_t)3360 * 1024); const int n16 = 224 * 1024 * 2 / 16;
      for (int i = blockIdx.x * 512 + F.tid; i < n16; i += F.G * 512) z[i] = (u32x4){0u, 0u, 0u, 0u}; }
    bf16* H = (bf16*)a.out;
    if (M % (2 * NGW) != 0) { for (int m = gw; m < M; m += NGW) rms_row_to_bf16(a.in[0] + (size_t)m * DM, a.in[3], H + (size_t)m * DM, F.lane); }
    else for (int m = gw; m < M; m += 2 * NGW) rms_row2_to_bf16(a.in[0] + (size_t)m * DM, a.in[0] + (size_t)(m + NGW) * DM, a.in[3], H + (size_t)m * DM, H + (size_t)(m + NGW) * DM, F.lane);
    for (int m = gw; m < BATCH * NMEM; m += NGW) rms_row_to_bf16(a.in[1] + (size_t)m * DM, a.in[12], (bf16*)(ws + WS_MEMN) + (size_t)m * DM, F.lane);
    { float* BT = (float*)(ws + WS_BT); const float* tab = a.in[2];
      for (int i = blockIdx.x * 512 + F.tid; i < 8 * 128 * 384; i += F.G * 512) { const int j = i % 384, t = (i / 384) % 128, h = i / (384 * 128);
          const int rel = j - 128 - t; const bool ok = rel >= -128 && rel <= 128;
          BT[i] = ok ? tab[t5_bucket(rel) * 8 + h] * LOG2E : -INFINITY; } }
}

__device__ __forceinline__ void attnA_unit(Frame& F, const Args& a, int b, int n, int kvh) {
    constexpr int RSK = 144, RSV = 128;
    LAS unsigned char* Kl = F.lds; LAS unsigned char* Vl = F.lds + 384 * RSK;
    bf16* P = (bf16*)(a.ws + WS_P);
    const float* BT = (const float*)(a.ws + WS_BT);
    for (int blk = 0; blk < 3; ++blk) { const int pos0 = n * 128 - 128 + blk * 128; if (pos0 < 0 || pos0 >= SEQ) continue;
        stage_kv<64, RSK, RSV>(Kl, Vl, blk * 128, P + (size_t)(b * SEQ + pos0) * PLD, PLD, C_AK + kvh * 64, C_AV + kvh * 64, 128, a.in[6], F.tid); }
    LDS_WAIT(); __syncthreads();
    const int h = kvh * 4 + (F.wave >> 1), r32 = F.lane & 31, hi = F.lane >> 5;
    const float sink = a.in[7][h] * LOG2E;
#pragma unroll 1
    for (int qb = 0; qb < 2; ++qb) {
        const int t0 = (F.wave & 1) * 64 + qb * 32, t = t0 + r32;
        bf16* qrow = P + (size_t)(b * SEQ + n * 128 + t) * PLD + C_AQ + h * 64;
        bf16x8 qf[4]; load_q<64>(qrow, a.in[5], 0.125f * LOG2E, qf, F.lane);
        float m = sink, l = hi == 0 ? 1.f : 0.f; f32x16 o[2];
#pragma unroll
        for (int r = 0; r < 16; ++r) { o[0][r] = 0.f; o[1][r] = 0.f; }
        const int lo = max(t0 >= 64 ? 1 : 0, n == 0 ? 2 : 0), hi_t = min(t0 >= 64 ? 5 : 4, n == SEQ / 128 - 1 ? 3 : 5);
        const float* brow = BT + ((size_t)h * 128 + t) * 384;
        f32x16 b0, b1; load_bias(brow + 64 * lo, hi, b0, b1);
#pragma unroll 1
        for (int kt = lo; kt <= hi_t; ++kt) {
            f32x16 nb0 = b0, nb1 = b1;
            if (kt < hi_t) load_bias(brow + 64 * (kt + 1), hi, nb0, nb1);
            attn_tile<64, RSK, RSV>(Kl, Vl, 64 * kt, qf, b0, b1, m, l, o, F.lane);
            b0 = nb0; b1 = nb1; }
        store_o<64>(qrow, o, l, F.lane);
    }
    LDS_WAIT(); __syncthreads();
}
__device__ __forceinline__ void xattn_unit(Frame& F, const Args& a, int b, int tb, int h) {
    constexpr int RSK = 272, RSV = 320;
    LAS unsigned char* Kl = F.lds; LAS unsigned char* Vl = F.lds + 128 * RSK;
    bf16* P = (bf16*)(a.ws + WS_P);
    const bf16* KV = (const bf16*)(a.ws + WS_KV);
    const int r32 = F.lane & 31;
    bf16* qrow = P + (size_t)(b * SEQ + tb * 256 + F.wave * 32 + r32) * PLD + C_MQ + h * 128;
    bf16x8 qf[8]; load_q<128>(qrow, a.in[14], 0.08838834764831845f * LOG2E, qf, F.lane);
    float m = -1e30f, l = 0.f; f32x16 o[4];
#pragma unroll
    for (int db = 0; db < 4; ++db)
#pragma unroll
        for (int r = 0; r < 16; ++r) o[db][r] = 0.f;
#pragma unroll 1
    for (int half = 0; half < 2; ++half) {
        stage_kv<128, RSK, RSV>(Kl, Vl, 0, KV + (size_t)(b * NMEM + half * 128) * 1024, 1024, h * 128, 512 + h * 128, 128, a.in[15], F.tid);
        LDS_WAIT(); __syncthreads();
#pragma unroll 1
        for (int kt = 0; kt < 2; ++kt) { f32x16 z0, z1;
#pragma unroll
            for (int r = 0; r < 16; ++r) { z0[r] = 0.f; z1[r] = 0.f; }
            attn_tile<128, RSK, RSV>(Kl, Vl, 64 * kt, qf, z0, z1, m, l, o, F.lane); }
        LDS_WAIT(); __syncthreads();
    }
    store_o<128>(qrow, o, l, F.lane);
}


constexpr int SAF = C_GATE, SCF = C_GATE + 512, SBF = C_GATE + 1024, SDF = C_GATE + 1536, SAB = C_GATE + 2048, SCB = C_GATE + 2560;
constexpr int C_OF = C_DQ, C_OB = C_DK;
__device__ __forceinline__ int dn_pcol(int x) { return (x & 32) + 8 * ((x & 15) >> 2) + 4 * ((x >> 4) & 1) + (x & 3); }
__device__ __forceinline__ bf16x8 frag_lo(const LAS unsigned char* p) { const u32x2 a0 = *(const LAS u32x2*)p; u32x4 w; w.x = a0.x; w.y = a0.y; w.z = 0u; w.w = 0u; return __builtin_bit_cast(bf16x8, w); }
__device__ __forceinline__ bf16x8 frag_2(const LAS unsigned char* p) { const u32x2 a0 = *(const LAS u32x2*)p, a1 = *(const LAS u32x2*)(p + 32); u32x4 w; w.x = a0.x; w.y = a0.y; w.z = a1.x; w.w = a1.y; return __builtin_bit_cast(bf16x8, w); }
__device__ __forceinline__ bf16x8 pack_f4z(const f32x4 a) { u32x4 w; w.x = pk2(a[0], a[1]); w.y = pk2(a[2], a[3]); w.z = 0u; w.w = 0u; return __builtin_bit_cast(bf16x8, w); }
__device__ __forceinline__ bf16x8 pack_f4f4(const f32x4 a, const f32x4 b) { u32x4 w; w.x = pk2(a[0], a[1]); w.y = pk2(a[2], a[3]); w.z = pk2(b[0], b[1]); w.w = pk2(b[2], b[3]); return __builtin_bit_cast(bf16x8, w); }
__device__ __forceinline__ void dn_prep_block(Frame& F, const Args& a, int b, int h, int c0, int nch) {
    LAS float* raw = (LAS float*)(F.lds);
    LAS unsigned char* NL = F.lds;
    LAS unsigned char* TD = F.lds + 18432;
    LAS unsigned char* Qb = F.lds + 53248;
    LAS unsigned char* Kb = F.lds + 62464;
    LAS unsigned char* Vb = F.lds + 71680;
    LAS float* sm = (LAS float*)(F.lds + 80896);
    LAS float* gt = sm;
    LAS float* btk = sm + 128;
    LAS float* gct = sm + 256;
    LAS float* cu = sm + 384;
    LAS float* cwp = sm + 512;
    LAS float* egp = sm + 640;
    LAS float* esp = sm + 768;
    LAS unsigned char* QKL = F.lds + 24576;
    LAS unsigned char* KT = F.lds + 84480;
    LAS unsigned char* QT = F.lds + 104960;
    bf16* P = (bf16*)(a.ws + WS_P);
    float* BA = (float*)(a.ws + WS_BA);
    bf16* XB2 = (bf16*)a.out + (size_t)M * 1024;
    const float* cw = a.in[8];
    const int w = F.wave, lane = F.lane, tid = F.tid;
    float wt[3][5];
#pragma unroll
    for (int which = 0; which < 3; ++which)
#pragma unroll
        for (int j = 0; j < 5; ++j) wt[which][j] = cw[j * 1536 + which * 512 + h * 64 + lane];
    const float Ah = expf(a.in[9][(tid >> 6 & 1) * 8 + h]), dtb = a.in[10][(tid >> 6 & 1) * 8 + h];
    u32x4 rr[4]; float pa = 0.f, pb = 0.f;
#define DN_PREFETCH(cidx) do { const int t0p_ = (cidx) * 64; \
        _Pragma("unroll") for (int i_ = 0; i_ < 4; ++i_) { const int e = tid + 512 * i_, row = e / 24, c8 = e % 24, which = c8 >> 3, t = t0p_ - 2 + row; \
            rr[i_] = (u32x4){0u, 0u, 0u, 0u}; \
            if (e < 68 * 24 && t >= 0 && t < SEQ) rr[i_] = *(const u32x4*)(P + ((size_t)b * SEQ + t) * PLD + (which == 0 ? C_DQ : which == 1 ? C_DK : C_DV) + h * 64 + (c8 & 7) * 8); } \
        if (tid < 128) { const size_t tok = (size_t)b * SEQ + t0p_ + (tid & 63); pa = BA[tok * 32 + 16 + (tid >> 6) * 8 + h]; pb = BA[tok * 32 + (tid >> 6) * 8 + h]; } } while (0)
    DN_PREFETCH(c0);
#pragma unroll 1
  for (int ci = 0; ci < nch; ++ci) {
    int tid_o = F.tid; asm volatile("" : "+v"(tid_o));
    const int tid = tid_o, lane = tid & 63;
    const int c = c0 + ci, t0 = c * 64;
    const size_t tok0 = (size_t)b * SEQ + t0;
#pragma unroll
    for (int i_ = 0; i_ < 4; ++i_) { const int e = tid + 512 * i_, row = e / 24, c8 = e % 24;
        if (e < 68 * 24) { float v[8]; unpack8(rr[i_], v);
            *(LAS f32x4*)(raw + row * 192 + c8 * 8) = (f32x4){v[0], v[1], v[2], v[3]}; *(LAS f32x4*)(raw + row * 192 + c8 * 8 + 4) = (f32x4){v[4], v[5], v[6], v[7]}; } }
    if (tid < 128) { const int d = tid >> 6, i = tid & 63; const float xa = pa + dtb;
        gt[d * 64 + i] = -Ah * (fmaxf(xa, 0.f) + __logf(1.0f + __expf(-fabsf(xa))));
        btk[d * 64 + i] = sigmoidf_(pb); }
    if (ci + 1 < nch) DN_PREFETCH(c + 1);
    LDS_WAIT(); __syncthreads();
#pragma unroll
    for (int which = 0; which < 3; ++which) {
        float x[12], y[8];
#pragma unroll
        for (int j = 0; j < 12; ++j) x[j] = raw[(w * 8 + j) * 192 + which * 64 + lane];
#pragma unroll
        for (int r = 0; r < 8; ++r) { float acc = 0.f;
#pragma unroll
            for (int j = 0; j < 5; ++j) acc += x[r + j] * wt[which][j];
            y[r] = siluf_(acc); }
        if (which < 2) {
            float ss[8];
#pragma unroll
            for (int r = 0; r < 8; ++r) ss[r] = y[r] * y[r];
#pragma unroll
            for (int o = 1; o < 64; o <<= 1)
#pragma unroll
                for (int r = 0; r < 8; ++r) ss[r] += __shfl_xor(ss[r], o);
#pragma unroll
            for (int r = 0; r < 8; ++r) y[r] *= __builtin_amdgcn_rsqf(ss[r] + EPS) * (which == 0 ? 0.125f : 1.0f);
        }
        LAS unsigned char* X = which == 0 ? Qb : which == 1 ? Kb : Vb;
#pragma unroll
        for (int r = 0; r < 8; ++r) *(LAS bf16*)(X + (w * 8 + r) * 144 + lane * 2) = (bf16)(pk2(y[r], 0.f) & 0xffffu);
        asm volatile("" ::: "memory");
    }
    if (w < 2) { const int i = w ? 63 - lane : lane; float gv = gt[w * 64 + i];
#pragma unroll
        for (int o = 1; o < 64; o <<= 1) { const float t = __shfl_up(gv, o); if (lane >= o) gv += t; }
        const float glast = __shfl(gv, 63), bt = btk[w * 64 + i], eg = __expf(gv);
        const float es = __expf(glast - gv);
        gct[w * 64 + i] = gv; cu[w * 64 + lane] = bt; cwp[w * 64 + lane] = bt * eg; egp[w * 64 + lane] = eg; esp[w * 64 + lane] = es;
        BA[(tok0 + lane) * 32 + w * 8 + h] = eg; }
    LDS_WAIT(); __syncthreads();
    { const int p = tid >> 3, c8 = tid & 7;
#pragma unroll
      for (int d = 0; d < 2; ++d) { const int i = d ? 63 - p : p; const float es = esp[d * 64 + p], eg = egp[d * 64 + p]; float v[8];
          unpack8(*(const LAS u32x4*)(Kb + i * 144 + c8 * 16), v);
#pragma unroll
          for (int j = 0; j < 8; ++j) v[j] *= es;
          *(LAS u32x4*)(KT + d * 10240 + p * 160 + c8 * 16) = pack8(v);
          unpack8(*(const LAS u32x4*)(Qb + i * 144 + c8 * 16), v);
#pragma unroll
          for (int j = 0; j < 8; ++j) v[j] *= eg;
          *(LAS u32x4*)(QT + d * 9216 + p * 144 + c8 * 16) = pack8(v); } }
    { const int wq = w & 3, tm = wq >> 1, tn = wq & 1, r32 = lane & 31, hi = lane >> 5;
      const LAS unsigned char* X = (w < 4) ? Kb : Qb;
      f32x16 acc;
#pragma unroll
      for (int r = 0; r < 16; ++r) acc[r] = 0.f;
#pragma unroll
      for (int kst = 0; kst < 4; ++kst) {
          const bf16x8 af = *(const LAS bf16x8*)(X + (32 * tm + r32) * 144 + (16 * kst + 8 * hi) * 2), bfr = *(const LAS bf16x8*)(Kb + (32 * tn + r32) * 144 + (16 * kst + 8 * hi) * 2);
          acc = __builtin_amdgcn_mfma_f32_32x32x16_bf16(af, bfr, acc, 0, 0, 0); }
      const int j = 32 * tn + r32; const float gjf = gct[j], gjb = gct[64 + j];
#pragma unroll
      for (int g4 = 0; g4 < 4; ++g4) { const int i0 = 32 * tm + 8 * g4 + 4 * hi;
          const f32x4 gif = *(const LAS f32x4*)(gct + i0), gib = *(const LAS f32x4*)(gct + 64 + i0), bif = *(const LAS f32x4*)(btk + i0), bib = *(const LAS f32x4*)(btk + 64 + i0);
#pragma unroll
          for (int q = 0; q < 4; ++q) { const int i = i0 + q; const float v = acc[4 * g4 + q];
              const float ef = __expf(fminf(gif[q] - gjf, 0.f)), eb = __expf(fminf(gib[q] - gjb, 0.f));
              if (w < 4) {
                  const float lf = (j < i) ? -bif[q] * v * ef : 0.f, lb = (j > i) ? -bib[q] * v * eb : 0.f;
                  *(LAS bf16*)(NL + i * 144 + j * 2) = (bf16)(pk2(lf, 0.f) & 0xffffu);
                  *(LAS bf16*)(NL + 9216 + (63 - i) * 144 + (63 - j) * 2) = (bf16)(pk2(lb, 0.f) & 0xffffu);
              } else {
                  const float qf = (j <= i) ? v * ef : 0.f, qb = (j >= i) ? v * eb : 0.f;
                  *(LAS bf16*)(QKL + i * 144 + j * 2) = (bf16)(pk2(qf, 0.f) & 0xffffu);
                  *(LAS bf16*)(QKL + 9216 + (63 - i) * 144 + (63 - j) * 2) = (bf16)(pk2(qb, 0.f) & 0xffffu);
              } } } }
    LDS_WAIT(); __syncthreads();
    if (w < 2) { const int blk = lane >> 4, col = lane & 15; const LAS unsigned char* nl = NL + w * 9216 + (16 * blk) * 144 + (16 * blk) * 2;
        u32x4 lr[16][2];
#pragma unroll
        for (int r = 1; r < 16; ++r) { lr[r][0] = *(const LAS u32x4*)(nl + r * 144); if (r > 8) lr[r][1] = *(const LAS u32x4*)(nl + r * 144 + 16); }
        float t[16];
#pragma unroll
        for (int r = 0; r < 16; ++r) { float a0 = (r == col) ? 1.f : 0.f, a1 = 0.f;
            if (r > 0) { float l[16]; { float l8[8]; unpack8(lr[r][0], l8);
#pragma unroll
                    for (int q = 0; q < 8; ++q) l[q] = l8[q]; }
                if (r > 8) { float l8[8]; unpack8(lr[r][1], l8);
#pragma unroll
                    for (int q = 0; q < 8; ++q) l[8 + q] = l8[q]; }
#pragma unroll
                for (int q = 0; q < r; ++q) { if (q & 1) a1 += l[q] * t[q]; else a0 += l[q] * t[q]; } }
            t[r] = a0 + a1; }
#pragma unroll
        for (int r = 0; r < 16; ++r) *(LAS bf16*)(TD + w * 3072 + blk * 768 + r * 48 + col * 2) = (bf16)(pk2(t[r], 0.f) & 0xffffu);
    }
    LDS_WAIT(); __syncthreads();
    { const int d = w >> 2, cc = lane & 15, g = lane >> 4;
      const LAS unsigned char* nl = NL + d * 9216; const LAS unsigned char* td = TD + d * 3072 + cc * 48 + 8 * g;
#pragma unroll
      for (int jj = 0; jj < 2; ++jj) { const int ct = 2 * (w & 3) + jj, part = ct >> 2, colb = 16 * (ct & 3);
          const LAS unsigned char* src = part ? Kb : Vb; const LAS float* coef = (part ? cwp : cu) + d * 64;
          f32x4 R[4];
#pragma unroll
          for (int bq = 0; bq < 4; ++bq) { const f32x4 cf = *(const LAS f32x4*)(coef + 16 * bq + 4 * g);
#pragma unroll
              for (int r = 0; r < 4; ++r) { const int p = 16 * bq + 4 * g + r, i = d ? 63 - p : p;
                  R[bq][r] = cf[r] * __uint_as_float((unsigned)(*(const LAS bf16*)(src + i * 144 + (colb + cc) * 2)) << 16); } }
          const f32x4 z4 = (f32x4){0.f, 0.f, 0.f, 0.f};
          f32x4 X0, X1, X2, X3, Y;
          const bf16x8 t0f = frag_lo(td), t1f = frag_lo(td + 768), t2f = frag_lo(td + 2 * 768), t3f = frag_lo(td + 3 * 768);
          const bf16x8 n1f = frag_lo(nl + (16 + cc) * 144 + 8 * g), n2f = frag_2(nl + (32 + cc) * 144 + 8 * g), n3f = frag_2(nl + (48 + cc) * 144 + 8 * g), n3g = frag_lo(nl + (48 + cc) * 144 + 64 + 8 * g);
          __builtin_amdgcn_sched_barrier(0);
          X0 = __builtin_amdgcn_mfma_f32_16x16x32_bf16(t0f, pack_f4z(R[0]), z4, 0, 0, 0);
          Y = __builtin_amdgcn_mfma_f32_16x16x32_bf16(n1f, pack_f4z(X0), R[1], 0, 0, 0);
          X1 = __builtin_amdgcn_mfma_f32_16x16x32_bf16(t1f, pack_f4z(Y), z4, 0, 0, 0);
          const bf16x8 x01 = pack_f4f4(X0, X1);
          Y = __builtin_amdgcn_mfma_f32_16x16x32_bf16(n2f, x01, R[2], 0, 0, 0);
          X2 = __builtin_amdgcn_mfma_f32_16x16x32_bf16(t2f, pack_f4z(Y), z4, 0, 0, 0);
          Y = __builtin_amdgcn_mfma_f32_16x16x32_bf16(n3f, x01, R[3], 0, 0, 0);
          Y = __builtin_amdgcn_mfma_f32_16x16x32_bf16(n3g, pack_f4z(X2), Y, 0, 0, 0);
          X3 = __builtin_amdgcn_mfma_f32_16x16x32_bf16(t3f, pack_f4z(Y), z4, 0, 0, 0);
          const float sgn = part ? -1.f : 1.f;
          const bf16x8 xb0 = pack_f4f4(X0 * sgn, X1 * sgn), xb1 = pack_f4f4(X2 * sgn, X3 * sgn);
          const int q4 = (lane & 15) >> 2, pp = lane & 3;
          const LAS unsigned char* qkl = QKL + d * 9216; const LAS unsigned char* qtl = QT + d * 9216;
          bf16* pA = (d == 0 || part == 1) ? P + tok0 * PLD + h * 64 + (part ? (d ? SAB : SAF) : SBF) : XB2 + tok0 * 512 + h * 64;
          bf16* pC = (d == 0 || part == 1) ? P + tok0 * PLD + h * 64 + (part ? (d ? SCB : SCF) : SDF) : XB2 + (size_t)M * 512 + tok0 * 512 + h * 64;
          const size_t pit = (d == 0 || part == 1) ? PLD : 512;
          const int pc = dn_pcol(colb + cc);
#pragma unroll
          for (int mt = 0; mt < 4; ++mt) {
              s16x4 klo[2], khi[2]; bf16x8 qkf[2]; f32x4 acc2;
              { const unsigned ka = (unsigned)(uintptr_t)(KT + d * 10240) + (4 * g + q4) * 160u + (16 * mt + 4 * pp) * 2u;
                asm volatile("ds_read_b64_tr_b16 %0, %1" : "=&v"(klo[0]) : "v"(ka) : "memory");
                asm volatile("ds_read_b64_tr_b16 %0, %1 offset:2560" : "=&v"(khi[0]) : "v"(ka) : "memory");
                asm volatile("ds_read_b64_tr_b16 %0, %1 offset:5120" : "=&v"(klo[1]) : "v"(ka) : "memory");
                asm volatile("ds_read_b64_tr_b16 %0, %1 offset:7680" : "=&v"(khi[1]) : "v"(ka) : "memory"); }
#pragma unroll
              for (int ks = 0; ks < 2; ++ks) { if (ks == 1 && mt < 2) continue; qkf[ks] = frag_2(qkl + (16 * mt + cc) * 144 + (32 * ks + 4 * g) * 2); }
#pragma unroll
              for (int r = 0; r < 4; ++r) acc2[r] = part ? __uint_as_float((unsigned)(*(const LAS bf16*)(qtl + (16 * mt + 4 * g + r) * 144 + (colb + cc) * 2)) << 16) : 0.f;
              asm volatile("s_waitcnt lgkmcnt(0)" ::: "memory"); __builtin_amdgcn_sched_barrier(0);
              f32x4 acc = z4;
#pragma unroll
              for (int ks = 0; ks < 2; ++ks) { const bf16x8 kf = (bf16x8){klo[ks][0], klo[ks][1], klo[ks][2], klo[ks][3], khi[ks][0], khi[ks][1], khi[ks][2], khi[ks][3]};
                  acc = __builtin_amdgcn_mfma_f32_16x16x32_bf16(kf, ks ? xb1 : xb0, acc, 0, 0, 0); }
#pragma unroll
              for (int ks = 0; ks < 2; ++ks) { if (ks == 1 && mt < 2) continue; acc2 = __builtin_amdgcn_mfma_f32_16x16x32_bf16(qkf[ks], ks ? xb1 : xb0, acc2, 0, 0, 0); }
              if (part == 0) {
                  u32x2 o; o.x = pk2(acc[0], acc[1]); o.y = pk2(acc[2], acc[3]); *(u32x2*)(pA + (size_t)(colb + cc) * pit + 16 * mt + 4 * g) = o;
                  o.x = pk2(acc2[0], acc2[1]); o.y = pk2(acc2[2], acc2[3]); *(u32x2*)(pC + (size_t)(colb + cc) * pit + 16 * mt + 4 * g) = o; }
              else {
#pragma unroll
                  for (int r = 0; r < 4; ++r) { pA[(size_t)(16 * mt + 4 * g + r) * pit + pc] = (bf16)(pk2(acc[r], 0.f) & 0xffffu); pC[(size_t)(16 * mt + 4 * g + r) * pit + pc] = (bf16)(pk2(acc2[r], 0.f) & 0xffffu); } }
              __builtin_amdgcn_sched_barrier(0);
          }
          asm volatile("" ::: "memory"); __builtin_amdgcn_sched_barrier(0);
      } }
    LDS_WAIT(); __syncthreads();
  }
#undef DN_PREFETCH
}

constexpr int DNX_A = 0, DNX_C = 8192, DNX_BT = 16384, DNX_DT = 24576, DNX_EG = 32768, DNX_SZ = 33792, DNX_OST = 3 * DNX_SZ;
__device__ __forceinline__ void dn_scan_step(const LAS unsigned char* buf, f32x4 (&Sacc)[4], int ws, int lane, LAS unsigned char* ost, int dir) {
    const int c = lane & 15, g = lane >> 4;
    const unsigned trow = 16 * ws + c, t0 = trow * 128u + ((((unsigned)(g >> 1)) ^ ((trow >> 1) & 7u)) << 4) + 8u * (g & 1);
    u32x2 bt[4], dt[4]; bf16x8 af[4][2], cf[4][2];
#pragma unroll
    for (int mt = 0; mt < 4; ++mt) { const unsigned row = 16 * mt + c, a0 = row * 128u + ((((unsigned)g) ^ ((row >> 1) & 7u)) << 4);
        bt[mt] = *(const LAS u32x2*)(buf + DNX_BT + (t0 ^ ((unsigned)mt << 5)));
#pragma unroll
        for (int ks = 0; ks < 2; ++ks) af[mt][ks] = *(const LAS bf16x8*)(buf + DNX_A + (a0 ^ ((unsigned)ks << 6))); }
#pragma unroll
    for (int mt = 0; mt < 4; ++mt) { const unsigned row = 16 * mt + c, a0 = row * 128u + ((((unsigned)g) ^ ((row >> 1) & 7u)) << 4);
        dt[mt] = *(const LAS u32x2*)(buf + DNX_DT + (t0 ^ ((unsigned)mt << 5)));
#pragma unroll
        for (int ks = 0; ks < 2; ++ks) cf[mt][ks] = *(const LAS bf16x8*)(buf + DNX_C + (a0 ^ ((unsigned)ks << 6))); }
    const float gm = ((const LAS float*)(buf + DNX_EG))[63];
    bf16x8 Sb[2];
#pragma unroll
    for (int ks = 0; ks < 2; ++ks) Sb[ks] = pack_f4f4(Sacc[2 * ks], Sacc[2 * ks + 1]);
    __builtin_amdgcn_sched_barrier(0);
#pragma unroll
    for (int mt = 0; mt < 4; ++mt) { f32x4 sn = Sacc[mt] * gm + (f32x4){bf_lo(bt[mt].x), bf_hi(bt[mt].x), bf_lo(bt[mt].y), bf_hi(bt[mt].y)};
#pragma unroll
        for (int ks = 0; ks < 2; ++ks) sn = __builtin_amdgcn_mfma_f32_16x16x32_bf16(af[mt][ks], Sb[ks], sn, 0, 0, 0);
        Sacc[mt] = sn; }
#pragma unroll
    for (int mt = 0; mt < 4; ++mt) { f32x4 oa = (f32x4){bf_lo(dt[mt].x), bf_hi(dt[mt].x), bf_lo(dt[mt].y), bf_hi(dt[mt].y)};
#pragma unroll
        for (int ks = 0; ks < 2; ++ks) oa = __builtin_amdgcn_mfma_f32_16x16x32_bf16(cf[mt][ks], Sb[ks], oa, 0, 0, 0);
#pragma unroll
        for (int r = 0; r < 4; ++r) { const int p = 16 * mt + 4 * g + r, i = dir ? 63 - p : p;
            *(LAS bf16*)(ost + i * 128 + (16 * ws + c) * 2) = (bf16)(pk2(oa[r], 0.f) & 0xffffu); } }
}
__device__ __forceinline__ void dn_scan_unit(Frame& F, const Args& a, int b, int h, int dir) {
    bf16* P = (bf16*)(a.ws + WS_P);
    const int w = F.wave, lane = F.lane;
#define DN_BAR() do { asm volatile("s_waitcnt lgkmcnt(0)" ::: "memory"); __builtin_amdgcn_s_barrier(); asm volatile("" ::: "memory"); } while (0)
    if (w < 4) {
        f32x4 Sacc[4];
#pragma unroll
        for (int mt = 0; mt < 4; ++mt) Sacc[mt] = (f32x4){0.f, 0.f, 0.f, 0.f};
        bf16* Ob = P + (size_t)b * SEQ * PLD + (dir ? C_OB : C_OF) + h * 64;
        DN_BAR();
        int slot = 0;
#pragma unroll 1
        for (int s = 0; s <= 128; ++s) {
            if (s > 0) { const int cp = dir ? 128 - s : s - 1; const LAS unsigned char* st = F.lds + DNX_OST + ((s - 1) & 1) * 8192;
#pragma unroll
                for (int k = 0; k < 2; ++k) { const int idx = F.tid + 256 * k, row = idx >> 3, ch = idx & 7;
                    *(u32x4*)(Ob + ((size_t)cp * 64 + row) * PLD + ch * 8) = *(const LAS u32x4*)(st + row * 128 + ch * 16); } }
            if (s < 128) dn_scan_step(F.lds + slot * DNX_SZ, Sacc, w, lane, F.lds + DNX_OST + (s & 1) * 8192, dir);
            slot = slot == 2 ? 0 : slot + 1;
            DN_BAR();
        }
    } else {
        const int hw = w - 4;
        const bf16* XB2 = (const bf16*)a.out + (size_t)M * 1024;
        const float* BAg = (const float*)(a.ws + WS_BA);
        const char* gp[8]; long gstep[8];
#pragma unroll
        for (int i = 0; i < 8; ++i) { const int pid = hw * 8 + i, blk = pid >> 3, pc = pid & 7, r = 8 * pc + (lane >> 3), cp = lane & 7;
            const int key = (r >> 1) & 7, cs = cp ^ key;
            const size_t tokb = (size_t)b * SEQ;
            if (dir == 1 && blk >= 2) { gp[i] = (const char*)(XB2 + (size_t)(blk - 2) * M * 512 + (tokb + r) * 512 + h * 64 + cs * 8); gstep[i] = 64L * 512 * 2; }
            else { const int col = blk == 0 ? (dir ? SAB : SAF) : blk == 1 ? (dir ? SCB : SCF) : blk == 2 ? SBF : SDF;
                   gp[i] = (const char*)(P + (tokb + r) * PLD + col + h * 64 + cs * 8); gstep[i] = 64L * PLD * 2; } }
        const char* ggc = (const char*)(BAg + ((size_t)b * SEQ + lane) * 32 + dir * 8 + h);
#define DN_ISSUE(n, slot_) do { const int cn_ = dir ? 127 - (n) : (n); LAS unsigned char* sb_ = F.lds + (slot_) * DNX_SZ; \
        _Pragma("unroll") for (int i = 0; i < 8; ++i) { const int pid = hw * 8 + i; \
            __builtin_amdgcn_global_load_lds((const unsigned*)(gp[i] + (long)cn_ * gstep[i]), (LAS unsigned*)(sb_ + (pid >> 3) * 8192 + (pid & 7) * 1024), 16, 0, 0); } \
        __builtin_amdgcn_global_load_lds((const unsigned*)(ggc + (long)cn_ * (64L * 32 * 4)), (LAS unsigned*)(sb_ + DNX_EG + hw * 256), 4, 0, 0); } while (0)
        DN_ISSUE(0, 0); DN_ISSUE(1, 1);
        asm volatile("s_waitcnt vmcnt(9)" ::: "memory");
        DN_BAR();
        int slot2 = 2;
#pragma unroll 1
        for (int s = 0; s <= 128; ++s) {
            if (s + 2 < 128) { DN_ISSUE(s + 2, slot2); asm volatile("s_waitcnt vmcnt(9)" ::: "memory"); }
            else { asm volatile("s_waitcnt vmcnt(0)" ::: "memory"); }
            slot2 = slot2 == 2 ? 0 : slot2 + 1;
            DN_BAR();
        }
#undef DN_ISSUE
    }
#undef DN_BAR
    __syncthreads();
}
__device__ __forceinline__ void dn_combine(Frame& F, const Args& a) {
    bf16* P = (bf16*)(a.ws + WS_P);
    const float* og = a.in[11];
    const int gw = F.vcu * NWAVES + F.wave, NGW = F.G * NWAVES, c0 = F.lane * 8;
    for (int row = gw; row < M; row += NGW) {
        bf16* rp = P + (size_t)row * PLD;
        float of[8], ob[8]; unpack8(*(const u32x4*)(rp + C_OF + c0), of); unpack8(*(const u32x4*)(rp + C_OB + c0), ob);
        float s[8], ss = 0.f;
#pragma unroll
        for (int j = 0; j < 8; ++j) { s[j] = of[j] + ob[j]; ss += s[j] * s[j]; }
        ss += __shfl_xor(ss, 1); ss += __shfl_xor(ss, 2); ss += __shfl_xor(ss, 4);
        const float rstd = __builtin_amdgcn_rsqf(ss * (1.0f / 64) + EPS);
        bf16* zp = rp + C_DZ + c0; float z[8]; unpack8(*(const u32x4*)zp, z);
        const f32x4 g0 = *(const f32x4*)(og + (c0 & 63)), g1 = *(const f32x4*)(og + (c0 & 63) + 4);
        float y[8];
#pragma unroll
        for (int j = 0; j < 4; ++j) { y[j] = s[j] * rstd * g0[j] * siluf_(z[j]); y[4 + j] = s[4 + j] * rstd * g1[j] * siluf_(z[4 + j]); }
        *(u32x4*)zp = pack8(y);
    }
}
__device__ __forceinline__ void ffn_fixup_panel(Frame& F, const Args& a, int pm) {
    bf16* P = (bf16*)(a.ws + WS_P); const float* UE = (const float*)(a.ws + WS_UE);
    const float* cw = a.in[22]; const float* cb = a.in[23];
#pragma unroll 2
    for (int e = F.tid; e < 8 * (DFF / 4); e += 512) { const int k = e / (DFF / 4), ch = (e % (DFF / 4)) * 4, g = pm * 4 + (k >> 1), last = k & 1;
        const int row = g * 64 + (last ? 63 : 0);
        const bool hp = last ? true : (row % SEQ) != 0, hn = last ? (row % SEQ) != SEQ - 1 : true;
        const float* pu = UE + ((size_t)(last ? g : (g > 0 ? g - 1 : 0)) * 4 + (last ? 2 : 3)) * NUP;
        const float* cu = UE + ((size_t)g * 4 + (last ? 3 : 0)) * NUP;
        const float* nu = UE + ((size_t)(last ? (g < 511 ? g + 1 : 511) : g) * 4 + (last ? 0 : 1)) * NUP;
        const f32x4 z = (f32x4){0.f, 0.f, 0.f, 0.f};
        const f32x4 pg = hp ? *(const f32x4*)(pu + ch) : z, pv = hp ? *(const f32x4*)(pu + DFF + ch) : z, ng = hn ? *(const f32x4*)(nu + ch) : z, nv = hn ? *(const f32x4*)(nu + DFF + ch) : z;
        const f32x4 cg = *(const f32x4*)(cu + ch), cv = *(const f32x4*)(cu + DFF + ch);
        const f32x4 gate = *(const f32x4*)(cw + ch) * pg + *(const f32x4*)(cw + NUP + ch) * cg + *(const f32x4*)(cw + 2 * NUP + ch) * ng + *(const f32x4*)(cb + ch);
        const f32x4 val = *(const f32x4*)(cw + DFF + ch) * pv + *(const f32x4*)(cw + NUP + DFF + ch) * cv + *(const f32x4*)(cw + 2 * NUP + DFF + ch) * nv + *(const f32x4*)(cb + DFF + ch);
        u32x2 w; w.x = pk2(siluf_(gate[0]) * val[0], siluf_(gate[1]) * val[1]); w.y = pk2(siluf_(gate[2]) * val[2], siluf_(gate[3]) * val[3]);
        *(u32x2*)(P + (size_t)row * PLD + C_ACT + ch) = w; }
}

__global__ void __launch_bounds__(NWAVES * 64, 2) fwd_kernel(Args args) {
    extern __shared__ __attribute__((aligned(16))) unsigned char lds[];
    Frame F;
    F.lds = (LAS unsigned char*)lds;
    F.MISC = (volatile LAS unsigned*)(F.lds + MISC_OFF);
    F.tid = threadIdx.x; F.lane = F.tid & 63; F.wave = __builtin_amdgcn_readfirstlane(F.tid >> 6);
    F.G = gridDim.x; { const int bx = blockIdx.x; F.vcu = (F.G % 8 == 0) ? (bx % 8) * (F.G / 8) + bx / 8 : bx; }
    unsigned char* ws = args.ws;
    F.ctl = (gu32*)(ws + WS_CTL);
    for (int u = F.tid; u < (LDS_BYTES - LDSCTL_OFF) / 4; u += NWAVES * 64) ((LAS unsigned*)(F.lds + LDSCTL_OFF))[u] = 0u;
    __syncthreads();
    const int lo = args.ph_lo, hi = args.ph_hi;
    const bool single = (hi - lo) > 1;
    XcdBarrier bar; bar.bar = (unsigned*)(F.ctl + CW_BAR); bar.x = 0; bar.st = nullptr;
    if (single) bar = xcd_barrier_post((unsigned*)(F.ctl + CW_BAR), F.MISC + 8);
#ifndef PH_MASK
#define PH_MASK 0x1FF
#endif
#define IN(k) (((PH_MASK >> (k)) & 1) && lo <= (k) && (k) < hi)
#define SEAM(k) do { if (IN(k) && IN((k) + 1)) xcd_barrier(bar); } while (0)
    bf16* P = (bf16*)(ws + WS_P);
    const int bid = (int)blockIdx.x;
#define TS(k) do {} while (0)
#define TSB(k, blk) do {} while (0)
    TS(0);

    if (IN(0)) { p0_prologue(F, args); }
    SEAM(0); TS(1);
    if (IN(1)) {
        { pg8::Gemm g{(const bf16*)args.out, (const bf16*)(ws + WS_WIN), M, 3584, 1024, 1024, 1024}; pg8::StaticOrder S; S.init(M, 3584, F.G, bid);
          EpiInProj E{P, (float*)(ws + WS_BA)};
          pg8::gemm_phase<EpiInProj, pg8::StaticOrder, true, true>(F.lds + RING_OFF, g, S, E); }
        { pg8::Gemm g{(const bf16*)(ws + WS_MEMN), (const bf16*)(ws + WS_WKV), BATCH * NMEM, 1024, 1024, 1024, 1024}; pg8::StaticOrder S; S.init(BATCH * NMEM, 1024, F.G, bid);
          EpiBf16 E{(bf16*)(ws + WS_KV), 1024};
          pg8::gemm_phase<EpiBf16, pg8::StaticOrder, true, true>(F.lds + RING_OFF, g, S, E); }
    }
    SEAM(1); TS(2);
    if (IN(2)) {
        if (F.G == 256) dn_prep_block(F, args, bid >> 6, (bid >> 3) & 7, (bid & 7) * 16, 16);
        else for (int u = bid; u < 4096; u += F.G) dn_prep_block(F, args, u >> 10, (u >> 7) & 7, u & 127, 1);
    }
    TS(12); SEAM(2); TS(3);
    if (IN(3)) {
        const int ndn = F.G >= 128 ? 64 : 0;
        if (bid < ndn) { if (args.mode != 2) dn_scan_unit(F, args, bid >> 4, (bid >> 1) & 7, bid & 1); }
        else if (args.mode != 1) {
            if (ndn == 0) for (int u = bid; u < 64; u += F.G) dn_scan_unit(F, args, u >> 4, (u >> 1) & 7, u & 1);
            const int nb = F.G - ndn, me = bid - ndn;
            for (int u = me; u < 1024; u += nb) {
                if (u < 512) attnA_unit(F, args, u >> 7, (u >> 1) & 63, u & 1);
                else { const int v = u - 512; xattn_unit(F, args, v >> 7, (v >> 2) & 31, v & 3); }
            }
        }
    }
    TS(10); TSB(11, 64); SEAM(3); TS(4);
    if (IN(4)) {
        dn_combine(F, args);
        pg8::Gemm g{(const bf16*)args.out, (const bf16*)(ws + WS_WIN) + (size_t)3584 * 1024, M, 3072, 1024, 1024, 1024}; pg8::StaticOrder S; S.init(M, 3072, F.G, bid);
        EpiGatesU8 E{P};
        pg8::gemm_phase<EpiGatesU8, pg8::StaticOrder, true, true>(F.lds + RING_OFF, g, S, E);
    }
    SEAM(4); TS(5);
    if (IN(5)) {
        pg8::Gemm g{P + C_AQ, (const bf16*)(ws + WS_WBR), M, 1024, 1536, PLD, 512};
        g.segt = 8; g.aoff1 = (long)(C_DZ - C_AQ) * 2 - 8 * 128; g.aoff2 = (long)(C_MQ - C_AQ) * 2 - 16 * 128;
        g.boff1 = (long)1024 * 512 * 2 - 8 * 128; g.boff2 = (long)2 * 1024 * 512 * 2 - 16 * 128;
        pg8::StaticOrder S; S.init(M, 1024, F.G, bid);
        EpiMerge E{P}; pg8::gemm_phase<EpiMerge, pg8::StaticOrder, true, true>(F.lds + RING_OFF, g, S, E);
    }
    SEAM(5); TS(6);
    if (IN(6)) {
        pg8::Gemm g{P + C_MG, (const bf16*)(ws + WS_WOUT), M, 1024, 1024, PLD, 1024}; pg8::StaticOrder S; S.init(M, 1024, F.G, bid);
        EpiWout E{args.in[0], args.out, P, (float*)(ws + WS_SSQ), (LAS float*)(F.lds + XCH_OFF)};
        pg8::gemm_phase<EpiWout, pg8::StaticOrder, true, true>(F.lds + RING_OFF, g, S, E);
    }
    SEAM(6); TS(7);
    if (IN(7)) {
        pg8::Gemm g{P + C_X1B, (const bf16*)(ws + WS_WUP), M, NUP, 1024, PLD, 1024}; pg8::StaticOrder S; S.init(M, NUP, F.G, bid);
        EpiUp E{(const float*)(ws + WS_SSQ), args.in[22], args.in[23], P, (float*)(ws + WS_UE), (LAS float*)(F.lds + XCH_OFF)};
        pg8::gemm_phase<EpiUp, pg8::StaticOrder, true, true>(F.lds + RING_OFF, g, S, E);
    }
    SEAM(7); TS(8);
    if (IN(8)) {
        pg8::Gemm g{P + C_ACT, (const bf16*)(ws + WS_WDN), M, 1024, DFF, PLD, DFF}; pg8::StaticOrder S; S.init(M, 1024, F.G, bid);
        { Unit u; int prev = -1; for (int i = 0; S.next(i, u); ++i) { if (u.pm != prev) ffn_fixup_panel(F, args, u.pm); prev = u.pm; } }
        VM_WAIT(); __syncthreads();
        EpiDown E{args.out, P};
        pg8::gemm_phase<EpiDown, pg8::StaticOrder, true, true>(F.lds + RING_OFF, g, S, E);
    }
    TS(9);
#undef IN
#undef SEAM
}

#ifdef DBG_TIME
__global__ void dbg_ts_kernel(unsigned char* ws, int k) { if (threadIdx.x == 0) ((unsigned long long*)(ws + WS_CTL + 65536))[k] = __builtin_amdgcn_s_memrealtime(); }
__global__ void dbg_wait_kernel(unsigned char* ws) {
    if (threadIdx.x == 0) { const unsigned long long* tsb = (const unsigned long long*)(ws + WS_CTL + 65536);
        const unsigned long long te = __builtin_amdgcn_s_memrealtime();
        const unsigned long long d1 = tsb[DBG_A1] - tsb[DBG_A0], d2 = tsb[DBG_B1] - tsb[DBG_B0];
        const unsigned long long W = d1 + 100000ull * (d2 / 1000ull);
        while (__builtin_amdgcn_s_memrealtime() - te < W) __builtin_amdgcn_s_sleep(32); }
}
#endif
constexpr int N_PHASES = 9;
#ifndef MK_PER_PHASE
#define MK_PER_PHASE 0
#endif
extern "C" void kernel_launch(void* const* d_in, const int* in_sizes, int n_in, void* d_out, int out_size, void* d_ws, size_t ws_size, hipStream_t stream) {
    static int grid = 0;
    if (grid == 0) {
        if (n_in != 25 || in_sizes[0] != M * DM || out_size != M * DM || ws_size < WS_END) {
            fprintf(stderr, "kernel_launch: unexpected shapes (n_in %d, in0 %d, out %d, ws %zu); nothing launched\n", n_in, n_in > 0 ? in_sizes[0] : -1, out_size, ws_size); grid = -1; return; }
        int dev = 0, cus = 0, per_cu = 0;
        if (hipGetDevice(&dev) != hipSuccess || hipDeviceGetAttribute(&cus, hipDeviceAttributeMultiprocessorCount, dev) != hipSuccess) { grid = -1; return; }
        if (hipFuncSetAttribute((const void*)fwd_kernel, hipFuncAttributeMaxDynamicSharedMemorySize, LDS_BYTES) != hipSuccess) { fprintf(stderr, "kernel_launch: hipFuncSetAttribute failed\n"); grid = -1; return; }
        if (hipOccupancyMaxActiveBlocksPerMultiprocessor(&per_cu, (const void*)fwd_kernel, NWAVES * 64, LDS_BYTES) != hipSuccess || per_cu < 1) { fprintf(stderr, "kernel_launch: occupancy query reports %d\n", per_cu); }
        (void)hipGetLastError();
        grid = cus;
    }
    if (grid < 0) return;
    if (hipMemsetAsync((char*)d_ws + WS_CTL, 0, CTL_ZERO_BYTES, stream) != hipSuccess) return;
    Args a{};
    for (int i = 0; i < 25; ++i) a.in[i] = (const float*)d_in[i];
    a.out = (float*)d_out; a.ws = (unsigned char*)d_ws;
#ifdef DBG_TIME
    for (int p = 0; p < N_PHASES; ++p) { hipLaunchKernelGGL(dbg_ts_kernel, dim3(1), dim3(64), 0, stream, (unsigned char*)d_ws, p);
        a.ph_lo = p; a.ph_hi = p + 1;
        if (p == 3) { a.mode = 1; hipLaunchKernelGGL(fwd_kernel, dim3(grid), dim3(NWAVES * 64), LDS_BYTES, stream, a); hipLaunchKernelGGL(dbg_ts_kernel, dim3(1), dim3(64), 0, stream, (unsigned char*)d_ws, 12); a.mode = 2; }
        hipLaunchKernelGGL(fwd_kernel, dim3(grid), dim3(NWAVES * 64), LDS_BYTES, stream, a); a.mode = 0; }
    hipLaunchKernelGGL(dbg_ts_kernel, dim3(1), dim3(64), 0, stream, (unsigned char*)d_ws, N_PHASES);
    hipLaunchKernelGGL(dbg_wait_kernel, dim3(1), dim3(64), 0, stream, (unsigned char*)d_ws);
    return;
#endif
    if (MK_PER_PHASE) {
        for (int p = 0; p < N_PHASES; ++p) { a.ph_lo = p; a.ph_hi = p + 1; hipLaunchKernelGGL(fwd_kernel, dim3(grid), dim3(NWAVES * 64), LDS_BYTES, stream, a); }
    } else {
        a.ph_lo = 0; a.ph_hi = N_PHASES; hipLaunchKernelGGL(fwd_kernel, dim3(grid), dim3(NWAVES * 64), LDS_BYTES, stream, a);
    }
}
```

```cpp
#include <hip/hip_runtime.h>
#include <cstdio>
#include <cstdint>
#include <cmath>
namespace pg8 {
#define PG8_LAS __attribute__((address_space(3)))
typedef unsigned short bf16_t;
typedef short bf16x8 __attribute__((ext_vector_type(8)));
typedef float f32x4 __attribute__((ext_vector_type(4)));
typedef unsigned u32x4 __attribute__((ext_vector_type(4)));
constexpr int BM = 256, BK = 64, HALF = 128, HTB = HALF * BK * 2  , STAGE_BYTES = 8 * HTB, NXCD = 8, WGM = 8;

__host__ __device__ __forceinline__ int lds_byte(int r, int c) { const int st = (r >> 4) * 2 + (c >> 5), rr = r & 15, cc = c & 31, ob = rr * 64 + cc * 2; return st * 1024 + (ob ^ (((ob >> 9) & 1) << 5)); }
__host__ __device__ __forceinline__ void stage_rc(int b, int& R, int& C) { const int st = b / 1024, sb = b % 1024, swz = sb ^ (((sb >> 9) & 1) << 5); R = (st >> 1) * 16 + swz / 64; C = (st & 1) * 32 + (swz % 64) / 2; }
__host__ __device__ __forceinline__ int perm32(int rho) { const int n = rho >> 4, i = rho & 15; return 8 * (i >> 2) + 4 * n + (i & 3); }

struct Unit { int pm, pn, aux; };
struct Gemm { const bf16_t* A; const bf16_t* Bt; int M, N, K, lda, ldb; int segt = 1 << 30; long aoff1 = 0, aoff2 = 0, boff1 = 0, boff2 = 0; };

struct StaticOrder {
    int nM, nN, nwg, G, c;
    __host__ __device__ __forceinline__ void init(int M, int N, int G_, int c_) { nM = M / BM; nN = N / BM; nwg = nM * nN; G = G_; c = c_; }
    __host__ __device__ __forceinline__ bool next(int i, Unit& u) const {
        const long L = (long)i * G + c; if (L >= nwg) return false;
        int wgid = (int)L; { const int q = nwg / NXCD, r = nwg % NXCD, xcd = wgid % NXCD, off = wgid / NXCD; wgid = (xcd < r ? xcd * (q + 1) : r * (q + 1) + (xcd - r) * q) + off; }
        const int nig = WGM * nN, gid = wgid / nig, fm = gid * WGM, gsz = (nM - fm) < WGM ? (nM - fm) : WGM;
        u.pm = fm + ((wgid % nig) % gsz); u.pn = (wgid % nig) / gsz; return true;
    }
    __device__ __forceinline__ void a_ready(const Unit&) const {}
    __device__ __forceinline__ void done(const Unit&) const {}
};

template <class Epi, class Sched, bool ALIGN_EPI = false, bool SP2 = false>
__device__ __forceinline__ void gemm_phase(PG8_LAS unsigned char* lds, const Gemm g, const Sched& S, const Epi& E) {
    const int tid = threadIdx.x, wid = __builtin_amdgcn_readfirstlane(tid >> 6), lane = tid & 63, wr = wid >> 2, wc = wid & 3, fr = lane & 15, fq = lane >> 4;
    const int K = g.K, nt = K / BK;
    unsigned voffA[2], voffB[2];
#pragma unroll
    for (int i = 0; i < 2; ++i) { int R, C; stage_rc(tid * 16 + i * 8192, R, C); const int Rb = Epi::PERM ? ((R & ~31) + perm32(R & 31)) : R;
        voffA[i] = (unsigned)(R * g.lda + C) * 2u; voffB[i] = (unsigned)(Rb * g.ldb + C) * 2u; }
    const size_t kstep = (size_t)(BK * 2);
    const size_t hstepA = (size_t)HALF * g.lda * 2, hstepB = (size_t)HALF * g.ldb * 2;
    const size_t tstepA = 2 * hstepA, tstepB = 2 * hstepB;
    const unsigned ldsw = (unsigned)wid * 1024u;
    const int aoff = lds_byte(wr * 64 + fr, fq * 8), boff = lds_byte(wc * 32 + fr, fq * 8);
#define PG8_SA(b, h) (((b) * 2 + (h)) * HTB)
#define PG8_SB(b, h) ((4 + (b) * 2 + (h)) * HTB)
#define PG8_STAGE(bufoff, gbase, voff) do { _Pragma("unroll") for (int _i = 0; _i < 2; ++_i) \
        __builtin_amdgcn_global_load_lds((const unsigned*)((const char*)(gbase) + (voff)[_i]), (PG8_LAS unsigned*)(lds + (bufoff) + ldsw + _i * 8192), 16, 0, 0); } while (0)
#define PG8_LDA(dst, b, h) do { _Pragma("unroll") for (int m = 0; m < 4; ++m) _Pragma("unroll") for (int k = 0; k < 2; ++k) dst[m][k] = *(const PG8_LAS bf16x8*)(lds + PG8_SA(b, h) + aoff + m * 2048 + k * 1024); } while (0)
#define PG8_LDB(dst, b, h) do { _Pragma("unroll") for (int n = 0; n < 2; ++n) _Pragma("unroll") for (int k = 0; k < 2; ++k) dst[n][k] = *(const PG8_LAS bf16x8*)(lds + PG8_SB(b, h) + boff + n * 2048 + k * 1024); } while (0)
#define PG8_MMA(ai, bj, At, Bt) do { __builtin_amdgcn_s_setprio(1); _Pragma("unroll") for (int m = 0; m < 4; ++m) _Pragma("unroll") for (int n = 0; n < 2; ++n) _Pragma("unroll") for (int k = 0; k < 2; ++k) \
        acc[ai][bj][m][n] = __builtin_amdgcn_mfma_f32_16x16x32_bf16(Bt[n][k], At[m][k], acc[ai][bj][m][n], 0, 0, 0); __builtin_amdgcn_s_setprio(0); } while (0)
#define PG8_WAIT_V(n) asm volatile("s_waitcnt vmcnt(" #n ")" ::: "memory")
#define PG8_WAIT_L(n) asm volatile("s_waitcnt lgkmcnt(" #n ")" ::: "memory")
#define PG8_BAR __builtin_amdgcn_s_barrier()
#define PG8_SCHED __builtin_amdgcn_sched_barrier(0)
    Unit cur, nxt; int ui = 0;
    if (!S.next(0, cur)) return;
    if constexpr (Epi::PREFETCH) E.prefetch(cur, 0, tid);
    f32x4 acc[2][2][4][2];
#pragma unroll
    for (int a = 0; a < 2; ++a)
#pragma unroll
        for (int b = 0; b < 2; ++b)
#pragma unroll
            for (int m = 0; m < 4; ++m)
#pragma unroll
                for (int n = 0; n < 2; ++n) acc[a][b][m][n] = (f32x4){0.f, 0.f, 0.f, 0.f};
    bf16x8 At[4][2], B0[2][2], B1[2][2];
    const char* cA = (const char*)g.A + (size_t)cur.pm * tstepA; const char* cB = (const char*)g.Bt + (size_t)cur.pn * tstepB;
    S.a_ready(cur);
    if constexpr (SP2) {
        PG8_STAGE(PG8_SB(0, 0), cB, voffB); PG8_STAGE(PG8_SB(0, 1), cB + hstepB, voffB); PG8_STAGE(PG8_SA(0, 0), cA, voffA); PG8_STAGE(PG8_SA(0, 1), cA + hstepA, voffA);
        if (wr == 1) PG8_BAR;
        PG8_WAIT_V(2); PG8_BAR;
        PG8_STAGE(PG8_SB(1, 0), cB + kstep, voffB); PG8_STAGE(PG8_SA(1, 0), cA + kstep, voffA); PG8_STAGE(PG8_SB(1, 1), cB + hstepB + kstep, voffB);
        PG8_WAIT_V(6); PG8_BAR;
    } else {
        PG8_STAGE(PG8_SB(0, 0), cB, voffB); PG8_STAGE(PG8_SA(0, 0), cA, voffA); PG8_STAGE(PG8_SB(0, 1), cB + hstepB, voffB); PG8_STAGE(PG8_SA(0, 1), cA + hstepA, voffA);
        if (wr == 1) PG8_BAR;
        PG8_WAIT_V(4); PG8_BAR;
        PG8_STAGE(PG8_SB(1, 0), cB + kstep, voffB); PG8_STAGE(PG8_SA(1, 0), cA + kstep, voffA); PG8_STAGE(PG8_SB(1, 1), cB + hstepB + kstep, voffB);
        PG8_WAIT_V(6); PG8_BAR;
    }
    for (;;) {
        const bool has_next = S.next(ui + 1, nxt);
        const char* nA = has_next ? (const char*)g.A + (size_t)nxt.pm * tstepA : cA; const char* nB = has_next ? (const char*)g.Bt + (size_t)nxt.pn * tstepB : cB;
        for (int t = 0; t < nt; t += 2) {
            const bool last = (t == nt - 2);
            if constexpr (Epi::RESCALE) { if (t == g.segt || t == 2 * g.segt) E.rescale(acc, cur, wr, wc, fr, fq, t / g.segt); }
            const long so1 = (t + 1 >= 2 * g.segt) ? g.aoff2 : ((t + 1 >= g.segt) ? g.aoff1 : 0), so2 = (t + 2 >= 2 * g.segt) ? g.aoff2 : ((t + 2 >= g.segt) ? g.aoff1 : 0), sb2 = (t + 2 >= 2 * g.segt) ? g.boff2 : ((t + 2 >= g.segt) ? g.boff1 : 0);
            const char* a1 = cA + so1 + (size_t)(t + 1) * kstep;
            const char* a2 = last ? nA : cA + so2 + (size_t)(t + 2) * kstep; const char* b2 = last ? nB : cB + sb2 + (size_t)(t + 2) * kstep;
            const char* a3 = a2 + kstep; const char* b3 = b2 + kstep;
            if (last && has_next) S.a_ready(nxt);
            if constexpr (SP2) {
            PG8_LDB(B0, 0, 0); PG8_LDB(B1, 0, 1); PG8_SCHED; PG8_LDA(At, 0, 0); PG8_STAGE(PG8_SA(1, 1), a1 + hstepA, voffA);
            PG8_WAIT_V(8); PG8_WAIT_L(0); PG8_BAR; PG8_MMA(0, 0, At, B0); PG8_MMA(0, 1, At, B1); PG8_BAR; PG8_SCHED;
            PG8_LDA(At, 0, 1); PG8_STAGE(PG8_SB(0, 0), b2, voffB); PG8_STAGE(PG8_SB(0, 1), b2 + hstepB, voffB); PG8_STAGE(PG8_SA(0, 0), a2, voffA);
            PG8_WAIT_V(8); PG8_WAIT_L(0); PG8_BAR; PG8_MMA(1, 0, At, B0); PG8_MMA(1, 1, At, B1); PG8_BAR; PG8_SCHED;
            PG8_LDB(B0, 1, 0); PG8_LDB(B1, 1, 1); PG8_SCHED; PG8_LDA(At, 1, 0); PG8_STAGE(PG8_SA(0, 1), a2 + hstepA, voffA);
            PG8_WAIT_V(8); PG8_WAIT_L(0); PG8_BAR; PG8_MMA(0, 0, At, B0); PG8_MMA(0, 1, At, B1); PG8_BAR; PG8_SCHED;
            PG8_LDA(At, 1, 1); PG8_STAGE(PG8_SB(1, 0), b3, voffB); PG8_STAGE(PG8_SB(1, 1), b3 + hstepB, voffB); PG8_STAGE(PG8_SA(1, 0), a3, voffA);
            PG8_WAIT_V(8); PG8_WAIT_L(0); PG8_BAR; PG8_MMA(1, 0, At, B0); PG8_MMA(1, 1, At, B1); PG8_BAR; PG8_SCHED;
            } else {
            PG8_LDB(B0, 0, 0); PG8_SCHED; PG8_LDA(At, 0, 0); PG8_STAGE(PG8_SA(1, 1), a1 + hstepA, voffA);
            PG8_WAIT_L(8); PG8_BAR; PG8_WAIT_L(0); PG8_MMA(0, 0, At, B0); PG8_BAR; PG8_SCHED;
            PG8_LDB(B1, 0, 1); PG8_STAGE(PG8_SB(0, 0), b2, voffB);
            PG8_BAR; PG8_WAIT_L(0); PG8_MMA(0, 1, At, B1); PG8_BAR;
            PG8_LDA(At, 0, 1); PG8_STAGE(PG8_SA(0, 0), a2, voffA);
            PG8_BAR; PG8_WAIT_L(0); PG8_MMA(1, 0, At, B0); PG8_BAR; PG8_SCHED;
            PG8_STAGE(PG8_SB(0, 1), b2 + hstepB, voffB);
            PG8_WAIT_V(6); PG8_BAR; PG8_MMA(1, 1, At, B1); PG8_BAR;
            PG8_LDB(B0, 1, 0); PG8_SCHED; PG8_LDA(At, 1, 0); PG8_STAGE(PG8_SA(0, 1), a2 + hstepA, voffA);
            PG8_WAIT_L(8); PG8_BAR; PG8_WAIT_L(0); PG8_MMA(0, 0, At, B0); PG8_BAR; PG8_SCHED;
            PG8_LDB(B1, 1, 1); PG8_STAGE(PG8_SB(1, 0), b3, voffB);
            PG8_BAR; PG8_WAIT_L(0); PG8_MMA(0, 1, At, B1); PG8_BAR;
            PG8_LDA(At, 1, 1); PG8_STAGE(PG8_SA(1, 0), a3, voffA);
            PG8_BAR; PG8_WAIT_L(0); PG8_MMA(1, 0, At, B0); PG8_BAR; PG8_SCHED;
            PG8_STAGE(PG8_SB(1, 1), b3 + hstepB, voffB);
            PG8_WAIT_V(6); PG8_BAR; PG8_MMA(1, 1, At, B1); PG8_BAR;
            }
        }
        if constexpr (ALIGN_EPI) { if (wr == 0) PG8_BAR; }
        if constexpr (Epi::PREFETCH) cur.aux = ui & 1;
        if constexpr (!Epi::AFTER_DRAIN) { E(acc, cur, wr, wc, fr, fq); S.done(cur); }
        if constexpr (Epi::PREFETCH) { if (has_next) E.prefetch(nxt, (ui + 1) & 1, tid); }
        if (!has_next) break;
#pragma unroll
        for (int a = 0; a < 2; ++a)
#pragma unroll
            for (int b = 0; b < 2; ++b)
#pragma unroll
                for (int m = 0; m < 4; ++m)
#pragma unroll
                    for (int n = 0; n < 2; ++n) acc[a][b][m][n] = (f32x4){0.f, 0.f, 0.f, 0.f};
        cur = nxt; cA = nA; cB = nB; ++ui;
        if constexpr (ALIGN_EPI) { if (wr == 1) PG8_BAR; }
    }
    PG8_WAIT_V(0);
    if constexpr (!ALIGN_EPI) { if (wr == 0) PG8_BAR; }
    PG8_BAR;
    if constexpr (Epi::AFTER_DRAIN) { E.fused(acc, cur, wr, wc, fr, fq, lds, wid, lane); S.done(cur); }
#undef PG8_SA
#undef PG8_SB
#undef PG8_STAGE
#undef PG8_LDA
#undef PG8_LDB
#undef PG8_MMA
#undef PG8_WAIT_V
#undef PG8_WAIT_L
#undef PG8_BAR
#undef PG8_SCHED
}
}

#define LAS __attribute__((address_space(3)))
#define GAS __attribute__((address_space(1)))
typedef unsigned short bf16;
typedef short bf16x8 __attribute__((ext_vector_type(8)));
typedef short s16x4 __attribute__((ext_vector_type(4)));
typedef float f32x4 __attribute__((ext_vector_type(4)));
typedef float f32x16 __attribute__((ext_vector_type(16)));
typedef unsigned u32x4 __attribute__((ext_vector_type(4)));
typedef unsigned u32x2 __attribute__((ext_vector_type(2)));
typedef float f32x2_t __attribute__((ext_vector_type(2)));
typedef __bf16 bf16x2_t __attribute__((ext_vector_type(2)));

constexpr int BATCH = 4, SEQ = 8192, DM = 1024, M = BATCH * SEQ;
constexpr int NMEM = 256;
constexpr int PLD = 6400;
constexpr int C_AQ = 0, C_AK = 512, C_AV = 640, C_DQ = 768, C_DK = 1280, C_DV = 1792, C_DZ = 2304, C_MQ = 2816, C_GATE = 3328;
constexpr int C_MG = 768, C_X1B = 1792, C_ACT = 2816;
constexpr int NIN = 6656;
constexpr int DFF = 2816, NUP = 5632;
constexpr float EPS = 1e-6f;
constexpr float LOG2E = 1.4426950408889634f;

__device__ __forceinline__ float bf_lo(unsigned w) { return __uint_as_float(w << 16); }
__device__ __forceinline__ float bf_hi(unsigned w) { return __uint_as_float(w & 0xffff0000u); }
__device__ __forceinline__ unsigned pk2(float lo, float hi) { f32x2_t v = {lo, hi}; bf16x2_t b = __builtin_convertvector(v, bf16x2_t); return __builtin_bit_cast(unsigned, b); }
__device__ __forceinline__ float fexp2(float x) { return __builtin_amdgcn_exp2f(x); }
__device__ __forceinline__ float frcp(float x) { return __builtin_amdgcn_rcpf(x); }
__device__ __forceinline__ float sigmoidf_(float x) { return frcp(1.0f + fexp2(-x * LOG2E)); }
__device__ __forceinline__ float siluf_(float x) { return x * sigmoidf_(x); }
__device__ __forceinline__ void unpack8(const u32x4 w, float (&v)[8]) {
    v[0] = bf_lo(w.x); v[1] = bf_hi(w.x); v[2] = bf_lo(w.y); v[3] = bf_hi(w.y); v[4] = bf_lo(w.z); v[5] = bf_hi(w.z); v[6] = bf_lo(w.w); v[7] = bf_hi(w.w); }
__device__ __forceinline__ u32x4 pack8(const float (&v)[8]) { u32x4 w; w.x = pk2(v[0], v[1]); w.y = pk2(v[2], v[3]); w.z = pk2(v[4], v[5]); w.w = pk2(v[6], v[7]); return w; }

using pg8::Unit;
constexpr int HALF = pg8::HALF, BM = pg8::BM;

struct EpiInProj {
    static constexpr bool PERM = true, AFTER_DRAIN = false, PREFETCH = false, RESCALE = false;
    bf16* P; float* BA;
    __device__ __forceinline__ void operator()(const f32x4 (&acc)[2][2][4][2], const Unit& u, int wr, int wc, int fr, int fq) const {
        const int row0 = u.pm * BM + wr * 64 + fr;
        if (u.pn < 13) {
            const int col0 = u.pn * BM + wc * 32 + 8 * fq;
#pragma unroll
            for (int ai = 0; ai < 2; ++ai)
#pragma unroll
                for (int m = 0; m < 4; ++m) { bf16* rowp = P + (size_t)(row0 + ai * HALF + m * 16) * PLD + col0;
#pragma unroll
                    for (int bj = 0; bj < 2; ++bj) { const f32x4 v0 = acc[ai][bj][m][0], v1 = acc[ai][bj][m][1];
                        u32x4 w; w.x = pk2(v0[0], v0[1]); w.y = pk2(v0[2], v0[3]); w.z = pk2(v1[0], v1[1]); w.w = pk2(v1[2], v1[3]);
                        *(u32x4*)(rowp + bj * HALF) = w; } }
        } else if (wc == 0) {
#pragma unroll
            for (int ai = 0; ai < 2; ++ai)
#pragma unroll
                for (int m = 0; m < 4; ++m) { float* rp = BA + (size_t)(row0 + ai * HALF + m * 16) * 32 + 8 * fq;
                    *(f32x4*)rp = acc[ai][0][m][0]; *(f32x4*)(rp + 4) = acc[ai][0][m][1]; }
        }
    }
};
struct EpiBf16 {
    static constexpr bool PERM = true, AFTER_DRAIN = false, PREFETCH = false, RESCALE = false;
    bf16* O; int ldc;
    __device__ __forceinline__ void operator()(const f32x4 (&acc)[2][2][4][2], const Unit& u, int wr, int wc, int fr, int fq) const {
        const int row0 = u.pm * BM + wr * 64 + fr, col0 = u.pn * BM + wc * 32 + 8 * fq;
#pragma unroll
        for (int ai = 0; ai < 2; ++ai)
#pragma unroll
            for (int m = 0; m < 4; ++m) { bf16* rowp = O + (size_t)(row0 + ai * HALF + m * 16) * ldc + col0;
#pragma unroll
                for (int bj = 0; bj < 2; ++bj) { const f32x4 v0 = acc[ai][bj][m][0], v1 = acc[ai][bj][m][1];
                    u32x4 w; w.x = pk2(v0[0], v0[1]); w.y = pk2(v0[2], v0[3]); w.z = pk2(v1[0], v1[1]); w.w = pk2(v1[2], v1[3]);
                    *(u32x4*)(rowp + bj * HALF) = w; } }
    }
};
template <int PASS> struct EpiBranch {
    static constexpr bool PERM = true, AFTER_DRAIN = false, PREFETCH = false, RESCALE = false;
    bf16* P;
    __device__ __forceinline__ void operator()(const f32x4 (&acc)[2][2][4][2], const Unit& u, int wr, int wc, int fr, int fq) const {
        const int row0 = u.pm * BM + wr * 64 + fr, col0 = u.pn * BM + wc * 32 + 8 * fq;
#pragma unroll
        for (int ai = 0; ai < 2; ++ai)
#pragma unroll
            for (int m = 0; m < 4; ++m) { bf16* rowp = P + (size_t)(row0 + ai * HALF + m * 16) * PLD;
#pragma unroll
                for (int bj = 0; bj < 2; ++bj) {
                    const int c = col0 + bj * HALF;
                    const u32x4 gw = *(const u32x4*)(rowp + C_GATE + 1024 * PASS + c);
                    float g[8]; unpack8(gw, g);
                    float pv[8];
                    if (PASS > 0) { const u32x4 mw = *(const u32x4*)(rowp + C_MG + c); unpack8(mw, pv); }
                    else {
#pragma unroll
                        for (int i = 0; i < 8; ++i) pv[i] = 0.f; }
                    const f32x4 v0 = acc[ai][bj][m][0], v1 = acc[ai][bj][m][1];
                    float o[8];
#pragma unroll
                    for (int i = 0; i < 4; ++i) { o[i] = pv[i] + sigmoidf_(g[i]) * v0[i]; o[4 + i] = pv[4 + i] + sigmoidf_(g[4 + i]) * v1[i]; }
                    *(u32x4*)(rowp + C_MG + c) = pack8(o); } }
    }
};
struct EpiGatesU8 {
    static constexpr bool PERM = true, AFTER_DRAIN = false, PREFETCH = false, RESCALE = false;
    bf16* P;
    __device__ __forceinline__ void operator()(const f32x4 (&acc)[2][2][4][2], const Unit& u, int wr, int wc, int fr, int fq) const {
        const int row0 = u.pm * BM + wr * 64 + fr, col0 = u.pn * BM + wc * 32 + 8 * fq;
#pragma unroll
        for (int ai = 0; ai < 2; ++ai)
#pragma unroll
            for (int m = 0; m < 4; ++m) { unsigned char* rowp = (unsigned char*)(P + (size_t)(row0 + ai * HALF + m * 16) * PLD + C_GATE) + col0;
#pragma unroll
                for (int bj = 0; bj < 2; ++bj) { const f32x4 v0 = acc[ai][bj][m][0], v1 = acc[ai][bj][m][1]; unsigned q[8];
#pragma unroll
                    for (int i = 0; i < 4; ++i) { q[i] = (unsigned)fminf(fmaxf(sigmoidf_(v0[i]) * 255.0f + 0.5f, 1.0f), 255.0f); q[4 + i] = (unsigned)fminf(fmaxf(sigmoidf_(v1[i]) * 255.0f + 0.5f, 1.0f), 255.0f); }
                    u32x2 w; w.x = q[0] | (q[1] << 8) | (q[2] << 16) | (q[3] << 24); w.y = q[4] | (q[5] << 8) | (q[6] << 16) | (q[7] << 24);
                    *(u32x2*)(rowp + bj * HALF) = w; } }
    }
};
struct EpiMerge {
    static constexpr bool PERM = true, AFTER_DRAIN = false, PREFETCH = false, RESCALE = true;
    bf16* P;
    __device__ __forceinline__ void rescale(f32x4 (&acc)[2][2][4][2], const Unit& u, int wr, int wc, int fr, int fq, int stage) const {
        asm volatile("" : "+v"(fr), "+v"(fq));
        const int row0 = u.pm * BM + wr * 64 + fr, col0 = u.pn * BM + wc * 32 + 8 * fq;
#pragma unroll
        for (int ai = 0; ai < 2; ++ai) {
#pragma unroll
            for (int m = 0; m < 4; ++m) { const unsigned char* rowp = (const unsigned char*)(P + (size_t)(row0 + ai * HALF + m * 16) * PLD + C_GATE) + 1024 * (stage - 1) + col0;
#pragma unroll
                for (int bj = 0; bj < 2; ++bj) { const u32x2 gx = *(const u32x2*)(rowp + bj * HALF), gy = *(const u32x2*)(rowp + 1024 + bj * HALF);
#pragma unroll
                    for (int i = 0; i < 4; ++i) { acc[ai][bj][m][0][i] *= (float)((gx.x >> (8 * i)) & 255u) * frcp((float)((gy.x >> (8 * i)) & 255u));
                        acc[ai][bj][m][1][i] *= (float)((gx.y >> (8 * i)) & 255u) * frcp((float)((gy.y >> (8 * i)) & 255u)); } } }
            asm volatile("" ::: "memory"); }
    }
    __device__ __forceinline__ void operator()(const f32x4 (&acc)[2][2][4][2], const Unit& u, int wr, int wc, int fr, int fq) const {
        const int row0 = u.pm * BM + wr * 64 + fr, col0 = u.pn * BM + wc * 32 + 8 * fq;
#pragma unroll
        for (int ai = 0; ai < 2; ++ai)
#pragma unroll
            for (int m = 0; m < 4; ++m) { bf16* rowp = P + (size_t)(row0 + ai * HALF + m * 16) * PLD;
#pragma unroll
                for (int bj = 0; bj < 2; ++bj) { const int c = col0 + bj * HALF; float o[8];
                    const u32x2 gq = *(const u32x2*)((const unsigned char*)(rowp + C_GATE) + 2048 + c);
                    const f32x4 v0 = acc[ai][bj][m][0], v1 = acc[ai][bj][m][1];
#pragma unroll
                    for (int i = 0; i < 4; ++i) { o[i] = (float)((gq.x >> (8 * i)) & 255u) * (1.0f / 255.0f) * v0[i]; o[4 + i] = (float)((gq.y >> (8 * i)) & 255u) * (1.0f / 255.0f) * v1[i]; }
                    *(u32x4*)(rowp + C_MG + c) = pack8(o); } }
    }
};
struct EpiWout {
    static constexpr bool PERM = true, AFTER_DRAIN = false, PREFETCH = false, RESCALE = false;
    const float* x; float* out; bf16* P; float* SSQ; LAS float* xl;
    __device__ __forceinline__ void operator()(const f32x4 (&acc)[2][2][4][2], const Unit& u, int wr, int wc, int fr, int fq) const {
        const int row0 = u.pm * BM + wr * 64 + fr, col0 = u.pn * BM + wc * 32 + 8 * fq;
#pragma unroll
        for (int ai = 0; ai < 2; ++ai)
#pragma unroll
            for (int m = 0; m < 4; ++m) { const int row = row0 + ai * HALF + m * 16; float ss = 0.f;
#pragma unroll
                for (int bj = 0; bj < 2; ++bj) { const int c = col0 + bj * HALF; const size_t off = (size_t)row * DM + c;
                    const f32x4 a0 = *(const f32x4*)(x + off), a1 = *(const f32x4*)(x + off + 4);
                    const f32x4 r0 = a0 + acc[ai][bj][m][0], r1 = a1 + acc[ai][bj][m][1];
                    ss += (r0[0] * r0[0] + r0[1] * r0[1]) + (r0[2] * r0[2] + r0[3] * r0[3]) + (r1[0] * r1[0] + r1[1] * r1[1]) + (r1[2] * r1[2] + r1[3] * r1[3]);
                    u32x4 w; w.x = pk2(r0[0], r0[1]); w.y = pk2(r0[2], r0[3]); w.z = pk2(r1[0], r1[1]); w.w = pk2(r1[2], r1[3]);
                    *(u32x4*)(P + (size_t)row * PLD + C_X1B + c) = w; }
                ss += __shfl_xor(ss, 16); ss += __shfl_xor(ss, 32);
                if (fq == 0) xl[(ai * HALF + wr * 64 + m * 16 + fr) * 4 + wc] = ss; }
        asm volatile("s_waitcnt lgkmcnt(0)" ::: "memory"); __builtin_amdgcn_s_barrier(); asm volatile("" ::: "memory");
        { const int t = (wr * 4 + wc) * 64 + fq * 16 + fr;
          if (t < 256) { const f32x4 p = *(const LAS f32x4*)(xl + t * 4); SSQ[(size_t)(u.pm * BM + t) * 4 + u.pn] = (p[0] + p[1]) + (p[2] + p[3]); } }
        asm volatile("s_waitcnt lgkmcnt(0)" ::: "memory"); __builtin_amdgcn_s_barrier(); asm volatile("" ::: "memory");
    }
};
template <int CTRL> __device__ __forceinline__ float dpp_mov(float old, float src) {
    return __builtin_bit_cast(float, __builtin_amdgcn_update_dpp(__builtin_bit_cast(int, old), __builtin_bit_cast(int, src), CTRL, 0xF, 0xF, false)); }
struct EpiUp {
    static constexpr bool PERM = true, AFTER_DRAIN = false, PREFETCH = true, RESCALE = false;
    const float* SSQ; const float* cw; const float* cb; bf16* P; float* UE; LAS float* xl;
    __device__ __forceinline__ void prefetch(const Unit& u, int buf, int tid) const {
        LAS float* d = xl + buf * 1280;
        if (tid < 256) { const int a = tid >> 5, c4 = (tid & 31) * 4, ch = u.pn * 128 + c4 + (a >= 4 ? DFF : 0), aa = a & 3;
            *(LAS f32x4*)(d + a * 128 + c4) = *(const f32x4*)((aa < 3 ? cw + aa * NUP : cb) + ch); }
        else { const int r = tid - 256; const f32x4 q = *(const f32x4*)(SSQ + (size_t)(u.pm * BM + r) * 4);
            d[1024 + r] = __builtin_amdgcn_rsqf(((q[0] + q[1]) + (q[2] + q[3])) * (1.0f / DM) + EPS); }
    }
    __device__ __forceinline__ void operator()(f32x4 (&acc)[2][2][4][2], const Unit& u, int wr, int wc, int fr, int fq) const {
        const int row0 = u.pm * BM + wr * 64 + fr;
        const LAS float* lw = xl + u.aux * 1280;
#pragma unroll
        for (int ai = 0; ai < 2; ++ai)
#pragma unroll
            for (int m = 0; m < 4; ++m) { const float rs = lw[1024 + ai * HALF + wr * 64 + m * 16 + fr];
#pragma unroll
                for (int bj = 0; bj < 2; ++bj)
#pragma unroll
                    for (int n = 0; n < 2; ++n) acc[ai][bj][m][n] *= rs; }
#pragma unroll
        for (int n = 0; n < 2; ++n) {
            const int c4 = wc * 32 + 8 * fq + 4 * n, a0 = u.pn * 128 + c4;
            const f32x4 wg0 = *(const LAS f32x4*)(lw + c4), wg1 = *(const LAS f32x4*)(lw + 128 + c4), wg2 = *(const LAS f32x4*)(lw + 256 + c4), bg = *(const LAS f32x4*)(lw + 384 + c4);
            const f32x4 wv0 = *(const LAS f32x4*)(lw + 512 + c4), wv1 = *(const LAS f32x4*)(lw + 640 + c4), wv2 = *(const LAS f32x4*)(lw + 768 + c4), bv = *(const LAS f32x4*)(lw + 896 + c4);
#pragma unroll
            for (int ai = 0; ai < 2; ++ai) {
                const int g64 = u.pm * 4 + ai * 2 + wr;
#pragma unroll
                for (int m = 0; m < 4; ++m) {
                    const f32x4 ugm = acc[ai][0][m][n], uvm = acc[ai][1][m][n], ugp = acc[ai][0][(m + 3) & 3][n], ugn = acc[ai][0][(m + 1) & 3][n], uvp = acc[ai][1][(m + 3) & 3][n], uvn = acc[ai][1][(m + 1) & 3][n];
                    f32x4 pg, ng, pvv, nv;
#pragma unroll
                    for (int i = 0; i < 4; ++i) {
                        pg[i] = dpp_mov<0x111>(dpp_mov<0x121>(0.f, ugp[i]), ugm[i]);
                        ng[i] = dpp_mov<0x101>(dpp_mov<0x12F>(0.f, ugn[i]), ugm[i]);
                        pvv[i] = dpp_mov<0x111>(dpp_mov<0x121>(0.f, uvp[i]), uvm[i]);
                        nv[i] = dpp_mov<0x101>(dpp_mov<0x12F>(0.f, uvn[i]), uvm[i]); }
                    const f32x4 gate = wg0 * pg + wg1 * ugm + wg2 * ng + bg;
                    const f32x4 val = wv0 * pvv + wv1 * uvm + wv2 * nv + bv;
                    const int row = row0 + ai * HALF + m * 16;
                    const bool edge = (m == 0 && fr == 0) || (m == 3 && fr == 15);
                    if (!edge) { u32x2 w; w.x = pk2(siluf_(gate[0]) * val[0], siluf_(gate[1]) * val[1]); w.y = pk2(siluf_(gate[2]) * val[2], siluf_(gate[3]) * val[3]);
                        *(u32x2*)(P + (size_t)row * PLD + C_ACT + a0) = w; }
                    if ((m == 0 && fr < 2) || (m == 3 && fr >= 14)) { const int slot = (m == 0) ? fr : fr - 12;
                        float* ue = UE + ((size_t)g64 * 4 + slot) * NUP;
                        *(f32x4*)(ue + a0) = ugm; *(f32x4*)(ue + DFF + a0) = uvm; }
                }
            }
        }
    }
};
struct EpiDown {
    static constexpr bool PERM = true, AFTER_DRAIN = false, PREFETCH = false, RESCALE = false;
    float* out; const bf16* P;
    __device__ __forceinline__ void operator()(const f32x4 (&acc)[2][2][4][2], const Unit& u, int wr, int wc, int fr, int fq) const {
        const int row0 = u.pm * BM + wr * 64 + fr, col0 = u.pn * BM + wc * 32 + 8 * fq;
#pragma unroll
        for (int ai = 0; ai < 2; ++ai)
#pragma unroll
            for (int m = 0; m < 4; ++m) { const int row = row0 + ai * HALF + m * 16;
#pragma unroll
                for (int bj = 0; bj < 2; ++bj) { const int c = col0 + bj * HALF; float xr[8]; unpack8(*(const u32x4*)(P + (size_t)row * PLD + C_X1B + c), xr);
                    const f32x4 v0 = acc[ai][bj][m][0], v1 = acc[ai][bj][m][1];
                    *(f32x4*)(out + (size_t)row * DM + c) = (f32x4){xr[0] + v0[0], xr[1] + v0[1], xr[2] + v0[2], xr[3] + v0[3]};
                    *(f32x4*)(out + (size_t)row * DM + c + 4) = (f32x4){xr[4] + v1[0], xr[5] + v1[1], xr[6] + v1[2], xr[7] + v1[3]}; } }
    }
};

template <int DH, int RSK, int RSV>
__device__ __forceinline__ void attn_tile(const LAS unsigned char* Kl, const LAS unsigned char* Vl, int jk, const bf16x8 (&qf)[DH / 16], f32x16 s0, f32x16 s1,
                                          float& m, float& l, f32x16 (&o)[DH / 32], int lane) {
    const int r32 = lane & 31, hi = lane >> 5;
    const LAS unsigned char* kp = Kl + (size_t)(jk + r32) * RSK + 16 * hi;
#pragma unroll
    for (int ks = 0; ks < DH / 16; ++ks) {
        const bf16x8 k0 = *(const LAS bf16x8*)(kp + 32 * ks), k1 = *(const LAS bf16x8*)(kp + 32 * RSK + 32 * ks);
        s0 = __builtin_amdgcn_mfma_f32_32x32x16_bf16(k0, qf[ks], s0, 0, 0, 0);
        s1 = __builtin_amdgcn_mfma_f32_32x32x16_bf16(k1, qf[ks], s1, 0, 0, 0);
    }
    const int g = lane >> 4, q4 = (lane & 15) >> 2, p = lane & 3;
    const unsigned va = (unsigned)(uintptr_t)Vl + (unsigned)(jk + 4 * hi + q4) * RSV + (16 * (g & 1) + 4 * p) * 2;
    s16x4 vlo[2][4], vhi[2][4];
#define ATT_VREAD(set, db) do { _Pragma("unroll") for (int kk = 0; kk < 4; ++kk) { \
        asm volatile("ds_read_b64_tr_b16 %0, %1 offset:%c2" : "=&v"(vlo[set][kk]) : "v"(va), "i"((16 * kk) * RSV + 64 * (db)) : "memory"); \
        asm volatile("ds_read_b64_tr_b16 %0, %1 offset:%c2" : "=&v"(vhi[set][kk]) : "v"(va), "i"((16 * kk + 8) * RSV + 64 * (db)) : "memory"); } } while (0)
    ATT_VREAD(0, 0);
    float mx = fmaxf(s0[0], s1[0]);
#pragma unroll
    for (int r = 1; r < 16; ++r) mx = fmaxf(mx, fmaxf(s0[r], s1[r]));
    mx = fmaxf(mx, __shfl_xor(mx, 32));
    const float mn = fmaxf(m, mx), f = fexp2(m - mn);
    m = mn; l *= f;
#pragma unroll
    for (int db = 0; db < DH / 32; ++db)
#pragma unroll
        for (int r = 0; r < 16; ++r) o[db][r] *= f;
    float ps = 0.f;
#pragma unroll
    for (int r = 0; r < 16; ++r) { s0[r] = fexp2(s0[r] - mn); s1[r] = fexp2(s1[r] - mn); ps += s0[r] + s1[r]; }
    l += ps;
    bf16x8 pf[4];
    { u32x4 w;
      w.x = pk2(s0[0], s0[1]); w.y = pk2(s0[2], s0[3]); w.z = pk2(s0[4], s0[5]); w.w = pk2(s0[6], s0[7]); pf[0] = __builtin_bit_cast(bf16x8, w);
      w.x = pk2(s0[8], s0[9]); w.y = pk2(s0[10], s0[11]); w.z = pk2(s0[12], s0[13]); w.w = pk2(s0[14], s0[15]); pf[1] = __builtin_bit_cast(bf16x8, w);
      w.x = pk2(s1[0], s1[1]); w.y = pk2(s1[2], s1[3]); w.z = pk2(s1[4], s1[5]); w.w = pk2(s1[6], s1[7]); pf[2] = __builtin_bit_cast(bf16x8, w);
      w.x = pk2(s1[8], s1[9]); w.y = pk2(s1[10], s1[11]); w.z = pk2(s1[12], s1[13]); w.w = pk2(s1[14], s1[15]); pf[3] = __builtin_bit_cast(bf16x8, w); }
#pragma unroll
    for (int db = 0; db < DH / 32; ++db) {
        asm volatile("s_waitcnt lgkmcnt(0)" ::: "memory"); __builtin_amdgcn_sched_barrier(0);
        if (db + 1 < DH / 32) { if ((db & 1) == 0) ATT_VREAD(1, db + 1); else ATT_VREAD(0, db + 1); }
#pragma unroll
        for (int kk = 0; kk < 4; ++kk) { const s16x4 lo = vlo[db & 1][kk], h4 = vhi[db & 1][kk];
            const bf16x8 vf = (bf16x8){lo[0], lo[1], lo[2], lo[3], h4[0], h4[1], h4[2], h4[3]};
            o[db] = __builtin_amdgcn_mfma_f32_32x32x16_bf16(vf, pf[kk], o[db], 0, 0, 0); }
        __builtin_amdgcn_sched_barrier(0);
    }
#undef ATT_VREAD
}
__device__ __forceinline__ void load_bias(const float* biasrow, int hi, f32x16& s0, f32x16& s1) {
#pragma unroll
    for (int g4 = 0; g4 < 4; ++g4) { const f32x4 c0 = *(const f32x4*)(biasrow + 8 * g4 + 4 * hi), c1 = *(const f32x4*)(biasrow + 32 + 8 * g4 + 4 * hi);
#pragma unroll
        for (int i = 0; i < 4; ++i) { s0[4 * g4 + i] = c0[i]; s1[4 * g4 + i] = c1[i]; } }
}
template <int DH>
__device__ __forceinline__ void load_q(const bf16* qrow, const float* gq, float scale, bf16x8 (&qf)[DH / 16], int lane) {
    const int hi = lane >> 5;
    u32x4 w[DH / 16]; float ss = 0.f;
#pragma unroll
    for (int ks = 0; ks < DH / 16; ++ks) { w[ks] = *(const u32x4*)(qrow + 16 * ks + 8 * hi); float v[8]; unpack8(w[ks], v);
#pragma unroll
        for (int j = 0; j < 8; ++j) ss += v[j] * v[j]; }
    ss += __shfl_xor(ss, 32);
    const float rstd = __builtin_amdgcn_rsqf(ss * (1.0f / DH) + EPS) * scale;
#pragma unroll
    for (int ks = 0; ks < DH / 16; ++ks) { float v[8]; unpack8(w[ks], v);
        const f32x4 g0 = *(const f32x4*)(gq + 16 * ks + 8 * hi), g1 = *(const f32x4*)(gq + 16 * ks + 8 * hi + 4);
#pragma unroll
        for (int j = 0; j < 4; ++j) { v[j] *= rstd * g0[j]; v[4 + j] *= rstd * g1[j]; }
        qf[ks] = __builtin_bit_cast(bf16x8, pack8(v)); }
}
template <int DH>
__device__ __forceinline__ void store_o(bf16* yrow, const f32x16 (&o)[DH / 32], float l, int lane) {
    const int hi = lane >> 5;
    const float inv = frcp(l + __shfl_xor(l, 32));
#pragma unroll
    for (int db = 0; db < DH / 32; ++db)
#pragma unroll
        for (int g4 = 0; g4 < 4; ++g4) { u32x2 w; w.x = pk2(o[db][4 * g4] * inv, o[db][4 * g4 + 1] * inv); w.y = pk2(o[db][4 * g4 + 2] * inv, o[db][4 * g4 + 3] * inv);
            *(u32x2*)(yrow + 32 * db + 8 * g4 + 4 * hi) = w; }
}
template <int DH, int RSK, int RSV>
__device__ __forceinline__ void stage_kv(LAS unsigned char* Kl, LAS unsigned char* Vl, int ldsrow0, const bf16* src, size_t pitch, int kcol, int vcol, int nrows, const float* gk, int tid) {
    constexpr int CPR = DH / 8;
    for (int c = tid; c < nrows * CPR; c += 512) {
        const int row = c / CPR, ch = c % CPR;
        const bf16* rp = src + (size_t)row * pitch;
        const u32x4 kw = *(const u32x4*)(rp + kcol + ch * 8), vw = *(const u32x4*)(rp + vcol + ch * 8);
        float v[8]; unpack8(kw, v); float ss = 0.f;
#pragma unroll
        for (int j = 0; j < 8; ++j) ss += v[j] * v[j];
#pragma unroll
        for (int o = 1; o < CPR; o <<= 1) ss += __shfl_xor(ss, o);
        const float rstd = __builtin_amdgcn_rsqf(ss * (1.0f / DH) + EPS);
        const f32x4 g0 = *(const f32x4*)(gk + ch * 8), g1 = *(const f32x4*)(gk + ch * 8 + 4);
#pragma unroll
        for (int j = 0; j < 4; ++j) { v[j] *= rstd * g0[j]; v[4 + j] *= rstd * g1[j]; }
        *(LAS u32x4*)(Kl + (size_t)(ldsrow0 + row) * RSK + ch * 16) = pack8(v);
        *(LAS u32x4*)(Vl + (size_t)(ldsrow0 + row) * RSV + ch * 16) = vw;
    }
}

constexpr int NWAVES = 8;
constexpr size_t MiB = 1u << 20;
constexpr size_t WS_CTL = 0, CTL_ZERO_BYTES = 1 * MiB;
constexpr size_t WS_WIN = 2 * MiB;
constexpr size_t WS_WBR = 15 * MiB;
constexpr size_t WS_WOUT = 18 * MiB;
constexpr size_t WS_WUP = 20 * MiB;
constexpr size_t WS_WDN = 31 * MiB;
constexpr size_t WS_WKV = 37 * MiB;
constexpr size_t WS_MEMN = 39 * MiB;
constexpr size_t WS_KV = 41 * MiB;
constexpr size_t WS_BT = 43 * MiB;
constexpr size_t WS_BA = 45 * MiB;
constexpr size_t WS_SSQ = 49 * MiB;
constexpr size_t WS_P = 52 * MiB;
constexpr size_t WS_UE = 452 * MiB;
constexpr size_t WS_END = 512 * MiB;
static_assert(WS_P + (size_t)M * PLD * 2 == WS_UE && WS_UE + (size_t)512 * 4 * NUP * 4 <= WS_END, "d_ws map");

constexpr int CW_TMO = 0, CW_CODE = 1;
constexpr int CW_BAR = 4096;
constexpr int RING_OFF = 0, RING_BYTES = 147456;
constexpr int LDSCTL_OFF = RING_BYTES, MISC_OFF = LDSCTL_OFF + 320;
constexpr int XCH_OFF = MISC_OFF + 256;
constexpr int LDS_BYTES = 163840;
static_assert(XCH_OFF + 2 * 1280 * 4 <= LDS_BYTES && XCH_OFF % 16 == 0, "LDS map");

typedef GAS unsigned gu32;
#define RLX_AGENT __ATOMIC_RELAXED, __HIP_MEMORY_SCOPE_AGENT
#define LDS_WAIT() asm volatile("s_waitcnt lgkmcnt(0)" ::: "memory")
#define VM_WAIT() asm volatile("s_waitcnt vmcnt(0)" ::: "memory")

#define XB_TMO      128
#define XB_XCNT(j)  (256  + 64 * (j))
#define XB_XSUB(j)  (1280 + 64 * (j))
#define XB_XGEN(j)  (2304 + 64 * (j))
#define XB_TOP      3328
#define XB_TOPGEN   3392
#define XCD_BAR_WORDS 3456
#define XB_SPIN_CAP (1u << 22)

__device__ __forceinline__ unsigned xb_ld(unsigned* p)              { return __hip_atomic_load(p, __ATOMIC_RELAXED, __HIP_MEMORY_SCOPE_AGENT); }
__device__ __forceinline__ unsigned xb_add(unsigned* p, unsigned v) { return __hip_atomic_fetch_add(p, v, __ATOMIC_RELAXED, __HIP_MEMORY_SCOPE_AGENT); }
__device__ __forceinline__ unsigned xb_xcc_id() { return (unsigned)__builtin_amdgcn_s_getreg((3 << 11) | 20) & 0xFu; }
#define XB_SPIN(cond, bar) do { unsigned _sp = 0; while (cond) { __builtin_amdgcn_s_sleep(1); \
    if ((++_sp & 255u) == 0u) { if (xb_ld(&(bar)[XB_TMO])) break; if (_sp > XB_SPIN_CAP) { atomicAdd(&(bar)[XB_TMO], 1u); break; } } } } while (0)

struct XcdBarrier { unsigned* bar; unsigned x; volatile LAS unsigned* st; };

__device__ __forceinline__ XcdBarrier xcd_barrier_post(unsigned* bar, volatile LAS unsigned* st) {
    XcdBarrier b; b.bar = bar; b.x = xb_xcc_id(); b.st = st;
    if (threadIdx.x == 0) (void)xb_add(&bar[XB_XCNT(b.x)], 1u);
    return b;
}
__device__ __forceinline__ void xcd_barrier_complete(unsigned* bar, unsigned x, unsigned& nloc, unsigned& nx) {
    const unsigned G = gridDim.x * gridDim.y * gridDim.z;
    unsigned sum, cnt, mine, sp = 0u;
    for (;;) {
        sum = 0u; cnt = 0u; mine = 0u;
#pragma unroll
        for (unsigned j = 0; j < 16; ++j) { const unsigned c = xb_ld(&bar[XB_XCNT(j)]); sum += c; cnt += (c > 0u) ? 1u : 0u; mine = (j == x) ? c : mine; }
        if (sum == G) break;
        __builtin_amdgcn_s_sleep(1);
        if ((++sp & 255u) == 0u) { if (xb_ld(&bar[XB_TMO])) break; if (sp > XB_SPIN_CAP) { atomicAdd(&bar[XB_TMO], 1u); break; } }
    }
    nloc = mine > 0u ? mine : 1u; nx = cnt > 0u ? cnt : 1u;
}
__device__ __forceinline__ void xcd_barrier(const XcdBarrier& b) {
    asm volatile("s_waitcnt vmcnt(0)" ::: "memory");
    __syncthreads();
    if (threadIdx.x == 0) {
        unsigned* bar = b.bar;
        __builtin_amdgcn_s_waitcnt(0);
        unsigned nloc = b.st[0], nx = b.st[1];
        if (nloc == 0u) { xcd_barrier_complete(bar, b.x, nloc, nx); b.st[0] = nloc; b.st[1] = nx; }
        const unsigned old = xb_add(&bar[XB_XSUB(b.x)], 1u);
        const unsigned gen = old / nloc;
        if (old + 1u == (gen + 1u) * nloc) {
            __builtin_amdgcn_fence(__ATOMIC_RELEASE, "agent");
            asm volatile("s_waitcnt vmcnt(0)" ::: "memory");
            const unsigned og = xb_add(&bar[XB_TOP], 1u);
            const unsigned tg = og / nx;
            if (og + 1u == (tg + 1u) * nx) xb_add(&bar[XB_TOPGEN], 1u);
            else XB_SPIN(xb_ld(&bar[XB_TOPGEN]) == tg, bar);
            __builtin_amdgcn_fence(__ATOMIC_ACQUIRE, "agent");
            xb_add(&bar[XB_XGEN(b.x)], 1u);
            asm volatile("s_waitcnt vmcnt(0)" ::: "memory");
        } else {
            XB_SPIN(xb_ld(&bar[XB_XGEN(b.x)]) == gen, bar);
            __builtin_amdgcn_fence(__ATOMIC_ACQUIRE, "agent");
            asm volatile("s_waitcnt vmcnt(0)" ::: "memory");
        }
    }
    __syncthreads();
}

struct Frame {
    LAS unsigned char* lds;
    volatile LAS unsigned* MISC;
    gu32* ctl;
    int tid, lane, wave, vcu, G;
};

__device__ __forceinline__ float wave_sum(float v) {
#pragma unroll
    for (int o = 1; o < 64; o <<= 1) v += __shfl_xor(v, o);
    return v;
}
__device__ __forceinline__ int t5_bucket(int rel) {
    const int n = rel < 0 ? -rel : rel;
    const int mag = n < 8 ? n : n < 12 ? 8 : n < 16 ? 9 : n < 23 ? 10 : n < 32 ? 11 : n < 46 ? 12 : n < 64 ? 13 : n < 91 ? 14 : 15;
    return (rel > 0 ? 16 : 0) + mag;
}

__device__ __forceinline__ void transpose_item(const float* W, int K, int N, int k0, int n0, bf16* WT, int drow0, const float* gk, LAS float* scr, int lane) {
    { f32x4 v[8];
#pragma unroll
      for (int i = 0; i < 8; ++i) v[i] = *(const f32x4*)(W + (size_t)(k0 + 8 * i + (lane >> 3)) * N + n0 + 4 * (lane & 7));
#pragma unroll
      for (int i = 0; i < 8; ++i) { const int kk = 8 * i + (lane >> 3); const float gs = gk ? gk[k0 + kk] : 1.0f; LAS float* d = scr + kk * 33 + 4 * (lane & 7);
          d[0] = v[i][0] * gs; d[1] = v[i][1] * gs; d[2] = v[i][2] * gs; d[3] = v[i][3] * gs; } }
    LDS_WAIT(); asm volatile("" ::: "memory");
    const int c = lane & 7;
#pragma unroll
    for (int j = 0; j < 4; ++j) { const int n = (lane >> 3) + 8 * j; const LAS float* s = scr + (8 * c) * 33 + n;
        u32x4 o; o.x = pk2(s[0 * 33], s[1 * 33]); o.y = pk2(s[2 * 33], s[3 * 33]); o.z = pk2(s[4 * 33], s[5 * 33]); o.w = pk2(s[6 * 33], s[7 * 33]);
        *(GAS u32x4*)(WT + (size_t)(drow0 + n) * K + k0 + 8 * c) = o; }
    LDS_WAIT(); asm volatile("" ::: "memory");
}
__device__ __forceinline__ void rms_row_to_bf16(const float* xrow, const float* g, bf16* orow, int lane) {
    const GAS f32x4* xr = (const GAS f32x4*)xrow + lane;
    const GAS f32x4* gr = (const GAS f32x4*)g + lane;
    f32x4 v[4]; float s = 0.f;
#pragma unroll
    for (int j = 0; j < 4; ++j) { v[j] = xr[64 * j]; s += (v[j].x * v[j].x + v[j].y * v[j].y) + (v[j].z * v[j].z + v[j].w * v[j].w); }
    const float rstd = __builtin_amdgcn_rsqf(wave_sum(s) * (1.f / DM) + EPS);
    GAS unsigned long long* o8 = (GAS unsigned long long*)orow + lane;
#pragma unroll
    for (int j = 0; j < 4; ++j) { const f32x4 gg = gr[64 * j];
        o8[64 * j] = (unsigned long long)pk2(v[j].x * rstd * gg.x, v[j].y * rstd * gg.y) | ((unsigned long long)pk2(v[j].z * rstd * gg.z, v[j].w * rstd * gg.w) << 32); }
}

__device__ __forceinline__ void rms_row2_to_bf16(const float* xa, const float* xb, const float* g, bf16* oa, bf16* ob, int lane) {
    const GAS f32x4* xr0 = (const GAS f32x4*)xa + lane; const GAS f32x4* xr1 = (const GAS f32x4*)xb + lane;
    const GAS f32x4* gr = (const GAS f32x4*)g + lane;
    f32x4 v0[4], v1[4]; float s0 = 0.f, s1 = 0.f;
#pragma unroll
    for (int j = 0; j < 4; ++j) { v0[j] = xr0[64 * j]; v1[j] = xr1[64 * j]; }
#pragma unroll
    for (int j = 0; j < 4; ++j) { s0 += (v0[j].x * v0[j].x + v0[j].y * v0[j].y) + (v0[j].z * v0[j].z + v0[j].w * v0[j].w); s1 += (v1[j].x * v1[j].x + v1[j].y * v1[j].y) + (v1[j].z * v1[j].z + v1[j].w * v1[j].w); }
#pragma unroll
    for (int o = 1; o < 64; o <<= 1) { s0 += __shfl_xor(s0, o); s1 += __shfl_xor(s1, o); }
    const float r0 = __builtin_amdgcn_rsqf(s0 * (1.f / DM) + EPS), r1 = __builtin_amdgcn_rsqf(s1 * (1.f / DM) + EPS);
    GAS unsigned long long* o0 = (GAS unsigned long long*)oa + lane; GAS unsigned long long* o1 = (GAS unsigned long long*)ob + lane;
#pragma unroll
    for (int j = 0; j < 4; ++j) { const f32x4 gg = gr[64 * j];
        o0[64 * j] = (unsigned long long)pk2(v0[j].x * r0 * gg.x, v0[j].y * r0 * gg.y) | ((unsigned long long)pk2(v0[j].z * r0 * gg.z, v0[j].w * r0 * gg.w) << 32);
        o1[64 * j] = (unsigned long long)pk2(v1[j].x * r1 * gg.x, v1[j].y * r1 * gg.y) | ((unsigned long long)pk2(v1[j].z * r1 * gg.z, v1[j].w * r1 * gg.w) << 32); }
}

struct Args { const float* in[25]; float* out; unsigned char* ws; int ph_lo, ph_hi, mode, pad; };

__device__ __forceinline__ void p0_prologue(Frame& F, const Args& a) {
    unsigned char* ws = a.ws;
    LAS float* scr = (LAS float*)(F.lds + RING_OFF + F.wave * 16384);
    const int gw = F.vcu * NWAVES + F.wave, NGW = F.G * NWAVES;
    constexpr int I_IN = 16 * 201, I_BR = 8 * 32, I_OUT = 16 * 32, I_UP = 16 * 176, I_DN = 44 * 32, I_KV = 16 * 32;
    constexpr int NITEMS = I_IN + 3 * I_BR + I_OUT + I_UP + I_DN + I_KV;
    for (int it = gw; it < NITEMS; it += NGW) {
        int r = it;
        if (r < I_IN) { const int kb = r / 201, nb = r % 201, n0 = nb * 32;
            const int d0 = n0 < 2816 ? n0 : (n0 < 2848 ? 3328 + (n0 - 2816) : (n0 < 3360 ? n0 - 32 : 3584 + (n0 - 3360)));
            transpose_item(a.in[4], 1024, 6432, kb * 64, n0, (bf16*)(ws + WS_WIN), d0, nullptr, scr, F.lane); continue; }
        r -= I_IN;
        if (r < 3 * I_BR) { const int br = r / I_BR, q = r % I_BR, kb = q / 32, nb = q % 32;
            transpose_item(a.in[16 + br], 512, 1024, kb * 64, nb * 32, (bf16*)(ws + WS_WBR) + (size_t)br * 1024 * 512, nb * 32, nullptr, scr, F.lane); continue; }
        r -= 3 * I_BR;
        if (r < I_OUT) { const int kb = r / 32, nb = r % 32;
            transpose_item(a.in[19], 1024, 1024, kb * 64, nb * 32, (bf16*)(ws + WS_WOUT), nb * 32, nullptr, scr, F.lane); continue; }
        r -= I_OUT;
        if (r < I_UP) { const int kb = r / 176, nb = r % 176, n0 = nb * 32;
            const int isv = n0 >= DFF, nn = isv ? n0 - DFF : n0, d0 = (nn >> 7) * 256 + isv * 128 + (nn & 127);
            transpose_item(a.in[21], 1024, NUP, kb * 64, n0, (bf16*)(ws + WS_WUP), d0, a.in[20], scr, F.lane); continue; }
        r -= I_UP;
        if (r < I_DN) { const int kb = r / 32, nb = r % 32;
            transpose_item(a.in[24], DFF, 1024, kb * 64, nb * 32, (bf16*)(ws + WS_WDN), nb * 32, nullptr, scr, F.lane); continue; }
        r -= I_DN;
        { const int kb = r / 32, nb = r % 32;
            transpose_item(a.in[13], 1024, 1024, kb * 64, nb * 32, (bf16*)(ws + WS_WKV), nb * 32, nullptr, scr, F.lane); }
    }
    { u32x4* z = (u32x4*)((bf16*)(ws + WS_WIN) + (size_t)3360 * 1024); const int n16 = 224 * 1024 * 2 / 16;
      for (int i = blockIdx.x * 512 + F.tid; i < n16; i += F.G * 512) z[i] = (u32x4){0u, 0u, 0u, 0u}; }
    bf16* H = (bf16*)a.out;
    if (M % (2 * NGW) != 0) { for (int m = gw; m < M; m += NGW) rms_row_to_bf16(a.in[0] + (size_t)m * DM, a.in[3], H + (size_t)m * DM, F.lane); }
    else for (int m = gw; m < M; m += 2 * NGW) rms_row2_to_bf16(a.in[0] + (size_t)m * DM, a.in[0] + (size_t)(m + NGW) * DM, a.in[3], H + (size_t)m * DM, H + (size_t)(m + NGW) * DM, F.lane);
    for (int m = gw; m < BATCH * NMEM; m += NGW) rms_row_to_bf16(a.in[1] + (size_t)m * DM, a.in[12], (bf16*)(ws + WS_MEMN) + (size_t)m * DM, F.lane);
    { float* BT = (float*)(ws + WS_BT); const float* tab = a.in[2];
      for (int i = blockIdx.x * 512 + F.tid; i < 8 * 128 * 384; i += F.G * 512) { const int j = i % 384, t = (i / 384) % 128, h = i / (384 * 128);
          const int rel = j - 128 - t; const bool ok = rel >= -128 && rel <= 128;
          BT[i] = ok ? tab[t5_bucket(rel) * 8 + h] * LOG2E : -INFINITY; } }
}

__device__ __forceinline__ void attnA_unit(Frame& F, const Args& a, int b, int n, int kvh) {
    constexpr int RSK = 144, RSV = 128;
    LAS unsigned char* Kl = F.lds; LAS unsigned char* Vl = F.lds + 384 * RSK;
    bf16* P = (bf16*)(a.ws + WS_P);
    const float* BT = (const float*)(a.ws + WS_BT);
    for (int blk = 0; blk < 3; ++blk) { const int pos0 = n * 128 - 128 + blk * 128; if (pos0 < 0 || pos0 >= SEQ) continue;
        stage_kv<64, RSK, RSV>(Kl, Vl, blk * 128, P + (size_t)(b * SEQ + pos0) * PLD, PLD, C_AK + kvh * 64, C_AV + kvh * 64, 128, a.in[6], F.tid); }
    LDS_WAIT(); __syncthreads();
    const int h = kvh * 4 + (F.wave >> 1), r32 = F.lane & 31, hi = F.lane >> 5;
    const float sink = a.in[7][h] * LOG2E;
#pragma unroll 1
    for (int qb = 0; qb < 2; ++qb) {
        const int t0 = (F.wave & 1) * 64 + qb * 32, t = t0 + r32;
        bf16* qrow = P + (size_t)(b * SEQ + n * 128 + t) * PLD + C_AQ + h * 64;
        bf16x8 qf[4]; load_q<64>(qrow, a.in[5], 0.125f * LOG2E, qf, F.lane);
        float m = sink, l = hi == 0 ? 1.f : 0.f; f32x16 o[2];
#pragma unroll
        for (int r = 0; r < 16; ++r) { o[0][r] = 0.f; o[1][r] = 0.f; }
        const int lo = max(t0 >= 64 ? 1 : 0, n == 0 ? 2 : 0), hi_t = min(t0 >= 64 ? 5 : 4, n == SEQ / 128 - 1 ? 3 : 5);
        const float* brow = BT + ((size_t)h * 128 + t) * 384;
        f32x16 b0, b1; load_bias(brow + 64 * lo, hi, b0, b1);
#pragma unroll 1
        for (int kt = lo; kt <= hi_t; ++kt) {
            f32x16 nb0 = b0, nb1 = b1;
            if (kt < hi_t) load_bias(brow + 64 * (kt + 1), hi, nb0, nb1);
            attn_tile<64, RSK, RSV>(Kl, Vl, 64 * kt, qf, b0, b1, m, l, o, F.lane);
            b0 = nb0; b1 = nb1; }
        store_o<64>(qrow, o, l, F.lane);
    }
    LDS_WAIT(); __syncthreads();
}
__device__ __forceinline__ void xattn_unit(Frame& F, const Args& a, int b, int tb, int h) {
    constexpr int RSK = 272, RSV = 320;
    LAS unsigned char* Kl = F.lds; LAS unsigned char* Vl = F.lds + 128 * RSK;
    bf16* P = (bf16*)(a.ws + WS_P);
    const bf16* KV = (const bf16*)(a.ws + WS_KV);
    const int r32 = F.lane & 31;
    bf16* qrow = P + (size_t)(b * SEQ + tb * 256 + F.wave * 32 + r32) * PLD + C_MQ + h * 128;
    bf16x8 qf[8]; load_q<128>(qrow, a.in[14], 0.08838834764831845f * LOG2E, qf, F.lane);
    float m = -1e30f, l = 0.f; f32x16 o[4];
#pragma unroll
    for (int db = 0; db < 4; ++db)
#pragma unroll
        for (int r = 0; r < 16; ++r) o[db][r] = 0.f;
#pragma unroll 1
    for (int half = 0; half < 2; ++half) {
        stage_kv<128, RSK, RSV>(Kl, Vl, 0, KV + (size_t)(b * NMEM + half * 128) * 1024, 1024, h * 128, 512 + h * 128, 128, a.in[15], F.tid);
        LDS_WAIT(); __syncthreads();
#pragma unroll 1
        for (int kt = 0; kt < 2; ++kt) { f32x16 z0, z1;
#pragma unroll
            for (int r = 0; r < 16; ++r) { z0[r] = 0.f; z1[r] = 0.f; }
            attn_tile<128, RSK, RSV>(Kl, Vl, 64 * kt, qf, z0, z1, m, l, o, F.lane); }
        LDS_WAIT(); __syncthreads();
    }
    store_o<128>(qrow, o, l, F.lane);
}


constexpr int SAF = C_GATE, SCF = C_GATE + 512, SBF = C_GATE + 1024, SDF = C_GATE + 1536, SAB = C_GATE + 2048, SCB = C_GATE + 2560;
constexpr int C_OF = C_DQ, C_OB = C_DK;
__device__ __forceinline__ int dn_pcol(int x) { return (x & 32) + 8 * ((x & 15) >> 2) + 4 * ((x >> 4) & 1) + (x & 3); }
__device__ __forceinline__ bf16x8 frag_lo(const LAS unsigned char* p) { const u32x2 a0 = *(const LAS u32x2*)p; u32x4 w; w.x = a0.x; w.y = a0.y; w.z = 0u; w.w = 0u; return __builtin_bit_cast(bf16x8, w); }
__device__ __forceinline__ bf16x8 frag_2(const LAS unsigned char* p) { const u32x2 a0 = *(const LAS u32x2*)p, a1 = *(const LAS u32x2*)(p + 32); u32x4 w; w.x = a0.x; w.y = a0.y; w.z = a1.x; w.w = a1.y; return __builtin_bit_cast(bf16x8, w); }
__device__ __forceinline__ bf16x8 pack_f4z(const f32x4 a) { u32x4 w; w.x = pk2(a[0], a[1]); w.y = pk2(a[2], a[3]); w.z = 0u; w.w = 0u; return __builtin_bit_cast(bf16x8, w); }
__device__ __forceinline__ bf16x8 pack_f4f4(const f32x4 a, const f32x4 b) { u32x4 w; w.x = pk2(a[0], a[1]); w.y = pk2(a[2], a[3]); w.z = pk2(b[0], b[1]); w.w = pk2(b[2], b[3]); return __builtin_bit_cast(bf16x8, w); }
__device__ __forceinline__ void dn_prep_block(Frame& F, const Args& a, int b, int h, int c0, int nch) {
    LAS float* raw = (LAS float*)(F.lds);
    LAS unsigned char* NL = F.lds;
    LAS unsigned char* TD = F.lds + 18432;
    LAS unsigned char* Qb = F.lds + 53248;
    LAS unsigned char* Kb = F.lds + 62464;
    LAS unsigned char* Vb = F.lds + 71680;
    LAS float* sm = (LAS float*)(F.lds + 80896);
    LAS float* gt = sm;
    LAS float* btk = sm + 128;
    LAS float* gct = sm + 256;
    LAS float* cu = sm + 384;
    LAS float* cwp = sm + 512;
    LAS float* egp = sm + 640;
    LAS float* esp = sm + 768;
    LAS unsigned char* QKL = F.lds + 24576;
    LAS unsigned char* KT = F.lds + 84480;
    LAS unsigned char* QT = F.lds + 104960;
    bf16* P = (bf16*)(a.ws + WS_P);
    float* BA = (float*)(a.ws + WS_BA);
    bf16* XB2 = (bf16*)a.out + (size_t)M * 1024;
    const float* cw = a.in[8];
    const int w = F.wave, lane = F.lane, tid = F.tid;
    float wt[3][5];
#pragma unroll
    for (int which = 0; which < 3; ++which)
#pragma unroll
        for (int j = 0; j < 5; ++j) wt[which][j] = cw[j * 1536 + which * 512 + h * 64 + lane];
    const float Ah = expf(a.in[9][(tid >> 6 & 1) * 8 + h]), dtb = a.in[10][(tid >> 6 & 1) * 8 + h];
    u32x4 rr[4]; float pa = 0.f, pb = 0.f;
#define DN_PREFETCH(cidx) do { const int t0p_ = (cidx) * 64; \
        _Pragma("unroll") for (int i_ = 0; i_ < 4; ++i_) { const int e = tid + 512 * i_, row = e / 24, c8 = e % 24, which = c8 >> 3, t = t0p_ - 2 + row; \
            rr[i_] = (u32x4){0u, 0u, 0u, 0u}; \
            if (e < 68 * 24 && t >= 0 && t < SEQ) rr[i_] = *(const u32x4*)(P + ((size_t)b * SEQ + t) * PLD + (which == 0 ? C_DQ : which == 1 ? C_DK : C_DV) + h * 64 + (c8 & 7) * 8); } \
        if (tid < 128) { const size_t tok = (size_t)b * SEQ + t0p_ + (tid & 63); pa = BA[tok * 32 + 16 + (tid >> 6) * 8 + h]; pb = BA[tok * 32 + (tid >> 6) * 8 + h]; } } while (0)
    DN_PREFETCH(c0);
#pragma unroll 1
  for (int ci = 0; ci < nch; ++ci) {
    int tid_o = F.tid; asm volatile("" : "+v"(tid_o));
    const int tid = tid_o, lane = tid & 63;
    const int c = c0 + ci, t0 = c * 64;
    const size_t tok0 = (size_t)b * SEQ + t0;
#pragma unroll
    for (int i_ = 0; i_ < 4; ++i_) { const int e = tid + 512 * i_, row = e / 24, c8 = e % 24;
        if (e < 68 * 24) { float v[8]; unpack8(rr[i_], v);
            *(LAS f32x4*)(raw + row * 192 + c8 * 8) = (f32x4){v[0], v[1], v[2], v[3]}; *(LAS f32x4*)(raw + row * 192 + c8 * 8 + 4) = (f32x4){v[4], v[5], v[6], v[7]}; } }
    if (tid < 128) { const int d = tid >> 6, i = tid & 63; const float xa = pa + dtb;
        gt[d * 64 + i] = -Ah * (fmaxf(xa, 0.f) + __logf(1.0f + __expf(-fabsf(xa))));
        btk[d * 64 + i] = sigmoidf_(pb); }
    if (ci + 1 < nch) DN_PREFETCH(c + 1);
    LDS_WAIT(); __syncthreads();
#pragma unroll
    for (int which = 0; which < 3; ++which) {
        float x[12], y[8];
#pragma unroll
        for (int j = 0; j < 12; ++j) x[j] = raw[(w * 8 + j) * 192 + which * 64 + lane];
#pragma unroll
        for (int r = 0; r < 8; ++r) { float acc = 0.f;
#pragma unroll
            for (int j = 0; j < 5; ++j) acc += x[r + j] * wt[which][j];
            y[r] = siluf_(acc); }
        if (which < 2) {
            float ss[8];
#pragma unroll
            for (int r = 0; r < 8; ++r) ss[r] = y[r] * y[r];
#pragma unroll
            for (int o = 1; o < 64; o <<= 1)
#pragma unroll
                for (int r = 0; r < 8; ++r) ss[r] += __shfl_xor(ss[r], o);
#pragma unroll
            for (int r = 0; r < 8; ++r) y[r] *= __builtin_amdgcn_rsqf(ss[r] + EPS) * (which == 0 ? 0.125f : 1.0f);
        }
        LAS unsigned char* X = which == 0 ? Qb : which == 1 ? Kb : Vb;
#pragma unroll
        for (int r = 0; r < 8; ++r) *(LAS bf16*)(X + (w * 8 + r) * 144 + lane * 2) = (bf16)(pk2(y[r], 0.f) & 0xffffu);
        asm volatile("" ::: "memory");
    }
    if (w < 2) { const int i = w ? 63 - lane : lane; float gv = gt[w * 64 + i];
#pragma unroll
        for (int o = 1; o < 64; o <<= 1) { const float t = __shfl_up(gv, o); if (lane >= o) gv += t; }
        const float glast = __shfl(gv, 63), bt = btk[w * 64 + i], eg = __expf(gv);
        const float es = __expf(glast - gv);
        gct[w * 64 + i] = gv; cu[w * 64 + lane] = bt; cwp[w * 64 + lane] = bt * eg; egp[w * 64 + lane] = eg; esp[w * 64 + lane] = es;
        BA[(tok0 + lane) * 32 + w * 8 + h] = eg; }
    LDS_WAIT(); __syncthreads();
    { const int p = tid >> 3, c8 = tid & 7;
#pragma unroll
      for (int d = 0; d < 2; ++d) { const int i = d ? 63 - p : p; const float es = esp[d * 64 + p], eg = egp[d * 64 + p]; float v[8];
          unpack8(*(const LAS u32x4*)(Kb + i * 144 + c8 * 16), v);
#pragma unroll
          for (int j = 0; j < 8; ++j) v[j] *= es;
          *(LAS u32x4*)(KT + d * 10240 + p * 160 + c8 * 16) = pack8(v);
          unpack8(*(const LAS u32x4*)(Qb + i * 144 + c8 * 16), v);
#pragma unroll
          for (int j = 0; j < 8; ++j) v[j] *= eg;
          *(LAS u32x4*)(QT + d * 9216 + p * 144 + c8 * 16) = pack8(v); } }
    { const int wq = w & 3, tm = wq >> 1, tn = wq & 1, r32 = lane & 31, hi = lane >> 5;
      const LAS unsigned char* X = (w < 4) ? Kb : Qb;
      f32x16 acc;
#pragma unroll
      for (int r = 0; r < 16; ++r) acc[r] = 0.f;
#pragma unroll
      for (int kst = 0; kst < 4; ++kst) {
          const bf16x8 af = *(const LAS bf16x8*)(X + (32 * tm + r32) * 144 + (16 * kst + 8 * hi) * 2), bfr = *(const LAS bf16x8*)(Kb + (32 * tn + r32) * 144 + (16 * kst + 8 * hi) * 2);
          acc = __builtin_amdgcn_mfma_f32_32x32x16_bf16(af, bfr, acc, 0, 0, 0); }
      const int j = 32 * tn + r32; const float gjf = gct[j], gjb = gct[64 + j];
#pragma unroll
      for (int g4 = 0; g4 < 4; ++g4) { const int i0 = 32 * tm + 8 * g4 + 4 * hi;
          const f32x4 gif = *(const LAS f32x4*)(gct + i0), gib = *(const LAS f32x4*)(gct + 64 + i0), bif = *(const LAS f32x4*)(btk + i0), bib = *(const LAS f32x4*)(btk + 64 + i0);
#pragma unroll
          for (int q = 0; q < 4; ++q) { const int i = i0 + q; const float v = acc[4 * g4 + q];
              const float ef = __expf(fminf(gif[q] - gjf, 0.f)), eb = __expf(fminf(gib[q] - gjb, 0.f));
              if (w < 4) {
                  const float lf = (j < i) ? -bif[q] * v * ef : 0.f, lb = (j > i) ? -bib[q] * v * eb : 0.f;
                  *(LAS bf16*)(NL + i * 144 + j * 2) = (bf16)(pk2(lf, 0.f) & 0xffffu);
                  *(LAS bf16*)(NL + 9216 + (63 - i) * 144 + (63 - j) * 2) = (bf16)(pk2(lb, 0.f) & 0xffffu);
              } else {
                  const float qf = (j <= i) ? v * ef : 0.f, qb = (j >= i) ? v * eb : 0.f;
                  *(LAS bf16*)(QKL + i * 144 + j * 2) = (bf16)(pk2(qf, 0.f) & 0xffffu);
                  *(LAS bf16*)(QKL + 9216 + (63 - i) * 144 + (63 - j) * 2) = (bf16)(pk2(qb, 0.f) & 0xffffu);
              } } } }
    LDS_WAIT(); __syncthreads();
    if (w < 2) { const int blk = lane >> 4, col = lane & 15; const LAS unsigned char* nl = NL + w * 9216 + (16 * blk) * 144 + (16 * blk) * 2;
        u32x4 lr[16][2];
#pragma unroll
        for (int r = 1; r < 16; ++r) { lr[r][0] = *(const LAS u32x4*)(nl + r * 144); if (r > 8) lr[r][1] = *(const LAS u32x4*)(nl + r * 144 + 16); }
        float t[16];
#pragma unroll
        for (int r = 0; r < 16; ++r) { float a0 = (r == col) ? 1.f : 0.f, a1 = 0.f;
            if (r > 0) { float l[16]; { float l8[8]; unpack8(lr[r][0], l8);
#pragma unroll
                    for (int q = 0; q < 8; ++q) l[q] = l8[q]; }
                if (r > 8) { float l8[8]; unpack8(lr[r][1], l8);
#pragma unroll
                    for (int q = 0; q < 8; ++q) l[8 + q] = l8[q]; }
#pragma unroll
                for (int q = 0; q < r; ++q) { if (q & 1) a1 += l[q] * t[q]; else a0 += l[q] * t[q]; } }
            t[r] = a0 + a1; }
#pragma unroll
        for (int r = 0; r < 16; ++r) *(LAS bf16*)(TD + w * 3072 + blk * 768 + r * 48 + col * 2) = (bf16)(pk2(t[r], 0.f) & 0xffffu);
    }
    LDS_WAIT(); __syncthreads();
    { const int d = w >> 2, cc = lane & 15, g = lane >> 4;
      const LAS unsigned char* nl = NL + d * 9216; const LAS unsigned char* td = TD + d * 3072 + cc * 48 + 8 * g;
#pragma unroll
      for (int jj = 0; jj < 2; ++jj) { const int ct = 2 * (w & 3) + jj, part = ct >> 2, colb = 16 * (ct & 3);
          const LAS unsigned char* src = part ? Kb : Vb; const LAS float* coef = (part ? cwp : cu) + d * 64;
          f32x4 R[4];
#pragma unroll
          for (int bq = 0; bq < 4; ++bq) { const f32x4 cf = *(const LAS f32x4*)(coef + 16 * bq + 4 * g);
#pragma unroll
              for (int r = 0; r < 4; ++r) { const int p = 16 * bq + 4 * g + r, i = d ? 63 - p : p;
                  R[bq][r] = cf[r] * __uint_as_float((unsigned)(*(const LAS bf16*)(src + i * 144 + (colb + cc) * 2)) << 16); } }
          const f32x4 z4 = (f32x4){0.f, 0.f, 0.f, 0.f};
          f32x4 X0, X1, X2, X3, Y;
          const bf16x8 t0f = frag_lo(td), t1f = frag_lo(td + 768), t2f = frag_lo(td + 2 * 768), t3f = frag_lo(td + 3 * 768);
          const bf16x8 n1f = frag_lo(nl + (16 + cc) * 144 + 8 * g), n2f = frag_2(nl + (32 + cc) * 144 + 8 * g), n3f = frag_2(nl + (48 + cc) * 144 + 8 * g), n3g = frag_lo(nl + (48 + cc) * 144 + 64 + 8 * g);
          __builtin_amdgcn_sched_barrier(0);
          X0 = __builtin_amdgcn_mfma_f32_16x16x32_bf16(t0f, pack_f4z(R[0]), z4, 0, 0, 0);
          Y = __builtin_amdgcn_mfma_f32_16x16x32_bf16(n1f, pack_f4z(X0), R[1], 0, 0, 0);
          X1 = __builtin_amdgcn_mfma_f32_16x16x32_bf16(t1f, pack_f4z(Y), z4, 0, 0, 0);
          const bf16x8 x01 = pack_f4f4(X0, X1);
          Y = __builtin_amdgcn_mfma_f32_16x16x32_bf16(n2f, x01, R[2], 0, 0, 0);
          X2 = __builtin_amdgcn_mfma_f32_16x16x32_bf16(t2f, pack_f4z(Y), z4, 0, 0, 0);
          Y = __builtin_amdgcn_mfma_f32_16x16x32_bf16(n3f, x01, R[3], 0, 0, 0);
          Y = __builtin_amdgcn_mfma_f32_16x16x32_bf16(n3g, pack_f4z(X2), Y, 0, 0, 0);
          X3 = __builtin_amdgcn_mfma_f32_16x16x32_bf16(t3f, pack_f4z(Y), z4, 0, 0, 0);
          const float sgn = part ? -1.f : 1.f;
          const bf16x8 xb0 = pack_f4f4(X0 * sgn, X1 * sgn), xb1 = pack_f4f4(X2 * sgn, X3 * sgn);
          const int q4 = (lane & 15) >> 2, pp = lane & 3;
          const LAS unsigned char* qkl = QKL + d * 9216; const LAS unsigned char* qtl = QT + d * 9216;
          bf16* pA = (d == 0 || part == 1) ? P + tok0 * PLD + h * 64 + (part ? (d ? SAB : SAF) : SBF) : XB2 + tok0 * 512 + h * 64;
          bf16* pC = (d == 0 || part == 1) ? P + tok0 * PLD + h * 64 + (part ? (d ? SCB : SCF) : SDF) : XB2 + (size_t)M * 512 + tok0 * 512 + h * 64;
          const size_t pit = (d == 0 || part == 1) ? PLD : 512;
          const int pc = dn_pcol(colb + cc);
#pragma unroll
          for (int mt = 0; mt < 4; ++mt) {
              s16x4 klo[2], khi[2]; bf16x8 qkf[2]; f32x4 acc2;
              { const unsigned ka = (unsigned)(uintptr_t)(KT + d * 10240) + (4 * g + q4) * 160u + (16 * mt + 4 * pp) * 2u;
                asm volatile("ds_read_b64_tr_b16 %0, %1" : "=&v"(klo[0]) : "v"(ka) : "memory");
                asm volatile("ds_read_b64_tr_b16 %0, %1 offset:2560" : "=&v"(khi[0]) : "v"(ka) : "memory");
                asm volatile("ds_read_b64_tr_b16 %0, %1 offset:5120" : "=&v"(klo[1]) : "v"(ka) : "memory");
                asm volatile("ds_read_b64_tr_b16 %0, %1 offset:7680" : "=&v"(khi[1]) : "v"(ka) : "memory"); }
#pragma unroll
              for (int ks = 0; ks < 2; ++ks) { if (ks == 1 && mt < 2) continue; qkf[ks] = frag_2(qkl + (16 * mt + cc) * 144 + (32 * ks + 4 * g) * 2); }
#pragma unroll
              for (int r = 0; r < 4; ++r) acc2[r] = part ? __uint_as_float((unsigned)(*(const LAS bf16*)(qtl + (16 * mt + 4 * g + r) * 144 + (colb + cc) * 2)) << 16) : 0.f;
              asm volatile("s_waitcnt lgkmcnt(0)" ::: "memory"); __builtin_amdgcn_sched_barrier(0);
              f32x4 acc = z4;
#pragma unroll
              for (int ks = 0; ks < 2; ++ks) { const bf16x8 kf = (bf16x8){klo[ks][0], klo[ks][1], klo[ks][2], klo[ks][3], khi[ks][0], khi[ks][1], khi[ks][2], khi[ks][3]};
                  acc = __builtin_amdgcn_mfma_f32_16x16x32_bf16(kf, ks ? xb1 : xb0, acc, 0, 0, 0); }
#pragma unroll
              for (int ks = 0; ks < 2; ++ks) { if (ks == 1 && mt < 2) continue; acc2 = __builtin_amdgcn_mfma_f32_16x16x32_bf16(qkf[ks], ks ? xb1 : xb0, acc2, 0, 0, 0); }
              if (part == 0) {
                  u32x2 o; o.x = pk2(acc[0], acc[1]); o.y = pk2(acc[2], acc[3]); *(u32x2*)(pA + (size_t)(colb + cc) * pit + 16 * mt + 4 * g) = o;
                  o.x = pk2(acc2[0], acc2[1]); o.y = pk2(acc2[2], acc2[3]); *(u32x2*)(pC + (size_t)(colb + cc) * pit + 16 * mt + 4 * g) = o; }
              else {
#pragma unroll
                  for (int r = 0; r < 4; ++r) { pA[(size_t)(16 * mt + 4 * g + r) * pit + pc] = (bf16)(pk2(acc[r], 0.f) & 0xffffu); pC[(size_t)(16 * mt + 4 * g + r) * pit + pc] = (bf16)(pk2(acc2[r], 0.f) & 0xffffu); } }
              __builtin_amdgcn_sched_barrier(0);
          }
          asm volatile("" ::: "memory"); __builtin_amdgcn_sched_barrier(0);
      } }
    LDS_WAIT(); __syncthreads();
  }
#undef DN_PREFETCH
}

constexpr int DNX_A = 0, DNX_C = 8192, DNX_BT = 16384, DNX_DT = 24576, DNX_EG = 32768, DNX_SZ = 33792, DNX_OST = 3 * DNX_SZ;
__device__ __forceinline__ void dn_scan_step(const LAS unsigned char* buf, f32x4 (&Sacc)[4], int ws, int lane, LAS unsigned char* ost, int dir) {
    const int c = lane & 15, g = lane >> 4;
    const unsigned trow = 16 * ws + c, t0 = trow * 128u + ((((unsigned)(g >> 1)) ^ ((trow >> 1) & 7u)) << 4) + 8u * (g & 1);
    u32x2 bt[4], dt[4]; bf16x8 af[4][2], cf[4][2];
#pragma unroll
    for (int mt = 0; mt < 4; ++mt) { const unsigned row = 16 * mt + c, a0 = row * 128u + ((((unsigned)g) ^ ((row >> 1) & 7u)) << 4);
        bt[mt] = *(const LAS u32x2*)(buf + DNX_BT + (t0 ^ ((unsigned)mt << 5)));
#pragma unroll
        for (int ks = 0; ks < 2; ++ks) af[mt][ks] = *(const LAS bf16x8*)(buf + DNX_A + (a0 ^ ((unsigned)ks << 6))); }
#pragma unroll
    for (int mt = 0; mt < 4; ++mt) { const unsigned row = 16 * mt + c, a0 = row * 128u + ((((unsigned)g) ^ ((row >> 1) & 7u)) << 4);
        dt[mt] = *(const LAS u32x2*)(buf + DNX_DT + (t0 ^ ((unsigned)mt << 5)));
#pragma unroll
        for (int ks = 0; ks < 2; ++ks) cf[mt][ks] = *(const LAS bf16x8*)(buf + DNX_C + (a0 ^ ((unsigned)ks << 6))); }
    const float gm = ((const LAS float*)(buf + DNX_EG))[63];
    bf16x8 Sb[2];
#pragma unroll
    for (int ks = 0; ks < 2; ++ks) Sb[ks] = pack_f4f4(Sacc[2 * ks], Sacc[2 * ks + 1]);
    __builtin_amdgcn_sched_barrier(0);
#pragma unroll
    for (int mt = 0; mt < 4; ++mt) { f32x4 sn = Sacc[mt] * gm + (f32x4){bf_lo(bt[mt].x), bf_hi(bt[mt].x), bf_lo(bt[mt].y), bf_hi(bt[mt].y)};
#pragma unroll
        for (int ks = 0; ks < 2; ++ks) sn = __builtin_amdgcn_mfma_f32_16x16x32_bf16(af[mt][ks], Sb[ks], sn, 0, 0, 0);
        Sacc[mt] = sn; }
#pragma unroll
    for (int mt = 0; mt < 4; ++mt) { f32x4 oa = (f32x4){bf_lo(dt[mt].x), bf_hi(dt[mt].x), bf_lo(dt[mt].y), bf_hi(dt[mt].y)};
#pragma unroll
        for (int ks = 0; ks < 2; ++ks) oa = __builtin_amdgcn_mfma_f32_16x16x32_bf16(cf[mt][ks], Sb[ks], oa, 0, 0, 0);
#pragma unroll
        for (int r = 0; r < 4; ++r) { const int p = 16 * mt + 4 * g + r, i = dir ? 63 - p : p;
            *(LAS bf16*)(ost + i * 128 + (16 * ws + c) * 2) = (bf16)(pk2(oa[r], 0.f) & 0xffffu); } }
}
__device__ __forceinline__ void dn_scan_unit(Frame& F, const Args& a, int b, int h, int dir) {
    bf16* P = (bf16*)(a.ws + WS_P);
    const int w = F.wave, lane = F.lane;
#define DN_BAR() do { asm volatile("s_waitcnt lgkmcnt(0)" ::: "memory"); __builtin_amdgcn_s_barrier(); asm volatile("" ::: "memory"); } while (0)
    if (w < 4) {
        f32x4 Sacc[4];
#pragma unroll
        for (int mt = 0; mt < 4; ++mt) Sacc[mt] = (f32x4){0.f, 0.f, 0.f, 0.f};
        bf16* Ob = P + (size_t)b * SEQ * PLD + (dir ? C_OB : C_OF) + h * 64;
        DN_BAR();
        int slot = 0;
#pragma unroll 1
        for (int s = 0; s <= 128; ++s) {
            if (s > 0) { const int cp = dir ? 128 - s : s - 1; const LAS unsigned char* st = F.lds + DNX_OST + ((s - 1) & 1) * 8192;
#pragma unroll
                for (int k = 0; k < 2; ++k) { const int idx = F.tid + 256 * k, row = idx >> 3, ch = idx & 7;
                    *(u32x4*)(Ob + ((size_t)cp * 64 + row) * PLD + ch * 8) = *(const LAS u32x4*)(st + row * 128 + ch * 16); } }
            if (s < 128) dn_scan_step(F.lds + slot * DNX_SZ, Sacc, w, lane, F.lds + DNX_OST + (s & 1) * 8192, dir);
            slot = slot == 2 ? 0 : slot + 1;
            DN_BAR();
        }
    } else {
        const int hw = w - 4;
        const bf16* XB2 = (const bf16*)a.out + (size_t)M * 1024;
        const float* BAg = (const float*)(a.ws + WS_BA);
        const char* gp[8]; long gstep[8];
#pragma unroll
        for (int i = 0; i < 8; ++i) { const int pid = hw * 8 + i, blk = pid >> 3, pc = pid & 7, r = 8 * pc + (lane >> 3), cp = lane & 7;
            const int key = (r >> 1) & 7, cs = cp ^ key;
            const size_t tokb = (size_t)b * SEQ;
            if (dir == 1 && blk >= 2) { gp[i] = (const char*)(XB2 + (size_t)(blk - 2) * M * 512 + (tokb + r) * 512 + h * 64 + cs * 8); gstep[i] = 64L * 512 * 2; }
            else { const int col = blk == 0 ? (dir ? SAB : SAF) : blk == 1 ? (dir ? SCB : SCF) : blk == 2 ? SBF : SDF;
                   gp[i] = (const char*)(P + (tokb + r) * PLD + col + h * 64 + cs * 8); gstep[i] = 64L * PLD * 2; } }
        const char* ggc = (const char*)(BAg + ((size_t)b * SEQ + lane) * 32 + dir * 8 + h);
#define DN_ISSUE(n, slot_) do { const int cn_ = dir ? 127 - (n) : (n); LAS unsigned char* sb_ = F.lds + (slot_) * DNX_SZ; \
        _Pragma("unroll") for (int i = 0; i < 8; ++i) { const int pid = hw * 8 + i; \
            __builtin_amdgcn_global_load_lds((const unsigned*)(gp[i] + (long)cn_ * gstep[i]), (LAS unsigned*)(sb_ + (pid >> 3) * 8192 + (pid & 7) * 1024), 16, 0, 0); } \
        __builtin_amdgcn_global_load_lds((const unsigned*)(ggc + (long)cn_ * (64L * 32 * 4)), (LAS unsigned*)(sb_ + DNX_EG + hw * 256), 4, 0, 0); } while (0)
        DN_ISSUE(0, 0); DN_ISSUE(1, 1);
        asm volatile("s_waitcnt vmcnt(9)" ::: "memory");
        DN_BAR();
        int slot2 = 2;
#pragma unroll 1
        for (int s = 0; s <= 128; ++s) {
            if (s + 2 < 128) { DN_ISSUE(s + 2, slot2); asm volatile("s_waitcnt vmcnt(9)" ::: "memory"); }
            else { asm volatile("s_waitcnt vmcnt(0)" ::: "memory"); }
            slot2 = slot2 == 2 ? 0 : slot2 + 1;
            DN_BAR();
        }
#undef DN_ISSUE
    }
#undef DN_BAR
    __syncthreads();
}
__device__ __forceinline__ void dn_combine(Frame& F, const Args& a) {
    bf16* P = (bf16*)(a.ws + WS_P);
    const float* og = a.in[11];
    const int gw = F.vcu * NWAVES + F.wave, NGW = F.G * NWAVES, c0 = F.lane * 8;
    for (int row = gw; row < M; row += NGW) {
        bf16* rp = P + (size_t)row * PLD;
        float of[8], ob[8]; unpack8(*(const u32x4*)(rp + C_OF + c0), of); unpack8(*(const u32x4*)(rp + C_OB + c0), ob);
        float s[8], ss = 0.f;
#pragma unroll
        for (int j = 0; j < 8; ++j) { s[j] = of[j] + ob[j]; ss += s[j] * s[j]; }
        ss += __shfl_xor(ss, 1); ss += __shfl_xor(ss, 2); ss += __shfl_xor(ss, 4);
        const float rstd = __builtin_amdgcn_rsqf(ss * (1.0f / 64) + EPS);
        bf16* zp = rp + C_DZ + c0; float z[8]; unpack8(*(const u32x4*)zp, z);
        const f32x4 g0 = *(const f32x4*)(og + (c0 & 63)), g1 = *(const f32x4*)(og + (c0 & 63) + 4);
        float y[8];
#pragma unroll
        for (int j = 0; j < 4; ++j) { y[j] = s[j] * rstd * g0[j] * siluf_(z[j]); y[4 + j] = s[4 + j] * rstd * g1[j] * siluf_(z[4 + j]); }
        *(u32x4*)zp = pack8(y);
    }
}
__device__ __forceinline__ void ffn_fixup_panel(Frame& F, const Args& a, int pm) {
    bf16* P = (bf16*)(a.ws + WS_P); const float* UE = (const float*)(a.ws + WS_UE);
    const float* cw = a.in[22]; const float* cb = a.in[23];
#pragma unroll 2
    for (int e = F.tid; e < 8 * (DFF / 4); e += 512) { const int k = e / (DFF / 4), ch = (e % (DFF / 4)) * 4, g = pm * 4 + (k >> 1), last = k & 1;
        const int row = g * 64 + (last ? 63 : 0);
        const bool hp = last ? true : (row % SEQ) != 0, hn = last ? (row % SEQ) != SEQ - 1 : true;
        const float* pu = UE + ((size_t)(last ? g : (g > 0 ? g - 1 : 0)) * 4 + (last ? 2 : 3)) * NUP;
        const float* cu = UE + ((size_t)g * 4 + (last ? 3 : 0)) * NUP;
        const float* nu = UE + ((size_t)(last ? (g < 511 ? g + 1 : 511) : g) * 4 + (last ? 0 : 1)) * NUP;
        const f32x4 z = (f32x4){0.f, 0.f, 0.f, 0.f};
        const f32x4 pg = hp ? *(const f32x4*)(pu + ch) : z, pv = hp ? *(const f32x4*)(pu + DFF + ch) : z, ng = hn ? *(const f32x4*)(nu + ch) : z, nv = hn ? *(const f32x4*)(nu + DFF + ch) : z;
        const f32x4 cg = *(const f32x4*)(cu + ch), cv = *(const f32x4*)(cu + DFF + ch);
        const f32x4 gate = *(const f32x4*)(cw + ch) * pg + *(const f32x4*)(cw + NUP + ch) * cg + *(const f32x4*)(cw + 2 * NUP + ch) * ng + *(const f32x4*)(cb + ch);
        const f32x4 val = *(const f32x4*)(cw + DFF + ch) * pv + *(const f32x4*)(cw + NUP + DFF + ch) * cv + *(const f32x4*)(cw + 2 * NUP + DFF + ch) * nv + *(const f32x4*)(cb + DFF + ch);
        u32x2 w; w.x = pk2(siluf_(gate[0]) * val[0], siluf_(gate[1]) * val[1]); w.y = pk2(siluf_(gate[2]) * val[2], siluf_(gate[3]) * val[3]);
        *(u32x2*)(P + (size_t)row * PLD + C_ACT + ch) = w; }
}

__global__ void __launch_bounds__(NWAVES * 64, 2) fwd_kernel(Args args) {
    extern __shared__ __attribute__((aligned(16))) unsigned char lds[];
    Frame F;
    F.lds = (LAS unsigned char*)lds;
    F.MISC = (volatile LAS unsigned*)(F.lds + MISC_OFF);
    F.tid = threadIdx.x; F.lane = F.tid & 63; F.wave = __builtin_amdgcn_readfirstlane(F.tid >> 6);
    F.G = gridDim.x; { const int bx = blockIdx.x; F.vcu = (F.G % 8 == 0) ? (bx % 8) * (F.G / 8) + bx / 8 : bx; }
    unsigned char* ws = args.ws;
    F.ctl = (gu32*)(ws + WS_CTL);
    for (int u = F.tid; u < (LDS_BYTES - LDSCTL_OFF) / 4; u += NWAVES * 64) ((LAS unsigned*)(F.lds + LDSCTL_OFF))[u] = 0u;
    __syncthreads();
    const int lo = args.ph_lo, hi = args.ph_hi;
    const bool single = (hi - lo) > 1;
    XcdBarrier bar; bar.bar = (unsigned*)(F.ctl + CW_BAR); bar.x = 0; bar.st = nullptr;
    if (single) bar = xcd_barrier_post((unsigned*)(F.ctl + CW_BAR), F.MISC + 8);
#ifndef PH_MASK
#define PH_MASK 0x1FF
#endif
#define IN(k) (((PH_MASK >> (k)) & 1) && lo <= (k) && (k) < hi)
#define SEAM(k) do { if (IN(k) && IN((k) + 1)) xcd_barrier(bar); } while (0)
    bf16* P = (bf16*)(ws + WS_P);
    const int bid = (int)blockIdx.x;
#define TS(k) do {} while (0)
#define TSB(k, blk) do {} while (0)
    TS(0);

    if (IN(0)) { p0_prologue(F, args); }
    SEAM(0); TS(1);
    if (IN(1)) {
        { pg8::Gemm g{(const bf16*)args.out, (const bf16*)(ws + WS_WIN), M, 3584, 1024, 1024, 1024}; pg8::StaticOrder S; S.init(M, 3584, F.G, bid);
          EpiInProj E{P, (float*)(ws + WS_BA)};
          pg8::gemm_phase<EpiInProj, pg8::StaticOrder, true, true>(F.lds + RING_OFF, g, S, E); }
        { pg8::Gemm g{(const bf16*)(ws + WS_MEMN), (const bf16*)(ws + WS_WKV), BATCH * NMEM, 1024, 1024, 1024, 1024}; pg8::StaticOrder S; S.init(BATCH * NMEM, 1024, F.G, bid);
          EpiBf16 E{(bf16*)(ws + WS_KV), 1024};
          pg8::gemm_phase<EpiBf16, pg8::StaticOrder, true, true>(F.lds + RING_OFF, g, S, E); }
    }
    SEAM(1); TS(2);
    if (IN(2)) {
        const bool full = F.G == 256; const int nU = full ? 256 : 4096;
        for (int u = bid; u < nU; u += F.G) { const int uu = full ? u * 16 : u; dn_prep_block(F, args, uu >> 10, (uu >> 7) & 7, uu & 127, full ? 16 : 1); }
    }
    TS(12); SEAM(2); TS(3);
    if (IN(3)) {
        const int ndn = F.G >= 128 ? 64 : 0;
        for (int u = (ndn ? (bid < ndn ? bid : 64) : bid); u < 64; u += (ndn ? 64 : F.G)) dn_scan_unit(F, args, u >> 4, (u >> 1) & 7, u & 1);
        if (bid >= ndn) { const int nb = F.G - ndn, me = bid - ndn;
            for (int u = me; u < 1024; u += nb) {
                if (u < 512) attnA_unit(F, args, u >> 7, (u >> 1) & 63, u & 1);
                else { const int v = u - 512; xattn_unit(F, args, v >> 7, (v >> 2) & 31, v & 3); }
            }
        }
    }
    TS(10); TSB(11, 64); SEAM(3); TS(4);
    if (IN(4)) {
        dn_combine(F, args);
        pg8::Gemm g{(const bf16*)args.out, (const bf16*)(ws + WS_WIN) + (size_t)3584 * 1024, M, 3072, 1024, 1024, 1024}; pg8::StaticOrder S; S.init(M, 3072, F.G, bid);
        EpiGatesU8 E{P};
        pg8::gemm_phase<EpiGatesU8, pg8::StaticOrder, true, true>(F.lds + RING_OFF, g, S, E);
    }
    SEAM(4); TS(5);
    if (IN(5)) {
        pg8::Gemm g{P + C_AQ, (const bf16*)(ws + WS_WBR), M, 1024, 1536, PLD, 512};
        g.segt = 8; g.aoff1 = (long)(C_DZ - C_AQ) * 2 - 8 * 128; g.aoff2 = (long)(C_MQ - C_AQ) * 2 - 16 * 128;
        g.boff1 = (long)1024 * 512 * 2 - 8 * 128; g.boff2 = (long)2 * 1024 * 512 * 2 - 16 * 128;
        pg8::StaticOrder S; S.init(M, 1024, F.G, bid);
        EpiMerge E{P}; pg8::gemm_phase<EpiMerge, pg8::StaticOrder, true, true>(F.lds + RING_OFF, g, S, E);
    }
    SEAM(5); TS(6);
    if (IN(6)) {
        pg8::Gemm g{P + C_MG, (const bf16*)(ws + WS_WOUT), M, 1024, 1024, PLD, 1024}; pg8::StaticOrder S; S.init(M, 1024, F.G, bid);
        EpiWout E{args.in[0], args.out, P, (float*)(ws + WS_SSQ), (LAS float*)(F.lds + XCH_OFF)};
        pg8::gemm_phase<EpiWout, pg8::StaticOrder, true, true>(F.lds + RING_OFF, g, S, E);
    }
    SEAM(6); TS(7);
    if (IN(7)) {
        pg8::Gemm g{P + C_X1B, (const bf16*)(ws + WS_WUP), M, NUP, 1024, PLD, 1024}; pg8::StaticOrder S; S.init(M, NUP, F.G, bid);
        EpiUp E{(const float*)(ws + WS_SSQ), args.in[22], args.in[23], P, (float*)(ws + WS_UE), (LAS float*)(F.lds + XCH_OFF)};
        pg8::gemm_phase<EpiUp, pg8::StaticOrder, true, true>(F.lds + RING_OFF, g, S, E);
    }
    SEAM(7); TS(8);
    if (IN(8)) {
        pg8::Gemm g{P + C_ACT, (const bf16*)(ws + WS_WDN), M, 1024, DFF, PLD, DFF}; pg8::StaticOrder S; S.init(M, 1024, F.G, bid);
        { Unit u; int prev = -1; for (int i = 0; S.next(i, u); ++i) { if (u.pm != prev) ffn_fixup_panel(F, args, u.pm); prev = u.pm; } }
        VM_WAIT(); __syncthreads();
        EpiDown E{args.out, P};
        pg8::gemm_phase<EpiDown, pg8::StaticOrder, true, true>(F.lds + RING_OFF, g, S, E);
    }
    TS(9);
#undef IN
#undef SEAM
}

#ifdef DBG_TIME
__global__ void dbg_ts_kernel(unsigned char* ws, int k) { if (threadIdx.x == 0) ((unsigned long long*)(ws + WS_CTL + 65536))[k] = __builtin_amdgcn_s_memrealtime(); }
__global__ void dbg_wait_kernel(unsigned char* ws) {
    if (threadIdx.x == 0) { const unsigned long long* tsb = (const unsigned long long*)(ws + WS_CTL + 65536);
        const unsigned long long te = __builtin_amdgcn_s_memrealtime();
        const unsigned long long d1 = tsb[DBG_A1] - tsb[DBG_A0], d2 = tsb[DBG_B1] - tsb[DBG_B0];
        const unsigned long long W = d1 + 100000ull * (d2 / 1000ull);
        while (__builtin_amdgcn_s_memrealtime() - te < W) __builtin_amdgcn_s_sleep(32); }
}
#endif
constexpr int N_PHASES = 9;
#ifndef MK_PER_PHASE
#define MK_PER_PHASE 0
#endif
extern "C" void kernel_launch(void* const* d_in, const int* in_sizes, int n_in, void* d_out, int out_size, void* d_ws, size_t ws_size, hipStream_t stream) {
    static int grid = 0;
    if (grid == 0) {
        if (n_in != 25 || in_sizes[0] != M * DM || out_size != M * DM || ws_size < WS_END) {
            fprintf(stderr, "kernel_launch: unexpected shapes (n_in %d, in0 %d, out %d, ws %zu); nothing launched\n", n_in, n_in > 0 ? in_sizes[0] : -1, out_size, ws_size); grid = -1; return; }
        int dev = 0, cus = 0, per_cu = 0;
        if (hipGetDevice(&dev) != hipSuccess || hipDeviceGetAttribute(&cus, hipDeviceAttributeMultiprocessorCount, dev) != hipSuccess) { grid = -1; return; }
        if (hipFuncSetAttribute((const void*)fwd_kernel, hipFuncAttributeMaxDynamicSharedMemorySize, LDS_BYTES) != hipSuccess) { fprintf(stderr, "kernel_launch: hipFuncSetAttribute failed\n"); grid = -1; return; }
        if (hipOccupancyMaxActiveBlocksPerMultiprocessor(&per_cu, (const void*)fwd_kernel, NWAVES * 64, LDS_BYTES) != hipSuccess || per_cu < 1) { fprintf(stderr, "kernel_launch: occupancy query reports %d\n", per_cu); }
        (void)hipGetLastError();
        grid = cus;
    }
    if (grid < 0) return;
    if (hipMemsetAsync((char*)d_ws + WS_CTL, 0, CTL_ZERO_BYTES, stream) != hipSuccess) return;
    Args a{};
    for (int i = 0; i < 25; ++i) a.in[i] = (const float*)d_in[i];
    a.out = (float*)d_out; a.ws = (unsigned char*)d_ws;
#ifdef DBG_TIME
    for (int p = 0; p < N_PHASES; ++p) { hipLaunchKernelGGL(dbg_ts_kernel, dim3(1), dim3(64), 0, stream, (unsigned char*)d_ws, p);
        a.ph_lo = p; a.ph_hi = p + 1;
        if (p == 3) { a.mode = 1; hipLaunchKernelGGL(fwd_kernel, dim3(grid), dim3(NWAVES * 64), LDS_BYTES, stream, a); hipLaunchKernelGGL(dbg_ts_kernel, dim3(1), dim3(64), 0, stream, (unsigned char*)d_ws, 12); a.mode = 2; }
        hipLaunchKernelGGL(fwd_kernel, dim3(grid), dim3(NWAVES * 64), LDS_BYTES, stream, a); a.mode = 0; }
    hipLaunchKernelGGL(dbg_ts_kernel, dim3(1), dim3(64), 0, stream, (unsigned char*)d_ws, N_PHASES);
    hipLaunchKernelGGL(dbg_wait_kernel, dim3(1), dim3(64), 0, stream, (unsigned char*)d_ws);
    return;
#endif
    if (MK_PER_PHASE) {
        for (int p = 0; p < N_PHASES; ++p) { a.ph_lo = p; a.ph_hi = p + 1; hipLaunchKernelGGL(fwd_kernel, dim3(grid), dim3(NWAVES * 64), LDS_BYTES, stream, a); }
    } else {
        a.ph_lo = 0; a.ph_hi = N_PHASES; hipLaunchKernelGGL(fwd_kernel, dim3(grid), dim3(NWAVES * 64), LDS_BYTES, stream, a);
    }
}
```

```cpp
#include <hip/hip_runtime.h>
#include <cstdio>
#include <cstdint>
#include <cmath>
namespace pg8 {
#define PG8_LAS __attribute__((address_space(3)))
typedef unsigned short bf16_t;
typedef short bf16x8 __attribute__((ext_vector_type(8)));
typedef float f32x4 __attribute__((ext_vector_type(4)));
typedef unsigned u32x4 __attribute__((ext_vector_type(4)));
constexpr int BM = 256, BK = 64, HALF = 128, HTB = HALF * BK * 2  , STAGE_BYTES = 8 * HTB, NXCD = 8, WGM = 8;

__host__ __device__ __forceinline__ int lds_byte(int r, int c) { const int st = (r >> 4) * 2 + (c >> 5), rr = r & 15, cc = c & 31, ob = rr * 64 + cc * 2; return st * 1024 + (ob ^ (((ob >> 9) & 1) << 5)); }
__host__ __device__ __forceinline__ void stage_rc(int b, int& R, int& C) { const int st = b / 1024, sb = b % 1024, swz = sb ^ (((sb >> 9) & 1) << 5); R = (st >> 1) * 16 + swz / 64; C = (st & 1) * 32 + (swz % 64) / 2; }
__host__ __device__ __forceinline__ int perm32(int rho) { const int n = rho >> 4, i = rho & 15; return 8 * (i >> 2) + 4 * n + (i & 3); }

struct Unit { int pm, pn, aux; };
struct Gemm { const bf16_t* A; const bf16_t* Bt; int M, N, K, lda, ldb; int segt = 1 << 30; long aoff1 = 0, aoff2 = 0, boff1 = 0, boff2 = 0; };

struct StaticOrder {
    int nM, nN, nwg, G, c;
    __host__ __device__ __forceinline__ void init(int M, int N, int G_, int c_) { nM = M / BM; nN = N / BM; nwg = nM * nN; G = G_; c = c_; }
    __host__ __device__ __forceinline__ bool next(int i, Unit& u) const {
        const long L = (long)i * G + c; if (L >= nwg) return false;
        int wgid = (int)L; { const int q = nwg / NXCD, r = nwg % NXCD, xcd = wgid % NXCD, off = wgid / NXCD; wgid = (xcd < r ? xcd * (q + 1) : r * (q + 1) + (xcd - r) * q) + off; }
        const int nig = WGM * nN, gid = wgid / nig, fm = gid * WGM, gsz = (nM - fm) < WGM ? (nM - fm) : WGM;
        u.pm = fm + ((wgid % nig) % gsz); u.pn = (wgid % nig) / gsz; return true;
    }
    __device__ __forceinline__ void a_ready(const Unit&) const {}
    __device__ __forceinline__ void done(const Unit&) const {}
};

template <class Epi, class Sched, bool ALIGN_EPI = false, bool SP2 = false>
__device__ __forceinline__ void gemm_phase(PG8_LAS unsigned char* lds, const Gemm g, const Sched& S, const Epi& E) {
    const int tid = threadIdx.x, wid = __builtin_amdgcn_readfirstlane(tid >> 6), lane = tid & 63, wr = wid >> 2, wc = wid & 3, fr = lane & 15, fq = lane >> 4;
    const int K = g.K, nt = K / BK;
    unsigned voffA[2], voffB[2];
#pragma unroll
    for (int i = 0; i < 2; ++i) { int R, C; stage_rc(tid * 16 + i * 8192, R, C); const int Rb = Epi::PERM ? ((R & ~31) + perm32(R & 31)) : R;
        voffA[i] = (unsigned)(R * g.lda + C) * 2u; voffB[i] = (unsigned)(Rb * g.ldb + C) * 2u; }
    const size_t kstep = (size_t)(BK * 2);
    const size_t hstepA = (size_t)HALF * g.lda * 2, hstepB = (size_t)HALF * g.ldb * 2;
    const size_t tstepA = 2 * hstepA, tstepB = 2 * hstepB;
    const unsigned ldsw = (unsigned)wid * 1024u;
    const int aoff = lds_byte(wr * 64 + fr, fq * 8), boff = lds_byte(wc * 32 + fr, fq * 8);
#define PG8_SA(b, h) (((b) * 2 + (h)) * HTB)
#define PG8_SB(b, h) ((4 + (b) * 2 + (h)) * HTB)
#define PG8_STAGE(bufoff, gbase, voff) do { _Pragma("unroll") for (int _i = 0; _i < 2; ++_i) \
        __builtin_amdgcn_global_load_lds((const unsigned*)((const char*)(gbase) + (voff)[_i]), (PG8_LAS unsigned*)(lds + (bufoff) + ldsw + _i * 8192), 16, 0, 0); } while (0)
#define PG8_LDA(dst, b, h) do { _Pragma("unroll") for (int m = 0; m < 4; ++m) _Pragma("unroll") for (int k = 0; k < 2; ++k) dst[m][k] = *(const PG8_LAS bf16x8*)(lds + PG8_SA(b, h) + aoff + m * 2048 + k * 1024); } while (0)
#define PG8_LDB(dst, b, h) do { _Pragma("unroll") for (int n = 0; n < 2; ++n) _Pragma("unroll") for (int k = 0; k < 2; ++k) dst[n][k] = *(const PG8_LAS bf16x8*)(lds + PG8_SB(b, h) + boff + n * 2048 + k * 1024); } while (0)
#define PG8_MMA(ai, bj, At, Bt) do { __builtin_amdgcn_s_setprio(1); _Pragma("unroll") for (int m = 0; m < 4; ++m) _Pragma("unroll") for (int n = 0; n < 2; ++n) _Pragma("unroll") for (int k = 0; k < 2; ++k) \
        acc[ai][bj][m][n] = __builtin_amdgcn_mfma_f32_16x16x32_bf16(Bt[n][k], At[m][k], acc[ai][bj][m][n], 0, 0, 0); __builtin_amdgcn_s_setprio(0); } while (0)
#define PG8_WAIT_V(n) asm volatile("s_waitcnt vmcnt(" #n ")" ::: "memory")
#define PG8_WAIT_L(n) asm volatile("s_waitcnt lgkmcnt(" #n ")" ::: "memory")
#define PG8_BAR __builtin_amdgcn_s_barrier()
#define PG8_SCHED __builtin_amdgcn_sched_barrier(0)
    Unit cur, nxt; int ui = 0;
    if (!S.next(0, cur)) return;
    if constexpr (Epi::PREFETCH) E.prefetch(cur, 0, tid);
    f32x4 acc[2][2][4][2];
#pragma unroll
    for (int a = 0; a < 2; ++a)
#pragma unroll
        for (int b = 0; b < 2; ++b)
#pragma unroll
            for (int m = 0; m < 4; ++m)
#pragma unroll
                for (int n = 0; n < 2; ++n) acc[a][b][m][n] = (f32x4){0.f, 0.f, 0.f, 0.f};
    bf16x8 At[4][2], B0[2][2], B1[2][2];
    const char* cA = (const char*)g.A + (size_t)cur.pm * tstepA; const char* cB = (const char*)g.Bt + (size_t)cur.pn * tstepB;
    S.a_ready(cur);
    if constexpr (SP2) {
        PG8_STAGE(PG8_SB(0, 0), cB, voffB); PG8_STAGE(PG8_SB(0, 1), cB + hstepB, voffB); PG8_STAGE(PG8_SA(0, 0), cA, voffA); PG8_STAGE(PG8_SA(0, 1), cA + hstepA, voffA);
        if (wr == 1) PG8_BAR;
        PG8_WAIT_V(2); PG8_BAR;
        PG8_STAGE(PG8_SB(1, 0), cB + kstep, voffB); PG8_STAGE(PG8_SA(1, 0), cA + kstep, voffA); PG8_STAGE(PG8_SB(1, 1), cB + hstepB + kstep, voffB);
        PG8_WAIT_V(6); PG8_BAR;
    } else {
        PG8_STAGE(PG8_SB(0, 0), cB, voffB); PG8_STAGE(PG8_SA(0, 0), cA, voffA); PG8_STAGE(PG8_SB(0, 1), cB + hstepB, voffB); PG8_STAGE(PG8_SA(0, 1), cA + hstepA, voffA);
        if (wr == 1) PG8_BAR;
        PG8_WAIT_V(4); PG8_BAR;
        PG8_STAGE(PG8_SB(1, 0), cB + kstep, voffB); PG8_STAGE(PG8_SA(1, 0), cA + kstep, voffA); PG8_STAGE(PG8_SB(1, 1), cB + hstepB + kstep, voffB);
        PG8_WAIT_V(6); PG8_BAR;
    }
    for (;;) {
        const bool has_next = S.next(ui + 1, nxt);
        const char* nA = has_next ? (const char*)g.A + (size_t)nxt.pm * tstepA : cA; const char* nB = has_next ? (const char*)g.Bt + (size_t)nxt.pn * tstepB : cB;
        for (int t = 0; t < nt; t += 2) {
            const bool last = (t == nt - 2);
            if constexpr (Epi::RESCALE) { if (t == g.segt || t == 2 * g.segt) E.rescale(acc, cur, wr, wc, fr, fq, t / g.segt); }
            const long so1 = (t + 1 >= 2 * g.segt) ? g.aoff2 : ((t + 1 >= g.segt) ? g.aoff1 : 0), so2 = (t + 2 >= 2 * g.segt) ? g.aoff2 : ((t + 2 >= g.segt) ? g.aoff1 : 0), sb2 = (t + 2 >= 2 * g.segt) ? g.boff2 : ((t + 2 >= g.segt) ? g.boff1 : 0);
            const char* a1 = cA + so1 + (size_t)(t + 1) * kstep;
            const char* a2 = last ? nA : cA + so2 + (size_t)(t + 2) * kstep; const char* b2 = last ? nB : cB + sb2 + (size_t)(t + 2) * kstep;
            const char* a3 = a2 + kstep; const char* b3 = b2 + kstep;
            if (last && has_next) S.a_ready(nxt);
            if constexpr (SP2) {
            PG8_LDB(B0, 0, 0); PG8_LDB(B1, 0, 1); PG8_SCHED; PG8_LDA(At, 0, 0); PG8_STAGE(PG8_SA(1, 1), a1 + hstepA, voffA);
            PG8_WAIT_V(8); PG8_WAIT_L(0); PG8_BAR; PG8_MMA(0, 0, At, B0); PG8_MMA(0, 1, At, B1); PG8_BAR; PG8_SCHED;
            PG8_LDA(At, 0, 1); PG8_STAGE(PG8_SB(0, 0), b2, voffB); PG8_STAGE(PG8_SB(0, 1), b2 + hstepB, voffB); PG8_STAGE(PG8_SA(0, 0), a2, voffA);
            PG8_WAIT_V(8); PG8_WAIT_L(0); PG8_BAR; PG8_MMA(1, 0, At, B0); PG8_MMA(1, 1, At, B1); PG8_BAR; PG8_SCHED;
            PG8_LDB(B0, 1, 0); PG8_LDB(B1, 1, 1); PG8_SCHED; PG8_LDA(At, 1, 0); PG8_STAGE(PG8_SA(0, 1), a2 + hstepA, voffA);
            PG8_WAIT_V(8); PG8_WAIT_L(0); PG8_BAR; PG8_MMA(0, 0, At, B0); PG8_MMA(0, 1, At, B1); PG8_BAR; PG8_SCHED;
            PG8_LDA(At, 1, 1); PG8_STAGE(PG8_SB(1, 0), b3, voffB); PG8_STAGE(PG8_SB(1, 1), b3 + hstepB, voffB); PG8_STAGE(PG8_SA(1, 0), a3, voffA);
            PG8_WAIT_V(8); PG8_WAIT_L(0); PG8_BAR; PG8_MMA(1, 0, At, B0); PG8_MMA(1, 1, At, B1); PG8_BAR; PG8_SCHED;
            } else {
            PG8_LDB(B0, 0, 0); PG8_SCHED; PG8_LDA(At, 0, 0); PG8_STAGE(PG8_SA(1, 1), a1 + hstepA, voffA);
            PG8_WAIT_L(8); PG8_BAR; PG8_WAIT_L(0); PG8_MMA(0, 0, At, B0); PG8_BAR; PG8_SCHED;
            PG8_LDB(B1, 0, 1); PG8_STAGE(PG8_SB(0, 0), b2, voffB);
            PG8_BAR; PG8_WAIT_L(0); PG8_MMA(0, 1, At, B1); PG8_BAR;
            PG8_LDA(At, 0, 1); PG8_STAGE(PG8_SA(0, 0), a2, voffA);
            PG8_BAR; PG8_WAIT_L(0); PG8_MMA(1, 0, At, B0); PG8_BAR; PG8_SCHED;
            PG8_STAGE(PG8_SB(0, 1), b2 + hstepB, voffB);
            PG8_WAIT_V(6); PG8_BAR; PG8_MMA(1, 1, At, B1); PG8_BAR;
            PG8_LDB(B0, 1, 0); PG8_SCHED; PG8_LDA(At, 1, 0); PG8_STAGE(PG8_SA(0, 1), a2 + hstepA, voffA);
            PG8_WAIT_L(8); PG8_BAR; PG8_WAIT_L(0); PG8_MMA(0, 0, At, B0); PG8_BAR; PG8_SCHED;
            PG8_LDB(B1, 1, 1); PG8_STAGE(PG8_SB(1, 0), b3, voffB);
            PG8_BAR; PG8_WAIT_L(0); PG8_MMA(0, 1, At, B1); PG8_BAR;
            PG8_LDA(At, 1, 1); PG8_STAGE(PG8_SA(1, 0), a3, voffA);
            PG8_BAR; PG8_WAIT_L(0); PG8_MMA(1, 0, At, B0); PG8_BAR; PG8_SCHED;
            PG8_STAGE(PG8_SB(1, 1), b3 + hstepB, voffB);
            PG8_WAIT_V(6); PG8_BAR; PG8_MMA(1, 1, At, B1); PG8_BAR;
            }
        }
        if constexpr (ALIGN_EPI) { if (wr == 0) PG8_BAR; }
        if constexpr (Epi::PREFETCH) cur.aux = ui & 1;
        if constexpr (!Epi::AFTER_DRAIN) { E(acc, cur, wr, wc, fr, fq); S.done(cur); }
        if constexpr (Epi::PREFETCH) { if (has_next) E.prefetch(nxt, (ui + 1) & 1, tid); }
        if (!has_next) break;
#pragma unroll
        for (int a = 0; a < 2; ++a)
#pragma unroll
            for (int b = 0; b < 2; ++b)
#pragma unroll
                for (int m = 0; m < 4; ++m)
#pragma unroll
                    for (int n = 0; n < 2; ++n) acc[a][b][m][n] = (f32x4){0.f, 0.f, 0.f, 0.f};
        cur = nxt; cA = nA; cB = nB; ++ui;
        if constexpr (ALIGN_EPI) { if (wr == 1) PG8_BAR; }
    }
    PG8_WAIT_V(0);
    if constexpr (!ALIGN_EPI) { if (wr == 0) PG8_BAR; }
    PG8_BAR;
    if constexpr (Epi::AFTER_DRAIN) { E.fused(acc, cur, wr, wc, fr, fq, lds, wid, lane); S.done(cur); }
#undef PG8_SA
#undef PG8_SB
#undef PG8_STAGE
#undef PG8_LDA
#undef PG8_LDB
#undef PG8_MMA
#undef PG8_WAIT_V
#undef PG8_WAIT_L
#undef PG8_BAR
#undef PG8_SCHED
}
}

#define LAS __attribute__((address_space(3)))
#define GAS __attribute__((address_space(1)))
typedef unsigned short bf16;
typedef short bf16x8 __attribute__((ext_vector_type(8)));
typedef short s16x4 __attribute__((ext_vector_type(4)));
typedef float f32x4 __attribute__((ext_vector_type(4)));
typedef float f32x16 __attribute__((ext_vector_type(16)));
typedef unsigned u32x4 __attribute__((ext_vector_type(4)));
typedef unsigned u32x2 __attribute__((ext_vector_type(2)));
typedef float f32x2_t __attribute__((ext_vector_type(2)));
typedef __bf16 bf16x2_t __attribute__((ext_vector_type(2)));

constexpr int BATCH = 4, SEQ = 8192, DM = 1024, M = BATCH * SEQ;
constexpr int NMEM = 256;
constexpr int PLD = 6400;
constexpr int C_AQ = 0, C_AK = 512, C_AV = 640, C_DQ = 768, C_DK = 1280, C_DV = 1792, C_DZ = 2304, C_MQ = 2816, C_GATE = 3328;
constexpr int C_MG = 768, C_X1B = 1792, C_ACT = 2816;
constexpr int NIN = 6656;
constexpr int DFF = 2816, NUP = 5632;
constexpr float EPS = 1e-6f;
constexpr float LOG2E = 1.4426950408889634f;

__device__ __forceinline__ float bf_lo(unsigned w) { return __uint_as_float(w << 16); }
__device__ __forceinline__ float bf_hi(unsigned w) { return __uint_as_float(w & 0xffff0000u); }
__device__ __forceinline__ unsigned pk2(float lo, float hi) { f32x2_t v = {lo, hi}; bf16x2_t b = __builtin_convertvector(v, bf16x2_t); return __builtin_bit_cast(unsigned, b); }
__device__ __forceinline__ float fexp2(float x) { return __builtin_amdgcn_exp2f(x); }
__device__ __forceinline__ float frcp(float x) { return __builtin_amdgcn_rcpf(x); }
__device__ __forceinline__ float sigmoidf_(float x) { return frcp(1.0f + fexp2(-x * LOG2E)); }
__device__ __forceinline__ float siluf_(float x) { return x * sigmoidf_(x); }
__device__ __forceinline__ void unpack8(const u32x4 w, float (&v)[8]) {
    v[0] = bf_lo(w.x); v[1] = bf_hi(w.x); v[2] = bf_lo(w.y); v[3] = bf_hi(w.y); v[4] = bf_lo(w.z); v[5] = bf_hi(w.z); v[6] = bf_lo(w.w); v[7] = bf_hi(w.w); }
__device__ __forceinline__ u32x4 pack8(const float (&v)[8]) { u32x4 w; w.x = pk2(v[0], v[1]); w.y = pk2(v[2], v[3]); w.z = pk2(v[4], v[5]); w.w = pk2(v[6], v[7]); return w; }

using pg8::Unit;
constexpr int HALF = pg8::HALF, BM = pg8::BM;

struct EpiInProj {
    static constexpr bool PERM = true, AFTER_DRAIN = false, PREFETCH = false, RESCALE = false;
    bf16* P; float* BA;
    __device__ __forceinline__ void operator()(const f32x4 (&acc)[2][2][4][2], const Unit& u, int wr, int wc, int fr, int fq) const {
        const int row0 = u.pm * BM + wr * 64 + fr;
        if (u.pn < 13) {
            const int col0 = u.pn * BM + wc * 32 + 8 * fq;
#pragma unroll
            for (int ai = 0; ai < 2; ++ai)
#pragma unroll
                for (int m = 0; m < 4; ++m) { bf16* rowp = P + (size_t)(row0 + ai * HALF + m * 16) * PLD + col0;
#pragma unroll
                    for (int bj = 0; bj < 2; ++bj) { const f32x4 v0 = acc[ai][bj][m][0], v1 = acc[ai][bj][m][1];
                        u32x4 w; w.x = pk2(v0[0], v0[1]); w.y = pk2(v0[2], v0[3]); w.z = pk2(v1[0], v1[1]); w.w = pk2(v1[2], v1[3]);
                        *(u32x4*)(rowp + bj * HALF) = w; } }
        } else if (wc == 0) {
#pragma unroll
            for (int ai = 0; ai < 2; ++ai)
#pragma unroll
                for (int m = 0; m < 4; ++m) { float* rp = BA + (size_t)(row0 + ai * HALF + m * 16) * 32 + 8 * fq;
                    *(f32x4*)rp = acc[ai][0][m][0]; *(f32x4*)(rp + 4) = acc[ai][0][m][1]; }
        }
    }
};
struct EpiBf16 {
    static constexpr bool PERM = true, AFTER_DRAIN = false, PREFETCH = false, RESCALE = false;
    bf16* O; int ldc;
    __device__ __forceinline__ void operator()(const f32x4 (&acc)[2][2][4][2], const Unit& u, int wr, int wc, int fr, int fq) const {
        const int row0 = u.pm * BM + wr * 64 + fr, col0 = u.pn * BM + wc * 32 + 8 * fq;
#pragma unroll
        for (int ai = 0; ai < 2; ++ai)
#pragma unroll
            for (int m = 0; m < 4; ++m) { bf16* rowp = O + (size_t)(row0 + ai * HALF + m * 16) * ldc + col0;
#pragma unroll
                for (int bj = 0; bj < 2; ++bj) { const f32x4 v0 = acc[ai][bj][m][0], v1 = acc[ai][bj][m][1];
                    u32x4 w; w.x = pk2(v0[0], v0[1]); w.y = pk2(v0[2], v0[3]); w.z = pk2(v1[0], v1[1]); w.w = pk2(v1[2], v1[3]);
                    *(u32x4*)(rowp + bj * HALF) = w; } }
    }
};
template <int PASS> struct EpiBranch {
    static constexpr bool PERM = true, AFTER_DRAIN = false, PREFETCH = false, RESCALE = false;
    bf16* P;
    __device__ __forceinline__ void operator()(const f32x4 (&acc)[2][2][4][2], const Unit& u, int wr, int wc, int fr, int fq) const {
        const int row0 = u.pm * BM + wr * 64 + fr, col0 = u.pn * BM + wc * 32 + 8 * fq;
#pragma unroll
        for (int ai = 0; ai < 2; ++ai)
#pragma unroll
            for (int m = 0; m < 4; ++m) { bf16* rowp = P + (size_t)(row0 + ai * HALF + m * 16) * PLD;
#pragma unroll
                for (int bj = 0; bj < 2; ++bj) {
                    const int c = col0 + bj * HALF;
                    const u32x4 gw = *(const u32x4*)(rowp + C_GATE + 1024 * PASS + c);
                    float g[8]; unpack8(gw, g);
                    float pv[8];
                    if (PASS > 0) { const u32x4 mw = *(const u32x4*)(rowp + C_MG + c); unpack8(mw, pv); }
                    else {
#pragma unroll
                        for (int i = 0; i < 8; ++i) pv[i] = 0.f; }
                    const f32x4 v0 = acc[ai][bj][m][0], v1 = acc[ai][bj][m][1];
                    float o[8];
#pragma unroll
                    for (int i = 0; i < 4; ++i) { o[i] = pv[i] + sigmoidf_(g[i]) * v0[i]; o[4 + i] = pv[4 + i] + sigmoidf_(g[4 + i]) * v1[i]; }
                    *(u32x4*)(rowp + C_MG + c) = pack8(o); } }
    }
};
struct EpiGatesU8 {
    static constexpr bool PERM = true, AFTER_DRAIN = false, PREFETCH = false, RESCALE = false;
    bf16* P;
    __device__ __forceinline__ void operator()(const f32x4 (&acc)[2][2][4][2], const Unit& u, int wr, int wc, int fr, int fq) const {
        const int row0 = u.pm * BM + wr * 64 + fr, col0 = u.pn * BM + wc * 32 + 8 * fq;
#pragma unroll
        for (int ai = 0; ai < 2; ++ai)
#pragma unroll
            for (int m = 0; m < 4; ++m) { unsigned char* rowp = (unsigned char*)(P + (size_t)(row0 + ai * HALF + m * 16) * PLD + C_GATE) + col0;
#pragma unroll
                for (int bj = 0; bj < 2; ++bj) { const f32x4 v0 = acc[ai][bj][m][0], v1 = acc[ai][bj][m][1]; unsigned q[8];
#pragma unroll
                    for (int i = 0; i < 4; ++i) { q[i] = (unsigned)fminf(fmaxf(sigmoidf_(v0[i]) * 255.0f + 0.5f, 1.0f), 255.0f); q[4 + i] = (unsigned)fminf(fmaxf(sigmoidf_(v1[i]) * 255.0f + 0.5f, 1.0f), 255.0f); }
                    u32x2 w; w.x = q[0] | (q[1] << 8) | (q[2] << 16) | (q[3] << 24); w.y = q[4] | (q[5] << 8) | (q[6] << 16) | (q[7] << 24);
                    *(u32x2*)(rowp + bj * HALF) = w; } }
    }
};
struct EpiMerge {
    static constexpr bool PERM = true, AFTER_DRAIN = false, PREFETCH = false, RESCALE = true;
    bf16* P;
    __device__ __forceinline__ void rescale(f32x4 (&acc)[2][2][4][2], const Unit& u, int wr, int wc, int fr, int fq, int stage) const {
        asm volatile("" : "+v"(fr), "+v"(fq));
        const int row0 = u.pm * BM + wr * 64 + fr, col0 = u.pn * BM + wc * 32 + 8 * fq;
#pragma unroll
        for (int ai = 0; ai < 2; ++ai) {
#pragma unroll
            for (int m = 0; m < 4; ++m) { const unsigned char* rowp = (const unsigned char*)(P + (size_t)(row0 + ai * HALF + m * 16) * PLD + C_GATE) + 1024 * (stage - 1) + col0;
#pragma unroll
                for (int bj = 0; bj < 2; ++bj) { const u32x2 gx = *(const u32x2*)(rowp + bj * HALF), gy = *(const u32x2*)(rowp + 1024 + bj * HALF);
#pragma unroll
                    for (int i = 0; i < 4; ++i) { acc[ai][bj][m][0][i] *= (float)((gx.x >> (8 * i)) & 255u) * frcp((float)((gy.x >> (8 * i)) & 255u));
                        acc[ai][bj][m][1][i] *= (float)((gx.y >> (8 * i)) & 255u) * frcp((float)((gy.y >> (8 * i)) & 255u)); } } }
            asm volatile("" ::: "memory"); }
    }
    __device__ __forceinline__ void operator()(const f32x4 (&acc)[2][2][4][2], const Unit& u, int wr, int wc, int fr, int fq) const {
        const int row0 = u.pm * BM + wr * 64 + fr, col0 = u.pn * BM + wc * 32 + 8 * fq;
#pragma unroll
        for (int ai = 0; ai < 2; ++ai)
#pragma unroll
            for (int m = 0; m < 4; ++m) { bf16* rowp = P + (size_t)(row0 + ai * HALF + m * 16) * PLD;
#pragma unroll
                for (int bj = 0; bj < 2; ++bj) { const int c = col0 + bj * HALF; float o[8];
                    const u32x2 gq = *(const u32x2*)((const unsigned char*)(rowp + C_GATE) + 2048 + c);
                    const f32x4 v0 = acc[ai][bj][m][0], v1 = acc[ai][bj][m][1];
#pragma unroll
                    for (int i = 0; i < 4; ++i) { o[i] = (float)((gq.x >> (8 * i)) & 255u) * (1.0f / 255.0f) * v0[i]; o[4 + i] = (float)((gq.y >> (8 * i)) & 255u) * (1.0f / 255.0f) * v1[i]; }
                    *(u32x4*)(rowp + C_MG + c) = pack8(o); } }
    }
};
struct EpiWout {
    static constexpr bool PERM = true, AFTER_DRAIN = false, PREFETCH = false, RESCALE = false;
    const float* x; float* out; bf16* P; float* SSQ; LAS float* xl;
    __device__ __forceinline__ void operator()(const f32x4 (&acc)[2][2][4][2], const Unit& u, int wr, int wc, int fr, int fq) const {
        const int row0 = u.pm * BM + wr * 64 + fr, col0 = u.pn * BM + wc * 32 + 8 * fq;
#pragma unroll
        for (int ai = 0; ai < 2; ++ai)
#pragma unroll
            for (int m = 0; m < 4; ++m) { const int row = row0 + ai * HALF + m * 16; float ss = 0.f;
#pragma unroll
                for (int bj = 0; bj < 2; ++bj) { const int c = col0 + bj * HALF; const size_t off = (size_t)row * DM + c;
                    const f32x4 a0 = *(const f32x4*)(x + off), a1 = *(const f32x4*)(x + off + 4);
                    const f32x4 r0 = a0 + acc[ai][bj][m][0], r1 = a1 + acc[ai][bj][m][1];
                    ss += (r0[0] * r0[0] + r0[1] * r0[1]) + (r0[2] * r0[2] + r0[3] * r0[3]) + (r1[0] * r1[0] + r1[1] * r1[1]) + (r1[2] * r1[2] + r1[3] * r1[3]);
                    u32x4 w; w.x = pk2(r0[0], r0[1]); w.y = pk2(r0[2], r0[3]); w.z = pk2(r1[0], r1[1]); w.w = pk2(r1[2], r1[3]);
                    *(u32x4*)(P + (size_t)row * PLD + C_X1B + c) = w; }
                ss += __shfl_xor(ss, 16); ss += __shfl_xor(ss, 32);
                if (fq == 0) xl[(ai * HALF + wr * 64 + m * 16 + fr) * 4 + wc] = ss; }
        asm volatile("s_waitcnt lgkmcnt(0)" ::: "memory"); __builtin_amdgcn_s_barrier(); asm volatile("" ::: "memory");
        { const int t = (wr * 4 + wc) * 64 + fq * 16 + fr;
          if (t < 256) { const f32x4 p = *(const LAS f32x4*)(xl + t * 4); SSQ[(size_t)(u.pm * BM + t) * 4 + u.pn] = (p[0] + p[1]) + (p[2] + p[3]); } }
        asm volatile("s_waitcnt lgkmcnt(0)" ::: "memory"); __builtin_amdgcn_s_barrier(); asm volatile("" ::: "memory");
    }
};
template <int CTRL> __device__ __forceinline__ float dpp_mov(float old, float src) {
    return __builtin_bit_cast(float, __builtin_amdgcn_update_dpp(__builtin_bit_cast(int, old), __builtin_bit_cast(int, src), CTRL, 0xF, 0xF, false)); }
struct EpiUp {
    static constexpr bool PERM = true, AFTER_DRAIN = false, PREFETCH = true, RESCALE = false;
    const float* SSQ; const float* cw; const float* cb; bf16* P; float* UE; LAS float* xl;
    __device__ __forceinline__ void prefetch(const Unit& u, int buf, int tid) const {
        LAS float* d = xl + buf * 1280;
        if (tid < 256) { const int a = tid >> 5, c4 = (tid & 31) * 4, ch = u.pn * 128 + c4 + (a >= 4 ? DFF : 0), aa = a & 3;
            *(LAS f32x4*)(d + a * 128 + c4) = *(const f32x4*)((aa < 3 ? cw + aa * NUP : cb) + ch); }
        else { const int r = tid - 256; const f32x4 q = *(const f32x4*)(SSQ + (size_t)(u.pm * BM + r) * 4);
            d[1024 + r] = __builtin_amdgcn_rsqf(((q[0] + q[1]) + (q[2] + q[3])) * (1.0f / DM) + EPS); }
    }
    __device__ __forceinline__ void operator()(f32x4 (&acc)[2][2][4][2], const Unit& u, int wr, int wc, int fr, int fq) const {
        const int row0 = u.pm * BM + wr * 64 + fr;
        const LAS float* lw = xl + u.aux * 1280;
#pragma unroll
        for (int ai = 0; ai < 2; ++ai)
#pragma unroll
            for (int m = 0; m < 4; ++m) { const float rs = lw[1024 + ai * HALF + wr * 64 + m * 16 + fr];
#pragma unroll
                for (int bj = 0; bj < 2; ++bj)
#pragma unroll
                    for (int n = 0; n < 2; ++n) acc[ai][bj][m][n] *= rs; }
#pragma unroll
        for (int n = 0; n < 2; ++n) {
            const int c4 = wc * 32 + 8 * fq + 4 * n, a0 = u.pn * 128 + c4;
            const f32x4 wg0 = *(const LAS f32x4*)(lw + c4), wg1 = *(const LAS f32x4*)(lw + 128 + c4), wg2 = *(const LAS f32x4*)(lw + 256 + c4), bg = *(const LAS f32x4*)(lw + 384 + c4);
            const f32x4 wv0 = *(const LAS f32x4*)(lw + 512 + c4), wv1 = *(const LAS f32x4*)(lw + 640 + c4), wv2 = *(const LAS f32x4*)(lw + 768 + c4), bv = *(const LAS f32x4*)(lw + 896 + c4);
#pragma unroll
            for (int ai = 0; ai < 2; ++ai) {
                const int g64 = u.pm * 4 + ai * 2 + wr;
#pragma unroll
                for (int m = 0; m < 4; ++m) {
                    const f32x4 ugm = acc[ai][0][m][n], uvm = acc[ai][1][m][n], ugp = acc[ai][0][(m + 3) & 3][n], ugn = acc[ai][0][(m + 1) & 3][n], uvp = acc[ai][1][(m + 3) & 3][n], uvn = acc[ai][1][(m + 1) & 3][n];
                    f32x4 pg, ng, pvv, nv;
#pragma unroll
                    for (int i = 0; i < 4; ++i) {
                        pg[i] = dpp_mov<0x111>(dpp_mov<0x121>(0.f, ugp[i]), ugm[i]);
                        ng[i] = dpp_mov<0x101>(dpp_mov<0x12F>(0.f, ugn[i]), ugm[i]);
                        pvv[i] = dpp_mov<0x111>(dpp_mov<0x121>(0.f, uvp[i]), uvm[i]);
                        nv[i] = dpp_mov<0x101>(dpp_mov<0x12F>(0.f, uvn[i]), uvm[i]); }
                    const f32x4 gate = wg0 * pg + wg1 * ugm + wg2 * ng + bg;
                    const f32x4 val = wv0 * pvv + wv1 * uvm + wv2 * nv + bv;
                    const int row = row0 + ai * HALF + m * 16;
                    const bool edge = (m == 0 && fr == 0) || (m == 3 && fr == 15);
                    if (!edge) { u32x2 w; w.x = pk2(siluf_(gate[0]) * val[0], siluf_(gate[1]) * val[1]); w.y = pk2(siluf_(gate[2]) * val[2], siluf_(gate[3]) * val[3]);
                        *(u32x2*)(P + (size_t)row * PLD + C_ACT + a0) = w; }
                    if ((m == 0 && fr < 2) || (m == 3 && fr >= 14)) { const int slot = (m == 0) ? fr : fr - 12;
                        float* ue = UE + ((size_t)g64 * 4 + slot) * NUP;
                        *(f32x4*)(ue + a0) = ugm; *(f32x4*)(ue + DFF + a0) = uvm; }
                }
            }
        }
    }
};
struct EpiDown {
    static constexpr bool PERM = true, AFTER_DRAIN = false, PREFETCH = false, RESCALE = false;
    float* out; const bf16* P;
    __device__ __forceinline__ void operator()(const f32x4 (&acc)[2][2][4][2], const Unit& u, int wr, int wc, int fr, int fq) const {
        const int row0 = u.pm * BM + wr * 64 + fr, col0 = u.pn * BM + wc * 32 + 8 * fq;
#pragma unroll
        for (int ai = 0; ai < 2; ++ai)
#pragma unroll
            for (int m = 0; m < 4; ++m) { const int row = row0 + ai * HALF + m * 16;
#pragma unroll
                for (int bj = 0; bj < 2; ++bj) { const int c = col0 + bj * HALF; float xr[8]; unpack8(*(const u32x4*)(P + (size_t)row * PLD + C_X1B + c), xr);
                    const f32x4 v0 = acc[ai][bj][m][0], v1 = acc[ai][bj][m][1];
                    *(f32x4*)(out + (size_t)row * DM + c) = (f32x4){xr[0] + v0[0], xr[1] + v0[1], xr[2] + v0[2], xr[3] + v0[3]};
                    *(f32x4*)(out + (size_t)row * DM + c + 4) = (f32x4){xr[4] + v1[0], xr[5] + v1[1], xr[6] + v1[2], xr[7] + v1[3]}; } }
    }
};

template <int DH, int RSK, int RSV>
__device__ __forceinline__ void attn_tile(const LAS unsigned char* Kl, const LAS unsigned char* Vl, int jk, const bf16x8 (&qf)[DH / 16], f32x16 s0, f32x16 s1,
                                          float& m, float& l, f32x16 (&o)[DH / 32], int lane) {
    const int r32 = lane & 31, hi = lane >> 5;
    const LAS unsigned char* kp = Kl + (size_t)(jk + r32) * RSK + 16 * hi;
#pragma unroll
    for (int ks = 0; ks < DH / 16; ++ks) {
        const bf16x8 k0 = *(const LAS bf16x8*)(kp + 32 * ks), k1 = *(const LAS bf16x8*)(kp + 32 * RSK + 32 * ks);
        s0 = __builtin_amdgcn_mfma_f32_32x32x16_bf16(k0, qf[ks], s0, 0, 0, 0);
        s1 = __builtin_amdgcn_mfma_f32_32x32x16_bf16(k1, qf[ks], s1, 0, 0, 0);
    }
    const int g = lane >> 4, q4 = (lane & 15) >> 2, p = lane & 3;
    const unsigned va = (unsigned)(uintptr_t)Vl + (unsigned)(jk + 4 * hi + q4) * RSV + (16 * (g & 1) + 4 * p) * 2;
    s16x4 vlo[2][4], vhi[2][4];
#define ATT_VREAD(set, db) do { _Pragma("unroll") for (int kk = 0; kk < 4; ++kk) { \
        asm volatile("ds_read_b64_tr_b16 %0, %1 offset:%c2" : "=&v"(vlo[set][kk]) : "v"(va), "i"((16 * kk) * RSV + 64 * (db)) : "memory"); \
        asm volatile("ds_read_b64_tr_b16 %0, %1 offset:%c2" : "=&v"(vhi[set][kk]) : "v"(va), "i"((16 * kk + 8) * RSV + 64 * (db)) : "memory"); } } while (0)
    ATT_VREAD(0, 0);
    float mx = fmaxf(s0[0], s1[0]);
#pragma unroll
    for (int r = 1; r < 16; ++r) mx = fmaxf(mx, fmaxf(s0[r], s1[r]));
    mx = fmaxf(mx, __shfl_xor(mx, 32));
    const float mn = fmaxf(m, mx), f = fexp2(m - mn);
    m = mn; l *= f;
#pragma unroll
    for (int db = 0; db < DH / 32; ++db)
#pragma unroll
        for (int r = 0; r < 16; ++r) o[db][r] *= f;
    float ps = 0.f;
#pragma unroll
    for (int r = 0; r < 16; ++r) { s0[r] = fexp2(s0[r] - mn); s1[r] = fexp2(s1[r] - mn); ps += s0[r] + s1[r]; }
    l += ps;
    bf16x8 pf[4];
    { u32x4 w;
      w.x = pk2(s0[0], s0[1]); w.y = pk2(s0[2], s0[3]); w.z = pk2(s0[4], s0[5]); w.w = pk2(s0[6], s0[7]); pf[0] = __builtin_bit_cast(bf16x8, w);
      w.x = pk2(s0[8], s0[9]); w.y = pk2(s0[10], s0[11]); w.z = pk2(s0[12], s0[13]); w.w = pk2(s0[14], s0[15]); pf[1] = __builtin_bit_cast(bf16x8, w);
      w.x = pk2(s1[0], s1[1]); w.y = pk2(s1[2], s1[3]); w.z = pk2(s1[4], s1[5]); w.w = pk2(s1[6], s1[7]); pf[2] = __builtin_bit_cast(bf16x8, w);
      w.x = pk2(s1[8], s1[9]); w.y = pk2(s1[10], s1[11]); w.z = pk2(s1[12], s1[13]); w.w = pk2(s1[14], s1[15]); pf[3] = __builtin_bit_cast(bf16x8, w); }
#pragma unroll
    for (int db = 0; db < DH / 32; ++db) {
        asm volatile("s_waitcnt lgkmcnt(0)" ::: "memory"); __builtin_amdgcn_sched_barrier(0);
        if (db + 1 < DH / 32) { if ((db & 1) == 0) ATT_VREAD(1, db + 1); else ATT_VREAD(0, db + 1); }
#pragma unroll
        for (int kk = 0; kk < 4; ++kk) { const s16x4 lo = vlo[db & 1][kk], h4 = vhi[db & 1][kk];
            const bf16x8 vf = (bf16x8){lo[0], lo[1], lo[2], lo[3], h4[0], h4[1], h4[2], h4[3]};
            o[db] = __builtin_amdgcn_mfma_f32_32x32x16_bf16(vf, pf[kk], o[db], 0, 0, 0); }
        __builtin_amdgcn_sched_barrier(0);
    }
#undef ATT_VREAD
}
__device__ __forceinline__ void load_bias(const float* biasrow, int hi, f32x16& s0, f32x16& s1) {
#pragma unroll
    for (int g4 = 0; g4 < 4; ++g4) { const f32x4 c0 = *(const f32x4*)(biasrow + 8 * g4 + 4 * hi), c1 = *(const f32x4*)(biasrow + 32 + 8 * g4 + 4 * hi);
#pragma unroll
        for (int i = 0; i < 4; ++i) { s0[4 * g4 + i] = c0[i]; s1[4 * g4 + i] = c1[i]; } }
}
template <int DH>
__device__ __forceinline__ void load_q(const bf16* qrow, const float* gq, float scale, bf16x8 (&qf)[DH / 16], int lane) {
    const int hi = lane >> 5;
    u32x4 w[DH / 16]; float ss = 0.f;
#pragma unroll
    for (int ks = 0; ks < DH / 16; ++ks) { w[ks] = *(const u32x4*)(qrow + 16 * ks + 8 * hi); float v[8]; unpack8(w[ks], v);
#pragma unroll
        for (int j = 0; j < 8; ++j) ss += v[j] * v[j]; }
    ss += __shfl_xor(ss, 32);
    const float rstd = __builtin_amdgcn_rsqf(ss * (1.0f / DH) + EPS) * scale;
#pragma unroll
    for (int ks = 0; ks < DH / 16; ++ks) { float v[8]; unpack8(w[ks], v);
        const f32x4 g0 = *(const f32x4*)(gq + 16 * ks + 8 * hi), g1 = *(const f32x4*)(gq + 16 * ks + 8 * hi + 4);
#pragma unroll
        for (int j = 0; j < 4; ++j) { v[j] *= rstd * g0[j]; v[4 + j] *= rstd * g1[j]; }
        qf[ks] = __builtin_bit_cast(bf16x8, pack8(v)); }
}
template <int DH>
__device__ __forceinline__ void store_o(bf16* yrow, const f32x16 (&o)[DH / 32], float l, int lane) {
    const int hi = lane >> 5;
    const float inv = frcp(l + __shfl_xor(l, 32));
#pragma unroll
    for (int db = 0; db < DH / 32; ++db)
#pragma unroll
        for (int g4 = 0; g4 < 4; ++g4) { u32x2 w; w.x = pk2(o[db][4 * g4] * inv, o[db][4 * g4 + 1] * inv); w.y = pk2(o[db][4 * g4 + 2] * inv, o[db][4 * g4 + 3] * inv);
            *(u32x2*)(yrow + 32 * db + 8 * g4 + 4 * hi) = w; }
}
template <int DH, int RSK, int RSV>
__device__ __forceinline__ void stage_kv(LAS unsigned char* Kl, LAS unsigned char* Vl, int ldsrow0, const bf16* src, size_t pitch, int kcol, int vcol, int nrows, const float* gk, int tid) {
    constexpr int CPR = DH / 8;
    for (int c = tid; c < nrows * CPR; c += 512) {
        const int row = c / CPR, ch = c % CPR;
        const bf16* rp = src + (size_t)row * pitch;
        const u32x4 kw = *(const u32x4*)(rp + kcol + ch * 8), vw = *(const u32x4*)(rp + vcol + ch * 8);
        float v[8]; unpack8(kw, v); float ss = 0.f;
#pragma unroll
        for (int j = 0; j < 8; ++j) ss += v[j] * v[j];
#pragma unroll
        for (int o = 1; o < CPR; o <<= 1) ss += __shfl_xor(ss, o);
        const float rstd = __builtin_amdgcn_rsqf(ss * (1.0f / DH) + EPS);
        const f32x4 g0 = *(const f32x4*)(gk + ch * 8), g1 = *(const f32x4*)(gk + ch * 8 + 4);
#pragma unroll
        for (int j = 0; j < 4; ++j) { v[j] *= rstd * g0[j]; v[4 + j] *= rstd * g1[j]; }
        *(LAS u32x4*)(Kl + (size_t)(ldsrow0 + row) * RSK + ch * 16) = pack8(v);
        *(LAS u32x4*)(Vl + (size_t)(ldsrow0 + row) * RSV + ch * 16) = vw;
    }
}

constexpr int NWAVES = 8;
constexpr size_t MiB = 1u << 20;
constexpr size_t WS_CTL = 0, CTL_ZERO_BYTES = 128 * 1024;
constexpr size_t WS_WIN = 2 * MiB;
constexpr size_t WS_WBR = 15 * MiB;
constexpr size_t WS_WOUT = 18 * MiB;
constexpr size_t WS_WUP = 20 * MiB;
constexpr size_t WS_WDN = 31 * MiB;
constexpr size_t WS_WKV = 37 * MiB;
constexpr size_t WS_MEMN = 39 * MiB;
constexpr size_t WS_KV = 41 * MiB;
constexpr size_t WS_BT = 43 * MiB;
constexpr size_t WS_BA = 45 * MiB;
constexpr size_t WS_SSQ = 49 * MiB;
constexpr size_t WS_P = 52 * MiB;
constexpr size_t WS_UE = 452 * MiB;
constexpr size_t WS_END = 512 * MiB;
static_assert(WS_P + (size_t)M * PLD * 2 == WS_UE && WS_UE + (size_t)512 * 4 * NUP * 4 <= WS_END, "d_ws map");

constexpr int CW_TMO = 0, CW_CODE = 1;
constexpr int CW_BAR = 4096;
constexpr int RING_OFF = 0, RING_BYTES = 147456;
constexpr int LDSCTL_OFF = RING_BYTES, MISC_OFF = LDSCTL_OFF + 320;
constexpr int XCH_OFF = MISC_OFF + 256;
constexpr int LDS_BYTES = 163840;
static_assert(XCH_OFF + 2 * 1280 * 4 <= LDS_BYTES && XCH_OFF % 16 == 0, "LDS map");

typedef GAS unsigned gu32;
#define RLX_AGENT __ATOMIC_RELAXED, __HIP_MEMORY_SCOPE_AGENT
#define LDS_WAIT() asm volatile("s_waitcnt lgkmcnt(0)" ::: "memory")
#define VM_WAIT() asm volatile("s_waitcnt vmcnt(0)" ::: "memory")

#define XB_TMO      128
#define XB_XCNT(j)  (256  + 64 * (j))
#define XB_XSUB(j)  (1280 + 64 * (j))
#define XB_XGEN(j)  (2304 + 64 * (j))
#define XB_TOP      3328
#define XB_TOPGEN   3392
#define XCD_BAR_WORDS 3456
#define XB_SPIN_CAP (1u << 22)

__device__ __forceinline__ unsigned xb_ld(unsigned* p)              { return __hip_atomic_load(p, __ATOMIC_RELAXED, __HIP_MEMORY_SCOPE_AGENT); }
__device__ __forceinline__ unsigned xb_add(unsigned* p, unsigned v) { return __hip_atomic_fetch_add(p, v, __ATOMIC_RELAXED, __HIP_MEMORY_SCOPE_AGENT); }
__device__ __forceinline__ unsigned xb_xcc_id() { return (unsigned)__builtin_amdgcn_s_getreg((3 << 11) | 20) & 0xFu; }
#define XB_SPIN(cond, bar) do { unsigned _sp = 0; while (cond) { __builtin_amdgcn_s_sleep(1); \
    if ((++_sp & 255u) == 0u) { if (xb_ld(&(bar)[XB_TMO])) break; if (_sp > XB_SPIN_CAP) { atomicAdd(&(bar)[XB_TMO], 1u); break; } } } } while (0)

struct XcdBarrier { unsigned* bar; unsigned x; volatile LAS unsigned* st; };

__device__ __forceinline__ XcdBarrier xcd_barrier_post(unsigned* bar, volatile LAS unsigned* st) {
    XcdBarrier b; b.bar = bar; b.x = xb_xcc_id(); b.st = st;
    if (threadIdx.x == 0) (void)xb_add(&bar[XB_XCNT(b.x)], 1u);
    return b;
}
__device__ __forceinline__ void xcd_barrier_complete(unsigned* bar, unsigned x, unsigned& nloc, unsigned& nx) {
    const unsigned G = gridDim.x * gridDim.y * gridDim.z;
    unsigned sum, cnt, mine, sp = 0u;
    for (;;) {
        sum = 0u; cnt = 0u; mine = 0u;
#pragma unroll
        for (unsigned j = 0; j < 16; ++j) { const unsigned c = xb_ld(&bar[XB_XCNT(j)]); sum += c; cnt += (c > 0u) ? 1u : 0u; mine = (j == x) ? c : mine; }
        if (sum == G) break;
        __builtin_amdgcn_s_sleep(1);
        if ((++sp & 255u) == 0u) { if (xb_ld(&bar[XB_TMO])) break; if (sp > XB_SPIN_CAP) { atomicAdd(&bar[XB_TMO], 1u); break; } }
    }
    nloc = mine > 0u ? mine : 1u; nx = cnt > 0u ? cnt : 1u;
}
__device__ __forceinline__ void xcd_barrier(const XcdBarrier& b) {
    asm volatile("s_waitcnt vmcnt(0)" ::: "memory");
    __syncthreads();
    if (threadIdx.x == 0) {
        unsigned* bar = b.bar;
        __builtin_amdgcn_s_waitcnt(0);
        unsigned nloc = b.st[0], nx = b.st[1];
        if (nloc == 0u) { xcd_barrier_complete(bar, b.x, nloc, nx); b.st[0] = nloc; b.st[1] = nx; }
        const unsigned old = xb_add(&bar[XB_XSUB(b.x)], 1u);
        const unsigned gen = old / nloc;
        if (old + 1u == (gen + 1u) * nloc) {
            __builtin_amdgcn_fence(__ATOMIC_RELEASE, "agent");
            asm volatile("s_waitcnt vmcnt(0)" ::: "memory");
            const unsigned og = xb_add(&bar[XB_TOP], 1u);
            const unsigned tg = og / nx;
            if (og + 1u == (tg + 1u) * nx) xb_add(&bar[XB_TOPGEN], 1u);
            else XB_SPIN(xb_ld(&bar[XB_TOPGEN]) == tg, bar);
            __builtin_amdgcn_fence(__ATOMIC_ACQUIRE, "agent");
            xb_add(&bar[XB_XGEN(b.x)], 1u);
            asm volatile("s_waitcnt vmcnt(0)" ::: "memory");
        } else {
            XB_SPIN(xb_ld(&bar[XB_XGEN(b.x)]) == gen, bar);
            __builtin_amdgcn_fence(__ATOMIC_ACQUIRE, "agent");
            asm volatile("s_waitcnt vmcnt(0)" ::: "memory");
        }
    }
    __syncthreads();
}

struct Frame {
    LAS unsigned char* lds;
    volatile LAS unsigned* MISC;
    gu32* ctl;
    int tid, lane, wave, vcu, G;
};

__device__ __forceinline__ float wave_sum(float v) {
#pragma unroll
    for (int o = 1; o < 64; o <<= 1) v += __shfl_xor(v, o);
    return v;
}
__device__ __forceinline__ int t5_bucket(int rel) {
    const int n = rel < 0 ? -rel : rel;
    const int mag = n < 8 ? n : n < 12 ? 8 : n < 16 ? 9 : n < 23 ? 10 : n < 32 ? 11 : n < 46 ? 12 : n < 64 ? 13 : n < 91 ? 14 : 15;
    return (rel > 0 ? 16 : 0) + mag;
}

__device__ __forceinline__ void transpose_item(const float* W, int K, int N, int k0, int n0, bf16* WT, int drow0, const float* gk, LAS float* scr, int lane) {
    { f32x4 v[8];
#pragma unroll
      for (int i = 0; i < 8; ++i) v[i] = *(const f32x4*)(W + (size_t)(k0 + 8 * i + (lane >> 3)) * N + n0 + 4 * (lane & 7));
#pragma unroll
      for (int i = 0; i < 8; ++i) { const int kk = 8 * i + (lane >> 3); const float gs = gk ? gk[k0 + kk] : 1.0f; LAS float* d = scr + kk * 33 + 4 * (lane & 7);
          d[0] = v[i][0] * gs; d[1] = v[i][1] * gs; d[2] = v[i][2] * gs; d[3] = v[i][3] * gs; } }
    LDS_WAIT(); asm volatile("" ::: "memory");
    const int c = lane & 7;
#pragma unroll
    for (int j = 0; j < 4; ++j) { const int n = (lane >> 3) + 8 * j; const LAS float* s = scr + (8 * c) * 33 + n;
        u32x4 o; o.x = pk2(s[0 * 33], s[1 * 33]); o.y = pk2(s[2 * 33], s[3 * 33]); o.z = pk2(s[4 * 33], s[5 * 33]); o.w = pk2(s[6 * 33], s[7 * 33]);
        *(GAS u32x4*)(WT + (size_t)(drow0 + n) * K + k0 + 8 * c) = o; }
    LDS_WAIT(); asm volatile("" ::: "memory");
}
__device__ __forceinline__ void rms_row_to_bf16(const float* xrow, const float* g, bf16* orow, int lane) {
    const GAS f32x4* xr = (const GAS f32x4*)xrow + lane;
    const GAS f32x4* gr = (const GAS f32x4*)g + lane;
    f32x4 v[4]; float s = 0.f;
#pragma unroll
    for (int j = 0; j < 4; ++j) { v[j] = xr[64 * j]; s += (v[j].x * v[j].x + v[j].y * v[j].y) + (v[j].z * v[j].z + v[j].w * v[j].w); }
    const float rstd = __builtin_amdgcn_rsqf(wave_sum(s) * (1.f / DM) + EPS);
    GAS unsigned long long* o8 = (GAS unsigned long long*)orow + lane;
#pragma unroll
    for (int j = 0; j < 4; ++j) { const f32x4 gg = gr[64 * j];
        o8[64 * j] = (unsigned long long)pk2(v[j].x * rstd * gg.x, v[j].y * rstd * gg.y) | ((unsigned long long)pk2(v[j].z * rstd * gg.z, v[j].w * rstd * gg.w) << 32); }
}

template <int R> __device__ __forceinline__ void rms_rows_to_bf16(const float* xa, size_t rstride, const float* g, bf16* oa, int lane) {
    const GAS f32x4* gr = (const GAS f32x4*)g + lane;
    f32x4 v[R][4]; float ss[R];
#pragma unroll
    for (int r = 0; r < R; ++r) { const GAS f32x4* xr = (const GAS f32x4*)(xa + (size_t)r * rstride) + lane;
#pragma unroll
        for (int j = 0; j < 4; ++j) v[r][j] = xr[64 * j]; }
#pragma unroll
    for (int r = 0; r < R; ++r) { ss[r] = 0.f;
#pragma unroll
        for (int j = 0; j < 4; ++j) ss[r] += (v[r][j].x * v[r][j].x + v[r][j].y * v[r][j].y) + (v[r][j].z * v[r][j].z + v[r][j].w * v[r][j].w); }
#pragma unroll
    for (int o = 1; o < 64; o <<= 1)
#pragma unroll
        for (int r = 0; r < R; ++r) ss[r] += __shfl_xor(ss[r], o);
#pragma unroll
    for (int r = 0; r < R; ++r) { const float rs = __builtin_amdgcn_rsqf(ss[r] * (1.f / DM) + EPS);
        GAS unsigned long long* o8 = (GAS unsigned long long*)(oa + (size_t)r * rstride) + lane;
#pragma unroll
        for (int j = 0; j < 4; ++j) { const f32x4 gg = gr[64 * j];
            o8[64 * j] = (unsigned long long)pk2(v[r][j].x * rs * gg.x, v[r][j].y * rs * gg.y) | ((unsigned long long)pk2(v[r][j].z * rs * gg.z, v[r][j].w * rs * gg.w) << 32); } }
}

struct Args { const float* in[25]; float* out; unsigned char* ws; int ph_lo, ph_hi, mode, pad; };

constexpr int WI_IN = 16 * 201, WI_KV = 16 * 32, WI_BR = 8 * 32, WI_OUT = 16 * 32, WI_UP = 16 * 176, WI_DN = 44 * 32;
constexpr int WI_EARLY = WI_IN + WI_KV, WI_ALL = WI_EARLY + 3 * WI_BR + WI_OUT + WI_UP + WI_DN;
__device__ __forceinline__ void weight_items(Frame& F, const Args& a, int first, int last, int gwl, int ngwl) {
    unsigned char* ws = a.ws;
    LAS float* scr = (LAS float*)(F.lds + RING_OFF + F.wave * 16384);
    for (int it = first + gwl; it < last; it += ngwl) {
        int r = it;
        if (r < WI_IN) { const int kb = r / 201, nb = r % 201, n0 = nb * 32;
            const int d0 = n0 < 2816 ? n0 : (n0 < 2848 ? 3328 + (n0 - 2816) : (n0 < 3360 ? n0 - 32 : 3584 + (n0 - 3360)));
            transpose_item(a.in[4], 1024, 6432, kb * 64, n0, (bf16*)(ws + WS_WIN), d0, nullptr, scr, F.lane); continue; }
        r -= WI_IN;
        if (r < WI_KV) { const int kb = r / 32, nb = r % 32;
            transpose_item(a.in[13], 1024, 1024, kb * 64, nb * 32, (bf16*)(ws + WS_WKV), nb * 32, nullptr, scr, F.lane); continue; }
        r -= WI_KV;
        if (r < 3 * WI_BR) { const int br = r / WI_BR, q = r % WI_BR, kb = q / 32, nb = q % 32;
            transpose_item(a.in[16 + br], 512, 1024, kb * 64, nb * 32, (bf16*)(ws + WS_WBR) + (size_t)br * 1024 * 512, nb * 32, nullptr, scr, F.lane); continue; }
        r -= 3 * WI_BR;
        if (r < WI_OUT) { const int kb = r / 32, nb = r % 32;
            transpose_item(a.in[19], 1024, 1024, kb * 64, nb * 32, (bf16*)(ws + WS_WOUT), nb * 32, nullptr, scr, F.lane); continue; }
        r -= WI_OUT;
        if (r < WI_UP) { const int kb = r / 176, nb = r % 176, n0 = nb * 32;
            const int isv = n0 >= DFF, nn = isv ? n0 - DFF : n0, d0 = (nn >> 7) * 256 + isv * 128 + (nn & 127);
            transpose_item(a.in[21], 1024, NUP, kb * 64, n0, (bf16*)(ws + WS_WUP), d0, a.in[20], scr, F.lane); continue; }
        r -= WI_UP;
        { const int kb = r / 32, nb = r % 32;
            transpose_item(a.in[24], DFF, 1024, kb * 64, nb * 32, (bf16*)(ws + WS_WDN), nb * 32, nullptr, scr, F.lane); }
    }
}
__device__ __forceinline__ void p0_prologue(Frame& F, const Args& a) {
    unsigned char* ws = a.ws;
    const int gw = F.vcu * NWAVES + F.wave, NGW = F.G * NWAVES;
    weight_items(F, a, 0, WI_EARLY, gw, NGW);
    { u32x4* z = (u32x4*)((bf16*)(ws + WS_WIN) + (size_t)3360 * 1024); const int n16 = 224 * 1024 * 2 / 16;
      for (int i = blockIdx.x * 512 + F.tid; i < n16; i += F.G * 512) z[i] = (u32x4){0u, 0u, 0u, 0u}; }
    bf16* H = (bf16*)a.out;
    if (M % (4 * NGW) != 0) { for (int m = gw; m < M; m += NGW) rms_row_to_bf16(a.in[0] + (size_t)m * DM, a.in[3], H + (size_t)m * DM, F.lane); }
    else for (int m = gw; m < M; m += 4 * NGW) rms_rows_to_bf16<4>(a.in[0] + (size_t)m * DM, (size_t)NGW * DM, a.in[3], H + (size_t)m * DM, F.lane);
    for (int m = gw; m < BATCH * NMEM; m += NGW) rms_row_to_bf16(a.in[1] + (size_t)m * DM, a.in[12], (bf16*)(ws + WS_MEMN) + (size_t)m * DM, F.lane);
    { float* BT = (float*)(ws + WS_BT); const float* tab = a.in[2];
      for (int i = blockIdx.x * 512 + F.tid; i < 8 * 128 * 384; i += F.G * 512) { const int j = i % 384, t = (i / 384) % 128, h = i / (384 * 128);
          const int rel = j - 128 - t; const bool ok = rel >= -128 && rel <= 128;
          BT[i] = ok ? tab[t5_bucket(rel) * 8 + h] * LOG2E : -INFINITY; } }
}

__device__ __forceinline__ void attnA_unit(Frame& F, const Args& a, int b, int n, int kvh) {
    constexpr int RSK = 144, RSV = 128;
    LAS unsigned char* Kl = F.lds; LAS unsigned char* Vl = F.lds + 384 * RSK;
    bf16* P = (bf16*)(a.ws + WS_P);
    const float* BT = (const float*)(a.ws + WS_BT);
    for (int blk = 0; blk < 3; ++blk) { const int pos0 = n * 128 - 128 + blk * 128; if (pos0 < 0 || pos0 >= SEQ) continue;
        stage_kv<64, RSK, RSV>(Kl, Vl, blk * 128, P + (size_t)(b * SEQ + pos0) * PLD, PLD, C_AK + kvh * 64, C_AV + kvh * 64, 128, a.in[6], F.tid); }
    LDS_WAIT(); __syncthreads();
    const int h = kvh * 4 + (F.wave >> 1), r32 = F.lane & 31, hi = F.lane >> 5;
    const float sink = a.in[7][h] * LOG2E;
#pragma unroll 1
    for (int qb = 0; qb < 2; ++qb) {
        const int t0 = (F.wave & 1) * 64 + qb * 32, t = t0 + r32;
        bf16* qrow = P + (size_t)(b * SEQ + n * 128 + t) * PLD + C_AQ + h * 64;
        bf16x8 qf[4]; load_q<64>(qrow, a.in[5], 0.125f * LOG2E, qf, F.lane);
        float m = sink, l = hi == 0 ? 1.f : 0.f; f32x16 o[2];
#pragma unroll
        for (int r = 0; r < 16; ++r) { o[0][r] = 0.f; o[1][r] = 0.f; }
        const int lo = max(t0 >= 64 ? 1 : 0, n == 0 ? 2 : 0), hi_t = min(t0 >= 64 ? 5 : 4, n == SEQ / 128 - 1 ? 3 : 5);
        const float* brow = BT + ((size_t)h * 128 + t) * 384;
        f32x16 b0, b1; load_bias(brow + 64 * lo, hi, b0, b1);
#pragma unroll 1
        for (int kt = lo; kt <= hi_t; ++kt) {
            f32x16 nb0 = b0, nb1 = b1;
            if (kt < hi_t) load_bias(brow + 64 * (kt + 1), hi, nb0, nb1);
            attn_tile<64, RSK, RSV>(Kl, Vl, 64 * kt, qf, b0, b1, m, l, o, F.lane);
            b0 = nb0; b1 = nb1; }
        store_o<64>(qrow, o, l, F.lane);
    }
    LDS_WAIT(); __syncthreads();
}
__device__ __forceinline__ void xattn_unit(Frame& F, const Args& a, int b, int tb, int h) {
    constexpr int RSK = 272, RSV = 320;
    LAS unsigned char* Kl = F.lds; LAS unsigned char* Vl = F.lds + 128 * RSK;
    bf16* P = (bf16*)(a.ws + WS_P);
    const bf16* KV = (const bf16*)(a.ws + WS_KV);
    const int r32 = F.lane & 31;
    bf16* qrow = P + (size_t)(b * SEQ + tb * 256 + F.wave * 32 + r32) * PLD + C_MQ + h * 128;
    bf16x8 qf[8]; load_q<128>(qrow, a.in[14], 0.08838834764831845f * LOG2E, qf, F.lane);
    float m = -1e30f, l = 0.f; f32x16 o[4];
#pragma unroll
    for (int db = 0; db < 4; ++db)
#pragma unroll
        for (int r = 0; r < 16; ++r) o[db][r] = 0.f;
#pragma unroll 1
    for (int half = 0; half < 2; ++half) {
        stage_kv<128, RSK, RSV>(Kl, Vl, 0, KV + (size_t)(b * NMEM + half * 128) * 1024, 1024, h * 128, 512 + h * 128, 128, a.in[15], F.tid);
        LDS_WAIT(); __syncthreads();
#pragma unroll 1
        for (int kt = 0; kt < 2; ++kt) { f32x16 z0, z1;
#pragma unroll
            for (int r = 0; r < 16; ++r) { z0[r] = 0.f; z1[r] = 0.f; }
            attn_tile<128, RSK, RSV>(Kl, Vl, 64 * kt, qf, z0, z1, m, l, o, F.lane); }
        LDS_WAIT(); __syncthreads();
    }
    store_o<128>(qrow, o, l, F.lane);
}


constexpr int SAF = C_GATE, SCF = C_GATE + 512, SBF = C_GATE + 1024, SDF = C_GATE + 1536, SAB = C_GATE + 2048, SCB = C_GATE + 2560;
constexpr int C_OF = C_DQ, C_OB = C_DK;
__device__ __forceinline__ int dn_pcol(int x) { return (x & 32) + 8 * ((x & 15) >> 2) + 4 * ((x >> 4) & 1) + (x & 3); }
__device__ __forceinline__ bf16x8 frag_lo(const LAS unsigned char* p) { const u32x2 a0 = *(const LAS u32x2*)p; u32x4 w; w.x = a0.x; w.y = a0.y; w.z = 0u; w.w = 0u; return __builtin_bit_cast(bf16x8, w); }
__device__ __forceinline__ bf16x8 frag_2(const LAS unsigned char* p) { const u32x2 a0 = *(const LAS u32x2*)p, a1 = *(const LAS u32x2*)(p + 32); u32x4 w; w.x = a0.x; w.y = a0.y; w.z = a1.x; w.w = a1.y; return __builtin_bit_cast(bf16x8, w); }
__device__ __forceinline__ bf16x8 pack_f4z(const f32x4 a) { u32x4 w; w.x = pk2(a[0], a[1]); w.y = pk2(a[2], a[3]); w.z = 0u; w.w = 0u; return __builtin_bit_cast(bf16x8, w); }
__device__ __forceinline__ bf16x8 pack_f4f4(const f32x4 a, const f32x4 b) { u32x4 w; w.x = pk2(a[0], a[1]); w.y = pk2(a[2], a[3]); w.z = pk2(b[0], b[1]); w.w = pk2(b[2], b[3]); return __builtin_bit_cast(bf16x8, w); }
__device__ __forceinline__ void dn_prep_block(Frame& F, const Args& a, int b, int h, int c0, int nch) {
    LAS float* raw = (LAS float*)(F.lds);
    LAS unsigned char* NL = F.lds;
    LAS unsigned char* TD = F.lds + 18432;
    LAS unsigned char* Qb = F.lds + 53248;
    LAS unsigned char* Kb = F.lds + 62464;
    LAS unsigned char* Vb = F.lds + 71680;
    LAS float* sm = (LAS float*)(F.lds + 80896);
    LAS float* gt = sm;
    LAS float* btk = sm + 128;
    LAS float* gct = sm + 256;
    LAS float* cu = sm + 384;
    LAS float* cwp = sm + 512;
    LAS float* egp = sm + 640;
    LAS float* esp = sm + 768;
    LAS unsigned char* QKL = F.lds + 24576;
    LAS unsigned char* KT = F.lds + 84480;
    LAS unsigned char* QT = F.lds + 104960;
    bf16* P = (bf16*)(a.ws + WS_P);
    float* BA = (float*)(a.ws + WS_BA);
    bf16* XB2 = (bf16*)a.out + (size_t)M * 1024;
    const float* cw = a.in[8];
    const int w = F.wave, lane = F.lane, tid = F.tid;
    float wt[3][5];
#pragma unroll
    for (int which = 0; which < 3; ++which)
#pragma unroll
        for (int j = 0; j < 5; ++j) wt[which][j] = cw[j * 1536 + which * 512 + h * 64 + lane];
    const float Ah = expf(a.in[9][(tid >> 6 & 1) * 8 + h]), dtb = a.in[10][(tid >> 6 & 1) * 8 + h];
    u32x4 rr[4]; float pa = 0.f, pb = 0.f;
#define DN_PREFETCH(cidx) do { const int t0p_ = (cidx) * 64; \
        _Pragma("unroll") for (int i_ = 0; i_ < 4; ++i_) { const int e = tid + 512 * i_, row = e / 24, c8 = e % 24, which = c8 >> 3, t = t0p_ - 2 + row; \
            rr[i_] = (u32x4){0u, 0u, 0u, 0u}; \
            if (e < 68 * 24 && t >= 0 && t < SEQ) rr[i_] = *(const u32x4*)(P + ((size_t)b * SEQ + t) * PLD + (which == 0 ? C_DQ : which == 1 ? C_DK : C_DV) + h * 64 + (c8 & 7) * 8); } \
        if (tid < 128) { const size_t tok = (size_t)b * SEQ + t0p_ + (tid & 63); pa = BA[tok * 32 + 16 + (tid >> 6) * 8 + h]; pb = BA[tok * 32 + (tid >> 6) * 8 + h]; } } while (0)
    DN_PREFETCH(c0);
#pragma unroll 1
  for (int ci = 0; ci < nch; ++ci) {
    int tid_o = F.tid; asm volatile("" : "+v"(tid_o));
    const int tid = tid_o, lane = tid & 63;
    const int c = c0 + ci, t0 = c * 64;
    const size_t tok0 = (size_t)b * SEQ + t0;
#pragma unroll
    for (int i_ = 0; i_ < 4; ++i_) { const int e = tid + 512 * i_, row = e / 24, c8 = e % 24;
        if (e < 68 * 24) { float v[8]; unpack8(rr[i_], v);
            *(LAS f32x4*)(raw + row * 192 + c8 * 8) = (f32x4){v[0], v[1], v[2], v[3]}; *(LAS f32x4*)(raw + row * 192 + c8 * 8 + 4) = (f32x4){v[4], v[5], v[6], v[7]}; } }
    if (tid < 128) { const int d = tid >> 6, i = tid & 63; const float xa = pa + dtb;
        gt[d * 64 + i] = -Ah * (fmaxf(xa, 0.f) + __logf(1.0f + __expf(-fabsf(xa))));
        btk[d * 64 + i] = sigmoidf_(pb); }
    if (ci + 1 < nch) DN_PREFETCH(c + 1);
    LDS_WAIT(); __syncthreads();
#pragma unroll
    for (int which = 0; which < 3; ++which) {
        float x[12], y[8];
#pragma unroll
        for (int j = 0; j < 12; ++j) x[j] = raw[(w * 8 + j) * 192 + which * 64 + lane];
#pragma unroll
        for (int r = 0; r < 8; ++r) { float acc = 0.f;
#pragma unroll
            for (int j = 0; j < 5; ++j) acc += x[r + j] * wt[which][j];
            y[r] = siluf_(acc); }
        if (which < 2) {
            float ss[8];
#pragma unroll
            for (int r = 0; r < 8; ++r) ss[r] = y[r] * y[r];
#pragma unroll
            for (int o = 1; o < 64; o <<= 1)
#pragma unroll
                for (int r = 0; r < 8; ++r) ss[r] += __shfl_xor(ss[r], o);
#pragma unroll
            for (int r = 0; r < 8; ++r) y[r] *= __builtin_amdgcn_rsqf(ss[r] + EPS) * (which == 0 ? 0.125f : 1.0f);
        }
        LAS unsigned char* X = which == 0 ? Qb : which == 1 ? Kb : Vb;
#pragma unroll
        for (int r = 0; r < 8; ++r) *(LAS bf16*)(X + (w * 8 + r) * 144 + lane * 2) = (bf16)(pk2(y[r], 0.f) & 0xffffu);
        asm volatile("" ::: "memory");
    }
    if (w < 2) { const int i = w ? 63 - lane : lane; float gv = gt[w * 64 + i];
#pragma unroll
        for (int o = 1; o < 64; o <<= 1) { const float t = __shfl_up(gv, o); if (lane >= o) gv += t; }
        const float glast = __shfl(gv, 63), bt = btk[w * 64 + i], eg = __expf(gv);
        const float es = __expf(glast - gv);
        gct[w * 64 + i] = gv; cu[w * 64 + lane] = bt; cwp[w * 64 + lane] = bt * eg; egp[w * 64 + lane] = eg; esp[w * 64 + lane] = es;
        BA[(tok0 + lane) * 32 + w * 8 + h] = eg; }
    LDS_WAIT(); __syncthreads();
    { const int p = tid >> 3, c8 = tid & 7;
#pragma unroll
      for (int d = 0; d < 2; ++d) { const int i = d ? 63 - p : p; const float es = esp[d * 64 + p], eg = egp[d * 64 + p]; float v[8];
          unpack8(*(const LAS u32x4*)(Kb + i * 144 + c8 * 16), v);
#pragma unroll
          for (int j = 0; j < 8; ++j) v[j] *= es;
          *(LAS u32x4*)(KT + d * 10240 + p * 160 + c8 * 16) = pack8(v);
          unpack8(*(const LAS u32x4*)(Qb + i * 144 + c8 * 16), v);
#pragma unroll
          for (int j = 0; j < 8; ++j) v[j] *= eg;
          *(LAS u32x4*)(QT + d * 9216 + p * 144 + c8 * 16) = pack8(v); } }
    { const int wq = w & 3, tm = wq >> 1, tn = wq & 1, r32 = lane & 31, hi = lane >> 5;
      const LAS unsigned char* X = (w < 4) ? Kb : Qb;
      f32x16 acc;
#pragma unroll
      for (int r = 0; r < 16; ++r) acc[r] = 0.f;
#pragma unroll
      for (int kst = 0; kst < 4; ++kst) {
          const bf16x8 af = *(const LAS bf16x8*)(X + (32 * tm + r32) * 144 + (16 * kst + 8 * hi) * 2), bfr = *(const LAS bf16x8*)(Kb + (32 * tn + r32) * 144 + (16 * kst + 8 * hi) * 2);
          acc = __builtin_amdgcn_mfma_f32_32x32x16_bf16(af, bfr, acc, 0, 0, 0); }
      const int j = 32 * tn + r32; const float gjf = gct[j], gjb = gct[64 + j];
#pragma unroll
      for (int g4 = 0; g4 < 4; ++g4) { const int i0 = 32 * tm + 8 * g4 + 4 * hi;
          const f32x4 gif = *(const LAS f32x4*)(gct + i0), gib = *(const LAS f32x4*)(gct + 64 + i0), bif = *(const LAS f32x4*)(btk + i0), bib = *(const LAS f32x4*)(btk + 64 + i0);
#pragma unroll
          for (int q = 0; q < 4; ++q) { const int i = i0 + q; const float v = acc[4 * g4 + q];
              const float ef = __expf(fminf(gif[q] - gjf, 0.f)), eb = __expf(fminf(gib[q] - gjb, 0.f));
              if (w < 4) {
                  const float lf = (j < i) ? -bif[q] * v * ef : 0.f, lb = (j > i) ? -bib[q] * v * eb : 0.f;
                  *(LAS bf16*)(NL + i * 144 + j * 2) = (bf16)(pk2(lf, 0.f) & 0xffffu);
                  *(LAS bf16*)(NL + 9216 + (63 - i) * 144 + (63 - j) * 2) = (bf16)(pk2(lb, 0.f) & 0xffffu);
              } else {
                  const float qf = (j <= i) ? v * ef : 0.f, qb = (j >= i) ? v * eb : 0.f;
                  *(LAS bf16*)(QKL + i * 144 + j * 2) = (bf16)(pk2(qf, 0.f) & 0xffffu);
                  *(LAS bf16*)(QKL + 9216 + (63 - i) * 144 + (63 - j) * 2) = (bf16)(pk2(qb, 0.f) & 0xffffu);
              } } } }
    LDS_WAIT(); __syncthreads();
    if (w < 2) { const int blk = lane >> 4, col = lane & 15; const LAS unsigned char* nl = NL + w * 9216 + (16 * blk) * 144 + (16 * blk) * 2;
        u32x4 lr[16][2];
#pragma unroll
        for (int r = 1; r < 16; ++r) { lr[r][0] = *(const LAS u32x4*)(nl + r * 144); if (r > 8) lr[r][1] = *(const LAS u32x4*)(nl + r * 144 + 16); }
        float t[16];
#pragma unroll
        for (int r = 0; r < 16; ++r) { float a0 = (r == col) ? 1.f : 0.f, a1 = 0.f;
            if (r > 0) { float l[16]; { float l8[8]; unpack8(lr[r][0], l8);
#pragma unroll
                    for (int q = 0; q < 8; ++q) l[q] = l8[q]; }
                if (r > 8) { float l8[8]; unpack8(lr[r][1], l8);
#pragma unroll
                    for (int q = 0; q < 8; ++q) l[8 + q] = l8[q]; }
#pragma unroll
                for (int q = 0; q < r; ++q) { if (q & 1) a1 += l[q] * t[q]; else a0 += l[q] * t[q]; } }
            t[r] = a0 + a1; }
#pragma unroll
        for (int r = 0; r < 16; ++r) *(LAS bf16*)(TD + w * 3072 + blk * 768 + r * 48 + col * 2) = (bf16)(pk2(t[r], 0.f) & 0xffffu);
    }
    LDS_WAIT(); __syncthreads();
    { const int d = w >> 2, cc = lane & 15, g = lane >> 4;
      const LAS unsigned char* nl = NL + d * 9216; const LAS unsigned char* td = TD + d * 3072 + cc * 48 + 8 * g;
#pragma unroll
      for (int jj = 0; jj < 2; ++jj) { const int ct = 2 * (w & 3) + jj, part = ct >> 2, colb = 16 * (ct & 3);
          const LAS unsigned char* src = part ? Kb : Vb; const LAS float* coef = (part ? cwp : cu) + d * 64;
          f32x4 R[4];
#pragma unroll
          for (int bq = 0; bq < 4; ++bq) { const f32x4 cf = *(const LAS f32x4*)(coef + 16 * bq + 4 * g);
#pragma unroll
              for (int r = 0; r < 4; ++r) { const int p = 16 * bq + 4 * g + r, i = d ? 63 - p : p;
                  R[bq][r] = cf[r] * __uint_as_float((unsigned)(*(const LAS bf16*)(src + i * 144 + (colb + cc) * 2)) << 16); } }
          const f32x4 z4 = (f32x4){0.f, 0.f, 0.f, 0.f};
          f32x4 X0, X1, X2, X3, Y;
          const bf16x8 t0f = frag_lo(td), t1f = frag_lo(td + 768), t2f = frag_lo(td + 2 * 768), t3f = frag_lo(td + 3 * 768);
          const bf16x8 n1f = frag_lo(nl + (16 + cc) * 144 + 8 * g), n2f = frag_2(nl + (32 + cc) * 144 + 8 * g), n3f = frag_2(nl + (48 + cc) * 144 + 8 * g), n3g = frag_lo(nl + (48 + cc) * 144 + 64 + 8 * g);
          __builtin_amdgcn_sched_barrier(0);
          X0 = __builtin_amdgcn_mfma_f32_16x16x32_bf16(t0f, pack_f4z(R[0]), z4, 0, 0, 0);
          Y = __builtin_amdgcn_mfma_f32_16x16x32_bf16(n1f, pack_f4z(X0), R[1], 0, 0, 0);
          X1 = __builtin_amdgcn_mfma_f32_16x16x32_bf16(t1f, pack_f4z(Y), z4, 0, 0, 0);
          const bf16x8 x01 = pack_f4f4(X0, X1);
          Y = __builtin_amdgcn_mfma_f32_16x16x32_bf16(n2f, x01, R[2], 0, 0, 0);
          X2 = __builtin_amdgcn_mfma_f32_16x16x32_bf16(t2f, pack_f4z(Y), z4, 0, 0, 0);
          Y = __builtin_amdgcn_mfma_f32_16x16x32_bf16(n3f, x01, R[3], 0, 0, 0);
          Y = __builtin_amdgcn_mfma_f32_16x16x32_bf16(n3g, pack_f4z(X2), Y, 0, 0, 0);
          X3 = __builtin_amdgcn_mfma_f32_16x16x32_bf16(t3f, pack_f4z(Y), z4, 0, 0, 0);
          const float sgn = part ? -1.f : 1.f;
          const bf16x8 xb0 = pack_f4f4(X0 * sgn, X1 * sgn), xb1 = pack_f4f4(X2 * sgn, X3 * sgn);
          const int q4 = (lane & 15) >> 2, pp = lane & 3;
          const LAS unsigned char* qkl = QKL + d * 9216; const LAS unsigned char* qtl = QT + d * 9216;
          bf16* pA = (d == 0 || part == 1) ? P + tok0 * PLD + h * 64 + (part ? (d ? SAB : SAF) : SBF) : XB2 + tok0 * 512 + h * 64;
          bf16* pC = (d == 0 || part == 1) ? P + tok0 * PLD + h * 64 + (part ? (d ? SCB : SCF) : SDF) : XB2 + (size_t)M * 512 + tok0 * 512 + h * 64;
          const size_t pit = (d == 0 || part == 1) ? PLD : 512;
          const int pc = dn_pcol(colb + cc);
#pragma unroll
          for (int mt = 0; mt < 4; ++mt) {
              s16x4 klo[2], khi[2]; bf16x8 qkf[2]; f32x4 acc2;
              { const unsigned ka = (unsigned)(uintptr_t)(KT + d * 10240) + (4 * g + q4) * 160u + (16 * mt + 4 * pp) * 2u;
                asm volatile("ds_read_b64_tr_b16 %0, %1" : "=&v"(klo[0]) : "v"(ka) : "memory");
                asm volatile("ds_read_b64_tr_b16 %0, %1 offset:2560" : "=&v"(khi[0]) : "v"(ka) : "memory");
                asm volatile("ds_read_b64_tr_b16 %0, %1 offset:5120" : "=&v"(klo[1]) : "v"(ka) : "memory");
                asm volatile("ds_read_b64_tr_b16 %0, %1 offset:7680" : "=&v"(khi[1]) : "v"(ka) : "memory"); }
#pragma unroll
              for (int ks = 0; ks < 2; ++ks) { if (ks == 1 && mt < 2) continue; qkf[ks] = frag_2(qkl + (16 * mt + cc) * 144 + (32 * ks + 4 * g) * 2); }
#pragma unroll
              for (int r = 0; r < 4; ++r) acc2[r] = part ? __uint_as_float((unsigned)(*(const LAS bf16*)(qtl + (16 * mt + 4 * g + r) * 144 + (colb + cc) * 2)) << 16) : 0.f;
              asm volatile("s_waitcnt lgkmcnt(0)" ::: "memory"); __builtin_amdgcn_sched_barrier(0);
              f32x4 acc = z4;
#pragma unroll
              for (int ks = 0; ks < 2; ++ks) { const bf16x8 kf = (bf16x8){klo[ks][0], klo[ks][1], klo[ks][2], klo[ks][3], khi[ks][0], khi[ks][1], khi[ks][2], khi[ks][3]};
                  acc = __builtin_amdgcn_mfma_f32_16x16x32_bf16(kf, ks ? xb1 : xb0, acc, 0, 0, 0); }
#pragma unroll
              for (int ks = 0; ks < 2; ++ks) { if (ks == 1 && mt < 2) continue; acc2 = __builtin_amdgcn_mfma_f32_16x16x32_bf16(qkf[ks], ks ? xb1 : xb0, acc2, 0, 0, 0); }
              if (part == 0) {
                  u32x2 o; o.x = pk2(acc[0], acc[1]); o.y = pk2(acc[2], acc[3]); *(u32x2*)(pA + (size_t)(colb + cc) * pit + 16 * mt + 4 * g) = o;
                  o.x = pk2(acc2[0], acc2[1]); o.y = pk2(acc2[2], acc2[3]); *(u32x2*)(pC + (size_t)(colb + cc) * pit + 16 * mt + 4 * g) = o; }
              else {
#pragma unroll
                  for (int r = 0; r < 4; ++r) { pA[(size_t)(16 * mt + 4 * g + r) * pit + pc] = (bf16)(pk2(acc[r], 0.f) & 0xffffu); pC[(size_t)(16 * mt + 4 * g + r) * pit + pc] = (bf16)(pk2(acc2[r], 0.f) & 0xffffu); } }
              __builtin_amdgcn_sched_barrier(0);
          }
          asm volatile("" ::: "memory"); __builtin_amdgcn_sched_barrier(0);
      } }
    LDS_WAIT(); __syncthreads();
  }
#undef DN_PREFETCH
}

constexpr int DNX_A = 0, DNX_C = 8192, DNX_BT = 16384, DNX_DT = 24576, DNX_EG = 32768, DNX_SZ = 33792, DNX_OST = 3 * DNX_SZ;
__device__ __forceinline__ void dn_scan_step(const LAS unsigned char* buf, f32x4 (&Sacc)[4], int ws, int lane, LAS unsigned char* ost, int dir) {
    const int c = lane & 15, g = lane >> 4;
    const unsigned trow = 16 * ws + c, t0 = trow * 128u + ((((unsigned)(g >> 1)) ^ ((trow >> 1) & 7u)) << 4) + 8u * (g & 1);
    u32x2 bt[4], dt[4]; bf16x8 af[4][2], cf[4][2];
#pragma unroll
    for (int mt = 0; mt < 4; ++mt) { const unsigned row = 16 * mt + c, a0 = row * 128u + ((((unsigned)g) ^ ((row >> 1) & 7u)) << 4);
        bt[mt] = *(const LAS u32x2*)(buf + DNX_BT + (t0 ^ ((unsigned)mt << 5)));
#pragma unroll
        for (int ks = 0; ks < 2; ++ks) af[mt][ks] = *(const LAS bf16x8*)(buf + DNX_A + (a0 ^ ((unsigned)ks << 6))); }
#pragma unroll
    for (int mt = 0; mt < 4; ++mt) { const unsigned row = 16 * mt + c, a0 = row * 128u + ((((unsigned)g) ^ ((row >> 1) & 7u)) << 4);
        dt[mt] = *(const LAS u32x2*)(buf + DNX_DT + (t0 ^ ((unsigned)mt << 5)));
#pragma unroll
        for (int ks = 0; ks < 2; ++ks) cf[mt][ks] = *(const LAS bf16x8*)(buf + DNX_C + (a0 ^ ((unsigned)ks << 6))); }
    const float gm = ((const LAS float*)(buf + DNX_EG))[63];
    bf16x8 Sb[2];
#pragma unroll
    for (int ks = 0; ks < 2; ++ks) Sb[ks] = pack_f4f4(Sacc[2 * ks], Sacc[2 * ks + 1]);
    __builtin_amdgcn_sched_barrier(0);
#pragma unroll
    for (int mt = 0; mt < 4; ++mt) { f32x4 sn = Sacc[mt] * gm + (f32x4){bf_lo(bt[mt].x), bf_hi(bt[mt].x), bf_lo(bt[mt].y), bf_hi(bt[mt].y)};
#pragma unroll
        for (int ks = 0; ks < 2; ++ks) sn = __builtin_amdgcn_mfma_f32_16x16x32_bf16(af[mt][ks], Sb[ks], sn, 0, 0, 0);
        Sacc[mt] = sn; }
#pragma unroll
    for (int mt = 0; mt < 4; ++mt) { f32x4 oa = (f32x4){bf_lo(dt[mt].x), bf_hi(dt[mt].x), bf_lo(dt[mt].y), bf_hi(dt[mt].y)};
#pragma unroll
        for (int ks = 0; ks < 2; ++ks) oa = __builtin_amdgcn_mfma_f32_16x16x32_bf16(cf[mt][ks], Sb[ks], oa, 0, 0, 0);
#pragma unroll
        for (int r = 0; r < 4; ++r) { const int p = 16 * mt + 4 * g + r, i = dir ? 63 - p : p;
            *(LAS bf16*)(ost + i * 128 + (16 * ws + c) * 2) = (bf16)(pk2(oa[r], 0.f) & 0xffffu); } }
}
__device__ __forceinline__ void dn_scan_unit(Frame& F, const Args& a, int b, int h, int dir) {
    bf16* P = (bf16*)(a.ws + WS_P);
    const int w = F.wave, lane = F.lane;
#define DN_BAR() do { asm volatile("s_waitcnt lgkmcnt(0)" ::: "memory"); __builtin_amdgcn_s_barrier(); asm volatile("" ::: "memory"); } while (0)
    if (w < 4) {
        f32x4 Sacc[4];
#pragma unroll
        for (int mt = 0; mt < 4; ++mt) Sacc[mt] = (f32x4){0.f, 0.f, 0.f, 0.f};
        bf16* Ob = P + (size_t)b * SEQ * PLD + (dir ? C_OB : C_OF) + h * 64;
        DN_BAR();
        int slot = 0;
#pragma unroll 1
        for (int s = 0; s <= 128; ++s) {
            if (s > 0) { const int cp = dir ? 128 - s : s - 1; const LAS unsigned char* st = F.lds + DNX_OST + ((s - 1) & 1) * 8192;
#pragma unroll
                for (int k = 0; k < 2; ++k) { const int idx = F.tid + 256 * k, row = idx >> 3, ch = idx & 7;
                    *(u32x4*)(Ob + ((size_t)cp * 64 + row) * PLD + ch * 8) = *(const LAS u32x4*)(st + row * 128 + ch * 16); } }
            if (s < 128) dn_scan_step(F.lds + slot * DNX_SZ, Sacc, w, lane, F.lds + DNX_OST + (s & 1) * 8192, dir);
            slot = slot == 2 ? 0 : slot + 1;
            DN_BAR();
        }
    } else {
        const int hw = w - 4;
        const bf16* XB2 = (const bf16*)a.out + (size_t)M * 1024;
        const float* BAg = (const float*)(a.ws + WS_BA);
        const char* gp[8]; long gstep[8];
#pragma unroll
        for (int i = 0; i < 8; ++i) { const int pid = hw * 8 + i, blk = pid >> 3, pc = pid & 7, r = 8 * pc + (lane >> 3), cp = lane & 7;
            const int key = (r >> 1) & 7, cs = cp ^ key;
            const size_t tokb = (size_t)b * SEQ;
            if (dir == 1 && blk >= 2) { gp[i] = (const char*)(XB2 + (size_t)(blk - 2) * M * 512 + (tokb + r) * 512 + h * 64 + cs * 8); gstep[i] = 64L * 512 * 2; }
            else { const int col = blk == 0 ? (dir ? SAB : SAF) : blk == 1 ? (dir ? SCB : SCF) : blk == 2 ? SBF : SDF;
                   gp[i] = (const char*)(P + (tokb + r) * PLD + col + h * 64 + cs * 8); gstep[i] = 64L * PLD * 2; } }
        const char* ggc = (const char*)(BAg + ((size_t)b * SEQ + lane) * 32 + dir * 8 + h);
#define DN_ISSUE(n, slot_) do { const int cn_ = dir ? 127 - (n) : (n); LAS unsigned char* sb_ = F.lds + (slot_) * DNX_SZ; \
        _Pragma("unroll") for (int i = 0; i < 8; ++i) { const int pid = hw * 8 + i; \
            __builtin_amdgcn_global_load_lds((const unsigned*)(gp[i] + (long)cn_ * gstep[i]), (LAS unsigned*)(sb_ + (pid >> 3) * 8192 + (pid & 7) * 1024), 16, 0, 0); } \
        __builtin_amdgcn_global_load_lds((const unsigned*)(ggc + (long)cn_ * (64L * 32 * 4)), (LAS unsigned*)(sb_ + DNX_EG + hw * 256), 4, 0, 0); } while (0)
        DN_ISSUE(0, 0); DN_ISSUE(1, 1);
        asm volatile("s_waitcnt vmcnt(9)" ::: "memory");
        DN_BAR();
        int slot2 = 2;
#pragma unroll 1
        for (int s = 0; s <= 128; ++s) {
            if (s + 2 < 128) { DN_ISSUE(s + 2, slot2); asm volatile("s_waitcnt vmcnt(9)" ::: "memory"); }
            else { asm volatile("s_waitcnt vmcnt(0)" ::: "memory"); }
            slot2 = slot2 == 2 ? 0 : slot2 + 1;
            DN_BAR();
        }
#undef DN_ISSUE
    }
#undef DN_BAR
    __syncthreads();
}
__device__ __forceinline__ void dn_combine(Frame& F, const Args& a) {
    bf16* P = (bf16*)(a.ws + WS_P);
    const float* og = a.in[11];
    const int gw = F.vcu * NWAVES + F.wave, NGW = F.G * NWAVES, c0 = F.lane * 8;
    for (int row = gw; row < M; row += NGW) {
        bf16* rp = P + (size_t)row * PLD;
        float of[8], ob[8]; unpack8(*(const u32x4*)(rp + C_OF + c0), of); unpack8(*(const u32x4*)(rp + C_OB + c0), ob);
        float s[8], ss = 0.f;
#pragma unroll
        for (int j = 0; j < 8; ++j) { s[j] = of[j] + ob[j]; ss += s[j] * s[j]; }
        ss += __shfl_xor(ss, 1); ss += __shfl_xor(ss, 2); ss += __shfl_xor(ss, 4);
        const float rstd = __builtin_amdgcn_rsqf(ss * (1.0f / 64) + EPS);
        bf16* zp = rp + C_DZ + c0; float z[8]; unpack8(*(const u32x4*)zp, z);
        const f32x4 g0 = *(const f32x4*)(og + (c0 & 63)), g1 = *(const f32x4*)(og + (c0 & 63) + 4);
        float y[8];
#pragma unroll
        for (int j = 0; j < 4; ++j) { y[j] = s[j] * rstd * g0[j] * siluf_(z[j]); y[4 + j] = s[4 + j] * rstd * g1[j] * siluf_(z[4 + j]); }
        *(u32x4*)zp = pack8(y);
    }
}
__device__ __forceinline__ void ffn_fixup_panel(Frame& F, const Args& a, int pm) {
    bf16* P = (bf16*)(a.ws + WS_P); const float* UE = (const float*)(a.ws + WS_UE);
    const float* cw = a.in[22]; const float* cb = a.in[23];
#pragma unroll 2
    for (int e = F.tid; e < 8 * (DFF / 4); e += 512) { const int k = e / (DFF / 4), ch = (e % (DFF / 4)) * 4, g = pm * 4 + (k >> 1), last = k & 1;
        const int row = g * 64 + (last ? 63 : 0);
        const bool hp = last ? true : (row % SEQ) != 0, hn = last ? (row % SEQ) != SEQ - 1 : true;
        const float* pu = UE + ((size_t)(last ? g : (g > 0 ? g - 1 : 0)) * 4 + (last ? 2 : 3)) * NUP;
        const float* cu = UE + ((size_t)g * 4 + (last ? 3 : 0)) * NUP;
        const float* nu = UE + ((size_t)(last ? (g < 511 ? g + 1 : 511) : g) * 4 + (last ? 0 : 1)) * NUP;
        const f32x4 z = (f32x4){0.f, 0.f, 0.f, 0.f};
        const f32x4 pg = hp ? *(const f32x4*)(pu + ch) : z, pv = hp ? *(const f32x4*)(pu + DFF + ch) : z, ng = hn ? *(const f32x4*)(nu + ch) : z, nv = hn ? *(const f32x4*)(nu + DFF + ch) : z;
        const f32x4 cg = *(const f32x4*)(cu + ch), cv = *(const f32x4*)(cu + DFF + ch);
        const f32x4 gate = *(const f32x4*)(cw + ch) * pg + *(const f32x4*)(cw + NUP + ch) * cg + *(const f32x4*)(cw + 2 * NUP + ch) * ng + *(const f32x4*)(cb + ch);
        const f32x4 val = *(const f32x4*)(cw + DFF + ch) * pv + *(const f32x4*)(cw + NUP + DFF + ch) * cv + *(const f32x4*)(cw + 2 * NUP + DFF + ch) * nv + *(const f32x4*)(cb + DFF + ch);
        u32x2 w; w.x = pk2(siluf_(gate[0]) * val[0], siluf_(gate[1]) * val[1]); w.y = pk2(siluf_(gate[2]) * val[2], siluf_(gate[3]) * val[3]);
        *(u32x2*)(P + (size_t)row * PLD + C_ACT + ch) = w; }
}

__global__ void __launch_bounds__(NWAVES * 64, 2) fwd_kernel(Args args) {
    extern __shared__ __attribute__((aligned(16))) unsigned char lds[];
    Frame F;
    F.lds = (LAS unsigned char*)lds;
    F.MISC = (volatile LAS unsigned*)(F.lds + MISC_OFF);
    F.tid = threadIdx.x; F.lane = F.tid & 63; F.wave = __builtin_amdgcn_readfirstlane(F.tid >> 6);
    F.G = gridDim.x; { const int bx = blockIdx.x; F.vcu = (F.G % 8 == 0) ? (bx % 8) * (F.G / 8) + bx / 8 : bx; }
    unsigned char* ws = args.ws;
    F.ctl = (gu32*)(ws + WS_CTL);
    for (int u = F.tid; u < (LDS_BYTES - LDSCTL_OFF) / 4; u += NWAVES * 64) ((LAS unsigned*)(F.lds + LDSCTL_OFF))[u] = 0u;
    __syncthreads();
    const int lo = args.ph_lo, hi = args.ph_hi;
    const bool single = (hi - lo) > 1;
    XcdBarrier bar; bar.bar = (unsigned*)(F.ctl + CW_BAR); bar.x = 0; bar.st = nullptr;
    if (single) bar = xcd_barrier_post((unsigned*)(F.ctl + CW_BAR), F.MISC + 8);
#ifndef PH_MASK
#define PH_MASK 0x1FF
#endif
#define IN(k) (((PH_MASK >> (k)) & 1) && lo <= (k) && (k) < hi)
#define SEAM(k) do { if (IN(k) && IN((k) + 1)) xcd_barrier(bar); } while (0)
    bf16* P = (bf16*)(ws + WS_P);
    const int bid = (int)blockIdx.x;
#define TS(k) do {} while (0)
#define TSB(k, blk) do {} while (0)
    TS(0);

    if (IN(0)) { p0_prologue(F, args); }
    SEAM(0); TS(1);
    if (IN(1)) {
        { pg8::Gemm g{(const bf16*)args.out, (const bf16*)(ws + WS_WIN), M, 3584, 1024, 1024, 1024}; pg8::StaticOrder S; S.init(M, 3584, F.G, bid);
          EpiInProj E{P, (float*)(ws + WS_BA)};
          pg8::gemm_phase<EpiInProj, pg8::StaticOrder, true, true>(F.lds + RING_OFF, g, S, E); }
        { pg8::Gemm g{(const bf16*)(ws + WS_MEMN), (const bf16*)(ws + WS_WKV), BATCH * NMEM, 1024, 1024, 1024, 1024}; pg8::StaticOrder S; S.init(BATCH * NMEM, 1024, F.G, bid);
          EpiBf16 E{(bf16*)(ws + WS_KV), 1024};
          pg8::gemm_phase<EpiBf16, pg8::StaticOrder, true, true>(F.lds + RING_OFF, g, S, E); }
    }
    SEAM(1); TS(2);
    if (IN(2)) {
        const bool full = F.G == 256; const int nU = full ? 256 : 4096;
        for (int u = bid; u < nU; u += F.G) { const int uu = full ? u * 16 : u; dn_prep_block(F, args, uu >> 10, (uu >> 7) & 7, uu & 127, full ? 16 : 1); }
    }
    TS(12); SEAM(2); TS(3);
    if (IN(3)) {
        const int ndn = F.G >= 128 ? 64 : 0;
        if (args.mode != 2) for (int u = (ndn ? (bid < ndn ? bid : 64) : bid); u < 64; u += (ndn ? 64 : F.G)) dn_scan_unit(F, args, u >> 4, (u >> 1) & 7, u & 1);
        if (bid >= ndn && args.mode != 1) { const int nb = F.G - ndn, me = bid - ndn;
            for (int u = me; u < 1024; u += nb) {
                if (u < 512) attnA_unit(F, args, u >> 7, (u >> 1) & 63, u & 1);
                else { const int v = u - 512; xattn_unit(F, args, v >> 7, (v >> 2) & 31, v & 3); }
            }
            weight_items(F, args, WI_EARLY, WI_ALL, me * NWAVES + F.wave, nb * NWAVES);
        }
    }
    TS(10); TSB(11, 64); SEAM(3); TS(4);
    if (IN(4)) {
        dn_combine(F, args);
        pg8::Gemm g{(const bf16*)args.out, (const bf16*)(ws + WS_WIN) + (size_t)3584 * 1024, M, 3072, 1024, 1024, 1024}; pg8::StaticOrder S; S.init(M, 3072, F.G, bid);
        EpiGatesU8 E{P};
        pg8::gemm_phase<EpiGatesU8, pg8::StaticOrder, true, true>(F.lds + RING_OFF, g, S, E);
    }
    SEAM(4); TS(5);
    if (IN(5)) {
        pg8::Gemm g{P + C_AQ, (const bf16*)(ws + WS_WBR), M, 1024, 1536, PLD, 512};
        g.segt = 8; g.aoff1 = (long)(C_DZ - C_AQ) * 2 - 8 * 128; g.aoff2 = (long)(C_MQ - C_AQ) * 2 - 16 * 128;
        g.boff1 = (long)1024 * 512 * 2 - 8 * 128; g.boff2 = (long)2 * 1024 * 512 * 2 - 16 * 128;
        pg8::StaticOrder S; S.init(M, 1024, F.G, bid);
        EpiMerge E{P}; pg8::gemm_phase<EpiMerge, pg8::StaticOrder, true, true>(F.lds + RING_OFF, g, S, E);
    }
    SEAM(5); TS(6);
    if (IN(6)) {
        pg8::Gemm g{P + C_MG, (const bf16*)(ws + WS_WOUT), M, 1024, 1024, PLD, 1024}; pg8::StaticOrder S; S.init(M, 1024, F.G, bid);
        EpiWout E{args.in[0], args.out, P, (float*)(ws + WS_SSQ), (LAS float*)(F.lds + XCH_OFF)};
        pg8::gemm_phase<EpiWout, pg8::StaticOrder, true, true>(F.lds + RING_OFF, g, S, E);
    }
    SEAM(6); TS(7);
    if (IN(7)) {
        pg8::Gemm g{P + C_X1B, (const bf16*)(ws + WS_WUP), M, NUP, 1024, PLD, 1024}; pg8::StaticOrder S; S.init(M, NUP, F.G, bid);
        EpiUp E{(const float*)(ws + WS_SSQ), args.in[22], args.in[23], P, (float*)(ws + WS_UE), (LAS float*)(F.lds + XCH_OFF)};
        pg8::gemm_phase<EpiUp, pg8::StaticOrder, true, true>(F.lds + RING_OFF, g, S, E);
    }
    SEAM(7); TS(8);
    if (IN(8)) {
        pg8::Gemm g{P + C_ACT, (const bf16*)(ws + WS_WDN), M, 1024, DFF, PLD, DFF}; pg8::StaticOrder S; S.init(M, 1024, F.G, bid);
        { Unit u; int prev = -1; for (int i = 0; S.next(i, u); ++i) { if (u.pm != prev) ffn_fixup_panel(F, args, u.pm); prev = u.pm; } }
        VM_WAIT(); __syncthreads();
        EpiDown E{args.out, P};
        pg8::gemm_phase<EpiDown, pg8::StaticOrder, true, true>(F.lds + RING_OFF, g, S, E);
    }
    TS(9);
#undef IN
#undef SEAM
}

#ifdef DBG_TIME
__global__ void dbg_ts_kernel(unsigned char* ws, int k) { if (threadIdx.x == 0) ((unsigned long long*)(ws + WS_CTL + 65536))[k] = __builtin_amdgcn_s_memrealtime(); }
__global__ void dbg_wait_kernel(unsigned char* ws) {
    if (threadIdx.x == 0) { const unsigned long long* tsb = (const unsigned long long*)(ws + WS_CTL + 65536);
        const unsigned long long te = __builtin_amdgcn_s_memrealtime();
        const unsigned long long d1 = tsb[DBG_A1] - tsb[DBG_A0], d2 = tsb[DBG_B1] - tsb[DBG_B0];
        const unsigned long long W = d1 + 100000ull * (d2 / 1000ull);
        while (__builtin_amdgcn_s_memrealtime() - te < W) __builtin_amdgcn_s_sleep(32); }
}
#endif
constexpr int N_PHASES = 9;
#ifndef MK_PER_PHASE
#define MK_PER_PHASE 0
#endif
extern "C" void kernel_launch(void* const* d_in, const int* in_sizes, int n_in, void* d_out, int out_size, void* d_ws, size_t ws_size, hipStream_t stream) {
    static int grid = 0;
    if (grid == 0) {
        if (n_in != 25 || in_sizes[0] != M * DM || out_size != M * DM || ws_size < WS_END) {
            fprintf(stderr, "kernel_launch: unexpected shapes (n_in %d, in0 %d, out %d, ws %zu); nothing launched\n", n_in, n_in > 0 ? in_sizes[0] : -1, out_size, ws_size); grid = -1; return; }
        int dev = 0, cus = 0, per_cu = 0;
        if (hipGetDevice(&dev) != hipSuccess || hipDeviceGetAttribute(&cus, hipDeviceAttributeMultiprocessorCount, dev) != hipSuccess) { grid = -1; return; }
        if (hipFuncSetAttribute((const void*)fwd_kernel, hipFuncAttributeMaxDynamicSharedMemorySize, LDS_BYTES) != hipSuccess) { fprintf(stderr, "kernel_launch: hipFuncSetAttribute failed\n"); grid = -1; return; }
        if (hipOccupancyMaxActiveBlocksPerMultiprocessor(&per_cu, (const void*)fwd_kernel, NWAVES * 64, LDS_BYTES) != hipSuccess || per_cu < 1) { fprintf(stderr, "kernel_launch: occupancy query reports %d\n", per_cu); }
        (void)hipGetLastError();
        grid = cus;
    }
    if (grid < 0) return;
    if (hipMemsetAsync((char*)d_ws + WS_CTL, 0, CTL_ZERO_BYTES, stream) != hipSuccess) return;
    Args a{};
    for (int i = 0; i < 25; ++i) a.in[i] = (const float*)d_in[i];
    a.out = (float*)d_out; a.ws = (unsigned char*)d_ws;
#ifdef DBG_TIME
    for (int p = 0; p < N_PHASES; ++p) { hipLaunchKernelGGL(dbg_ts_kernel, dim3(1), dim3(64), 0, stream, (unsigned char*)d_ws, p);
        a.ph_lo = p; a.ph_hi = p + 1;
        if (p == 3) { a.mode = 1; hipLaunchKernelGGL(fwd_kernel, dim3(grid), dim3(NWAVES * 64), LDS_BYTES, stream, a); hipLaunchKernelGGL(dbg_ts_kernel, dim3(1), dim3(64), 0, stream, (unsigned char*)d_ws, 12); a.mode = 2; }
        hipLaunchKernelGGL(fwd_kernel, dim3(grid), dim3(NWAVES * 64), LDS_BYTES, stream, a); a.mode = 0; }
    hipLaunchKernelGGL(dbg_ts_kernel, dim3(1), dim3(64), 0, stream, (unsigned char*)d_ws, N_PHASES);
    hipLaunchKernelGGL(dbg_wait_kernel, dim3(1), dim3(64), 0, stream, (unsigned char*)d_ws);
    return;
#endif
    if (MK_PER_PHASE) {
        for (int p = 0; p < N_PHASES; ++p) { a.ph_lo = p; a.ph_hi = p + 1; hipLaunchKernelGGL(fwd_kernel, dim3(grid), dim3(NWAVES * 64), LDS_BYTES, stream, a); }
    } else {
        a.ph_lo = 0; a.ph_hi = N_PHASES; hipLaunchKernelGGL(fwd_kernel, dim3(grid), dim3(NWAVES * 64), LDS_BYTES, stream, a);
    }
}
```

```cpp
#include <hip/hip_runtime.h>
#include <cstdio>
#include <cstdint>
#include <cmath>
namespace pg8 {
#define PG8_LAS __attribute__((address_space(3)))
typedef unsigned short bf16_t;
typedef short bf16x8 __attribute__((ext_vector_type(8)));
typedef float f32x4 __attribute__((ext_vector_type(4)));
typedef unsigned u32x4 __attribute__((ext_vector_type(4)));
constexpr int BM = 256, BK = 64, HALF = 128, HTB = HALF * BK * 2  , STAGE_BYTES = 8 * HTB, NXCD = 8, WGM = 8;

__host__ __device__ __forceinline__ int lds_byte(int r, int c) { const int st = (r >> 4) * 2 + (c >> 5), rr = r & 15, cc = c & 31, ob = rr * 64 + cc * 2; return st * 1024 + (ob ^ (((ob >> 9) & 1) << 5)); }
__host__ __device__ __forceinline__ void stage_rc(int b, int& R, int& C) { const int st = b / 1024, sb = b % 1024, swz = sb ^ (((sb >> 9) & 1) << 5); R = (st >> 1) * 16 + swz / 64; C = (st & 1) * 32 + (swz % 64) / 2; }
__host__ __device__ __forceinline__ int perm32(int rho) { const int n = rho >> 4, i = rho & 15; return 8 * (i >> 2) + 4 * n + (i & 3); }

struct Unit { int pm, pn, aux; };
struct Gemm { const bf16_t* A; const bf16_t* Bt; int M, N, K, lda, ldb; int segt = 1 << 30; long aoff1 = 0, aoff2 = 0, boff1 = 0, boff2 = 0; };

struct StaticOrder {
    int nM, nN, nwg, G, c;
    __host__ __device__ __forceinline__ void init(int M, int N, int G_, int c_) { nM = M / BM; nN = N / BM; nwg = nM * nN; G = G_; c = c_; }
    __host__ __device__ __forceinline__ bool next(int i, Unit& u) const {
        const long L = (long)i * G + c; if (L >= nwg) return false;
        int wgid = (int)L; { const int q = nwg / NXCD, r = nwg % NXCD, xcd = wgid % NXCD, off = wgid / NXCD; wgid = (xcd < r ? xcd * (q + 1) : r * (q + 1) + (xcd - r) * q) + off; }
        const int nig = WGM * nN, gid = wgid / nig, fm = gid * WGM, gsz = (nM - fm) < WGM ? (nM - fm) : WGM;
        u.pm = fm + ((wgid % nig) % gsz); u.pn = (wgid % nig) / gsz; return true;
    }
    __device__ __forceinline__ void a_ready(const Unit&) const {}
    __device__ __forceinline__ void done(const Unit&) const {}
};

template <class Epi, class Sched, bool ALIGN_EPI = false, bool SP2 = false>
__device__ __forceinline__ void gemm_phase(PG8_LAS unsigned char* lds, const Gemm g, const Sched& S, const Epi& E) {
    const int tid = threadIdx.x, wid = __builtin_amdgcn_readfirstlane(tid >> 6), lane = tid & 63, wr = wid >> 2, wc = wid & 3, fr = lane & 15, fq = lane >> 4;
    const int K = g.K, nt = K / BK;
    unsigned voffA[2], voffB[2];
#pragma unroll
    for (int i = 0; i < 2; ++i) { int R, C; stage_rc(tid * 16 + i * 8192, R, C); const int Rb = Epi::PERM ? ((R & ~31) + perm32(R & 31)) : R;
        voffA[i] = (unsigned)(R * g.lda + C) * 2u; voffB[i] = (unsigned)(Rb * g.ldb + C) * 2u; }
    const size_t kstep = (size_t)(BK * 2);
    const size_t hstepA = (size_t)HALF * g.lda * 2, hstepB = (size_t)HALF * g.ldb * 2;
    const size_t tstepA = 2 * hstepA, tstepB = 2 * hstepB;
    const unsigned ldsw = (unsigned)wid * 1024u;
    const int aoff = lds_byte(wr * 64 + fr, fq * 8), boff = lds_byte(wc * 32 + fr, fq * 8);
#define PG8_SA(b, h) (((b) * 2 + (h)) * HTB)
#define PG8_SB(b, h) ((4 + (b) * 2 + (h)) * HTB)
#define PG8_STAGE(bufoff, gbase, voff) do { _Pragma("unroll") for (int _i = 0; _i < 2; ++_i) \
        __builtin_amdgcn_global_load_lds((const unsigned*)((const char*)(gbase) + (voff)[_i]), (PG8_LAS unsigned*)(lds + (bufoff) + ldsw + _i * 8192), 16, 0, 0); } while (0)
#define PG8_LDA(dst, b, h) do { _Pragma("unroll") for (int m = 0; m < 4; ++m) _Pragma("unroll") for (int k = 0; k < 2; ++k) dst[m][k] = *(const PG8_LAS bf16x8*)(lds + PG8_SA(b, h) + aoff + m * 2048 + k * 1024); } while (0)
#define PG8_LDB(dst, b, h) do { _Pragma("unroll") for (int n = 0; n < 2; ++n) _Pragma("unroll") for (int k = 0; k < 2; ++k) dst[n][k] = *(const PG8_LAS bf16x8*)(lds + PG8_SB(b, h) + boff + n * 2048 + k * 1024); } while (0)
#define PG8_MMA(ai, bj, At, Bt) do { __builtin_amdgcn_s_setprio(1); _Pragma("unroll") for (int m = 0; m < 4; ++m) _Pragma("unroll") for (int n = 0; n < 2; ++n) _Pragma("unroll") for (int k = 0; k < 2; ++k) \
        acc[ai][bj][m][n] = __builtin_amdgcn_mfma_f32_16x16x32_bf16(Bt[n][k], At[m][k], acc[ai][bj][m][n], 0, 0, 0); __builtin_amdgcn_s_setprio(0); } while (0)
#define PG8_WAIT_V(n) asm volatile("s_waitcnt vmcnt(" #n ")" ::: "memory")
#define PG8_WAIT_L(n) asm volatile("s_waitcnt lgkmcnt(" #n ")" ::: "memory")
#define PG8_BAR __builtin_amdgcn_s_barrier()
#define PG8_SCHED __builtin_amdgcn_sched_barrier(0)
    Unit cur, nxt; int ui = 0;
    if (!S.next(0, cur)) return;
    if constexpr (Epi::PREFETCH) E.prefetch(cur, 0, tid);
    f32x4 acc[2][2][4][2];
#pragma unroll
    for (int a = 0; a < 2; ++a)
#pragma unroll
        for (int b = 0; b < 2; ++b)
#pragma unroll
            for (int m = 0; m < 4; ++m)
#pragma unroll
                for (int n = 0; n < 2; ++n) acc[a][b][m][n] = (f32x4){0.f, 0.f, 0.f, 0.f};
    bf16x8 At[4][2], B0[2][2], B1[2][2];
    const char* cA = (const char*)g.A + (size_t)cur.pm * tstepA; const char* cB = (const char*)g.Bt + (size_t)cur.pn * tstepB;
    S.a_ready(cur);
    if constexpr (SP2) {
        PG8_STAGE(PG8_SB(0, 0), cB, voffB); PG8_STAGE(PG8_SB(0, 1), cB + hstepB, voffB); PG8_STAGE(PG8_SA(0, 0), cA, voffA); PG8_STAGE(PG8_SA(0, 1), cA + hstepA, voffA);
        if (wr == 1) PG8_BAR;
        PG8_WAIT_V(2); PG8_BAR;
        PG8_STAGE(PG8_SB(1, 0), cB + kstep, voffB); PG8_STAGE(PG8_SA(1, 0), cA + kstep, voffA); PG8_STAGE(PG8_SB(1, 1), cB + hstepB + kstep, voffB);
        PG8_WAIT_V(6); PG8_BAR;
    } else {
        PG8_STAGE(PG8_SB(0, 0), cB, voffB); PG8_STAGE(PG8_SA(0, 0), cA, voffA); PG8_STAGE(PG8_SB(0, 1), cB + hstepB, voffB); PG8_STAGE(PG8_SA(0, 1), cA + hstepA, voffA);
        if (wr == 1) PG8_BAR;
        PG8_WAIT_V(4); PG8_BAR;
        PG8_STAGE(PG8_SB(1, 0), cB + kstep, voffB); PG8_STAGE(PG8_SA(1, 0), cA + kstep, voffA); PG8_STAGE(PG8_SB(1, 1), cB + hstepB + kstep, voffB);
        PG8_WAIT_V(6); PG8_BAR;
    }
    for (;;) {
        const bool has_next = S.next(ui + 1, nxt);
        const char* nA = has_next ? (const char*)g.A + (size_t)nxt.pm * tstepA : cA; const char* nB = has_next ? (const char*)g.Bt + (size_t)nxt.pn * tstepB : cB;
        for (int t = 0; t < nt; t += 2) {
            const bool last = (t == nt - 2);
            if constexpr (Epi::RESCALE) { if (t == g.segt || t == 2 * g.segt) E.rescale(acc, cur, wr, wc, fr, fq, t / g.segt); }
            const long so1 = (t + 1 >= 2 * g.segt) ? g.aoff2 : ((t + 1 >= g.segt) ? g.aoff1 : 0), so2 = (t + 2 >= 2 * g.segt) ? g.aoff2 : ((t + 2 >= g.segt) ? g.aoff1 : 0), sb2 = (t + 2 >= 2 * g.segt) ? g.boff2 : ((t + 2 >= g.segt) ? g.boff1 : 0);
            const char* a1 = cA + so1 + (size_t)(t + 1) * kstep;
            const char* a2 = last ? nA : cA + so2 + (size_t)(t + 2) * kstep; const char* b2 = last ? nB : cB + sb2 + (size_t)(t + 2) * kstep;
            const char* a3 = a2 + kstep; const char* b3 = b2 + kstep;
            if (last && has_next) S.a_ready(nxt);
            if constexpr (SP2) {
            PG8_LDB(B0, 0, 0); PG8_LDB(B1, 0, 1); PG8_SCHED; PG8_LDA(At, 0, 0); PG8_STAGE(PG8_SA(1, 1), a1 + hstepA, voffA);
            PG8_WAIT_V(8); PG8_WAIT_L(0); PG8_BAR; PG8_MMA(0, 0, At, B0); PG8_MMA(0, 1, At, B1); PG8_BAR; PG8_SCHED;
            PG8_LDA(At, 0, 1); PG8_STAGE(PG8_SB(0, 0), b2, voffB); PG8_STAGE(PG8_SB(0, 1), b2 + hstepB, voffB); PG8_STAGE(PG8_SA(0, 0), a2, voffA);
            PG8_WAIT_V(8); PG8_WAIT_L(0); PG8_BAR; PG8_MMA(1, 0, At, B0); PG8_MMA(1, 1, At, B1); PG8_BAR; PG8_SCHED;
            PG8_LDB(B0, 1, 0); PG8_LDB(B1, 1, 1); PG8_SCHED; PG8_LDA(At, 1, 0); PG8_STAGE(PG8_SA(0, 1), a2 + hstepA, voffA);
            PG8_WAIT_V(8); PG8_WAIT_L(0); PG8_BAR; PG8_MMA(0, 0, At, B0); PG8_MMA(0, 1, At, B1); PG8_BAR; PG8_SCHED;
            PG8_LDA(At, 1, 1); PG8_STAGE(PG8_SB(1, 0), b3, voffB); PG8_STAGE(PG8_SB(1, 1), b3 + hstepB, voffB); PG8_STAGE(PG8_SA(1, 0), a3, voffA);
            PG8_WAIT_V(8); PG8_WAIT_L(0); PG8_BAR; PG8_MMA(1, 0, At, B0); PG8_MMA(1, 1, At, B1); PG8_BAR; PG8_SCHED;
            } else {
            PG8_LDB(B0, 0, 0); PG8_SCHED; PG8_LDA(At, 0, 0); PG8_STAGE(PG8_SA(1, 1), a1 + hstepA, voffA);
            PG8_WAIT_L(8); PG8_BAR; PG8_WAIT_L(0); PG8_MMA(0, 0, At, B0); PG8_BAR; PG8_SCHED;
            PG8_LDB(B1, 0, 1); PG8_STAGE(PG8_SB(0, 0), b2, voffB);
            PG8_BAR; PG8_WAIT_L(0); PG8_MMA(0, 1, At, B1); PG8_BAR;
            PG8_LDA(At, 0, 1); PG8_STAGE(PG8_SA(0, 0), a2, voffA);
            PG8_BAR; PG8_WAIT_L(0); PG8_MMA(1, 0, At, B0); PG8_BAR; PG8_SCHED;
            PG8_STAGE(PG8_SB(0, 1), b2 + hstepB, voffB);
            PG8_WAIT_V(6); PG8_BAR; PG8_MMA(1, 1, At, B1); PG8_BAR;
            PG8_LDB(B0, 1, 0); PG8_SCHED; PG8_LDA(At, 1, 0); PG8_STAGE(PG8_SA(0, 1), a2 + hstepA, voffA);
            PG8_WAIT_L(8); PG8_BAR; PG8_WAIT_L(0); PG8_MMA(0, 0, At, B0); PG8_BAR; PG8_SCHED;
            PG8_LDB(B1, 1, 1); PG8_STAGE(PG8_SB(1, 0), b3, voffB);
            PG8_BAR; PG8_WAIT_L(0); PG8_MMA(0, 1, At, B1); PG8_BAR;
            PG8_LDA(At, 1, 1); PG8_STAGE(PG8_SA(1, 0), a3, voffA);
            PG8_BAR; PG8_WAIT_L(0); PG8_MMA(1, 0, At, B0); PG8_BAR; PG8_SCHED;
            PG8_STAGE(PG8_SB(1, 1), b3 + hstepB, voffB);
            PG8_WAIT_V(6); PG8_BAR; PG8_MMA(1, 1, At, B1); PG8_BAR;
            }
        }
        if constexpr (ALIGN_EPI) { if (wr == 0) PG8_BAR; }
        if constexpr (Epi::PREFETCH) cur.aux = ui & 1;
        if constexpr (!Epi::AFTER_DRAIN) { E(acc, cur, wr, wc, fr, fq); S.done(cur); }
        if constexpr (Epi::PREFETCH) { if (has_next) E.prefetch(nxt, (ui + 1) & 1, tid); }
        if (!has_next) break;
#pragma unroll
        for (int a = 0; a < 2; ++a)
#pragma unroll
            for (int b = 0; b < 2; ++b)
#pragma unroll
                for (int m = 0; m < 4; ++m)
#pragma unroll
                    for (int n = 0; n < 2; ++n) acc[a][b][m][n] = (f32x4){0.f, 0.f, 0.f, 0.f};
        cur = nxt; cA = nA; cB = nB; ++ui;
        if constexpr (ALIGN_EPI) { if (wr == 1) PG8_BAR; }
    }
    PG8_WAIT_V(0);
    if constexpr (!ALIGN_EPI) { if (wr == 0) PG8_BAR; }
    PG8_BAR;
    if constexpr (Epi::AFTER_DRAIN) { E.fused(acc, cur, wr, wc, fr, fq, lds, wid, lane); S.done(cur); }
#undef PG8_SA
#undef PG8_SB
#undef PG8_STAGE
#undef PG8_LDA
#undef PG8_LDB
#undef PG8_MMA
#undef PG8_WAIT_V
#undef PG8_WAIT_L
#undef PG8_BAR
#undef PG8_SCHED
}
}

#define LAS __attribute__((address_space(3)))
#define GAS __attribute__((address_space(1)))
typedef unsigned short bf16;
typedef short bf16x8 __attribute__((ext_vector_type(8)));
typedef short s16x4 __attribute__((ext_vector_type(4)));
typedef float f32x4 __attribute__((ext_vector_type(4)));
typedef float f32x16 __attribute__((ext_vector_type(16)));
typedef unsigned u32x4 __attribute__((ext_vector_type(4)));
typedef unsigned u32x2 __attribute__((ext_vector_type(2)));
typedef float f32x2_t __attribute__((ext_vector_type(2)));
typedef __bf16 bf16x2_t __attribute__((ext_vector_type(2)));

constexpr int BATCH = 4, SEQ = 8192, DM = 1024, M = BATCH * SEQ;
constexpr int NMEM = 256;
constexpr int PLD = 6400;
constexpr int C_AQ = 0, C_AK = 512, C_AV = 640, C_DQ = 768, C_DK = 1280, C_DV = 1792, C_DZ = 2304, C_MQ = 2816, C_GATE = 3328;
constexpr int C_MG = 768, C_X1B = 1792, C_ACT = 2816;
constexpr int NIN = 6656;
constexpr int DFF = 2816, NUP = 5632;
constexpr float EPS = 1e-6f;
constexpr float LOG2E = 1.4426950408889634f;

__device__ __forceinline__ float bf_lo(unsigned w) { return __uint_as_float(w << 16); }
__device__ __forceinline__ float bf_hi(unsigned w) { return __uint_as_float(w & 0xffff0000u); }
__device__ __forceinline__ unsigned pk2(float lo, float hi) { f32x2_t v = {lo, hi}; bf16x2_t b = __builtin_convertvector(v, bf16x2_t); return __builtin_bit_cast(unsigned, b); }
__device__ __forceinline__ float fexp2(float x) { return __builtin_amdgcn_exp2f(x); }
__device__ __forceinline__ float frcp(float x) { return __builtin_amdgcn_rcpf(x); }
__device__ __forceinline__ float sigmoidf_(float x) { return frcp(1.0f + fexp2(-x * LOG2E)); }
__device__ __forceinline__ float siluf_(float x) { return x * sigmoidf_(x); }
__device__ __forceinline__ void unpack8(const u32x4 w, float (&v)[8]) {
    v[0] = bf_lo(w.x); v[1] = bf_hi(w.x); v[2] = bf_lo(w.y); v[3] = bf_hi(w.y); v[4] = bf_lo(w.z); v[5] = bf_hi(w.z); v[6] = bf_lo(w.w); v[7] = bf_hi(w.w); }
__device__ __forceinline__ u32x4 pack8(const float (&v)[8]) { u32x4 w; w.x = pk2(v[0], v[1]); w.y = pk2(v[2], v[3]); w.z = pk2(v[4], v[5]); w.w = pk2(v[6], v[7]); return w; }

template <int CTRL, int ROWMASK> __device__ __forceinline__ float dpp_add(float x) {
    return x + __builtin_bit_cast(float, __builtin_amdgcn_update_dpp(0, __builtin_bit_cast(int, x), CTRL, ROWMASK, 0xF, false)); }
__device__ __forceinline__ float wave_sum_dpp(float x) {
    x = dpp_add<0xB1, 0xF>(x); x = dpp_add<0x4E, 0xF>(x); x = dpp_add<0x141, 0xF>(x); x = dpp_add<0x140, 0xF>(x);
    x = dpp_add<0x142, 0xA>(x); x = dpp_add<0x143, 0xC>(x);
    return __builtin_bit_cast(float, __builtin_amdgcn_readlane(__builtin_bit_cast(int, x), 63)); }
__device__ __forceinline__ float wave_scan_dpp(float x) {
    x = dpp_add<0x111, 0xF>(x); x = dpp_add<0x112, 0xF>(x); x = dpp_add<0x114, 0xF>(x); x = dpp_add<0x118, 0xF>(x);
    x = dpp_add<0x142, 0xA>(x); x = dpp_add<0x143, 0xC>(x);
    return x; }
__device__ __forceinline__ float group8_sum_dpp(float x) { x = dpp_add<0xB1, 0xF>(x); x = dpp_add<0x4E, 0xF>(x); return dpp_add<0x141, 0xF>(x); }
__device__ __forceinline__ float group16_sum_dpp(float x) { return dpp_add<0x140, 0xF>(group8_sum_dpp(x)); }
using pg8::Unit;
constexpr int HALF = pg8::HALF, BM = pg8::BM;

struct EpiInProj {
    static constexpr bool PERM = true, AFTER_DRAIN = false, PREFETCH = false, RESCALE = false;
    bf16* P; float* BA;
    __device__ __forceinline__ void operator()(const f32x4 (&acc)[2][2][4][2], const Unit& u, int wr, int wc, int fr, int fq) const {
        const int row0 = u.pm * BM + wr * 64 + fr;
        if (u.pn < 13) {
            const int col0 = u.pn * BM + wc * 32 + 8 * fq;
#pragma unroll
            for (int ai = 0; ai < 2; ++ai)
#pragma unroll
                for (int m = 0; m < 4; ++m) { bf16* rowp = P + (size_t)(row0 + ai * HALF + m * 16) * PLD + col0;
#pragma unroll
                    for (int bj = 0; bj < 2; ++bj) { const f32x4 v0 = acc[ai][bj][m][0], v1 = acc[ai][bj][m][1];
                        u32x4 w; w.x = pk2(v0[0], v0[1]); w.y = pk2(v0[2], v0[3]); w.z = pk2(v1[0], v1[1]); w.w = pk2(v1[2], v1[3]);
                        *(u32x4*)(rowp + bj * HALF) = w; } }
        } else if (wc == 0) {
#pragma unroll
            for (int ai = 0; ai < 2; ++ai)
#pragma unroll
                for (int m = 0; m < 4; ++m) { float* rp = BA + (size_t)(row0 + ai * HALF + m * 16) * 32 + 8 * fq;
                    *(f32x4*)rp = acc[ai][0][m][0]; *(f32x4*)(rp + 4) = acc[ai][0][m][1]; }
        }
    }
};
struct EpiBf16 {
    static constexpr bool PERM = true, AFTER_DRAIN = false, PREFETCH = false, RESCALE = false;
    bf16* O; int ldc;
    __device__ __forceinline__ void operator()(const f32x4 (&acc)[2][2][4][2], const Unit& u, int wr, int wc, int fr, int fq) const {
        const int row0 = u.pm * BM + wr * 64 + fr, col0 = u.pn * BM + wc * 32 + 8 * fq;
#pragma unroll
        for (int ai = 0; ai < 2; ++ai)
#pragma unroll
            for (int m = 0; m < 4; ++m) { bf16* rowp = O + (size_t)(row0 + ai * HALF + m * 16) * ldc + col0;
#pragma unroll
                for (int bj = 0; bj < 2; ++bj) { const f32x4 v0 = acc[ai][bj][m][0], v1 = acc[ai][bj][m][1];
                    u32x4 w; w.x = pk2(v0[0], v0[1]); w.y = pk2(v0[2], v0[3]); w.z = pk2(v1[0], v1[1]); w.w = pk2(v1[2], v1[3]);
                    *(u32x4*)(rowp + bj * HALF) = w; } }
    }
};
template <int PASS> struct EpiBranch {
    static constexpr bool PERM = true, AFTER_DRAIN = false, PREFETCH = false, RESCALE = false;
    bf16* P;
    __device__ __forceinline__ void operator()(const f32x4 (&acc)[2][2][4][2], const Unit& u, int wr, int wc, int fr, int fq) const {
        const int row0 = u.pm * BM + wr * 64 + fr, col0 = u.pn * BM + wc * 32 + 8 * fq;
#pragma unroll
        for (int ai = 0; ai < 2; ++ai)
#pragma unroll
            for (int m = 0; m < 4; ++m) { bf16* rowp = P + (size_t)(row0 + ai * HALF + m * 16) * PLD;
#pragma unroll
                for (int bj = 0; bj < 2; ++bj) {
                    const int c = col0 + bj * HALF;
                    const u32x4 gw = *(const u32x4*)(rowp + C_GATE + 1024 * PASS + c);
                    float g[8]; unpack8(gw, g);
                    float pv[8];
                    if (PASS > 0) { const u32x4 mw = *(const u32x4*)(rowp + C_MG + c); unpack8(mw, pv); }
                    else {
#pragma unroll
                        for (int i = 0; i < 8; ++i) pv[i] = 0.f; }
                    const f32x4 v0 = acc[ai][bj][m][0], v1 = acc[ai][bj][m][1];
                    float o[8];
#pragma unroll
                    for (int i = 0; i < 4; ++i) { o[i] = pv[i] + sigmoidf_(g[i]) * v0[i]; o[4 + i] = pv[4 + i] + sigmoidf_(g[4 + i]) * v1[i]; }
                    *(u32x4*)(rowp + C_MG + c) = pack8(o); } }
    }
};
struct EpiGatesU8 {
    static constexpr bool PERM = true, AFTER_DRAIN = false, PREFETCH = false, RESCALE = false;
    bf16* P;
    __device__ __forceinline__ void operator()(const f32x4 (&acc)[2][2][4][2], const Unit& u, int wr, int wc, int fr, int fq) const {
        const int row0 = u.pm * BM + wr * 64 + fr, col0 = u.pn * BM + wc * 32 + 8 * fq;
#pragma unroll
        for (int ai = 0; ai < 2; ++ai)
#pragma unroll
            for (int m = 0; m < 4; ++m) { unsigned char* rowp = (unsigned char*)(P + (size_t)(row0 + ai * HALF + m * 16) * PLD + C_GATE) + col0;
#pragma unroll
                for (int bj = 0; bj < 2; ++bj) { const f32x4 v0 = acc[ai][bj][m][0], v1 = acc[ai][bj][m][1]; unsigned q[8];
#pragma unroll
                    for (int i = 0; i < 4; ++i) { q[i] = (unsigned)fminf(fmaxf(sigmoidf_(v0[i]) * 255.0f + 0.5f, 1.0f), 255.0f); q[4 + i] = (unsigned)fminf(fmaxf(sigmoidf_(v1[i]) * 255.0f + 0.5f, 1.0f), 255.0f); }
                    u32x2 w; w.x = q[0] | (q[1] << 8) | (q[2] << 16) | (q[3] << 24); w.y = q[4] | (q[5] << 8) | (q[6] << 16) | (q[7] << 24);
                    *(u32x2*)(rowp + bj * HALF) = w; } }
    }
};
struct EpiMerge {
    static constexpr bool PERM = true, AFTER_DRAIN = false, PREFETCH = false, RESCALE = true;
    bf16* P;
    __device__ __forceinline__ void rescale(f32x4 (&acc)[2][2][4][2], const Unit& u, int wr, int wc, int fr, int fq, int stage) const {
        asm volatile("" : "+v"(fr), "+v"(fq));
        const int row0 = u.pm * BM + wr * 64 + fr, col0 = u.pn * BM + wc * 32 + 8 * fq;
#pragma unroll
        for (int ai = 0; ai < 2; ++ai) {
#pragma unroll
            for (int m = 0; m < 4; ++m) { const unsigned char* rowp = (const unsigned char*)(P + (size_t)(row0 + ai * HALF + m * 16) * PLD + C_GATE) + 1024 * (stage - 1) + col0;
#pragma unroll
                for (int bj = 0; bj < 2; ++bj) { const u32x2 gx = *(const u32x2*)(rowp + bj * HALF), gy = *(const u32x2*)(rowp + 1024 + bj * HALF);
#pragma unroll
                    for (int i = 0; i < 4; ++i) { acc[ai][bj][m][0][i] *= (float)((gx.x >> (8 * i)) & 255u) * frcp((float)((gy.x >> (8 * i)) & 255u));
                        acc[ai][bj][m][1][i] *= (float)((gx.y >> (8 * i)) & 255u) * frcp((float)((gy.y >> (8 * i)) & 255u)); } } }
            asm volatile("" ::: "memory"); }
    }
    __device__ __forceinline__ void operator()(const f32x4 (&acc)[2][2][4][2], const Unit& u, int wr, int wc, int fr, int fq) const {
        const int row0 = u.pm * BM + wr * 64 + fr, col0 = u.pn * BM + wc * 32 + 8 * fq;
#pragma unroll
        for (int ai = 0; ai < 2; ++ai)
#pragma unroll
            for (int m = 0; m < 4; ++m) { bf16* rowp = P + (size_t)(row0 + ai * HALF + m * 16) * PLD;
#pragma unroll
                for (int bj = 0; bj < 2; ++bj) { const int c = col0 + bj * HALF; float o[8];
                    const u32x2 gq = *(const u32x2*)((const unsigned char*)(rowp + C_GATE) + 2048 + c);
                    const f32x4 v0 = acc[ai][bj][m][0], v1 = acc[ai][bj][m][1];
#pragma unroll
                    for (int i = 0; i < 4; ++i) { o[i] = (float)((gq.x >> (8 * i)) & 255u) * (1.0f / 255.0f) * v0[i]; o[4 + i] = (float)((gq.y >> (8 * i)) & 255u) * (1.0f / 255.0f) * v1[i]; }
                    *(u32x4*)(rowp + C_MG + c) = pack8(o); } }
    }
};
struct EpiWout {
    static constexpr bool PERM = true, AFTER_DRAIN = false, PREFETCH = false, RESCALE = false;
    const float* x; float* out; bf16* P; float* SSQ; LAS float* xl;
    __device__ __forceinline__ void operator()(const f32x4 (&acc)[2][2][4][2], const Unit& u, int wr, int wc, int fr, int fq) const {
        const int row0 = u.pm * BM + wr * 64 + fr, col0 = u.pn * BM + wc * 32 + 8 * fq;
#pragma unroll
        for (int ai = 0; ai < 2; ++ai)
#pragma unroll
            for (int m = 0; m < 4; ++m) { const int row = row0 + ai * HALF + m * 16; float ss = 0.f;
#pragma unroll
                for (int bj = 0; bj < 2; ++bj) { const int c = col0 + bj * HALF; const size_t off = (size_t)row * DM + c;
                    const f32x4 a0 = *(const f32x4*)(x + off), a1 = *(const f32x4*)(x + off + 4);
                    const f32x4 r0 = a0 + acc[ai][bj][m][0], r1 = a1 + acc[ai][bj][m][1];
                    ss += (r0[0] * r0[0] + r0[1] * r0[1]) + (r0[2] * r0[2] + r0[3] * r0[3]) + (r1[0] * r1[0] + r1[1] * r1[1]) + (r1[2] * r1[2] + r1[3] * r1[3]);
                    u32x4 w; w.x = pk2(r0[0], r0[1]); w.y = pk2(r0[2], r0[3]); w.z = pk2(r1[0], r1[1]); w.w = pk2(r1[2], r1[3]);
                    *(u32x4*)(P + (size_t)row * PLD + C_X1B + c) = w; }
                ss += __shfl_xor(ss, 16); ss += __shfl_xor(ss, 32);
                if (fq == 0) xl[(ai * HALF + wr * 64 + m * 16 + fr) * 4 + wc] = ss; }
        asm volatile("s_waitcnt lgkmcnt(0)" ::: "memory"); __builtin_amdgcn_s_barrier(); asm volatile("" ::: "memory");
        { const int t = (wr * 4 + wc) * 64 + fq * 16 + fr;
          if (t < 256) { const f32x4 p = *(const LAS f32x4*)(xl + t * 4); SSQ[(size_t)(u.pm * BM + t) * 4 + u.pn] = (p[0] + p[1]) + (p[2] + p[3]); } }
        asm volatile("s_waitcnt lgkmcnt(0)" ::: "memory"); __builtin_amdgcn_s_barrier(); asm volatile("" ::: "memory");
    }
};
template <int CTRL> __device__ __forceinline__ float dpp_mov(float old, float src) {
    return __builtin_bit_cast(float, __builtin_amdgcn_update_dpp(__builtin_bit_cast(int, old), __builtin_bit_cast(int, src), CTRL, 0xF, 0xF, false)); }
struct EpiUp {
    static constexpr bool PERM = true, AFTER_DRAIN = false, PREFETCH = true, RESCALE = false;
    const float* SSQ; const float* cw; const float* cb; bf16* P; float* UE; LAS float* xl;
    __device__ __forceinline__ void prefetch(const Unit& u, int buf, int tid) const {
        LAS float* d = xl + buf * 1280;
        if (tid < 256) { const int a = tid >> 5, c4 = (tid & 31) * 4, ch = u.pn * 128 + c4 + (a >= 4 ? DFF : 0), aa = a & 3;
            *(LAS f32x4*)(d + a * 128 + c4) = *(const f32x4*)((aa < 3 ? cw + aa * NUP : cb) + ch); }
        else { const int r = tid - 256; const f32x4 q = *(const f32x4*)(SSQ + (size_t)(u.pm * BM + r) * 4);
            d[1024 + r] = __builtin_amdgcn_rsqf(((q[0] + q[1]) + (q[2] + q[3])) * (1.0f / DM) + EPS); }
    }
    __device__ __forceinline__ void operator()(f32x4 (&acc)[2][2][4][2], const Unit& u, int wr, int wc, int fr, int fq) const {
        const int row0 = u.pm * BM + wr * 64 + fr;
        const LAS float* lw = xl + u.aux * 1280;
#pragma unroll
        for (int ai = 0; ai < 2; ++ai)
#pragma unroll
            for (int m = 0; m < 4; ++m) { const float rs = lw[1024 + ai * HALF + wr * 64 + m * 16 + fr];
#pragma unroll
                for (int bj = 0; bj < 2; ++bj)
#pragma unroll
                    for (int n = 0; n < 2; ++n) acc[ai][bj][m][n] *= rs; }
#pragma unroll
        for (int n = 0; n < 2; ++n) {
            const int c4 = wc * 32 + 8 * fq + 4 * n, a0 = u.pn * 128 + c4;
            const f32x4 wg0 = *(const LAS f32x4*)(lw + c4), wg1 = *(const LAS f32x4*)(lw + 128 + c4), wg2 = *(const LAS f32x4*)(lw + 256 + c4), bg = *(const LAS f32x4*)(lw + 384 + c4);
            const f32x4 wv0 = *(const LAS f32x4*)(lw + 512 + c4), wv1 = *(const LAS f32x4*)(lw + 640 + c4), wv2 = *(const LAS f32x4*)(lw + 768 + c4), bv = *(const LAS f32x4*)(lw + 896 + c4);
#pragma unroll
            for (int ai = 0; ai < 2; ++ai) {
                const int g64 = u.pm * 4 + ai * 2 + wr;
#pragma unroll
                for (int m = 0; m < 4; ++m) {
                    const f32x4 ugm = acc[ai][0][m][n], uvm = acc[ai][1][m][n], ugp = acc[ai][0][(m + 3) & 3][n], ugn = acc[ai][0][(m + 1) & 3][n], uvp = acc[ai][1][(m + 3) & 3][n], uvn = acc[ai][1][(m + 1) & 3][n];
                    f32x4 pg, ng, pvv, nv;
#pragma unroll
                    for (int i = 0; i < 4; ++i) {
                        pg[i] = dpp_mov<0x111>(dpp_mov<0x121>(0.f, ugp[i]), ugm[i]);
                        ng[i] = dpp_mov<0x101>(dpp_mov<0x12F>(0.f, ugn[i]), ugm[i]);
                        pvv[i] = dpp_mov<0x111>(dpp_mov<0x121>(0.f, uvp[i]), uvm[i]);
                        nv[i] = dpp_mov<0x101>(dpp_mov<0x12F>(0.f, uvn[i]), uvm[i]); }
                    const f32x4 gate = wg0 * pg + wg1 * ugm + wg2 * ng + bg;
                    const f32x4 val = wv0 * pvv + wv1 * uvm + wv2 * nv + bv;
                    const int row = row0 + ai * HALF + m * 16;
                    const bool edge = (m == 0 && fr == 0) || (m == 3 && fr == 15);
                    if (!edge) { u32x2 w; w.x = pk2(siluf_(gate[0]) * val[0], siluf_(gate[1]) * val[1]); w.y = pk2(siluf_(gate[2]) * val[2], siluf_(gate[3]) * val[3]);
                        *(u32x2*)(P + (size_t)row * PLD + C_ACT + a0) = w; }
                    if ((m == 0 && fr < 2) || (m == 3 && fr >= 14)) { const int slot = (m == 0) ? fr : fr - 12;
                        float* ue = UE + ((size_t)g64 * 4 + slot) * NUP;
                        *(f32x4*)(ue + a0) = ugm; *(f32x4*)(ue + DFF + a0) = uvm; }
                }
            }
        }
    }
};
struct EpiDown {
    static constexpr bool PERM = true, AFTER_DRAIN = false, PREFETCH = false, RESCALE = false;
    float* out; const bf16* P;
    __device__ __forceinline__ void operator()(const f32x4 (&acc)[2][2][4][2], const Unit& u, int wr, int wc, int fr, int fq) const {
        const int row0 = u.pm * BM + wr * 64 + fr, col0 = u.pn * BM + wc * 32 + 8 * fq;
#pragma unroll
        for (int ai = 0; ai < 2; ++ai)
#pragma unroll
            for (int m = 0; m < 4; ++m) { const int row = row0 + ai * HALF + m * 16;
#pragma unroll
                for (int bj = 0; bj < 2; ++bj) { const int c = col0 + bj * HALF; float xr[8]; unpack8(*(const u32x4*)(P + (size_t)row * PLD + C_X1B + c), xr);
                    const f32x4 v0 = acc[ai][bj][m][0], v1 = acc[ai][bj][m][1];
                    *(f32x4*)(out + (size_t)row * DM + c) = (f32x4){xr[0] + v0[0], xr[1] + v0[1], xr[2] + v0[2], xr[3] + v0[3]};
                    *(f32x4*)(out + (size_t)row * DM + c + 4) = (f32x4){xr[4] + v1[0], xr[5] + v1[1], xr[6] + v1[2], xr[7] + v1[3]}; } }
    }
};

template <int DH, int RSK, int RSV>
__device__ __forceinline__ void attn_tile(const LAS unsigned char* Kl, const LAS unsigned char* Vl, int jk, const bf16x8 (&qf)[DH / 16], f32x16 s0, f32x16 s1,
                                          float& m, float& l, f32x16 (&o)[DH / 32], int lane) {
    const int r32 = lane & 31, hi = lane >> 5;
    const LAS unsigned char* kp = Kl + (size_t)(jk + r32) * RSK + 16 * hi;
#pragma unroll
    for (int ks = 0; ks < DH / 16; ++ks) {
        const bf16x8 k0 = *(const LAS bf16x8*)(kp + 32 * ks), k1 = *(const LAS bf16x8*)(kp + 32 * RSK + 32 * ks);
        s0 = __builtin_amdgcn_mfma_f32_32x32x16_bf16(k0, qf[ks], s0, 0, 0, 0);
        s1 = __builtin_amdgcn_mfma_f32_32x32x16_bf16(k1, qf[ks], s1, 0, 0, 0);
    }
    const int g = lane >> 4, q4 = (lane & 15) >> 2, p = lane & 3;
    const unsigned va = (unsigned)(uintptr_t)Vl + (unsigned)(jk + 4 * hi + q4) * RSV + (16 * (g & 1) + 4 * p) * 2;
    s16x4 vlo[2][4], vhi[2][4];
#define ATT_VREAD(set, db) do { _Pragma("unroll") for (int kk = 0; kk < 4; ++kk) { \
        asm volatile("ds_read_b64_tr_b16 %0, %1 offset:%c2" : "=&v"(vlo[set][kk]) : "v"(va), "i"((16 * kk) * RSV + 64 * (db)) : "memory"); \
        asm volatile("ds_read_b64_tr_b16 %0, %1 offset:%c2" : "=&v"(vhi[set][kk]) : "v"(va), "i"((16 * kk + 8) * RSV + 64 * (db)) : "memory"); } } while (0)
    ATT_VREAD(0, 0);
    float mx = fmaxf(s0[0], s1[0]);
#pragma unroll
    for (int r = 1; r < 16; ++r) mx = fmaxf(mx, fmaxf(s0[r], s1[r]));
    mx = fmaxf(mx, __shfl_xor(mx, 32));
    const float mn = fmaxf(m, mx), f = fexp2(m - mn);
    m = mn; l *= f;
#pragma unroll
    for (int db = 0; db < DH / 32; ++db)
#pragma unroll
        for (int r = 0; r < 16; ++r) o[db][r] *= f;
    float ps = 0.f;
#pragma unroll
    for (int r = 0; r < 16; ++r) { s0[r] = fexp2(s0[r] - mn); s1[r] = fexp2(s1[r] - mn); ps += s0[r] + s1[r]; }
    l += ps;
    bf16x8 pf[4];
    { u32x4 w;
      w.x = pk2(s0[0], s0[1]); w.y = pk2(s0[2], s0[3]); w.z = pk2(s0[4], s0[5]); w.w = pk2(s0[6], s0[7]); pf[0] = __builtin_bit_cast(bf16x8, w);
      w.x = pk2(s0[8], s0[9]); w.y = pk2(s0[10], s0[11]); w.z = pk2(s0[12], s0[13]); w.w = pk2(s0[14], s0[15]); pf[1] = __builtin_bit_cast(bf16x8, w);
      w.x = pk2(s1[0], s1[1]); w.y = pk2(s1[2], s1[3]); w.z = pk2(s1[4], s1[5]); w.w = pk2(s1[6], s1[7]); pf[2] = __builtin_bit_cast(bf16x8, w);
      w.x = pk2(s1[8], s1[9]); w.y = pk2(s1[10], s1[11]); w.z = pk2(s1[12], s1[13]); w.w = pk2(s1[14], s1[15]); pf[3] = __builtin_bit_cast(bf16x8, w); }
#pragma unroll
    for (int db = 0; db < DH / 32; ++db) {
        asm volatile("s_waitcnt lgkmcnt(0)" ::: "memory"); __builtin_amdgcn_sched_barrier(0);
        if (db + 1 < DH / 32) { if ((db & 1) == 0) ATT_VREAD(1, db + 1); else ATT_VREAD(0, db + 1); }
#pragma unroll
        for (int kk = 0; kk < 4; ++kk) { const s16x4 lo = vlo[db & 1][kk], h4 = vhi[db & 1][kk];
            const bf16x8 vf = (bf16x8){lo[0], lo[1], lo[2], lo[3], h4[0], h4[1], h4[2], h4[3]};
            o[db] = __builtin_amdgcn_mfma_f32_32x32x16_bf16(vf, pf[kk], o[db], 0, 0, 0); }
        __builtin_amdgcn_sched_barrier(0);
    }
#undef ATT_VREAD
}
__device__ __forceinline__ void load_bias(const float* biasrow, int hi, f32x16& s0, f32x16& s1) {
#pragma unroll
    for (int g4 = 0; g4 < 4; ++g4) { const f32x4 c0 = *(const f32x4*)(biasrow + 8 * g4 + 4 * hi), c1 = *(const f32x4*)(biasrow + 32 + 8 * g4 + 4 * hi);
#pragma unroll
        for (int i = 0; i < 4; ++i) { s0[4 * g4 + i] = c0[i]; s1[4 * g4 + i] = c1[i]; } }
}
template <int DH>
__device__ __forceinline__ void load_q(const bf16* qrow, const float* gq, float scale, bf16x8 (&qf)[DH / 16], int lane) {
    const int hi = lane >> 5;
    u32x4 w[DH / 16]; float ss = 0.f;
#pragma unroll
    for (int ks = 0; ks < DH / 16; ++ks) { w[ks] = *(const u32x4*)(qrow + 16 * ks + 8 * hi); float v[8]; unpack8(w[ks], v);
#pragma unroll
        for (int j = 0; j < 8; ++j) ss += v[j] * v[j]; }
    ss += __shfl_xor(ss, 32);
    const float rstd = __builtin_amdgcn_rsqf(ss * (1.0f / DH) + EPS) * scale;
#pragma unroll
    for (int ks = 0; ks < DH / 16; ++ks) { float v[8]; unpack8(w[ks], v);
        const f32x4 g0 = *(const f32x4*)(gq + 16 * ks + 8 * hi), g1 = *(const f32x4*)(gq + 16 * ks + 8 * hi + 4);
#pragma unroll
        for (int j = 0; j < 4; ++j) { v[j] *= rstd * g0[j]; v[4 + j] *= rstd * g1[j]; }
        qf[ks] = __builtin_bit_cast(bf16x8, pack8(v)); }
}
template <int DH>
__device__ __forceinline__ void store_o(bf16* yrow, const f32x16 (&o)[DH / 32], float l, int lane) {
    const int hi = lane >> 5;
    const float inv = frcp(l + __shfl_xor(l, 32));
#pragma unroll
    for (int db = 0; db < DH / 32; ++db)
#pragma unroll
        for (int g4 = 0; g4 < 4; ++g4) { u32x2 w; w.x = pk2(o[db][4 * g4] * inv, o[db][4 * g4 + 1] * inv); w.y = pk2(o[db][4 * g4 + 2] * inv, o[db][4 * g4 + 3] * inv);
            *(u32x2*)(yrow + 32 * db + 8 * g4 + 4 * hi) = w; }
}
template <int DH, int RSK, int RSV>
__device__ __forceinline__ void stage_kv(LAS unsigned char* Kl, LAS unsigned char* Vl, int ldsrow0, const bf16* src, size_t pitch, int kcol, int vcol, int nrows, const float* gk, int tid) {
    constexpr int CPR = DH / 8;
    for (int c = tid; c < nrows * CPR; c += 512) {
        const int row = c / CPR, ch = c % CPR;
        const bf16* rp = src + (size_t)row * pitch;
        const u32x4 kw = *(const u32x4*)(rp + kcol + ch * 8), vw = *(const u32x4*)(rp + vcol + ch * 8);
        float v[8]; unpack8(kw, v); float ss = 0.f;
#pragma unroll
        for (int j = 0; j < 8; ++j) ss += v[j] * v[j];
        ss = (CPR == 8) ? group8_sum_dpp(ss) : group16_sum_dpp(ss);
        const float rstd = __builtin_amdgcn_rsqf(ss * (1.0f / DH) + EPS);
        const f32x4 g0 = *(const f32x4*)(gk + ch * 8), g1 = *(const f32x4*)(gk + ch * 8 + 4);
#pragma unroll
        for (int j = 0; j < 4; ++j) { v[j] *= rstd * g0[j]; v[4 + j] *= rstd * g1[j]; }
        *(LAS u32x4*)(Kl + (size_t)(ldsrow0 + row) * RSK + ch * 16) = pack8(v);
        *(LAS u32x4*)(Vl + (size_t)(ldsrow0 + row) * RSV + ch * 16) = vw;
    }
}

constexpr int NWAVES = 8;
constexpr size_t MiB = 1u << 20;
constexpr size_t WS_CTL = 0, CTL_ZERO_BYTES = 128 * 1024;
constexpr size_t WS_WIN = 2 * MiB;
constexpr size_t WS_WBR = 15 * MiB;
constexpr size_t WS_WOUT = 18 * MiB;
constexpr size_t WS_WUP = 20 * MiB;
constexpr size_t WS_WDN = 31 * MiB;
constexpr size_t WS_WKV = 37 * MiB;
constexpr size_t WS_MEMN = 39 * MiB;
constexpr size_t WS_KV = 41 * MiB;
constexpr size_t WS_BT = 43 * MiB;
constexpr size_t WS_BA = 45 * MiB;
constexpr size_t WS_SSQ = 49 * MiB;
constexpr size_t WS_P = 52 * MiB;
constexpr size_t WS_UE = 452 * MiB;
constexpr size_t WS_END = 512 * MiB;
static_assert(WS_P + (size_t)M * PLD * 2 == WS_UE && WS_UE + (size_t)512 * 4 * NUP * 4 <= WS_END, "d_ws map");

constexpr int CW_TMO = 0, CW_CODE = 1;
constexpr int CW_BAR = 4096;
constexpr int RING_OFF = 0, RING_BYTES = 147456;
constexpr int LDSCTL_OFF = RING_BYTES, MISC_OFF = LDSCTL_OFF + 320;
constexpr int XCH_OFF = MISC_OFF + 256;
constexpr int LDS_BYTES = 163840;
static_assert(XCH_OFF + 2 * 1280 * 4 <= LDS_BYTES && XCH_OFF % 16 == 0, "LDS map");

typedef GAS unsigned gu32;
#define RLX_AGENT __ATOMIC_RELAXED, __HIP_MEMORY_SCOPE_AGENT
#define LDS_WAIT() asm volatile("s_waitcnt lgkmcnt(0)" ::: "memory")
#define VM_WAIT() asm volatile("s_waitcnt vmcnt(0)" ::: "memory")

#define XB_TMO      128
#define XB_XCNT(j)  (256  + 64 * (j))
#define XB_XSUB(j)  (1280 + 64 * (j))
#define XB_XGEN(j)  (2304 + 64 * (j))
#define XB_TOP      3328
#define XB_TOPGEN   3392
#define XCD_BAR_WORDS 3456
#define XB_SPIN_CAP (1u << 22)

__device__ __forceinline__ unsigned xb_ld(unsigned* p)              { return __hip_atomic_load(p, __ATOMIC_RELAXED, __HIP_MEMORY_SCOPE_AGENT); }
__device__ __forceinline__ unsigned xb_add(unsigned* p, unsigned v) { return __hip_atomic_fetch_add(p, v, __ATOMIC_RELAXED, __HIP_MEMORY_SCOPE_AGENT); }
__device__ __forceinline__ unsigned xb_xcc_id() { return (unsigned)__builtin_amdgcn_s_getreg((3 << 11) | 20) & 0xFu; }
#define XB_SPIN(cond, bar) do { unsigned _sp = 0; while (cond) { __builtin_amdgcn_s_sleep(1); \
    if ((++_sp & 255u) == 0u) { if (xb_ld(&(bar)[XB_TMO])) break; if (_sp > XB_SPIN_CAP) { atomicAdd(&(bar)[XB_TMO], 1u); break; } } } } while (0)

struct XcdBarrier { unsigned* bar; unsigned x; volatile LAS unsigned* st; };

__device__ __forceinline__ XcdBarrier xcd_barrier_post(unsigned* bar, volatile LAS unsigned* st) {
    XcdBarrier b; b.bar = bar; b.x = xb_xcc_id(); b.st = st;
    if (threadIdx.x == 0) (void)xb_add(&bar[XB_XCNT(b.x)], 1u);
    return b;
}
__device__ __forceinline__ void xcd_barrier_complete(unsigned* bar, unsigned x, unsigned& nloc, unsigned& nx) {
    const unsigned G = gridDim.x * gridDim.y * gridDim.z;
    unsigned sum, cnt, mine, sp = 0u;
    for (;;) {
        sum = 0u; cnt = 0u; mine = 0u;
#pragma unroll
        for (unsigned j = 0; j < 16; ++j) { const unsigned c = xb_ld(&bar[XB_XCNT(j)]); sum += c; cnt += (c > 0u) ? 1u : 0u; mine = (j == x) ? c : mine; }
        if (sum == G) break;
        __builtin_amdgcn_s_sleep(1);
        if ((++sp & 255u) == 0u) { if (xb_ld(&bar[XB_TMO])) break; if (sp > XB_SPIN_CAP) { atomicAdd(&bar[XB_TMO], 1u); break; } }
    }
    nloc = mine > 0u ? mine : 1u; nx = cnt > 0u ? cnt : 1u;
}
__device__ __forceinline__ void xcd_barrier(const XcdBarrier& b) {
    asm volatile("s_waitcnt vmcnt(0)" ::: "memory");
    __syncthreads();
    if (threadIdx.x == 0) {
        unsigned* bar = b.bar;
        __builtin_amdgcn_s_waitcnt(0);
        unsigned nloc = b.st[0], nx = b.st[1];
        if (nloc == 0u) { xcd_barrier_complete(bar, b.x, nloc, nx); b.st[0] = nloc; b.st[1] = nx; }
        const unsigned old = xb_add(&bar[XB_XSUB(b.x)], 1u);
        const unsigned gen = old / nloc;
        if (old + 1u == (gen + 1u) * nloc) {
            __builtin_amdgcn_fence(__ATOMIC_RELEASE, "agent");
            asm volatile("s_waitcnt vmcnt(0)" ::: "memory");
            const unsigned og = xb_add(&bar[XB_TOP], 1u);
            const unsigned tg = og / nx;
            if (og + 1u == (tg + 1u) * nx) xb_add(&bar[XB_TOPGEN], 1u);
            else XB_SPIN(xb_ld(&bar[XB_TOPGEN]) == tg, bar);
            __builtin_amdgcn_fence(__ATOMIC_ACQUIRE, "agent");
            xb_add(&bar[XB_XGEN(b.x)], 1u);
            asm volatile("s_waitcnt vmcnt(0)" ::: "memory");
        } else {
            XB_SPIN(xb_ld(&bar[XB_XGEN(b.x)]) == gen, bar);
            __builtin_amdgcn_fence(__ATOMIC_ACQUIRE, "agent");
            asm volatile("s_waitcnt vmcnt(0)" ::: "memory");
        }
    }
    __syncthreads();
}

struct Frame {
    LAS unsigned char* lds;
    volatile LAS unsigned* MISC;
    gu32* ctl;
    int tid, lane, wave, vcu, G;
};

__device__ __forceinline__ float wave_sum(float v) {
#pragma unroll
    for (int o = 1; o < 64; o <<= 1) v += __shfl_xor(v, o);
    return v;
}
__device__ __forceinline__ int t5_bucket(int rel) {
    const int n = rel < 0 ? -rel : rel;
    const int mag = n < 8 ? n : n < 12 ? 8 : n < 16 ? 9 : n < 23 ? 10 : n < 32 ? 11 : n < 46 ? 12 : n < 64 ? 13 : n < 91 ? 14 : 15;
    return (rel > 0 ? 16 : 0) + mag;
}

__device__ __forceinline__ void transpose_item(const float* W, int K, int N, int k0, int n0, bf16* WT, int drow0, const float* gk, LAS float* scr, int lane) {
    { f32x4 v[8];
#pragma unroll
      for (int i = 0; i < 8; ++i) v[i] = *(const f32x4*)(W + (size_t)(k0 + 8 * i + (lane >> 3)) * N + n0 + 4 * (lane & 7));
#pragma unroll
      for (int i = 0; i < 8; ++i) { const int kk = 8 * i + (lane >> 3); const float gs = gk ? gk[k0 + kk] : 1.0f; LAS float* d = scr + kk * 33 + 4 * (lane & 7);
          d[0] = v[i][0] * gs; d[1] = v[i][1] * gs; d[2] = v[i][2] * gs; d[3] = v[i][3] * gs; } }
    LDS_WAIT(); asm volatile("" ::: "memory");
    const int c = lane & 7;
#pragma unroll
    for (int j = 0; j < 4; ++j) { const int n = (lane >> 3) + 8 * j; const LAS float* s = scr + (8 * c) * 33 + n;
        u32x4 o; o.x = pk2(s[0 * 33], s[1 * 33]); o.y = pk2(s[2 * 33], s[3 * 33]); o.z = pk2(s[4 * 33], s[5 * 33]); o.w = pk2(s[6 * 33], s[7 * 33]);
        *(GAS u32x4*)(WT + (size_t)(drow0 + n) * K + k0 + 8 * c) = o; }
    LDS_WAIT(); asm volatile("" ::: "memory");
}
__device__ __forceinline__ void rms_row_to_bf16(const float* xrow, const float* g, bf16* orow, int lane) {
    const GAS f32x4* xr = (const GAS f32x4*)xrow + lane;
    const GAS f32x4* gr = (const GAS f32x4*)g + lane;
    f32x4 v[4]; float s = 0.f;
#pragma unroll
    for (int j = 0; j < 4; ++j) { v[j] = xr[64 * j]; s += (v[j].x * v[j].x + v[j].y * v[j].y) + (v[j].z * v[j].z + v[j].w * v[j].w); }
    const float rstd = __builtin_amdgcn_rsqf(wave_sum(s) * (1.f / DM) + EPS);
    GAS unsigned long long* o8 = (GAS unsigned long long*)orow + lane;
#pragma unroll
    for (int j = 0; j < 4; ++j) { const f32x4 gg = gr[64 * j];
        o8[64 * j] = (unsigned long long)pk2(v[j].x * rstd * gg.x, v[j].y * rstd * gg.y) | ((unsigned long long)pk2(v[j].z * rstd * gg.z, v[j].w * rstd * gg.w) << 32); }
}

template <int R> __device__ __forceinline__ void rms_rows_to_bf16(const float* xa, size_t rstride, const float* g, bf16* oa, int lane) {
    const GAS f32x4* gr = (const GAS f32x4*)g + lane;
    f32x4 v[R][4]; float ss[R];
#pragma unroll
    for (int r = 0; r < R; ++r) { const GAS f32x4* xr = (const GAS f32x4*)(xa + (size_t)r * rstride) + lane;
#pragma unroll
        for (int j = 0; j < 4; ++j) v[r][j] = xr[64 * j]; }
#pragma unroll
    for (int r = 0; r < R; ++r) { ss[r] = 0.f;
#pragma unroll
        for (int j = 0; j < 4; ++j) ss[r] += (v[r][j].x * v[r][j].x + v[r][j].y * v[r][j].y) + (v[r][j].z * v[r][j].z + v[r][j].w * v[r][j].w); }
#pragma unroll
    for (int o = 1; o < 64; o <<= 1)
#pragma unroll
        for (int r = 0; r < R; ++r) ss[r] += __shfl_xor(ss[r], o);
#pragma unroll
    for (int r = 0; r < R; ++r) { const float rs = __builtin_amdgcn_rsqf(ss[r] * (1.f / DM) + EPS);
        GAS unsigned long long* o8 = (GAS unsigned long long*)(oa + (size_t)r * rstride) + lane;
#pragma unroll
        for (int j = 0; j < 4; ++j) { const f32x4 gg = gr[64 * j];
            o8[64 * j] = (unsigned long long)pk2(v[r][j].x * rs * gg.x, v[r][j].y * rs * gg.y) | ((unsigned long long)pk2(v[r][j].z * rs * gg.z, v[r][j].w * rs * gg.w) << 32); } }
}

struct Args { const float* in[25]; float* out; unsigned char* ws; int ph_lo, ph_hi, mode, pad; };

constexpr int WI_IN = 16 * 201, WI_KV = 16 * 32, WI_BR = 8 * 32, WI_OUT = 16 * 32, WI_UP = 16 * 176, WI_DN = 44 * 32;
constexpr int WI_EARLY = WI_IN + WI_KV, WI_ALL = WI_EARLY + 3 * WI_BR + WI_OUT + WI_UP + WI_DN;
__device__ __forceinline__ void weight_items(Frame& F, const Args& a, int first, int last, int gwl, int ngwl) {
    unsigned char* ws = a.ws;
    LAS float* scr = (LAS float*)(F.lds + RING_OFF + F.wave * 16384);
    for (int it = first + gwl; it < last; it += ngwl) {
        int r = it;
        if (r < WI_IN) { const int kb = r / 201, nb = r % 201, n0 = nb * 32;
            const int d0 = n0 < 2816 ? n0 : (n0 < 2848 ? 3328 + (n0 - 2816) : (n0 < 3360 ? n0 - 32 : 3584 + (n0 - 3360)));
            transpose_item(a.in[4], 1024, 6432, kb * 64, n0, (bf16*)(ws + WS_WIN), d0, nullptr, scr, F.lane); continue; }
        r -= WI_IN;
        if (r < WI_KV) { const int kb = r / 32, nb = r % 32;
            transpose_item(a.in[13], 1024, 1024, kb * 64, nb * 32, (bf16*)(ws + WS_WKV), nb * 32, nullptr, scr, F.lane); continue; }
        r -= WI_KV;
        if (r < 3 * WI_BR) { const int br = r / WI_BR, q = r % WI_BR, kb = q / 32, nb = q % 32;
            transpose_item(a.in[16 + br], 512, 1024, kb * 64, nb * 32, (bf16*)(ws + WS_WBR) + (size_t)br * 1024 * 512, nb * 32, nullptr, scr, F.lane); continue; }
        r -= 3 * WI_BR;
        if (r < WI_OUT) { const int kb = r / 32, nb = r % 32;
            transpose_item(a.in[19], 1024, 1024, kb * 64, nb * 32, (bf16*)(ws + WS_WOUT), nb * 32, nullptr, scr, F.lane); continue; }
        r -= WI_OUT;
        if (r < WI_UP) { const int kb = r / 176, nb = r % 176, n0 = nb * 32;
            const int isv = n0 >= DFF, nn = isv ? n0 - DFF : n0, d0 = (nn >> 7) * 256 + isv * 128 + (nn & 127);
            transpose_item(a.in[21], 1024, NUP, kb * 64, n0, (bf16*)(ws + WS_WUP), d0, a.in[20], scr, F.lane); continue; }
        r -= WI_UP;
        { const int kb = r / 32, nb = r % 32;
            transpose_item(a.in[24], DFF, 1024, kb * 64, nb * 32, (bf16*)(ws + WS_WDN), nb * 32, nullptr, scr, F.lane); }
    }
}
__device__ __forceinline__ void p0_prologue(Frame& F, const Args& a) {
    unsigned char* ws = a.ws;
    const int gw = F.vcu * NWAVES + F.wave, NGW = F.G * NWAVES;
    weight_items(F, a, 0, WI_EARLY, gw, NGW);
    { u32x4* z = (u32x4*)((bf16*)(ws + WS_WIN) + (size_t)3360 * 1024); const int n16 = 224 * 1024 * 2 / 16;
      for (int i = blockIdx.x * 512 + F.tid; i < n16; i += F.G * 512) z[i] = (u32x4){0u, 0u, 0u, 0u}; }
    bf16* H = (bf16*)a.out;
    if (M % (4 * NGW) != 0) { for (int m = gw; m < M; m += NGW) rms_row_to_bf16(a.in[0] + (size_t)m * DM, a.in[3], H + (size_t)m * DM, F.lane); }
    else for (int m = gw; m < M; m += 4 * NGW) rms_rows_to_bf16<4>(a.in[0] + (size_t)m * DM, (size_t)NGW * DM, a.in[3], H + (size_t)m * DM, F.lane);
    for (int m = gw; m < BATCH * NMEM; m += NGW) rms_row_to_bf16(a.in[1] + (size_t)m * DM, a.in[12], (bf16*)(ws + WS_MEMN) + (size_t)m * DM, F.lane);
    { float* BT = (float*)(ws + WS_BT); const float* tab = a.in[2];
      for (int i = blockIdx.x * 512 + F.tid; i < 8 * 128 * 384; i += F.G * 512) { const int j = i % 384, t = (i / 384) % 128, h = i / (384 * 128);
          const int rel = j - 128 - t; const bool ok = rel >= -128 && rel <= 128;
          BT[i] = ok ? tab[t5_bucket(rel) * 8 + h] * LOG2E : -INFINITY; } }
}

__device__ __forceinline__ void attnA_unit(Frame& F, const Args& a, int b, int n, int kvh) {
    constexpr int RSK = 144, RSV = 128;
    LAS unsigned char* Kl = F.lds; LAS unsigned char* Vl = F.lds + 384 * RSK;
    bf16* P = (bf16*)(a.ws + WS_P);
    const float* BT = (const float*)(a.ws + WS_BT);
    for (int blk = 0; blk < 3; ++blk) { const int pos0 = n * 128 - 128 + blk * 128; if (pos0 < 0 || pos0 >= SEQ) continue;
        stage_kv<64, RSK, RSV>(Kl, Vl, blk * 128, P + (size_t)(b * SEQ + pos0) * PLD, PLD, C_AK + kvh * 64, C_AV + kvh * 64, 128, a.in[6], F.tid); }
    LDS_WAIT(); __syncthreads();
    const int h = kvh * 4 + (F.wave >> 1), r32 = F.lane & 31, hi = F.lane >> 5;
    const float sink = a.in[7][h] * LOG2E;
#pragma unroll 1
    for (int qb = 0; qb < 2; ++qb) {
        const int t0 = (F.wave & 1) * 64 + qb * 32, t = t0 + r32;
        bf16* qrow = P + (size_t)(b * SEQ + n * 128 + t) * PLD + C_AQ + h * 64;
        bf16x8 qf[4]; load_q<64>(qrow, a.in[5], 0.125f * LOG2E, qf, F.lane);
        float m = sink, l = hi == 0 ? 1.f : 0.f; f32x16 o[2];
#pragma unroll
        for (int r = 0; r < 16; ++r) { o[0][r] = 0.f; o[1][r] = 0.f; }
        const int lo = max(t0 >= 64 ? 1 : 0, n == 0 ? 2 : 0), hi_t = min(t0 >= 64 ? 5 : 4, n == SEQ / 128 - 1 ? 3 : 5);
        const float* brow = BT + ((size_t)h * 128 + t) * 384;
        f32x16 b0, b1; load_bias(brow + 64 * lo, hi, b0, b1);
#pragma unroll 1
        for (int kt = lo; kt <= hi_t; ++kt) {
            f32x16 nb0 = b0, nb1 = b1;
            if (kt < hi_t) load_bias(brow + 64 * (kt + 1), hi, nb0, nb1);
            attn_tile<64, RSK, RSV>(Kl, Vl, 64 * kt, qf, b0, b1, m, l, o, F.lane);
            b0 = nb0; b1 = nb1; }
        store_o<64>(qrow, o, l, F.lane);
    }
    LDS_WAIT(); __syncthreads();
}
__device__ __forceinline__ void xattn_unit(Frame& F, const Args& a, int b, int tb, int h) {
    constexpr int RSK = 272, RSV = 320;
    LAS unsigned char* Kl = F.lds; LAS unsigned char* Vl = F.lds + 128 * RSK;
    bf16* P = (bf16*)(a.ws + WS_P);
    const bf16* KV = (const bf16*)(a.ws + WS_KV);
    const int r32 = F.lane & 31;
    bf16* qrow = P + (size_t)(b * SEQ + tb * 256 + F.wave * 32 + r32) * PLD + C_MQ + h * 128;
    bf16x8 qf[8]; load_q<128>(qrow, a.in[14], 0.08838834764831845f * LOG2E, qf, F.lane);
    float m = -1e30f, l = 0.f; f32x16 o[4];
#pragma unroll
    for (int db = 0; db < 4; ++db)
#pragma unroll
        for (int r = 0; r < 16; ++r) o[db][r] = 0.f;
#pragma unroll 1
    for (int half = 0; half < 2; ++half) {
        stage_kv<128, RSK, RSV>(Kl, Vl, 0, KV + (size_t)(b * NMEM + half * 128) * 1024, 1024, h * 128, 512 + h * 128, 128, a.in[15], F.tid);
        LDS_WAIT(); __syncthreads();
#pragma unroll 1
        for (int kt = 0; kt < 2; ++kt) { f32x16 z0, z1;
#pragma unroll
            for (int r = 0; r < 16; ++r) { z0[r] = 0.f; z1[r] = 0.f; }
            attn_tile<128, RSK, RSV>(Kl, Vl, 64 * kt, qf, z0, z1, m, l, o, F.lane); }
        LDS_WAIT(); __syncthreads();
    }
    store_o<128>(qrow, o, l, F.lane);
}


constexpr int SAF = C_GATE, SCF = C_GATE + 512, SBF = C_GATE + 1024, SDF = C_GATE + 1536, SAB = C_GATE + 2048, SCB = C_GATE + 2560;
constexpr int C_OF = C_DQ, C_OB = C_DK;
__device__ __forceinline__ int dn_pcol(int x) { return (x & 32) + 8 * ((x & 15) >> 2) + 4 * ((x >> 4) & 1) + (x & 3); }
__device__ __forceinline__ bf16x8 frag_lo(const LAS unsigned char* p) { const u32x2 a0 = *(const LAS u32x2*)p; u32x4 w; w.x = a0.x; w.y = a0.y; w.z = 0u; w.w = 0u; return __builtin_bit_cast(bf16x8, w); }
__device__ __forceinline__ bf16x8 frag_2(const LAS unsigned char* p) { const u32x2 a0 = *(const LAS u32x2*)p, a1 = *(const LAS u32x2*)(p + 32); u32x4 w; w.x = a0.x; w.y = a0.y; w.z = a1.x; w.w = a1.y; return __builtin_bit_cast(bf16x8, w); }
__device__ __forceinline__ bf16x8 pack_f4z(const f32x4 a) { u32x4 w; w.x = pk2(a[0], a[1]); w.y = pk2(a[2], a[3]); w.z = 0u; w.w = 0u; return __builtin_bit_cast(bf16x8, w); }
__device__ __forceinline__ bf16x8 pack_f4f4(const f32x4 a, const f32x4 b) { u32x4 w; w.x = pk2(a[0], a[1]); w.y = pk2(a[2], a[3]); w.z = pk2(b[0], b[1]); w.w = pk2(b[2], b[3]); return __builtin_bit_cast(bf16x8, w); }
__device__ __forceinline__ void dn_prep_block(Frame& F, const Args& a, int b, int h, int c0, int nch) {
    LAS float* raw = (LAS float*)(F.lds);
    LAS unsigned char* NL = F.lds;
    LAS unsigned char* TD = F.lds + 18432;
    LAS unsigned char* Qb = F.lds + 53248;
    LAS unsigned char* Kb = F.lds + 62464;
    LAS unsigned char* Vb = F.lds + 71680;
    LAS float* sm = (LAS float*)(F.lds + 80896);
    LAS float* gt = sm;
    LAS float* btk = sm + 128;
    LAS float* gct = sm + 256;
    LAS float* cu = sm + 384;
    LAS float* cwp = sm + 512;
    LAS float* egp = sm + 640;
    LAS float* esp = sm + 768;
    LAS unsigned char* QKL = F.lds + 24576;
    LAS unsigned char* KT = F.lds + 84480;
    LAS unsigned char* QT = F.lds + 104960;
    bf16* P = (bf16*)(a.ws + WS_P);
    float* BA = (float*)(a.ws + WS_BA);
    bf16* XB2 = (bf16*)a.out + (size_t)M * 1024;
    const float* cw = a.in[8];
    const int w = F.wave, lane = F.lane, tid = F.tid;
    float wt[3][5];
#pragma unroll
    for (int which = 0; which < 3; ++which)
#pragma unroll
        for (int j = 0; j < 5; ++j) wt[which][j] = cw[j * 1536 + which * 512 + h * 64 + lane];
    const float Ah = expf(a.in[9][(tid >> 6 & 1) * 8 + h]), dtb = a.in[10][(tid >> 6 & 1) * 8 + h];
    u32x4 rr[4]; float pa = 0.f, pb = 0.f;
#define DN_PREFETCH(cidx) do { const int t0p_ = (cidx) * 64; \
        _Pragma("unroll") for (int i_ = 0; i_ < 4; ++i_) { const int e = tid + 512 * i_, row = e / 24, c8 = e % 24, which = c8 >> 3, t = t0p_ - 2 + row; \
            rr[i_] = (u32x4){0u, 0u, 0u, 0u}; \
            if (e < 68 * 24 && t >= 0 && t < SEQ) rr[i_] = *(const u32x4*)(P + ((size_t)b * SEQ + t) * PLD + (which == 0 ? C_DQ : which == 1 ? C_DK : C_DV) + h * 64 + (c8 & 7) * 8); } \
        if (tid < 128) { const size_t tok = (size_t)b * SEQ + t0p_ + (tid & 63); pa = BA[tok * 32 + 16 + (tid >> 6) * 8 + h]; pb = BA[tok * 32 + (tid >> 6) * 8 + h]; } } while (0)
    DN_PREFETCH(c0);
#pragma unroll 1
  for (int ci = 0; ci < nch; ++ci) {
    int tid_o = F.tid; asm volatile("" : "+v"(tid_o));
    const int tid = tid_o, lane = tid & 63;
    const int c = c0 + ci, t0 = c * 64;
    const size_t tok0 = (size_t)b * SEQ + t0;
#pragma unroll
    for (int i_ = 0; i_ < 4; ++i_) { const int e = tid + 512 * i_, row = e / 24, c8 = e % 24;
        if (e < 68 * 24) { float v[8]; unpack8(rr[i_], v);
            *(LAS f32x4*)(raw + row * 192 + c8 * 8) = (f32x4){v[0], v[1], v[2], v[3]}; *(LAS f32x4*)(raw + row * 192 + c8 * 8 + 4) = (f32x4){v[4], v[5], v[6], v[7]}; } }
    if (tid < 128) { const int d = tid >> 6, i = tid & 63; const float xa = pa + dtb;
        gt[d * 64 + i] = -Ah * (fmaxf(xa, 0.f) + __logf(1.0f + __expf(-fabsf(xa))));
        btk[d * 64 + i] = sigmoidf_(pb); }
    if (ci + 1 < nch) DN_PREFETCH(c + 1);
    LDS_WAIT(); __syncthreads();
#pragma unroll
    for (int which = 0; which < 3; ++which) {
        float x[12], y[8];
#pragma unroll
        for (int j = 0; j < 12; ++j) x[j] = raw[(w * 8 + j) * 192 + which * 64 + lane];
#pragma unroll
        for (int r = 0; r < 8; ++r) { float acc = 0.f;
#pragma unroll
            for (int j = 0; j < 5; ++j) acc += x[r + j] * wt[which][j];
            y[r] = siluf_(acc); }
        if (which < 2) {
#pragma unroll
            for (int r = 0; r < 8; ++r) y[r] *= __builtin_amdgcn_rsqf(wave_sum_dpp(y[r] * y[r]) + EPS) * (which == 0 ? 0.125f : 1.0f);
        }
        LAS unsigned char* X = which == 0 ? Qb : which == 1 ? Kb : Vb;
#pragma unroll
        for (int r = 0; r < 8; ++r) *(LAS bf16*)(X + (w * 8 + r) * 144 + lane * 2) = (bf16)(pk2(y[r], 0.f) & 0xffffu);
        asm volatile("" ::: "memory");
    }
    if (w < 2) { const int i = w ? 63 - lane : lane; float gv = gt[w * 64 + i];
        gv = wave_scan_dpp(gv);
        const float glast = __builtin_bit_cast(float, __builtin_amdgcn_readlane(__builtin_bit_cast(int, gv), 63)), bt = btk[w * 64 + i], eg = __expf(gv);
        const float es = __expf(glast - gv);
        gct[w * 64 + i] = gv; cu[w * 64 + lane] = bt; cwp[w * 64 + lane] = bt * eg; egp[w * 64 + lane] = eg; esp[w * 64 + lane] = es;
        BA[(tok0 + lane) * 32 + w * 8 + h] = eg; }
    LDS_WAIT(); __syncthreads();
    { const int p = tid >> 3, c8 = tid & 7;
#pragma unroll
      for (int d = 0; d < 2; ++d) { const int i = d ? 63 - p : p; const float es = esp[d * 64 + p], eg = egp[d * 64 + p]; float v[8];
          unpack8(*(const LAS u32x4*)(Kb + i * 144 + c8 * 16), v);
#pragma unroll
          for (int j = 0; j < 8; ++j) v[j] *= es;
          *(LAS u32x4*)(KT + d * 10240 + p * 160 + c8 * 16) = pack8(v);
          unpack8(*(const LAS u32x4*)(Qb + i * 144 + c8 * 16), v);
#pragma unroll
          for (int j = 0; j < 8; ++j) v[j] *= eg;
          *(LAS u32x4*)(QT + d * 9216 + p * 144 + c8 * 16) = pack8(v); } }
    { const int wq = w & 3, tm = wq >> 1, tn = wq & 1, r32 = lane & 31, hi = lane >> 5;
      const LAS unsigned char* X = (w < 4) ? Kb : Qb;
      f32x16 acc;
#pragma unroll
      for (int r = 0; r < 16; ++r) acc[r] = 0.f;
#pragma unroll
      for (int kst = 0; kst < 4; ++kst) {
          const bf16x8 af = *(const LAS bf16x8*)(X + (32 * tm + r32) * 144 + (16 * kst + 8 * hi) * 2), bfr = *(const LAS bf16x8*)(Kb + (32 * tn + r32) * 144 + (16 * kst + 8 * hi) * 2);
          acc = __builtin_amdgcn_mfma_f32_32x32x16_bf16(af, bfr, acc, 0, 0, 0); }
      const int j = 32 * tn + r32; const float gjf = gct[j], gjb = gct[64 + j];
#pragma unroll
      for (int g4 = 0; g4 < 4; ++g4) { const int i0 = 32 * tm + 8 * g4 + 4 * hi;
          const f32x4 gif = *(const LAS f32x4*)(gct + i0), gib = *(const LAS f32x4*)(gct + 64 + i0), bif = *(const LAS f32x4*)(btk + i0), bib = *(const LAS f32x4*)(btk + 64 + i0);
#pragma unroll
          for (int q = 0; q < 4; ++q) { const int i = i0 + q; const float v = acc[4 * g4 + q];
              const float ef = __expf(fminf(gif[q] - gjf, 0.f)), eb = __expf(fminf(gib[q] - gjb, 0.f));
              if (w < 4) {
                  const float lf = (j < i) ? -bif[q] * v * ef : 0.f, lb = (j > i) ? -bib[q] * v * eb : 0.f;
                  *(LAS bf16*)(NL + i * 144 + j * 2) = (bf16)(pk2(lf, 0.f) & 0xffffu);
                  *(LAS bf16*)(NL + 9216 + (63 - i) * 144 + (63 - j) * 2) = (bf16)(pk2(lb, 0.f) & 0xffffu);
              } else {
                  const float qf = (j <= i) ? v * ef : 0.f, qb = (j >= i) ? v * eb : 0.f;
                  *(LAS bf16*)(QKL + i * 144 + j * 2) = (bf16)(pk2(qf, 0.f) & 0xffffu);
                  *(LAS bf16*)(QKL + 9216 + (63 - i) * 144 + (63 - j) * 2) = (bf16)(pk2(qb, 0.f) & 0xffffu);
              } } } }
    LDS_WAIT(); __syncthreads();
    if (w < 2) { const int blk = lane >> 4, col = lane & 15; const LAS unsigned char* nl = NL + w * 9216 + (16 * blk) * 144 + (16 * blk) * 2;
        u32x4 lr[16][2];
#pragma unroll
        for (int r = 1; r < 16; ++r) { lr[r][0] = *(const LAS u32x4*)(nl + r * 144); if (r > 8) lr[r][1] = *(const LAS u32x4*)(nl + r * 144 + 16); }
        float t[16];
#pragma unroll
        for (int r = 0; r < 16; ++r) { float a0 = (r == col) ? 1.f : 0.f, a1 = 0.f;
            if (r > 0) { float l[16]; { float l8[8]; unpack8(lr[r][0], l8);
#pragma unroll
                    for (int q = 0; q < 8; ++q) l[q] = l8[q]; }
                if (r > 8) { float l8[8]; unpack8(lr[r][1], l8);
#pragma unroll
                    for (int q = 0; q < 8; ++q) l[8 + q] = l8[q]; }
#pragma unroll
                for (int q = 0; q < r; ++q) { if (q & 1) a1 += l[q] * t[q]; else a0 += l[q] * t[q]; } }
            t[r] = a0 + a1; }
#pragma unroll
        for (int r = 0; r < 16; ++r) *(LAS bf16*)(TD + w * 3072 + blk * 768 + r * 48 + col * 2) = (bf16)(pk2(t[r], 0.f) & 0xffffu);
    }
    LDS_WAIT(); __syncthreads();
    { const int d = w >> 2, cc = lane & 15, g = lane >> 4;
      const LAS unsigned char* nl = NL + d * 9216; const LAS unsigned char* td = TD + d * 3072 + cc * 48 + 8 * g;
#pragma unroll
      for (int jj = 0; jj < 2; ++jj) { const int ct = 2 * (w & 3) + jj, part = ct >> 2, colb = 16 * (ct & 3);
          const LAS unsigned char* src = part ? Kb : Vb; const LAS float* coef = (part ? cwp : cu) + d * 64;
          f32x4 R[4];
#pragma unroll
          for (int bq = 0; bq < 4; ++bq) { const f32x4 cf = *(const LAS f32x4*)(coef + 16 * bq + 4 * g);
#pragma unroll
              for (int r = 0; r < 4; ++r) { const int p = 16 * bq + 4 * g + r, i = d ? 63 - p : p;
                  R[bq][r] = cf[r] * __uint_as_float((unsigned)(*(const LAS bf16*)(src + i * 144 + (colb + cc) * 2)) << 16); } }
          const f32x4 z4 = (f32x4){0.f, 0.f, 0.f, 0.f};
          f32x4 X0, X1, X2, X3, Y;
          const bf16x8 t0f = frag_lo(td), t1f = frag_lo(td + 768), t2f = frag_lo(td + 2 * 768), t3f = frag_lo(td + 3 * 768);
          const bf16x8 n1f = frag_lo(nl + (16 + cc) * 144 + 8 * g), n2f = frag_2(nl + (32 + cc) * 144 + 8 * g), n3f = frag_2(nl + (48 + cc) * 144 + 8 * g), n3g = frag_lo(nl + (48 + cc) * 144 + 64 + 8 * g);
          __builtin_amdgcn_sched_barrier(0);
          X0 = __builtin_amdgcn_mfma_f32_16x16x32_bf16(t0f, pack_f4z(R[0]), z4, 0, 0, 0);
          Y = __builtin_amdgcn_mfma_f32_16x16x32_bf16(n1f, pack_f4z(X0), R[1], 0, 0, 0);
          X1 = __builtin_amdgcn_mfma_f32_16x16x32_bf16(t1f, pack_f4z(Y), z4, 0, 0, 0);
          const bf16x8 x01 = pack_f4f4(X0, X1);
          Y = __builtin_amdgcn_mfma_f32_16x16x32_bf16(n2f, x01, R[2], 0, 0, 0);
          X2 = __builtin_amdgcn_mfma_f32_16x16x32_bf16(t2f, pack_f4z(Y), z4, 0, 0, 0);
          Y = __builtin_amdgcn_mfma_f32_16x16x32_bf16(n3f, x01, R[3], 0, 0, 0);
          Y = __builtin_amdgcn_mfma_f32_16x16x32_bf16(n3g, pack_f4z(X2), Y, 0, 0, 0);
          X3 = __builtin_amdgcn_mfma_f32_16x16x32_bf16(t3f, pack_f4z(Y), z4, 0, 0, 0);
          const float sgn = part ? -1.f : 1.f;
          const bf16x8 xb0 = pack_f4f4(X0 * sgn, X1 * sgn), xb1 = pack_f4f4(X2 * sgn, X3 * sgn);
          const int q4 = (lane & 15) >> 2, pp = lane & 3;
          const LAS unsigned char* qkl = QKL + d * 9216; const LAS unsigned char* qtl = QT + d * 9216;
          bf16* pA = (d == 0 || part == 1) ? P + tok0 * PLD + h * 64 + (part ? (d ? SAB : SAF) : SBF) : XB2 + tok0 * 512 + h * 64;
          bf16* pC = (d == 0 || part == 1) ? P + tok0 * PLD + h * 64 + (part ? (d ? SCB : SCF) : SDF) : XB2 + (size_t)M * 512 + tok0 * 512 + h * 64;
          const size_t pit = (d == 0 || part == 1) ? PLD : 512;
          const int pc = dn_pcol(colb + cc);
#pragma unroll
          for (int mt = 0; mt < 4; ++mt) {
              s16x4 klo[2], khi[2]; bf16x8 qkf[2]; f32x4 acc2;
              { const unsigned ka = (unsigned)(uintptr_t)(KT + d * 10240) + (4 * g + q4) * 160u + (16 * mt + 4 * pp) * 2u;
                asm volatile("ds_read_b64_tr_b16 %0, %1" : "=&v"(klo[0]) : "v"(ka) : "memory");
                asm volatile("ds_read_b64_tr_b16 %0, %1 offset:2560" : "=&v"(khi[0]) : "v"(ka) : "memory");
                asm volatile("ds_read_b64_tr_b16 %0, %1 offset:5120" : "=&v"(klo[1]) : "v"(ka) : "memory");
                asm volatile("ds_read_b64_tr_b16 %0, %1 offset:7680" : "=&v"(khi[1]) : "v"(ka) : "memory"); }
#pragma unroll
              for (int ks = 0; ks < 2; ++ks) { if (ks == 1 && mt < 2) continue; qkf[ks] = frag_2(qkl + (16 * mt + cc) * 144 + (32 * ks + 4 * g) * 2); }
#pragma unroll
              for (int r = 0; r < 4; ++r) acc2[r] = part ? __uint_as_float((unsigned)(*(const LAS bf16*)(qtl + (16 * mt + 4 * g + r) * 144 + (colb + cc) * 2)) << 16) : 0.f;
              asm volatile("s_waitcnt lgkmcnt(0)" ::: "memory"); __builtin_amdgcn_sched_barrier(0);
              f32x4 acc = z4;
#pragma unroll
              for (int ks = 0; ks < 2; ++ks) { const bf16x8 kf = (bf16x8){klo[ks][0], klo[ks][1], klo[ks][2], klo[ks][3], khi[ks][0], khi[ks][1], khi[ks][2], khi[ks][3]};
                  acc = __builtin_amdgcn_mfma_f32_16x16x32_bf16(kf, ks ? xb1 : xb0, acc, 0, 0, 0); }
#pragma unroll
              for (int ks = 0; ks < 2; ++ks) { if (ks == 1 && mt < 2) continue; acc2 = __builtin_amdgcn_mfma_f32_16x16x32_bf16(qkf[ks], ks ? xb1 : xb0, acc2, 0, 0, 0); }
              if (part == 0) {
                  u32x2 o; o.x = pk2(acc[0], acc[1]); o.y = pk2(acc[2], acc[3]); *(u32x2*)(pA + (size_t)(colb + cc) * pit + 16 * mt + 4 * g) = o;
                  o.x = pk2(acc2[0], acc2[1]); o.y = pk2(acc2[2], acc2[3]); *(u32x2*)(pC + (size_t)(colb + cc) * pit + 16 * mt + 4 * g) = o; }
              else {
#pragma unroll
                  for (int r = 0; r < 4; ++r) { pA[(size_t)(16 * mt + 4 * g + r) * pit + pc] = (bf16)(pk2(acc[r], 0.f) & 0xffffu); pC[(size_t)(16 * mt + 4 * g + r) * pit + pc] = (bf16)(pk2(acc2[r], 0.f) & 0xffffu); } }
              __builtin_amdgcn_sched_barrier(0);
          }
          asm volatile("" ::: "memory"); __builtin_amdgcn_sched_barrier(0);
      } }
    LDS_WAIT(); __syncthreads();
  }
#undef DN_PREFETCH
}

constexpr int DNX_A = 0, DNX_C = 8192, DNX_BT = 16384, DNX_DT = 24576, DNX_EG = 32768, DNX_SZ = 33792, DNX_OST = 3 * DNX_SZ;
__device__ __forceinline__ void dn_scan_step(const LAS unsigned char* buf, f32x4 (&Sacc)[4], int ws, int lane, LAS unsigned char* ost, int dir) {
    const int c = lane & 15, g = lane >> 4;
    const unsigned trow = 16 * ws + c, t0 = trow * 128u + ((((unsigned)(g >> 1)) ^ ((trow >> 1) & 7u)) << 4) + 8u * (g & 1);
    u32x2 bt[4], dt[4]; bf16x8 af[4][2], cf[4][2];
#pragma unroll
    for (int mt = 0; mt < 4; ++mt) { const unsigned row = 16 * mt + c, a0 = row * 128u + ((((unsigned)g) ^ ((row >> 1) & 7u)) << 4);
        bt[mt] = *(const LAS u32x2*)(buf + DNX_BT + (t0 ^ ((unsigned)mt << 5)));
#pragma unroll
        for (int ks = 0; ks < 2; ++ks) af[mt][ks] = *(const LAS bf16x8*)(buf + DNX_A + (a0 ^ ((unsigned)ks << 6))); }
#pragma unroll
    for (int mt = 0; mt < 4; ++mt) { const unsigned row = 16 * mt + c, a0 = row * 128u + ((((unsigned)g) ^ ((row >> 1) & 7u)) << 4);
        dt[mt] = *(const LAS u32x2*)(buf + DNX_DT + (t0 ^ ((unsigned)mt << 5)));
#pragma unroll
        for (int ks = 0; ks < 2; ++ks) cf[mt][ks] = *(const LAS bf16x8*)(buf + DNX_C + (a0 ^ ((unsigned)ks << 6))); }
    const float gm = ((const LAS float*)(buf + DNX_EG))[63];
    bf16x8 Sb[2];
#pragma unroll
    for (int ks = 0; ks < 2; ++ks) Sb[ks] = pack_f4f4(Sacc[2 * ks], Sacc[2 * ks + 1]);
    __builtin_amdgcn_sched_barrier(0);
#pragma unroll
    for (int mt = 0; mt < 4; ++mt) { f32x4 sn = Sacc[mt] * gm + (f32x4){bf_lo(bt[mt].x), bf_hi(bt[mt].x), bf_lo(bt[mt].y), bf_hi(bt[mt].y)};
#pragma unroll
        for (int ks = 0; ks < 2; ++ks) sn = __builtin_amdgcn_mfma_f32_16x16x32_bf16(af[mt][ks], Sb[ks], sn, 0, 0, 0);
        Sacc[mt] = sn; }
#pragma unroll
    for (int mt = 0; mt < 4; ++mt) { f32x4 oa = (f32x4){bf_lo(dt[mt].x), bf_hi(dt[mt].x), bf_lo(dt[mt].y), bf_hi(dt[mt].y)};
#pragma unroll
        for (int ks = 0; ks < 2; ++ks) oa = __builtin_amdgcn_mfma_f32_16x16x32_bf16(cf[mt][ks], Sb[ks], oa, 0, 0, 0);
#pragma unroll
        for (int r = 0; r < 4; ++r) { const int p = 16 * mt + 4 * g + r, i = dir ? 63 - p : p;
            *(LAS bf16*)(ost + i * 128 + (16 * ws + c) * 2) = (bf16)(pk2(oa[r], 0.f) & 0xffffu); } }
}
__device__ __forceinline__ void dn_scan_unit(Frame& F, const Args& a, int b, int h, int dir) {
    bf16* P = (bf16*)(a.ws + WS_P);
    const int w = F.wave, lane = F.lane;
#define DN_BAR() do { asm volatile("s_waitcnt lgkmcnt(0)" ::: "memory"); __builtin_amdgcn_s_barrier(); asm volatile("" ::: "memory"); } while (0)
    if (w < 4) {
        f32x4 Sacc[4];
#pragma unroll
        for (int mt = 0; mt < 4; ++mt) Sacc[mt] = (f32x4){0.f, 0.f, 0.f, 0.f};
        bf16* Ob = P + (size_t)b * SEQ * PLD + (dir ? C_OB : C_OF) + h * 64;
        DN_BAR();
        int slot = 0;
#pragma unroll 1
        for (int s = 0; s <= 128; ++s) {
            if (s > 0) { const int cp = dir ? 128 - s : s - 1; const LAS unsigned char* st = F.lds + DNX_OST + ((s - 1) & 1) * 8192;
#pragma unroll
                for (int k = 0; k < 2; ++k) { const int idx = F.tid + 256 * k, row = idx >> 3, ch = idx & 7;
                    *(u32x4*)(Ob + ((size_t)cp * 64 + row) * PLD + ch * 8) = *(const LAS u32x4*)(st + row * 128 + ch * 16); } }
            if (s < 128) dn_scan_step(F.lds + slot * DNX_SZ, Sacc, w, lane, F.lds + DNX_OST + (s & 1) * 8192, dir);
            slot = slot == 2 ? 0 : slot + 1;
            DN_BAR();
        }
    } else {
        const int hw = w - 4;
        const bf16* XB2 = (const bf16*)a.out + (size_t)M * 1024;
        const float* BAg = (const float*)(a.ws + WS_BA);
        const char* gp[8]; long gstep[8];
#pragma unroll
        for (int i = 0; i < 8; ++i) { const int pid = hw * 8 + i, blk = pid >> 3, pc = pid & 7, r = 8 * pc + (lane >> 3), cp = lane & 7;
            const int key = (r >> 1) & 7, cs = cp ^ key;
            const size_t tokb = (size_t)b * SEQ;
            if (dir == 1 && blk >= 2) { gp[i] = (const char*)(XB2 + (size_t)(blk - 2) * M * 512 + (tokb + r) * 512 + h * 64 + cs * 8); gstep[i] = 64L * 512 * 2; }
            else { const int col = blk == 0 ? (dir ? SAB : SAF) : blk == 1 ? (dir ? SCB : SCF) : blk == 2 ? SBF : SDF;
                   gp[i] = (const char*)(P + (tokb + r) * PLD + col + h * 64 + cs * 8); gstep[i] = 64L * PLD * 2; } }
        const char* ggc = (const char*)(BAg + ((size_t)b * SEQ + lane) * 32 + dir * 8 + h);
#define DN_ISSUE(n, slot_) do { const int cn_ = dir ? 127 - (n) : (n); LAS unsigned char* sb_ = F.lds + (slot_) * DNX_SZ; \
        _Pragma("unroll") for (int i = 0; i < 8; ++i) { const int pid = hw * 8 + i; \
            __builtin_amdgcn_global_load_lds((const unsigned*)(gp[i] + (long)cn_ * gstep[i]), (LAS unsigned*)(sb_ + (pid >> 3) * 8192 + (pid & 7) * 1024), 16, 0, 0); } \
        __builtin_amdgcn_global_load_lds((const unsigned*)(ggc + (long)cn_ * (64L * 32 * 4)), (LAS unsigned*)(sb_ + DNX_EG + hw * 256), 4, 0, 0); } while (0)
        DN_ISSUE(0, 0); DN_ISSUE(1, 1);
        asm volatile("s_waitcnt vmcnt(9)" ::: "memory");
        DN_BAR();
        int slot2 = 2;
#pragma unroll 1
        for (int s = 0; s <= 128; ++s) {
            if (s + 2 < 128) { DN_ISSUE(s + 2, slot2); asm volatile("s_waitcnt vmcnt(9)" ::: "memory"); }
            else { asm volatile("s_waitcnt vmcnt(0)" ::: "memory"); }
            slot2 = slot2 == 2 ? 0 : slot2 + 1;
            DN_BAR();
        }
#undef DN_ISSUE
    }
#undef DN_BAR
    __syncthreads();
}
__device__ __forceinline__ void dn_combine(Frame& F, const Args& a) {
    bf16* P = (bf16*)(a.ws + WS_P);
    const float* og = a.in[11];
    const int gw = F.vcu * NWAVES + F.wave, NGW = F.G * NWAVES, c0 = F.lane * 8;
    for (int row = gw; row < M; row += NGW) {
        bf16* rp = P + (size_t)row * PLD;
        float of[8], ob[8]; unpack8(*(const u32x4*)(rp + C_OF + c0), of); unpack8(*(const u32x4*)(rp + C_OB + c0), ob);
        float s[8], ss = 0.f;
#pragma unroll
        for (int j = 0; j < 8; ++j) { s[j] = of[j] + ob[j]; ss += s[j] * s[j]; }
        ss = group8_sum_dpp(ss);
        const float rstd = __builtin_amdgcn_rsqf(ss * (1.0f / 64) + EPS);
        bf16* zp = rp + C_DZ + c0; float z[8]; unpack8(*(const u32x4*)zp, z);
        const f32x4 g0 = *(const f32x4*)(og + (c0 & 63)), g1 = *(const f32x4*)(og + (c0 & 63) + 4);
        float y[8];
#pragma unroll
        for (int j = 0; j < 4; ++j) { y[j] = s[j] * rstd * g0[j] * siluf_(z[j]); y[4 + j] = s[4 + j] * rstd * g1[j] * siluf_(z[4 + j]); }
        *(u32x4*)zp = pack8(y);
    }
}
__device__ __forceinline__ void ffn_fixup_panel(Frame& F, const Args& a, int pm) {
    bf16* P = (bf16*)(a.ws + WS_P); const float* UE = (const float*)(a.ws + WS_UE);
    const float* cw = a.in[22]; const float* cb = a.in[23];
#pragma unroll 2
    for (int e = F.tid; e < 8 * (DFF / 4); e += 512) { const int k = e / (DFF / 4), ch = (e % (DFF / 4)) * 4, g = pm * 4 + (k >> 1), last = k & 1;
        const int row = g * 64 + (last ? 63 : 0);
        const bool hp = last ? true : (row % SEQ) != 0, hn = last ? (row % SEQ) != SEQ - 1 : true;
        const float* pu = UE + ((size_t)(last ? g : (g > 0 ? g - 1 : 0)) * 4 + (last ? 2 : 3)) * NUP;
        const float* cu = UE + ((size_t)g * 4 + (last ? 3 : 0)) * NUP;
        const float* nu = UE + ((size_t)(last ? (g < 511 ? g + 1 : 511) : g) * 4 + (last ? 0 : 1)) * NUP;
        const f32x4 z = (f32x4){0.f, 0.f, 0.f, 0.f};
        const f32x4 pg = hp ? *(const f32x4*)(pu + ch) : z, pv = hp ? *(const f32x4*)(pu + DFF + ch) : z, ng = hn ? *(const f32x4*)(nu + ch) : z, nv = hn ? *(const f32x4*)(nu + DFF + ch) : z;
        const f32x4 cg = *(const f32x4*)(cu + ch), cv = *(const f32x4*)(cu + DFF + ch);
        const f32x4 gate = *(const f32x4*)(cw + ch) * pg + *(const f32x4*)(cw + NUP + ch) * cg + *(const f32x4*)(cw + 2 * NUP + ch) * ng + *(const f32x4*)(cb + ch);
        const f32x4 val = *(const f32x4*)(cw + DFF + ch) * pv + *(const f32x4*)(cw + NUP + DFF + ch) * cv + *(const f32x4*)(cw + 2 * NUP + DFF + ch) * nv + *(const f32x4*)(cb + DFF + ch);
        u32x2 w; w.x = pk2(siluf_(gate[0]) * val[0], siluf_(gate[1]) * val[1]); w.y = pk2(siluf_(gate[2]) * val[2], siluf_(gate[3]) * val[3]);
        *(u32x2*)(P + (size_t)row * PLD + C_ACT + ch) = w; }
}

__global__ void __launch_bounds__(NWAVES * 64, 2) fwd_kernel(Args args) {
    extern __shared__ __attribute__((aligned(16))) unsigned char lds[];
    Frame F;
    F.lds = (LAS unsigned char*)lds;
    F.MISC = (volatile LAS unsigned*)(F.lds + MISC_OFF);
    F.tid = threadIdx.x; F.lane = F.tid & 63; F.wave = __builtin_amdgcn_readfirstlane(F.tid >> 6);
    F.G = gridDim.x; { const int bx = blockIdx.x; F.vcu = (F.G % 8 == 0) ? (bx % 8) * (F.G / 8) + bx / 8 : bx; }
    unsigned char* ws = args.ws;
    F.ctl = (gu32*)(ws + WS_CTL);
    for (int u = F.tid; u < (LDS_BYTES - LDSCTL_OFF) / 4; u += NWAVES * 64) ((LAS unsigned*)(F.lds + LDSCTL_OFF))[u] = 0u;
    __syncthreads();
    const int lo = args.ph_lo, hi = args.ph_hi;
    const bool single = (hi - lo) > 1;
    XcdBarrier bar; bar.bar = (unsigned*)(F.ctl + CW_BAR); bar.x = 0; bar.st = nullptr;
    if (single) bar = xcd_barrier_post((unsigned*)(F.ctl + CW_BAR), F.MISC + 8);
#ifndef PH_MASK
#define PH_MASK 0x1FF
#endif
#define IN(k) (((PH_MASK >> (k)) & 1) && lo <= (k) && (k) < hi)
#define SEAM(k) do { if (IN(k) && IN((k) + 1)) xcd_barrier(bar); } while (0)
    bf16* P = (bf16*)(ws + WS_P);
    const int bid = (int)blockIdx.x;
#define TS(k) do {} while (0)
#define TSB(k, blk) do {} while (0)
    TS(0);

    if (IN(0)) { p0_prologue(F, args); }
    SEAM(0); TS(1);
    if (IN(1)) {
        { pg8::Gemm g{(const bf16*)args.out, (const bf16*)(ws + WS_WIN), M, 3584, 1024, 1024, 1024}; pg8::StaticOrder S; S.init(M, 3584, F.G, bid);
          EpiInProj E{P, (float*)(ws + WS_BA)};
          pg8::gemm_phase<EpiInProj, pg8::StaticOrder, true, true>(F.lds + RING_OFF, g, S, E); }
        { pg8::Gemm g{(const bf16*)(ws + WS_MEMN), (const bf16*)(ws + WS_WKV), BATCH * NMEM, 1024, 1024, 1024, 1024}; pg8::StaticOrder S; S.init(BATCH * NMEM, 1024, F.G, bid);
          EpiBf16 E{(bf16*)(ws + WS_KV), 1024};
          pg8::gemm_phase<EpiBf16, pg8::StaticOrder, true, true>(F.lds + RING_OFF, g, S, E); }
    }
    SEAM(1); TS(2);
    if (IN(2)) {
        const bool full = F.G == 256; const int nU = full ? 256 : 4096;
        for (int u = bid; u < nU; u += F.G) { const int uu = full ? u * 16 : u; dn_prep_block(F, args, uu >> 10, (uu >> 7) & 7, uu & 127, full ? 16 : 1); }
    }
    TS(12); SEAM(2); TS(3);
    if (IN(3)) {
        const int ndn = F.G >= 128 ? 64 : 0;
        if (args.mode != 2) for (int u = (ndn ? (bid < ndn ? bid : 64) : bid); u < 64; u += (ndn ? 64 : F.G)) dn_scan_unit(F, args, u >> 4, (u >> 1) & 7, u & 1);
        if (bid >= ndn && args.mode != 1) { const int nb = F.G - ndn, me = bid - ndn;
            for (int u = me; u < 1024; u += nb) {
                if (u < 512) attnA_unit(F, args, u >> 7, (u >> 1) & 63, u & 1);
                else { const int v = u - 512; xattn_unit(F, args, v >> 7, (v >> 2) & 31, v & 3); }
            }
            weight_items(F, args, WI_EARLY, WI_ALL, me * NWAVES + F.wave, nb * NWAVES);
        }
    }
    TS(10); TSB(11, 64); SEAM(3); TS(4);
    if (IN(4)) {
        dn_combine(F, args);
        pg8::Gemm g{(const bf16*)args.out, (const bf16*)(ws + WS_WIN) + (size_t)3584 * 1024, M, 3072, 1024, 1024, 1024}; pg8::StaticOrder S; S.init(M, 3072, F.G, bid);
        EpiGatesU8 E{P};
        pg8::gemm_phase<EpiGatesU8, pg8::StaticOrder, true, true>(F.lds + RING_OFF, g, S, E);
    }
    SEAM(4); TS(5);
    if (IN(5)) {
        pg8::Gemm g{P + C_AQ, (const bf16*)(ws + WS_WBR), M, 1024, 1536, PLD, 512};
        g.segt = 8; g.aoff1 = (long)(C_DZ - C_AQ) * 2 - 8 * 128; g.aoff2 = (long)(C_MQ - C_AQ) * 2 - 16 * 128;
        g.boff1 = (long)1024 * 512 * 2 - 8 * 128; g.boff2 = (long)2 * 1024 * 512 * 2 - 16 * 128;
        pg8::StaticOrder S; S.init(M, 1024, F.G, bid);
        EpiMerge E{P}; pg8::gemm_phase<EpiMerge, pg8::StaticOrder, true, true>(F.lds + RING_OFF, g, S, E);
    }
    SEAM(5); TS(6);
    if (IN(6)) {
        pg8::Gemm g{P + C_MG, (const bf16*)(ws + WS_WOUT), M, 1024, 1024, PLD, 1024}; pg8::StaticOrder S; S.init(M, 1024, F.G, bid);
        EpiWout E{args.in[0], args.out, P, (float*)(ws + WS_SSQ), (LAS float*)(F.lds + XCH_OFF)};
        pg8::gemm_phase<EpiWout, pg8::StaticOrder, true, true>(F.lds + RING_OFF, g, S, E);
    }
    SEAM(6); TS(7);
    if (IN(7)) {
        pg8::Gemm g{P + C_X1B, (const bf16*)(ws + WS_WUP), M, NUP, 1024, PLD, 1024}; pg8::StaticOrder S; S.init(M, NUP, F.G, bid);
        EpiUp E{(const float*)(ws + WS_SSQ), args.in[22], args.in[23], P, (float*)(ws + WS_UE), (LAS float*)(F.lds + XCH_OFF)};
        pg8::gemm_phase<EpiUp, pg8::StaticOrder, true, true>(F.lds + RING_OFF, g, S, E);
    }
    SEAM(7); TS(8);
    if (IN(8)) {
        pg8::Gemm g{P + C_ACT, (const bf16*)(ws + WS_WDN), M, 1024, DFF, PLD, DFF}; pg8::StaticOrder S; S.init(M, 1024, F.G, bid);
        { Unit u; int prev = -1; for (int i = 0; S.next(i, u); ++i) { if (u.pm != prev) ffn_fixup_panel(F, args, u.pm); prev = u.pm; } }
        VM_WAIT(); __syncthreads();
        EpiDown E{args.out, P};
        pg8::gemm_phase<EpiDown, pg8::StaticOrder, true, true>(F.lds + RING_OFF, g, S, E);
    }
    TS(9);
#undef IN
#undef SEAM
}

#ifdef DBG_TIME
__global__ void dbg_ts_kernel(unsigned char* ws, int k) { if (threadIdx.x == 0) ((unsigned long long*)(ws + WS_CTL + 65536))[k] = __builtin_amdgcn_s_memrealtime(); }
__global__ void dbg_wait_kernel(unsigned char* ws) {
    if (threadIdx.x == 0) { const unsigned long long* tsb = (const unsigned long long*)(ws + WS_CTL + 65536);
        const unsigned long long te = __builtin_amdgcn_s_memrealtime();
        const unsigned long long d1 = tsb[DBG_A1] - tsb[DBG_A0], d2 = tsb[DBG_B1] - tsb[DBG_B0];
        const unsigned long long W = d1 + 100000ull * (d2 / 1000ull);
        while (__builtin_amdgcn_s_memrealtime() - te < W) __builtin_amdgcn_s_sleep(32); }
}
#endif
constexpr int N_PHASES = 9;
#ifndef MK_PER_PHASE
#define MK_PER_PHASE 0
#endif
extern "C" void kernel_launch(void* const* d_in, const int* in_sizes, int n_in, void* d_out, int out_size, void* d_ws, size_t ws_size, hipStream_t stream) {
    static int grid = 0;
    if (grid == 0) {
        if (n_in != 25 || in_sizes[0] != M * DM || out_size != M * DM || ws_size < WS_END) {
            fprintf(stderr, "kernel_launch: unexpected shapes (n_in %d, in0 %d, out %d, ws %zu); nothing launched\n", n_in, n_in > 0 ? in_sizes[0] : -1, out_size, ws_size); grid = -1; return; }
        int dev = 0, cus = 0, per_cu = 0;
        if (hipGetDevice(&dev) != hipSuccess || hipDeviceGetAttribute(&cus, hipDeviceAttributeMultiprocessorCount, dev) != hipSuccess) { grid = -1; return; }
        if (hipFuncSetAttribute((const void*)fwd_kernel, hipFuncAttributeMaxDynamicSharedMemorySize, LDS_BYTES) != hipSuccess) { fprintf(stderr, "kernel_launch: hipFuncSetAttribute failed\n"); grid = -1; return; }
        if (hipOccupancyMaxActiveBlocksPerMultiprocessor(&per_cu, (const void*)fwd_kernel, NWAVES * 64, LDS_BYTES) != hipSuccess || per_cu < 1) { fprintf(stderr, "kernel_launch: occupancy query reports %d\n", per_cu); }
        (void)hipGetLastError();
        grid = cus;
    }
    if (grid < 0) return;
    if (hipMemsetAsync((char*)d_ws + WS_CTL, 0, CTL_ZERO_BYTES, stream) != hipSuccess) return;
    Args a{};
    for (int i = 0; i < 25; ++i) a.in[i] = (const float*)d_in[i];
    a.out = (float*)d_out; a.ws = (unsigned char*)d_ws;
#ifdef DBG_TIME
    for (int p = 0; p < N_PHASES; ++p) { hipLaunchKernelGGL(dbg_ts_kernel, dim3(1), dim3(64), 0, stream, (unsigned char*)d_ws, p);
        a.ph_lo = p; a.ph_hi = p + 1;
        if (p == 3) { a.mode = 1; hipLaunchKernelGGL(fwd_kernel, dim3(grid), dim3(NWAVES * 64), LDS_BYTES, stream, a); hipLaunchKernelGGL(dbg_ts_kernel, dim3(1), dim3(64), 0, stream, (unsigned char*)d_ws, 12); a.mode = 2; }
        hipLaunchKernelGGL(fwd_kernel, dim3(grid), dim3(NWAVES * 64), LDS_BYTES, stream, a); a.mode = 0; }
    hipLaunchKernelGGL(dbg_ts_kernel, dim3(1), dim3(64), 0, stream, (unsigned char*)d_ws, N_PHASES);
    hipLaunchKernelGGL(dbg_wait_kernel, dim3(1), dim3(64), 0, stream, (unsigned char*)d_ws);
    return;
#endif
    if (MK_PER_PHASE) {
        for (int p = 0; p < N_PHASES; ++p) { a.ph_lo = p; a.ph_hi = p + 1; hipLaunchKernelGGL(fwd_kernel, dim3(grid), dim3(NWAVES * 64), LDS_BYTES, stream, a); }
    } else {
        a.ph_lo = 0; a.ph_hi = N_PHASES; hipLaunchKernelGGL(fwd_kernel, dim3(grid), dim3(NWAVES * 64), LDS_BYTES, stream, a);
    }
}
```

```cpp
#include <hip/hip_runtime.h>
#include <cstdio>
#include <cstdint>
#include <cmath>
namespace pg8 {
#define PG8_LAS __attribute__((address_space(3)))
typedef unsigned short bf16_t;
typedef short bf16x8 __attribute__((ext_vector_type(8)));
typedef float f32x4 __attribute__((ext_vector_type(4)));
typedef unsigned u32x4 __attribute__((ext_vector_type(4)));
constexpr int BM = 256, BK = 64, HALF = 128, HTB = HALF * BK * 2  , STAGE_BYTES = 8 * HTB, NXCD = 8, WGM = 8;

__host__ __device__ __forceinline__ int lds_byte(int r, int c) { const int st = (r >> 4) * 2 + (c >> 5), rr = r & 15, cc = c & 31, ob = rr * 64 + cc * 2; return st * 1024 + (ob ^ (((ob >> 9) & 1) << 5)); }
__host__ __device__ __forceinline__ void stage_rc(int b, int& R, int& C) { const int st = b / 1024, sb = b % 1024, swz = sb ^ (((sb >> 9) & 1) << 5); R = (st >> 1) * 16 + swz / 64; C = (st & 1) * 32 + (swz % 64) / 2; }
__host__ __device__ __forceinline__ int perm32(int rho) { const int n = rho >> 4, i = rho & 15; return 8 * (i >> 2) + 4 * n + (i & 3); }

struct Unit { int pm, pn, aux; };
struct Gemm { const bf16_t* A; const bf16_t* Bt; int M, N, K, lda, ldb; int segt = 1 << 30; long aoff1 = 0, aoff2 = 0, boff1 = 0, boff2 = 0; };

struct StaticOrder {
    int nM, nN, nwg, G, c;
    __host__ __device__ __forceinline__ void init(int M, int N, int G_, int c_) { nM = M / BM; nN = N / BM; nwg = nM * nN; G = G_; c = c_; }
    __host__ __device__ __forceinline__ bool next(int i, Unit& u) const {
        const long L = (long)i * G + c; if (L >= nwg) return false;
        int wgid = (int)L; { const int q = nwg / NXCD, r = nwg % NXCD, xcd = wgid % NXCD, off = wgid / NXCD; wgid = (xcd < r ? xcd * (q + 1) : r * (q + 1) + (xcd - r) * q) + off; }
        const int nig = WGM * nN, gid = wgid / nig, fm = gid * WGM, gsz = (nM - fm) < WGM ? (nM - fm) : WGM;
        u.pm = fm + ((wgid % nig) % gsz); u.pn = (wgid % nig) / gsz; return true;
    }
    __device__ __forceinline__ void a_ready(const Unit&) const {}
    __device__ __forceinline__ void done(const Unit&) const {}
};

template <class Epi, class Sched, bool ALIGN_EPI = false, bool SP2 = false>
__device__ __forceinline__ void gemm_phase(PG8_LAS unsigned char* lds, const Gemm g, const Sched& S, const Epi& E) {
    const int tid = threadIdx.x, wid = __builtin_amdgcn_readfirstlane(tid >> 6), lane = tid & 63, wr = wid >> 2, wc = wid & 3, fr = lane & 15, fq = lane >> 4;
    const int K = g.K, nt = K / BK;
    unsigned voffA[2], voffB[2];
#pragma unroll
    for (int i = 0; i < 2; ++i) { int R, C; stage_rc(tid * 16 + i * 8192, R, C); const int Rb = Epi::PERM ? ((R & ~31) + perm32(R & 31)) : R;
        voffA[i] = (unsigned)(R * g.lda + C) * 2u; voffB[i] = (unsigned)(Rb * g.ldb + C) * 2u; }
    const size_t kstep = (size_t)(BK * 2);
    const size_t hstepA = (size_t)HALF * g.lda * 2, hstepB = (size_t)HALF * g.ldb * 2;
    const size_t tstepA = 2 * hstepA, tstepB = 2 * hstepB;
    const unsigned ldsw = (unsigned)wid * 1024u;
    const int aoff = lds_byte(wr * 64 + fr, fq * 8), boff = lds_byte(wc * 32 + fr, fq * 8);
#define PG8_SA(b, h) (((b) * 2 + (h)) * HTB)
#define PG8_SB(b, h) ((4 + (b) * 2 + (h)) * HTB)
#define PG8_STAGE(bufoff, gbase, voff) do { _Pragma("unroll") for (int _i = 0; _i < 2; ++_i) \
        __builtin_amdgcn_global_load_lds((const unsigned*)((const char*)(gbase) + (voff)[_i]), (PG8_LAS unsigned*)(lds + (bufoff) + ldsw + _i * 8192), 16, 0, 0); } while (0)
#define PG8_LDA(dst, b, h) do { _Pragma("unroll") for (int m = 0; m < 4; ++m) _Pragma("unroll") for (int k = 0; k < 2; ++k) dst[m][k] = *(const PG8_LAS bf16x8*)(lds + PG8_SA(b, h) + aoff + m * 2048 + k * 1024); } while (0)
#define PG8_LDB(dst, b, h) do { _Pragma("unroll") for (int n = 0; n < 2; ++n) _Pragma("unroll") for (int k = 0; k < 2; ++k) dst[n][k] = *(const PG8_LAS bf16x8*)(lds + PG8_SB(b, h) + boff + n * 2048 + k * 1024); } while (0)
#define PG8_MMA(ai, bj, At, Bt) do { __builtin_amdgcn_s_setprio(1); _Pragma("unroll") for (int m = 0; m < 4; ++m) _Pragma("unroll") for (int n = 0; n < 2; ++n) _Pragma("unroll") for (int k = 0; k < 2; ++k) \
        acc[ai][bj][m][n] = __builtin_amdgcn_mfma_f32_16x16x32_bf16(Bt[n][k], At[m][k], acc[ai][bj][m][n], 0, 0, 0); __builtin_amdgcn_s_setprio(0); } while (0)
#define PG8_WAIT_V(n) asm volatile("s_waitcnt vmcnt(" #n ")" ::: "memory")
#define PG8_WAIT_L(n) asm volatile("s_waitcnt lgkmcnt(" #n ")" ::: "memory")
#define PG8_BAR __builtin_amdgcn_s_barrier()
#define PG8_SCHED __builtin_amdgcn_sched_barrier(0)
    Unit cur, nxt; int ui = 0;
    if (!S.next(0, cur)) return;
    if constexpr (Epi::PREFETCH) E.prefetch(cur, 0, tid);
    f32x4 acc[2][2][4][2];
#pragma unroll
    for (int a = 0; a < 2; ++a)
#pragma unroll
        for (int b = 0; b < 2; ++b)
#pragma unroll
            for (int m = 0; m < 4; ++m)
#pragma unroll
                for (int n = 0; n < 2; ++n) acc[a][b][m][n] = (f32x4){0.f, 0.f, 0.f, 0.f};
    bf16x8 At[4][2], B0[2][2], B1[2][2];
    const char* cA = (const char*)g.A + (size_t)cur.pm * tstepA; const char* cB = (const char*)g.Bt + (size_t)cur.pn * tstepB;
    S.a_ready(cur);
    if constexpr (SP2) {
        PG8_STAGE(PG8_SB(0, 0), cB, voffB); PG8_STAGE(PG8_SB(0, 1), cB + hstepB, voffB); PG8_STAGE(PG8_SA(0, 0), cA, voffA); PG8_STAGE(PG8_SA(0, 1), cA + hstepA, voffA);
        if (wr == 1) PG8_BAR;
        PG8_WAIT_V(2); PG8_BAR;
        PG8_STAGE(PG8_SB(1, 0), cB + kstep, voffB); PG8_STAGE(PG8_SA(1, 0), cA + kstep, voffA); PG8_STAGE(PG8_SB(1, 1), cB + hstepB + kstep, voffB);
        PG8_WAIT_V(6); PG8_BAR;
    } else {
        PG8_STAGE(PG8_SB(0, 0), cB, voffB); PG8_STAGE(PG8_SA(0, 0), cA, voffA); PG8_STAGE(PG8_SB(0, 1), cB + hstepB, voffB); PG8_STAGE(PG8_SA(0, 1), cA + hstepA, voffA);
        if (wr == 1) PG8_BAR;
        PG8_WAIT_V(4); PG8_BAR;
        PG8_STAGE(PG8_SB(1, 0), cB + kstep, voffB); PG8_STAGE(PG8_SA(1, 0), cA + kstep, voffA); PG8_STAGE(PG8_SB(1, 1), cB + hstepB + kstep, voffB);
        PG8_WAIT_V(6); PG8_BAR;
    }
    for (;;) {
        const bool has_next = S.next(ui + 1, nxt);
        const char* nA = has_next ? (const char*)g.A + (size_t)nxt.pm * tstepA : cA; const char* nB = has_next ? (const char*)g.Bt + (size_t)nxt.pn * tstepB : cB;
        for (int t = 0; t < nt; t += 2) {
            const bool last = (t == nt - 2);
            if constexpr (Epi::RESCALE) { if (t == g.segt || t == 2 * g.segt) E.rescale(acc, cur, wr, wc, fr, fq, t / g.segt); }
            const long so1 = (t + 1 >= 2 * g.segt) ? g.aoff2 : ((t + 1 >= g.segt) ? g.aoff1 : 0), so2 = (t + 2 >= 2 * g.segt) ? g.aoff2 : ((t + 2 >= g.segt) ? g.aoff1 : 0), sb2 = (t + 2 >= 2 * g.segt) ? g.boff2 : ((t + 2 >= g.segt) ? g.boff1 : 0);
            const char* a1 = cA + so1 + (size_t)(t + 1) * kstep;
            const char* a2 = last ? nA : cA + so2 + (size_t)(t + 2) * kstep; const char* b2 = last ? nB : cB + sb2 + (size_t)(t + 2) * kstep;
            const char* a3 = a2 + kstep; const char* b3 = b2 + kstep;
            if (last && has_next) S.a_ready(nxt);
            if constexpr (SP2) {
            PG8_LDB(B0, 0, 0); PG8_LDB(B1, 0, 1); PG8_SCHED; PG8_LDA(At, 0, 0); PG8_STAGE(PG8_SA(1, 1), a1 + hstepA, voffA);
            PG8_WAIT_V(8); PG8_WAIT_L(0); PG8_BAR; PG8_MMA(0, 0, At, B0); PG8_MMA(0, 1, At, B1); PG8_BAR; PG8_SCHED;
            PG8_LDA(At, 0, 1); PG8_STAGE(PG8_SB(0, 0), b2, voffB); PG8_STAGE(PG8_SB(0, 1), b2 + hstepB, voffB); PG8_STAGE(PG8_SA(0, 0), a2, voffA);
            PG8_WAIT_V(8); PG8_WAIT_L(0); PG8_BAR; PG8_MMA(1, 0, At, B0); PG8_MMA(1, 1, At, B1); PG8_BAR; PG8_SCHED;
            PG8_LDB(B0, 1, 0); PG8_LDB(B1, 1, 1); PG8_SCHED; PG8_LDA(At, 1, 0); PG8_STAGE(PG8_SA(0, 1), a2 + hstepA, voffA);
            PG8_WAIT_V(8); PG8_WAIT_L(0); PG8_BAR; PG8_MMA(0, 0, At, B0); PG8_MMA(0, 1, At, B1); PG8_BAR; PG8_SCHED;
            PG8_LDA(At, 1, 1); PG8_STAGE(PG8_SB(1, 0), b3, voffB); PG8_STAGE(PG8_SB(1, 1), b3 + hstepB, voffB); PG8_STAGE(PG8_SA(1, 0), a3, voffA);
            PG8_WAIT_V(8); PG8_WAIT_L(0); PG8_BAR; PG8_MMA(1, 0, At, B0); PG8_MMA(1, 1, At, B1); PG8_BAR; PG8_SCHED;
            } else {
            PG8_LDB(B0, 0, 0); PG8_SCHED; PG8_LDA(At, 0, 0); PG8_STAGE(PG8_SA(1, 1), a1 + hstepA, voffA);
            PG8_WAIT_L(8); PG8_BAR; PG8_WAIT_L(0); PG8_MMA(0, 0, At, B0); PG8_BAR; PG8_SCHED;
            PG8_LDB(B1, 0, 1); PG8_STAGE(PG8_SB(0, 0), b2, voffB);
            PG8_BAR; PG8_WAIT_L(0); PG8_MMA(0, 1, At, B1); PG8_BAR;
            PG8_LDA(At, 0, 1); PG8_STAGE(PG8_SA(0, 0), a2, voffA);
            PG8_BAR; PG8_WAIT_L(0); PG8_MMA(1, 0, At, B0); PG8_BAR; PG8_SCHED;
            PG8_STAGE(PG8_SB(0, 1), b2 + hstepB, voffB);
            PG8_WAIT_V(6); PG8_BAR; PG8_MMA(1, 1, At, B1); PG8_BAR;
            PG8_LDB(B0, 1, 0); PG8_SCHED; PG8_LDA(At, 1, 0); PG8_STAGE(PG8_SA(0, 1), a2 + hstepA, voffA);
            PG8_WAIT_L(8); PG8_BAR; PG8_WAIT_L(0); PG8_MMA(0, 0, At, B0); PG8_BAR; PG8_SCHED;
            PG8_LDB(B1, 1, 1); PG8_STAGE(PG8_SB(1, 0), b3, voffB);
            PG8_BAR; PG8_WAIT_L(0); PG8_MMA(0, 1, At, B1); PG8_BAR;
            PG8_LDA(At, 1, 1); PG8_STAGE(PG8_SA(1, 0), a3, voffA);
            PG8_BAR; PG8_WAIT_L(0); PG8_MMA(1, 0, At, B0); PG8_BAR; PG8_SCHED;
            PG8_STAGE(PG8_SB(1, 1), b3 + hstepB, voffB);
            PG8_WAIT_V(6); PG8_BAR; PG8_MMA(1, 1, At, B1); PG8_BAR;
            }
        }
        if constexpr (ALIGN_EPI) { if (wr == 0) PG8_BAR; }
        if constexpr (Epi::PREFETCH) cur.aux = ui & 1;
        if constexpr (!Epi::AFTER_DRAIN) { E(acc, cur, wr, wc, fr, fq); S.done(cur); }
        if constexpr (Epi::PREFETCH) { if (has_next) E.prefetch(nxt, (ui + 1) & 1, tid); }
        if (!has_next) break;
#pragma unroll
        for (int a = 0; a < 2; ++a)
#pragma unroll
            for (int b = 0; b < 2; ++b)
#pragma unroll
                for (int m = 0; m < 4; ++m)
#pragma unroll
                    for (int n = 0; n < 2; ++n) acc[a][b][m][n] = (f32x4){0.f, 0.f, 0.f, 0.f};
        cur = nxt; cA = nA; cB = nB; ++ui;
        if constexpr (ALIGN_EPI) { if (wr == 1) PG8_BAR; }
    }
    PG8_WAIT_V(0);
    if constexpr (!ALIGN_EPI) { if (wr == 0) PG8_BAR; }
    PG8_BAR;
    if constexpr (Epi::AFTER_DRAIN) { E.fused(acc, cur, wr, wc, fr, fq, lds, wid, lane); S.done(cur); }
#undef PG8_SA
#undef PG8_SB
#undef PG8_STAGE
#undef PG8_LDA
#undef PG8_LDB
#undef PG8_MMA
#undef PG8_WAIT_V
#undef PG8_WAIT_L
#undef PG8_BAR
#undef PG8_SCHED
}
}

#define LAS __attribute__((address_space(3)))
#define GAS __attribute__((address_space(1)))
typedef unsigned short bf16;
typedef short bf16x8 __attribute__((ext_vector_type(8)));
typedef short s16x4 __attribute__((ext_vector_type(4)));
typedef float f32x4 __attribute__((ext_vector_type(4)));
typedef float f32x16 __attribute__((ext_vector_type(16)));
typedef unsigned u32x4 __attribute__((ext_vector_type(4)));
typedef unsigned u32x2 __attribute__((ext_vector_type(2)));
typedef float f32x2_t __attribute__((ext_vector_type(2)));
typedef __bf16 bf16x2_t __attribute__((ext_vector_type(2)));

constexpr int BATCH = 4, SEQ = 8192, DM = 1024, M = BATCH * SEQ;
constexpr int NMEM = 256;
constexpr int PLD = 6400;
constexpr int C_AQ = 0, C_AK = 512, C_AV = 640, C_DQ = 768, C_DK = 1280, C_DV = 1792, C_DZ = 2304, C_MQ = 2816, C_GATE = 3328;
constexpr int C_MG = 768, C_X1B = 1792, C_ACT = 2816;
constexpr int NIN = 6656;
constexpr int DFF = 2816, NUP = 5632;
constexpr float EPS = 1e-6f;
constexpr float LOG2E = 1.4426950408889634f;

__device__ __forceinline__ float bf_lo(unsigned w) { return __uint_as_float(w << 16); }
__device__ __forceinline__ float bf_hi(unsigned w) { return __uint_as_float(w & 0xffff0000u); }
__device__ __forceinline__ unsigned pk2(float lo, float hi) { f32x2_t v = {lo, hi}; bf16x2_t b = __builtin_convertvector(v, bf16x2_t); return __builtin_bit_cast(unsigned, b); }
__device__ __forceinline__ float fexp2(float x) { return __builtin_amdgcn_exp2f(x); }
__device__ __forceinline__ float frcp(float x) { return __builtin_amdgcn_rcpf(x); }
__device__ __forceinline__ float sigmoidf_(float x) { return frcp(1.0f + fexp2(-x * LOG2E)); }
__device__ __forceinline__ float siluf_(float x) { return x * sigmoidf_(x); }
__device__ __forceinline__ void unpack8(const u32x4 w, float (&v)[8]) {
    v[0] = bf_lo(w.x); v[1] = bf_hi(w.x); v[2] = bf_lo(w.y); v[3] = bf_hi(w.y); v[4] = bf_lo(w.z); v[5] = bf_hi(w.z); v[6] = bf_lo(w.w); v[7] = bf_hi(w.w); }
__device__ __forceinline__ u32x4 pack8(const float (&v)[8]) { u32x4 w; w.x = pk2(v[0], v[1]); w.y = pk2(v[2], v[3]); w.z = pk2(v[4], v[5]); w.w = pk2(v[6], v[7]); return w; }

template <int CTRL, int ROWMASK> __device__ __forceinline__ float dpp_add(float x) {
    return x + __builtin_bit_cast(float, __builtin_amdgcn_update_dpp(0, __builtin_bit_cast(int, x), CTRL, ROWMASK, 0xF, false)); }
__device__ __forceinline__ float wave_sum_dpp(float x) {
    x = dpp_add<0xB1, 0xF>(x); x = dpp_add<0x4E, 0xF>(x); x = dpp_add<0x141, 0xF>(x); x = dpp_add<0x140, 0xF>(x);
    x = dpp_add<0x142, 0xA>(x); x = dpp_add<0x143, 0xC>(x);
    return __builtin_bit_cast(float, __builtin_amdgcn_readlane(__builtin_bit_cast(int, x), 63)); }
__device__ __forceinline__ float wave_scan_dpp(float x) {
    x = dpp_add<0x111, 0xF>(x); x = dpp_add<0x112, 0xF>(x); x = dpp_add<0x114, 0xF>(x); x = dpp_add<0x118, 0xF>(x);
    x = dpp_add<0x142, 0xA>(x); x = dpp_add<0x143, 0xC>(x);
    return x; }
__device__ __forceinline__ float group8_sum_dpp(float x) { x = dpp_add<0xB1, 0xF>(x); x = dpp_add<0x4E, 0xF>(x); return dpp_add<0x141, 0xF>(x); }
__device__ __forceinline__ float group16_sum_dpp(float x) { return dpp_add<0x140, 0xF>(group8_sum_dpp(x)); }
using pg8::Unit;
constexpr int HALF = pg8::HALF, BM = pg8::BM;

struct EpiInProj {
    static constexpr bool PERM = true, AFTER_DRAIN = false, PREFETCH = false, RESCALE = false;
    bf16* P; float* BA;
    __device__ __forceinline__ void operator()(const f32x4 (&acc)[2][2][4][2], const Unit& u, int wr, int wc, int fr, int fq) const {
        const int row0 = u.pm * BM + wr * 64 + fr;
        if (u.pn < 13) {
            const int col0 = u.pn * BM + wc * 32 + 8 * fq;
#pragma unroll
            for (int ai = 0; ai < 2; ++ai)
#pragma unroll
                for (int m = 0; m < 4; ++m) { bf16* rowp = P + (size_t)(row0 + ai * HALF + m * 16) * PLD + col0;
#pragma unroll
                    for (int bj = 0; bj < 2; ++bj) { const f32x4 v0 = acc[ai][bj][m][0], v1 = acc[ai][bj][m][1];
                        u32x4 w; w.x = pk2(v0[0], v0[1]); w.y = pk2(v0[2], v0[3]); w.z = pk2(v1[0], v1[1]); w.w = pk2(v1[2], v1[3]);
                        __builtin_nontemporal_store(w, (u32x4*)(rowp + bj * HALF)); } }
        } else if (wc == 0) {
#pragma unroll
            for (int ai = 0; ai < 2; ++ai)
#pragma unroll
                for (int m = 0; m < 4; ++m) { float* rp = BA + (size_t)(row0 + ai * HALF + m * 16) * 32 + 8 * fq;
                    *(f32x4*)rp = acc[ai][0][m][0]; *(f32x4*)(rp + 4) = acc[ai][0][m][1]; }
        }
    }
};
struct EpiBf16 {
    static constexpr bool PERM = true, AFTER_DRAIN = false, PREFETCH = false, RESCALE = false;
    bf16* O; int ldc;
    __device__ __forceinline__ void operator()(const f32x4 (&acc)[2][2][4][2], const Unit& u, int wr, int wc, int fr, int fq) const {
        const int row0 = u.pm * BM + wr * 64 + fr, col0 = u.pn * BM + wc * 32 + 8 * fq;
#pragma unroll
        for (int ai = 0; ai < 2; ++ai)
#pragma unroll
            for (int m = 0; m < 4; ++m) { bf16* rowp = O + (size_t)(row0 + ai * HALF + m * 16) * ldc + col0;
#pragma unroll
                for (int bj = 0; bj < 2; ++bj) { const f32x4 v0 = acc[ai][bj][m][0], v1 = acc[ai][bj][m][1];
                    u32x4 w; w.x = pk2(v0[0], v0[1]); w.y = pk2(v0[2], v0[3]); w.z = pk2(v1[0], v1[1]); w.w = pk2(v1[2], v1[3]);
                    *(u32x4*)(rowp + bj * HALF) = w; } }
    }
};
template <int PASS> struct EpiBranch {
    static constexpr bool PERM = true, AFTER_DRAIN = false, PREFETCH = false, RESCALE = false;
    bf16* P;
    __device__ __forceinline__ void operator()(const f32x4 (&acc)[2][2][4][2], const Unit& u, int wr, int wc, int fr, int fq) const {
        const int row0 = u.pm * BM + wr * 64 + fr, col0 = u.pn * BM + wc * 32 + 8 * fq;
#pragma unroll
        for (int ai = 0; ai < 2; ++ai)
#pragma unroll
            for (int m = 0; m < 4; ++m) { bf16* rowp = P + (size_t)(row0 + ai * HALF + m * 16) * PLD;
#pragma unroll
                for (int bj = 0; bj < 2; ++bj) {
                    const int c = col0 + bj * HALF;
                    const u32x4 gw = *(const u32x4*)(rowp + C_GATE + 1024 * PASS + c);
                    float g[8]; unpack8(gw, g);
                    float pv[8];
                    if (PASS > 0) { const u32x4 mw = *(const u32x4*)(rowp + C_MG + c); unpack8(mw, pv); }
                    else {
#pragma unroll
                        for (int i = 0; i < 8; ++i) pv[i] = 0.f; }
                    const f32x4 v0 = acc[ai][bj][m][0], v1 = acc[ai][bj][m][1];
                    float o[8];
#pragma unroll
                    for (int i = 0; i < 4; ++i) { o[i] = pv[i] + sigmoidf_(g[i]) * v0[i]; o[4 + i] = pv[4 + i] + sigmoidf_(g[4 + i]) * v1[i]; }
                    *(u32x4*)(rowp + C_MG + c) = pack8(o); } }
    }
};
struct EpiGatesU8 {
    static constexpr bool PERM = true, AFTER_DRAIN = false, PREFETCH = false, RESCALE = false;
    bf16* P;
    __device__ __forceinline__ void operator()(const f32x4 (&acc)[2][2][4][2], const Unit& u, int wr, int wc, int fr, int fq) const {
        const int row0 = u.pm * BM + wr * 64 + fr, col0 = u.pn * BM + wc * 32 + 8 * fq;
#pragma unroll
        for (int ai = 0; ai < 2; ++ai)
#pragma unroll
            for (int m = 0; m < 4; ++m) { unsigned char* rowp = (unsigned char*)(P + (size_t)(row0 + ai * HALF + m * 16) * PLD + C_GATE) + col0;
#pragma unroll
                for (int bj = 0; bj < 2; ++bj) { const f32x4 v0 = acc[ai][bj][m][0], v1 = acc[ai][bj][m][1]; unsigned q[8];
#pragma unroll
                    for (int i = 0; i < 4; ++i) { q[i] = (unsigned)fminf(fmaxf(sigmoidf_(v0[i]) * 255.0f + 0.5f, 1.0f), 255.0f); q[4 + i] = (unsigned)fminf(fmaxf(sigmoidf_(v1[i]) * 255.0f + 0.5f, 1.0f), 255.0f); }
                    u32x2 w; w.x = q[0] | (q[1] << 8) | (q[2] << 16) | (q[3] << 24); w.y = q[4] | (q[5] << 8) | (q[6] << 16) | (q[7] << 24);
                    *(u32x2*)(rowp + bj * HALF) = w; } }
    }
};
struct EpiMerge {
    static constexpr bool PERM = true, AFTER_DRAIN = false, PREFETCH = false, RESCALE = true;
    bf16* P;
    __device__ __forceinline__ void rescale(f32x4 (&acc)[2][2][4][2], const Unit& u, int wr, int wc, int fr, int fq, int stage) const {
        asm volatile("" : "+v"(fr), "+v"(fq));
        const int row0 = u.pm * BM + wr * 64 + fr, col0 = u.pn * BM + wc * 32 + 8 * fq;
#pragma unroll
        for (int ai = 0; ai < 2; ++ai) {
#pragma unroll
            for (int m = 0; m < 4; ++m) { const unsigned char* rowp = (const unsigned char*)(P + (size_t)(row0 + ai * HALF + m * 16) * PLD + C_GATE) + 1024 * (stage - 1) + col0;
#pragma unroll
                for (int bj = 0; bj < 2; ++bj) { const u32x2 gx = *(const u32x2*)(rowp + bj * HALF), gy = *(const u32x2*)(rowp + 1024 + bj * HALF);
#pragma unroll
                    for (int i = 0; i < 4; ++i) { acc[ai][bj][m][0][i] *= (float)((gx.x >> (8 * i)) & 255u) * frcp((float)((gy.x >> (8 * i)) & 255u));
                        acc[ai][bj][m][1][i] *= (float)((gx.y >> (8 * i)) & 255u) * frcp((float)((gy.y >> (8 * i)) & 255u)); } } }
            asm volatile("" ::: "memory"); }
    }
    __device__ __forceinline__ void operator()(const f32x4 (&acc)[2][2][4][2], const Unit& u, int wr, int wc, int fr, int fq) const {
        const int row0 = u.pm * BM + wr * 64 + fr, col0 = u.pn * BM + wc * 32 + 8 * fq;
#pragma unroll
        for (int ai = 0; ai < 2; ++ai)
#pragma unroll
            for (int m = 0; m < 4; ++m) { bf16* rowp = P + (size_t)(row0 + ai * HALF + m * 16) * PLD;
#pragma unroll
                for (int bj = 0; bj < 2; ++bj) { const int c = col0 + bj * HALF; float o[8];
                    const u32x2 gq = *(const u32x2*)((const unsigned char*)(rowp + C_GATE) + 2048 + c);
                    const f32x4 v0 = acc[ai][bj][m][0], v1 = acc[ai][bj][m][1];
#pragma unroll
                    for (int i = 0; i < 4; ++i) { o[i] = (float)((gq.x >> (8 * i)) & 255u) * (1.0f / 255.0f) * v0[i]; o[4 + i] = (float)((gq.y >> (8 * i)) & 255u) * (1.0f / 255.0f) * v1[i]; }
                    *(u32x4*)(rowp + C_MG + c) = pack8(o); } }
    }
};
struct EpiWout {
    static constexpr bool PERM = true, AFTER_DRAIN = false, PREFETCH = false, RESCALE = false;
    const float* x; float* out; bf16* P; float* SSQ; LAS float* xl;
    __device__ __forceinline__ void operator()(const f32x4 (&acc)[2][2][4][2], const Unit& u, int wr, int wc, int fr, int fq) const {
        const int row0 = u.pm * BM + wr * 64 + fr, col0 = u.pn * BM + wc * 32 + 8 * fq;
#pragma unroll
        for (int ai = 0; ai < 2; ++ai)
#pragma unroll
            for (int m = 0; m < 4; ++m) { const int row = row0 + ai * HALF + m * 16; float ss = 0.f;
#pragma unroll
                for (int bj = 0; bj < 2; ++bj) { const int c = col0 + bj * HALF; const size_t off = (size_t)row * DM + c;
                    const f32x4 a0 = *(const f32x4*)(x + off), a1 = *(const f32x4*)(x + off + 4);
                    const f32x4 r0 = a0 + acc[ai][bj][m][0], r1 = a1 + acc[ai][bj][m][1];
                    ss += (r0[0] * r0[0] + r0[1] * r0[1]) + (r0[2] * r0[2] + r0[3] * r0[3]) + (r1[0] * r1[0] + r1[1] * r1[1]) + (r1[2] * r1[2] + r1[3] * r1[3]);
                    u32x4 w; w.x = pk2(r0[0], r0[1]); w.y = pk2(r0[2], r0[3]); w.z = pk2(r1[0], r1[1]); w.w = pk2(r1[2], r1[3]);
                    *(u32x4*)(P + (size_t)row * PLD + C_X1B + c) = w; }
                ss += __shfl_xor(ss, 16); ss += __shfl_xor(ss, 32);
                if (fq == 0) xl[(ai * HALF + wr * 64 + m * 16 + fr) * 4 + wc] = ss; }
        asm volatile("s_waitcnt lgkmcnt(0)" ::: "memory"); __builtin_amdgcn_s_barrier(); asm volatile("" ::: "memory");
        { const int t = (wr * 4 + wc) * 64 + fq * 16 + fr;
          if (t < 256) { const f32x4 p = *(const LAS f32x4*)(xl + t * 4); SSQ[(size_t)(u.pm * BM + t) * 4 + u.pn] = (p[0] + p[1]) + (p[2] + p[3]); } }
        asm volatile("s_waitcnt lgkmcnt(0)" ::: "memory"); __builtin_amdgcn_s_barrier(); asm volatile("" ::: "memory");
    }
};
template <int CTRL> __device__ __forceinline__ float dpp_mov(float old, float src) {
    return __builtin_bit_cast(float, __builtin_amdgcn_update_dpp(__builtin_bit_cast(int, old), __builtin_bit_cast(int, src), CTRL, 0xF, 0xF, false)); }
template <int CTRL> __device__ __forceinline__ float dpp_rot(float src) {
    return __builtin_bit_cast(float, __builtin_amdgcn_mov_dpp(__builtin_bit_cast(int, src), CTRL, 0xF, 0xF, true)); }
struct EpiUp {
    static constexpr bool PERM = true, AFTER_DRAIN = false, PREFETCH = true, RESCALE = false;
    const float* SSQ; const float* cw; const float* cb; bf16* P; float* UE; LAS float* xl;
    __device__ __forceinline__ void prefetch(const Unit& u, int buf, int tid) const {
        LAS float* d = xl + buf * 1280;
        if (tid < 256) { const int a = tid >> 5, c4 = (tid & 31) * 4, ch = u.pn * 128 + c4 + (a >= 4 ? DFF : 0), aa = a & 3;
            *(LAS f32x4*)(d + a * 128 + c4) = *(const f32x4*)((aa < 3 ? cw + aa * NUP : cb) + ch); }
        else { const int r = tid - 256; const f32x4 q = *(const f32x4*)(SSQ + (size_t)(u.pm * BM + r) * 4);
            d[1024 + r] = __builtin_amdgcn_rsqf(((q[0] + q[1]) + (q[2] + q[3])) * (1.0f / DM) + EPS); }
    }
    __device__ __forceinline__ void operator()(f32x4 (&acc)[2][2][4][2], const Unit& u, int wr, int wc, int fr, int fq) const {
        const int row0 = u.pm * BM + wr * 64 + fr;
        const LAS float* lw = xl + u.aux * 1280;
#pragma unroll
        for (int ai = 0; ai < 2; ++ai)
#pragma unroll
            for (int m = 0; m < 4; ++m) { const float rs = lw[1024 + ai * HALF + wr * 64 + m * 16 + fr];
#pragma unroll
                for (int bj = 0; bj < 2; ++bj)
#pragma unroll
                    for (int n = 0; n < 2; ++n) acc[ai][bj][m][n] *= rs; }
#pragma unroll
        for (int n = 0; n < 2; ++n) {
            const int c4 = wc * 32 + 8 * fq + 4 * n, a0 = u.pn * 128 + c4;
            const f32x4 wg0 = *(const LAS f32x4*)(lw + c4), wg1 = *(const LAS f32x4*)(lw + 128 + c4), wg2 = *(const LAS f32x4*)(lw + 256 + c4), bg = *(const LAS f32x4*)(lw + 384 + c4);
            const f32x4 wv0 = *(const LAS f32x4*)(lw + 512 + c4), wv1 = *(const LAS f32x4*)(lw + 640 + c4), wv2 = *(const LAS f32x4*)(lw + 768 + c4), bv = *(const LAS f32x4*)(lw + 896 + c4);
#pragma unroll
            for (int ai = 0; ai < 2; ++ai) {
                const int g64 = u.pm * 4 + ai * 2 + wr;
#pragma unroll
                for (int m = 0; m < 4; ++m) {
                    const f32x4 ugm = acc[ai][0][m][n], uvm = acc[ai][1][m][n], ugp = acc[ai][0][(m + 3) & 3][n], ugn = acc[ai][0][(m + 1) & 3][n], uvp = acc[ai][1][(m + 3) & 3][n], uvn = acc[ai][1][(m + 1) & 3][n];
                    f32x4 pg, ng, pvv, nv;
#pragma unroll
                    for (int i = 0; i < 4; ++i) {
                        pg[i] = dpp_mov<0x111>(dpp_rot<0x121>(ugp[i]), ugm[i]);
                        ng[i] = dpp_mov<0x101>(dpp_rot<0x12F>(ugn[i]), ugm[i]);
                        pvv[i] = dpp_mov<0x111>(dpp_rot<0x121>(uvp[i]), uvm[i]);
                        nv[i] = dpp_mov<0x101>(dpp_rot<0x12F>(uvn[i]), uvm[i]); }
                    const f32x4 gate = wg0 * pg + wg1 * ugm + wg2 * ng + bg;
                    const f32x4 val = wv0 * pvv + wv1 * uvm + wv2 * nv + bv;
                    const int row = row0 + ai * HALF + m * 16;
                    const bool edge = (m == 0 && fr == 0) || (m == 3 && fr == 15);
                    if (!edge) { u32x2 w; w.x = pk2(siluf_(gate[0]) * val[0], siluf_(gate[1]) * val[1]); w.y = pk2(siluf_(gate[2]) * val[2], siluf_(gate[3]) * val[3]);
                        *(u32x2*)(P + (size_t)row * PLD + C_ACT + a0) = w; }
                    if ((m == 0 && fr < 2) || (m == 3 && fr >= 14)) { const int slot = (m == 0) ? fr : fr - 12;
                        float* ue = UE + ((size_t)g64 * 4 + slot) * NUP;
                        *(f32x4*)(ue + a0) = ugm; *(f32x4*)(ue + DFF + a0) = uvm; }
                }
            }
        }
    }
};
struct EpiDown {
    static constexpr bool PERM = true, AFTER_DRAIN = false, PREFETCH = false, RESCALE = false;
    float* out; const bf16* P;
    __device__ __forceinline__ void operator()(const f32x4 (&acc)[2][2][4][2], const Unit& u, int wr, int wc, int fr, int fq) const {
        const int row0 = u.pm * BM + wr * 64 + fr, col0 = u.pn * BM + wc * 32 + 8 * fq;
#pragma unroll
        for (int ai = 0; ai < 2; ++ai)
#pragma unroll
            for (int m = 0; m < 4; ++m) { const int row = row0 + ai * HALF + m * 16;
#pragma unroll
                for (int bj = 0; bj < 2; ++bj) { const int c = col0 + bj * HALF; float xr[8]; unpack8(*(const u32x4*)(P + (size_t)row * PLD + C_X1B + c), xr);
                    const f32x4 v0 = acc[ai][bj][m][0], v1 = acc[ai][bj][m][1];
                    __builtin_nontemporal_store((f32x4){xr[0] + v0[0], xr[1] + v0[1], xr[2] + v0[2], xr[3] + v0[3]}, (f32x4*)(out + (size_t)row * DM + c));
                    __builtin_nontemporal_store((f32x4){xr[4] + v1[0], xr[5] + v1[1], xr[6] + v1[2], xr[7] + v1[3]}, (f32x4*)(out + (size_t)row * DM + c + 4)); } }
    }
};

template <int DH, int RSK, int RSV>
__device__ __forceinline__ void attn_tile(const LAS unsigned char* Kl, const LAS unsigned char* Vl, int jk, const bf16x8 (&qf)[DH / 16], f32x16 s0, f32x16 s1,
                                          float& m, float& l, f32x16 (&o)[DH / 32], int lane) {
    const int r32 = lane & 31, hi = lane >> 5;
    const LAS unsigned char* kp = Kl + (size_t)(jk + r32) * RSK + 16 * hi;
#pragma unroll
    for (int ks = 0; ks < DH / 16; ++ks) {
        const bf16x8 k0 = *(const LAS bf16x8*)(kp + 32 * ks), k1 = *(const LAS bf16x8*)(kp + 32 * RSK + 32 * ks);
        s0 = __builtin_amdgcn_mfma_f32_32x32x16_bf16(k0, qf[ks], s0, 0, 0, 0);
        s1 = __builtin_amdgcn_mfma_f32_32x32x16_bf16(k1, qf[ks], s1, 0, 0, 0);
    }
    const int g = lane >> 4, q4 = (lane & 15) >> 2, p = lane & 3;
    const unsigned va = (unsigned)(uintptr_t)Vl + (unsigned)(jk + 4 * hi + q4) * RSV + (16 * (g & 1) + 4 * p) * 2;
    s16x4 vlo[2][4], vhi[2][4];
#define ATT_VREAD(set, db) do { _Pragma("unroll") for (int kk = 0; kk < 4; ++kk) { \
        asm volatile("ds_read_b64_tr_b16 %0, %1 offset:%c2" : "=&v"(vlo[set][kk]) : "v"(va), "i"((16 * kk) * RSV + 64 * (db)) : "memory"); \
        asm volatile("ds_read_b64_tr_b16 %0, %1 offset:%c2" : "=&v"(vhi[set][kk]) : "v"(va), "i"((16 * kk + 8) * RSV + 64 * (db)) : "memory"); } } while (0)
    ATT_VREAD(0, 0);
    float mx = fmaxf(s0[0], s1[0]);
#pragma unroll
    for (int r = 1; r < 16; ++r) mx = fmaxf(mx, fmaxf(s0[r], s1[r]));
    mx = fmaxf(mx, __shfl_xor(mx, 32));
    const float mn = fmaxf(m, mx), f = fexp2(m - mn);
    m = mn; l *= f;
#pragma unroll
    for (int db = 0; db < DH / 32; ++db)
#pragma unroll
        for (int r = 0; r < 16; ++r) o[db][r] *= f;
    float ps = 0.f;
#pragma unroll
    for (int r = 0; r < 16; ++r) { s0[r] = fexp2(s0[r] - mn); s1[r] = fexp2(s1[r] - mn); ps += s0[r] + s1[r]; }
    l += ps;
    bf16x8 pf[4];
    { u32x4 w;
      w.x = pk2(s0[0], s0[1]); w.y = pk2(s0[2], s0[3]); w.z = pk2(s0[4], s0[5]); w.w = pk2(s0[6], s0[7]); pf[0] = __builtin_bit_cast(bf16x8, w);
      w.x = pk2(s0[8], s0[9]); w.y = pk2(s0[10], s0[11]); w.z = pk2(s0[12], s0[13]); w.w = pk2(s0[14], s0[15]); pf[1] = __builtin_bit_cast(bf16x8, w);
      w.x = pk2(s1[0], s1[1]); w.y = pk2(s1[2], s1[3]); w.z = pk2(s1[4], s1[5]); w.w = pk2(s1[6], s1[7]); pf[2] = __builtin_bit_cast(bf16x8, w);
      w.x = pk2(s1[8], s1[9]); w.y = pk2(s1[10], s1[11]); w.z = pk2(s1[12], s1[13]); w.w = pk2(s1[14], s1[15]); pf[3] = __builtin_bit_cast(bf16x8, w); }
#pragma unroll
    for (int db = 0; db < DH / 32; ++db) {
        asm volatile("s_waitcnt lgkmcnt(0)" ::: "memory"); __builtin_amdgcn_sched_barrier(0);
        if (db + 1 < DH / 32) { if ((db & 1) == 0) ATT_VREAD(1, db + 1); else ATT_VREAD(0, db + 1); }
#pragma unroll
        for (int kk = 0; kk < 4; ++kk) { const s16x4 lo = vlo[db & 1][kk], h4 = vhi[db & 1][kk];
            const bf16x8 vf = (bf16x8){lo[0], lo[1], lo[2], lo[3], h4[0], h4[1], h4[2], h4[3]};
            o[db] = __builtin_amdgcn_mfma_f32_32x32x16_bf16(vf, pf[kk], o[db], 0, 0, 0); }
        __builtin_amdgcn_sched_barrier(0);
    }
#undef ATT_VREAD
}
__device__ __forceinline__ void load_bias(const float* biasrow, int hi, f32x16& s0, f32x16& s1) {
#pragma unroll
    for (int g4 = 0; g4 < 4; ++g4) { const f32x4 c0 = *(const f32x4*)(biasrow + 8 * g4 + 4 * hi), c1 = *(const f32x4*)(biasrow + 32 + 8 * g4 + 4 * hi);
#pragma unroll
        for (int i = 0; i < 4; ++i) { s0[4 * g4 + i] = c0[i]; s1[4 * g4 + i] = c1[i]; } }
}
template <int DH>
__device__ __forceinline__ void load_q(const bf16* qrow, const float* gq, float scale, bf16x8 (&qf)[DH / 16], int lane) {
    const int hi = lane >> 5;
    u32x4 w[DH / 16]; float ss = 0.f;
#pragma unroll
    for (int ks = 0; ks < DH / 16; ++ks) { w[ks] = *(const u32x4*)(qrow + 16 * ks + 8 * hi); float v[8]; unpack8(w[ks], v);
#pragma unroll
        for (int j = 0; j < 8; ++j) ss += v[j] * v[j]; }
    ss += __shfl_xor(ss, 32);
    const float rstd = __builtin_amdgcn_rsqf(ss * (1.0f / DH) + EPS) * scale;
#pragma unroll
    for (int ks = 0; ks < DH / 16; ++ks) { float v[8]; unpack8(w[ks], v);
        const f32x4 g0 = *(const f32x4*)(gq + 16 * ks + 8 * hi), g1 = *(const f32x4*)(gq + 16 * ks + 8 * hi + 4);
#pragma unroll
        for (int j = 0; j < 4; ++j) { v[j] *= rstd * g0[j]; v[4 + j] *= rstd * g1[j]; }
        qf[ks] = __builtin_bit_cast(bf16x8, pack8(v)); }
}
template <int DH>
__device__ __forceinline__ void store_o(bf16* yrow, const f32x16 (&o)[DH / 32], float l, int lane) {
    const int hi = lane >> 5;
    const float inv = frcp(l + __shfl_xor(l, 32));
#pragma unroll
    for (int db = 0; db < DH / 32; ++db)
#pragma unroll
        for (int g4 = 0; g4 < 4; ++g4) { u32x2 w; w.x = pk2(o[db][4 * g4] * inv, o[db][4 * g4 + 1] * inv); w.y = pk2(o[db][4 * g4 + 2] * inv, o[db][4 * g4 + 3] * inv);
            *(u32x2*)(yrow + 32 * db + 8 * g4 + 4 * hi) = w; }
}
template <int DH, int RSK, int RSV>
__device__ __forceinline__ void stage_kv(LAS unsigned char* Kl, LAS unsigned char* Vl, int ldsrow0, const bf16* src, size_t pitch, int kcol, int vcol, int nrows, const float* gk, int tid) {
    constexpr int CPR = DH / 8;
    for (int c = tid; c < nrows * CPR; c += 512) {
        const int row = c / CPR, ch = c % CPR;
        const bf16* rp = src + (size_t)row * pitch;
        const u32x4 kw = *(const u32x4*)(rp + kcol + ch * 8), vw = *(const u32x4*)(rp + vcol + ch * 8);
        float v[8]; unpack8(kw, v); float ss = 0.f;
#pragma unroll
        for (int j = 0; j < 8; ++j) ss += v[j] * v[j];
        ss = (CPR == 8) ? group8_sum_dpp(ss) : group16_sum_dpp(ss);
        const float rstd = __builtin_amdgcn_rsqf(ss * (1.0f / DH) + EPS);
        const f32x4 g0 = *(const f32x4*)(gk + ch * 8), g1 = *(const f32x4*)(gk + ch * 8 + 4);
#pragma unroll
        for (int j = 0; j < 4; ++j) { v[j] *= rstd * g0[j]; v[4 + j] *= rstd * g1[j]; }
        *(LAS u32x4*)(Kl + (size_t)(ldsrow0 + row) * RSK + ch * 16) = pack8(v);
        *(LAS u32x4*)(Vl + (size_t)(ldsrow0 + row) * RSV + ch * 16) = vw;
    }
}

constexpr int NWAVES = 8;
constexpr size_t MiB = 1u << 20;
constexpr size_t WS_CTL = 0, CTL_ZERO_BYTES = 128 * 1024;
constexpr size_t WS_WIN = 2 * MiB;
constexpr size_t WS_WBR = 15 * MiB;
constexpr size_t WS_WOUT = 18 * MiB;
constexpr size_t WS_WUP = 20 * MiB;
constexpr size_t WS_WDN = 31 * MiB;
constexpr size_t WS_WKV = 37 * MiB;
constexpr size_t WS_MEMN = 39 * MiB;
constexpr size_t WS_KV = 41 * MiB;
constexpr size_t WS_BT = 43 * MiB;
constexpr size_t WS_BA = 45 * MiB;
constexpr size_t WS_SSQ = 49 * MiB;
constexpr size_t WS_P = 52 * MiB;
constexpr size_t WS_UE = 452 * MiB;
constexpr size_t WS_END = 512 * MiB;
static_assert(WS_P + (size_t)M * PLD * 2 == WS_UE && WS_UE + (size_t)512 * 4 * NUP * 4 <= WS_END, "d_ws map");

constexpr int CW_TMO = 0, CW_CODE = 1;
constexpr int CW_BAR = 4096;
constexpr int CW_KVF = 1024;
constexpr int RING_OFF = 0, RING_BYTES = 147456;
constexpr int LDSCTL_OFF = RING_BYTES, MISC_OFF = LDSCTL_OFF + 320;
constexpr int XCH_OFF = MISC_OFF + 256;
constexpr int LDS_BYTES = 163840;
static_assert(XCH_OFF + 2 * 1280 * 4 <= LDS_BYTES && XCH_OFF % 16 == 0, "LDS map");

typedef GAS unsigned gu32;
#define RLX_AGENT __ATOMIC_RELAXED, __HIP_MEMORY_SCOPE_AGENT
#define LDS_WAIT() asm volatile("s_waitcnt lgkmcnt(0)" ::: "memory")
#define VM_WAIT() asm volatile("s_waitcnt vmcnt(0)" ::: "memory")

#define XB_TMO      128
#define XB_XCNT(j)  (256  + 64 * (j))
#define XB_XSUB(j)  (1280 + 64 * (j))
#define XB_XGEN(j)  (2304 + 64 * (j))
#define XB_TOP      3328
#define XB_TOPGEN   3392
#define XCD_BAR_WORDS 3456
#define XB_SPIN_CAP (1u << 22)

__device__ __forceinline__ unsigned xb_ld(unsigned* p)              { return __hip_atomic_load(p, __ATOMIC_RELAXED, __HIP_MEMORY_SCOPE_AGENT); }
__device__ __forceinline__ unsigned xb_add(unsigned* p, unsigned v) { return __hip_atomic_fetch_add(p, v, __ATOMIC_RELAXED, __HIP_MEMORY_SCOPE_AGENT); }
__device__ __forceinline__ unsigned xb_xcc_id() { return (unsigned)__builtin_amdgcn_s_getreg((3 << 11) | 20) & 0xFu; }
#define XB_SPIN(cond, bar) do { unsigned _sp = 0; while (cond) { __builtin_amdgcn_s_sleep(1); \
    if ((++_sp & 255u) == 0u) { if (xb_ld(&(bar)[XB_TMO])) break; if (_sp > XB_SPIN_CAP) { atomicAdd(&(bar)[XB_TMO], 1u); break; } } } } while (0)

struct XcdBarrier { unsigned* bar; unsigned x; volatile LAS unsigned* st; };

__device__ __forceinline__ XcdBarrier xcd_barrier_post(unsigned* bar, volatile LAS unsigned* st) {
    XcdBarrier b; b.bar = bar; b.x = xb_xcc_id(); b.st = st;
    if (threadIdx.x == 0) (void)xb_add(&bar[XB_XCNT(b.x)], 1u);
    return b;
}
__device__ __forceinline__ void xcd_barrier_complete(unsigned* bar, unsigned x, unsigned& nloc, unsigned& nx) {
    const unsigned G = gridDim.x * gridDim.y * gridDim.z;
    unsigned sum, cnt, mine, sp = 0u;
    for (;;) {
        sum = 0u; cnt = 0u; mine = 0u;
#pragma unroll
        for (unsigned j = 0; j < 16; ++j) { const unsigned c = xb_ld(&bar[XB_XCNT(j)]); sum += c; cnt += (c > 0u) ? 1u : 0u; mine = (j == x) ? c : mine; }
        if (sum == G) break;
        __builtin_amdgcn_s_sleep(1);
        if ((++sp & 255u) == 0u) { if (xb_ld(&bar[XB_TMO])) break; if (sp > XB_SPIN_CAP) { atomicAdd(&bar[XB_TMO], 1u); break; } }
    }
    nloc = mine > 0u ? mine : 1u; nx = cnt > 0u ? cnt : 1u;
}
__device__ __forceinline__ void xcd_barrier(const XcdBarrier& b) {
    asm volatile("s_waitcnt vmcnt(0)" ::: "memory");
    __syncthreads();
    if (threadIdx.x == 0) {
        unsigned* bar = b.bar;
        __builtin_amdgcn_s_waitcnt(0);
        unsigned nloc = b.st[0], nx = b.st[1];
        if (nloc == 0u) { xcd_barrier_complete(bar, b.x, nloc, nx); b.st[0] = nloc; b.st[1] = nx; }
        const unsigned old = xb_add(&bar[XB_XSUB(b.x)], 1u);
        const unsigned gen = old / nloc;
        if (old + 1u == (gen + 1u) * nloc) {
            __builtin_amdgcn_fence(__ATOMIC_RELEASE, "agent");
            asm volatile("s_waitcnt vmcnt(0)" ::: "memory");
            const unsigned og = xb_add(&bar[XB_TOP], 1u);
            const unsigned tg = og / nx;
            if (og + 1u == (tg + 1u) * nx) xb_add(&bar[XB_TOPGEN], 1u);
            else XB_SPIN(xb_ld(&bar[XB_TOPGEN]) == tg, bar);
            __builtin_amdgcn_fence(__ATOMIC_ACQUIRE, "agent");
            xb_add(&bar[XB_XGEN(b.x)], 1u);
            asm volatile("s_waitcnt vmcnt(0)" ::: "memory");
        } else {
            XB_SPIN(xb_ld(&bar[XB_XGEN(b.x)]) == gen, bar);
            __builtin_amdgcn_fence(__ATOMIC_ACQUIRE, "agent");
            asm volatile("s_waitcnt vmcnt(0)" ::: "memory");
        }
    }
    __syncthreads();
}

struct Frame {
    LAS unsigned char* lds;
    volatile LAS unsigned* MISC;
    gu32* ctl;
    int tid, lane, wave, vcu, G;
};

__device__ __forceinline__ float wave_sum(float v) {
#pragma unroll
    for (int o = 1; o < 64; o <<= 1) v += __shfl_xor(v, o);
    return v;
}
__device__ __forceinline__ int t5_bucket(int rel) {
    const int n = rel < 0 ? -rel : rel;
    const int mag = n < 8 ? n : n < 12 ? 8 : n < 16 ? 9 : n < 23 ? 10 : n < 32 ? 11 : n < 46 ? 12 : n < 64 ? 13 : n < 91 ? 14 : 15;
    return (rel > 0 ? 16 : 0) + mag;
}

__device__ __forceinline__ void transpose_item(const float* W, int K, int N, int k0, int n0, bf16* WT, int drow0, const float* gk, LAS float* scr, int lane) {
    { f32x4 v[8];
#pragma unroll
      for (int i = 0; i < 8; ++i) v[i] = *(const f32x4*)(W + (size_t)(k0 + 8 * i + (lane >> 3)) * N + n0 + 4 * (lane & 7));
#pragma unroll
      for (int i = 0; i < 8; ++i) { const int kk = 8 * i + (lane >> 3); const float gs = gk ? gk[k0 + kk] : 1.0f; LAS float* d = scr + kk * 33 + 4 * (lane & 7);
          d[0] = v[i][0] * gs; d[1] = v[i][1] * gs; d[2] = v[i][2] * gs; d[3] = v[i][3] * gs; } }
    LDS_WAIT(); asm volatile("" ::: "memory");
    const int c = lane & 7;
#pragma unroll
    for (int j = 0; j < 4; ++j) { const int n = (lane >> 3) + 8 * j; const LAS float* s = scr + (8 * c) * 33 + n;
        u32x4 o; o.x = pk2(s[0 * 33], s[1 * 33]); o.y = pk2(s[2 * 33], s[3 * 33]); o.z = pk2(s[4 * 33], s[5 * 33]); o.w = pk2(s[6 * 33], s[7 * 33]);
        *(GAS u32x4*)(WT + (size_t)(drow0 + n) * K + k0 + 8 * c) = o; }
    LDS_WAIT(); asm volatile("" ::: "memory");
}
__device__ __forceinline__ void rms_row_to_bf16(const float* xrow, const float* g, bf16* orow, int lane) {
    const GAS f32x4* xr = (const GAS f32x4*)xrow + lane;
    const GAS f32x4* gr = (const GAS f32x4*)g + lane;
    f32x4 v[4]; float s = 0.f;
#pragma unroll
    for (int j = 0; j < 4; ++j) { v[j] = xr[64 * j]; s += (v[j].x * v[j].x + v[j].y * v[j].y) + (v[j].z * v[j].z + v[j].w * v[j].w); }
    const float rstd = __builtin_amdgcn_rsqf(wave_sum(s) * (1.f / DM) + EPS);
    GAS unsigned long long* o8 = (GAS unsigned long long*)orow + lane;
#pragma unroll
    for (int j = 0; j < 4; ++j) { const f32x4 gg = gr[64 * j];
        o8[64 * j] = (unsigned long long)pk2(v[j].x * rstd * gg.x, v[j].y * rstd * gg.y) | ((unsigned long long)pk2(v[j].z * rstd * gg.z, v[j].w * rstd * gg.w) << 32); }
}

template <int R> __device__ __forceinline__ void rms_rows_to_bf16(const float* xa, size_t rstride, const float* g, bf16* oa, int lane) {
    const GAS f32x4* gr = (const GAS f32x4*)g + lane;
    f32x4 v[R][4]; float ss[R];
#pragma unroll
    for (int r = 0; r < R; ++r) { const GAS f32x4* xr = (const GAS f32x4*)(xa + (size_t)r * rstride) + lane;
#pragma unroll
        for (int j = 0; j < 4; ++j) v[r][j] = xr[64 * j]; }
#pragma unroll
    for (int r = 0; r < R; ++r) { ss[r] = 0.f;
#pragma unroll
        for (int j = 0; j < 4; ++j) ss[r] += (v[r][j].x * v[r][j].x + v[r][j].y * v[r][j].y) + (v[r][j].z * v[r][j].z + v[r][j].w * v[r][j].w); }
#pragma unroll
    for (int o = 1; o < 64; o <<= 1)
#pragma unroll
        for (int r = 0; r < R; ++r) ss[r] += __shfl_xor(ss[r], o);
#pragma unroll
    for (int r = 0; r < R; ++r) { const float rs = __builtin_amdgcn_rsqf(ss[r] * (1.f / DM) + EPS);
        GAS unsigned long long* o8 = (GAS unsigned long long*)(oa + (size_t)r * rstride) + lane;
#pragma unroll
        for (int j = 0; j < 4; ++j) { const f32x4 gg = gr[64 * j];
            o8[64 * j] = (unsigned long long)pk2(v[r][j].x * rs * gg.x, v[r][j].y * rs * gg.y) | ((unsigned long long)pk2(v[r][j].z * rs * gg.z, v[r][j].w * rs * gg.w) << 32); } }
}

struct Args { const float* in[25]; float* out; unsigned char* ws; int ph_lo, ph_hi, mode, pad; };

constexpr int WI_IN = 16 * 201, WI_KV = 16 * 32, WI_BR = 8 * 32, WI_OUT = 16 * 32, WI_UP = 16 * 176, WI_DN = 44 * 32;
constexpr int WI_EARLY = WI_IN + WI_KV, WI_ALL = WI_EARLY + 3 * WI_BR + WI_OUT + WI_UP + WI_DN;
__device__ __forceinline__ void weight_items(Frame& F, const Args& a, int first, int last, int gwl, int ngwl) {
    unsigned char* ws = a.ws;
    LAS float* scr = (LAS float*)(F.lds + RING_OFF + F.wave * 16384);
    for (int it = first + gwl; it < last; it += ngwl) {
        int r = it;
        if (r < WI_IN) { const int kb = r / 201, nb = r % 201, n0 = nb * 32;
            const int d0 = n0 < 2816 ? n0 : (n0 < 2848 ? 3328 + (n0 - 2816) : (n0 < 3360 ? n0 - 32 : 3584 + (n0 - 3360)));
            transpose_item(a.in[4], 1024, 6432, kb * 64, n0, (bf16*)(ws + WS_WIN), d0, nullptr, scr, F.lane); continue; }
        r -= WI_IN;
        if (r < WI_KV) { const int kb = r / 32, nb = r % 32;
            transpose_item(a.in[13], 1024, 1024, kb * 64, nb * 32, (bf16*)(ws + WS_WKV), nb * 32, nullptr, scr, F.lane); continue; }
        r -= WI_KV;
        if (r < 3 * WI_BR) { const int br = r / WI_BR, q = r % WI_BR, kb = q / 32, nb = q % 32;
            transpose_item(a.in[16 + br], 512, 1024, kb * 64, nb * 32, (bf16*)(ws + WS_WBR) + (size_t)br * 1024 * 512, nb * 32, nullptr, scr, F.lane); continue; }
        r -= 3 * WI_BR;
        if (r < WI_OUT) { const int kb = r / 32, nb = r % 32;
            transpose_item(a.in[19], 1024, 1024, kb * 64, nb * 32, (bf16*)(ws + WS_WOUT), nb * 32, nullptr, scr, F.lane); continue; }
        r -= WI_OUT;
        if (r < WI_UP) { const int kb = r / 176, nb = r % 176, n0 = nb * 32;
            const int isv = n0 >= DFF, nn = isv ? n0 - DFF : n0, d0 = (nn >> 7) * 256 + isv * 128 + (nn & 127);
            transpose_item(a.in[21], 1024, NUP, kb * 64, n0, (bf16*)(ws + WS_WUP), d0, a.in[20], scr, F.lane); continue; }
        r -= WI_UP;
        { const int kb = r / 32, nb = r % 32;
            transpose_item(a.in[24], DFF, 1024, kb * 64, nb * 32, (bf16*)(ws + WS_WDN), nb * 32, nullptr, scr, F.lane); }
    }
}
__device__ __forceinline__ void p0_prologue(Frame& F, const Args& a) {
    unsigned char* ws = a.ws;
    const int gw = F.vcu * NWAVES + F.wave, NGW = F.G * NWAVES;
    weight_items(F, a, 0, WI_EARLY, gw, NGW);
    { u32x4* z = (u32x4*)((bf16*)(ws + WS_WIN) + (size_t)3360 * 1024); const int n16 = 224 * 1024 * 2 / 16;
      for (int i = blockIdx.x * 512 + F.tid; i < n16; i += F.G * 512) z[i] = (u32x4){0u, 0u, 0u, 0u}; }
    bf16* H = (bf16*)a.out;
    if (M % (4 * NGW) != 0) { for (int m = gw; m < M; m += NGW) rms_row_to_bf16(a.in[0] + (size_t)m * DM, a.in[3], H + (size_t)m * DM, F.lane); }
    else for (int m = gw; m < M; m += 4 * NGW) rms_rows_to_bf16<4>(a.in[0] + (size_t)m * DM, (size_t)NGW * DM, a.in[3], H + (size_t)m * DM, F.lane);
    for (int m = gw; m < BATCH * NMEM; m += NGW) rms_row_to_bf16(a.in[1] + (size_t)m * DM, a.in[12], (bf16*)(ws + WS_MEMN) + (size_t)m * DM, F.lane);
    { float* BT = (float*)(ws + WS_BT); const float* tab = a.in[2];
      for (int i = blockIdx.x * 512 + F.tid; i < 8 * 128 * 384; i += F.G * 512) { const int j = i % 384, t = (i / 384) % 128, h = i / (384 * 128);
          const int rel = j - 128 - t; const bool ok = rel >= -128 && rel <= 128;
          BT[i] = ok ? tab[t5_bucket(rel) * 8 + h] * LOG2E : -INFINITY; } }
}

__device__ __forceinline__ void attnA_unit(Frame& F, const Args& a, int b, int n, int kvh) {
    constexpr int RSK = 144, RSV = 128;
    LAS unsigned char* Kl = F.lds; LAS unsigned char* Vl = F.lds + 384 * RSK;
    bf16* P = (bf16*)(a.ws + WS_P);
    const float* BT = (const float*)(a.ws + WS_BT);
    for (int blk = 0; blk < 3; ++blk) { const int pos0 = n * 128 - 128 + blk * 128; if (pos0 < 0 || pos0 >= SEQ) continue;
        stage_kv<64, RSK, RSV>(Kl, Vl, blk * 128, P + (size_t)(b * SEQ + pos0) * PLD, PLD, C_AK + kvh * 64, C_AV + kvh * 64, 128, a.in[6], F.tid); }
    LDS_WAIT(); __syncthreads();
    const int h = kvh * 4 + (F.wave >> 1), r32 = F.lane & 31, hi = F.lane >> 5;
    const float sink = a.in[7][h] * LOG2E;
#pragma unroll 1
    for (int qb = 0; qb < 2; ++qb) {
        const int t0 = (F.wave & 1) * 64 + qb * 32, t = t0 + r32;
        bf16* qrow = P + (size_t)(b * SEQ + n * 128 + t) * PLD + C_AQ + h * 64;
        bf16x8 qf[4]; load_q<64>(qrow, a.in[5], 0.125f * LOG2E, qf, F.lane);
        float m = sink, l = hi == 0 ? 1.f : 0.f; f32x16 o[2];
#pragma unroll
        for (int r = 0; r < 16; ++r) { o[0][r] = 0.f; o[1][r] = 0.f; }
        const int lo = max(t0 >= 64 ? 1 : 0, n == 0 ? 2 : 0), hi_t = min(t0 >= 64 ? 5 : 4, n == SEQ / 128 - 1 ? 3 : 5);
        const float* brow = BT + ((size_t)h * 128 + t) * 384;
        f32x16 b0, b1; load_bias(brow + 64 * lo, hi, b0, b1);
#pragma unroll 1
        for (int kt = lo; kt <= hi_t; ++kt) {
            f32x16 nb0 = b0, nb1 = b1;
            if (kt < hi_t) load_bias(brow + 64 * (kt + 1), hi, nb0, nb1);
            attn_tile<64, RSK, RSV>(Kl, Vl, 64 * kt, qf, b0, b1, m, l, o, F.lane);
            b0 = nb0; b1 = nb1; }
        store_o<64>(qrow, o, l, F.lane);
    }
    LDS_WAIT(); __syncthreads();
}
__device__ __forceinline__ void xattn_unit(Frame& F, const Args& a, int b, int tb, int h) {
    constexpr int RSK = 272, RSV = 320;
    LAS unsigned char* Kl = F.lds; LAS unsigned char* Vl = F.lds + 128 * RSK;
    bf16* P = (bf16*)(a.ws + WS_P);
    const bf16* KV = (const bf16*)(a.ws + WS_KV);
    const int r32 = F.lane & 31;
    bf16* qrow = P + (size_t)(b * SEQ + tb * 256 + F.wave * 32 + r32) * PLD + C_MQ + h * 128;
    bf16x8 qf[8]; load_q<128>(qrow, a.in[14], 0.08838834764831845f * LOG2E, qf, F.lane);
    float m = -1e30f, l = 0.f; f32x16 o[4];
#pragma unroll
    for (int db = 0; db < 4; ++db)
#pragma unroll
        for (int r = 0; r < 16; ++r) o[db][r] = 0.f;
#pragma unroll 1
    for (int half = 0; half < 2; ++half) {
        stage_kv<128, RSK, RSV>(Kl, Vl, 0, KV + (size_t)(b * NMEM + half * 128) * 1024, 1024, h * 128, 512 + h * 128, 128, a.in[15], F.tid);
        LDS_WAIT(); __syncthreads();
#pragma unroll 1
        for (int kt = 0; kt < 2; ++kt) { f32x16 z0, z1;
#pragma unroll
            for (int r = 0; r < 16; ++r) { z0[r] = 0.f; z1[r] = 0.f; }
            attn_tile<128, RSK, RSV>(Kl, Vl, 64 * kt, qf, z0, z1, m, l, o, F.lane); }
        LDS_WAIT(); __syncthreads();
    }
    store_o<128>(qrow, o, l, F.lane);
}


constexpr int SAF = C_GATE, SCF = C_GATE + 512, SBF = C_GATE + 1024, SDF = C_GATE + 1536, SAB = C_GATE + 2048, SCB = C_GATE + 2560;
constexpr int C_OF = C_DQ, C_OB = C_DK;
__device__ __forceinline__ int dn_pcol(int x) { return (x & 32) + 8 * ((x & 15) >> 2) + 4 * ((x >> 4) & 1) + (x & 3); }
__device__ __forceinline__ bf16x8 frag_lo(const LAS unsigned char* p) { const u32x2 a0 = *(const LAS u32x2*)p; u32x4 w; w.x = a0.x; w.y = a0.y; w.z = 0u; w.w = 0u; return __builtin_bit_cast(bf16x8, w); }
__device__ __forceinline__ bf16x8 frag_2(const LAS unsigned char* p) { const u32x2 a0 = *(const LAS u32x2*)p, a1 = *(const LAS u32x2*)(p + 32); u32x4 w; w.x = a0.x; w.y = a0.y; w.z = a1.x; w.w = a1.y; return __builtin_bit_cast(bf16x8, w); }
__device__ __forceinline__ bf16x8 pack_f4z(const f32x4 a) { u32x4 w; w.x = pk2(a[0], a[1]); w.y = pk2(a[2], a[3]); w.z = 0u; w.w = 0u; return __builtin_bit_cast(bf16x8, w); }
__device__ __forceinline__ bf16x8 pack_f4f4(const f32x4 a, const f32x4 b) { u32x4 w; w.x = pk2(a[0], a[1]); w.y = pk2(a[2], a[3]); w.z = pk2(b[0], b[1]); w.w = pk2(b[2], b[3]); return __builtin_bit_cast(bf16x8, w); }
__device__ __forceinline__ void dn_prep_block(Frame& F, const Args& a, int b, int h, int c0, int nch) {
    LAS float* raw = (LAS float*)(F.lds);
    LAS unsigned char* NL = F.lds;
    LAS unsigned char* TD = F.lds + 18432;
    LAS unsigned char* Qb = F.lds + 53248;
    LAS unsigned char* Kb = F.lds + 62464;
    LAS unsigned char* Vb = F.lds + 71680;
    LAS float* sm = (LAS float*)(F.lds + 80896);
    LAS float* gt = sm;
    LAS float* btk = sm + 128;
    LAS float* gct = sm + 256;
    LAS float* cu = sm + 384;
    LAS float* cwp = sm + 512;
    LAS float* egp = sm + 640;
    LAS float* esp = sm + 768;
    LAS unsigned char* QKL = F.lds + 24576;
    LAS unsigned char* KT = F.lds + 84480;
    LAS unsigned char* QT = F.lds + 104960;
    bf16* P = (bf16*)(a.ws + WS_P);
    float* BA = (float*)(a.ws + WS_BA);
    bf16* XB2 = (bf16*)a.out + (size_t)M * 1024;
    const float* cw = a.in[8];
    const int w = F.wave, lane = F.lane, tid = F.tid;
    float wt[3][5];
#pragma unroll
    for (int which = 0; which < 3; ++which)
#pragma unroll
        for (int j = 0; j < 5; ++j) wt[which][j] = cw[j * 1536 + which * 512 + h * 64 + lane];
    const float Ah = expf(a.in[9][(tid >> 6 & 1) * 8 + h]), dtb = a.in[10][(tid >> 6 & 1) * 8 + h];
    u32x4 rr[4]; float pa = 0.f, pb = 0.f;
#define DN_PREFETCH(cidx) do { const int t0p_ = (cidx) * 64; \
        _Pragma("unroll") for (int i_ = 0; i_ < 4; ++i_) { const int e = tid + 512 * i_, row = e / 24, c8 = e % 24, which = c8 >> 3, t = t0p_ - 2 + row; \
            rr[i_] = (u32x4){0u, 0u, 0u, 0u}; \
            if (e < 68 * 24 && t >= 0 && t < SEQ) rr[i_] = *(const u32x4*)(P + ((size_t)b * SEQ + t) * PLD + (which == 0 ? C_DQ : which == 1 ? C_DK : C_DV) + h * 64 + (c8 & 7) * 8); } \
        if (tid < 128) { const size_t tok = (size_t)b * SEQ + t0p_ + (tid & 63); pa = BA[tok * 32 + 16 + (tid >> 6) * 8 + h]; pb = BA[tok * 32 + (tid >> 6) * 8 + h]; } } while (0)
    DN_PREFETCH(c0);
#pragma unroll 1
  for (int ci = 0; ci < nch; ++ci) {
    int tid_o = F.tid; asm volatile("" : "+v"(tid_o));
    const int tid = tid_o, lane = tid & 63;
    const int c = c0 + ci, t0 = c * 64;
    const size_t tok0 = (size_t)b * SEQ + t0;
#pragma unroll
    for (int i_ = 0; i_ < 4; ++i_) { const int e = tid + 512 * i_, row = e / 24, c8 = e % 24;
        if (e < 68 * 24) { float v[8]; unpack8(rr[i_], v);
            *(LAS f32x4*)(raw + row * 192 + c8 * 8) = (f32x4){v[0], v[1], v[2], v[3]}; *(LAS f32x4*)(raw + row * 192 + c8 * 8 + 4) = (f32x4){v[4], v[5], v[6], v[7]}; } }
    if (tid < 128) { const int d = tid >> 6, i = tid & 63; const float xa = pa + dtb;
        gt[d * 64 + i] = -Ah * (fmaxf(xa, 0.f) + __logf(1.0f + __expf(-fabsf(xa))));
        btk[d * 64 + i] = sigmoidf_(pb); }
    if (ci + 1 < nch) DN_PREFETCH(c + 1);
    LDS_WAIT(); __syncthreads();
#pragma unroll
    for (int which = 0; which < 3; ++which) {
        float x[12], y[8];
#pragma unroll
        for (int j = 0; j < 12; ++j) x[j] = raw[(w * 8 + j) * 192 + which * 64 + lane];
#pragma unroll
        for (int r = 0; r < 8; ++r) { float acc = 0.f;
#pragma unroll
            for (int j = 0; j < 5; ++j) acc += x[r + j] * wt[which][j];
            y[r] = siluf_(acc); }
        if (which < 2) {
#pragma unroll
            for (int r = 0; r < 8; ++r) y[r] *= __builtin_amdgcn_rsqf(wave_sum_dpp(y[r] * y[r]) + EPS) * (which == 0 ? 0.125f : 1.0f);
        }
        LAS unsigned char* X = which == 0 ? Qb : which == 1 ? Kb : Vb;
#pragma unroll
        for (int r = 0; r < 8; ++r) *(LAS bf16*)(X + (w * 8 + r) * 144 + lane * 2) = (bf16)(pk2(y[r], 0.f) & 0xffffu);
        asm volatile("" ::: "memory");
    }
    if (w < 2) { const int i = w ? 63 - lane : lane; float gv = gt[w * 64 + i];
        gv = wave_scan_dpp(gv);
        const float glast = __builtin_bit_cast(float, __builtin_amdgcn_readlane(__builtin_bit_cast(int, gv), 63)), bt = btk[w * 64 + i], eg = __expf(gv);
        const float es = __expf(glast - gv);
        gct[w * 64 + i] = gv; cu[w * 64 + lane] = bt; cwp[w * 64 + lane] = bt * eg; egp[w * 64 + lane] = eg; esp[w * 64 + lane] = es;
        BA[(tok0 + lane) * 32 + w * 8 + h] = eg; }
    LDS_WAIT(); __syncthreads();
    { const int p = tid >> 3, c8 = tid & 7;
#pragma unroll
      for (int d = 0; d < 2; ++d) { const int i = d ? 63 - p : p; const float es = esp[d * 64 + p], eg = egp[d * 64 + p]; float v[8];
          unpack8(*(const LAS u32x4*)(Kb + i * 144 + c8 * 16), v);
#pragma unroll
          for (int j = 0; j < 8; ++j) v[j] *= es;
          *(LAS u32x4*)(KT + d * 10240 + p * 160 + c8 * 16) = pack8(v);
          unpack8(*(const LAS u32x4*)(Qb + i * 144 + c8 * 16), v);
#pragma unroll
          for (int j = 0; j < 8; ++j) v[j] *= eg;
          *(LAS u32x4*)(QT + d * 9216 + p * 144 + c8 * 16) = pack8(v); } }
    { const int wq = w & 3, tm = wq >> 1, tn = wq & 1, r32 = lane & 31, hi = lane >> 5;
      const LAS unsigned char* X = (w < 4) ? Kb : Qb;
      f32x16 acc;
#pragma unroll
      for (int r = 0; r < 16; ++r) acc[r] = 0.f;
#pragma unroll
      for (int kst = 0; kst < 4; ++kst) {
          const bf16x8 af = *(const LAS bf16x8*)(X + (32 * tm + r32) * 144 + (16 * kst + 8 * hi) * 2), bfr = *(const LAS bf16x8*)(Kb + (32 * tn + r32) * 144 + (16 * kst + 8 * hi) * 2);
          acc = __builtin_amdgcn_mfma_f32_32x32x16_bf16(af, bfr, acc, 0, 0, 0); }
      const int j = 32 * tn + r32; const float gjf = gct[j], gjb = gct[64 + j];
#pragma unroll
      for (int g4 = 0; g4 < 4; ++g4) { const int i0 = 32 * tm + 8 * g4 + 4 * hi;
          const f32x4 gif = *(const LAS f32x4*)(gct + i0), gib = *(const LAS f32x4*)(gct + 64 + i0), bif = *(const LAS f32x4*)(btk + i0), bib = *(const LAS f32x4*)(btk + 64 + i0);
#pragma unroll
          for (int q = 0; q < 4; ++q) { const int i = i0 + q; const float v = acc[4 * g4 + q];
              const float ef = __expf(fminf(gif[q] - gjf, 0.f)), eb = __expf(fminf(gib[q] - gjb, 0.f));
              if (w < 4) {
                  const float lf = (j < i) ? -bif[q] * v * ef : 0.f, lb = (j > i) ? -bib[q] * v * eb : 0.f;
                  *(LAS bf16*)(NL + i * 144 + j * 2) = (bf16)(pk2(lf, 0.f) & 0xffffu);
                  *(LAS bf16*)(NL + 9216 + (63 - i) * 144 + (63 - j) * 2) = (bf16)(pk2(lb, 0.f) & 0xffffu);
              } else {
                  const float qf = (j <= i) ? v * ef : 0.f, qb = (j >= i) ? v * eb : 0.f;
                  *(LAS bf16*)(QKL + i * 144 + j * 2) = (bf16)(pk2(qf, 0.f) & 0xffffu);
                  *(LAS bf16*)(QKL + 9216 + (63 - i) * 144 + (63 - j) * 2) = (bf16)(pk2(qb, 0.f) & 0xffffu);
              } } } }
    LDS_WAIT(); __syncthreads();
    if (w < 2) { const int blk = lane >> 4, col = lane & 15; const LAS unsigned char* nl = NL + w * 9216 + (16 * blk) * 144 + (16 * blk) * 2;
        u32x4 lr[16][2];
#pragma unroll
        for (int r = 1; r < 16; ++r) { lr[r][0] = *(const LAS u32x4*)(nl + r * 144); if (r > 8) lr[r][1] = *(const LAS u32x4*)(nl + r * 144 + 16); }
        float t[16];
#pragma unroll
        for (int r = 0; r < 16; ++r) { float a0 = (r == col) ? 1.f : 0.f, a1 = 0.f;
            if (r > 0) { float l[16]; { float l8[8]; unpack8(lr[r][0], l8);
#pragma unroll
                    for (int q = 0; q < 8; ++q) l[q] = l8[q]; }
                if (r > 8) { float l8[8]; unpack8(lr[r][1], l8);
#pragma unroll
                    for (int q = 0; q < 8; ++q) l[8 + q] = l8[q]; }
#pragma unroll
                for (int q = 0; q < r; ++q) { if (q & 1) a1 += l[q] * t[q]; else a0 += l[q] * t[q]; } }
            t[r] = a0 + a1; }
#pragma unroll
        for (int r = 0; r < 16; ++r) *(LAS bf16*)(TD + w * 3072 + blk * 768 + r * 48 + col * 2) = (bf16)(pk2(t[r], 0.f) & 0xffffu);
    }
    LDS_WAIT(); __syncthreads();
    { const int d = w >> 2, cc = lane & 15, g = lane >> 4;
      const LAS unsigned char* nl = NL + d * 9216; const LAS unsigned char* td = TD + d * 3072 + cc * 48 + 8 * g;
#pragma unroll
      for (int jj = 0; jj < 2; ++jj) { const int ct = 2 * (w & 3) + jj, part = ct >> 2, colb = 16 * (ct & 3);
          const LAS unsigned char* src = part ? Kb : Vb; const LAS float* coef = (part ? cwp : cu) + d * 64;
          f32x4 R[4];
#pragma unroll
          for (int bq = 0; bq < 4; ++bq) { const f32x4 cf = *(const LAS f32x4*)(coef + 16 * bq + 4 * g);
#pragma unroll
              for (int r = 0; r < 4; ++r) { const int p = 16 * bq + 4 * g + r, i = d ? 63 - p : p;
                  R[bq][r] = cf[r] * __uint_as_float((unsigned)(*(const LAS bf16*)(src + i * 144 + (colb + cc) * 2)) << 16); } }
          const f32x4 z4 = (f32x4){0.f, 0.f, 0.f, 0.f};
          f32x4 X0, X1, X2, X3, Y;
          const bf16x8 t0f = frag_lo(td), t1f = frag_lo(td + 768), t2f = frag_lo(td + 2 * 768), t3f = frag_lo(td + 3 * 768);
          const bf16x8 n1f = frag_lo(nl + (16 + cc) * 144 + 8 * g), n2f = frag_2(nl + (32 + cc) * 144 + 8 * g), n3f = frag_2(nl + (48 + cc) * 144 + 8 * g), n3g = frag_lo(nl + (48 + cc) * 144 + 64 + 8 * g);
          __builtin_amdgcn_sched_barrier(0);
          X0 = __builtin_amdgcn_mfma_f32_16x16x32_bf16(t0f, pack_f4z(R[0]), z4, 0, 0, 0);
          Y = __builtin_amdgcn_mfma_f32_16x16x32_bf16(n1f, pack_f4z(X0), R[1], 0, 0, 0);
          X1 = __builtin_amdgcn_mfma_f32_16x16x32_bf16(t1f, pack_f4z(Y), z4, 0, 0, 0);
          const bf16x8 x01 = pack_f4f4(X0, X1);
          Y = __builtin_amdgcn_mfma_f32_16x16x32_bf16(n2f, x01, R[2], 0, 0, 0);
          X2 = __builtin_amdgcn_mfma_f32_16x16x32_bf16(t2f, pack_f4z(Y), z4, 0, 0, 0);
          Y = __builtin_amdgcn_mfma_f32_16x16x32_bf16(n3f, x01, R[3], 0, 0, 0);
          Y = __builtin_amdgcn_mfma_f32_16x16x32_bf16(n3g, pack_f4z(X2), Y, 0, 0, 0);
          X3 = __builtin_amdgcn_mfma_f32_16x16x32_bf16(t3f, pack_f4z(Y), z4, 0, 0, 0);
          const float sgn = part ? -1.f : 1.f;
          const bf16x8 xb0 = pack_f4f4(X0 * sgn, X1 * sgn), xb1 = pack_f4f4(X2 * sgn, X3 * sgn);
          const int q4 = (lane & 15) >> 2, pp = lane & 3;
          const LAS unsigned char* qkl = QKL + d * 9216; const LAS unsigned char* qtl = QT + d * 9216;
          bf16* pA = (d == 0 || part == 1) ? P + tok0 * PLD + h * 64 + (part ? (d ? SAB : SAF) : SBF) : XB2 + tok0 * 512 + h * 64;
          bf16* pC = (d == 0 || part == 1) ? P + tok0 * PLD + h * 64 + (part ? (d ? SCB : SCF) : SDF) : XB2 + (size_t)M * 512 + tok0 * 512 + h * 64;
          const size_t pit = (d == 0 || part == 1) ? PLD : 512;
          const int pc = dn_pcol(colb + cc);
#pragma unroll
          for (int mt = 0; mt < 4; ++mt) {
              s16x4 klo[2], khi[2]; bf16x8 qkf[2]; f32x4 acc2;
              { const unsigned ka = (unsigned)(uintptr_t)(KT + d * 10240) + (4 * g + q4) * 160u + (16 * mt + 4 * pp) * 2u;
                asm volatile("ds_read_b64_tr_b16 %0, %1" : "=&v"(klo[0]) : "v"(ka) : "memory");
                asm volatile("ds_read_b64_tr_b16 %0, %1 offset:2560" : "=&v"(khi[0]) : "v"(ka) : "memory");
                asm volatile("ds_read_b64_tr_b16 %0, %1 offset:5120" : "=&v"(klo[1]) : "v"(ka) : "memory");
                asm volatile("ds_read_b64_tr_b16 %0, %1 offset:7680" : "=&v"(khi[1]) : "v"(ka) : "memory"); }
#pragma unroll
              for (int ks = 0; ks < 2; ++ks) { if (ks == 1 && mt < 2) continue; qkf[ks] = frag_2(qkl + (16 * mt + cc) * 144 + (32 * ks + 4 * g) * 2); }
#pragma unroll
              for (int r = 0; r < 4; ++r) acc2[r] = part ? __uint_as_float((unsigned)(*(const LAS bf16*)(qtl + (16 * mt + 4 * g + r) * 144 + (colb + cc) * 2)) << 16) : 0.f;
              asm volatile("s_waitcnt lgkmcnt(0)" ::: "memory"); __builtin_amdgcn_sched_barrier(0);
              f32x4 acc = z4;
#pragma unroll
              for (int ks = 0; ks < 2; ++ks) { const bf16x8 kf = (bf16x8){klo[ks][0], klo[ks][1], klo[ks][2], klo[ks][3], khi[ks][0], khi[ks][1], khi[ks][2], khi[ks][3]};
                  acc = __builtin_amdgcn_mfma_f32_16x16x32_bf16(kf, ks ? xb1 : xb0, acc, 0, 0, 0); }
#pragma unroll
              for (int ks = 0; ks < 2; ++ks) { if (ks == 1 && mt < 2) continue; acc2 = __builtin_amdgcn_mfma_f32_16x16x32_bf16(qkf[ks], ks ? xb1 : xb0, acc2, 0, 0, 0); }
              if (part == 0) {
                  u32x2 o; o.x = pk2(acc[0], acc[1]); o.y = pk2(acc[2], acc[3]); *(u32x2*)(pA + (size_t)(colb + cc) * pit + 16 * mt + 4 * g) = o;
                  o.x = pk2(acc2[0], acc2[1]); o.y = pk2(acc2[2], acc2[3]); *(u32x2*)(pC + (size_t)(colb + cc) * pit + 16 * mt + 4 * g) = o; }
              else {
#pragma unroll
                  for (int r = 0; r < 4; ++r) { pA[(size_t)(16 * mt + 4 * g + r) * pit + pc] = (bf16)(pk2(acc[r], 0.f) & 0xffffu); pC[(size_t)(16 * mt + 4 * g + r) * pit + pc] = (bf16)(pk2(acc2[r], 0.f) & 0xffffu); } }
              __builtin_amdgcn_sched_barrier(0);
          }
          asm volatile("" ::: "memory"); __builtin_amdgcn_sched_barrier(0);
      } }
    LDS_WAIT(); __syncthreads();
  }
#undef DN_PREFETCH
}

constexpr int DNX_A = 0, DNX_C = 8192, DNX_BT = 16384, DNX_DT = 24576, DNX_EG = 32768, DNX_SZ = 33792, DNX_OST = 3 * DNX_SZ;
__device__ __forceinline__ void dn_scan_step(const LAS unsigned char* buf, f32x4 (&Sacc)[4], int ws, int lane, LAS unsigned char* ost, int dir) {
    const int c = lane & 15, g = lane >> 4;
    const unsigned trow = 16 * ws + c, t0 = trow * 128u + ((((unsigned)(g >> 1)) ^ ((trow >> 1) & 7u)) << 4) + 8u * (g & 1);
    u32x2 bt[4], dt[4]; bf16x8 af[4][2], cf[4][2];
#pragma unroll
    for (int mt = 0; mt < 4; ++mt) { const unsigned row = 16 * mt + c, a0 = row * 128u + ((((unsigned)g) ^ ((row >> 1) & 7u)) << 4);
        bt[mt] = *(const LAS u32x2*)(buf + DNX_BT + (t0 ^ ((unsigned)mt << 5)));
#pragma unroll
        for (int ks = 0; ks < 2; ++ks) af[mt][ks] = *(const LAS bf16x8*)(buf + DNX_A + (a0 ^ ((unsigned)ks << 6))); }
#pragma unroll
    for (int mt = 0; mt < 4; ++mt) { const unsigned row = 16 * mt + c, a0 = row * 128u + ((((unsigned)g) ^ ((row >> 1) & 7u)) << 4);
        dt[mt] = *(const LAS u32x2*)(buf + DNX_DT + (t0 ^ ((unsigned)mt << 5)));
#pragma unroll
        for (int ks = 0; ks < 2; ++ks) cf[mt][ks] = *(const LAS bf16x8*)(buf + DNX_C + (a0 ^ ((unsigned)ks << 6))); }
    const float gm = ((const LAS float*)(buf + DNX_EG))[63];
    bf16x8 Sb[2];
#pragma unroll
    for (int ks = 0; ks < 2; ++ks) Sb[ks] = pack_f4f4(Sacc[2 * ks], Sacc[2 * ks + 1]);
    __builtin_amdgcn_sched_barrier(0);
#pragma unroll
    for (int mt = 0; mt < 4; ++mt) { f32x4 sn = Sacc[mt] * gm + (f32x4){bf_lo(bt[mt].x), bf_hi(bt[mt].x), bf_lo(bt[mt].y), bf_hi(bt[mt].y)};
#pragma unroll
        for (int ks = 0; ks < 2; ++ks) sn = __builtin_amdgcn_mfma_f32_16x16x32_bf16(af[mt][ks], Sb[ks], sn, 0, 0, 0);
        Sacc[mt] = sn; }
#pragma unroll
    for (int mt = 0; mt < 4; ++mt) { f32x4 oa = (f32x4){bf_lo(dt[mt].x), bf_hi(dt[mt].x), bf_lo(dt[mt].y), bf_hi(dt[mt].y)};
#pragma unroll
        for (int ks = 0; ks < 2; ++ks) oa = __builtin_amdgcn_mfma_f32_16x16x32_bf16(cf[mt][ks], Sb[ks], oa, 0, 0, 0);
#pragma unroll
        for (int r = 0; r < 4; ++r) { const int p = 16 * mt + 4 * g + r, i = dir ? 63 - p : p;
            *(LAS bf16*)(ost + i * 128 + (16 * ws + c) * 2) = (bf16)(pk2(oa[r], 0.f) & 0xffffu); } }
}
__device__ __forceinline__ void dn_scan_unit(Frame& F, const Args& a, int b, int h, int dir) {
    bf16* P = (bf16*)(a.ws + WS_P);
    const int w = F.wave, lane = F.lane;
#define DN_BAR() do { asm volatile("s_waitcnt lgkmcnt(0)" ::: "memory"); __builtin_amdgcn_s_barrier(); asm volatile("" ::: "memory"); } while (0)
    if (w < 4) {
        f32x4 Sacc[4];
#pragma unroll
        for (int mt = 0; mt < 4; ++mt) Sacc[mt] = (f32x4){0.f, 0.f, 0.f, 0.f};
        bf16* Ob = P + (size_t)b * SEQ * PLD + (dir ? C_OB : C_OF) + h * 64;
        DN_BAR();
        int slot = 0;
#pragma unroll 1
        for (int s = 0; s <= 128; ++s) {
            if (s > 0) { const int cp = dir ? 128 - s : s - 1; const LAS unsigned char* st = F.lds + DNX_OST + ((s - 1) & 1) * 8192;
#pragma unroll
                for (int k = 0; k < 2; ++k) { const int idx = F.tid + 256 * k, row = idx >> 3, ch = idx & 7;
                    *(u32x4*)(Ob + ((size_t)cp * 64 + row) * PLD + ch * 8) = *(const LAS u32x4*)(st + row * 128 + ch * 16); } }
            if (s < 128) dn_scan_step(F.lds + slot * DNX_SZ, Sacc, w, lane, F.lds + DNX_OST + (s & 1) * 8192, dir);
            slot = slot == 2 ? 0 : slot + 1;
            DN_BAR();
        }
    } else {
        const int hw = w - 4;
        const bf16* XB2 = (const bf16*)a.out + (size_t)M * 1024;
        const float* BAg = (const float*)(a.ws + WS_BA);
        const char* gp[8]; long gstep[8];
#pragma unroll
        for (int i = 0; i < 8; ++i) { const int pid = hw * 8 + i, blk = pid >> 3, pc = pid & 7, r = 8 * pc + (lane >> 3), cp = lane & 7;
            const int key = (r >> 1) & 7, cs = cp ^ key;
            const size_t tokb = (size_t)b * SEQ;
            if (dir == 1 && blk >= 2) { gp[i] = (const char*)(XB2 + (size_t)(blk - 2) * M * 512 + (tokb + r) * 512 + h * 64 + cs * 8); gstep[i] = 64L * 512 * 2; }
            else { const int col = blk == 0 ? (dir ? SAB : SAF) : blk == 1 ? (dir ? SCB : SCF) : blk == 2 ? SBF : SDF;
                   gp[i] = (const char*)(P + (tokb + r) * PLD + col + h * 64 + cs * 8); gstep[i] = 64L * PLD * 2; } }
        const char* ggc = (const char*)(BAg + ((size_t)b * SEQ + lane) * 32 + dir * 8 + h);
#define DN_ISSUE(n, slot_) do { const int cn_ = dir ? 127 - (n) : (n); LAS unsigned char* sb_ = F.lds + (slot_) * DNX_SZ; \
        _Pragma("unroll") for (int i = 0; i < 8; ++i) { const int pid = hw * 8 + i; \
            __builtin_amdgcn_global_load_lds((const unsigned*)(gp[i] + (long)cn_ * gstep[i]), (LAS unsigned*)(sb_ + (pid >> 3) * 8192 + (pid & 7) * 1024), 16, 0, 0); } \
        __builtin_amdgcn_global_load_lds((const unsigned*)(ggc + (long)cn_ * (64L * 32 * 4)), (LAS unsigned*)(sb_ + DNX_EG + hw * 256), 4, 0, 0); } while (0)
        DN_ISSUE(0, 0); DN_ISSUE(1, 1);
        asm volatile("s_waitcnt vmcnt(9)" ::: "memory");
        DN_BAR();
        int slot2 = 2;
#pragma unroll 1
        for (int s = 0; s <= 128; ++s) {
            if (s + 2 < 128) { DN_ISSUE(s + 2, slot2); asm volatile("s_waitcnt vmcnt(9)" ::: "memory"); }
            else { asm volatile("s_waitcnt vmcnt(0)" ::: "memory"); }
            slot2 = slot2 == 2 ? 0 : slot2 + 1;
            DN_BAR();
        }
#undef DN_ISSUE
    }
#undef DN_BAR
    __syncthreads();
}
__device__ __forceinline__ void dn_combine(Frame& F, const Args& a) {
    bf16* P = (bf16*)(a.ws + WS_P);
    const float* og = a.in[11];
    const int gw = F.vcu * NWAVES + F.wave, NGW = F.G * NWAVES, c0 = F.lane * 8;
    for (int row = gw; row < M; row += NGW) {
        bf16* rp = P + (size_t)row * PLD;
        float of[8], ob[8]; unpack8(*(const u32x4*)(rp + C_OF + c0), of); unpack8(*(const u32x4*)(rp + C_OB + c0), ob);
        float s[8], ss = 0.f;
#pragma unroll
        for (int j = 0; j < 8; ++j) { s[j] = of[j] + ob[j]; ss += s[j] * s[j]; }
        ss = group8_sum_dpp(ss);
        const float rstd = __builtin_amdgcn_rsqf(ss * (1.0f / 64) + EPS);
        bf16* zp = rp + C_DZ + c0; float z[8]; unpack8(*(const u32x4*)zp, z);
        const f32x4 g0 = *(const f32x4*)(og + (c0 & 63)), g1 = *(const f32x4*)(og + (c0 & 63) + 4);
        float y[8];
#pragma unroll
        for (int j = 0; j < 4; ++j) { y[j] = s[j] * rstd * g0[j] * siluf_(z[j]); y[4 + j] = s[4 + j] * rstd * g1[j] * siluf_(z[4 + j]); }
        *(u32x4*)zp = pack8(y);
    }
}
__device__ __forceinline__ void ffn_fixup_panel(Frame& F, const Args& a, int pm) {
    bf16* P = (bf16*)(a.ws + WS_P); const float* UE = (const float*)(a.ws + WS_UE);
    const float* cw = a.in[22]; const float* cb = a.in[23];
#pragma unroll 2
    for (int e = F.tid; e < 8 * (DFF / 4); e += 512) { const int k = e / (DFF / 4), ch = (e % (DFF / 4)) * 4, g = pm * 4 + (k >> 1), last = k & 1;
        const int row = g * 64 + (last ? 63 : 0);
        const bool hp = last ? true : (row % SEQ) != 0, hn = last ? (row % SEQ) != SEQ - 1 : true;
        const float* pu = UE + ((size_t)(last ? g : (g > 0 ? g - 1 : 0)) * 4 + (last ? 2 : 3)) * NUP;
        const float* cu = UE + ((size_t)g * 4 + (last ? 3 : 0)) * NUP;
        const float* nu = UE + ((size_t)(last ? (g < 511 ? g + 1 : 511) : g) * 4 + (last ? 0 : 1)) * NUP;
        const f32x4 z = (f32x4){0.f, 0.f, 0.f, 0.f};
        const f32x4 pg = hp ? *(const f32x4*)(pu + ch) : z, pv = hp ? *(const f32x4*)(pu + DFF + ch) : z, ng = hn ? *(const f32x4*)(nu + ch) : z, nv = hn ? *(const f32x4*)(nu + DFF + ch) : z;
        const f32x4 cg = *(const f32x4*)(cu + ch), cv = *(const f32x4*)(cu + DFF + ch);
        const f32x4 gate = *(const f32x4*)(cw + ch) * pg + *(const f32x4*)(cw + NUP + ch) * cg + *(const f32x4*)(cw + 2 * NUP + ch) * ng + *(const f32x4*)(cb + ch);
        const f32x4 val = *(const f32x4*)(cw + DFF + ch) * pv + *(const f32x4*)(cw + NUP + DFF + ch) * cv + *(const f32x4*)(cw + 2 * NUP + DFF + ch) * nv + *(const f32x4*)(cb + DFF + ch);
        u32x2 w; w.x = pk2(siluf_(gate[0]) * val[0], siluf_(gate[1]) * val[1]); w.y = pk2(siluf_(gate[2]) * val[2], siluf_(gate[3]) * val[3]);
        *(u32x2*)(P + (size_t)row * PLD + C_ACT + ch) = w; }
}

struct OneUnit { int pm, pn;
    __device__ __forceinline__ bool next(int i, Unit& u) const { if (i != 0) return false; u.pm = pm; u.pn = pn; return true; }
    __device__ __forceinline__ void a_ready(const Unit&) const {}
    __device__ __forceinline__ void done(const Unit&) const {} };
__global__ void __launch_bounds__(NWAVES * 64, 2) fwd_kernel(Args args) {
    extern __shared__ __attribute__((aligned(16))) unsigned char lds[];
    Frame F;
    F.lds = (LAS unsigned char*)lds;
    F.MISC = (volatile LAS unsigned*)(F.lds + MISC_OFF);
    F.tid = threadIdx.x; F.lane = F.tid & 63; F.wave = __builtin_amdgcn_readfirstlane(F.tid >> 6);
    F.G = gridDim.x; { const int bx = blockIdx.x; F.vcu = (F.G % 8 == 0) ? (bx % 8) * (F.G / 8) + bx / 8 : bx; }
    unsigned char* ws = args.ws;
    F.ctl = (gu32*)(ws + WS_CTL);
    for (int u = F.tid; u < (LDS_BYTES - LDSCTL_OFF) / 4; u += NWAVES * 64) ((LAS unsigned*)(F.lds + LDSCTL_OFF))[u] = 0u;
    __syncthreads();
    const int lo = args.ph_lo, hi = args.ph_hi;
    const bool single = (hi - lo) > 1;
    XcdBarrier bar; bar.bar = (unsigned*)(F.ctl + CW_BAR); bar.x = 0; bar.st = nullptr;
    if (single) bar = xcd_barrier_post((unsigned*)(F.ctl + CW_BAR), F.MISC + 8);
#ifndef PH_MASK
#define PH_MASK 0x1FF
#endif
#define IN(k) (((PH_MASK >> (k)) & 1) && lo <= (k) && (k) < hi)
#define SEAM(k) do { if (IN(k) && IN((k) + 1)) xcd_barrier(bar); } while (0)
    bf16* P = (bf16*)(ws + WS_P);
    const int bid = (int)blockIdx.x;
#define TS(k) do {} while (0)
#define TSB(k, blk) do {} while (0)
    TS(0);

    if (IN(0)) { p0_prologue(F, args); }
    SEAM(0); TS(1);
    if (IN(1)) {
        { pg8::Gemm g{(const bf16*)args.out, (const bf16*)(ws + WS_WIN), M, 3584, 1024, 1024, 1024}; pg8::StaticOrder S; S.init(M, 3584, F.G, bid);
          EpiInProj E{P, (float*)(ws + WS_BA)};
          pg8::gemm_phase<EpiInProj, pg8::StaticOrder, true, true>(F.lds + RING_OFF, g, S, E); }
    }
    SEAM(1); TS(2);
    if (IN(2)) {
        const bool full = F.G == 256; const int nU = full ? 256 : 4096;
        for (int u = bid; u < nU; u += F.G) { const int uu = full ? u * 16 : u; dn_prep_block(F, args, uu >> 10, (uu >> 7) & 7, uu & 127, full ? 16 : 1); }
    }
    TS(12); SEAM(2); TS(3);
    if (IN(3)) {
        const int ndn = F.G >= 128 ? 64 : 0;
        if (args.mode != 2) for (int u = (ndn ? (bid < ndn ? bid : 64) : bid); u < 64; u += (ndn ? 64 : F.G)) dn_scan_unit(F, args, u >> 4, (u >> 1) & 7, u & 1);
        if (bid >= ndn && args.mode != 1) { const int nb = F.G - ndn, me = bid - ndn;
            { const int pbase = nb >= 80 ? 64 : 0, np = (nb - pbase) < 16 ? (nb - pbase) : 16;
              if (me >= pbase && me < pbase + np) { unsigned done = 0;
                  for (int u = me - pbase; u < 16; u += np) {
                      pg8::Gemm g{(const bf16*)(ws + WS_MEMN), (const bf16*)(ws + WS_WKV), BATCH * NMEM, 1024, 1024, 1024, 1024}; OneUnit S{u >> 2, u & 3};
                      EpiBf16 E{(bf16*)(ws + WS_KV), 1024};
                      pg8::gemm_phase<EpiBf16, OneUnit, true, true>(F.lds + RING_OFF, g, S, E); ++done; }
                  VM_WAIT(); __syncthreads();
                  if (F.tid == 0) { __builtin_amdgcn_fence(__ATOMIC_RELEASE, "agent"); VM_WAIT(); (void)xb_add((unsigned*)(F.ctl + CW_KVF), done); }
              } }
            bool kv_ready = false;
            for (int u = me; u < 1024; u += nb) {
                if (u < 512) attnA_unit(F, args, u >> 7, (u >> 1) & 63, u & 1);
                else { const int v = u - 512;
                    if (!kv_ready) { kv_ready = true;
                        if (F.tid == 0) { unsigned* bw = (unsigned*)(F.ctl + CW_BAR); XB_SPIN(xb_ld((unsigned*)(F.ctl + CW_KVF)) < 16u, bw); __builtin_amdgcn_fence(__ATOMIC_ACQUIRE, "agent"); VM_WAIT(); }
                        __syncthreads(); }
                    xattn_unit(F, args, v >> 7, (v >> 2) & 31, v & 3); }
            }
            weight_items(F, args, WI_EARLY, WI_ALL, me * NWAVES + F.wave, nb * NWAVES);
        }
    }
    TS(10); TSB(11, 64); SEAM(3); TS(4);
    if (IN(4)) {
        dn_combine(F, args);
        pg8::Gemm g{(const bf16*)args.out, (const bf16*)(ws + WS_WIN) + (size_t)3584 * 1024, M, 3072, 1024, 1024, 1024}; pg8::StaticOrder S; S.init(M, 3072, F.G, bid);
        EpiGatesU8 E{P};
        pg8::gemm_phase<EpiGatesU8, pg8::StaticOrder, true, true>(F.lds + RING_OFF, g, S, E);
    }
    SEAM(4); TS(5);
    if (IN(5)) {
        pg8::Gemm g{P + C_AQ, (const bf16*)(ws + WS_WBR), M, 1024, 1536, PLD, 512};
        g.segt = 8; g.aoff1 = (long)(C_DZ - C_AQ) * 2 - 8 * 128; g.aoff2 = (long)(C_MQ - C_AQ) * 2 - 16 * 128;
        g.boff1 = (long)1024 * 512 * 2 - 8 * 128; g.boff2 = (long)2 * 1024 * 512 * 2 - 16 * 128;
        pg8::StaticOrder S; S.init(M, 1024, F.G, bid);
        EpiMerge E{P}; pg8::gemm_phase<EpiMerge, pg8::StaticOrder, true, true>(F.lds + RING_OFF, g, S, E);
    }
    SEAM(5); TS(6);
    if (IN(6)) {
        pg8::Gemm g{P + C_MG, (const bf16*)(ws + WS_WOUT), M, 1024, 1024, PLD, 1024}; pg8::StaticOrder S; S.init(M, 1024, F.G, bid);
        EpiWout E{args.in[0], args.out, P, (float*)(ws + WS_SSQ), (LAS float*)(F.lds + XCH_OFF)};
        pg8::gemm_phase<EpiWout, pg8::StaticOrder, true, true>(F.lds + RING_OFF, g, S, E);
    }
    SEAM(6); TS(7);
    if (IN(7)) {
        pg8::Gemm g{P + C_X1B, (const bf16*)(ws + WS_WUP), M, NUP, 1024, PLD, 1024}; pg8::StaticOrder S; S.init(M, NUP, F.G, bid);
        EpiUp E{(const float*)(ws + WS_SSQ), args.in[22], args.in[23], P, (float*)(ws + WS_UE), (LAS float*)(F.lds + XCH_OFF)};
        pg8::gemm_phase<EpiUp, pg8::StaticOrder, true, true>(F.lds + RING_OFF, g, S, E);
    }
    SEAM(7); TS(8);
    if (IN(8)) {
        pg8::Gemm g{P + C_ACT, (const bf16*)(ws + WS_WDN), M, 1024, DFF, PLD, DFF}; pg8::StaticOrder S; S.init(M, 1024, F.G, bid);
        { Unit u; int prev = -1; for (int i = 0; S.next(i, u); ++i) { if (u.pm != prev) ffn_fixup_panel(F, args, u.pm); prev = u.pm; } }
        VM_WAIT(); __syncthreads();
        EpiDown E{args.out, P};
        pg8::gemm_phase<EpiDown, pg8::StaticOrder, true, true>(F.lds + RING_OFF, g, S, E);
    }
    TS(9);
#undef IN
#undef SEAM
}

#ifdef DBG_TIME
__global__ void dbg_ts_kernel(unsigned char* ws, int k) { if (threadIdx.x == 0) ((unsigned long long*)(ws + WS_CTL + 65536))[k] = __builtin_amdgcn_s_memrealtime(); }
__global__ void dbg_wait_kernel(unsigned char* ws) {
    if (threadIdx.x == 0) { const unsigned long long* tsb = (const unsigned long long*)(ws + WS_CTL + 65536);
        const unsigned long long te = __builtin_amdgcn_s_memrealtime();
        const unsigned long long d1 = tsb[DBG_A1] - tsb[DBG_A0], d2 = tsb[DBG_B1] - tsb[DBG_B0];
        const unsigned long long W = d1 + 100000ull * (d2 / 1000ull);
        while (__builtin_amdgcn_s_memrealtime() - te < W) __builtin_amdgcn_s_sleep(32); }
}
#endif
constexpr int N_PHASES = 9;
#ifndef MK_PER_PHASE
#define MK_PER_PHASE 0
#endif
extern "C" void kernel_launch(void* const* d_in, const int* in_sizes, int n_in, void* d_out, int out_size, void* d_ws, size_t ws_size, hipStream_t stream) {
    static int grid = 0;
    if (grid == 0) {
        if (n_in != 25 || in_sizes[0] != M * DM || out_size != M * DM || ws_size < WS_END) {
            fprintf(stderr, "kernel_launch: unexpected shapes (n_in %d, in0 %d, out %d, ws %zu); nothing launched\n", n_in, n_in > 0 ? in_sizes[0] : -1, out_size, ws_size); grid = -1; return; }
        int dev = 0, cus = 0, per_cu = 0;
        if (hipGetDevice(&dev) != hipSuccess || hipDeviceGetAttribute(&cus, hipDeviceAttributeMultiprocessorCount, dev) != hipSuccess) { grid = -1; return; }
        if (hipFuncSetAttribute((const void*)fwd_kernel, hipFuncAttributeMaxDynamicSharedMemorySize, LDS_BYTES) != hipSuccess) { fprintf(stderr, "kernel_launch: hipFuncSetAttribute failed\n"); grid = -1; return; }
        if (hipOccupancyMaxActiveBlocksPerMultiprocessor(&per_cu, (const void*)fwd_kernel, NWAVES * 64, LDS_BYTES) != hipSuccess || per_cu < 1) { fprintf(stderr, "kernel_launch: occupancy query reports %d\n", per_cu); }
        (void)hipGetLastError();
        grid = cus;
    }
    if (grid < 0) return;
    if (hipMemsetAsync((char*)d_ws + WS_CTL, 0, CTL_ZERO_BYTES, stream) != hipSuccess) return;
    Args a{};
    for (int i = 0; i < 25; ++i) a.in[i] = (const float*)d_in[i];
    a.out = (float*)d_out; a.ws = (unsigned char*)d_ws;
#ifdef DBG_TIME
    for (int p = 0; p < N_PHASES; ++p) { hipLaunchKernelGGL(dbg_ts_kernel, dim3(1), dim3(64), 0, stream, (unsigned char*)d_ws, p);
        a.ph_lo = p; a.ph_hi = p + 1;
        if (p == 3) { a.mode = 1; hipLaunchKernelGGL(fwd_kernel, dim3(grid), dim3(NWAVES * 64), LDS_BYTES, stream, a); hipLaunchKernelGGL(dbg_ts_kernel, dim3(1), dim3(64), 0, stream, (unsigned char*)d_ws, 12); a.mode = 2; }
        hipLaunchKernelGGL(fwd_kernel, dim3(grid), dim3(NWAVES * 64), LDS_BYTES, stream, a); a.mode = 0; }
    hipLaunchKernelGGL(dbg_ts_kernel, dim3(1), dim3(64), 0, stream, (unsigned char*)d_ws, N_PHASES);
    hipLaunchKernelGGL(dbg_wait_kernel, dim3(1), dim3(64), 0, stream, (unsigned char*)d_ws);
    return;
#endif
    if (MK_PER_PHASE) {
        for (int p = 0; p < N_PHASES; ++p) { a.ph_lo = p; a.ph_hi = p + 1; hipLaunchKernelGGL(fwd_kernel, dim3(grid), dim3(NWAVES * 64), LDS_BYTES, stream, a); }
    } else {
        a.ph_lo = 0; a.ph_hi = N_PHASES; hipLaunchKernelGGL(fwd_kernel, dim3(grid), dim3(NWAVES * 64), LDS_BYTES, stream, a);
    }
}
```

```cpp
#include <hip/hip_runtime.h>
#include <cstdio>
#include <cstdint>
#include <cmath>
namespace pg8 {
#define PG8_LAS __attribute__((address_space(3)))
typedef unsigned short bf16_t;
typedef short bf16x8 __attribute__((ext_vector_type(8)));
typedef float f32x4 __attribute__((ext_vector_type(4)));
typedef unsigned u32x4 __attribute__((ext_vector_type(4)));
constexpr int BM = 256, BK = 64, HALF = 128, HTB = HALF * BK * 2  , STAGE_BYTES = 8 * HTB, NXCD = 8, WGM = 8;

__host__ __device__ __forceinline__ int lds_byte(int r, int c) { const int st = (r >> 4) * 2 + (c >> 5), rr = r & 15, cc = c & 31, ob = rr * 64 + cc * 2; return st * 1024 + (ob ^ (((ob >> 9) & 1) << 5)); }
__host__ __device__ __forceinline__ void stage_rc(int b, int& R, int& C) { const int st = b / 1024, sb = b % 1024, swz = sb ^ (((sb >> 9) & 1) << 5); R = (st >> 1) * 16 + swz / 64; C = (st & 1) * 32 + (swz % 64) / 2; }
__host__ __device__ __forceinline__ int perm32(int rho) { const int n = rho >> 4, i = rho & 15; return 8 * (i >> 2) + 4 * n + (i & 3); }

struct Unit { int pm, pn, aux; };
struct Gemm { const bf16_t* A; const bf16_t* Bt; int M, N, K, lda, ldb; int segt = 1 << 30; long aoff1 = 0, aoff2 = 0, boff1 = 0, boff2 = 0; };

struct StaticOrder {
    int nM, nN, nwg, G, c;
    __host__ __device__ __forceinline__ void init(int M, int N, int G_, int c_) { nM = M / BM; nN = N / BM; nwg = nM * nN; G = G_; c = c_; }
    __host__ __device__ __forceinline__ bool next(int i, Unit& u) const {
        const long L = (long)i * G + c; if (L >= nwg) return false;
        int wgid = (int)L; { const int q = nwg / NXCD, r = nwg % NXCD, xcd = wgid % NXCD, off = wgid / NXCD; wgid = (xcd < r ? xcd * (q + 1) : r * (q + 1) + (xcd - r) * q) + off; }
        const int nig = WGM * nN, gid = wgid / nig, fm = gid * WGM, gsz = (nM - fm) < WGM ? (nM - fm) : WGM;
        u.pm = fm + ((wgid % nig) % gsz); u.pn = (wgid % nig) / gsz; return true;
    }
    __device__ __forceinline__ void a_ready(const Unit&) const {}
    __device__ __forceinline__ void done(const Unit&) const {}
};

template <class Epi, class Sched, bool ALIGN_EPI = false, bool SP2 = false>
__device__ __forceinline__ void gemm_phase(PG8_LAS unsigned char* lds, const Gemm g, const Sched& S, const Epi& E) {
    const int tid = threadIdx.x, wid = __builtin_amdgcn_readfirstlane(tid >> 6), lane = tid & 63, wr = wid >> 2, wc = wid & 3, fr = lane & 15, fq = lane >> 4;
    const int K = g.K, nt = K / BK;
    unsigned voffA[2], voffB[2];
#pragma unroll
    for (int i = 0; i < 2; ++i) { int R, C; stage_rc(tid * 16 + i * 8192, R, C); const int Rb = Epi::PERM ? ((R & ~31) + perm32(R & 31)) : R;
        voffA[i] = (unsigned)(R * g.lda + C) * 2u; voffB[i] = (unsigned)(Rb * g.ldb + C) * 2u; }
    const size_t kstep = (size_t)(BK * 2);
    const size_t hstepA = (size_t)HALF * g.lda * 2, hstepB = (size_t)HALF * g.ldb * 2;
    const size_t tstepA = 2 * hstepA, tstepB = 2 * hstepB;
    const unsigned ldsw = (unsigned)wid * 1024u;
    const int aoff = lds_byte(wr * 64 + fr, fq * 8), boff = lds_byte(wc * 32 + fr, fq * 8);
#define PG8_SA(b, h) (((b) * 2 + (h)) * HTB)
#define PG8_SB(b, h) ((4 + (b) * 2 + (h)) * HTB)
#define PG8_STAGE(bufoff, gbase, voff) do { _Pragma("unroll") for (int _i = 0; _i < 2; ++_i) \
        __builtin_amdgcn_global_load_lds((const unsigned*)((const char*)(gbase) + (voff)[_i]), (PG8_LAS unsigned*)(lds + (bufoff) + ldsw + _i * 8192), 16, 0, 0); } while (0)
#define PG8_LDA(dst, b, h) do { _Pragma("unroll") for (int m = 0; m < 4; ++m) _Pragma("unroll") for (int k = 0; k < 2; ++k) dst[m][k] = *(const PG8_LAS bf16x8*)(lds + PG8_SA(b, h) + aoff + m * 2048 + k * 1024); } while (0)
#define PG8_LDB(dst, b, h) do { _Pragma("unroll") for (int n = 0; n < 2; ++n) _Pragma("unroll") for (int k = 0; k < 2; ++k) dst[n][k] = *(const PG8_LAS bf16x8*)(lds + PG8_SB(b, h) + boff + n * 2048 + k * 1024); } while (0)
#define PG8_MMA(ai, bj, At, Bt) do { __builtin_amdgcn_s_setprio(1); _Pragma("unroll") for (int m = 0; m < 4; ++m) _Pragma("unroll") for (int n = 0; n < 2; ++n) _Pragma("unroll") for (int k = 0; k < 2; ++k) \
        acc[ai][bj][m][n] = __builtin_amdgcn_mfma_f32_16x16x32_bf16(Bt[n][k], At[m][k], acc[ai][bj][m][n], 0, 0, 0); __builtin_amdgcn_s_setprio(0); } while (0)
#define PG8_WAIT_V(n) asm volatile("s_waitcnt vmcnt(" #n ")" ::: "memory")
#define PG8_WAIT_L(n) asm volatile("s_waitcnt lgkmcnt(" #n ")" ::: "memory")
#define PG8_BAR __builtin_amdgcn_s_barrier()
#define PG8_SCHED __builtin_amdgcn_sched_barrier(0)
    Unit cur, nxt; int ui = 0;
    if (!S.next(0, cur)) return;
    if constexpr (Epi::PREFETCH) E.prefetch(cur, 0, tid);
    f32x4 acc[2][2][4][2];
#pragma unroll
    for (int a = 0; a < 2; ++a)
#pragma unroll
        for (int b = 0; b < 2; ++b)
#pragma unroll
            for (int m = 0; m < 4; ++m)
#pragma unroll
                for (int n = 0; n < 2; ++n) acc[a][b][m][n] = (f32x4){0.f, 0.f, 0.f, 0.f};
    bf16x8 At[4][2], B0[2][2], B1[2][2];
    const char* cA = (const char*)g.A + (size_t)cur.pm * tstepA; const char* cB = (const char*)g.Bt + (size_t)cur.pn * tstepB;
    S.a_ready(cur);
    if constexpr (SP2) {
        PG8_STAGE(PG8_SB(0, 0), cB, voffB); PG8_STAGE(PG8_SB(0, 1), cB + hstepB, voffB); PG8_STAGE(PG8_SA(0, 0), cA, voffA); PG8_STAGE(PG8_SA(0, 1), cA + hstepA, voffA);
        if (wr == 1) PG8_BAR;
        PG8_WAIT_V(2); PG8_BAR;
        PG8_STAGE(PG8_SB(1, 0), cB + kstep, voffB); PG8_STAGE(PG8_SA(1, 0), cA + kstep, voffA); PG8_STAGE(PG8_SB(1, 1), cB + hstepB + kstep, voffB);
        PG8_WAIT_V(6); PG8_BAR;
    } else {
        PG8_STAGE(PG8_SB(0, 0), cB, voffB); PG8_STAGE(PG8_SA(0, 0), cA, voffA); PG8_STAGE(PG8_SB(0, 1), cB + hstepB, voffB); PG8_STAGE(PG8_SA(0, 1), cA + hstepA, voffA);
        if (wr == 1) PG8_BAR;
        PG8_WAIT_V(4); PG8_BAR;
        PG8_STAGE(PG8_SB(1, 0), cB + kstep, voffB); PG8_STAGE(PG8_SA(1, 0), cA + kstep, voffA); PG8_STAGE(PG8_SB(1, 1), cB + hstepB + kstep, voffB);
        PG8_WAIT_V(6); PG8_BAR;
    }
    for (;;) {
        const bool has_next = S.next(ui + 1, nxt);
        const char* nA = has_next ? (const char*)g.A + (size_t)nxt.pm * tstepA : cA; const char* nB = has_next ? (const char*)g.Bt + (size_t)nxt.pn * tstepB : cB;
        for (int t = 0; t < nt; t += 2) {
            const bool last = (t == nt - 2);
            if constexpr (Epi::RESCALE) { if (t == g.segt || t == 2 * g.segt) E.rescale(acc, cur, wr, wc, fr, fq, t / g.segt); }
            const long so1 = (t + 1 >= 2 * g.segt) ? g.aoff2 : ((t + 1 >= g.segt) ? g.aoff1 : 0), so2 = (t + 2 >= 2 * g.segt) ? g.aoff2 : ((t + 2 >= g.segt) ? g.aoff1 : 0), sb2 = (t + 2 >= 2 * g.segt) ? g.boff2 : ((t + 2 >= g.segt) ? g.boff1 : 0);
            const char* a1 = cA + so1 + (size_t)(t + 1) * kstep;
            const char* a2 = last ? nA : cA + so2 + (size_t)(t + 2) * kstep; const char* b2 = last ? nB : cB + sb2 + (size_t)(t + 2) * kstep;
            const char* a3 = a2 + kstep; const char* b3 = b2 + kstep;
            if (last && has_next) S.a_ready(nxt);
            if constexpr (SP2) {
            PG8_LDB(B0, 0, 0); PG8_LDB(B1, 0, 1); PG8_SCHED; PG8_LDA(At, 0, 0); PG8_STAGE(PG8_SA(1, 1), a1 + hstepA, voffA);
            PG8_WAIT_V(8); PG8_WAIT_L(0); PG8_BAR; PG8_MMA(0, 0, At, B0); PG8_MMA(0, 1, At, B1); PG8_BAR; PG8_SCHED;
            PG8_LDA(At, 0, 1); PG8_STAGE(PG8_SB(0, 0), b2, voffB); PG8_STAGE(PG8_SB(0, 1), b2 + hstepB, voffB); PG8_STAGE(PG8_SA(0, 0), a2, voffA);
            PG8_WAIT_V(8); PG8_WAIT_L(0); PG8_BAR; PG8_MMA(1, 0, At, B0); PG8_MMA(1, 1, At, B1); PG8_BAR; PG8_SCHED;
            PG8_LDB(B0, 1, 0); PG8_LDB(B1, 1, 1); PG8_SCHED; PG8_LDA(At, 1, 0); PG8_STAGE(PG8_SA(0, 1), a2 + hstepA, voffA);
            PG8_WAIT_V(8); PG8_WAIT_L(0); PG8_BAR; PG8_MMA(0, 0, At, B0); PG8_MMA(0, 1, At, B1); PG8_BAR; PG8_SCHED;
            PG8_LDA(At, 1, 1); PG8_STAGE(PG8_SB(1, 0), b3, voffB); PG8_STAGE(PG8_SB(1, 1), b3 + hstepB, voffB); PG8_STAGE(PG8_SA(1, 0), a3, voffA);
            PG8_WAIT_V(8); PG8_WAIT_L(0); PG8_BAR; PG8_MMA(1, 0, At, B0); PG8_MMA(1, 1, At, B1); PG8_BAR; PG8_SCHED;
            } else {
            PG8_LDB(B0, 0, 0); PG8_SCHED; PG8_LDA(At, 0, 0); PG8_STAGE(PG8_SA(1, 1), a1 + hstepA, voffA);
            PG8_WAIT_L(8); PG8_BAR; PG8_WAIT_L(0); PG8_MMA(0, 0, At, B0); PG8_BAR; PG8_SCHED;
            PG8_LDB(B1, 0, 1); PG8_STAGE(PG8_SB(0, 0), b2, voffB);
            PG8_BAR; PG8_WAIT_L(0); PG8_MMA(0, 1, At, B1); PG8_BAR;
            PG8_LDA(At, 0, 1); PG8_STAGE(PG8_SA(0, 0), a2, voffA);
            PG8_BAR; PG8_WAIT_L(0); PG8_MMA(1, 0, At, B0); PG8_BAR; PG8_SCHED;
            PG8_STAGE(PG8_SB(0, 1), b2 + hstepB, voffB);
            PG8_WAIT_V(6); PG8_BAR; PG8_MMA(1, 1, At, B1); PG8_BAR;
            PG8_LDB(B0, 1, 0); PG8_SCHED; PG8_LDA(At, 1, 0); PG8_STAGE(PG8_SA(0, 1), a2 + hstepA, voffA);
            PG8_WAIT_L(8); PG8_BAR; PG8_WAIT_L(0); PG8_MMA(0, 0, At, B0); PG8_BAR; PG8_SCHED;
            PG8_LDB(B1, 1, 1); PG8_STAGE(PG8_SB(1, 0), b3, voffB);
            PG8_BAR; PG8_WAIT_L(0); PG8_MMA(0, 1, At, B1); PG8_BAR;
            PG8_LDA(At, 1, 1); PG8_STAGE(PG8_SA(1, 0), a3, voffA);
            PG8_BAR; PG8_WAIT_L(0); PG8_MMA(1, 0, At, B0); PG8_BAR; PG8_SCHED;
            PG8_STAGE(PG8_SB(1, 1), b3 + hstepB, voffB);
            PG8_WAIT_V(6); PG8_BAR; PG8_MMA(1, 1, At, B1); PG8_BAR;
            }
        }
        if constexpr (ALIGN_EPI) { if (wr == 0) PG8_BAR; }
        if constexpr (Epi::PREFETCH) cur.aux = ui & 1;
        if constexpr (!Epi::AFTER_DRAIN) { E(acc, cur, wr, wc, fr, fq); S.done(cur); }
        if constexpr (Epi::PREFETCH) { if (has_next) E.prefetch(nxt, (ui + 1) & 1, tid); }
        if (!has_next) break;
#pragma unroll
        for (int a = 0; a < 2; ++a)
#pragma unroll
            for (int b = 0; b < 2; ++b)
#pragma unroll
                for (int m = 0; m < 4; ++m)
#pragma unroll
                    for (int n = 0; n < 2; ++n) acc[a][b][m][n] = (f32x4){0.f, 0.f, 0.f, 0.f};
        cur = nxt; cA = nA; cB = nB; ++ui;
        if constexpr (ALIGN_EPI) { if (wr == 1) PG8_BAR; }
    }
    PG8_WAIT_V(0);
    if constexpr (!ALIGN_EPI) { if (wr == 0) PG8_BAR; }
    PG8_BAR;
    if constexpr (Epi::AFTER_DRAIN) { E.fused(acc, cur, wr, wc, fr, fq, lds, wid, lane); S.done(cur); }
#undef PG8_SA
#undef PG8_SB
#undef PG8_STAGE
#undef PG8_LDA
#undef PG8_LDB
#undef PG8_MMA
#undef PG8_WAIT_V
#undef PG8_WAIT_L
#undef PG8_BAR
#undef PG8_SCHED
}
}

#define LAS __attribute__((address_space(3)))
#define GAS __attribute__((address_space(1)))
typedef unsigned short bf16;
typedef short bf16x8 __attribute__((ext_vector_type(8)));
typedef short s16x4 __attribute__((ext_vector_type(4)));
typedef float f32x4 __attribute__((ext_vector_type(4)));
typedef float f32x16 __attribute__((ext_vector_type(16)));
typedef unsigned u32x4 __attribute__((ext_vector_type(4)));
typedef unsigned u32x2 __attribute__((ext_vector_type(2)));
typedef float f32x2_t __attribute__((ext_vector_type(2)));
typedef __bf16 bf16x2_t __attribute__((ext_vector_type(2)));

constexpr int BATCH = 4, SEQ = 8192, DM = 1024, M = BATCH * SEQ;
constexpr int NMEM = 256;
constexpr int PLD = 6400;
constexpr int C_AQ = 0, C_AK = 512, C_AV = 640, C_DQ = 768, C_DK = 1280, C_DV = 1792, C_DZ = 2304, C_MQ = 2816, C_GATE = 3328;
constexpr int C_MG = 768, C_X1B = 1792, C_ACT = 2816;
constexpr int NIN = 6656;
constexpr int DFF = 2816, NUP = 5632;
constexpr float EPS = 1e-6f;
constexpr float LOG2E = 1.4426950408889634f;

__device__ __forceinline__ float bf_lo(unsigned w) { return __uint_as_float(w << 16); }
__device__ __forceinline__ float bf_hi(unsigned w) { return __uint_as_float(w & 0xffff0000u); }
__device__ __forceinline__ unsigned pk2(float lo, float hi) { f32x2_t v = {lo, hi}; bf16x2_t b = __builtin_convertvector(v, bf16x2_t); return __builtin_bit_cast(unsigned, b); }
__device__ __forceinline__ float fexp2(float x) { return __builtin_amdgcn_exp2f(x); }
__device__ __forceinline__ float frcp(float x) { return __builtin_amdgcn_rcpf(x); }
__device__ __forceinline__ float sigmoidf_(float x) { return frcp(1.0f + fexp2(-x * LOG2E)); }
__device__ __forceinline__ float siluf_(float x) { return x * sigmoidf_(x); }
__device__ __forceinline__ void unpack8(const u32x4 w, float (&v)[8]) {
    v[0] = bf_lo(w.x); v[1] = bf_hi(w.x); v[2] = bf_lo(w.y); v[3] = bf_hi(w.y); v[4] = bf_lo(w.z); v[5] = bf_hi(w.z); v[6] = bf_lo(w.w); v[7] = bf_hi(w.w); }
__device__ __forceinline__ u32x4 pack8(const float (&v)[8]) { u32x4 w; w.x = pk2(v[0], v[1]); w.y = pk2(v[2], v[3]); w.z = pk2(v[4], v[5]); w.w = pk2(v[6], v[7]); return w; }

template <int CTRL, int ROWMASK> __device__ __forceinline__ float dpp_add(float x) {
    return x + __builtin_bit_cast(float, __builtin_amdgcn_update_dpp(0, __builtin_bit_cast(int, x), CTRL, ROWMASK, 0xF, false)); }
__device__ __forceinline__ float wave_sum_dpp(float x) {
    x = dpp_add<0xB1, 0xF>(x); x = dpp_add<0x4E, 0xF>(x); x = dpp_add<0x141, 0xF>(x); x = dpp_add<0x140, 0xF>(x);
    x = dpp_add<0x142, 0xA>(x); x = dpp_add<0x143, 0xC>(x);
    return __builtin_bit_cast(float, __builtin_amdgcn_readlane(__builtin_bit_cast(int, x), 63)); }
__device__ __forceinline__ float wave_scan_dpp(float x) {
    x = dpp_add<0x111, 0xF>(x); x = dpp_add<0x112, 0xF>(x); x = dpp_add<0x114, 0xF>(x); x = dpp_add<0x118, 0xF>(x);
    x = dpp_add<0x142, 0xA>(x); x = dpp_add<0x143, 0xC>(x);
    return x; }
__device__ __forceinline__ float group8_sum_dpp(float x) { x = dpp_add<0xB1, 0xF>(x); x = dpp_add<0x4E, 0xF>(x); return dpp_add<0x141, 0xF>(x); }
__device__ __forceinline__ float group16_sum_dpp(float x) { return dpp_add<0x140, 0xF>(group8_sum_dpp(x)); }
using pg8::Unit;
constexpr int HALF = pg8::HALF, BM = pg8::BM;

struct EpiInProj {
    static constexpr bool PERM = true, AFTER_DRAIN = false, PREFETCH = false, RESCALE = false;
    bf16* P; float* BA;
    __device__ __forceinline__ void operator()(const f32x4 (&acc)[2][2][4][2], const Unit& u, int wr, int wc, int fr, int fq) const {
        const int row0 = u.pm * BM + wr * 64 + fr;
        if (u.pn < 13) {
            const int col0 = u.pn * BM + wc * 32 + 8 * fq;
#pragma unroll
            for (int ai = 0; ai < 2; ++ai)
#pragma unroll
                for (int m = 0; m < 4; ++m) { bf16* rowp = P + (size_t)(row0 + ai * HALF + m * 16) * PLD + col0;
#pragma unroll
                    for (int bj = 0; bj < 2; ++bj) { const f32x4 v0 = acc[ai][bj][m][0], v1 = acc[ai][bj][m][1];
                        u32x4 w; w.x = pk2(v0[0], v0[1]); w.y = pk2(v0[2], v0[3]); w.z = pk2(v1[0], v1[1]); w.w = pk2(v1[2], v1[3]);
                        __builtin_nontemporal_store(w, (u32x4*)(rowp + bj * HALF)); } }
        } else if (wc == 0) {
#pragma unroll
            for (int ai = 0; ai < 2; ++ai)
#pragma unroll
                for (int m = 0; m < 4; ++m) { float* rp = BA + (size_t)(row0 + ai * HALF + m * 16) * 32 + 8 * fq;
                    *(f32x4*)rp = acc[ai][0][m][0]; *(f32x4*)(rp + 4) = acc[ai][0][m][1]; }
        }
    }
};
struct EpiBf16 {
    static constexpr bool PERM = true, AFTER_DRAIN = false, PREFETCH = false, RESCALE = false;
    bf16* O; int ldc;
    __device__ __forceinline__ void operator()(const f32x4 (&acc)[2][2][4][2], const Unit& u, int wr, int wc, int fr, int fq) const {
        const int row0 = u.pm * BM + wr * 64 + fr, col0 = u.pn * BM + wc * 32 + 8 * fq;
#pragma unroll
        for (int ai = 0; ai < 2; ++ai)
#pragma unroll
            for (int m = 0; m < 4; ++m) { bf16* rowp = O + (size_t)(row0 + ai * HALF + m * 16) * ldc + col0;
#pragma unroll
                for (int bj = 0; bj < 2; ++bj) { const f32x4 v0 = acc[ai][bj][m][0], v1 = acc[ai][bj][m][1];
                    u32x4 w; w.x = pk2(v0[0], v0[1]); w.y = pk2(v0[2], v0[3]); w.z = pk2(v1[0], v1[1]); w.w = pk2(v1[2], v1[3]);
                    *(u32x4*)(rowp + bj * HALF) = w; } }
    }
};
template <int PASS> struct EpiBranch {
    static constexpr bool PERM = true, AFTER_DRAIN = false, PREFETCH = false, RESCALE = false;
    bf16* P;
    __device__ __forceinline__ void operator()(const f32x4 (&acc)[2][2][4][2], const Unit& u, int wr, int wc, int fr, int fq) const {
        const int row0 = u.pm * BM + wr * 64 + fr, col0 = u.pn * BM + wc * 32 + 8 * fq;
#pragma unroll
        for (int ai = 0; ai < 2; ++ai)
#pragma unroll
            for (int m = 0; m < 4; ++m) { bf16* rowp = P + (size_t)(row0 + ai * HALF + m * 16) * PLD;
#pragma unroll
                for (int bj = 0; bj < 2; ++bj) {
                    const int c = col0 + bj * HALF;
                    const u32x4 gw = *(const u32x4*)(rowp + C_GATE + 1024 * PASS + c);
                    float g[8]; unpack8(gw, g);
                    float pv[8];
                    if (PASS > 0) { const u32x4 mw = *(const u32x4*)(rowp + C_MG + c); unpack8(mw, pv); }
                    else {
#pragma unroll
                        for (int i = 0; i < 8; ++i) pv[i] = 0.f; }
                    const f32x4 v0 = acc[ai][bj][m][0], v1 = acc[ai][bj][m][1];
                    float o[8];
#pragma unroll
                    for (int i = 0; i < 4; ++i) { o[i] = pv[i] + sigmoidf_(g[i]) * v0[i]; o[4 + i] = pv[4 + i] + sigmoidf_(g[4 + i]) * v1[i]; }
                    *(u32x4*)(rowp + C_MG + c) = pack8(o); } }
    }
};
struct EpiGatesU8 {
    static constexpr bool PERM = true, AFTER_DRAIN = false, PREFETCH = false, RESCALE = false;
    bf16* P;
    __device__ __forceinline__ void operator()(const f32x4 (&acc)[2][2][4][2], const Unit& u, int wr, int wc, int fr, int fq) const {
        const int row0 = u.pm * BM + wr * 64 + fr, pos0 = u.pn * BM + wc * 64 + 16 * fq;
#pragma unroll
        for (int ai = 0; ai < 2; ++ai)
#pragma unroll
            for (int m = 0; m < 4; ++m) { unsigned char* rowp = (unsigned char*)(P + (size_t)(row0 + ai * HALF + m * 16) * PLD + C_GATE) + pos0; u32x4 w4;
#pragma unroll
                for (int bj = 0; bj < 2; ++bj) { const f32x4 v0 = acc[ai][bj][m][0], v1 = acc[ai][bj][m][1]; unsigned q[8];
#pragma unroll
                    for (int i = 0; i < 4; ++i) { q[i] = (unsigned)fminf(fmaxf(sigmoidf_(v0[i]) * 255.0f + 0.5f, 1.0f), 255.0f); q[4 + i] = (unsigned)fminf(fmaxf(sigmoidf_(v1[i]) * 255.0f + 0.5f, 1.0f), 255.0f); }
                    const unsigned wx = q[0] | (q[1] << 8) | (q[2] << 16) | (q[3] << 24), wy = q[4] | (q[5] << 8) | (q[6] << 16) | (q[7] << 24);
                    if (bj == 0) { w4.x = wx; w4.y = wy; } else { w4.z = wx; w4.w = wy; } }
                *(u32x4*)rowp = w4; }
    }
};
struct EpiMerge {
    static constexpr bool PERM = true, AFTER_DRAIN = false, PREFETCH = false, RESCALE = true;
    bf16* P;
    __device__ __forceinline__ void rescale(f32x4 (&acc)[2][2][4][2], const Unit& u, int wr, int wc, int fr, int fq, int stage) const {
        asm volatile("" : "+v"(fr), "+v"(fq));
        const int row0 = u.pm * BM + wr * 64 + fr, pos0 = u.pn * BM + wc * 64 + 16 * fq;
#pragma unroll
        for (int ai = 0; ai < 2; ++ai) {
#pragma unroll
            for (int m = 0; m < 4; ++m) { const unsigned char* rowp = (const unsigned char*)(P + (size_t)(row0 + ai * HALF + m * 16) * PLD + C_GATE) + 1024 * (stage - 1) + pos0;
                const u32x4 gx4 = *(const u32x4*)rowp, gy4 = *(const u32x4*)(rowp + 1024);
#pragma unroll
                for (int bj = 0; bj < 2; ++bj) { const unsigned gxx = bj ? gx4.z : gx4.x, gxy = bj ? gx4.w : gx4.y, gyx = bj ? gy4.z : gy4.x, gyy = bj ? gy4.w : gy4.y;
#pragma unroll
                    for (int i = 0; i < 4; ++i) { acc[ai][bj][m][0][i] *= (float)((gxx >> (8 * i)) & 255u) * frcp((float)((gyx >> (8 * i)) & 255u));
                        acc[ai][bj][m][1][i] *= (float)((gxy >> (8 * i)) & 255u) * frcp((float)((gyy >> (8 * i)) & 255u)); } } }
            asm volatile("" ::: "memory"); }
    }
    __device__ __forceinline__ void operator()(const f32x4 (&acc)[2][2][4][2], const Unit& u, int wr, int wc, int fr, int fq) const {
        const int row0 = u.pm * BM + wr * 64 + fr, col0 = u.pn * BM + wc * 32 + 8 * fq;
#pragma unroll
        for (int ai = 0; ai < 2; ++ai)
#pragma unroll
            for (int m = 0; m < 4; ++m) { bf16* rowp = P + (size_t)(row0 + ai * HALF + m * 16) * PLD;
                const u32x4 gq4 = *(const u32x4*)((const unsigned char*)(rowp + C_GATE) + 2048 + u.pn * BM + wc * 64 + 16 * fq);
#pragma unroll
                for (int bj = 0; bj < 2; ++bj) { const int c = col0 + bj * HALF; float o[8];
                    const unsigned gqx = bj ? gq4.z : gq4.x, gqy = bj ? gq4.w : gq4.y;
                    const f32x4 v0 = acc[ai][bj][m][0], v1 = acc[ai][bj][m][1];
#pragma unroll
                    for (int i = 0; i < 4; ++i) { o[i] = (float)((gqx >> (8 * i)) & 255u) * (1.0f / 255.0f) * v0[i]; o[4 + i] = (float)((gqy >> (8 * i)) & 255u) * (1.0f / 255.0f) * v1[i]; }
                    *(u32x4*)(rowp + C_MG + c) = pack8(o); } }
    }
};
struct EpiWout {
    static constexpr bool PERM = true, AFTER_DRAIN = false, PREFETCH = false, RESCALE = false;
    const float* x; float* out; bf16* P; float* SSQ; LAS float* xl;
    __device__ __forceinline__ void operator()(const f32x4 (&acc)[2][2][4][2], const Unit& u, int wr, int wc, int fr, int fq) const {
        const int row0 = u.pm * BM + wr * 64 + fr, col0 = u.pn * BM + wc * 32 + 8 * fq;
#pragma unroll
        for (int ai = 0; ai < 2; ++ai)
#pragma unroll
            for (int m = 0; m < 4; ++m) { const int row = row0 + ai * HALF + m * 16; float ss = 0.f;
#pragma unroll
                for (int bj = 0; bj < 2; ++bj) { const int c = col0 + bj * HALF; const size_t off = (size_t)row * DM + c;
                    const f32x4 a0 = *(const f32x4*)(x + off), a1 = *(const f32x4*)(x + off + 4);
                    const f32x4 r0 = a0 + acc[ai][bj][m][0], r1 = a1 + acc[ai][bj][m][1];
                    ss += (r0[0] * r0[0] + r0[1] * r0[1]) + (r0[2] * r0[2] + r0[3] * r0[3]) + (r1[0] * r1[0] + r1[1] * r1[1]) + (r1[2] * r1[2] + r1[3] * r1[3]);
                    u32x4 w; w.x = pk2(r0[0], r0[1]); w.y = pk2(r0[2], r0[3]); w.z = pk2(r1[0], r1[1]); w.w = pk2(r1[2], r1[3]);
                    *(u32x4*)(P + (size_t)row * PLD + C_X1B + c) = w; }
                ss += __shfl_xor(ss, 16); ss += __shfl_xor(ss, 32);
                if (fq == 0) xl[(ai * HALF + wr * 64 + m * 16 + fr) * 4 + wc] = ss; }
        asm volatile("s_waitcnt lgkmcnt(0)" ::: "memory"); __builtin_amdgcn_s_barrier(); asm volatile("" ::: "memory");
        { const int t = (wr * 4 + wc) * 64 + fq * 16 + fr;
          if (t < 256) { const f32x4 p = *(const LAS f32x4*)(xl + t * 4); SSQ[(size_t)(u.pm * BM + t) * 4 + u.pn] = (p[0] + p[1]) + (p[2] + p[3]); } }
        asm volatile("s_waitcnt lgkmcnt(0)" ::: "memory"); __builtin_amdgcn_s_barrier(); asm volatile("" ::: "memory");
    }
};
template <int CTRL> __device__ __forceinline__ float dpp_mov(float old, float src) {
    return __builtin_bit_cast(float, __builtin_amdgcn_update_dpp(__builtin_bit_cast(int, old), __builtin_bit_cast(int, src), CTRL, 0xF, 0xF, false)); }
template <int CTRL> __device__ __forceinline__ float dpp_rot(float src) {
    return __builtin_bit_cast(float, __builtin_amdgcn_mov_dpp(__builtin_bit_cast(int, src), CTRL, 0xF, 0xF, true)); }
struct EpiUp {
    static constexpr bool PERM = true, AFTER_DRAIN = false, PREFETCH = true, RESCALE = false;
    const float* SSQ; const float* cw; const float* cb; bf16* P; float* UE; LAS float* xl; LAS float* xr;
    __device__ __forceinline__ void prefetch(const Unit& u, int buf, int tid) const {
        LAS float* d = xl + buf * 1280;
        if (tid < 256) { const int a = tid >> 5, c4 = (tid & 31) * 4, ch = u.pn * 128 + c4 + (a >= 4 ? DFF : 0), aa = a & 3;
            *(LAS f32x4*)(d + a * 128 + c4) = *(const f32x4*)((aa < 3 ? cw + aa * NUP : cb) + ch); }
        else { const int r = tid - 256; const f32x4 q = *(const f32x4*)(SSQ + (size_t)(u.pm * BM + r) * 4);
            d[1024 + r] = __builtin_amdgcn_rsqf(((q[0] + q[1]) + (q[2] + q[3])) * (1.0f / DM) + EPS); }
    }
    __device__ __forceinline__ void operator()(f32x4 (&acc)[2][2][4][2], const Unit& u, int wr, int wc, int fr, int fq) const {
        const int row0 = u.pm * BM + wr * 64 + fr;
        const LAS float* lw = xl + u.aux * 1280;
#pragma unroll
        for (int ai = 0; ai < 2; ++ai)
#pragma unroll
            for (int m = 0; m < 4; ++m) { const float rs = lw[1024 + ai * HALF + wr * 64 + m * 16 + fr];
#pragma unroll
                for (int bj = 0; bj < 2; ++bj)
#pragma unroll
                    for (int n = 0; n < 2; ++n) acc[ai][bj][m][n] *= rs; }
#pragma unroll
        for (int ai = 0; ai < 2; ++ai)
#pragma unroll
            for (int bj = 0; bj < 2; ++bj)
#pragma unroll
                for (int n = 0; n < 2; ++n) { LAS float* d = xr + ((ai * 2 + wr) * 4 + bj) * 128 + wc * 32 + 8 * fq + 4 * n;
                    if (fr == 0) *(LAS f32x4*)d = acc[ai][bj][0][n];
                    if (fr == 15) *(LAS f32x4*)(d + 256) = acc[ai][bj][3][n]; }
        asm volatile("s_waitcnt lgkmcnt(0)" ::: "memory"); __builtin_amdgcn_s_barrier(); asm volatile("" ::: "memory");
#pragma unroll
        for (int n = 0; n < 2; ++n) {
            const int c4 = wc * 32 + 8 * fq + 4 * n, a0 = u.pn * 128 + c4;
            const f32x4 wg0 = *(const LAS f32x4*)(lw + c4), wg1 = *(const LAS f32x4*)(lw + 128 + c4), wg2 = *(const LAS f32x4*)(lw + 256 + c4), bg = *(const LAS f32x4*)(lw + 384 + c4);
            const f32x4 wv0 = *(const LAS f32x4*)(lw + 512 + c4), wv1 = *(const LAS f32x4*)(lw + 640 + c4), wv2 = *(const LAS f32x4*)(lw + 768 + c4), bv = *(const LAS f32x4*)(lw + 896 + c4);
#pragma unroll
            for (int ai = 0; ai < 2; ++ai) {
                const int grp = ai * 2 + wr, g64 = u.pm * 4 + grp;
                const LAS float* xp = xr + ((grp > 0 ? grp - 1 : 0) * 4) * 128 + 256 + c4; const LAS float* xn = xr + ((grp < 3 ? grp + 1 : 3) * 4) * 128 + c4;
                const f32x4 xpg = *(const LAS f32x4*)xp, xpv = *(const LAS f32x4*)(xp + 128), xng = *(const LAS f32x4*)xn, xnv = *(const LAS f32x4*)(xn + 128);
#pragma unroll
                for (int m = 0; m < 4; ++m) {
                    const f32x4 ugm = acc[ai][0][m][n], uvm = acc[ai][1][m][n], ugp = acc[ai][0][(m + 3) & 3][n], ugn = acc[ai][0][(m + 1) & 3][n], uvp = acc[ai][1][(m + 3) & 3][n], uvn = acc[ai][1][(m + 1) & 3][n];
                    f32x4 pg, ng, pvv, nv;
#pragma unroll
                    for (int i = 0; i < 4; ++i) {
                        pg[i] = dpp_mov<0x111>(m == 0 ? xpg[i] : dpp_rot<0x121>(ugp[i]), ugm[i]);
                        ng[i] = dpp_mov<0x101>(m == 3 ? xng[i] : dpp_rot<0x12F>(ugn[i]), ugm[i]);
                        pvv[i] = dpp_mov<0x111>(m == 0 ? xpv[i] : dpp_rot<0x121>(uvp[i]), uvm[i]);
                        nv[i] = dpp_mov<0x101>(m == 3 ? xnv[i] : dpp_rot<0x12F>(uvn[i]), uvm[i]); }
                    const f32x4 gate = wg0 * pg + wg1 * ugm + wg2 * ng + bg;
                    const f32x4 val = wv0 * pvv + wv1 * uvm + wv2 * nv + bv;
                    const int row = row0 + ai * HALF + m * 16;
                    const bool edge = (m == 0 && fr == 0 && grp == 0) || (m == 3 && fr == 15 && grp == 3);
                    if (!edge) { u32x2 w; w.x = pk2(siluf_(gate[0]) * val[0], siluf_(gate[1]) * val[1]); w.y = pk2(siluf_(gate[2]) * val[2], siluf_(gate[3]) * val[3]);
                        *(u32x2*)(P + (size_t)row * PLD + C_ACT + a0) = w; }
                    if ((m == 0 && fr < 2 && grp == 0) || (m == 3 && fr >= 14 && grp == 3)) { const int slot = (m == 0) ? fr : fr - 12;
                        float* ue = UE + ((size_t)g64 * 4 + slot) * NUP;
                        *(f32x4*)(ue + a0) = ugm; *(f32x4*)(ue + DFF + a0) = uvm; }
                }
            }
        }
    }
};
struct EpiDown {
    static constexpr bool PERM = true, AFTER_DRAIN = false, PREFETCH = false, RESCALE = false;
    float* out; const bf16* P;
    __device__ __forceinline__ void operator()(const f32x4 (&acc)[2][2][4][2], const Unit& u, int wr, int wc, int fr, int fq) const {
        const int row0 = u.pm * BM + wr * 64 + fr, col0 = u.pn * BM + wc * 32 + 8 * fq;
#pragma unroll
        for (int ai = 0; ai < 2; ++ai)
#pragma unroll
            for (int m = 0; m < 4; ++m) { const int row = row0 + ai * HALF + m * 16;
#pragma unroll
                for (int bj = 0; bj < 2; ++bj) { const int c = col0 + bj * HALF; float xr[8]; unpack8(*(const u32x4*)(P + (size_t)row * PLD + C_X1B + c), xr);
                    const f32x4 v0 = acc[ai][bj][m][0], v1 = acc[ai][bj][m][1];
                    __builtin_nontemporal_store((f32x4){xr[0] + v0[0], xr[1] + v0[1], xr[2] + v0[2], xr[3] + v0[3]}, (f32x4*)(out + (size_t)row * DM + c));
                    __builtin_nontemporal_store((f32x4){xr[4] + v1[0], xr[5] + v1[1], xr[6] + v1[2], xr[7] + v1[3]}, (f32x4*)(out + (size_t)row * DM + c + 4)); } }
    }
};

template <int DH, int RSK, int RSV>
__device__ __forceinline__ void attn_tile(const LAS unsigned char* Kl, const LAS unsigned char* Vl, int jk, const bf16x8 (&qf)[DH / 16], f32x16 s0, f32x16 s1,
                                          float& m, float& l, f32x16 (&o)[DH / 32], int lane) {
    const int r32 = lane & 31, hi = lane >> 5;
    const LAS unsigned char* kp = Kl + (size_t)(jk + r32) * RSK + 16 * hi;
#pragma unroll
    for (int ks = 0; ks < DH / 16; ++ks) {
        const bf16x8 k0 = *(const LAS bf16x8*)(kp + 32 * ks), k1 = *(const LAS bf16x8*)(kp + 32 * RSK + 32 * ks);
        s0 = __builtin_amdgcn_mfma_f32_32x32x16_bf16(k0, qf[ks], s0, 0, 0, 0);
        s1 = __builtin_amdgcn_mfma_f32_32x32x16_bf16(k1, qf[ks], s1, 0, 0, 0);
    }
    const int g = lane >> 4, q4 = (lane & 15) >> 2, p = lane & 3;
    const unsigned va = (unsigned)(uintptr_t)Vl + (unsigned)(jk + 4 * hi + q4) * RSV + (16 * (g & 1) + 4 * p) * 2;
    s16x4 vlo[2][4], vhi[2][4];
#define ATT_VREAD(set, db) do { _Pragma("unroll") for (int kk = 0; kk < 4; ++kk) { \
        asm volatile("ds_read_b64_tr_b16 %0, %1 offset:%c2" : "=&v"(vlo[set][kk]) : "v"(va), "i"((16 * kk) * RSV + 64 * (db)) : "memory"); \
        asm volatile("ds_read_b64_tr_b16 %0, %1 offset:%c2" : "=&v"(vhi[set][kk]) : "v"(va), "i"((16 * kk + 8) * RSV + 64 * (db)) : "memory"); } } while (0)
    ATT_VREAD(0, 0);
    float mx = fmaxf(s0[0], s1[0]);
#pragma unroll
    for (int r = 1; r < 16; ++r) mx = fmaxf(mx, fmaxf(s0[r], s1[r]));
    mx = fmaxf(mx, __shfl_xor(mx, 32));
    const float mn = fmaxf(m, mx), f = fexp2(m - mn);
    m = mn; l *= f;
#pragma unroll
    for (int db = 0; db < DH / 32; ++db)
#pragma unroll
        for (int r = 0; r < 16; ++r) o[db][r] *= f;
    float ps = 0.f;
#pragma unroll
    for (int r = 0; r < 16; ++r) { s0[r] = fexp2(s0[r] - mn); s1[r] = fexp2(s1[r] - mn); ps += s0[r] + s1[r]; }
    l += ps;
    bf16x8 pf[4];
    { u32x4 w;
      w.x = pk2(s0[0], s0[1]); w.y = pk2(s0[2], s0[3]); w.z = pk2(s0[4], s0[5]); w.w = pk2(s0[6], s0[7]); pf[0] = __builtin_bit_cast(bf16x8, w);
      w.x = pk2(s0[8], s0[9]); w.y = pk2(s0[10], s0[11]); w.z = pk2(s0[12], s0[13]); w.w = pk2(s0[14], s0[15]); pf[1] = __builtin_bit_cast(bf16x8, w);
      w.x = pk2(s1[0], s1[1]); w.y = pk2(s1[2], s1[3]); w.z = pk2(s1[4], s1[5]); w.w = pk2(s1[6], s1[7]); pf[2] = __builtin_bit_cast(bf16x8, w);
      w.x = pk2(s1[8], s1[9]); w.y = pk2(s1[10], s1[11]); w.z = pk2(s1[12], s1[13]); w.w = pk2(s1[14], s1[15]); pf[3] = __builtin_bit_cast(bf16x8, w); }
#pragma unroll
    for (int db = 0; db < DH / 32; ++db) {
        asm volatile("s_waitcnt lgkmcnt(0)" ::: "memory"); __builtin_amdgcn_sched_barrier(0);
        if (db + 1 < DH / 32) { if ((db & 1) == 0) ATT_VREAD(1, db + 1); else ATT_VREAD(0, db + 1); }
#pragma unroll
        for (int kk = 0; kk < 4; ++kk) { const s16x4 lo = vlo[db & 1][kk], h4 = vhi[db & 1][kk];
            const bf16x8 vf = (bf16x8){lo[0], lo[1], lo[2], lo[3], h4[0], h4[1], h4[2], h4[3]};
            o[db] = __builtin_amdgcn_mfma_f32_32x32x16_bf16(vf, pf[kk], o[db], 0, 0, 0); }
        __builtin_amdgcn_sched_barrier(0);
    }
#undef ATT_VREAD
}
__device__ __forceinline__ void load_bias(const float* biasrow, int hi, f32x16& s0, f32x16& s1) {
#pragma unroll
    for (int g4 = 0; g4 < 4; ++g4) { const f32x4 c0 = *(const f32x4*)(biasrow + 8 * g4 + 4 * hi), c1 = *(const f32x4*)(biasrow + 32 + 8 * g4 + 4 * hi);
#pragma unroll
        for (int i = 0; i < 4; ++i) { s0[4 * g4 + i] = c0[i]; s1[4 * g4 + i] = c1[i]; } }
}
template <int DH>
__device__ __forceinline__ void load_q(const bf16* qrow, const float* gq, float scale, bf16x8 (&qf)[DH / 16], int lane) {
    const int hi = lane >> 5;
    u32x4 w[DH / 16]; float ss = 0.f;
#pragma unroll
    for (int ks = 0; ks < DH / 16; ++ks) { w[ks] = *(const u32x4*)(qrow + 16 * ks + 8 * hi); float v[8]; unpack8(w[ks], v);
#pragma unroll
        for (int j = 0; j < 8; ++j) ss += v[j] * v[j]; }
    ss += __shfl_xor(ss, 32);
    const float rstd = __builtin_amdgcn_rsqf(ss * (1.0f / DH) + EPS) * scale;
#pragma unroll
    for (int ks = 0; ks < DH / 16; ++ks) { float v[8]; unpack8(w[ks], v);
        const f32x4 g0 = *(const f32x4*)(gq + 16 * ks + 8 * hi), g1 = *(const f32x4*)(gq + 16 * ks + 8 * hi + 4);
#pragma unroll
        for (int j = 0; j < 4; ++j) { v[j] *= rstd * g0[j]; v[4 + j] *= rstd * g1[j]; }
        qf[ks] = __builtin_bit_cast(bf16x8, pack8(v)); }
}
template <int DH>
__device__ __forceinline__ void store_o(bf16* yrow, const f32x16 (&o)[DH / 32], float l, int lane) {
    const int hi = lane >> 5;
    const float inv = frcp(l + __shfl_xor(l, 32));
#pragma unroll
    for (int db = 0; db < DH / 32; ++db)
#pragma unroll
        for (int g4 = 0; g4 < 4; ++g4) { u32x2 w; w.x = pk2(o[db][4 * g4] * inv, o[db][4 * g4 + 1] * inv); w.y = pk2(o[db][4 * g4 + 2] * inv, o[db][4 * g4 + 3] * inv);
            *(u32x2*)(yrow + 32 * db + 8 * g4 + 4 * hi) = w; }
}
template <int DH, int RSK, int RSV>
__device__ __forceinline__ void stage_kv(LAS unsigned char* Kl, LAS unsigned char* Vl, int ldsrow0, const bf16* src, size_t pitch, int kcol, int vcol, int nrows, const float* gk, int tid) {
    constexpr int CPR = DH / 8;
    for (int c = tid; c < nrows * CPR; c += 512) {
        const int row = c / CPR, ch = c % CPR;
        const bf16* rp = src + (size_t)row * pitch;
        const u32x4 kw = *(const u32x4*)(rp + kcol + ch * 8), vw = *(const u32x4*)(rp + vcol + ch * 8);
        float v[8]; unpack8(kw, v); float ss = 0.f;
#pragma unroll
        for (int j = 0; j < 8; ++j) ss += v[j] * v[j];
        ss = (CPR == 8) ? group8_sum_dpp(ss) : group16_sum_dpp(ss);
        const float rstd = __builtin_amdgcn_rsqf(ss * (1.0f / DH) + EPS);
        const f32x4 g0 = *(const f32x4*)(gk + ch * 8), g1 = *(const f32x4*)(gk + ch * 8 + 4);
#pragma unroll
        for (int j = 0; j < 4; ++j) { v[j] *= rstd * g0[j]; v[4 + j] *= rstd * g1[j]; }
        *(LAS u32x4*)(Kl + (size_t)(ldsrow0 + row) * RSK + ch * 16) = pack8(v);
        *(LAS u32x4*)(Vl + (size_t)(ldsrow0 + row) * RSV + ch * 16) = vw;
    }
}

constexpr int NWAVES = 8;
constexpr size_t MiB = 1u << 20;
constexpr size_t WS_CTL = 0, CTL_ZERO_BYTES = 128 * 1024;
constexpr size_t WS_WIN = 2 * MiB;
constexpr size_t WS_WBR = 15 * MiB;
constexpr size_t WS_WOUT = 18 * MiB;
constexpr size_t WS_WUP = 20 * MiB;
constexpr size_t WS_WDN = 31 * MiB;
constexpr size_t WS_WKV = 37 * MiB;
constexpr size_t WS_MEMN = 39 * MiB;
constexpr size_t WS_KV = 41 * MiB;
constexpr size_t WS_BT = 43 * MiB;
constexpr size_t WS_BA = 45 * MiB;
constexpr size_t WS_SSQ = 49 * MiB;
constexpr size_t WS_P = 52 * MiB;
constexpr size_t WS_UE = 452 * MiB;
constexpr size_t WS_END = 512 * MiB;
static_assert(WS_P + (size_t)M * PLD * 2 == WS_UE && WS_UE + (size_t)512 * 4 * NUP * 4 <= WS_END, "d_ws map");

constexpr int CW_TMO = 0, CW_CODE = 1;
constexpr int CW_BAR = 4096;
constexpr int CW_FIX = 1152;
constexpr int CW_KVF = 1024;
constexpr int RING_OFF = 0, RING_BYTES = 147456;
constexpr int LDSCTL_OFF = RING_BYTES, MISC_OFF = LDSCTL_OFF + 320;
constexpr int XCH_OFF = MISC_OFF + 256;
constexpr int LDS_BYTES = 163840;
static_assert(XCH_OFF + 2 * 1280 * 4 <= LDS_BYTES && XCH_OFF % 16 == 0, "LDS map");

typedef GAS unsigned gu32;
#define RLX_AGENT __ATOMIC_RELAXED, __HIP_MEMORY_SCOPE_AGENT
#define LDS_WAIT() asm volatile("s_waitcnt lgkmcnt(0)" ::: "memory")
#define VM_WAIT() asm volatile("s_waitcnt vmcnt(0)" ::: "memory")

#define XB_TMO      128
#define XB_XCNT(j)  (256  + 64 * (j))
#define XB_XSUB(j)  (1280 + 64 * (j))
#define XB_XGEN(j)  (2304 + 64 * (j))
#define XB_TOP      3328
#define XB_TOPGEN   3392
#define XCD_BAR_WORDS 3456
#define XB_SPIN_CAP (1u << 22)

__device__ __forceinline__ unsigned xb_ld(unsigned* p)              { return __hip_atomic_load(p, __ATOMIC_RELAXED, __HIP_MEMORY_SCOPE_AGENT); }
__device__ __forceinline__ unsigned xb_add(unsigned* p, unsigned v) { return __hip_atomic_fetch_add(p, v, __ATOMIC_RELAXED, __HIP_MEMORY_SCOPE_AGENT); }
__device__ __forceinline__ unsigned xb_xcc_id() { return (unsigned)__builtin_amdgcn_s_getreg((3 << 11) | 20) & 0xFu; }
#define XB_SPIN(cond, bar) do { unsigned _sp = 0; while (cond) { __builtin_amdgcn_s_sleep(1); \
    if ((++_sp & 255u) == 0u) { if (xb_ld(&(bar)[XB_TMO])) break; if (_sp > XB_SPIN_CAP) { atomicAdd(&(bar)[XB_TMO], 1u); break; } } } } while (0)

struct XcdBarrier { unsigned* bar; unsigned x; volatile LAS unsigned* st; };

__device__ __forceinline__ XcdBarrier xcd_barrier_post(unsigned* bar, volatile LAS unsigned* st) {
    XcdBarrier b; b.bar = bar; b.x = xb_xcc_id(); b.st = st;
    if (threadIdx.x == 0) (void)xb_add(&bar[XB_XCNT(b.x)], 1u);
    return b;
}
__device__ __forceinline__ void xcd_barrier_complete(unsigned* bar, unsigned x, unsigned& nloc, unsigned& nx) {
    const unsigned G = gridDim.x * gridDim.y * gridDim.z;
    unsigned sum, cnt, mine, sp = 0u;
    for (;;) {
        sum = 0u; cnt = 0u; mine = 0u;
#pragma unroll
        for (unsigned j = 0; j < 16; ++j) { const unsigned c = xb_ld(&bar[XB_XCNT(j)]); sum += c; cnt += (c > 0u) ? 1u : 0u; mine = (j == x) ? c : mine; }
        if (sum == G) break;
        __builtin_amdgcn_s_sleep(1);
        if ((++sp & 255u) == 0u) { if (xb_ld(&bar[XB_TMO])) break; if (sp > XB_SPIN_CAP) { atomicAdd(&bar[XB_TMO], 1u); break; } }
    }
    nloc = mine > 0u ? mine : 1u; nx = cnt > 0u ? cnt : 1u;
}
__device__ __forceinline__ void xcd_barrier(const XcdBarrier& b) {
    asm volatile("s_waitcnt vmcnt(0)" ::: "memory");
    __syncthreads();
    if (threadIdx.x == 0) {
        unsigned* bar = b.bar;
        __builtin_amdgcn_s_waitcnt(0);
        unsigned nloc = b.st[0], nx = b.st[1];
        if (nloc == 0u) { xcd_barrier_complete(bar, b.x, nloc, nx); b.st[0] = nloc; b.st[1] = nx; }
        const unsigned old = xb_add(&bar[XB_XSUB(b.x)], 1u);
        const unsigned gen = old / nloc;
        if (old + 1u == (gen + 1u) * nloc) {
            __builtin_amdgcn_fence(__ATOMIC_RELEASE, "agent");
            asm volatile("s_waitcnt vmcnt(0)" ::: "memory");
            const unsigned og = xb_add(&bar[XB_TOP], 1u);
            const unsigned tg = og / nx;
            if (og + 1u == (tg + 1u) * nx) xb_add(&bar[XB_TOPGEN], 1u);
            else XB_SPIN(xb_ld(&bar[XB_TOPGEN]) == tg, bar);
            __builtin_amdgcn_fence(__ATOMIC_ACQUIRE, "agent");
            xb_add(&bar[XB_XGEN(b.x)], 1u);
            asm volatile("s_waitcnt vmcnt(0)" ::: "memory");
        } else {
            XB_SPIN(xb_ld(&bar[XB_XGEN(b.x)]) == gen, bar);
            __builtin_amdgcn_fence(__ATOMIC_ACQUIRE, "agent");
            asm volatile("s_waitcnt vmcnt(0)" ::: "memory");
        }
    }
    __syncthreads();
}

struct Frame {
    LAS unsigned char* lds;
    volatile LAS unsigned* MISC;
    gu32* ctl;
    int tid, lane, wave, vcu, G;
};

__device__ __forceinline__ float wave_sum(float v) {
#pragma unroll
    for (int o = 1; o < 64; o <<= 1) v += __shfl_xor(v, o);
    return v;
}
__device__ __forceinline__ int t5_bucket(int rel) {
    const int n = rel < 0 ? -rel : rel;
    const int mag = n < 8 ? n : n < 12 ? 8 : n < 16 ? 9 : n < 23 ? 10 : n < 32 ? 11 : n < 46 ? 12 : n < 64 ? 13 : n < 91 ? 14 : 15;
    return (rel > 0 ? 16 : 0) + mag;
}

__device__ __forceinline__ void transpose_item(const float* W, int K, int N, int k0, int n0, bf16* WT, int drow0, const float* gk, LAS float* scr, int lane) {
    { f32x4 v[8];
#pragma unroll
      for (int i = 0; i < 8; ++i) v[i] = *(const f32x4*)(W + (size_t)(k0 + 8 * i + (lane >> 3)) * N + n0 + 4 * (lane & 7));
#pragma unroll
      for (int i = 0; i < 8; ++i) { const int kk = 8 * i + (lane >> 3); const float gs = gk ? gk[k0 + kk] : 1.0f; LAS float* d = scr + kk * 33 + 4 * (lane & 7);
          d[0] = v[i][0] * gs; d[1] = v[i][1] * gs; d[2] = v[i][2] * gs; d[3] = v[i][3] * gs; } }
    LDS_WAIT(); asm volatile("" ::: "memory");
    const int c = lane & 7;
#pragma unroll
    for (int j = 0; j < 4; ++j) { const int n = (lane >> 3) + 8 * j; const LAS float* s = scr + (8 * c) * 33 + n;
        u32x4 o; o.x = pk2(s[0 * 33], s[1 * 33]); o.y = pk2(s[2 * 33], s[3 * 33]); o.z = pk2(s[4 * 33], s[5 * 33]); o.w = pk2(s[6 * 33], s[7 * 33]);
        *(GAS u32x4*)(WT + (size_t)(drow0 + n) * K + k0 + 8 * c) = o; }
    LDS_WAIT(); asm volatile("" ::: "memory");
}
__device__ __forceinline__ void rms_row_to_bf16(const float* xrow, const float* g, bf16* orow, int lane) {
    const GAS f32x4* xr = (const GAS f32x4*)xrow + lane;
    const GAS f32x4* gr = (const GAS f32x4*)g + lane;
    f32x4 v[4]; float s = 0.f;
#pragma unroll
    for (int j = 0; j < 4; ++j) { v[j] = xr[64 * j]; s += (v[j].x * v[j].x + v[j].y * v[j].y) + (v[j].z * v[j].z + v[j].w * v[j].w); }
    const float rstd = __builtin_amdgcn_rsqf(wave_sum(s) * (1.f / DM) + EPS);
    GAS unsigned long long* o8 = (GAS unsigned long long*)orow + lane;
#pragma unroll
    for (int j = 0; j < 4; ++j) { const f32x4 gg = gr[64 * j];
        o8[64 * j] = (unsigned long long)pk2(v[j].x * rstd * gg.x, v[j].y * rstd * gg.y) | ((unsigned long long)pk2(v[j].z * rstd * gg.z, v[j].w * rstd * gg.w) << 32); }
}

template <int R> __device__ __forceinline__ void rms_rows_to_bf16(const float* xa, size_t rstride, const float* g, bf16* oa, int lane) {
    const GAS f32x4* gr = (const GAS f32x4*)g + lane;
    f32x4 v[R][4]; float ss[R];
#pragma unroll
    for (int r = 0; r < R; ++r) { const GAS f32x4* xr = (const GAS f32x4*)(xa + (size_t)r * rstride) + lane;
#pragma unroll
        for (int j = 0; j < 4; ++j) v[r][j] = xr[64 * j]; }
#pragma unroll
    for (int r = 0; r < R; ++r) { ss[r] = 0.f;
#pragma unroll
        for (int j = 0; j < 4; ++j) ss[r] += (v[r][j].x * v[r][j].x + v[r][j].y * v[r][j].y) + (v[r][j].z * v[r][j].z + v[r][j].w * v[r][j].w); }
#pragma unroll
    for (int o = 1; o < 64; o <<= 1)
#pragma unroll
        for (int r = 0; r < R; ++r) ss[r] += __shfl_xor(ss[r], o);
#pragma unroll
    for (int r = 0; r < R; ++r) { const float rs = __builtin_amdgcn_rsqf(ss[r] * (1.f / DM) + EPS);
        GAS unsigned long long* o8 = (GAS unsigned long long*)(oa + (size_t)r * rstride) + lane;
#pragma unroll
        for (int j = 0; j < 4; ++j) { const f32x4 gg = gr[64 * j];
            o8[64 * j] = (unsigned long long)pk2(v[r][j].x * rs * gg.x, v[r][j].y * rs * gg.y) | ((unsigned long long)pk2(v[r][j].z * rs * gg.z, v[r][j].w * rs * gg.w) << 32); } }
}

struct Args { const float* in[25]; float* out; unsigned char* ws; int ph_lo, ph_hi, mode, pad; };

constexpr int WI_IN = 16 * 201, WI_KV = 16 * 32, WI_BR = 8 * 32, WI_OUT = 16 * 32, WI_UP = 16 * 176, WI_DN = 44 * 32;
constexpr int WI_EARLY = WI_IN + WI_KV, WI_ALL = WI_EARLY + 3 * WI_BR + WI_OUT + WI_UP + WI_DN;
__device__ __forceinline__ void weight_items(Frame& F, const Args& a, int first, int last, int gwl, int ngwl) {
    unsigned char* ws = a.ws;
    LAS float* scr = (LAS float*)(F.lds + RING_OFF + F.wave * 16384);
    for (int it = first + gwl; it < last; it += ngwl) {
        int r = it;
        if (r < WI_IN) { const int kb = r / 201, nb = r % 201, n0 = nb * 32;
            const int d0 = n0 < 2816 ? n0 : (n0 < 2848 ? 3328 + (n0 - 2816) : (n0 < 3360 ? n0 - 32 : 3584 + (n0 - 3360)));
            transpose_item(a.in[4], 1024, 6432, kb * 64, n0, (bf16*)(ws + WS_WIN), d0, nullptr, scr, F.lane); continue; }
        r -= WI_IN;
        if (r < WI_KV) { const int kb = r / 32, nb = r % 32;
            transpose_item(a.in[13], 1024, 1024, kb * 64, nb * 32, (bf16*)(ws + WS_WKV), nb * 32, nullptr, scr, F.lane); continue; }
        r -= WI_KV;
        if (r < 3 * WI_BR) { const int br = r / WI_BR, q = r % WI_BR, kb = q / 32, nb = q % 32;
            transpose_item(a.in[16 + br], 512, 1024, kb * 64, nb * 32, (bf16*)(ws + WS_WBR) + (size_t)br * 1024 * 512, nb * 32, nullptr, scr, F.lane); continue; }
        r -= 3 * WI_BR;
        if (r < WI_OUT) { const int kb = r / 32, nb = r % 32;
            transpose_item(a.in[19], 1024, 1024, kb * 64, nb * 32, (bf16*)(ws + WS_WOUT), nb * 32, nullptr, scr, F.lane); continue; }
        r -= WI_OUT;
        if (r < WI_UP) { const int kb = r / 176, nb = r % 176, n0 = nb * 32;
            const int isv = n0 >= DFF, nn = isv ? n0 - DFF : n0, d0 = (nn >> 7) * 256 + isv * 128 + (nn & 127);
            transpose_item(a.in[21], 1024, NUP, kb * 64, n0, (bf16*)(ws + WS_WUP), d0, a.in[20], scr, F.lane); continue; }
        r -= WI_UP;
        { const int kb = r / 32, nb = r % 32;
            transpose_item(a.in[24], DFF, 1024, kb * 64, nb * 32, (bf16*)(ws + WS_WDN), nb * 32, nullptr, scr, F.lane); }
    }
}
__device__ __forceinline__ void p0_prologue(Frame& F, const Args& a) {
    unsigned char* ws = a.ws;
    const int gw = F.vcu * NWAVES + F.wave, NGW = F.G * NWAVES;
    weight_items(F, a, 0, WI_EARLY, gw, NGW);
    { u32x4* z = (u32x4*)((bf16*)(ws + WS_WIN) + (size_t)3360 * 1024); const int n16 = 224 * 1024 * 2 / 16;
      for (int i = blockIdx.x * 512 + F.tid; i < n16; i += F.G * 512) z[i] = (u32x4){0u, 0u, 0u, 0u}; }
    bf16* H = (bf16*)a.out;
    if (M % (4 * NGW) != 0) { for (int m = gw; m < M; m += NGW) rms_row_to_bf16(a.in[0] + (size_t)m * DM, a.in[3], H + (size_t)m * DM, F.lane); }
    else for (int m = gw; m < M; m += 4 * NGW) rms_rows_to_bf16<4>(a.in[0] + (size_t)m * DM, (size_t)NGW * DM, a.in[3], H + (size_t)m * DM, F.lane);
    for (int m = gw; m < BATCH * NMEM; m += NGW) rms_row_to_bf16(a.in[1] + (size_t)m * DM, a.in[12], (bf16*)(ws + WS_MEMN) + (size_t)m * DM, F.lane);
    { float* BT = (float*)(ws + WS_BT); const float* tab = a.in[2];
      for (int i = blockIdx.x * 512 + F.tid; i < 8 * 128 * 384; i += F.G * 512) { const int j = i % 384, t = (i / 384) % 128, h = i / (384 * 128);
          const int rel = j - 128 - t; const bool ok = rel >= -128 && rel <= 128;
          BT[i] = ok ? tab[t5_bucket(rel) * 8 + h] * LOG2E : -INFINITY; } }
}

__device__ __forceinline__ void attnA_unit(Frame& F, const Args& a, int b, int n, int kvh) {
    constexpr int RSK = 144, RSV = 128;
    LAS unsigned char* Kl = F.lds; LAS unsigned char* Vl = F.lds + 384 * RSK;
    bf16* P = (bf16*)(a.ws + WS_P);
    const float* BT = (const float*)(a.ws + WS_BT);
    for (int blk = 0; blk < 3; ++blk) { const int pos0 = n * 128 - 128 + blk * 128; if (pos0 < 0 || pos0 >= SEQ) continue;
        stage_kv<64, RSK, RSV>(Kl, Vl, blk * 128, P + (size_t)(b * SEQ + pos0) * PLD, PLD, C_AK + kvh * 64, C_AV + kvh * 64, 128, a.in[6], F.tid); }
    LDS_WAIT(); __syncthreads();
    const int h = kvh * 4 + (F.wave >> 1), r32 = F.lane & 31, hi = F.lane >> 5;
    const float sink = a.in[7][h] * LOG2E;
#pragma unroll 1
    for (int qb = 0; qb < 2; ++qb) {
        const int t0 = (F.wave & 1) * 64 + qb * 32, t = t0 + r32;
        bf16* qrow = P + (size_t)(b * SEQ + n * 128 + t) * PLD + C_AQ + h * 64;
        bf16x8 qf[4]; load_q<64>(qrow, a.in[5], 0.125f * LOG2E, qf, F.lane);
        float m = sink, l = hi == 0 ? 1.f : 0.f; f32x16 o[2];
#pragma unroll
        for (int r = 0; r < 16; ++r) { o[0][r] = 0.f; o[1][r] = 0.f; }
        const int lo = max(t0 >= 64 ? 1 : 0, n == 0 ? 2 : 0), hi_t = min(t0 >= 64 ? 5 : 4, n == SEQ / 128 - 1 ? 3 : 5);
        const float* brow = BT + ((size_t)h * 128 + t) * 384;
        f32x16 b0, b1; load_bias(brow + 64 * lo, hi, b0, b1);
#pragma unroll 1
        for (int kt = lo; kt <= hi_t; ++kt) {
            f32x16 nb0 = b0, nb1 = b1;
            if (kt < hi_t) load_bias(brow + 64 * (kt + 1), hi, nb0, nb1);
            attn_tile<64, RSK, RSV>(Kl, Vl, 64 * kt, qf, b0, b1, m, l, o, F.lane);
            b0 = nb0; b1 = nb1; }
        store_o<64>(qrow, o, l, F.lane);
    }
    LDS_WAIT(); __syncthreads();
}
__device__ __forceinline__ void xattn_unit(Frame& F, const Args& a, int b, int tb, int h) {
    constexpr int RSK = 272, RSV = 320;
    LAS unsigned char* Kl = F.lds; LAS unsigned char* Vl = F.lds + 128 * RSK;
    bf16* P = (bf16*)(a.ws + WS_P);
    const bf16* KV = (const bf16*)(a.ws + WS_KV);
    const int r32 = F.lane & 31;
    bf16* qrow = P + (size_t)(b * SEQ + tb * 256 + F.wave * 32 + r32) * PLD + C_MQ + h * 128;
    bf16x8 qf[8]; load_q<128>(qrow, a.in[14], 0.08838834764831845f * LOG2E, qf, F.lane);
    float m = -1e30f, l = 0.f; f32x16 o[4];
#pragma unroll
    for (int db = 0; db < 4; ++db)
#pragma unroll
        for (int r = 0; r < 16; ++r) o[db][r] = 0.f;
#pragma unroll 1
    for (int half = 0; half < 2; ++half) {
        stage_kv<128, RSK, RSV>(Kl, Vl, 0, KV + (size_t)(b * NMEM + half * 128) * 1024, 1024, h * 128, 512 + h * 128, 128, a.in[15], F.tid);
        LDS_WAIT(); __syncthreads();
#pragma unroll 1
        for (int kt = 0; kt < 2; ++kt) { f32x16 z0, z1;
#pragma unroll
            for (int r = 0; r < 16; ++r) { z0[r] = 0.f; z1[r] = 0.f; }
            attn_tile<128, RSK, RSV>(Kl, Vl, 64 * kt, qf, z0, z1, m, l, o, F.lane); }
        LDS_WAIT(); __syncthreads();
    }
    store_o<128>(qrow, o, l, F.lane);
}


constexpr int SAF = C_GATE, SCF = C_GATE + 512, SBF = C_GATE + 1024, SDF = C_GATE + 1536, SAB = C_GATE + 2048, SCB = C_GATE + 2560;
constexpr int C_OF = C_DQ, C_OB = C_DK;
__device__ __forceinline__ int dn_pcol(int x) { return (x & 32) + 8 * ((x & 15) >> 2) + 4 * ((x >> 4) & 1) + (x & 3); }
__device__ __forceinline__ bf16x8 frag_lo(const LAS unsigned char* p) { const u32x2 a0 = *(const LAS u32x2*)p; u32x4 w; w.x = a0.x; w.y = a0.y; w.z = 0u; w.w = 0u; return __builtin_bit_cast(bf16x8, w); }
__device__ __forceinline__ bf16x8 frag_2(const LAS unsigned char* p) { const u32x2 a0 = *(const LAS u32x2*)p, a1 = *(const LAS u32x2*)(p + 32); u32x4 w; w.x = a0.x; w.y = a0.y; w.z = a1.x; w.w = a1.y; return __builtin_bit_cast(bf16x8, w); }
__device__ __forceinline__ bf16x8 pack_f4z(const f32x4 a) { u32x4 w; w.x = pk2(a[0], a[1]); w.y = pk2(a[2], a[3]); w.z = 0u; w.w = 0u; return __builtin_bit_cast(bf16x8, w); }
__device__ __forceinline__ bf16x8 pack_f4f4(const f32x4 a, const f32x4 b) { u32x4 w; w.x = pk2(a[0], a[1]); w.y = pk2(a[2], a[3]); w.z = pk2(b[0], b[1]); w.w = pk2(b[2], b[3]); return __builtin_bit_cast(bf16x8, w); }
__device__ __forceinline__ void dn_prep_block(Frame& F, const Args& a, int b, int h, int c0, int nch) {
    LAS float* raw = (LAS float*)(F.lds);
    LAS unsigned char* NL = F.lds;
    LAS unsigned char* TD = F.lds + 18432;
    LAS unsigned char* Qb = F.lds + 53248;
    LAS unsigned char* Kb = F.lds + 62464;
    LAS unsigned char* Vb = F.lds + 71680;
    LAS float* sm = (LAS float*)(F.lds + 80896);
    LAS float* gt = sm;
    LAS float* btk = sm + 128;
    LAS float* gct = sm + 256;
    LAS float* cu = sm + 384;
    LAS float* cwp = sm + 512;
    LAS float* egp = sm + 640;
    LAS float* esp = sm + 768;
    LAS unsigned char* QKL = F.lds + 24576;
    LAS unsigned char* KT = F.lds + 84480;
    LAS unsigned char* QT = F.lds + 104960;
    bf16* P = (bf16*)(a.ws + WS_P);
    float* BA = (float*)(a.ws + WS_BA);
    bf16* XB2 = (bf16*)a.out + (size_t)M * 1024;
    const float* cw = a.in[8];
    const int w = F.wave, lane = F.lane, tid = F.tid;
    float wt[3][5];
#pragma unroll
    for (int which = 0; which < 3; ++which)
#pragma unroll
        for (int j = 0; j < 5; ++j) wt[which][j] = cw[j * 1536 + which * 512 + h * 64 + lane];
    const float Ah = expf(a.in[9][(tid >> 6 & 1) * 8 + h]), dtb = a.in[10][(tid >> 6 & 1) * 8 + h];
    u32x4 rr[4]; float pa = 0.f, pb = 0.f;
#define DN_PREFETCH(cidx) do { const int t0p_ = (cidx) * 64; \
        _Pragma("unroll") for (int i_ = 0; i_ < 4; ++i_) { const int e = tid + 512 * i_, row = e / 24, c8 = e % 24, which = c8 >> 3, t = t0p_ - 2 + row; \
            rr[i_] = (u32x4){0u, 0u, 0u, 0u}; \
            if (e < 68 * 24 && t >= 0 && t < SEQ) rr[i_] = *(const u32x4*)(P + ((size_t)b * SEQ + t) * PLD + (which == 0 ? C_DQ : which == 1 ? C_DK : C_DV) + h * 64 + (c8 & 7) * 8); } \
        if (tid < 128) { const size_t tok = (size_t)b * SEQ + t0p_ + (tid & 63); pa = BA[tok * 32 + 16 + (tid >> 6) * 8 + h]; pb = BA[tok * 32 + (tid >> 6) * 8 + h]; } } while (0)
    DN_PREFETCH(c0);
#pragma unroll 1
  for (int ci = 0; ci < nch; ++ci) {
    int tid_o = F.tid; asm volatile("" : "+v"(tid_o));
    const int tid = tid_o, lane = tid & 63;
    const int c = c0 + ci, t0 = c * 64;
    const size_t tok0 = (size_t)b * SEQ + t0;
#pragma unroll
    for (int i_ = 0; i_ < 4; ++i_) { const int e = tid + 512 * i_, row = e / 24, c8 = e % 24;
        if (e < 68 * 24) { float v[8]; unpack8(rr[i_], v);
            *(LAS f32x4*)(raw + row * 192 + c8 * 8) = (f32x4){v[0], v[1], v[2], v[3]}; *(LAS f32x4*)(raw + row * 192 + c8 * 8 + 4) = (f32x4){v[4], v[5], v[6], v[7]}; } }
    if (tid < 128) { const int d = tid >> 6, i = tid & 63; const float xa = pa + dtb;
        gt[d * 64 + i] = -Ah * (fmaxf(xa, 0.f) + __logf(1.0f + __expf(-fabsf(xa))));
        btk[d * 64 + i] = sigmoidf_(pb); }
    if (ci + 1 < nch) DN_PREFETCH(c + 1);
    LDS_WAIT(); __syncthreads();
#pragma unroll
    for (int which = 0; which < 3; ++which) {
        float x[12], y[8];
#pragma unroll
        for (int j = 0; j < 12; ++j) x[j] = raw[(w * 8 + j) * 192 + which * 64 + lane];
#pragma unroll
        for (int r = 0; r < 8; ++r) { float acc = 0.f;
#pragma unroll
            for (int j = 0; j < 5; ++j) acc += x[r + j] * wt[which][j];
            y[r] = siluf_(acc); }
        if (which < 2) {
#pragma unroll
            for (int r = 0; r < 8; ++r) y[r] *= __builtin_amdgcn_rsqf(wave_sum_dpp(y[r] * y[r]) + EPS) * (which == 0 ? 0.125f : 1.0f);
        }
        LAS unsigned char* X = which == 0 ? Qb : which == 1 ? Kb : Vb;
#pragma unroll
        for (int r = 0; r < 8; ++r) *(LAS bf16*)(X + (w * 8 + r) * 144 + lane * 2) = (bf16)(pk2(y[r], 0.f) & 0xffffu);
        asm volatile("" ::: "memory");
    }
    if (w < 2) { const int i = w ? 63 - lane : lane; float gv = gt[w * 64 + i];
        gv = wave_scan_dpp(gv);
        const float glast = __builtin_bit_cast(float, __builtin_amdgcn_readlane(__builtin_bit_cast(int, gv), 63)), bt = btk[w * 64 + i], eg = __expf(gv);
        const float es = __expf(glast - gv);
        gct[w * 64 + i] = gv; cu[w * 64 + lane] = bt; cwp[w * 64 + lane] = bt * eg; egp[w * 64 + lane] = eg; esp[w * 64 + lane] = es;
        BA[(tok0 + lane) * 32 + w * 8 + h] = eg; }
    LDS_WAIT(); __syncthreads();
    { const int wq = w & 3, tm = wq >> 1, tn = wq & 1, r32 = lane & 31, hi = lane >> 5;
      const LAS unsigned char* X = (w < 4) ? Kb : Qb;
      f32x16 acc;
#pragma unroll
      for (int r = 0; r < 16; ++r) acc[r] = 0.f;
#pragma unroll
      for (int kst = 0; kst < 4; ++kst) {
          const bf16x8 af = *(const LAS bf16x8*)(X + (32 * tm + r32) * 144 + (16 * kst + 8 * hi) * 2), bfr = *(const LAS bf16x8*)(Kb + (32 * tn + r32) * 144 + (16 * kst + 8 * hi) * 2);
          acc = __builtin_amdgcn_mfma_f32_32x32x16_bf16(af, bfr, acc, 0, 0, 0); }
      const int j = 32 * tn + r32; const float gjf = gct[j], gjb = gct[64 + j];
#pragma unroll
      for (int g4 = 0; g4 < 4; ++g4) { const int i0 = 32 * tm + 8 * g4 + 4 * hi;
          const f32x4 gif = *(const LAS f32x4*)(gct + i0), gib = *(const LAS f32x4*)(gct + 64 + i0), bif = *(const LAS f32x4*)(btk + i0), bib = *(const LAS f32x4*)(btk + 64 + i0);
#pragma unroll
          for (int q = 0; q < 4; ++q) { const int i = i0 + q; const float v = acc[4 * g4 + q];
              const float ef = __expf(fminf(gif[q] - gjf, 0.f)), eb = __expf(fminf(gib[q] - gjb, 0.f));
              if (w < 4) {
                  const float lf = (j < i) ? -bif[q] * v * ef : 0.f, lb = (j > i) ? -bib[q] * v * eb : 0.f;
                  *(LAS bf16*)(NL + i * 144 + j * 2) = (bf16)(pk2(lf, 0.f) & 0xffffu);
                  *(LAS bf16*)(NL + 9216 + (63 - i) * 144 + (63 - j) * 2) = (bf16)(pk2(lb, 0.f) & 0xffffu);
              } else {
                  const float qf = (j <= i) ? v * ef : 0.f, qb = (j >= i) ? v * eb : 0.f;
                  *(LAS bf16*)(QKL + i * 144 + j * 2) = (bf16)(pk2(qf, 0.f) & 0xffffu);
                  *(LAS bf16*)(QKL + 9216 + (63 - i) * 144 + (63 - j) * 2) = (bf16)(pk2(qb, 0.f) & 0xffffu);
              } } } }
    LDS_WAIT(); __syncthreads();
    if (w < 2) { const int blk = lane >> 4, col = lane & 15; const LAS unsigned char* nl = NL + w * 9216 + (16 * blk) * 144 + (16 * blk) * 2;
        u32x4 lr[16][2];
#pragma unroll
        for (int r = 1; r < 16; ++r) { lr[r][0] = *(const LAS u32x4*)(nl + r * 144); if (r > 8) lr[r][1] = *(const LAS u32x4*)(nl + r * 144 + 16); }
        float t[16];
#pragma unroll
        for (int r = 0; r < 16; ++r) { float a0 = (r == col) ? 1.f : 0.f, a1 = 0.f;
            if (r > 0) { float l[16]; { float l8[8]; unpack8(lr[r][0], l8);
#pragma unroll
                    for (int q = 0; q < 8; ++q) l[q] = l8[q]; }
                if (r > 8) { float l8[8]; unpack8(lr[r][1], l8);
#pragma unroll
                    for (int q = 0; q < 8; ++q) l[8 + q] = l8[q]; }
#pragma unroll
                for (int q = 0; q < r; ++q) { if (q & 1) a1 += l[q] * t[q]; else a0 += l[q] * t[q]; } }
            t[r] = a0 + a1; }
#pragma unroll
        for (int r = 0; r < 16; ++r) *(LAS bf16*)(TD + w * 3072 + blk * 768 + r * 48 + col * 2) = (bf16)(pk2(t[r], 0.f) & 0xffffu);
    } else {
#pragma unroll
      for (int it = 0; it < 3; ++it) { const int e = (tid - 128) + 384 * it, d = e >> 9, p = (e >> 3) & 63, c8 = e & 7;
          if (e < 1024) { const int i = d ? 63 - p : p; const float es = esp[d * 64 + p], eg = egp[d * 64 + p]; float v[8];
              unpack8(*(const LAS u32x4*)(Kb + i * 144 + c8 * 16), v);
#pragma unroll
              for (int j = 0; j < 8; ++j) v[j] *= es;
              *(LAS u32x4*)(KT + d * 10240 + p * 160 + c8 * 16) = pack8(v);
              unpack8(*(const LAS u32x4*)(Qb + i * 144 + c8 * 16), v);
#pragma unroll
              for (int j = 0; j < 8; ++j) v[j] *= eg;
              *(LAS u32x4*)(QT + d * 9216 + p * 144 + c8 * 16) = pack8(v); } }
    }
    LDS_WAIT(); __syncthreads();
    { const int d = w >> 2, cc = lane & 15, g = lane >> 4;
      const LAS unsigned char* nl = NL + d * 9216; const LAS unsigned char* td = TD + d * 3072 + cc * 48 + 8 * g;
#pragma unroll
      for (int jj = 0; jj < 2; ++jj) { const int part = jj, colb = 16 * (w & 3);
          const LAS unsigned char* src = part ? Kb : Vb; const LAS float* coef = (part ? cwp : cu) + d * 64;
          f32x4 R[4];
#pragma unroll
          for (int bq = 0; bq < 4; ++bq) { const f32x4 cf = *(const LAS f32x4*)(coef + 16 * bq + 4 * g);
#pragma unroll
              for (int r = 0; r < 4; ++r) { const int p = 16 * bq + 4 * g + r, i = d ? 63 - p : p;
                  R[bq][r] = cf[r] * __uint_as_float((unsigned)(*(const LAS bf16*)(src + i * 144 + (colb + cc) * 2)) << 16); } }
          const f32x4 z4 = (f32x4){0.f, 0.f, 0.f, 0.f};
          f32x4 X0, X1, X2, X3, Y;
          const bf16x8 t0f = frag_lo(td), t1f = frag_lo(td + 768), t2f = frag_lo(td + 2 * 768), t3f = frag_lo(td + 3 * 768);
          const bf16x8 n1f = frag_lo(nl + (16 + cc) * 144 + 8 * g), n2f = frag_2(nl + (32 + cc) * 144 + 8 * g), n3f = frag_2(nl + (48 + cc) * 144 + 8 * g), n3g = frag_lo(nl + (48 + cc) * 144 + 64 + 8 * g);
          __builtin_amdgcn_sched_barrier(0);
          X0 = __builtin_amdgcn_mfma_f32_16x16x32_bf16(t0f, pack_f4z(R[0]), z4, 0, 0, 0);
          Y = __builtin_amdgcn_mfma_f32_16x16x32_bf16(n1f, pack_f4z(X0), R[1], 0, 0, 0);
          X1 = __builtin_amdgcn_mfma_f32_16x16x32_bf16(t1f, pack_f4z(Y), z4, 0, 0, 0);
          const bf16x8 x01 = pack_f4f4(X0, X1);
          Y = __builtin_amdgcn_mfma_f32_16x16x32_bf16(n2f, x01, R[2], 0, 0, 0);
          X2 = __builtin_amdgcn_mfma_f32_16x16x32_bf16(t2f, pack_f4z(Y), z4, 0, 0, 0);
          Y = __builtin_amdgcn_mfma_f32_16x16x32_bf16(n3f, x01, R[3], 0, 0, 0);
          Y = __builtin_amdgcn_mfma_f32_16x16x32_bf16(n3g, pack_f4z(X2), Y, 0, 0, 0);
          X3 = __builtin_amdgcn_mfma_f32_16x16x32_bf16(t3f, pack_f4z(Y), z4, 0, 0, 0);
          const float sgn = part ? -1.f : 1.f;
          const bf16x8 xb0 = pack_f4f4(X0 * sgn, X1 * sgn), xb1 = pack_f4f4(X2 * sgn, X3 * sgn);
          const int q4 = (lane & 15) >> 2, pp = lane & 3;
          const LAS unsigned char* qkl = QKL + d * 9216; const LAS unsigned char* qtl = QT + d * 9216;
          bf16* pA = (d == 0 || part == 1) ? P + tok0 * PLD + h * 64 + (part ? (d ? SAB : SAF) : SBF) : XB2 + tok0 * 512 + h * 64;
          bf16* pC = (d == 0 || part == 1) ? P + tok0 * PLD + h * 64 + (part ? (d ? SCB : SCF) : SDF) : XB2 + (size_t)M * 512 + tok0 * 512 + h * 64;
          const size_t pit = (d == 0 || part == 1) ? PLD : 512;
          const int pc = dn_pcol(colb + cc);
#pragma unroll
          for (int mt = 0; mt < 4; ++mt) {
              s16x4 klo[2], khi[2]; bf16x8 qkf[2]; f32x4 acc2;
              { const unsigned ka = (unsigned)(uintptr_t)(KT + d * 10240) + (4 * g + q4) * 160u + (16 * mt + 4 * pp) * 2u;
                asm volatile("ds_read_b64_tr_b16 %0, %1" : "=&v"(klo[0]) : "v"(ka) : "memory");
                asm volatile("ds_read_b64_tr_b16 %0, %1 offset:2560" : "=&v"(khi[0]) : "v"(ka) : "memory");
                asm volatile("ds_read_b64_tr_b16 %0, %1 offset:5120" : "=&v"(klo[1]) : "v"(ka) : "memory");
                asm volatile("ds_read_b64_tr_b16 %0, %1 offset:7680" : "=&v"(khi[1]) : "v"(ka) : "memory"); }
#pragma unroll
              for (int ks = 0; ks < 2; ++ks) { if (ks == 1 && mt < 2) continue; qkf[ks] = frag_2(qkl + (16 * mt + cc) * 144 + (32 * ks + 4 * g) * 2); }
#pragma unroll
              for (int r = 0; r < 4; ++r) acc2[r] = part ? __uint_as_float((unsigned)(*(const LAS bf16*)(qtl + (16 * mt + 4 * g + r) * 144 + (colb + cc) * 2)) << 16) : 0.f;
              asm volatile("s_waitcnt lgkmcnt(0)" ::: "memory"); __builtin_amdgcn_sched_barrier(0);
              f32x4 acc = z4;
#pragma unroll
              for (int ks = 0; ks < 2; ++ks) { const bf16x8 kf = (bf16x8){klo[ks][0], klo[ks][1], klo[ks][2], klo[ks][3], khi[ks][0], khi[ks][1], khi[ks][2], khi[ks][3]};
                  acc = __builtin_amdgcn_mfma_f32_16x16x32_bf16(kf, ks ? xb1 : xb0, acc, 0, 0, 0); }
#pragma unroll
              for (int ks = 0; ks < 2; ++ks) { if (ks == 1 && mt < 2) continue; acc2 = __builtin_amdgcn_mfma_f32_16x16x32_bf16(qkf[ks], ks ? xb1 : xb0, acc2, 0, 0, 0); }
              if (part == 0) {
                  u32x2 o; o.x = pk2(acc[0], acc[1]); o.y = pk2(acc[2], acc[3]); *(u32x2*)(pA + (size_t)(colb + cc) * pit + 16 * mt + 4 * g) = o;
                  o.x = pk2(acc2[0], acc2[1]); o.y = pk2(acc2[2], acc2[3]); *(u32x2*)(pC + (size_t)(colb + cc) * pit + 16 * mt + 4 * g) = o; }
              else {
#pragma unroll
                  for (int r = 0; r < 4; ++r) { pA[(size_t)(16 * mt + 4 * g + r) * pit + pc] = (bf16)(pk2(acc[r], 0.f) & 0xffffu); pC[(size_t)(16 * mt + 4 * g + r) * pit + pc] = (bf16)(pk2(acc2[r], 0.f) & 0xffffu); } }
              __builtin_amdgcn_sched_barrier(0);
          }
          asm volatile("" ::: "memory"); __builtin_amdgcn_sched_barrier(0);
      } }
    LDS_WAIT(); __syncthreads();
  }
#undef DN_PREFETCH
}

constexpr int DNX_A = 0, DNX_C = 8192, DNX_BT = 16384, DNX_DT = 24576, DNX_EG = 32768, DNX_SZ = 33792, DNX_OST = 3 * DNX_SZ;
__device__ __forceinline__ void dn_scan_step(const LAS unsigned char* buf, f32x4 (&Sacc)[4], int ws, int lane, LAS unsigned char* ost, int dir) {
    const int c = lane & 15, g = lane >> 4;
    const unsigned trow = 16 * ws + c, t0 = trow * 128u + ((((unsigned)(g >> 1)) ^ ((trow >> 1) & 7u)) << 4) + 8u * (g & 1);
    u32x2 bt[4], dt[4]; bf16x8 af[4][2], cf[4][2];
#pragma unroll
    for (int mt = 0; mt < 4; ++mt) { const unsigned row = 16 * mt + c, a0 = row * 128u + ((((unsigned)g) ^ ((row >> 1) & 7u)) << 4);
        bt[mt] = *(const LAS u32x2*)(buf + DNX_BT + (t0 ^ ((unsigned)mt << 5)));
#pragma unroll
        for (int ks = 0; ks < 2; ++ks) af[mt][ks] = *(const LAS bf16x8*)(buf + DNX_A + (a0 ^ ((unsigned)ks << 6))); }
#pragma unroll
    for (int mt = 0; mt < 4; ++mt) { const unsigned row = 16 * mt + c, a0 = row * 128u + ((((unsigned)g) ^ ((row >> 1) & 7u)) << 4);
        dt[mt] = *(const LAS u32x2*)(buf + DNX_DT + (t0 ^ ((unsigned)mt << 5)));
#pragma unroll
        for (int ks = 0; ks < 2; ++ks) cf[mt][ks] = *(const LAS bf16x8*)(buf + DNX_C + (a0 ^ ((unsigned)ks << 6))); }
    const float gm = ((const LAS float*)(buf + DNX_EG))[63];
    bf16x8 Sb[2];
#pragma unroll
    for (int ks = 0; ks < 2; ++ks) Sb[ks] = pack_f4f4(Sacc[2 * ks], Sacc[2 * ks + 1]);
    __builtin_amdgcn_sched_barrier(0);
#pragma unroll
    for (int mt = 0; mt < 4; ++mt) { f32x4 sn = Sacc[mt] * gm + (f32x4){bf_lo(bt[mt].x), bf_hi(bt[mt].x), bf_lo(bt[mt].y), bf_hi(bt[mt].y)};
#pragma unroll
        for (int ks = 0; ks < 2; ++ks) sn = __builtin_amdgcn_mfma_f32_16x16x32_bf16(af[mt][ks], Sb[ks], sn, 0, 0, 0);
        Sacc[mt] = sn; }
#pragma unroll
    for (int mt = 0; mt < 4; ++mt) { f32x4 oa = (f32x4){bf_lo(dt[mt].x), bf_hi(dt[mt].x), bf_lo(dt[mt].y), bf_hi(dt[mt].y)};
#pragma unroll
        for (int ks = 0; ks < 2; ++ks) oa = __builtin_amdgcn_mfma_f32_16x16x32_bf16(cf[mt][ks], Sb[ks], oa, 0, 0, 0);
#pragma unroll
        for (int r = 0; r < 4; ++r) { const int p = 16 * mt + 4 * g + r, i = dir ? 63 - p : p;
            *(LAS bf16*)(ost + i * 128 + (16 * ws + c) * 2) = (bf16)(pk2(oa[r], 0.f) & 0xffffu); } }
}
__device__ __forceinline__ void dn_scan_unit(Frame& F, const Args& a, int b, int h, int dir) {
    bf16* P = (bf16*)(a.ws + WS_P);
    const int w = F.wave, lane = F.lane;
#define DN_BAR() do { asm volatile("s_waitcnt lgkmcnt(0)" ::: "memory"); __builtin_amdgcn_s_barrier(); asm volatile("" ::: "memory"); } while (0)
    if (w < 4) {
        f32x4 Sacc[4];
#pragma unroll
        for (int mt = 0; mt < 4; ++mt) Sacc[mt] = (f32x4){0.f, 0.f, 0.f, 0.f};
        bf16* Ob = P + (size_t)b * SEQ * PLD + (dir ? C_OB : C_OF) + h * 64;
        DN_BAR();
        int slot = 0;
#pragma unroll 1
        for (int s = 0; s <= 128; ++s) {
            if (s > 0) { const int cp = dir ? 128 - s : s - 1; const LAS unsigned char* st = F.lds + DNX_OST + ((s - 1) & 1) * 8192;
#pragma unroll
                for (int k = 0; k < 2; ++k) { const int idx = F.tid + 256 * k, row = idx >> 3, ch = idx & 7;
                    *(u32x4*)(Ob + ((size_t)cp * 64 + row) * PLD + ch * 8) = *(const LAS u32x4*)(st + row * 128 + ch * 16); } }
            if (s < 128) dn_scan_step(F.lds + slot * DNX_SZ, Sacc, w, lane, F.lds + DNX_OST + (s & 1) * 8192, dir);
            slot = slot == 2 ? 0 : slot + 1;
            DN_BAR();
        }
    } else {
        const int hw = w - 4;
        const bf16* XB2 = (const bf16*)a.out + (size_t)M * 1024;
        const float* BAg = (const float*)(a.ws + WS_BA);
        const char* gp[8]; long gstep[8];
#pragma unroll
        for (int i = 0; i < 8; ++i) { const int pid = hw * 8 + i, blk = pid >> 3, pc = pid & 7, r = 8 * pc + (lane >> 3), cp = lane & 7;
            const int key = (r >> 1) & 7, cs = cp ^ key;
            const size_t tokb = (size_t)b * SEQ;
            if (dir == 1 && blk >= 2) { gp[i] = (const char*)(XB2 + (size_t)(blk - 2) * M * 512 + (tokb + r) * 512 + h * 64 + cs * 8); gstep[i] = 64L * 512 * 2; }
            else { const int col = blk == 0 ? (dir ? SAB : SAF) : blk == 1 ? (dir ? SCB : SCF) : blk == 2 ? SBF : SDF;
                   gp[i] = (const char*)(P + (tokb + r) * PLD + col + h * 64 + cs * 8); gstep[i] = 64L * PLD * 2; } }
        const char* ggc = (const char*)(BAg + ((size_t)b * SEQ + lane) * 32 + dir * 8 + h);
#define DN_ISSUE(n, slot_) do { const int cn_ = dir ? 127 - (n) : (n); LAS unsigned char* sb_ = F.lds + (slot_) * DNX_SZ; \
        _Pragma("unroll") for (int i = 0; i < 8; ++i) { const int pid = hw * 8 + i; \
            __builtin_amdgcn_global_load_lds((const unsigned*)(gp[i] + (long)cn_ * gstep[i]), (LAS unsigned*)(sb_ + (pid >> 3) * 8192 + (pid & 7) * 1024), 16, 0, 0); } \
        __builtin_amdgcn_global_load_lds((const unsigned*)(ggc + (long)cn_ * (64L * 32 * 4)), (LAS unsigned*)(sb_ + DNX_EG + hw * 256), 4, 0, 0); } while (0)
        DN_ISSUE(0, 0); DN_ISSUE(1, 1);
        asm volatile("s_waitcnt vmcnt(9)" ::: "memory");
        DN_BAR();
        int slot2 = 2;
#pragma unroll 1
        for (int s = 0; s <= 128; ++s) {
            if (s + 2 < 128) { DN_ISSUE(s + 2, slot2); asm volatile("s_waitcnt vmcnt(9)" ::: "memory"); }
            else { asm volatile("s_waitcnt vmcnt(0)" ::: "memory"); }
            slot2 = slot2 == 2 ? 0 : slot2 + 1;
            DN_BAR();
        }
#undef DN_ISSUE
    }
#undef DN_BAR
    __syncthreads();
}
__device__ __forceinline__ void dn_combine(Frame& F, const Args& a) {
    bf16* P = (bf16*)(a.ws + WS_P);
    const float* og = a.in[11];
    const int gw = F.vcu * NWAVES + F.wave, NGW = F.G * NWAVES, c0 = F.lane * 8;
    for (int row = gw; row < M; row += NGW) {
        bf16* rp = P + (size_t)row * PLD;
        float of[8], ob[8]; unpack8(*(const u32x4*)(rp + C_OF + c0), of); unpack8(*(const u32x4*)(rp + C_OB + c0), ob);
        float s[8], ss = 0.f;
#pragma unroll
        for (int j = 0; j < 8; ++j) { s[j] = of[j] + ob[j]; ss += s[j] * s[j]; }
        ss = group8_sum_dpp(ss);
        const float rstd = __builtin_amdgcn_rsqf(ss * (1.0f / 64) + EPS);
        bf16* zp = rp + C_DZ + c0; float z[8]; unpack8(*(const u32x4*)zp, z);
        const f32x4 g0 = *(const f32x4*)(og + (c0 & 63)), g1 = *(const f32x4*)(og + (c0 & 63) + 4);
        float y[8];
#pragma unroll
        for (int j = 0; j < 4; ++j) { y[j] = s[j] * rstd * g0[j] * siluf_(z[j]); y[4 + j] = s[4 + j] * rstd * g1[j] * siluf_(z[4 + j]); }
        *(u32x4*)zp = pack8(y);
    }
}
__device__ __forceinline__ void ffn_fixup_panel(Frame& F, const Args& a, int pm, int ch0) {
    bf16* P = (bf16*)(a.ws + WS_P); const float* UE = (const float*)(a.ws + WS_UE);
    const float* cw = a.in[22]; const float* cb = a.in[23];
    constexpr int NQ = DFF / 16;
#pragma unroll 1
    for (int e = F.tid; e < 2 * NQ; e += 512) { const int last = e / NQ, ch = ch0 + (e % NQ) * 4, g = pm * 4 + (last ? 3 : 0);
        const int row = g * 64 + (last ? 63 : 0);
        const bool hp = last ? true : (row % SEQ) != 0, hn = last ? (row % SEQ) != SEQ - 1 : true;
        const float* pu = UE + ((size_t)(last ? g : (g > 0 ? g - 1 : 0)) * 4 + (last ? 2 : 3)) * NUP;
        const float* cu = UE + ((size_t)g * 4 + (last ? 3 : 0)) * NUP;
        const float* nu = UE + ((size_t)(last ? (g < 511 ? g + 1 : 511) : g) * 4 + (last ? 0 : 1)) * NUP;
        f32x4 pg = *(const f32x4*)(pu + ch), pv = *(const f32x4*)(pu + DFF + ch), ng = *(const f32x4*)(nu + ch), nv = *(const f32x4*)(nu + DFF + ch);
        const f32x4 cg = *(const f32x4*)(cu + ch), cv = *(const f32x4*)(cu + DFF + ch);
        const f32x4 w0g = *(const f32x4*)(cw + ch), w1g = *(const f32x4*)(cw + NUP + ch), w2g = *(const f32x4*)(cw + 2 * NUP + ch), bg = *(const f32x4*)(cb + ch);
        const f32x4 w0v = *(const f32x4*)(cw + DFF + ch), w1v = *(const f32x4*)(cw + NUP + DFF + ch), w2v = *(const f32x4*)(cw + 2 * NUP + DFF + ch), bv = *(const f32x4*)(cb + DFF + ch);
        asm volatile("" : "+v"(pg), "+v"(pv), "+v"(ng), "+v"(nv));
        const float mp = hp ? 1.f : 0.f, mn = hn ? 1.f : 0.f;
        const f32x4 gate = w0g * (pg * mp) + w1g * cg + w2g * (ng * mn) + bg;
        const f32x4 val = w0v * (pv * mp) + w1v * cv + w2v * (nv * mn) + bv;
        u32x2 w; w.x = pk2(siluf_(gate[0]) * val[0], siluf_(gate[1]) * val[1]); w.y = pk2(siluf_(gate[2]) * val[2], siluf_(gate[3]) * val[3]);
        *(u32x2*)(P + (size_t)row * PLD + C_ACT + ch) = w; }
}

struct OneUnit { int pm, pn;
    __device__ __forceinline__ bool next(int i, Unit& u) const { if (i != 0) return false; u.pm = pm; u.pn = pn; return true; }
    __device__ __forceinline__ void a_ready(const Unit&) const {}
    __device__ __forceinline__ void done(const Unit&) const {} };
__global__ void __launch_bounds__(NWAVES * 64, 2) fwd_kernel(Args args) {
    extern __shared__ __attribute__((aligned(16))) unsigned char lds[];
    Frame F;
    F.lds = (LAS unsigned char*)lds;
    F.MISC = (volatile LAS unsigned*)(F.lds + MISC_OFF);
    F.tid = threadIdx.x; F.lane = F.tid & 63; F.wave = __builtin_amdgcn_readfirstlane(F.tid >> 6);
    F.G = gridDim.x; { const int bx = blockIdx.x; F.vcu = (F.G % 8 == 0) ? (bx % 8) * (F.G / 8) + bx / 8 : bx; }
    unsigned char* ws = args.ws;
    F.ctl = (gu32*)(ws + WS_CTL);
    for (int u = F.tid; u < (LDS_BYTES - LDSCTL_OFF) / 4; u += NWAVES * 64) ((LAS unsigned*)(F.lds + LDSCTL_OFF))[u] = 0u;
    __syncthreads();
    const int lo = args.ph_lo, hi = args.ph_hi;
    const bool single = (hi - lo) > 1;
    XcdBarrier bar; bar.bar = (unsigned*)(F.ctl + CW_BAR); bar.x = 0; bar.st = nullptr;
    if (single) bar = xcd_barrier_post((unsigned*)(F.ctl + CW_BAR), F.MISC + 8);
#ifndef PH_MASK
#define PH_MASK 0x1FF
#endif
#define IN(k) (((PH_MASK >> (k)) & 1) && lo <= (k) && (k) < hi)
#define SEAM(k) do { if (IN(k) && IN((k) + 1)) xcd_barrier(bar); } while (0)
    bf16* P = (bf16*)(ws + WS_P);
    const int bid = (int)blockIdx.x;
#ifdef DBG_IN
#define TS(k) do { if (bid == DBG_BLK && F.tid == 0) ((unsigned long long*)(ws + WS_CTL + 65536))[k] = __builtin_amdgcn_s_memrealtime(); } while (0)
#else
#define TS(k) do {} while (0)
#endif
#define TSB(k, blk) do {} while (0)
    TS(0);

    if (IN(0)) { p0_prologue(F, args); }
    SEAM(0); TS(1);
    if (IN(1)) {
        { pg8::Gemm g{(const bf16*)args.out, (const bf16*)(ws + WS_WIN), M, 3584, 1024, 1024, 1024}; pg8::StaticOrder S; S.init(M, 3584, F.G, bid);
          EpiInProj E{P, (float*)(ws + WS_BA)};
          pg8::gemm_phase<EpiInProj, pg8::StaticOrder, true, true>(F.lds + RING_OFF, g, S, E); }
    }
    SEAM(1); TS(2);
    if (IN(2)) {
        const bool full = F.G == 256; const int nU = full ? 256 : 4096;
        for (int u = bid; u < nU; u += F.G) { const int uu = full ? u * 16 : u; dn_prep_block(F, args, uu >> 10, (uu >> 7) & 7, uu & 127, full ? 16 : 1); }
    }
    TS(12); SEAM(2); TS(3);
    if (IN(3)) {
        const int ndn = F.G >= 128 ? 64 : 0;
        if (args.mode != 2) for (int u = (ndn ? (bid < ndn ? bid : 64) : bid); u < 64; u += (ndn ? 64 : F.G)) dn_scan_unit(F, args, u >> 4, (u >> 1) & 7, u & 1);
        if (bid >= ndn && args.mode != 1) { const int nb = F.G - ndn, me = bid - ndn;
            { const int pbase = nb >= 80 ? 64 : 0, np = (nb - pbase) < 16 ? (nb - pbase) : 16;
              if (me >= pbase && me < pbase + np) { unsigned done = 0;
                  for (int u = me - pbase; u < 16; u += np) {
                      pg8::Gemm g{(const bf16*)(ws + WS_MEMN), (const bf16*)(ws + WS_WKV), BATCH * NMEM, 1024, 1024, 1024, 1024}; OneUnit S{u >> 2, u & 3};
                      EpiBf16 E{(bf16*)(ws + WS_KV), 1024};
                      pg8::gemm_phase<EpiBf16, OneUnit, true, true>(F.lds + RING_OFF, g, S, E); ++done; }
                  VM_WAIT(); __syncthreads();
                  if (F.tid == 0) { __builtin_amdgcn_fence(__ATOMIC_RELEASE, "agent"); VM_WAIT(); (void)xb_add((unsigned*)(F.ctl + CW_KVF), done); }
              } }
            bool kv_ready = false;
            for (int u = me; u < 1024; u += nb) {
                if (u < 512) attnA_unit(F, args, u >> 7, (u >> 1) & 63, u & 1);
                else { const int v = u - 512;
                    if (!kv_ready) { kv_ready = true;
                        if (F.tid == 0) { unsigned* bw = (unsigned*)(F.ctl + CW_BAR); XB_SPIN(xb_ld((unsigned*)(F.ctl + CW_KVF)) < 16u, bw); __builtin_amdgcn_fence(__ATOMIC_ACQUIRE, "agent"); VM_WAIT(); }
                        __syncthreads(); }
                    xattn_unit(F, args, v >> 7, (v >> 2) & 31, v & 3); }
            }
            weight_items(F, args, WI_EARLY, WI_ALL, me * NWAVES + F.wave, nb * NWAVES);
        }
    }
    TS(10); TSB(11, 64); SEAM(3); TS(4);
    if (IN(4)) {
        dn_combine(F, args);
        pg8::Gemm g{(const bf16*)args.out, (const bf16*)(ws + WS_WIN) + (size_t)3584 * 1024, M, 3072, 1024, 1024, 1024}; pg8::StaticOrder S; S.init(M, 3072, F.G, bid);
        EpiGatesU8 E{P};
        pg8::gemm_phase<EpiGatesU8, pg8::StaticOrder, true, true>(F.lds + RING_OFF, g, S, E);
    }
    SEAM(4); TS(5);
    if (IN(5)) {
        pg8::Gemm g{P + C_AQ, (const bf16*)(ws + WS_WBR), M, 1024, 1536, PLD, 512};
        g.segt = 8; g.aoff1 = (long)(C_DZ - C_AQ) * 2 - 8 * 128; g.aoff2 = (long)(C_MQ - C_AQ) * 2 - 16 * 128;
        g.boff1 = (long)1024 * 512 * 2 - 8 * 128; g.boff2 = (long)2 * 1024 * 512 * 2 - 16 * 128;
        pg8::StaticOrder S; S.init(M, 1024, F.G, bid);
        EpiMerge E{P}; pg8::gemm_phase<EpiMerge, pg8::StaticOrder, true, true>(F.lds + RING_OFF, g, S, E);
    }
    SEAM(5); TS(6);
    if (IN(6)) {
        pg8::Gemm g{P + C_MG, (const bf16*)(ws + WS_WOUT), M, 1024, 1024, PLD, 1024}; pg8::StaticOrder S; S.init(M, 1024, F.G, bid);
        EpiWout E{args.in[0], args.out, P, (float*)(ws + WS_SSQ), (LAS float*)(F.lds + XCH_OFF)};
        pg8::gemm_phase<EpiWout, pg8::StaticOrder, true, true>(F.lds + RING_OFF, g, S, E);
    }
    SEAM(6); TS(7);
    if (IN(7)) {
        pg8::Gemm g{P + C_X1B, (const bf16*)(ws + WS_WUP), M, NUP, 1024, PLD, 1024}; pg8::StaticOrder S; S.init(M, NUP, F.G, bid);
        EpiUp E{(const float*)(ws + WS_SSQ), args.in[22], args.in[23], P, (float*)(ws + WS_UE), (LAS float*)(F.lds + XCH_OFF), (LAS float*)(F.lds + RING_OFF + pg8::STAGE_BYTES)};
        pg8::gemm_phase<EpiUp, pg8::StaticOrder, true, true>(F.lds + RING_OFF, g, S, E);
    }
    SEAM(7); TS(8);
    if (IN(8)) {
        pg8::Gemm g{P + C_ACT, (const bf16*)(ws + WS_WDN), M, 1024, DFF, PLD, DFF}; pg8::StaticOrder S; S.init(M, 1024, F.G, bid);
        TS(20);
        { Unit u; for (int i = 0; S.next(i, u); ++i) ffn_fixup_panel(F, args, u.pm, u.pn * (DFF / 4)); }
        VM_WAIT(); __syncthreads(); TS(22);
        if (F.tid == 0) { unsigned* fx = (unsigned*)(F.ctl + CW_FIX); Unit u;
            __builtin_amdgcn_fence(__ATOMIC_RELEASE, "agent"); VM_WAIT();
            for (int i = 0; S.next(i, u); ++i) (void)xb_add(fx + u.pm, 1u);
            TS(23);
            for (int i = 0; S.next(i, u); ++i) { XB_SPIN(xb_ld(fx + u.pm) < 4u, (unsigned*)(F.ctl + CW_BAR)); }
            __builtin_amdgcn_fence(__ATOMIC_ACQUIRE, "agent"); VM_WAIT(); }
        __syncthreads(); TS(21);
        EpiDown E{args.out, P};
        pg8::gemm_phase<EpiDown, pg8::StaticOrder, true, true>(F.lds + RING_OFF, g, S, E);
    }
    TS(9);
#undef IN
#undef SEAM
}

#ifdef DBG_IN
__global__ void dbg_wait_in_kernel(unsigned char* ws) {
    if (threadIdx.x == 0) { const unsigned long long* tsb = (const unsigned long long*)(ws + WS_CTL + 65536);
        const unsigned long long te = __builtin_amdgcn_s_memrealtime();
        const unsigned long long W = (tsb[DBG_A1] - tsb[DBG_A0]) * (unsigned long long)DBG_GAIN;
        while (__builtin_amdgcn_s_memrealtime() - te < W) __builtin_amdgcn_s_sleep(32); }
}
#endif
#ifdef DBG_TIME
__global__ void dbg_ts_kernel(unsigned char* ws, int k) { if (threadIdx.x == 0) ((unsigned long long*)(ws + WS_CTL + 65536))[k] = __builtin_amdgcn_s_memrealtime(); }
__global__ void dbg_wait_kernel(unsigned char* ws) {
    if (threadIdx.x == 0) { const unsigned long long* tsb = (const unsigned long long*)(ws + WS_CTL + 65536);
        const unsigned long long te = __builtin_amdgcn_s_memrealtime();
        const unsigned long long d1 = tsb[DBG_A1] - tsb[DBG_A0], d2 = tsb[DBG_B1] - tsb[DBG_B0];
        const unsigned long long W = d1 + 100000ull * (d2 / 1000ull);
        while (__builtin_amdgcn_s_memrealtime() - te < W) __builtin_amdgcn_s_sleep(32); }
}
#endif
constexpr int N_PHASES = 9;
#ifndef MK_PER_PHASE
#define MK_PER_PHASE 0
#endif
extern "C" void kernel_launch(void* const* d_in, const int* in_sizes, int n_in, void* d_out, int out_size, void* d_ws, size_t ws_size, hipStream_t stream) {
    static int grid = 0;
    if (grid == 0) {
        if (n_in != 25 || in_sizes[0] != M * DM || out_size != M * DM || ws_size < WS_END) {
            fprintf(stderr, "kernel_launch: unexpected shapes (n_in %d, in0 %d, out %d, ws %zu); nothing launched\n", n_in, n_in > 0 ? in_sizes[0] : -1, out_size, ws_size); grid = -1; return; }
        int dev = 0, cus = 0, per_cu = 0;
        if (hipGetDevice(&dev) != hipSuccess || hipDeviceGetAttribute(&cus, hipDeviceAttributeMultiprocessorCount, dev) != hipSuccess) { grid = -1; return; }
        if (hipFuncSetAttribute((const void*)fwd_kernel, hipFuncAttributeMaxDynamicSharedMemorySize, LDS_BYTES) != hipSuccess) { fprintf(stderr, "kernel_launch: hipFuncSetAttribute failed\n"); grid = -1; return; }
        if (hipOccupancyMaxActiveBlocksPerMultiprocessor(&per_cu, (const void*)fwd_kernel, NWAVES * 64, LDS_BYTES) != hipSuccess || per_cu < 1) { fprintf(stderr, "kernel_launch: occupancy query reports %d\n", per_cu); }
        (void)hipGetLastError();
        grid = cus;
    }
    if (grid < 0) return;
    if (hipMemsetAsync((char*)d_ws + WS_CTL, 0, CTL_ZERO_BYTES, stream) != hipSuccess) return;
    Args a{};
    for (int i = 0; i < 25; ++i) a.in[i] = (const float*)d_in[i];
    a.out = (float*)d_out; a.ws = (unsigned char*)d_ws;
#ifdef DBG_TIME
    for (int p = 0; p < N_PHASES; ++p) { hipLaunchKernelGGL(dbg_ts_kernel, dim3(1), dim3(64), 0, stream, (unsigned char*)d_ws, p);
        a.ph_lo = p; a.ph_hi = p + 1;
        if (p == 3) { a.mode = 1; hipLaunchKernelGGL(fwd_kernel, dim3(grid), dim3(NWAVES * 64), LDS_BYTES, stream, a); hipLaunchKernelGGL(dbg_ts_kernel, dim3(1), dim3(64), 0, stream, (unsigned char*)d_ws, 12); a.mode = 2; }
        hipLaunchKernelGGL(fwd_kernel, dim3(grid), dim3(NWAVES * 64), LDS_BYTES, stream, a); a.mode = 0; }
    hipLaunchKernelGGL(dbg_ts_kernel, dim3(1), dim3(64), 0, stream, (unsigned char*)d_ws, N_PHASES);
    hipLaunchKernelGGL(dbg_wait_kernel, dim3(1), dim3(64), 0, stream, (unsigned char*)d_ws);
    return;
#endif
    if (MK_PER_PHASE) {
        for (int p = 0; p < N_PHASES; ++p) { a.ph_lo = p; a.ph_hi = p + 1; hipLaunchKernelGGL(fwd_kernel, dim3(grid), dim3(NWAVES * 64), LDS_BYTES, stream, a); }
    } else {
        a.ph_lo = 0; a.ph_hi = N_PHASES; hipLaunchKernelGGL(fwd_kernel, dim3(grid), dim3(NWAVES * 64), LDS_BYTES, stream, a);
    }
#ifdef DBG_IN
    hipLaunchKernelGGL(dbg_wait_in_kernel, dim3(1), dim3(64), 0, stream, (unsigned char*)d_ws);
#endif
}
```

```cpp
#include <hip/hip_runtime.h>
#include <cstdio>
#include <cstdint>
#include <cmath>
namespace pg8 {
#define PG8_LAS __attribute__((address_space(3)))
typedef unsigned short bf16_t;
typedef short bf16x8 __attribute__((ext_vector_type(8)));
typedef float f32x4 __attribute__((ext_vector_type(4)));
typedef unsigned u32x4 __attribute__((ext_vector_type(4)));
constexpr int BM = 256, BK = 64, HALF = 128, HTB = HALF * BK * 2  , STAGE_BYTES = 8 * HTB, NXCD = 8, WGM = 8;

__host__ __device__ __forceinline__ int lds_byte(int r, int c) { const int st = (r >> 4) * 2 + (c >> 5), rr = r & 15, cc = c & 31, ob = rr * 64 + cc * 2; return st * 1024 + (ob ^ (((ob >> 9) & 1) << 5)); }
__host__ __device__ __forceinline__ void stage_rc(int b, int& R, int& C) { const int st = b / 1024, sb = b % 1024, swz = sb ^ (((sb >> 9) & 1) << 5); R = (st >> 1) * 16 + swz / 64; C = (st & 1) * 32 + (swz % 64) / 2; }
__host__ __device__ __forceinline__ int perm32(int rho) { const int n = rho >> 4, i = rho & 15; return 8 * (i >> 2) + 4 * n + (i & 3); }

struct Unit { int pm, pn, aux; };
struct Gemm { const bf16_t* A; const bf16_t* Bt; int M, N, K, lda, ldb; int segt = 1 << 30; long aoff1 = 0, aoff2 = 0, boff1 = 0, boff2 = 0; };

struct StaticOrder {
    int nM, nN, nwg, G, c;
    __host__ __device__ __forceinline__ void init(int M, int N, int G_, int c_) { nM = M / BM; nN = N / BM; nwg = nM * nN; G = G_; c = c_; }
    __host__ __device__ __forceinline__ bool next(int i, Unit& u) const {
        const long L = (long)i * G + c; if (L >= nwg) return false;
        int wgid = (int)L; { const int q = nwg / NXCD, r = nwg % NXCD, xcd = wgid % NXCD, off = wgid / NXCD; wgid = (xcd < r ? xcd * (q + 1) : r * (q + 1) + (xcd - r) * q) + off; }
        const int nig = WGM * nN, gid = wgid / nig, fm = gid * WGM, gsz = (nM % WGM == 0) ? WGM : ((nM - fm) < WGM ? (nM - fm) : WGM);
        u.pm = fm + ((wgid % nig) % gsz); u.pn = (wgid % nig) / gsz; return true;
    }
    __device__ __forceinline__ void a_ready(const Unit&) const {}
    __device__ __forceinline__ void done(const Unit&) const {}
};

template <class Epi, class Sched, bool ALIGN_EPI = false, bool SP2 = false>
__device__ __forceinline__ void gemm_phase(PG8_LAS unsigned char* lds, const Gemm g, const Sched& S, const Epi& E) {
    const int tid = threadIdx.x, wid = __builtin_amdgcn_readfirstlane(tid >> 6), lane = tid & 63, wr = wid >> 2, wc = wid & 3, fr = lane & 15, fq = lane >> 4;
    const int K = g.K, nt = K / BK;
    unsigned voffA[2], voffB[2];
#pragma unroll
    for (int i = 0; i < 2; ++i) { int R, C; stage_rc(tid * 16 + i * 8192, R, C); const int Rb = Epi::PERM ? (Epi::WIDE ? ((R >> 5) * 64 + perm32(R & 31)) : ((R & ~31) + perm32(R & 31))) : R;
        voffA[i] = (unsigned)(R * g.lda + C) * 2u; voffB[i] = (unsigned)(Rb * g.ldb + C) * 2u; }
    const size_t kstep = (size_t)(BK * 2);
    const size_t hstepA = (size_t)HALF * g.lda * 2, hstepB = (size_t)(Epi::WIDE ? 32 : HALF) * g.ldb * 2;
    const size_t tstepA = 2 * hstepA, tstepB = (size_t)BM * g.ldb * 2;
    const unsigned ldsw = (unsigned)wid * 1024u;
    const int aoff = lds_byte(wr * 64 + fr, fq * 8), boff = lds_byte(wc * 32 + fr, fq * 8);
#define PG8_SA(b, h) (((b) * 2 + (h)) * HTB)
#define PG8_SB(b, h) ((4 + (b) * 2 + (h)) * HTB)
#define PG8_STAGE(bufoff, gbase, voff) do { _Pragma("unroll") for (int _i = 0; _i < 2; ++_i) \
        __builtin_amdgcn_global_load_lds((const unsigned*)((const char*)(gbase) + (voff)[_i]), (PG8_LAS unsigned*)(lds + (bufoff) + ldsw + _i * 8192), 16, 0, 0); } while (0)
#define PG8_LDA(dst, b, h) do { _Pragma("unroll") for (int m = 0; m < 4; ++m) _Pragma("unroll") for (int k = 0; k < 2; ++k) dst[m][k] = *(const PG8_LAS bf16x8*)(lds + PG8_SA(b, h) + aoff + m * 2048 + k * 1024); } while (0)
#define PG8_LDB(dst, b, h) do { _Pragma("unroll") for (int n = 0; n < 2; ++n) _Pragma("unroll") for (int k = 0; k < 2; ++k) dst[n][k] = *(const PG8_LAS bf16x8*)(lds + PG8_SB(b, h) + boff + n * 2048 + k * 1024); } while (0)
#define PG8_MMA(ai, bj, At, Bt) do { __builtin_amdgcn_s_setprio(1); _Pragma("unroll") for (int m = 0; m < 4; ++m) _Pragma("unroll") for (int n = 0; n < 2; ++n) _Pragma("unroll") for (int k = 0; k < 2; ++k) \
        acc[ai][bj][m][n] = __builtin_amdgcn_mfma_f32_16x16x32_bf16(Bt[n][k], At[m][k], acc[ai][bj][m][n], 0, 0, 0); __builtin_amdgcn_s_setprio(0); } while (0)
#define PG8_WAIT_V(n) asm volatile("s_waitcnt vmcnt(" #n ")" ::: "memory")
#define PG8_WAIT_L(n) asm volatile("s_waitcnt lgkmcnt(" #n ")" ::: "memory")
#define PG8_BAR __builtin_amdgcn_s_barrier()
#define PG8_SCHED __builtin_amdgcn_sched_barrier(0)
    Unit cur, nxt; int ui = 0;
    if (!S.next(0, cur)) return;
    if constexpr (Epi::PREFETCH) E.prefetch(cur, 0, tid);
    f32x4 acc[2][2][4][2];
#pragma unroll
    for (int a = 0; a < 2; ++a)
#pragma unroll
        for (int b = 0; b < 2; ++b)
#pragma unroll
            for (int m = 0; m < 4; ++m)
#pragma unroll
                for (int n = 0; n < 2; ++n) acc[a][b][m][n] = (f32x4){0.f, 0.f, 0.f, 0.f};
    bf16x8 At[4][2], B0[2][2], B1[2][2];
    const char* cA = (const char*)g.A + (size_t)cur.pm * tstepA; const char* cB = (const char*)g.Bt + (size_t)cur.pn * tstepB;
    S.a_ready(cur);
    if constexpr (SP2) {
        PG8_STAGE(PG8_SB(0, 0), cB, voffB); PG8_STAGE(PG8_SB(0, 1), cB + hstepB, voffB); PG8_STAGE(PG8_SA(0, 0), cA, voffA); PG8_STAGE(PG8_SA(0, 1), cA + hstepA, voffA);
        if (wr == 1) PG8_BAR;
        PG8_WAIT_V(2); PG8_BAR;
        PG8_STAGE(PG8_SB(1, 0), cB + kstep, voffB); PG8_STAGE(PG8_SA(1, 0), cA + kstep, voffA); PG8_STAGE(PG8_SB(1, 1), cB + hstepB + kstep, voffB);
        PG8_WAIT_V(6); PG8_BAR;
    } else {
        PG8_STAGE(PG8_SB(0, 0), cB, voffB); PG8_STAGE(PG8_SA(0, 0), cA, voffA); PG8_STAGE(PG8_SB(0, 1), cB + hstepB, voffB); PG8_STAGE(PG8_SA(0, 1), cA + hstepA, voffA);
        if (wr == 1) PG8_BAR;
        PG8_WAIT_V(4); PG8_BAR;
        PG8_STAGE(PG8_SB(1, 0), cB + kstep, voffB); PG8_STAGE(PG8_SA(1, 0), cA + kstep, voffA); PG8_STAGE(PG8_SB(1, 1), cB + hstepB + kstep, voffB);
        PG8_WAIT_V(6); PG8_BAR;
    }
    for (;;) {
        const bool has_next = S.next(ui + 1, nxt);
        const char* nA = has_next ? (const char*)g.A + (size_t)nxt.pm * tstepA : cA; const char* nB = has_next ? (const char*)g.Bt + (size_t)nxt.pn * tstepB : cB;
        for (int t = 0; t < nt; t += 2) {
            const bool last = (t == nt - 2);
            if constexpr (Epi::RESCALE) { if (t == g.segt || t == 2 * g.segt) E.rescale(acc, cur, wr, wc, fr, fq, t / g.segt); }
            const long so1 = (t + 1 >= 2 * g.segt) ? g.aoff2 : ((t + 1 >= g.segt) ? g.aoff1 : 0), so2 = (t + 2 >= 2 * g.segt) ? g.aoff2 : ((t + 2 >= g.segt) ? g.aoff1 : 0), sb2 = (t + 2 >= 2 * g.segt) ? g.boff2 : ((t + 2 >= g.segt) ? g.boff1 : 0);
            const char* a1 = cA + so1 + (size_t)(t + 1) * kstep;
            const char* a2 = last ? nA : cA + so2 + (size_t)(t + 2) * kstep; const char* b2 = last ? nB : cB + sb2 + (size_t)(t + 2) * kstep;
            const char* a3 = a2 + kstep; const char* b3 = b2 + kstep;
            if (last && has_next) S.a_ready(nxt);
            if constexpr (SP2) {
            PG8_LDB(B0, 0, 0); PG8_LDB(B1, 0, 1); PG8_SCHED; PG8_LDA(At, 0, 0); PG8_STAGE(PG8_SA(1, 1), a1 + hstepA, voffA);
            PG8_WAIT_V(8); PG8_WAIT_L(0); PG8_BAR; PG8_MMA(0, 0, At, B0); PG8_MMA(0, 1, At, B1); PG8_BAR; PG8_SCHED;
            PG8_LDA(At, 0, 1); PG8_STAGE(PG8_SB(0, 0), b2, voffB); PG8_STAGE(PG8_SB(0, 1), b2 + hstepB, voffB); PG8_STAGE(PG8_SA(0, 0), a2, voffA);
            PG8_WAIT_V(8); PG8_WAIT_L(0); PG8_BAR; PG8_MMA(1, 0, At, B0); PG8_MMA(1, 1, At, B1); PG8_BAR; PG8_SCHED;
            PG8_LDB(B0, 1, 0); PG8_LDB(B1, 1, 1); PG8_SCHED; PG8_LDA(At, 1, 0); PG8_STAGE(PG8_SA(0, 1), a2 + hstepA, voffA);
            PG8_WAIT_V(8); PG8_WAIT_L(0); PG8_BAR; PG8_MMA(0, 0, At, B0); PG8_MMA(0, 1, At, B1); PG8_BAR; PG8_SCHED;
            PG8_LDA(At, 1, 1); PG8_STAGE(PG8_SB(1, 0), b3, voffB); PG8_STAGE(PG8_SB(1, 1), b3 + hstepB, voffB); PG8_STAGE(PG8_SA(1, 0), a3, voffA);
            PG8_WAIT_V(8); PG8_WAIT_L(0); PG8_BAR; PG8_MMA(1, 0, At, B0); PG8_MMA(1, 1, At, B1); PG8_BAR; PG8_SCHED;
            } else {
            PG8_LDB(B0, 0, 0); PG8_SCHED; PG8_LDA(At, 0, 0); PG8_STAGE(PG8_SA(1, 1), a1 + hstepA, voffA);
            PG8_WAIT_L(8); PG8_BAR; PG8_WAIT_L(0); PG8_MMA(0, 0, At, B0); PG8_BAR; PG8_SCHED;
            PG8_LDB(B1, 0, 1); PG8_STAGE(PG8_SB(0, 0), b2, voffB);
            PG8_BAR; PG8_WAIT_L(0); PG8_MMA(0, 1, At, B1); PG8_BAR;
            PG8_LDA(At, 0, 1); PG8_STAGE(PG8_SA(0, 0), a2, voffA);
            PG8_BAR; PG8_WAIT_L(0); PG8_MMA(1, 0, At, B0); PG8_BAR; PG8_SCHED;
            PG8_STAGE(PG8_SB(0, 1), b2 + hstepB, voffB);
            PG8_WAIT_V(6); PG8_BAR; PG8_MMA(1, 1, At, B1); PG8_BAR;
            PG8_LDB(B0, 1, 0); PG8_SCHED; PG8_LDA(At, 1, 0); PG8_STAGE(PG8_SA(0, 1), a2 + hstepA, voffA);
            PG8_WAIT_L(8); PG8_BAR; PG8_WAIT_L(0); PG8_MMA(0, 0, At, B0); PG8_BAR; PG8_SCHED;
            PG8_LDB(B1, 1, 1); PG8_STAGE(PG8_SB(1, 0), b3, voffB);
            PG8_BAR; PG8_WAIT_L(0); PG8_MMA(0, 1, At, B1); PG8_BAR;
            PG8_LDA(At, 1, 1); PG8_STAGE(PG8_SA(1, 0), a3, voffA);
            PG8_BAR; PG8_WAIT_L(0); PG8_MMA(1, 0, At, B0); PG8_BAR; PG8_SCHED;
            PG8_STAGE(PG8_SB(1, 1), b3 + hstepB, voffB);
            PG8_WAIT_V(6); PG8_BAR; PG8_MMA(1, 1, At, B1); PG8_BAR;
            }
        }
        if constexpr (ALIGN_EPI) { if (wr == 0) PG8_BAR; }
        if constexpr (Epi::PREFETCH) cur.aux = ui & 1;
        if constexpr (!Epi::AFTER_DRAIN) { E(acc, cur, wr, wc, fr, fq); S.done(cur); }
        if constexpr (Epi::PREFETCH) { if (has_next) E.prefetch(nxt, (ui + 1) & 1, tid); }
        if (!has_next) break;
#pragma unroll
        for (int a = 0; a < 2; ++a)
#pragma unroll
            for (int b = 0; b < 2; ++b)
#pragma unroll
                for (int m = 0; m < 4; ++m)
#pragma unroll
                    for (int n = 0; n < 2; ++n) acc[a][b][m][n] = (f32x4){0.f, 0.f, 0.f, 0.f};
        cur = nxt; cA = nA; cB = nB; ++ui;
        if constexpr (ALIGN_EPI) { if (wr == 1) PG8_BAR; }
    }
    PG8_WAIT_V(0);
    if constexpr (!ALIGN_EPI) { if (wr == 0) PG8_BAR; }
    PG8_BAR;
    if constexpr (Epi::AFTER_DRAIN) { E.fused(acc, cur, wr, wc, fr, fq, lds, wid, lane); S.done(cur); }
#undef PG8_SA
#undef PG8_SB
#undef PG8_STAGE
#undef PG8_LDA
#undef PG8_LDB
#undef PG8_MMA
#undef PG8_WAIT_V
#undef PG8_WAIT_L
#undef PG8_BAR
#undef PG8_SCHED
}
}

#define LAS __attribute__((address_space(3)))
#define GAS __attribute__((address_space(1)))
typedef unsigned short bf16;
typedef short bf16x8 __attribute__((ext_vector_type(8)));
typedef short s16x4 __attribute__((ext_vector_type(4)));
typedef float f32x4 __attribute__((ext_vector_type(4)));
typedef float f32x16 __attribute__((ext_vector_type(16)));
typedef unsigned u32x4 __attribute__((ext_vector_type(4)));
typedef unsigned u32x2 __attribute__((ext_vector_type(2)));
typedef float f32x2_t __attribute__((ext_vector_type(2)));
typedef __bf16 bf16x2_t __attribute__((ext_vector_type(2)));

constexpr int BATCH = 4, SEQ = 8192, DM = 1024, M = BATCH * SEQ;
constexpr int NMEM = 256;
constexpr int PLD = 6400;
constexpr int C_AQ = 0, C_AK = 512, C_AV = 640, C_DQ = 768, C_DK = 1280, C_DV = 1792, C_DZ = 2304, C_MQ = 2816, C_GATE = 3328;
constexpr int C_MG = 768, C_X1B = 1792, C_ACT = 2816;
constexpr int NIN = 6656;
constexpr int DFF = 2816, NUP = 5632;
constexpr float EPS = 1e-6f;
constexpr float LOG2E = 1.4426950408889634f;

__device__ __forceinline__ float bf_lo(unsigned w) { return __uint_as_float(w << 16); }
__device__ __forceinline__ float bf_hi(unsigned w) { return __uint_as_float(w & 0xffff0000u); }
__device__ __forceinline__ unsigned pk2(float lo, float hi) { f32x2_t v = {lo, hi}; bf16x2_t b = __builtin_convertvector(v, bf16x2_t); return __builtin_bit_cast(unsigned, b); }
__device__ __forceinline__ float fexp2(float x) { return __builtin_amdgcn_exp2f(x); }
__device__ __forceinline__ float frcp(float x) { return __builtin_amdgcn_rcpf(x); }
__device__ __forceinline__ float sigmoidf_(float x) { return frcp(1.0f + fexp2(-x * LOG2E)); }
__device__ __forceinline__ float siluf_(float x) { return x * sigmoidf_(x); }
__device__ __forceinline__ void unpack8(const u32x4 w, float (&v)[8]) {
    v[0] = bf_lo(w.x); v[1] = bf_hi(w.x); v[2] = bf_lo(w.y); v[3] = bf_hi(w.y); v[4] = bf_lo(w.z); v[5] = bf_hi(w.z); v[6] = bf_lo(w.w); v[7] = bf_hi(w.w); }
__device__ __forceinline__ u32x4 pack8(const float (&v)[8]) { u32x4 w; w.x = pk2(v[0], v[1]); w.y = pk2(v[2], v[3]); w.z = pk2(v[4], v[5]); w.w = pk2(v[6], v[7]); return w; }

template <int CTRL, int ROWMASK> __device__ __forceinline__ float dpp_add(float x) {
    return x + __builtin_bit_cast(float, __builtin_amdgcn_update_dpp(0, __builtin_bit_cast(int, x), CTRL, ROWMASK, 0xF, false)); }
__device__ __forceinline__ float wave_sum_dpp(float x) {
    x = dpp_add<0xB1, 0xF>(x); x = dpp_add<0x4E, 0xF>(x); x = dpp_add<0x141, 0xF>(x); x = dpp_add<0x140, 0xF>(x);
    x = dpp_add<0x142, 0xA>(x); x = dpp_add<0x143, 0xC>(x);
    return __builtin_bit_cast(float, __builtin_amdgcn_readlane(__builtin_bit_cast(int, x), 63)); }
__device__ __forceinline__ float wave_scan_dpp(float x) {
    x = dpp_add<0x111, 0xF>(x); x = dpp_add<0x112, 0xF>(x); x = dpp_add<0x114, 0xF>(x); x = dpp_add<0x118, 0xF>(x);
    x = dpp_add<0x142, 0xA>(x); x = dpp_add<0x143, 0xC>(x);
    return x; }
__device__ __forceinline__ float dpp_xor4(float x) {
    int t = __builtin_amdgcn_update_dpp(0, __builtin_bit_cast(int, x), 0x104, 0xF, 0x5, false);
    t = __builtin_amdgcn_update_dpp(t, __builtin_bit_cast(int, x), 0x114, 0xF, 0xA, false);
    return __builtin_bit_cast(float, t); }
__device__ __forceinline__ float group8_sum_dpp(float x) { x = dpp_add<0xB1, 0xF>(x); x = dpp_add<0x4E, 0xF>(x); return dpp_add<0x141, 0xF>(x); }
__device__ __forceinline__ float group16_sum_dpp(float x) { return dpp_add<0x140, 0xF>(group8_sum_dpp(x)); }
using pg8::Unit;
constexpr int HALF = pg8::HALF, BM = pg8::BM;

struct EpiInProj {
    static constexpr bool PERM = true, WIDE = true, AFTER_DRAIN = false, PREFETCH = false, RESCALE = false;
    bf16* P; float* BA; LAS unsigned char* stg;
    __device__ __forceinline__ void operator()(const f32x4 (&acc)[2][2][4][2], const Unit& u, int wr, int wc, int fr, int fq) const {
        const int row0 = u.pm * BM + wr * 64 + fr;
        if (u.pn < 13) {
            LAS unsigned char* sw = stg + (wr * 4 + wc) * 2048; const int ln = fq * 16 + fr;
            bf16* gp = P + (size_t)(u.pm * BM + wr * 64 + (ln >> 3)) * PLD + u.pn * BM + wc * 64 + (ln & 7) * 8;
#pragma unroll
            for (int ai = 0; ai < 2; ++ai)
#pragma unroll
                for (int m = 0; m < 4; ++m) {
#pragma unroll
                    for (int bj = 0; bj < 2; ++bj) { const f32x4 v0 = acc[ai][bj][m][0], v1 = acc[ai][bj][m][1];
                        u32x4 w; w.x = pk2(v0[0], v0[1]); w.y = pk2(v0[2], v0[3]); w.z = pk2(v1[0], v1[1]); w.w = pk2(v1[2], v1[3]);
                        *(LAS u32x4*)(sw + fr * 128 + bj * 64 + fq * 16) = w; }
#pragma unroll
                    for (int sx = 0; sx < 2; ++sx) { const u32x4 v = *(const LAS u32x4*)(sw + (8 * sx + (ln >> 3)) * 128 + (ln & 7) * 16);
                        __builtin_nontemporal_store(v, (u32x4*)(gp + (size_t)(ai * HALF + m * 16 + 8 * sx) * PLD)); } }
        } else if (wc == 0) {
#pragma unroll
            for (int ai = 0; ai < 2; ++ai)
#pragma unroll
                for (int m = 0; m < 4; ++m) { float* rp = BA + (size_t)(row0 + ai * HALF + m * 16) * 32 + 8 * fq;
                    *(f32x4*)rp = acc[ai][0][m][0]; *(f32x4*)(rp + 4) = acc[ai][0][m][1]; }
        }
    }
};
struct EpiBf16 {
    static constexpr bool PERM = true, WIDE = false, AFTER_DRAIN = false, PREFETCH = false, RESCALE = false;
    bf16* O; int ldc;
    __device__ __forceinline__ void operator()(const f32x4 (&acc)[2][2][4][2], const Unit& u, int wr, int wc, int fr, int fq) const {
        const int row0 = u.pm * BM + wr * 64 + fr, col0 = u.pn * BM + wc * 32 + 8 * fq;
#pragma unroll
        for (int ai = 0; ai < 2; ++ai)
#pragma unroll
            for (int m = 0; m < 4; ++m) { bf16* rowp = O + (size_t)(row0 + ai * HALF + m * 16) * ldc + col0;
#pragma unroll
                for (int bj = 0; bj < 2; ++bj) { const f32x4 v0 = acc[ai][bj][m][0], v1 = acc[ai][bj][m][1];
                    u32x4 w; w.x = pk2(v0[0], v0[1]); w.y = pk2(v0[2], v0[3]); w.z = pk2(v1[0], v1[1]); w.w = pk2(v1[2], v1[3]);
                    *(u32x4*)(rowp + bj * HALF) = w; } }
    }
};
template <int PASS> struct EpiBranch {
    static constexpr bool PERM = true, WIDE = false, AFTER_DRAIN = false, PREFETCH = false, RESCALE = false;
    bf16* P;
    __device__ __forceinline__ void operator()(const f32x4 (&acc)[2][2][4][2], const Unit& u, int wr, int wc, int fr, int fq) const {
        const int row0 = u.pm * BM + wr * 64 + fr, col0 = u.pn * BM + wc * 32 + 8 * fq;
#pragma unroll
        for (int ai = 0; ai < 2; ++ai)
#pragma unroll
            for (int m = 0; m < 4; ++m) { bf16* rowp = P + (size_t)(row0 + ai * HALF + m * 16) * PLD;
#pragma unroll
                for (int bj = 0; bj < 2; ++bj) {
                    const int c = col0 + bj * HALF;
                    const u32x4 gw = *(const u32x4*)(rowp + C_GATE + 1024 * PASS + c);
                    float g[8]; unpack8(gw, g);
                    float pv[8];
                    if (PASS > 0) { const u32x4 mw = *(const u32x4*)(rowp + C_MG + c); unpack8(mw, pv); }
                    else {
#pragma unroll
                        for (int i = 0; i < 8; ++i) pv[i] = 0.f; }
                    const f32x4 v0 = acc[ai][bj][m][0], v1 = acc[ai][bj][m][1];
                    float o[8];
#pragma unroll
                    for (int i = 0; i < 4; ++i) { o[i] = pv[i] + sigmoidf_(g[i]) * v0[i]; o[4 + i] = pv[4 + i] + sigmoidf_(g[4 + i]) * v1[i]; }
                    *(u32x4*)(rowp + C_MG + c) = pack8(o); } }
    }
};
struct EpiGatesU8 {
    static constexpr bool PERM = true, WIDE = false, AFTER_DRAIN = false, PREFETCH = false, RESCALE = false;
    bf16* P;
    __device__ __forceinline__ void operator()(const f32x4 (&acc)[2][2][4][2], const Unit& u, int wr, int wc, int fr, int fq) const {
        const int row0 = u.pm * BM + wr * 64 + fr, pos0 = u.pn * BM + wc * 64 + 16 * fq;
#pragma unroll
        for (int ai = 0; ai < 2; ++ai)
#pragma unroll
            for (int m = 0; m < 4; ++m) { unsigned char* rowp = (unsigned char*)(P + (size_t)(row0 + ai * HALF + m * 16) * PLD + C_GATE) + pos0; u32x4 w4;
#pragma unroll
                for (int bj = 0; bj < 2; ++bj) { const f32x4 v0 = acc[ai][bj][m][0], v1 = acc[ai][bj][m][1]; unsigned q[8];
                    f32x4 t0 = v0 * -LOG2E, t1 = v1 * -LOG2E;
#pragma unroll
                    for (int i = 0; i < 4; ++i) { t0[i] = fexp2(t0[i]); t1[i] = fexp2(t1[i]); }
                    t0 = t0 + 1.0f; t1 = t1 + 1.0f;
#pragma unroll
                    for (int i = 0; i < 4; ++i) { t0[i] = frcp(t0[i]); t1[i] = frcp(t1[i]); }
                    t0 = t0 * 255.0f + 0.5f; t1 = t1 * 255.0f + 0.5f;
#pragma unroll
                    for (int i = 0; i < 4; ++i) { q[i] = (unsigned)fminf(fmaxf(t0[i], 1.0f), 255.0f); q[4 + i] = (unsigned)fminf(fmaxf(t1[i], 1.0f), 255.0f); }
                    const unsigned wx = q[0] | (q[1] << 8) | (q[2] << 16) | (q[3] << 24), wy = q[4] | (q[5] << 8) | (q[6] << 16) | (q[7] << 24);
                    if (bj == 0) { w4.x = wx; w4.y = wy; } else { w4.z = wx; w4.w = wy; } }
                *(u32x4*)rowp = w4; }
    }
};
struct EpiMerge {
    static constexpr bool PERM = true, WIDE = false, AFTER_DRAIN = false, PREFETCH = false, RESCALE = true;
    bf16* P;
    __device__ __forceinline__ void rescale(f32x4 (&acc)[2][2][4][2], const Unit& u, int wr, int wc, int fr, int fq, int stage) const {
        asm volatile("" : "+v"(fr), "+v"(fq));
        const int row0 = u.pm * BM + wr * 64 + fr, pos0 = u.pn * BM + wc * 64 + 16 * fq;
#pragma unroll
        for (int ai = 0; ai < 2; ++ai) {
#pragma unroll
            for (int m = 0; m < 4; ++m) { const unsigned char* rowp = (const unsigned char*)(P + (size_t)(row0 + ai * HALF + m * 16) * PLD + C_GATE) + 1024 * (stage - 1) + pos0;
                const u32x4 gx4 = *(const u32x4*)rowp, gy4 = *(const u32x4*)(rowp + 1024);
#pragma unroll
                for (int bj = 0; bj < 2; ++bj) { const unsigned gxx = bj ? gx4.z : gx4.x, gxy = bj ? gx4.w : gx4.y, gyx = bj ? gy4.z : gy4.x, gyy = bj ? gy4.w : gy4.y;
#pragma unroll
                    for (int i = 0; i < 4; ++i) { acc[ai][bj][m][0][i] *= (float)((gxx >> (8 * i)) & 255u) * frcp((float)((gyx >> (8 * i)) & 255u));
                        acc[ai][bj][m][1][i] *= (float)((gxy >> (8 * i)) & 255u) * frcp((float)((gyy >> (8 * i)) & 255u)); } } }
            asm volatile("" ::: "memory"); }
    }
    __device__ __forceinline__ void operator()(const f32x4 (&acc)[2][2][4][2], const Unit& u, int wr, int wc, int fr, int fq) const {
        const int row0 = u.pm * BM + wr * 64 + fr, col0 = u.pn * BM + wc * 32 + 8 * fq;
#pragma unroll
        for (int ai = 0; ai < 2; ++ai)
#pragma unroll
            for (int m = 0; m < 4; ++m) { bf16* rowp = P + (size_t)(row0 + ai * HALF + m * 16) * PLD;
                const u32x4 gq4 = *(const u32x4*)((const unsigned char*)(rowp + C_GATE) + 2048 + u.pn * BM + wc * 64 + 16 * fq);
#pragma unroll
                for (int bj = 0; bj < 2; ++bj) { const int c = col0 + bj * HALF; float o[8];
                    const unsigned gqx = bj ? gq4.z : gq4.x, gqy = bj ? gq4.w : gq4.y;
                    const f32x4 v0 = acc[ai][bj][m][0], v1 = acc[ai][bj][m][1];
#pragma unroll
                    for (int i = 0; i < 4; ++i) { o[i] = (float)((gqx >> (8 * i)) & 255u) * (1.0f / 255.0f) * v0[i]; o[4 + i] = (float)((gqy >> (8 * i)) & 255u) * (1.0f / 255.0f) * v1[i]; }
                    *(u32x4*)(rowp + C_MG + c) = pack8(o); } }
    }
};
struct EpiWout {
    static constexpr bool PERM = true, WIDE = false, AFTER_DRAIN = false, PREFETCH = false, RESCALE = false;
    const float* x; float* out; bf16* P; float* SSQ; LAS float* xl;
    __device__ __forceinline__ void operator()(const f32x4 (&acc)[2][2][4][2], const Unit& u, int wr, int wc, int fr, int fq) const {
        const int row0 = u.pm * BM + wr * 64 + fr, col0 = u.pn * BM + wc * 32 + 8 * fq;
#pragma unroll
        for (int ai = 0; ai < 2; ++ai)
#pragma unroll
            for (int m = 0; m < 4; ++m) { const int row = row0 + ai * HALF + m * 16; float ss = 0.f;
#pragma unroll
                for (int bj = 0; bj < 2; ++bj) { const int c = col0 + bj * HALF; const size_t off = (size_t)row * DM + c;
                    const f32x4 a0 = *(const f32x4*)(x + off), a1 = *(const f32x4*)(x + off + 4);
                    const f32x4 r0 = a0 + acc[ai][bj][m][0], r1 = a1 + acc[ai][bj][m][1];
                    ss += (r0[0] * r0[0] + r0[1] * r0[1]) + (r0[2] * r0[2] + r0[3] * r0[3]) + (r1[0] * r1[0] + r1[1] * r1[1]) + (r1[2] * r1[2] + r1[3] * r1[3]);
                    u32x4 w; w.x = pk2(r0[0], r0[1]); w.y = pk2(r0[2], r0[3]); w.z = pk2(r1[0], r1[1]); w.w = pk2(r1[2], r1[3]);
                    *(u32x4*)(P + (size_t)row * PLD + C_X1B + c) = w; }
                ss += __shfl_xor(ss, 16); ss += __shfl_xor(ss, 32);
                if (fq == 0) xl[(ai * HALF + wr * 64 + m * 16 + fr) * 4 + wc] = ss; }
        asm volatile("s_waitcnt lgkmcnt(0)" ::: "memory"); __builtin_amdgcn_s_barrier(); asm volatile("" ::: "memory");
        { const int t = (wr * 4 + wc) * 64 + fq * 16 + fr;
          if (t < 256) { const f32x4 p = *(const LAS f32x4*)(xl + t * 4); SSQ[(size_t)(u.pm * BM + t) * 4 + u.pn] = (p[0] + p[1]) + (p[2] + p[3]); } }
        asm volatile("s_waitcnt lgkmcnt(0)" ::: "memory"); __builtin_amdgcn_s_barrier(); asm volatile("" ::: "memory");
    }
};
template <int CTRL> __device__ __forceinline__ float dpp_mov(float old, float src) {
    return __builtin_bit_cast(float, __builtin_amdgcn_update_dpp(__builtin_bit_cast(int, old), __builtin_bit_cast(int, src), CTRL, 0xF, 0xF, false)); }
template <int CTRL> __device__ __forceinline__ float dpp_rot(float src) {
    return __builtin_bit_cast(float, __builtin_amdgcn_mov_dpp(__builtin_bit_cast(int, src), CTRL, 0xF, 0xF, true)); }
struct EpiUp {
    static constexpr bool PERM = true, WIDE = false, AFTER_DRAIN = false, PREFETCH = true, RESCALE = false;
    const float* SSQ; const float* cw; const float* cb; bf16* P; float* UE; LAS float* xl; LAS float* xr;
    __device__ __forceinline__ void prefetch(const Unit& u, int buf, int tid) const {
        LAS float* d = xl + buf * 1280;
        if (tid < 256) { const int a = tid >> 5, c4 = (tid & 31) * 4, ch = u.pn * 128 + c4 + (a >= 4 ? DFF : 0), aa = a & 3;
            *(LAS f32x4*)(d + a * 128 + c4) = *(const f32x4*)((aa < 3 ? cw + aa * NUP : cb) + ch); }
        else { const int r = tid - 256; const f32x4 q = *(const f32x4*)(SSQ + (size_t)(u.pm * BM + r) * 4);
            d[1024 + r] = __builtin_amdgcn_rsqf(((q[0] + q[1]) + (q[2] + q[3])) * (1.0f / DM) + EPS); }
    }
    __device__ __forceinline__ void operator()(f32x4 (&acc)[2][2][4][2], const Unit& u, int wr, int wc, int fr, int fq) const {
        const int row0 = u.pm * BM + wr * 64 + fr;
        const LAS float* lw = xl + u.aux * 1280;
#pragma unroll
        for (int ai = 0; ai < 2; ++ai)
#pragma unroll
            for (int m = 0; m < 4; ++m) { const float rs = lw[1024 + ai * HALF + wr * 64 + m * 16 + fr];
#pragma unroll
                for (int bj = 0; bj < 2; ++bj)
#pragma unroll
                    for (int n = 0; n < 2; ++n) acc[ai][bj][m][n] *= rs; }
#pragma unroll
        for (int ai = 0; ai < 2; ++ai)
#pragma unroll
            for (int bj = 0; bj < 2; ++bj)
#pragma unroll
                for (int n = 0; n < 2; ++n) { LAS float* d = xr + ((ai * 2 + wr) * 4 + bj) * 128 + wc * 32 + 8 * fq + 4 * n;
                    if (fr == 0) *(LAS f32x4*)d = acc[ai][bj][0][n];
                    if (fr == 15) *(LAS f32x4*)(d + 256) = acc[ai][bj][3][n]; }
        asm volatile("s_waitcnt lgkmcnt(0)" ::: "memory"); __builtin_amdgcn_s_barrier(); asm volatile("" ::: "memory");
#pragma unroll
        for (int n = 0; n < 2; ++n) {
            const int c4 = wc * 32 + 8 * fq + 4 * n, a0 = u.pn * 128 + c4;
            const f32x4 wg0 = *(const LAS f32x4*)(lw + c4), wg1 = *(const LAS f32x4*)(lw + 128 + c4), wg2 = *(const LAS f32x4*)(lw + 256 + c4), bg = *(const LAS f32x4*)(lw + 384 + c4);
            const f32x4 wv0 = *(const LAS f32x4*)(lw + 512 + c4), wv1 = *(const LAS f32x4*)(lw + 640 + c4), wv2 = *(const LAS f32x4*)(lw + 768 + c4), bv = *(const LAS f32x4*)(lw + 896 + c4);
#pragma unroll
            for (int ai = 0; ai < 2; ++ai) {
                const int grp = ai * 2 + wr, g64 = u.pm * 4 + grp;
                const LAS float* xp = xr + ((grp > 0 ? grp - 1 : 0) * 4) * 128 + 256 + c4; const LAS float* xn = xr + ((grp < 3 ? grp + 1 : 3) * 4) * 128 + c4;
                const f32x4 xpg = *(const LAS f32x4*)xp, xpv = *(const LAS f32x4*)(xp + 128), xng = *(const LAS f32x4*)xn, xnv = *(const LAS f32x4*)(xn + 128);
#pragma unroll
                for (int m = 0; m < 4; ++m) {
                    const f32x4 ugm = acc[ai][0][m][n], uvm = acc[ai][1][m][n], ugp = acc[ai][0][(m + 3) & 3][n], ugn = acc[ai][0][(m + 1) & 3][n], uvp = acc[ai][1][(m + 3) & 3][n], uvn = acc[ai][1][(m + 1) & 3][n];
                    f32x4 pg, ng, pvv, nv;
#pragma unroll
                    for (int i = 0; i < 4; ++i) {
                        pg[i] = dpp_mov<0x111>(m == 0 ? xpg[i] : dpp_rot<0x121>(ugp[i]), ugm[i]);
                        ng[i] = dpp_mov<0x101>(m == 3 ? xng[i] : dpp_rot<0x12F>(ugn[i]), ugm[i]);
                        pvv[i] = dpp_mov<0x111>(m == 0 ? xpv[i] : dpp_rot<0x121>(uvp[i]), uvm[i]);
                        nv[i] = dpp_mov<0x101>(m == 3 ? xnv[i] : dpp_rot<0x12F>(uvn[i]), uvm[i]); }
                    const f32x4 gate = wg0 * pg + wg1 * ugm + wg2 * ng + bg;
                    const f32x4 val = wv0 * pvv + wv1 * uvm + wv2 * nv + bv;
                    const int row = row0 + ai * HALF + m * 16;
                    const bool edge = (m == 0 && fr == 0 && grp == 0) || (m == 3 && fr == 15 && grp == 3);
                    if (!edge) { u32x2 w; w.x = pk2(siluf_(gate[0]) * val[0], siluf_(gate[1]) * val[1]); w.y = pk2(siluf_(gate[2]) * val[2], siluf_(gate[3]) * val[3]);
                        *(u32x2*)(P + (size_t)row * PLD + C_ACT + a0) = w; }
                    if ((m == 0 && fr < 2 && grp == 0) || (m == 3 && fr >= 14 && grp == 3)) { const int slot = (m == 0) ? fr : fr - 12;
                        float* ue = UE + ((size_t)g64 * 4 + slot) * NUP;
                        *(f32x4*)(ue + a0) = ugm; *(f32x4*)(ue + DFF + a0) = uvm; }
                }
            }
        }
    }
};
struct EpiDown {
    static constexpr bool PERM = true, WIDE = false, AFTER_DRAIN = false, PREFETCH = false, RESCALE = false;
    float* out; const bf16* P;
    __device__ __forceinline__ void operator()(const f32x4 (&acc)[2][2][4][2], const Unit& u, int wr, int wc, int fr, int fq) const {
        const int row0 = u.pm * BM + wr * 64 + fr, col0 = u.pn * BM + wc * 32 + 8 * fq;
#pragma unroll
        for (int ai = 0; ai < 2; ++ai)
#pragma unroll
            for (int m = 0; m < 4; ++m) { const int row = row0 + ai * HALF + m * 16;
#pragma unroll
                for (int bj = 0; bj < 2; ++bj) { const int c = col0 + bj * HALF; float xr[8]; unpack8(*(const u32x4*)(P + (size_t)row * PLD + C_X1B + c), xr);
                    const f32x4 v0 = acc[ai][bj][m][0], v1 = acc[ai][bj][m][1];
                    __builtin_nontemporal_store((f32x4){xr[0] + v0[0], xr[1] + v0[1], xr[2] + v0[2], xr[3] + v0[3]}, (f32x4*)(out + (size_t)row * DM + c));
                    __builtin_nontemporal_store((f32x4){xr[4] + v1[0], xr[5] + v1[1], xr[6] + v1[2], xr[7] + v1[3]}, (f32x4*)(out + (size_t)row * DM + c + 4)); } }
    }
};

template <int DH, int RSK, int RSV, bool FIXED = false>
__device__ __forceinline__ void attn_tile(const LAS unsigned char* Kl, const LAS unsigned char* Vl, int jk, const bf16x8 (&qf)[DH / 16], f32x16 s0, f32x16 s1,
                                          float& m, float& l, f32x16 (&o)[DH / 32], int lane) {
    const int r32 = lane & 31, hi = lane >> 5;
    const LAS unsigned char* kp = Kl + (size_t)(jk + r32) * RSK + 16 * hi;
#pragma unroll
    for (int ks = 0; ks < DH / 16; ++ks) {
        const bf16x8 k0 = *(const LAS bf16x8*)(kp + 32 * ks), k1 = *(const LAS bf16x8*)(kp + 32 * RSK + 32 * ks);
        s0 = __builtin_amdgcn_mfma_f32_32x32x16_bf16(k0, qf[ks], s0, 0, 0, 0);
        s1 = __builtin_amdgcn_mfma_f32_32x32x16_bf16(k1, qf[ks], s1, 0, 0, 0);
    }
    const int g = lane >> 4, q4 = (lane & 15) >> 2, p = lane & 3;
    const unsigned va = (unsigned)(uintptr_t)Vl + (unsigned)(jk + 4 * hi + q4) * RSV + (16 * (g & 1) + 4 * p) * 2;
    s16x4 vlo[2][4], vhi[2][4];
#define ATT_VREAD(set, db) do { _Pragma("unroll") for (int kk = 0; kk < 4; ++kk) { \
        asm volatile("ds_read_b64_tr_b16 %0, %1 offset:%c2" : "=&v"(vlo[set][kk]) : "v"(va), "i"((16 * kk) * RSV + 64 * (db)) : "memory"); \
        asm volatile("ds_read_b64_tr_b16 %0, %1 offset:%c2" : "=&v"(vhi[set][kk]) : "v"(va), "i"((16 * kk + 8) * RSV + 64 * (db)) : "memory"); } } while (0)
    ATT_VREAD(0, 0);
    float ps = 0.f;
    if constexpr (FIXED) {
#pragma unroll
        for (int r = 0; r < 16; ++r) { s0[r] = fexp2(s0[r]); s1[r] = fexp2(s1[r]); ps += s0[r] + s1[r]; }
    } else {
        float mx = fmaxf(s0[0], s1[0]);
#pragma unroll
        for (int r = 1; r < 16; ++r) mx = fmaxf(mx, fmaxf(s0[r], s1[r]));
        mx = fmaxf(mx, __shfl_xor(mx, 32));
        const float mn = fmaxf(m, mx), f = fexp2(m - mn);
        m = mn; l *= f;
#pragma unroll
        for (int db = 0; db < DH / 32; ++db)
#pragma unroll
            for (int r = 0; r < 16; ++r) o[db][r] *= f;
#pragma unroll
        for (int r = 0; r < 16; ++r) { s0[r] = fexp2(s0[r] - mn); s1[r] = fexp2(s1[r] - mn); ps += s0[r] + s1[r]; }
    }
    l += ps;
    bf16x8 pf[4];
    { u32x4 w;
      w.x = pk2(s0[0], s0[1]); w.y = pk2(s0[2], s0[3]); w.z = pk2(s0[4], s0[5]); w.w = pk2(s0[6], s0[7]); pf[0] = __builtin_bit_cast(bf16x8, w);
      w.x = pk2(s0[8], s0[9]); w.y = pk2(s0[10], s0[11]); w.z = pk2(s0[12], s0[13]); w.w = pk2(s0[14], s0[15]); pf[1] = __builtin_bit_cast(bf16x8, w);
      w.x = pk2(s1[0], s1[1]); w.y = pk2(s1[2], s1[3]); w.z = pk2(s1[4], s1[5]); w.w = pk2(s1[6], s1[7]); pf[2] = __builtin_bit_cast(bf16x8, w);
      w.x = pk2(s1[8], s1[9]); w.y = pk2(s1[10], s1[11]); w.z = pk2(s1[12], s1[13]); w.w = pk2(s1[14], s1[15]); pf[3] = __builtin_bit_cast(bf16x8, w); }
#pragma unroll
    for (int db = 0; db < DH / 32; ++db) {
        asm volatile("s_waitcnt lgkmcnt(0)" ::: "memory"); __builtin_amdgcn_sched_barrier(0);
        if (db + 1 < DH / 32) { if ((db & 1) == 0) ATT_VREAD(1, db + 1); else ATT_VREAD(0, db + 1); }
#pragma unroll
        for (int kk = 0; kk < 4; ++kk) { const s16x4 lo = vlo[db & 1][kk], h4 = vhi[db & 1][kk];
            const bf16x8 vf = (bf16x8){lo[0], lo[1], lo[2], lo[3], h4[0], h4[1], h4[2], h4[3]};
            o[db] = __builtin_amdgcn_mfma_f32_32x32x16_bf16(vf, pf[kk], o[db], 0, 0, 0); }
        __builtin_amdgcn_sched_barrier(0);
    }
#undef ATT_VREAD
}
__device__ __forceinline__ void load_bias(const float* tilep, f32x16& s0, f32x16& s1) {
#pragma unroll
    for (int g4 = 0; g4 < 4; ++g4) { const f32x4 c0 = *(const f32x4*)(tilep + (2 * g4) * 256), c1 = *(const f32x4*)(tilep + (2 * g4 + 1) * 256);
#pragma unroll
        for (int i = 0; i < 4; ++i) { s0[4 * g4 + i] = c0[i]; s1[4 * g4 + i] = c1[i]; } }
}
template <int DH>
__device__ __forceinline__ void load_q_raw(const bf16* qrow, u32x4 (&w)[DH / 16], int lane) {
    const int hi = lane >> 5;
#pragma unroll
    for (int ks = 0; ks < DH / 16; ++ks) w[ks] = *(const u32x4*)(qrow + 16 * ks + 8 * hi);
}
template <int DH>
__device__ __forceinline__ void finish_q(const u32x4 (&w)[DH / 16], float scale, bf16x8 (&qf)[DH / 16], int lane) {
    float ss = 0.f;
#pragma unroll
    for (int ks = 0; ks < DH / 16; ++ks) { float v[8]; unpack8(w[ks], v);
#pragma unroll
        for (int j = 0; j < 8; ++j) ss += v[j] * v[j]; }
    ss += __shfl_xor(ss, 32);
    const float rstd = __builtin_amdgcn_rsqf(ss * (1.0f / DH) + EPS) * scale;
#pragma unroll
    for (int ks = 0; ks < DH / 16; ++ks) { float v[8]; unpack8(w[ks], v);
#pragma unroll
        for (int j = 0; j < 8; ++j) v[j] *= rstd;
        qf[ks] = __builtin_bit_cast(bf16x8, pack8(v)); }
}
template <int DH>
__device__ __forceinline__ void store_o(bf16* yrow, const f32x16 (&o)[DH / 32], float l, int lane) {
    const int hi = lane >> 5;
    const float inv = frcp(l + __shfl_xor(l, 32));
#pragma unroll
    for (int db = 0; db < DH / 32; ++db)
#pragma unroll
        for (int g4 = 0; g4 < 4; ++g4) { u32x2 w; w.x = pk2(o[db][4 * g4] * inv, o[db][4 * g4 + 1] * inv); w.y = pk2(o[db][4 * g4 + 2] * inv, o[db][4 * g4 + 3] * inv);
            *(u32x2*)(yrow + 32 * db + 8 * g4 + 4 * hi) = w; }
}
template <int DH, int RSK, int RSV, int NIT>
__device__ __forceinline__ void stage_kv(LAS unsigned char* Kl, LAS unsigned char* Vl, const bf16* src, size_t pitch, int kcol, int vcol, int rlo, int rhi, const float* gk, const float* gq, int tid) {
    constexpr int CPR = DH / 8;
    static_assert(512 % CPR == 0, "a thread's items share one 8-column chunk");
    u32x4 kw[NIT], vw[NIT];
    const f32x4 g0 = *(const f32x4*)(gk + (tid % CPR) * 8) * *(const f32x4*)(gq + (tid % CPR) * 8), g1 = *(const f32x4*)(gk + (tid % CPR) * 8 + 4) * *(const f32x4*)(gq + (tid % CPR) * 8 + 4);
#pragma unroll
    for (int i = 0; i < NIT; ++i) { const int c = tid + 512 * i, row = c / CPR, ch = c % CPR; kw[i] = (u32x4){0u, 0u, 0u, 0u}; vw[i] = kw[i];
        if (row >= rlo && row < rhi) { const bf16* rp = src + (ptrdiff_t)row * (ptrdiff_t)pitch; kw[i] = *(const u32x4*)(rp + kcol + ch * 8); vw[i] = *(const u32x4*)(rp + vcol + ch * 8); } }
#pragma unroll
    for (int i = 0; i < NIT; ++i) { const int c = tid + 512 * i, row = c / CPR, ch = c % CPR;
        float v[8]; unpack8(kw[i], v); float ss = 0.f;
#pragma unroll
        for (int j = 0; j < 8; ++j) ss += v[j] * v[j];
        ss = (CPR == 8) ? group8_sum_dpp(ss) : group16_sum_dpp(ss);
        const float rstd = __builtin_amdgcn_rsqf(ss * (1.0f / DH) + EPS);
#pragma unroll
        for (int j = 0; j < 4; ++j) { v[j] *= rstd * g0[j]; v[4 + j] *= rstd * g1[j]; }
        if (row >= rlo && row < rhi) { *(LAS u32x4*)(Kl + (size_t)row * RSK + ch * 16) = pack8(v); *(LAS u32x4*)(Vl + (size_t)row * RSV + ch * 16) = vw[i]; }
    }
}

constexpr int NWAVES = 8;
constexpr size_t MiB = 1u << 20;
constexpr size_t WS_CTL = 0, CTL_ZERO_BYTES = 128 * 1024;
constexpr size_t WS_WIN = 2 * MiB;
constexpr size_t WS_WBR = 15 * MiB;
constexpr size_t WS_WOUT = 18 * MiB;
constexpr size_t WS_WUP = 20 * MiB;
constexpr size_t WS_WDN = 31 * MiB;
constexpr size_t WS_WKV = 37 * MiB;
constexpr size_t WS_MEMN = 39 * MiB;
constexpr size_t WS_KV = 41 * MiB;
constexpr size_t WS_BT = 43 * MiB;
constexpr size_t WS_MH = 44 * MiB + 512 * 1024;
constexpr size_t WS_BA = 45 * MiB;
constexpr size_t WS_SSQ = 49 * MiB;
constexpr size_t WS_P = 52 * MiB;
constexpr size_t WS_UE = 452 * MiB;
constexpr size_t WS_END = 512 * MiB;
static_assert(WS_P + (size_t)M * PLD * 2 == WS_UE && WS_UE + (size_t)512 * 4 * NUP * 4 <= WS_END, "d_ws map");

constexpr int CW_TMO = 0, CW_CODE = 1;
constexpr int CW_BAR = 4096;
constexpr int CW_FIX = 1152;
constexpr int CW_KVF = 1024;
constexpr int RING_OFF = 0, RING_BYTES = 147456;
constexpr int LDSCTL_OFF = RING_BYTES, MISC_OFF = LDSCTL_OFF + 320;
constexpr int XCH_OFF = MISC_OFF + 256;
constexpr int LDS_BYTES = 163840;
static_assert(XCH_OFF + 2 * 1280 * 4 <= LDS_BYTES && XCH_OFF % 16 == 0, "LDS map");

typedef GAS unsigned gu32;
#define RLX_AGENT __ATOMIC_RELAXED, __HIP_MEMORY_SCOPE_AGENT
#define LDS_WAIT() asm volatile("s_waitcnt lgkmcnt(0)" ::: "memory")
#define VM_WAIT() asm volatile("s_waitcnt vmcnt(0)" ::: "memory")

#define XB_TMO      128
#define XB_XCNT(j)  (256  + 64 * (j))
#define XB_XSUB(j)  (1280 + 64 * (j))
#define XB_XGEN(j)  (2304 + 64 * (j))
#define XB_TOP      3328
#define XB_TOPGEN   3392
#define XCD_BAR_WORDS 3456
#define XB_SPIN_CAP (1u << 22)

__device__ __forceinline__ unsigned xb_ld(unsigned* p)              { return __hip_atomic_load(p, __ATOMIC_RELAXED, __HIP_MEMORY_SCOPE_AGENT); }
__device__ __forceinline__ unsigned xb_add(unsigned* p, unsigned v) { return __hip_atomic_fetch_add(p, v, __ATOMIC_RELAXED, __HIP_MEMORY_SCOPE_AGENT); }
__device__ __forceinline__ unsigned xb_xcc_id() { return (unsigned)__builtin_amdgcn_s_getreg((3 << 11) | 20) & 0xFu; }
#define XB_SPIN(cond, bar) do { unsigned _sp = 0; while (cond) { __builtin_amdgcn_s_sleep(1); \
    if ((++_sp & 255u) == 0u) { if (xb_ld(&(bar)[XB_TMO])) break; if (_sp > XB_SPIN_CAP) { atomicAdd(&(bar)[XB_TMO], 1u); break; } } } } while (0)

struct XcdBarrier { unsigned* bar; unsigned x; volatile LAS unsigned* st; };

__device__ __forceinline__ XcdBarrier xcd_barrier_post(unsigned* bar, volatile LAS unsigned* st) {
    XcdBarrier b; b.bar = bar; b.x = xb_xcc_id(); b.st = st;
    if (threadIdx.x == 0) (void)xb_add(&bar[XB_XCNT(b.x)], 1u);
    return b;
}
__device__ __forceinline__ void xcd_barrier_complete(unsigned* bar, unsigned x, unsigned& nloc, unsigned& nx) {
    const unsigned G = gridDim.x * gridDim.y * gridDim.z;
    unsigned sum, cnt, mine, sp = 0u;
    for (;;) {
        sum = 0u; cnt = 0u; mine = 0u;
#pragma unroll
        for (unsigned j = 0; j < 16; ++j) { const unsigned c = xb_ld(&bar[XB_XCNT(j)]); sum += c; cnt += (c > 0u) ? 1u : 0u; mine = (j == x) ? c : mine; }
        if (sum == G) break;
        __builtin_amdgcn_s_sleep(1);
        if ((++sp & 255u) == 0u) { if (xb_ld(&bar[XB_TMO])) break; if (sp > XB_SPIN_CAP) { atomicAdd(&bar[XB_TMO], 1u); break; } }
    }
    nloc = mine > 0u ? mine : 1u; nx = cnt > 0u ? cnt : 1u;
}
__device__ __forceinline__ void xcd_barrier(const XcdBarrier& b) {
    asm volatile("s_waitcnt vmcnt(0)" ::: "memory");
    __syncthreads();
    if (threadIdx.x == 0) {
        unsigned* bar = b.bar;
        __builtin_amdgcn_s_waitcnt(0);
        unsigned nloc = b.st[0], nx = b.st[1];
        if (nloc == 0u) { xcd_barrier_complete(bar, b.x, nloc, nx); b.st[0] = nloc; b.st[1] = nx; }
        const unsigned old = xb_add(&bar[XB_XSUB(b.x)], 1u);
        const unsigned gen = old / nloc;
        if (old + 1u == (gen + 1u) * nloc) {
            __builtin_amdgcn_fence(__ATOMIC_RELEASE, "agent");
            asm volatile("s_waitcnt vmcnt(0)" ::: "memory");
            const unsigned og = xb_add(&bar[XB_TOP], 1u);
            const unsigned tg = og / nx;
            if (og + 1u == (tg + 1u) * nx) xb_add(&bar[XB_TOPGEN], 1u);
            else XB_SPIN(xb_ld(&bar[XB_TOPGEN]) == tg, bar);
            __builtin_amdgcn_fence(__ATOMIC_ACQUIRE, "agent");
            xb_add(&bar[XB_XGEN(b.x)], 1u);
            asm volatile("s_waitcnt vmcnt(0)" ::: "memory");
        } else {
            XB_SPIN(xb_ld(&bar[XB_XGEN(b.x)]) == gen, bar);
            __builtin_amdgcn_fence(__ATOMIC_ACQUIRE, "agent");
            asm volatile("s_waitcnt vmcnt(0)" ::: "memory");
        }
    }
    __syncthreads();
}

struct Frame {
    LAS unsigned char* lds;
    volatile LAS unsigned* MISC;
    gu32* ctl;
    int tid, lane, wave, vcu, G;
};

__device__ __forceinline__ float wave_sum(float v) {
#pragma unroll
    for (int o = 1; o < 64; o <<= 1) v += __shfl_xor(v, o);
    return v;
}
__device__ __forceinline__ int t5_bucket(int rel) {
    const int n = rel < 0 ? -rel : rel;
    const int mag = n < 8 ? n : n < 12 ? 8 : n < 16 ? 9 : n < 23 ? 10 : n < 32 ? 11 : n < 46 ? 12 : n < 64 ? 13 : n < 91 ? 14 : 15;
    return (rel > 0 ? 16 : 0) + mag;
}

__device__ __forceinline__ void transpose_item(const float* W, int K, int N, int k0, int n0, bf16* WT, int drow0, const float* gk, LAS float* scr, int lane) {
    { f32x4 v[8];
#pragma unroll
      for (int i = 0; i < 8; ++i) v[i] = *(const f32x4*)(W + (size_t)(k0 + 8 * i + (lane >> 3)) * N + n0 + 4 * (lane & 7));
#pragma unroll
      for (int i = 0; i < 8; ++i) { const int kk = 8 * i + (lane >> 3); const float gs = gk ? gk[k0 + kk] : 1.0f; LAS float* d = scr + kk * 33 + 4 * (lane & 7);
          d[0] = v[i][0] * gs; d[1] = v[i][1] * gs; d[2] = v[i][2] * gs; d[3] = v[i][3] * gs; } }
    LDS_WAIT(); asm volatile("" ::: "memory");
    const int c = lane & 7;
#pragma unroll
    for (int j = 0; j < 4; ++j) { const int n = (lane >> 3) + 8 * j; const LAS float* s = scr + (8 * c) * 33 + n;
        u32x4 o; o.x = pk2(s[0 * 33], s[1 * 33]); o.y = pk2(s[2 * 33], s[3 * 33]); o.z = pk2(s[4 * 33], s[5 * 33]); o.w = pk2(s[6 * 33], s[7 * 33]);
        *(GAS u32x4*)(WT + (size_t)(drow0 + n) * K + k0 + 8 * c) = o; }
    LDS_WAIT(); asm volatile("" ::: "memory");
}
__device__ __forceinline__ void rms_row_to_bf16(const float* xrow, const float* g, bf16* orow, int lane) {
    const GAS f32x4* xr = (const GAS f32x4*)xrow + lane;
    const GAS f32x4* gr = (const GAS f32x4*)g + lane;
    f32x4 v[4]; float s = 0.f;
#pragma unroll
    for (int j = 0; j < 4; ++j) { v[j] = xr[64 * j]; s += (v[j].x * v[j].x + v[j].y * v[j].y) + (v[j].z * v[j].z + v[j].w * v[j].w); }
    const float rstd = __builtin_amdgcn_rsqf(wave_sum(s) * (1.f / DM) + EPS);
    GAS unsigned long long* o8 = (GAS unsigned long long*)orow + lane;
#pragma unroll
    for (int j = 0; j < 4; ++j) { const f32x4 gg = gr[64 * j];
        o8[64 * j] = (unsigned long long)pk2(v[j].x * rstd * gg.x, v[j].y * rstd * gg.y) | ((unsigned long long)pk2(v[j].z * rstd * gg.z, v[j].w * rstd * gg.w) << 32); }
}

template <int R> __device__ __forceinline__ void rms_rows_to_bf16(const float* xa, size_t rstride, const float* g, bf16* oa, int lane) {
    const GAS f32x4* gr = (const GAS f32x4*)g + lane;
    f32x4 v[R][4]; float ss[R];
#pragma unroll
    for (int r = 0; r < R; ++r) { const GAS f32x4* xr = (const GAS f32x4*)(xa + (size_t)r * rstride) + lane;
#pragma unroll
        for (int j = 0; j < 4; ++j) v[r][j] = xr[64 * j]; }
#pragma unroll
    for (int r = 0; r < R; ++r) { ss[r] = 0.f;
#pragma unroll
        for (int j = 0; j < 4; ++j) ss[r] += (v[r][j].x * v[r][j].x + v[r][j].y * v[r][j].y) + (v[r][j].z * v[r][j].z + v[r][j].w * v[r][j].w); }
#pragma unroll
    for (int o = 1; o < 64; o <<= 1)
#pragma unroll
        for (int r = 0; r < R; ++r) ss[r] += __shfl_xor(ss[r], o);
#pragma unroll
    for (int r = 0; r < R; ++r) { const float rs = __builtin_amdgcn_rsqf(ss[r] * (1.f / DM) + EPS);
        GAS unsigned long long* o8 = (GAS unsigned long long*)(oa + (size_t)r * rstride) + lane;
#pragma unroll
        for (int j = 0; j < 4; ++j) { const f32x4 gg = gr[64 * j];
            o8[64 * j] = (unsigned long long)pk2(v[r][j].x * rs * gg.x, v[r][j].y * rs * gg.y) | ((unsigned long long)pk2(v[r][j].z * rs * gg.z, v[r][j].w * rs * gg.w) << 32); } }
}

struct Args { const float* in[25]; float* out; unsigned char* ws; int ph_lo, ph_hi, mode, pad; };

constexpr int WI_IN = 16 * 201, WI_KV = 16 * 32, WI_BR = 8 * 32, WI_OUT = 16 * 32, WI_UP = 16 * 176, WI_DN = 44 * 32;
constexpr int WI_EARLY = WI_IN + WI_KV, WI_ALL = WI_EARLY + 3 * WI_BR + WI_OUT + WI_UP + WI_DN;
__device__ __forceinline__ void weight_items(Frame& F, const Args& a, int first, int last, int gwl, int ngwl) {
    unsigned char* ws = a.ws;
    LAS float* scr = (LAS float*)(F.lds + RING_OFF + F.wave * 16384);
    for (int it = first + gwl; it < last; it += ngwl) {
        int r = it;
        if (r < WI_IN) { const int kb = r / 201, nb = r % 201, n0 = nb * 32;
            const int d0 = n0 < 2816 ? n0 : (n0 < 2848 ? 3328 + (n0 - 2816) : (n0 < 3360 ? n0 - 32 : 3584 + (n0 - 3360)));
            transpose_item(a.in[4], 1024, 6432, kb * 64, n0, (bf16*)(ws + WS_WIN), d0, nullptr, scr, F.lane); continue; }
        r -= WI_IN;
        if (r < WI_KV) { const int kb = r / 32, nb = r % 32;
            transpose_item(a.in[13], 1024, 1024, kb * 64, nb * 32, (bf16*)(ws + WS_WKV), nb * 32, nullptr, scr, F.lane); continue; }
        r -= WI_KV;
        if (r < 3 * WI_BR) { const int br = r / WI_BR, q = r % WI_BR, kb = q / 32, nb = q % 32;
            transpose_item(a.in[16 + br], 512, 1024, kb * 64, nb * 32, (bf16*)(ws + WS_WBR) + (size_t)br * 1024 * 512, nb * 32, nullptr, scr, F.lane); continue; }
        r -= 3 * WI_BR;
        if (r < WI_OUT) { const int kb = r / 32, nb = r % 32;
            transpose_item(a.in[19], 1024, 1024, kb * 64, nb * 32, (bf16*)(ws + WS_WOUT), nb * 32, nullptr, scr, F.lane); continue; }
        r -= WI_OUT;
        if (r < WI_UP) { const int kb = r / 176, nb = r % 176, n0 = nb * 32;
            const int isv = n0 >= DFF, nn = isv ? n0 - DFF : n0, d0 = (nn >> 7) * 256 + isv * 128 + (nn & 127);
            transpose_item(a.in[21], 1024, NUP, kb * 64, n0, (bf16*)(ws + WS_WUP), d0, a.in[20], scr, F.lane); continue; }
        r -= WI_UP;
        { const int kb = r / 32, nb = r % 32;
            transpose_item(a.in[24], DFF, 1024, kb * 64, nb * 32, (bf16*)(ws + WS_WDN), nb * 32, nullptr, scr, F.lane); }
    }
}
__device__ __forceinline__ float wave_max(float v) {
#pragma unroll
    for (int o = 1; o < 64; o <<= 1) v = fmaxf(v, __shfl_xor(v, o));
    return v;
}
__device__ __forceinline__ void p0_prologue(Frame& F, const Args& a) {
    unsigned char* ws = a.ws;
    const int gw = F.vcu * NWAVES + F.wave, NGW = F.G * NWAVES;
    LAS float* mh = (LAS float*)(F.lds + XCH_OFF);
    if (F.wave == 0) { const int lane = F.lane;
        const float wa = wave_max(fabsf(a.in[5][lane] * a.in[6][lane]));
        const float wx = wave_max(fmaxf(fabsf(a.in[14][lane] * a.in[15][lane]), fabsf(a.in[14][64 + lane] * a.in[15][64 + lane])));
        float tsel = 0.f;
#pragma unroll
        for (int h = 0; h < 8; ++h) { const float tb = wave_max(lane < 32 ? fabsf(a.in[2][lane * 8 + h]) : 0.f); tsel = (lane == h) ? tb : tsel; }
        float Mv = 0.f;
        if (lane < 8) Mv = fmaxf((0.125f * 64.f * 1.02f) * wa + tsel, a.in[7][lane]) * LOG2E;
        if (lane == 8) Mv = (0.08838834764831845f * 128.f * 1.02f) * wx * LOG2E;
        if (lane < 16) { mh[lane] = Mv; if (blockIdx.x == 0) ((float*)(ws + WS_MH))[lane] = Mv; } }
    weight_items(F, a, 0, WI_EARLY, gw, NGW);
    { u32x4* z = (u32x4*)((bf16*)(ws + WS_WIN) + (size_t)3360 * 1024); const int n16 = 224 * 1024 * 2 / 16;
      for (int i = blockIdx.x * 512 + F.tid; i < n16; i += F.G * 512) z[i] = (u32x4){0u, 0u, 0u, 0u}; }
    bf16* H = (bf16*)a.out;
    if (M % (4 * NGW) != 0) { for (int m = gw; m < M; m += NGW) rms_row_to_bf16(a.in[0] + (size_t)m * DM, a.in[3], H + (size_t)m * DM, F.lane); }
    else for (int m = gw; m < M; m += 4 * NGW) rms_rows_to_bf16<4>(a.in[0] + (size_t)m * DM, (size_t)NGW * DM, a.in[3], H + (size_t)m * DM, F.lane);
    for (int m = gw; m < BATCH * NMEM; m += NGW) rms_row_to_bf16(a.in[1] + (size_t)m * DM, a.in[12], (bf16*)(ws + WS_MEMN) + (size_t)m * DM, F.lane);
    LDS_WAIT(); __syncthreads();
    { float* BT = (float*)(ws + WS_BT); const float* tab = a.in[2];
      for (int i = blockIdx.x * 512 + F.tid; i < 8 * 128 * 384; i += F.G * 512) { const int ii = i & 3, ln = (i >> 2) & 63, gc = (i >> 8) & 7, kt = (i >> 11) % 6, tb = ((i >> 11) / 6) & 3, h = (i >> 11) / 24;
          const int t = tb * 32 + (ln & 31), j = kt * 64 + (gc & 1) * 32 + (gc >> 1) * 8 + (ln >> 5) * 4 + ii;
          const int rel = j - 128 - t; const bool ok = rel >= -128 && rel <= 128;
          BT[i] = ok ? tab[t5_bucket(rel) * 8 + h] * LOG2E - mh[h] : -INFINITY; } }
}

__device__ __forceinline__ void attnA_unit(Frame& F, const Args& a, int b, int n, int kvh) {
    constexpr int RSK = 144, RSV = 128;
    LAS unsigned char* Kl = F.lds; LAS unsigned char* Vl = F.lds + 384 * RSK;
    bf16* P = (bf16*)(a.ws + WS_P);
    const float* BT = (const float*)(a.ws + WS_BT);
    const int h = kvh * 4 + (F.wave >> 1), r32 = F.lane & 31, hi = F.lane >> 5;
    bf16* qrow0 = P + (size_t)(b * SEQ + n * 128 + (F.wave & 1) * 64 + r32) * PLD + C_AQ + h * 64;
    u32x4 qw[4]; load_q_raw<64>(qrow0, qw, F.lane);
    int tid_o = F.tid; asm volatile("" : "+v"(tid_o));
    stage_kv<64, RSK, RSV, 6>(Kl, Vl, P + ((ptrdiff_t)b * SEQ + (ptrdiff_t)n * 128 - 128) * PLD, PLD, C_AK + kvh * 64, C_AV + kvh * 64, n == 0 ? 128 : 0, n == SEQ / 128 - 1 ? 256 : 384, a.in[6], a.in[5], tid_o);
    LDS_WAIT(); __syncthreads();
    const float sink = fexp2(a.in[7][h] * LOG2E - ((const float*)(a.ws + WS_MH))[h]);
#pragma unroll 1
    for (int qb = 0; qb < 2; ++qb) {
        const int t0 = (F.wave & 1) * 64 + qb * 32, t = t0 + r32;
        bf16* qrow = qrow0 + (size_t)qb * 32 * PLD;
        const int lo = max(t0 >= 64 ? 1 : 0, n == 0 ? 2 : 0), hi_t = min(t0 >= 64 ? 5 : 4, n == SEQ / 128 - 1 ? 3 : 5);
        const float* brow = BT + (size_t)((h * 4 + (t0 >> 5)) * 6) * 2048 + F.lane * 4;
        f32x16 b0, b1; load_bias(brow + 2048 * lo, b0, b1);
        bf16x8 qf[4]; finish_q<64>(qw, 0.125f * LOG2E, qf, F.lane);
        if (qb == 0) load_q_raw<64>(qrow + (size_t)32 * PLD, qw, F.lane);
        float m = 0.f, l = hi == 0 ? sink : 0.f; f32x16 o[2];
#pragma unroll
        for (int r = 0; r < 16; ++r) { o[0][r] = 0.f; o[1][r] = 0.f; }
#pragma unroll 1
        for (int kt = lo; kt <= hi_t; ++kt) {
            f32x16 nb0 = b0, nb1 = b1;
            if (kt < hi_t) load_bias(brow + 2048 * (kt + 1), nb0, nb1);
            attn_tile<64, RSK, RSV, true>(Kl, Vl, 64 * kt, qf, b0, b1, m, l, o, F.lane);
            b0 = nb0; b1 = nb1; }
        store_o<64>(qrow, o, l, F.lane);
    }
    LDS_WAIT(); __syncthreads();
}
__device__ __forceinline__ void xattn_unit(Frame& F, const Args& a, int b, int tb, int h) {
    constexpr int RSK = 272, RSV = 320;
    LAS unsigned char* Kl = F.lds; LAS unsigned char* Vl = F.lds + 128 * RSK;
    bf16* P = (bf16*)(a.ws + WS_P);
    const bf16* KV = (const bf16*)(a.ws + WS_KV);
    const int r32 = F.lane & 31;
    bf16* qrow = P + (size_t)(b * SEQ + tb * 256 + F.wave * 32 + r32) * PLD + C_MQ + h * 128;
    u32x4 qw[8]; load_q_raw<128>(qrow, qw, F.lane);
    int tid_o = F.tid; asm volatile("" : "+v"(tid_o));
    stage_kv<128, RSK, RSV, 4>(Kl, Vl, KV + (size_t)(b * NMEM) * 1024, 1024, h * 128, 512 + h * 128, 0, 128, a.in[15], a.in[14], tid_o);
    bf16x8 qf[8]; finish_q<128>(qw, 0.08838834764831845f * LOG2E, qf, F.lane);
    float m = 0.f, l = 0.f; f32x16 o[4]; const float nMx = -((const float*)(a.ws + WS_MH))[8];
#pragma unroll
    for (int db = 0; db < 4; ++db)
#pragma unroll
        for (int r = 0; r < 16; ++r) o[db][r] = 0.f;
#pragma unroll 1
    for (int half = 0; half < 2; ++half) {
        if (half == 1) stage_kv<128, RSK, RSV, 4>(Kl, Vl, KV + (size_t)(b * NMEM + 128) * 1024, 1024, h * 128, 512 + h * 128, 0, 128, a.in[15], a.in[14], tid_o);
        LDS_WAIT(); __syncthreads();
#pragma unroll 1
        for (int kt = 0; kt < 2; ++kt) { f32x16 z0, z1;
#pragma unroll
            for (int r = 0; r < 16; ++r) { z0[r] = nMx; z1[r] = nMx; }
            attn_tile<128, RSK, RSV, true>(Kl, Vl, 64 * kt, qf, z0, z1, m, l, o, F.lane); }
        LDS_WAIT(); __syncthreads();
    }
    store_o<128>(qrow, o, l, F.lane);
}


constexpr int SAF = C_GATE, SCF = C_GATE + 512, SBF = C_GATE + 1024, SDF = C_GATE + 1536, SAB = C_GATE + 2048, SCB = C_GATE + 2560;
constexpr int C_OF = C_DQ, C_OB = C_DK;
__device__ __forceinline__ int dn_pcol(int x) { return (x & 32) + 8 * ((x & 15) >> 2) + 4 * ((x >> 4) & 1) + (x & 3); }
__device__ __forceinline__ bf16x8 frag_lo(const LAS unsigned char* p) { const u32x2 a0 = *(const LAS u32x2*)p; u32x4 w; w.x = a0.x; w.y = a0.y; w.z = 0u; w.w = 0u; return __builtin_bit_cast(bf16x8, w); }
__device__ __forceinline__ bf16x8 frag_2(const LAS unsigned char* p) { const u32x2 a0 = *(const LAS u32x2*)p, a1 = *(const LAS u32x2*)(p + 32); u32x4 w; w.x = a0.x; w.y = a0.y; w.z = a1.x; w.w = a1.y; return __builtin_bit_cast(bf16x8, w); }
__device__ __forceinline__ bf16x8 pack_f4z(const f32x4 a) { u32x4 w; w.x = pk2(a[0], a[1]); w.y = pk2(a[2], a[3]); w.z = 0u; w.w = 0u; return __builtin_bit_cast(bf16x8, w); }
__device__ __forceinline__ bf16x8 pack_f4f4(const f32x4 a, const f32x4 b) { u32x4 w; w.x = pk2(a[0], a[1]); w.y = pk2(a[2], a[3]); w.z = pk2(b[0], b[1]); w.w = pk2(b[2], b[3]); return __builtin_bit_cast(bf16x8, w); }
constexpr int DNP_ST0 = 53248, DNP_ST1 = 123392, DNP_ST2 = 131584, DNP_ST3 = XCH_OFF;
static_assert(DNP_ST2 + 8192 <= LDSCTL_OFF && DNP_ST3 + 8192 <= LDS_BYTES && DNP_ST3 % 16 == 0, "prep staging map");
__device__ __forceinline__ void dn_prep_block(Frame& F, const Args& a, int b, int h, int c0, int nch) {
    LAS float* raw = (LAS float*)(F.lds);
    LAS unsigned char* NL = F.lds;
    LAS unsigned char* TD = F.lds + 18432;
    LAS unsigned char* Qb = F.lds + 53248;
    LAS unsigned char* Kb = F.lds + 62464;
    LAS unsigned char* Vb = F.lds + 71680;
    LAS float* sm = (LAS float*)(F.lds + 80896);
    LAS float* gt = sm;
    LAS float* btk = sm + 128;
    LAS float* gct = sm + 256;
    LAS float* cu = sm + 384;
    LAS float* cwp = sm + 512;
    LAS float* egp = sm + 640;
    LAS float* esp = sm + 768;
    LAS unsigned char* QKL = F.lds + 24576;
    LAS unsigned char* KT = F.lds + 84480;
    LAS unsigned char* QT = F.lds + 104960;
    bf16* P = (bf16*)(a.ws + WS_P);
    float* BA = (float*)(a.ws + WS_BA);
    bf16* XB2 = (bf16*)a.out + (size_t)M * 1024;
    const float* cw = a.in[8];
    const int w = F.wave, lane = F.lane, tid = F.tid;
    float wt[3][5];
#pragma unroll
    for (int which = 0; which < 3; ++which)
#pragma unroll
        for (int j = 0; j < 5; ++j) wt[which][j] = cw[j * 1536 + which * 512 + h * 64 + lane];
    const float Ah = expf(a.in[9][(tid >> 6 & 1) * 8 + h]), dtb = a.in[10][(tid >> 6 & 1) * 8 + h];
    u32x4 rr[4]; float pa = 0.f, pb = 0.f;
    int pl_[4], pg_[4], pr_[4];
#pragma unroll
    for (int i_ = 0; i_ < 4; ++i_) { const int e = tid + 512 * i_, row = e / 24, c8 = e % 24, which = c8 >> 3;
        pl_[i_] = row * 192 + c8 * 8; pr_[i_] = e < 68 * 24 ? row : 1 << 20; pg_[i_] = row * PLD + (which == 0 ? C_DQ : which == 1 ? C_DK : C_DV) + h * 64 + (c8 & 7) * 8; }
#define DN_PREFETCH(cidx) do { const int t0p_ = (cidx) * 64; \
        _Pragma("unroll") for (int i_ = 0; i_ < 4; ++i_) { const int t = t0p_ - 2 + pr_[i_]; \
            rr[i_] = (u32x4){0u, 0u, 0u, 0u}; \
            if (t >= 0 && t < SEQ) rr[i_] = *(const u32x4*)(P + ((ptrdiff_t)b * SEQ + t0p_ - 2) * PLD + pg_[i_]); } \
        if (tid < 128) { const size_t tok = (size_t)b * SEQ + t0p_ + (tid & 63); pa = BA[tok * 32 + 16 + (tid >> 6) * 8 + h]; pb = BA[tok * 32 + (tid >> 6) * 8 + h]; } } while (0)
    DN_PREFETCH(c0);
#pragma unroll 1
  for (int ci = 0; ci < nch; ++ci) {
    int tid_o = F.tid; asm volatile("" : "+v"(tid_o));
    const int tid = tid_o, lane = tid & 63;
    const int c = c0 + ci, t0 = c * 64;
    const size_t tok0 = (size_t)b * SEQ + t0;

#pragma unroll
    for (int i_ = 0; i_ < 4; ++i_) {
        if (pr_[i_] < 68) { float v[8]; unpack8(rr[i_], v);
            *(LAS f32x4*)(raw + pl_[i_]) = (f32x4){v[0], v[1], v[2], v[3]}; *(LAS f32x4*)(raw + pl_[i_] + 4) = (f32x4){v[4], v[5], v[6], v[7]}; } }
    if (tid < 128) { const int d = tid >> 6, i = tid & 63; const float xa = pa + dtb;
        gt[d * 64 + i] = -Ah * (fmaxf(xa, 0.f) + __logf(1.0f + __expf(-fabsf(xa))));
        btk[d * 64 + i] = sigmoidf_(pb); }
    if (ci + 1 < nch) DN_PREFETCH(c + 1);
    LDS_WAIT(); __syncthreads();
    { const int lane = F.lane;
#pragma unroll
    for (int which = 0; which < 3; ++which) {
        float x[12], y[8];
#pragma unroll
        for (int j = 0; j < 12; ++j) x[j] = raw[(w * 8 + j) * 192 + which * 64 + lane];
#pragma unroll
        for (int r = 0; r < 8; ++r) { float acc = 0.f;
#pragma unroll
            for (int j = 0; j < 5; ++j) acc += x[r + j] * wt[which][j];
            y[r] = siluf_(acc); }
        if (which < 2) {
            float a[4], bb[2], c;
#pragma unroll
            for (int i = 0; i < 4; ++i) { const float lo = dpp_add<0xB1, 0xF>(y[i] * y[i]), hi = dpp_add<0xB1, 0xF>(y[i + 4] * y[i + 4]); a[i] = (lane & 1) ? hi : lo; }
#pragma unroll
            for (int i = 0; i < 2; ++i) { const float lo = dpp_add<0x4E, 0xF>(a[i]), hi = dpp_add<0x4E, 0xF>(a[i + 2]); bb[i] = (lane & 2) ? hi : lo; }
            { const float lo = bb[0] + dpp_xor4(bb[0]), hi = bb[1] + dpp_xor4(bb[1]); c = (lane & 4) ? hi : lo; }
            c = dpp_add<0x128, 0xF>(c);
            c += __shfl_xor(c, 16); c += __shfl_xor(c, 32);
            const float rs = __builtin_amdgcn_rsqf(c + EPS) * (which == 0 ? 0.125f : 1.0f);
#pragma unroll
            for (int r = 0; r < 8; ++r) y[r] *= __builtin_bit_cast(float, __builtin_amdgcn_readlane(__builtin_bit_cast(int, rs), (r >> 2) | (((r >> 1) & 1) << 1) | ((r & 1) << 2)));
        }
        LAS unsigned char* X = which == 0 ? Qb : which == 1 ? Kb : Vb;
#pragma unroll
        for (int r = 0; r < 8; ++r) *(LAS bf16*)(X + (w * 8 + r) * 144 + lane * 2) = (bf16)(pk2(y[r], 0.f) & 0xffffu);
        asm volatile("" ::: "memory");
    } }
    if (w < 2) { const int i = w ? 63 - lane : lane; float gv = gt[w * 64 + i];
        gv = wave_scan_dpp(gv);
        const float glast = __builtin_bit_cast(float, __builtin_amdgcn_readlane(__builtin_bit_cast(int, gv), 63)), bt = btk[w * 64 + i], eg = __expf(gv);
        const float es = __expf(glast - gv);
        gct[w * 64 + i] = gv; cu[w * 64 + lane] = bt; cwp[w * 64 + lane] = bt * eg; egp[w * 64 + lane] = eg; esp[w * 64 + lane] = es;
        BA[(tok0 + lane) * 32 + w * 8 + h] = eg; }
    LDS_WAIT(); __syncthreads();
    { const int lane = F.lane;
      const int wq = w & 3, tm = wq >> 1, tn = wq & 1, r32 = lane & 31, hi = lane >> 5;
      const LAS unsigned char* X = (w < 4) ? Kb : Qb;
      f32x16 acc;
#pragma unroll
      for (int r = 0; r < 16; ++r) acc[r] = 0.f;
#pragma unroll
      for (int kst = 0; kst < 4; ++kst) {
          const bf16x8 af = *(const LAS bf16x8*)(X + (32 * tm + r32) * 144 + (16 * kst + 8 * hi) * 2), bfr = *(const LAS bf16x8*)(Kb + (32 * tn + r32) * 144 + (16 * kst + 8 * hi) * 2);
          acc = __builtin_amdgcn_mfma_f32_32x32x16_bf16(bfr, af, acc, 0, 0, 0); }
      const int i = 32 * tm + r32; const float gif = gct[i], gib = gct[64 + i], bif = btk[i], bib = btk[64 + i];
      LAS unsigned char* D = (w < 4) ? NL : QKL;
#pragma unroll
      for (int g4 = 0; g4 < 4; ++g4) { const int j0 = 32 * tn + 8 * g4 + 4 * hi;
          const f32x4 gjf = *(const LAS f32x4*)(gct + j0), gjb = *(const LAS f32x4*)(gct + 64 + j0);
          float vf[4], vb[4];
#pragma unroll
          for (int q = 0; q < 4; ++q) { const int j = j0 + q; const float v = acc[4 * g4 + q];
              const float ef = __expf(fminf(gif - gjf[q], 0.f)), eb = __expf(fminf(gib - gjb[q], 0.f));
              if (w < 4) { vf[q] = (j < i) ? -bif * v * ef : 0.f; vb[q] = (j > i) ? -bib * v * eb : 0.f; }
              else { vf[q] = (j <= i) ? v * ef : 0.f; vb[q] = (j >= i) ? v * eb : 0.f; } }
          u32x2 of, ob; of.x = pk2(vf[0], vf[1]); of.y = pk2(vf[2], vf[3]); ob.x = pk2(vb[3], vb[2]); ob.y = pk2(vb[1], vb[0]);
          *(LAS u32x2*)(D + i * 144 + j0 * 2) = of;
          *(LAS u32x2*)(D + 9216 + (63 - i) * 144 + (60 - j0) * 2) = ob; } }
    LDS_WAIT(); __syncthreads();
    { const int lane = F.lane, n = lane & 15, g = lane >> 4, d = w >> 2, blk = w & 3;
      const LAS unsigned char* nlb = NL + d * 9216 + (16 * blk) * 144 + (16 * blk) * 2;
      const f32x4 z4 = (f32x4){0.f, 0.f, 0.f, 0.f};
      f32x4 xd, xtd, idn;
      { const u32x2 rw = *(const LAS u32x2*)(nlb + n * 144 + 8 * g); xtd = (f32x4){bf_lo(rw.x), bf_hi(rw.x), bf_lo(rw.y), bf_hi(rw.y)}; }
#pragma unroll
      for (int r = 0; r < 4; ++r) { xd[r] = __uint_as_float((unsigned)(*(const LAS bf16*)(nlb + (4 * g + r) * 144 + n * 2)) << 16); idn[r] = (4 * g + r == n) ? 1.f : 0.f; }
      f32x4 qT = xtd + idn;
#pragma unroll
      for (int k = 0; k < 3; ++k) {
          const bf16x8 pa = pack_f4z(xtd), pb = pack_f4z(xd);
          const f32x4 x2d = __builtin_amdgcn_mfma_f32_16x16x32_bf16(pa, pb, z4, 0, 0, 0);
          if (k < 2) xtd = __builtin_amdgcn_mfma_f32_16x16x32_bf16(pb, pa, z4, 0, 0, 0);
          xd = x2d;
          qT = __builtin_amdgcn_mfma_f32_16x16x32_bf16(pack_f4z(xd + idn), pack_f4z(qT), z4, 0, 0, 0);
      }
      { u32x2 o; o.x = pk2(qT[0], qT[1]); o.y = pk2(qT[2], qT[3]); *(LAS u32x2*)(TD + d * 3072 + blk * 768 + n * 48 + 8 * g) = o; }
    }
#pragma unroll
    for (int it = 0; it < 2; ++it) { const int e = tid + 512 * it, d = e >> 9, p = (e >> 3) & 63, c8 = e & 7;
        const int i = d ? 63 - p : p; const float es = esp[d * 64 + p], eg = egp[d * 64 + p]; float v[8];
        unpack8(*(const LAS u32x4*)(Kb + i * 144 + c8 * 16), v);
#pragma unroll
        for (int j = 0; j < 8; ++j) v[j] *= es;
        *(LAS u32x4*)(KT + d * 10240 + p * 160 + c8 * 16) = pack8(v);
        unpack8(*(const LAS u32x4*)(Qb + i * 144 + c8 * 16), v);
#pragma unroll
        for (int j = 0; j < 8; ++j) v[j] *= eg;
        *(LAS u32x4*)(QT + d * 9216 + p * 144 + c8 * 16) = pack8(v); }
    LDS_WAIT(); __syncthreads();
    { const int lane = F.lane;
      const int d = w >> 2, cc = lane & 15, g = lane >> 4, colb = 16 * (w & 3);
      const LAS unsigned char* nl = NL + d * 9216; const LAS unsigned char* td = TD + d * 3072 + cc * 48 + 8 * g;
      f32x4 R[2][4];
#pragma unroll
      for (int p = 0; p < 2; ++p) { const LAS unsigned char* src = p ? Kb : Vb; const LAS float* coef = (p ? cwp : cu) + d * 64;
#pragma unroll
          for (int bq = 0; bq < 4; ++bq) { const f32x4 cf = *(const LAS f32x4*)(coef + 16 * bq + 4 * g);
#pragma unroll
              for (int r = 0; r < 4; ++r) { const int pp_ = 16 * bq + 4 * g + r, i = d ? 63 - pp_ : pp_;
                  R[p][bq][r] = cf[r] * __uint_as_float((unsigned)(*(const LAS bf16*)(src + i * 144 + (colb + cc) * 2)) << 16); } } }
      const f32x4 z4 = (f32x4){0.f, 0.f, 0.f, 0.f};
      const bf16x8 t0f = frag_lo(td), t1f = frag_lo(td + 768), t2f = frag_lo(td + 2 * 768), t3f = frag_lo(td + 3 * 768);
      const bf16x8 n1f = frag_lo(nl + (16 + cc) * 144 + 8 * g), n2f = frag_2(nl + (32 + cc) * 144 + 8 * g), n3f = frag_2(nl + (48 + cc) * 144 + 8 * g), n3g = frag_lo(nl + (48 + cc) * 144 + 64 + 8 * g);
      __builtin_amdgcn_sched_barrier(0);
      f32x4 X0[2], X1[2], X2[2], X3[2], Y[2]; bf16x8 x01[2];
#pragma unroll
      for (int p = 0; p < 2; ++p) X0[p] = __builtin_amdgcn_mfma_f32_16x16x32_bf16(t0f, pack_f4z(R[p][0]), z4, 0, 0, 0);
#pragma unroll
      for (int p = 0; p < 2; ++p) Y[p] = __builtin_amdgcn_mfma_f32_16x16x32_bf16(n1f, pack_f4z(X0[p]), R[p][1], 0, 0, 0);
#pragma unroll
      for (int p = 0; p < 2; ++p) X1[p] = __builtin_amdgcn_mfma_f32_16x16x32_bf16(t1f, pack_f4z(Y[p]), z4, 0, 0, 0);
#pragma unroll
      for (int p = 0; p < 2; ++p) { x01[p] = pack_f4f4(X0[p], X1[p]); Y[p] = __builtin_amdgcn_mfma_f32_16x16x32_bf16(n2f, x01[p], R[p][2], 0, 0, 0); }
#pragma unroll
      for (int p = 0; p < 2; ++p) X2[p] = __builtin_amdgcn_mfma_f32_16x16x32_bf16(t2f, pack_f4z(Y[p]), z4, 0, 0, 0);
#pragma unroll
      for (int p = 0; p < 2; ++p) Y[p] = __builtin_amdgcn_mfma_f32_16x16x32_bf16(n3f, x01[p], R[p][3], 0, 0, 0);
#pragma unroll
      for (int p = 0; p < 2; ++p) Y[p] = __builtin_amdgcn_mfma_f32_16x16x32_bf16(n3g, pack_f4z(X2[p]), Y[p], 0, 0, 0);
#pragma unroll
      for (int p = 0; p < 2; ++p) X3[p] = __builtin_amdgcn_mfma_f32_16x16x32_bf16(t3f, pack_f4z(Y[p]), z4, 0, 0, 0);
      bf16x8 xb0[2], xb1[2];
      xb0[0] = pack_f4f4(X0[0], X1[0]); xb1[0] = pack_f4f4(X2[0], X3[0]); xb0[1] = pack_f4f4(-X0[1], -X1[1]); xb1[1] = pack_f4f4(-X2[1], -X3[1]);
      const int q4 = (lane & 15) >> 2, pp = lane & 3;
      const LAS unsigned char* qkl = QKL + d * 9216; const LAS unsigned char* qtl = QT + d * 9216;
      const int hr = (h + c) & 7;
      bf16* pB = (d == 0) ? P + tok0 * PLD + hr * 64 + SBF : XB2 + tok0 * 512 + hr * 64;
      bf16* pD = (d == 0) ? P + tok0 * PLD + hr * 64 + SDF : XB2 + (size_t)M * 512 + tok0 * 512 + hr * 64;
      const size_t pit = (d == 0) ? PLD : 512;
      const int pc = dn_pcol(colb + cc);
      LAS unsigned char* sA = F.lds + (d ? DNP_ST2 : DNP_ST0); LAS unsigned char* sC = F.lds + (d ? DNP_ST3 : DNP_ST1);
#pragma unroll
      for (int mt = 0; mt < 4; ++mt) {
          s16x4 klo[2], khi[2]; bf16x8 qkf[2]; f32x4 c1;
          { const unsigned ka = (unsigned)(uintptr_t)(KT + d * 10240) + (4 * g + q4) * 160u + (16 * mt + 4 * pp) * 2u;
            asm volatile("ds_read_b64_tr_b16 %0, %1" : "=&v"(klo[0]) : "v"(ka) : "memory");
            asm volatile("ds_read_b64_tr_b16 %0, %1 offset:2560" : "=&v"(khi[0]) : "v"(ka) : "memory");
            asm volatile("ds_read_b64_tr_b16 %0, %1 offset:5120" : "=&v"(klo[1]) : "v"(ka) : "memory");
            asm volatile("ds_read_b64_tr_b16 %0, %1 offset:7680" : "=&v"(khi[1]) : "v"(ka) : "memory"); }
#pragma unroll
          for (int ks = 0; ks < 2; ++ks) { if (ks == 1 && mt < 2) continue; qkf[ks] = frag_2(qkl + (16 * mt + cc) * 144 + (32 * ks + 4 * g) * 2); }
#pragma unroll
          for (int r = 0; r < 4; ++r) c1[r] = __uint_as_float((unsigned)(*(const LAS bf16*)(qtl + (16 * mt + 4 * g + r) * 144 + (colb + cc) * 2)) << 16);
          asm volatile("s_waitcnt lgkmcnt(0)" ::: "memory"); __builtin_amdgcn_sched_barrier(0);
          f32x4 a0 = z4, a1 = z4, b0 = z4, b1 = c1;
#pragma unroll
          for (int ks = 0; ks < 2; ++ks) { const bf16x8 kf = (bf16x8){klo[ks][0], klo[ks][1], klo[ks][2], klo[ks][3], khi[ks][0], khi[ks][1], khi[ks][2], khi[ks][3]};
              a0 = __builtin_amdgcn_mfma_f32_16x16x32_bf16(kf, ks ? xb1[0] : xb0[0], a0, 0, 0, 0);
              a1 = __builtin_amdgcn_mfma_f32_16x16x32_bf16(kf, ks ? xb1[1] : xb0[1], a1, 0, 0, 0); }
#pragma unroll
          for (int ks = 0; ks < 2; ++ks) { if (ks == 1 && mt < 2) continue;
              b0 = __builtin_amdgcn_mfma_f32_16x16x32_bf16(qkf[ks], ks ? xb1[0] : xb0[0], b0, 0, 0, 0);
              b1 = __builtin_amdgcn_mfma_f32_16x16x32_bf16(qkf[ks], ks ? xb1[1] : xb0[1], b1, 0, 0, 0); }
          { u32x2 o; o.x = pk2(a0[0], a0[1]); o.y = pk2(a0[2], a0[3]); *(u32x2*)(pB + (size_t)(colb + cc) * pit + 16 * mt + 4 * g) = o;
            o.x = pk2(b0[0], b0[1]); o.y = pk2(b0[2], b0[3]); *(u32x2*)(pD + (size_t)(colb + cc) * pit + 16 * mt + 4 * g) = o; }
#pragma unroll
          for (int r = 0; r < 4; ++r) {
              *(LAS bf16*)(sA + (16 * mt + 4 * g + r) * 128 + pc * 2) = (bf16)(pk2(a1[r], 0.f) & 0xffffu); *(LAS bf16*)(sC + (16 * mt + 4 * g + r) * 128 + pc * 2) = (bf16)(pk2(b1[r], 0.f) & 0xffffu); }
          __builtin_amdgcn_sched_barrier(0);
      }
      asm volatile("" ::: "memory"); __builtin_amdgcn_sched_barrier(0);
    }
    LDS_WAIT(); __syncthreads();
    { const int row = tid >> 3, ch = tid & 7; bf16* dst = P + (tok0 + row) * PLD + ((h + c) & 7) * 64 + ch * 8;
      const u32x4 v0 = *(const LAS u32x4*)(F.lds + DNP_ST0 + row * 128 + ch * 16), v1 = *(const LAS u32x4*)(F.lds + DNP_ST1 + row * 128 + ch * 16);
      const u32x4 v2 = *(const LAS u32x4*)(F.lds + DNP_ST2 + row * 128 + ch * 16), v3 = *(const LAS u32x4*)(F.lds + DNP_ST3 + row * 128 + ch * 16);
      *(u32x4*)(dst + SAF) = v0; *(u32x4*)(dst + SCF) = v1; *(u32x4*)(dst + SAB) = v2; *(u32x4*)(dst + SCB) = v3; }
  }
#undef DN_PREFETCH
}

constexpr int DNX_A = 0, DNX_C = 8192, DNX_BT = 16384, DNX_DT = 24576, DNX_EG = 32768, DNX_SZ = 33792, DNX_OST = 3 * DNX_SZ;
__device__ __forceinline__ void dn_scan_step(const LAS unsigned char* buf, f32x4 (&Sacc)[4], int ws, int lane, LAS unsigned char* ost, int dir) {
    const int c = lane & 15, g = lane >> 4;
    const unsigned trow = 16 * ws + c, t0 = trow * 128u + ((((unsigned)(g >> 1)) ^ ((trow >> 1) & 7u)) << 4) + 8u * (g & 1);
    u32x2 bt[4], dt[4]; bf16x8 af[4][2], cf[4][2];
#pragma unroll
    for (int mt = 0; mt < 4; ++mt) { const unsigned row = 16 * mt + c, a0 = row * 128u + ((((unsigned)g) ^ ((row >> 1) & 7u)) << 4);
        bt[mt] = *(const LAS u32x2*)(buf + DNX_BT + (t0 ^ ((unsigned)mt << 5)));
#pragma unroll
        for (int ks = 0; ks < 2; ++ks) af[mt][ks] = *(const LAS bf16x8*)(buf + DNX_A + (a0 ^ ((unsigned)ks << 6))); }
#pragma unroll
    for (int mt = 0; mt < 4; ++mt) { const unsigned row = 16 * mt + c, a0 = row * 128u + ((((unsigned)g) ^ ((row >> 1) & 7u)) << 4);
        dt[mt] = *(const LAS u32x2*)(buf + DNX_DT + (t0 ^ ((unsigned)mt << 5)));
#pragma unroll
        for (int ks = 0; ks < 2; ++ks) cf[mt][ks] = *(const LAS bf16x8*)(buf + DNX_C + (a0 ^ ((unsigned)ks << 6))); }
    const float gm = ((const LAS float*)(buf + DNX_EG))[63];
    bf16x8 Sb[2];
#pragma unroll
    for (int ks = 0; ks < 2; ++ks) Sb[ks] = pack_f4f4(Sacc[2 * ks], Sacc[2 * ks + 1]);
    __builtin_amdgcn_sched_barrier(0);
#pragma unroll
    for (int mt = 0; mt < 4; ++mt) { f32x4 sn = Sacc[mt] * gm + (f32x4){bf_lo(bt[mt].x), bf_hi(bt[mt].x), bf_lo(bt[mt].y), bf_hi(bt[mt].y)};
#pragma unroll
        for (int ks = 0; ks < 2; ++ks) sn = __builtin_amdgcn_mfma_f32_16x16x32_bf16(af[mt][ks], Sb[ks], sn, 0, 0, 0);
        Sacc[mt] = sn; }
#pragma unroll
    for (int mt = 0; mt < 4; ++mt) { f32x4 oa = (f32x4){bf_lo(dt[mt].x), bf_hi(dt[mt].x), bf_lo(dt[mt].y), bf_hi(dt[mt].y)};
#pragma unroll
        for (int ks = 0; ks < 2; ++ks) oa = __builtin_amdgcn_mfma_f32_16x16x32_bf16(cf[mt][ks], Sb[ks], oa, 0, 0, 0);
#pragma unroll
        for (int r = 0; r < 4; ++r) { const int p = 16 * mt + 4 * g + r, i = dir ? 63 - p : p;
            *(LAS bf16*)(ost + i * 128 + (16 * ws + c) * 2) = (bf16)(pk2(oa[r], 0.f) & 0xffffu); } }
}
__device__ __forceinline__ void dn_scan_unit(Frame& F, const Args& a, int b, int h, int dir) {
    bf16* P = (bf16*)(a.ws + WS_P);
    const int w = F.wave, lane = F.lane;
#define DN_BAR() do { asm volatile("s_waitcnt lgkmcnt(0)" ::: "memory"); __builtin_amdgcn_s_barrier(); asm volatile("" ::: "memory"); } while (0)
    if (w < 4) {
        f32x4 Sacc[4];
#pragma unroll
        for (int mt = 0; mt < 4; ++mt) Sacc[mt] = (f32x4){0.f, 0.f, 0.f, 0.f};
        bf16* Ob = P + (size_t)b * SEQ * PLD + (dir ? C_OB : C_OF) + h * 64;
        DN_BAR();
        int slot = 0;
#pragma unroll 1
        for (int s = 0; s <= 128; ++s) {
            if (s > 0) { const int cp = dir ? 128 - s : s - 1; const LAS unsigned char* st = F.lds + DNX_OST + ((s - 1) & 1) * 8192;
#pragma unroll
                for (int k = 0; k < 2; ++k) { const int idx = F.tid + 256 * k, row = idx >> 3, ch = idx & 7;
                    *(u32x4*)(Ob + ((size_t)cp * 64 + row) * PLD + ch * 8) = *(const LAS u32x4*)(st + row * 128 + ch * 16); } }
            if (s < 128) dn_scan_step(F.lds + slot * DNX_SZ, Sacc, w, lane, F.lds + DNX_OST + (s & 1) * 8192, dir);
            slot = slot == 2 ? 0 : slot + 1;
            DN_BAR();
        }
    } else {
        const int hw = w - 4;
        const bf16* XB2 = (const bf16*)a.out + (size_t)M * 1024;
        const float* BAg = (const float*)(a.ws + WS_BA);
        const char* gp[8]; long gstep[8];
#pragma unroll
        for (int i = 0; i < 8; ++i) { const int pid = hw * 8 + i, blk = pid >> 3, pc = pid & 7, r = 8 * pc + (lane >> 3), cp = lane & 7;
            const int key = (r >> 1) & 7, cs = cp ^ key;
            const size_t tokb = (size_t)b * SEQ;
            if (dir == 1 && blk >= 2) { gp[i] = (const char*)(XB2 + (size_t)(blk - 2) * M * 512 + (tokb + r) * 512 + cs * 8); gstep[i] = 64L * 512 * 2; }
            else { const int col = blk == 0 ? (dir ? SAB : SAF) : blk == 1 ? (dir ? SCB : SCF) : blk == 2 ? SBF : SDF;
                   gp[i] = (const char*)(P + (tokb + r) * PLD + col + cs * 8); gstep[i] = 64L * PLD * 2; } }
        const char* ggc = (const char*)(BAg + ((size_t)b * SEQ + lane) * 32 + dir * 8 + h);
#define DN_ISSUE(n, slot_) do { const int cn_ = dir ? 127 - (n) : (n); LAS unsigned char* sb_ = F.lds + (slot_) * DNX_SZ; const long hoff_ = ((h + cn_) & 7) * 128;     \
        _Pragma("unroll") for (int i = 0; i < 8; ++i) { const int pid = hw * 8 + i; \
            __builtin_amdgcn_global_load_lds((const unsigned*)(gp[i] + (long)cn_ * gstep[i] + hoff_), (LAS unsigned*)(sb_ + (pid >> 3) * 8192 + (pid & 7) * 1024), 16, 0, 0); } \
        if (lane == 63) __builtin_amdgcn_global_load_lds((const unsigned*)(ggc + (long)cn_ * (64L * 32 * 4)), (LAS unsigned*)(sb_ + DNX_EG + hw * 256), 4, 0, 0); } while (0)
        DN_ISSUE(0, 0); DN_ISSUE(1, 1);
        asm volatile("s_waitcnt vmcnt(9)" ::: "memory");
        DN_BAR();
        int slot2 = 2;
#pragma unroll 1
        for (int s = 0; s <= 128; ++s) {
            if (s + 2 < 128) { DN_ISSUE(s + 2, slot2); asm volatile("s_waitcnt vmcnt(9)" ::: "memory"); }
            else { asm volatile("s_waitcnt vmcnt(0)" ::: "memory"); }
            slot2 = slot2 == 2 ? 0 : slot2 + 1;
            DN_BAR();
        }
#undef DN_ISSUE
    }
#undef DN_BAR
    __syncthreads();
}
__device__ __forceinline__ void dn_combine(Frame& F, const Args& a) {
    bf16* P = (bf16*)(a.ws + WS_P);
    const float* og = a.in[11];
    const int gw = F.vcu * NWAVES + F.wave, NGW = F.G * NWAVES, c0 = F.lane * 8;
    for (int row = gw; row < M; row += NGW) {
        bf16* rp = P + (size_t)row * PLD;
        float of[8], ob[8]; unpack8(*(const u32x4*)(rp + C_OF + c0), of); unpack8(*(const u32x4*)(rp + C_OB + c0), ob);
        float s[8], ss = 0.f;
#pragma unroll
        for (int j = 0; j < 8; ++j) { s[j] = of[j] + ob[j]; ss += s[j] * s[j]; }
        ss = group8_sum_dpp(ss);
        const float rstd = __builtin_amdgcn_rsqf(ss * (1.0f / 64) + EPS);
        bf16* zp = rp + C_DZ + c0; float z[8]; unpack8(*(const u32x4*)zp, z);
        const f32x4 g0 = *(const f32x4*)(og + (c0 & 63)), g1 = *(const f32x4*)(og + (c0 & 63) + 4);
        float y[8];
#pragma unroll
        for (int j = 0; j < 4; ++j) { y[j] = s[j] * rstd * g0[j] * siluf_(z[j]); y[4 + j] = s[4 + j] * rstd * g1[j] * siluf_(z[4 + j]); }
        *(u32x4*)zp = pack8(y);
    }
}
__device__ __forceinline__ void ffn_fixup_panel(Frame& F, const Args& a, int pm, int ch0) {
    bf16* P = (bf16*)(a.ws + WS_P); const float* UE = (const float*)(a.ws + WS_UE);
    const float* cw = a.in[22]; const float* cb = a.in[23];
    constexpr int NQ = DFF / 16;
#pragma unroll 1
    for (int e = F.tid; e < 2 * NQ; e += 512) { const int last = e / NQ, ch = ch0 + (e % NQ) * 4, g = pm * 4 + (last ? 3 : 0);
        const int row = g * 64 + (last ? 63 : 0);
        const bool hp = last ? true : (row % SEQ) != 0, hn = last ? (row % SEQ) != SEQ - 1 : true;
        const float* pu = UE + ((size_t)(last ? g : (g > 0 ? g - 1 : 0)) * 4 + (last ? 2 : 3)) * NUP;
        const float* cu = UE + ((size_t)g * 4 + (last ? 3 : 0)) * NUP;
        const float* nu = UE + ((size_t)(last ? (g < 511 ? g + 1 : 511) : g) * 4 + (last ? 0 : 1)) * NUP;
        f32x4 pg = *(const f32x4*)(pu + ch), pv = *(const f32x4*)(pu + DFF + ch), ng = *(const f32x4*)(nu + ch), nv = *(const f32x4*)(nu + DFF + ch);
        const f32x4 cg = *(const f32x4*)(cu + ch), cv = *(const f32x4*)(cu + DFF + ch);
        const f32x4 w0g = *(const f32x4*)(cw + ch), w1g = *(const f32x4*)(cw + NUP + ch), w2g = *(const f32x4*)(cw + 2 * NUP + ch), bg = *(const f32x4*)(cb + ch);
        const f32x4 w0v = *(const f32x4*)(cw + DFF + ch), w1v = *(const f32x4*)(cw + NUP + DFF + ch), w2v = *(const f32x4*)(cw + 2 * NUP + DFF + ch), bv = *(const f32x4*)(cb + DFF + ch);
        asm volatile("" : "+v"(pg), "+v"(pv), "+v"(ng), "+v"(nv));
        const float mp = hp ? 1.f : 0.f, mn = hn ? 1.f : 0.f;
        const f32x4 gate = w0g * (pg * mp) + w1g * cg + w2g * (ng * mn) + bg;
        const f32x4 val = w0v * (pv * mp) + w1v * cv + w2v * (nv * mn) + bv;
        u32x2 w; w.x = pk2(siluf_(gate[0]) * val[0], siluf_(gate[1]) * val[1]); w.y = pk2(siluf_(gate[2]) * val[2], siluf_(gate[3]) * val[3]);
        *(u32x2*)(P + (size_t)row * PLD + C_ACT + ch) = w; }
}

struct OneUnit { int pm, pn;
    __device__ __forceinline__ bool next(int i, Unit& u) const { if (i != 0) return false; u.pm = pm; u.pn = pn; return true; }
    __device__ __forceinline__ void a_ready(const Unit&) const {}
    __device__ __forceinline__ void done(const Unit&) const {} };
__global__ void __launch_bounds__(NWAVES * 64, 2) fwd_kernel(Args args) {
    extern __shared__ __attribute__((aligned(16))) unsigned char lds[];
    Frame F;
    F.lds = (LAS unsigned char*)lds;
    F.MISC = (volatile LAS unsigned*)(F.lds + MISC_OFF);
    F.tid = threadIdx.x; F.lane = F.tid & 63; F.wave = __builtin_amdgcn_readfirstlane(F.tid >> 6);
    F.G = gridDim.x; { const int bx = blockIdx.x; F.vcu = (F.G % 8 == 0) ? (bx % 8) * (F.G / 8) + bx / 8 : bx; }
    unsigned char* ws = args.ws;
    F.ctl = (gu32*)(ws + WS_CTL);
    for (int u = F.tid; u < (LDS_BYTES - LDSCTL_OFF) / 4; u += NWAVES * 64) ((LAS unsigned*)(F.lds + LDSCTL_OFF))[u] = 0u;
    __syncthreads();
    const int lo = args.ph_lo, hi = args.ph_hi;
    const bool single = (hi - lo) > 1;
    XcdBarrier bar; bar.bar = (unsigned*)(F.ctl + CW_BAR); bar.x = 0; bar.st = nullptr;
    if (single) bar = xcd_barrier_post((unsigned*)(F.ctl + CW_BAR), F.MISC + 8);
#ifndef PH_MASK
#define PH_MASK 0x1FF
#endif
#define IN(k) (((PH_MASK >> (k)) & 1) && lo <= (k) && (k) < hi)
#define SEAM(k) do { if (IN(k) && IN((k) + 1)) xcd_barrier(bar); } while (0)
    bf16* P = (bf16*)(ws + WS_P);
    const int bid = (int)blockIdx.x;
#ifdef DBG_IN
#define TS(k) do { if (bid == DBG_BLK && F.tid == 0) ((unsigned long long*)(ws + WS_CTL + 65536))[k] = __builtin_amdgcn_s_memrealtime(); } while (0)
#else
#define TS(k) do {} while (0)
#endif
#define TSB(k, blk) do {} while (0)
    TS(0);

    if (IN(0)) { p0_prologue(F, args); }
    SEAM(0); TS(1);
    if (IN(1)) {
        { pg8::Gemm g{(const bf16*)args.out, (const bf16*)(ws + WS_WIN), M, 3584, 1024, 1024, 1024}; pg8::StaticOrder S; S.init(M, 3584, F.G, bid);
          EpiInProj E{P, (float*)(ws + WS_BA), F.lds + RING_OFF + pg8::STAGE_BYTES};
          pg8::gemm_phase<EpiInProj, pg8::StaticOrder, true, true>(F.lds + RING_OFF, g, S, E); }
    }
    SEAM(1); TS(2);
    if (IN(2)) {
        const bool full = F.G == 256; const int nU = full ? 256 : 4096;
        for (int u = bid; u < nU; u += F.G) { const int uu = full ? u * 16 : u; dn_prep_block(F, args, uu >> 10, (uu >> 7) & 7, uu & 127, full ? 16 : 1); }
    }
    TS(12); SEAM(2); TS(3);
    if (IN(3)) {
        const int ndn = F.G >= 128 ? 64 : 0;
        if (args.mode != 2) for (int u = (ndn ? (bid < ndn ? bid : 64) : bid); u < 64; u += (ndn ? 64 : F.G)) dn_scan_unit(F, args, u >> 4, (u >> 1) & 7, u & 1);
        if (bid >= ndn && args.mode != 1) { const int nb = F.G - ndn, me = bid - ndn;
            { const int pbase = nb >= 80 ? 64 : 0, np = (nb - pbase) < 16 ? (nb - pbase) : 16;
              if (me >= pbase && me < pbase + np) { unsigned done = 0;
                  for (int u = me - pbase; u < 16; u += np) {
                      pg8::Gemm g{(const bf16*)(ws + WS_MEMN), (const bf16*)(ws + WS_WKV), BATCH * NMEM, 1024, 1024, 1024, 1024}; OneUnit S{u >> 2, u & 3};
                      EpiBf16 E{(bf16*)(ws + WS_KV), 1024};
                      pg8::gemm_phase<EpiBf16, OneUnit, true, true>(F.lds + RING_OFF, g, S, E); ++done; }
                  VM_WAIT(); __syncthreads();
                  if (F.tid == 0) { __builtin_amdgcn_fence(__ATOMIC_RELEASE, "agent"); VM_WAIT(); (void)xb_add((unsigned*)(F.ctl + CW_KVF), done); }
              } }
            const bool tuned = nb == 192;
            bool kv_ready = false;
            for (int k = 0; ; ++k) { int u = me + k * nb;
                if (tuned && k == 4 && me >= 64 && me < 80) continue;
                if (tuned && k == 5 && me >= 80 && me < 96) u = (me - 16) + 4 * nb;
                if (u >= 1024) break;
                if (u < 512) attnA_unit(F, args, u >> 7, (u >> 1) & 63, u & 1);
                else { const int v = u - 512;
                    if (!kv_ready) { kv_ready = true;
                        if (F.tid == 0) { unsigned* bw = (unsigned*)(F.ctl + CW_BAR); XB_SPIN(xb_ld((unsigned*)(F.ctl + CW_KVF)) < 16u, bw); __builtin_amdgcn_fence(__ATOMIC_ACQUIRE, "agent"); VM_WAIT(); }
                        __syncthreads(); }
                    xattn_unit(F, args, v >> 7, (v >> 2) & 31, v & 3); }
            }
            if (tuned) { constexpr int WI_TAIL = 448;
                if (me >= 96) weight_items(F, args, WI_EARLY, WI_ALL - WI_TAIL, (me - 96) * NWAVES + F.wave, 96 * NWAVES);
                else if (me >= 64 && me < 80) weight_items(F, args, WI_ALL - WI_TAIL, WI_ALL, (me - 64) * NWAVES + F.wave, 16 * NWAVES); }
            else weight_items(F, args, WI_EARLY, WI_ALL, me * NWAVES + F.wave, nb * NWAVES);
        }
    }
    TS(10); TSB(11, 64); SEAM(3); TS(4);
    if (IN(4)) {
        dn_combine(F, args);
        pg8::Gemm g{(const bf16*)args.out, (const bf16*)(ws + WS_WIN) + (size_t)3584 * 1024, M, 3072, 1024, 1024, 1024}; pg8::StaticOrder S; S.init(M, 3072, F.G, bid);
        EpiGatesU8 E{P};
        pg8::gemm_phase<EpiGatesU8, pg8::StaticOrder, true, true>(F.lds + RING_OFF, g, S, E);
    }
    SEAM(4); TS(5);
    if (IN(5)) {
        pg8::Gemm g{P + C_AQ, (const bf16*)(ws + WS_WBR), M, 1024, 1536, PLD, 512};
        g.segt = 8; g.aoff1 = (long)(C_DZ - C_AQ) * 2 - 8 * 128; g.aoff2 = (long)(C_MQ - C_AQ) * 2 - 16 * 128;
        g.boff1 = (long)1024 * 512 * 2 - 8 * 128; g.boff2 = (long)2 * 1024 * 512 * 2 - 16 * 128;
        pg8::StaticOrder S; S.init(M, 1024, F.G, bid);
        EpiMerge E{P}; pg8::gemm_phase<EpiMerge, pg8::StaticOrder, true, true>(F.lds + RING_OFF, g, S, E);
    }
    SEAM(5); TS(6);
    if (IN(6)) {
        pg8::Gemm g{P + C_MG, (const bf16*)(ws + WS_WOUT), M, 1024, 1024, PLD, 1024}; pg8::StaticOrder S; S.init(M, 1024, F.G, bid);
        EpiWout E{args.in[0], args.out, P, (float*)(ws + WS_SSQ), (LAS float*)(F.lds + XCH_OFF)};
        pg8::gemm_phase<EpiWout, pg8::StaticOrder, true, true>(F.lds + RING_OFF, g, S, E);
    }
    SEAM(6); TS(7);
    if (IN(7)) {
        pg8::Gemm g{P + C_X1B, (const bf16*)(ws + WS_WUP), M, NUP, 1024, PLD, 1024}; pg8::StaticOrder S; S.init(M, NUP, F.G, bid);
        EpiUp E{(const float*)(ws + WS_SSQ), args.in[22], args.in[23], P, (float*)(ws + WS_UE), (LAS float*)(F.lds + XCH_OFF), (LAS float*)(F.lds + RING_OFF + pg8::STAGE_BYTES)};
        pg8::gemm_phase<EpiUp, pg8::StaticOrder, true, true>(F.lds + RING_OFF, g, S, E);
    }
    SEAM(7); TS(8);
    if (IN(8)) {
        pg8::Gemm g{P + C_ACT, (const bf16*)(ws + WS_WDN), M, 1024, DFF, PLD, DFF}; pg8::StaticOrder S; S.init(M, 1024, F.G, bid);
        TS(20);
        { Unit u; for (int i = 0; S.next(i, u); ++i) ffn_fixup_panel(F, args, u.pm, u.pn * (DFF / 4)); }
        VM_WAIT(); __syncthreads(); TS(22);
        if (F.tid == 0) { unsigned* fx = (unsigned*)(F.ctl + CW_FIX); Unit u;
            __builtin_amdgcn_fence(__ATOMIC_RELEASE, "agent"); VM_WAIT();
            for (int i = 0; S.next(i, u); ++i) (void)xb_add(fx + u.pm, 1u);
            TS(23);
            for (int i = 0; S.next(i, u); ++i) { XB_SPIN(xb_ld(fx + u.pm) < 4u, (unsigned*)(F.ctl + CW_BAR)); }
            __builtin_amdgcn_fence(__ATOMIC_ACQUIRE, "agent"); VM_WAIT(); }
        __syncthreads(); TS(21);
        EpiDown E{args.out, P};
        pg8::gemm_phase<EpiDown, pg8::StaticOrder, true, true>(F.lds + RING_OFF, g, S, E);
    }
    TS(9);
#undef IN
#undef SEAM
}

#ifdef DBG_IN
__global__ void dbg_wait_in_kernel(unsigned char* ws) {
    if (threadIdx.x == 0) { const unsigned long long* tsb = (const unsigned long long*)(ws + WS_CTL + 65536);
        const unsigned long long te = __builtin_amdgcn_s_memrealtime();
        const unsigned long long W = (tsb[DBG_A1] - tsb[DBG_A0]) * (unsigned long long)DBG_GAIN;
        while (__builtin_amdgcn_s_memrealtime() - te < W) __builtin_amdgcn_s_sleep(32); }
}
#endif
#ifdef DBG_TIME
__global__ void dbg_ts_kernel(unsigned char* ws, int k) { if (threadIdx.x == 0) ((unsigned long long*)(ws + WS_CTL + 65536))[k] = __builtin_amdgcn_s_memrealtime(); }
__global__ void dbg_wait_kernel(unsigned char* ws) {
    if (threadIdx.x == 0) { const unsigned long long* tsb = (const unsigned long long*)(ws + WS_CTL + 65536);
        const unsigned long long te = __builtin_amdgcn_s_memrealtime();
        const unsigned long long d1 = tsb[DBG_A1] - tsb[DBG_A0], d2 = tsb[DBG_B1] - tsb[DBG_B0];
        const unsigned long long W = d1 + 100000ull * (d2 / 1000ull);
        while (__builtin_amdgcn_s_memrealtime() - te < W) __builtin_amdgcn_s_sleep(32); }
}
#endif
constexpr int N_PHASES = 9;
#ifndef MK_PER_PHASE
#define MK_PER_PHASE 0
#endif
extern "C" void kernel_launch(void* const* d_in, const int* in_sizes, int n_in, void* d_out, int out_size, void* d_ws, size_t ws_size, hipStream_t stream) {
    static int grid = 0;
    if (grid == 0) {
        if (n_in != 25 || in_sizes[0] != M * DM || out_size != M * DM || ws_size < WS_END) {
            fprintf(stderr, "kernel_launch: unexpected shapes (n_in %d, in0 %d, out %d, ws %zu); nothing launched\n", n_in, n_in > 0 ? in_sizes[0] : -1, out_size, ws_size); grid = -1; return; }
        int dev = 0, cus = 0, per_cu = 0;
        if (hipGetDevice(&dev) != hipSuccess || hipDeviceGetAttribute(&cus, hipDeviceAttributeMultiprocessorCount, dev) != hipSuccess) { grid = -1; return; }
        if (hipFuncSetAttribute((const void*)fwd_kernel, hipFuncAttributeMaxDynamicSharedMemorySize, LDS_BYTES) != hipSuccess) { fprintf(stderr, "kernel_launch: hipFuncSetAttribute failed\n"); grid = -1; return; }
        if (hipOccupancyMaxActiveBlocksPerMultiprocessor(&per_cu, (const void*)fwd_kernel, NWAVES * 64, LDS_BYTES) != hipSuccess || per_cu < 1) { fprintf(stderr, "kernel_launch: occupancy query reports %d\n", per_cu); }
        (void)hipGetLastError();
        grid = cus;
    }
    if (grid < 0) return;
    if (hipMemsetAsync((char*)d_ws + WS_CTL, 0, CTL_ZERO_BYTES, stream) != hipSuccess) return;
    Args a{};
    for (int i = 0; i < 25; ++i) a.in[i] = (const float*)d_in[i];
    a.out = (float*)d_out; a.ws = (unsigned char*)d_ws;
#ifdef DBG_TIME
    for (int p = 0; p < N_PHASES; ++p) { hipLaunchKernelGGL(dbg_ts_kernel, dim3(1), dim3(64), 0, stream, (unsigned char*)d_ws, p);
        a.ph_lo = p; a.ph_hi = p + 1;
        if (p == 3) { a.mode = 1; hipLaunchKernelGGL(fwd_kernel, dim3(grid), dim3(NWAVES * 64), LDS_BYTES, stream, a); hipLaunchKernelGGL(dbg_ts_kernel, dim3(1), dim3(64), 0, stream, (unsigned char*)d_ws, 12); a.mode = 2; }
        hipLaunchKernelGGL(fwd_kernel, dim3(grid), dim3(NWAVES * 64), LDS_BYTES, stream, a); a.mode = 0; }
    hipLaunchKernelGGL(dbg_ts_kernel, dim3(1), dim3(64), 0, stream, (unsigned char*)d_ws, N_PHASES);
    hipLaunchKernelGGL(dbg_wait_kernel, dim3(1), dim3(64), 0, stream, (unsigned char*)d_ws);
    return;
#endif
    if (MK_PER_PHASE) {
        for (int p = 0; p < N_PHASES; ++p) { a.ph_lo = p; a.ph_hi = p + 1; hipLaunchKernelGGL(fwd_kernel, dim3(grid), dim3(NWAVES * 64), LDS_BYTES, stream, a); }
    } else {
        a.ph_lo = 0; a.ph_hi = N_PHASES; hipLaunchKernelGGL(fwd_kernel, dim3(grid), dim3(NWAVES * 64), LDS_BYTES, stream, a);
    }
#ifdef DBG_IN
    hipLaunchKernelGGL(dbg_wait_in_kernel, dim3(1), dim3(64), 0, stream, (unsigned char*)d_ws);
#endif
}
```
